# Optimizing an MI355X kernel written in HIP

```python
import jax, jax.numpy as jnp
from jax import lax
import numpy as np

D_MODEL = 1024
BATCH = 16
SEQ = 2048
DEPTH = 4

CHUNK = 64
RWKV_HEADS = 8
RWKV_HEAD_DIM = 64
RWKV_WIDTH = RWKV_HEADS * RWKV_HEAD_DIM
ATT_HEADS = 8
ATT_HEAD_DIM = 64
ATT_WIDTH = ATT_HEADS * ATT_HEAD_DIM
MIX_WIDTH = RWKV_WIDTH + ATT_WIDTH
DECAY_LORA = 64
AAA_LORA = 64
MV_LORA = 32
GATE_LORA = 128
RWKV_IN = 3 * RWKV_WIDTH + DECAY_LORA + AAA_LORA + GATE_LORA
RWKV_SPLITS = (RWKV_WIDTH, 2 * RWKV_WIDTH, 3 * RWKV_WIDTH,
               3 * RWKV_WIDTH + DECAY_LORA, 3 * RWKV_WIDTH + DECAY_LORA + AAA_LORA)
ATT_IN = 3 * ATT_WIDTH
IN_WIDTH = RWKV_IN + ATT_IN
PREV_CHUNKS = 8
BAND = (PREV_CHUNKS + 1) * CHUNK
REL_MAX = 256
REL_BUCKETS = REL_MAX + CHUNK
N_MEM = 256
XA_HEADS = 4
XA_HEAD_DIM = 128
XA_WIDTH = XA_HEADS * XA_HEAD_DIM
N_GROUPS = 4
EXPERTS_PER_GROUP = 8
N_EXPERTS = N_GROUPS * EXPERTS_PER_GROUP
TOP_K = 2
EXPERT_FF = 512
MOE_BLOCK = 128
NORM_EPS = 1e-6
LNX_EPS = 64e-5
NEG_INF = -1e30

kernel_name = 'hybrid_rwkv7_chunkattn_hmoe'


def rms_norm(x, g, eps=NORM_EPS):
    x32 = x.astype(jnp.float32)
    y = x32 * lax.rsqrt(jnp.mean(x32 * x32, axis=-1, keepdims=True) + eps)
    return (y * g.astype(jnp.float32)).astype(x.dtype)


def token_shift(u):
    return jnp.pad(u, ((0, 0), (1, 0), (0, 0)))[:, :-1]


def wkv7_scan(r, decay, k, v, a, b):
    B, S, H, N = r.shape

    def step(state, inp):
        r_t, w_t, k_t, v_t, a_t, b_t = inp
        sa = jnp.einsum('bhvk,bhk->bhv', state, a_t)
        state = (state * w_t[:, :, None, :] + sa[..., None] * b_t[:, :, None, :]
                 + v_t[..., None] * k_t[:, :, None, :])
        return state, jnp.einsum('bhvk,bhk->bhv', state, r_t)

    xs = tuple(jnp.moveaxis(t, 1, 0) for t in (r, decay, k, v, a, b))
    s0 = jnp.zeros((B, H, N, N), jnp.float32)
    _, ys = lax.scan(step, s0, xs)
    return jnp.moveaxis(ys, 0, 1)


def rwkv7_time_mix(u, v_first, mu, w0, w2, a0, a2, g2, k_k, k_a, r_k, lnx_w, lnx_b, vres):
    B, S, _ = u.shape
    H, N = RWKV_HEADS, RWKV_HEAD_DIM
    u = u.astype(jnp.float32)
    u = u + mu * (token_shift(u) - u)
    r, k, v, wl, al, gl = jnp.split(u, RWKV_SPLITS, axis=-1)
    w = w0 + jnp.tanh(wl) @ w2
    w = -jax.nn.softplus(-w) - 0.5
    decay = jnp.exp(-jnp.exp(w))
    a = jax.nn.sigmoid(a0 + al @ a2)
    g = jax.nn.sigmoid(gl) @ g2
    if vres is None:
        v_first = v
    else:
        v0, v1, v2 = vres
        v = v + (v_first - v) * jax.nn.sigmoid(v0 + (v @ v1) @ v2)
    kk = (k * k_k).reshape(B, S, H, N)
    kk = kk * lax.rsqrt(jnp.maximum(jnp.sum(kk * kk, axis=-1, keepdims=True), 1e-24))
    k = k * (1.0 + (a - 1.0) * k_a)
    r_h = r.reshape(B, S, H, N)
    k_h = k.reshape(B, S, H, N)
    v_h = v.reshape(B, S, H, N)
    a_h = a.reshape(B, S, H, N)
    y = wkv7_scan(r_h, decay.reshape(B, S, H, N), k_h, v_h, -kk, kk * a_h)
    mean = jnp.mean(y, axis=-1, keepdims=True)
    var = jnp.mean(jnp.square(y - mean), axis=-1, keepdims=True)
    y = ((y - mean) * lax.rsqrt(var + LNX_EPS)).reshape(B, S, RWKV_WIDTH) * lnx_w + lnx_b
    bonus = jnp.sum(r_h * k_h * r_k, axis=-1, keepdims=True) * v_h
    y = (y + bonus.reshape(B, S, RWKV_WIDTH)) * g
    return y, v_first


def rel_bias_band(table):
    q_off = jnp.arange(CHUNK)[:, None]
    k_off = jnp.arange(BAND)[None, :] - PREV_CHUNKS * CHUNK
    dist = jnp.clip(q_off - k_off, -(CHUNK - 1), REL_MAX) + (CHUNK - 1)
    return table[:, dist].astype(jnp.float32)


def chunk_band_attention(q, k, v, bias):
    B, S, H, Dh = q.shape
    nc = S // CHUNK
    pad = PREV_CHUNKS * CHUNK
    qc = q.reshape(B, nc, CHUNK, H, Dh).transpose(1, 0, 3, 2, 4)
    kp = jnp.pad(k, ((0, 0), (pad, 0), (0, 0), (0, 0))).transpose(0, 2, 1, 3)
    vp = jnp.pad(v, ((0, 0), (pad, 0), (0, 0), (0, 0))).transpose(0, 2, 1, 3)
    band_off = jnp.arange(BAND) - pad
    scale = Dh ** -0.5

    def one_chunk(args):
        c, qb = args
        start = c * CHUNK
        kb = lax.dynamic_slice_in_dim(kp, start, BAND, axis=2)
        vb = lax.dynamic_slice_in_dim(vp, start, BAND, axis=2)
        s = jnp.einsum('bhqd,bhkd->bhqk', qb.astype(jnp.float32), kb.astype(jnp.float32)) * scale + bias
        s = jnp.where((start + band_off) >= 0, s, NEG_INF)
        p = jax.nn.softmax(s, axis=-1)
        return jnp.einsum('bhqk,bhkd->bhqd', p.astype(vb.dtype), vb)

    out = lax.map(one_chunk, (jnp.arange(nc, dtype=jnp.int32), qc))
    return out.transpose(1, 0, 3, 2, 4).reshape(B, S, H * Dh)


def memory_cross_attention(h, mem_n, w_q, w_kv, w_o, q_norm, k_norm):
    B, S, _ = h.shape
    M = mem_n.shape[1]
    q = (h @ w_q).reshape(B, S, XA_HEADS, XA_HEAD_DIM)
    k, v = jnp.split(mem_n @ w_kv, 2, axis=-1)
    k = k.reshape(B, M, XA_HEADS, XA_HEAD_DIM)
    v = v.reshape(B, M, XA_HEADS, XA_HEAD_DIM)
    q = rms_norm(q, q_norm)
    k = rms_norm(k, k_norm)
    s = jnp.einsum('bshd,bmhd->bhsm', q.astype(jnp.float32), k.astype(jnp.float32)) * (XA_HEAD_DIM ** -0.5)
    p = jax.nn.softmax(s, axis=-1)
    o = jnp.einsum('bhsm,bmhd->bshd', p.astype(v.dtype), v).reshape(B, S, XA_WIDTH)
    return o @ w_o


def hierarchical_moe(h, w_group, b_group, w_route, b_route, w_gate, w_up, w_down):
    B, S, D = h.shape
    T = B * S
    xt = h.reshape(T, D)
    group_p = jax.nn.softmax((xt @ w_group).astype(jnp.float32) + b_group, axis=-1)
    g_top = jnp.argmax(group_p, axis=-1).astype(jnp.int32)
    g_gate = jnp.take_along_axis(group_p, g_top[:, None], axis=-1)[:, 0]
    logits = ((xt @ w_route).astype(jnp.float32) + b_route).reshape(T, N_GROUPS, EXPERTS_PER_GROUP)
    logits = jnp.take_along_axis(logits, g_top[:, None, None], axis=1)[:, 0]
    p_in = jax.nn.softmax(logits, axis=-1)
    top_p, top_j = lax.top_k(p_in, TOP_K)
    top_p = top_p / jnp.sum(top_p, axis=-1, keepdims=True)
    weights = g_gate[:, None] * top_p
    expert_id = g_top[:, None] * EXPERTS_PER_GROUP + top_j.astype(jnp.int32)
    A = T * TOP_K
    e = expert_id.reshape(A)
    tok = jnp.repeat(jnp.arange(T, dtype=jnp.int32), TOP_K)
    wts = weights.reshape(A)
    order = jnp.argsort(e)
    e_s, tok_s, w_s = e[order], tok[order], wts[order]
    counts = jnp.bincount(e, length=N_EXPERTS)
    starts = jnp.cumsum(counts) - counts
    padded = ((counts + MOE_BLOCK - 1) // MOE_BLOCK) * MOE_BLOCK
    pends = jnp.cumsum(padded)
    pstarts = pends - padded
    dest = pstarts[e_s] + (jnp.arange(A, dtype=jnp.int32) - starts[e_s])
    n_blocks = (A + N_EXPERTS * (MOE_BLOCK - 1) + MOE_BLOCK - 1) // MOE_BLOCK
    L = n_blocks * MOE_BLOCK
    buf_tok = jnp.full((L,), T, jnp.int32).at[dest].set(tok_s)
    buf_w = jnp.zeros((L,), wts.dtype).at[dest].set(w_s)
    block_expert = jnp.minimum(
        jnp.searchsorted(pends, jnp.arange(n_blocks) * MOE_BLOCK, side='right'), N_EXPERTS - 1).astype(jnp.int32)
    xs = jnp.concatenate([xt, jnp.zeros((1, D), xt.dtype)], axis=0)[buf_tok].reshape(n_blocks, MOE_BLOCK, D)

    def expert_block(args):
        xb, eid = args
        return (jax.nn.silu(xb @ w_gate[eid]) * (xb @ w_up[eid])) @ w_down[eid]

    yb = lax.map(expert_block, (xs, block_expert)).reshape(L, D)
    out = jnp.zeros((T + 1, D), yb.dtype).at[buf_tok].add(yb * buf_w[:, None].astype(yb.dtype))
    return out[:T].reshape(B, S, D)


def setup_inputs(seed: int = 0) -> dict:
    key = jax.random.key(seed)
    ks = iter(jax.random.split(key, 48))

    def nrm(shape, scale):
        return jax.random.normal(next(ks), shape, jnp.float32) * scale

    L, LV, D = DEPTH, DEPTH - 1, D_MODEL
    return {
        'x': nrm((BATCH, SEQ, D), 1.0),
        'mem': nrm((BATCH, N_MEM, D), 1.0),
        'norm_mix': 1.0 + nrm((L, D), 0.02),
        'w_in': nrm((L, D, IN_WIDTH), D ** -0.5),
        'shift_mu': jax.random.uniform(next(ks), (L, RWKV_IN), jnp.float32),
        'decay_w0': jax.random.uniform(next(ks), (L, RWKV_WIDTH), jnp.float32, -6.0, -1.0),
        'decay_w2': nrm((L, DECAY_LORA, RWKV_WIDTH), 0.1),
        'iclr_a0': nrm((L, RWKV_WIDTH), 0.1),
        'iclr_a2': nrm((L, AAA_LORA, RWKV_WIDTH), 0.1),
        'gate_g2': nrm((L, GATE_LORA, RWKV_WIDTH), GATE_LORA ** -0.5),
        'rw_k_k': 0.85 + nrm((L, RWKV_WIDTH), 0.05),
        'rw_k_a': 1.0 + nrm((L, RWKV_WIDTH), 0.05),
        'rw_r_k': nrm((L, RWKV_HEADS, RWKV_HEAD_DIM), 0.1),
        'lnx_w': 1.0 + nrm((L, RWKV_WIDTH), 0.05),
        'lnx_b': nrm((L, RWKV_WIDTH), 0.01),
        'vres_v0': 1.0 + nrm((LV, RWKV_WIDTH), 0.1),
        'vres_v1': nrm((LV, RWKV_WIDTH, MV_LORA), RWKV_WIDTH ** -0.5),
        'vres_v2': nrm((LV, MV_LORA, RWKV_WIDTH), 0.1),
        'att_q_norm': 1.0 + nrm((L, ATT_HEAD_DIM), 0.02),
        'att_k_norm': 1.0 + nrm((L, ATT_HEAD_DIM), 0.02),
        'att_rel_bias': nrm((L, ATT_HEADS, REL_BUCKETS), 0.5),
        'att_out_norm': 1.0 + nrm((L, ATT_WIDTH), 0.02),
        'w_out': nrm((L, MIX_WIDTH, D), 0.5 * MIX_WIDTH ** -0.5),
        'norm_xa': 1.0 + nrm((L, D), 0.02),
        'norm_mem': 1.0 + nrm((L, D), 0.02),
        'xa_w_q': nrm((L, D, XA_WIDTH), D ** -0.5),
        'xa_w_kv': nrm((L, D, 2 * XA_WIDTH), D ** -0.5),
        'xa_w_o': nrm((L, XA_WIDTH, D), 0.5 * XA_WIDTH ** -0.5),
        'xa_q_norm': 1.0 + nrm((L, XA_HEAD_DIM), 0.02),
        'xa_k_norm': 1.0 + nrm((L, XA_HEAD_DIM), 0.02),
        'norm_ffn': 1.0 + nrm((L, D), 0.02),
        'moe_w_group': nrm((L, D, N_GROUPS), D ** -0.5),
        'moe_b_group': nrm((L, N_GROUPS), 0.01),
        'moe_w_route': nrm((L, D, N_EXPERTS), D ** -0.5),
        'moe_b_route': nrm((L, N_EXPERTS), 0.01),
        'moe_w_gate': nrm((L, N_EXPERTS, D, EXPERT_FF), D ** -0.5),
        'moe_w_up': nrm((L, N_EXPERTS, D, EXPERT_FF), D ** -0.5),
        'moe_w_down': nrm((L, N_EXPERTS, EXPERT_FF, D), 0.5 * EXPERT_FF ** -0.5),
    }


def reference(x, mem, norm_mix, w_in, shift_mu, decay_w0, decay_w2, iclr_a0, iclr_a2, gate_g2,
              rw_k_k, rw_k_a, rw_r_k, lnx_w, lnx_b, vres_v0, vres_v1, vres_v2,
              att_q_norm, att_k_norm, att_rel_bias, att_out_norm, w_out,
              norm_xa, norm_mem, xa_w_q, xa_w_kv, xa_w_o, xa_q_norm, xa_k_norm,
              norm_ffn, moe_w_group, moe_b_group, moe_w_route, moe_b_route,
              moe_w_gate, moe_w_up, moe_w_down):
    B, S, _ = x.shape
    v_first = None
    for l in range(DEPTH):
        h = rms_norm(x, norm_mix[l])
        proj = h @ w_in[l]
        vres = None if l == 0 else (vres_v0[l - 1], vres_v1[l - 1], vres_v2[l - 1])
        y_r, v_first = rwkv7_time_mix(proj[..., :RWKV_IN], v_first, shift_mu[l], decay_w0[l], decay_w2[l],
                                      iclr_a0[l], iclr_a2[l], gate_g2[l], rw_k_k[l], rw_k_a[l], rw_r_k[l],
                                      lnx_w[l], lnx_b[l], vres)
        q, k, v = jnp.split(proj[..., RWKV_IN:], 3, axis=-1)
        q = rms_norm(q.reshape(B, S, ATT_HEADS, ATT_HEAD_DIM), att_q_norm[l])
        k = rms_norm(k.reshape(B, S, ATT_HEADS, ATT_HEAD_DIM), att_k_norm[l])
        v = v.reshape(B, S, ATT_HEADS, ATT_HEAD_DIM)
        y_a = chunk_band_attention(q, k, v, rel_bias_band(att_rel_bias[l]))
        y_a = rms_norm(y_a, att_out_norm[l])
        x = x + jnp.concatenate([y_r.astype(x.dtype), y_a.astype(x.dtype)], axis=-1) @ w_out[l]
        x = x + memory_cross_attention(rms_norm(x, norm_xa[l]), rms_norm(mem, norm_mem[l]),
                                       xa_w_q[l], xa_w_kv[l], xa_w_o[l], xa_q_norm[l], xa_k_norm[l])
        x = x + hierarchical_moe(rms_norm(x, norm_ffn[l]), moe_w_group[l], moe_b_group[l], moe_w_route[l],
                                 moe_b_route[l], moe_w_gate[l], moe_w_up[l], moe_w_down[l])
    return x
```

```cpp
#include <hip/hip_runtime.h>
#include <cstdio>
#include <cstdint>

#ifndef MK_PER_PHASE
#define MK_PER_PHASE 1
#endif

#define LAS __attribute__((address_space(3)))
typedef unsigned short bf16_t;
typedef short bf16x8 __attribute__((ext_vector_type(8)));
typedef float f32x4 __attribute__((ext_vector_type(4)));
typedef unsigned u32x4 __attribute__((ext_vector_type(4)));
typedef unsigned u32x2 __attribute__((ext_vector_type(2)));

constexpr int T = 32768, D = 1024, SEQ = 2048, NL = 4;
constexpr int INW = 3328;
constexpr int MROWS = 4096;
constexpr int MAXROWS = 73728, MAXMT = 288;
constexpr int NPH = 3 + 12 * NL;

constexpr size_t WS_CTL   = 0;
constexpr size_t CTL_BYTES = 65536;
constexpr size_t WS_WIN   = WS_CTL + CTL_BYTES;
constexpr size_t WS_WOUT  = WS_WIN  + (size_t)4 * 3328 * 1024 * 2;
constexpr size_t WS_WQ    = WS_WOUT + (size_t)4 * 1024 * 1024 * 2;
constexpr size_t WS_WKV   = WS_WQ   + (size_t)4 * 512 * 1024 * 2;
constexpr size_t WS_WO    = WS_WKV  + (size_t)4 * 1024 * 1024 * 2;
constexpr size_t WS_WGU   = WS_WO   + (size_t)4 * 1024 * 512 * 2;
constexpr size_t WS_WD    = WS_WGU  + (size_t)32 * 1024 * 1024 * 2;
constexpr size_t WS_KV    = WS_WD   + (size_t)32 * 1024 * 512 * 2;
constexpr size_t WS_MEMB  = WS_KV   + (size_t)4 * 4096 * 1024 * 2;
constexpr size_t WS_MEMSS = WS_MEMB + (size_t)4096 * 1024 * 2;
constexpr size_t WS_XB    = WS_MEMSS + (size_t)4096 * 16 * 4;
constexpr size_t WS_SS    = WS_XB   + (size_t)T * 1024 * 2;
constexpr size_t WS_VF    = WS_SS   + (size_t)T * 16 * 4;
constexpr size_t WS_EID   = WS_VF   + (size_t)T * 512 * 2;
constexpr size_t WS_EW    = WS_EID  + (size_t)T * 2 * 4;
constexpr size_t WS_ERK   = WS_EW   + (size_t)T * 2 * 4;
constexpr size_t WS_SSLOT = WS_ERK  + (size_t)T * 2 * 4;
constexpr size_t WS_SW    = WS_SSLOT + (size_t)MAXROWS * 4;
constexpr size_t WS_MTE   = WS_SW   + (size_t)MAXROWS * 4;
constexpr size_t WS_U     = WS_MTE  + 2048;
constexpr size_t WS_PROJ  = WS_U;
constexpr size_t WS_SR    = WS_PROJ + (size_t)T * 3328 * 2;
constexpr size_t WS_SK    = WS_SR   + (size_t)T * 512 * 2;
constexpr size_t WS_SV    = WS_SK   + (size_t)T * 512 * 2;
constexpr size_t WS_SA    = WS_SV   + (size_t)T * 512 * 2;
constexpr size_t WS_SB    = WS_SA   + (size_t)T * 512 * 2;
constexpr size_t WS_SG    = WS_SB   + (size_t)T * 512 * 2;
constexpr size_t WS_SWD   = WS_SG   + (size_t)T * 512 * 2;
constexpr size_t WS_YCAT  = WS_SWD  + (size_t)T * 512 * 4;
constexpr size_t WS_UEND1 = WS_YCAT + (size_t)T * 1024 * 2;
constexpr size_t WS_QX    = WS_U;
constexpr size_t WS_OX    = WS_QX   + (size_t)T * 512 * 2;
constexpr size_t WS_XS    = WS_U;
constexpr size_t WS_HB    = WS_XS   + (size_t)MAXROWS * 1024 * 2;
constexpr size_t WS_Y     = WS_HB   + (size_t)MAXROWS * 512 * 2;
constexpr size_t WS_UEND2 = WS_Y    + (size_t)2 * T * 1024 * 2;
constexpr size_t WS_END   = WS_UEND1 > WS_UEND2 ? WS_UEND1 : WS_UEND2;

constexpr int CW_BAR = 0;
constexpr int CW_CNT = 4096;
constexpr int CW_QUEUE = 4096 + 256;

constexpr int LDS_MISC = 131072;
constexpr int LDS_BYTES = 131072 + 16384;

struct Args { const float* in[38]; float* out; unsigned char* ws; int ph_lo, ph_hi; };
struct PA { float* out; unsigned char* ws; };

__device__ __forceinline__ float bf2f(bf16_t b) { return __uint_as_float(((unsigned)b) << 16); }
__device__ __forceinline__ bf16_t f2bf(float f) { unsigned u = __float_as_uint(f); u += 0x7FFFu + ((u >> 16) & 1u); return (bf16_t)(u >> 16); }
__device__ __forceinline__ unsigned pk2(float lo, float hi) { unsigned r; asm volatile("v_cvt_pk_bf16_f32 %0, %1, %2" : "=v"(r) : "v"(lo), "v"(hi)); return r; }
__device__ __forceinline__ float lo16(unsigned u) { return __uint_as_float(u << 16); }
__device__ __forceinline__ float hi16(unsigned u) { return __uint_as_float(u & 0xffff0000u); }
__device__ __forceinline__ float wsum(float v) {
#pragma unroll
    for (int o = 32; o; o >>= 1) v += __shfl_xor(v, o);
    return v;
}
__device__ __forceinline__ float sigmoidf_(float x) { return 1.0f / (1.0f + __expf(-x)); }

#define XB_TMO      128
#define XB_XCNT(j)  (256  + 64 * (j))
#define XB_XSUB(j)  (1280 + 64 * (j))
#define XB_XGEN(j)  (2304 + 64 * (j))
#define XB_TOP      3328
#define XB_TOPGEN   3392
#define XCD_BAR_WORDS 3456
#define XB_SPIN_CAP (1u << 22)

__device__ __forceinline__ unsigned xb_ld(unsigned* p)              { return __hip_atomic_load(p, __ATOMIC_RELAXED, __HIP_MEMORY_SCOPE_AGENT); }
__device__ __forceinline__ unsigned xb_add(unsigned* p, unsigned v) { return __hip_atomic_fetch_add(p, v, __ATOMIC_RELAXED, __HIP_MEMORY_SCOPE_AGENT); }
__device__ __forceinline__ unsigned xb_xcc_id() { return (unsigned)__builtin_amdgcn_s_getreg((3 << 11) | 20) & 0xFu; }
#define XB_SPIN(cond, bar) do { unsigned _sp = 0; while (cond) { __builtin_amdgcn_s_sleep(1); \
    if ((++_sp & 255u) == 0u) { if (xb_ld(&(bar)[XB_TMO])) break; if (_sp > XB_SPIN_CAP) { atomicAdd(&(bar)[XB_TMO], 1u); break; } } } } while (0)

struct XcdBarrier { unsigned* bar; unsigned x; volatile LAS unsigned* st; };

__device__ __forceinline__ XcdBarrier xcd_barrier_post(unsigned* bar, volatile LAS unsigned* st) {
    XcdBarrier b; b.bar = bar; b.x = xb_xcc_id(); b.st = st;
    if (threadIdx.x == 0) (void)xb_add(&bar[XB_XCNT(b.x)], 1u);
    return b;
}
__device__ __forceinline__ void xcd_barrier_complete(unsigned* bar, unsigned x, unsigned& nloc, unsigned& nx) {
    const unsigned G = gridDim.x * gridDim.y * gridDim.z;
    unsigned sum, cnt, mine, sp = 0u;
    for (;;) {
        sum = 0u; cnt = 0u; mine = 0u;
#pragma unroll
        for (unsigned j = 0; j < 16; ++j) { const unsigned c = xb_ld(&bar[XB_XCNT(j)]); sum += c; cnt += (c > 0u) ? 1u : 0u; mine = (j == x) ? c : mine; }
        if (sum == G) break;
        __builtin_amdgcn_s_sleep(1);
        if ((++sp & 255u) == 0u) { if (xb_ld(&bar[XB_TMO])) break; if (sp > XB_SPIN_CAP) { atomicAdd(&bar[XB_TMO], 1u); break; } }
    }
    nloc = mine > 0u ? mine : 1u; nx = cnt > 0u ? cnt : 1u;
}
__device__ __forceinline__ void xcd_barrier(const XcdBarrier& b) {
    asm volatile("s_waitcnt vmcnt(0)" ::: "memory");
    __syncthreads();
    if (threadIdx.x == 0) {
        unsigned* bar = b.bar;
        __builtin_amdgcn_s_waitcnt(0);
        unsigned nloc = b.st[0], nx = b.st[1];
        if (nloc == 0u) { xcd_barrier_complete(bar, b.x, nloc, nx); b.st[0] = nloc; b.st[1] = nx; }
        const unsigned old = xb_add(&bar[XB_XSUB(b.x)], 1u);
        const unsigned gen = old / nloc;
        if (old + 1u == (gen + 1u) * nloc) {
            __builtin_amdgcn_fence(__ATOMIC_RELEASE, "agent");
            asm volatile("s_waitcnt vmcnt(0)" ::: "memory");
            const unsigned og = xb_add(&bar[XB_TOP], 1u);
            const unsigned tg = og / nx;
            if (og + 1u == (tg + 1u) * nx) xb_add(&bar[XB_TOPGEN], 1u);
            else XB_SPIN(xb_ld(&bar[XB_TOPGEN]) == tg, bar);
            __builtin_amdgcn_fence(__ATOMIC_ACQUIRE, "agent");
            xb_add(&bar[XB_XGEN(b.x)], 1u);
            asm volatile("s_waitcnt vmcnt(0)" ::: "memory");
        } else {
            XB_SPIN(xb_ld(&bar[XB_XGEN(b.x)]) == gen, bar);
            __builtin_amdgcn_fence(__ATOMIC_ACQUIRE, "agent");
            asm volatile("s_waitcnt vmcnt(0)" ::: "memory");
        }
    }
    __syncthreads();
}

namespace pg8 {
constexpr int BM = 256, BK = 64, HALF = 128, HTB = HALF * BK * 2, STAGE_BYTES = 8 * HTB, NXCD = 8, WGM = 8;
__host__ __device__ __forceinline__ int lds_byte(int r, int c) { const int st = (r >> 4) * 2 + (c >> 5), rr = r & 15, cc = c & 31, ob = rr * 64 + cc * 2; return st * 1024 + (ob ^ (((ob >> 9) & 1) << 5)); }
__host__ __device__ __forceinline__ void stage_rc(int b, int& R, int& C) { const int st = b / 1024, sb = b % 1024, swz = sb ^ (((sb >> 9) & 1) << 5); R = (st >> 1) * 16 + swz / 64; C = (st & 1) * 32 + (swz % 64) / 2; }
__host__ __device__ __forceinline__ int perm32(int rho) { const int n = rho >> 4, i = rho & 15; return 8 * (i >> 2) + 4 * n + (i & 3); }

struct Unit { int pm, pn, pa, z; };
struct Gemm { const bf16_t* A; const bf16_t* Bt; int K; size_t bz_stride; };

struct StaticOrder {
    int nM, nN, nwg, G, c;
    __device__ void init(int M, int N, int G_, int c_) { nM = M / BM; nN = N / BM; nwg = nM * nN; G = G_; c = c_; }
    __device__ bool next(int i, Unit& u) const {
        const long L = (long)i * G + c; if (L >= nwg) return false;
        int wgid = (int)L; { const int q = nwg / NXCD, r = nwg % NXCD, xcd = wgid % NXCD, off = wgid / NXCD; wgid = (xcd < r ? xcd * (q + 1) : r * (q + 1) + (xcd - r) * q) + off; }
        const int nig = WGM * nN, gid = wgid / nig, fm = gid * WGM, gsz = (nM - fm) < WGM ? (nM - fm) : WGM;
        u.pm = fm + ((wgid % nig) % gsz); u.pn = (wgid % nig) / gsz; u.pa = u.pm; u.z = 0; return true;
    }
};
struct KvOrder {
    int G, c;
    __device__ bool next(int i, Unit& u) const {
        const int L = i * G + c; if (L >= 256) return false;
        u.z = L >> 6; const int r = L & 63; u.pa = r >> 2; u.pn = r & 3; u.pm = u.z * 16 + u.pa; return true;
    }
};
struct MoeOrder {
    const int* mte; int G, c;
    __device__ bool next(int i, Unit& u) const {
        const int nunits = mte[511] * 4;
        const int L = i * G + c; if (L >= nunits) return false;
        u.pm = L >> 2; u.pa = u.pm; u.pn = L & 3; u.z = mte[u.pm]; return true;
    }
};

template <class Epi, class Sched, bool ALIGN_EPI = true>
__device__ __forceinline__ void gemm_phase(LAS unsigned char* lds, const Gemm g, const Sched& S, const Epi& E) {
    int tid_ = threadIdx.x; asm volatile("" : "+v"(tid_));
    const int tid = tid_, wid = __builtin_amdgcn_readfirstlane(tid >> 6), lane = tid & 63, wr = wid >> 2, wc = wid & 3, fr = lane & 15, fq = lane >> 4;
    const int K = g.K, nt = K / BK;
    unsigned voffA[2], voffB[2];
#pragma unroll
    for (int i = 0; i < 2; ++i) { int R, C; stage_rc(tid * 16 + i * 8192, R, C); const int Rb = ((R & ~31) + perm32(R & 31));
        voffA[i] = (unsigned)(R * K + C) * 2u; voffB[i] = (unsigned)(Rb * K + C) * 2u; }
    const size_t kstep = (size_t)(BK * 2);
    const size_t hstep = (size_t)HALF * K * 2;
    const size_t tstep = 2 * hstep;
    const unsigned ldsw = (unsigned)wid * 1024u;
    const int aoff = lds_byte(wr * 64 + fr, fq * 8), boff = lds_byte(wc * 32 + fr, fq * 8);
#define PG8_SA(b, h) (((b) * 2 + (h)) * HTB)
#define PG8_SB(b, h) ((4 + (b) * 2 + (h)) * HTB)
#define PG8_STAGE(bufoff, gbase, voff) do { _Pragma("unroll") for (int _i = 0; _i < 2; ++_i) \
        __builtin_amdgcn_global_load_lds((const unsigned*)((const char*)(gbase) + (voff)[_i]), (LAS unsigned*)(lds + (bufoff) + ldsw + _i * 8192), 16, 0, 0); } while (0)
#define PG8_LDA(dst, b, h) do { _Pragma("unroll") for (int m = 0; m < 4; ++m) _Pragma("unroll") for (int k = 0; k < 2; ++k) dst[m][k] = *(const LAS bf16x8*)(lds + PG8_SA(b, h) + aoff + m * 2048 + k * 1024); } while (0)
#define PG8_LDB(dst, b, h) do { _Pragma("unroll") for (int n = 0; n < 2; ++n) _Pragma("unroll") for (int k = 0; k < 2; ++k) dst[n][k] = *(const LAS bf16x8*)(lds + PG8_SB(b, h) + boff + n * 2048 + k * 1024); } while (0)
#define PG8_MMA(ai, bj, At, Bt) do { __builtin_amdgcn_s_setprio(1); _Pragma("unroll") for (int m = 0; m < 4; ++m) _Pragma("unroll") for (int n = 0; n < 2; ++n) _Pragma("unroll") for (int k = 0; k < 2; ++k) \
        acc[ai][bj][m][n] = __builtin_amdgcn_mfma_f32_16x16x32_bf16(Bt[n][k], At[m][k], acc[ai][bj][m][n], 0, 0, 0); __builtin_amdgcn_s_setprio(0); } while (0)
#define PG8_WAIT_V(n) asm volatile("s_waitcnt vmcnt(" #n ")" ::: "memory")
#define PG8_WAIT_L(n) asm volatile("s_waitcnt lgkmcnt(" #n ")" ::: "memory")
#define PG8_BAR __builtin_amdgcn_s_barrier()
#define PG8_SCHED __builtin_amdgcn_sched_barrier(0)
#define PG8_APTR(u) ((const char*)g.A + (size_t)(u).pa * tstep)
#define PG8_BPTR(u) ((const char*)g.Bt + ((size_t)(u).z * g.bz_stride) * 2 + (size_t)(u).pn * tstep)
    Unit cur, nxt; int ui = 0;
    if (!S.next(0, cur)) return;
    f32x4 acc[2][2][4][2];
#pragma unroll
    for (int a = 0; a < 2; ++a)
#pragma unroll
        for (int b = 0; b < 2; ++b)
#pragma unroll
            for (int m = 0; m < 4; ++m)
#pragma unroll
                for (int n = 0; n < 2; ++n) acc[a][b][m][n] = (f32x4){0.f, 0.f, 0.f, 0.f};
    bf16x8 At[4][2], B0[2][2], B1[2][2];
    const char* cA = PG8_APTR(cur); const char* cB = PG8_BPTR(cur);
    PG8_STAGE(PG8_SB(0, 0), cB, voffB); PG8_STAGE(PG8_SB(0, 1), cB + hstep, voffB); PG8_STAGE(PG8_SA(0, 0), cA, voffA); PG8_STAGE(PG8_SA(0, 1), cA + hstep, voffA);
    if (wr == 1) PG8_BAR;
    PG8_WAIT_V(2); PG8_BAR;
    PG8_STAGE(PG8_SB(1, 0), cB + kstep, voffB); PG8_STAGE(PG8_SA(1, 0), cA + kstep, voffA); PG8_STAGE(PG8_SB(1, 1), cB + hstep + kstep, voffB);
    PG8_WAIT_V(6); PG8_BAR;
    for (;;) {
        const bool has_next = S.next(ui + 1, nxt);
        const char* nA = has_next ? PG8_APTR(nxt) : cA; const char* nB = has_next ? PG8_BPTR(nxt) : cB;
        for (int t = 0; t < nt; t += 2) {
            const bool last = (t == nt - 2);
            const char* a1 = cA + (size_t)(t + 1) * kstep;
            const char* a2 = last ? nA : cA + (size_t)(t + 2) * kstep; const char* b2 = last ? nB : cB + (size_t)(t + 2) * kstep;
            const char* a3 = a2 + kstep; const char* b3 = b2 + kstep;
            PG8_LDB(B0, 0, 0); PG8_LDB(B1, 0, 1); PG8_SCHED; PG8_LDA(At, 0, 0); PG8_STAGE(PG8_SA(1, 1), a1 + hstep, voffA);
            PG8_WAIT_V(8); PG8_WAIT_L(0); PG8_BAR; PG8_MMA(0, 0, At, B0); PG8_MMA(0, 1, At, B1); PG8_BAR; PG8_SCHED;
            PG8_LDA(At, 0, 1); PG8_STAGE(PG8_SB(0, 0), b2, voffB); PG8_STAGE(PG8_SB(0, 1), b2 + hstep, voffB); PG8_STAGE(PG8_SA(0, 0), a2, voffA);
            PG8_WAIT_V(8); PG8_WAIT_L(0); PG8_BAR; PG8_MMA(1, 0, At, B0); PG8_MMA(1, 1, At, B1); PG8_BAR; PG8_SCHED;
            PG8_LDB(B0, 1, 0); PG8_LDB(B1, 1, 1); PG8_SCHED; PG8_LDA(At, 1, 0); PG8_STAGE(PG8_SA(0, 1), a2 + hstep, voffA);
            PG8_WAIT_V(8); PG8_WAIT_L(0); PG8_BAR; PG8_MMA(0, 0, At, B0); PG8_MMA(0, 1, At, B1); PG8_BAR; PG8_SCHED;
            PG8_LDA(At, 1, 1); PG8_STAGE(PG8_SB(1, 0), b3, voffB); PG8_STAGE(PG8_SB(1, 1), b3 + hstep, voffB); PG8_STAGE(PG8_SA(1, 0), a3, voffA);
            PG8_WAIT_V(8); PG8_WAIT_L(0); PG8_BAR; PG8_MMA(1, 0, At, B0); PG8_MMA(1, 1, At, B1); PG8_BAR; PG8_SCHED;
        }
        if constexpr (ALIGN_EPI) { if (wr == 0) PG8_BAR; }
        E(acc, cur, wr, wc, fr, fq);
        if (!has_next) break;
#pragma unroll
        for (int a = 0; a < 2; ++a)
#pragma unroll
            for (int b = 0; b < 2; ++b)
#pragma unroll
                for (int m = 0; m < 4; ++m)
#pragma unroll
                    for (int n = 0; n < 2; ++n) acc[a][b][m][n] = (f32x4){0.f, 0.f, 0.f, 0.f};
        cur = nxt; cA = nA; cB = nB; ++ui;
        if constexpr (ALIGN_EPI) { if (wr == 1) PG8_BAR; }
    }
    PG8_WAIT_V(0);
    if constexpr (!ALIGN_EPI) { if (wr == 0) PG8_BAR; }
    PG8_BAR;
#undef PG8_SA
#undef PG8_SB
#undef PG8_STAGE
#undef PG8_LDA
#undef PG8_LDB
#undef PG8_MMA
#undef PG8_WAIT_V
#undef PG8_WAIT_L
#undef PG8_BAR
#undef PG8_SCHED
#undef PG8_APTR
#undef PG8_BPTR
}

typedef const f32x4 (&AccRef)[2][2][4][2];

struct EpiScale {
    bf16_t* O; int ldc; const float* ss; int ssmask;
    __device__ __forceinline__ void operator()(AccRef acc, const Unit& u, int wr, int wc, int fr, int fq) const {
#pragma unroll
        for (int ai = 0; ai < 2; ++ai)
#pragma unroll
            for (int m = 0; m < 4; ++m) {
                const int row = u.pm * 256 + ai * 128 + wr * 64 + m * 16 + fr;
                const f32x4* sp = (const f32x4*)(ss + (size_t)(row & ssmask) * 16);
                const f32x4 s0 = sp[0], s1 = sp[1], s2 = sp[2], s3 = sp[3];
                const float tot = ((s0[0] + s0[1]) + (s0[2] + s0[3])) + ((s1[0] + s1[1]) + (s1[2] + s1[3])) + ((s2[0] + s2[1]) + (s2[2] + s2[3])) + ((s3[0] + s3[1]) + (s3[2] + s3[3]));
                const float rinv = rsqrtf(tot * (1.0f / 1024.0f) + 1e-6f);
#pragma unroll
                for (int bj = 0; bj < 2; ++bj) {
                    const int col = u.pn * 256 + bj * 128 + wc * 32 + 8 * fq;
                    const f32x4 v0 = acc[ai][bj][m][0] * rinv, v1 = acc[ai][bj][m][1] * rinv;
                    u32x4 w; w.x = pk2(v0[0], v0[1]); w.y = pk2(v0[2], v0[3]); w.z = pk2(v1[0], v1[1]); w.w = pk2(v1[2], v1[3]);
                    *(u32x4*)(O + (size_t)row * ldc + col) = w;
                }
            }
    }
};
struct EpiRes {
    float* X; bf16_t* XB; float* SS;
    __device__ __forceinline__ void operator()(AccRef acc, const Unit& u, int wr, int wc, int fr, int fq) const {
#pragma unroll
        for (int ai = 0; ai < 2; ++ai)
#pragma unroll
            for (int m = 0; m < 4; ++m) {
                const int row = u.pm * 256 + ai * 128 + wr * 64 + m * 16 + fr;
                float sq = 0.f;
#pragma unroll
                for (int bj = 0; bj < 2; ++bj) {
                    const int col = u.pn * 256 + bj * 128 + wc * 32 + 8 * fq;
                    float* xp = X + (size_t)row * 1024 + col;
                    f32x4 x0 = *(const f32x4*)xp, x1 = *(const f32x4*)(xp + 4);
                    x0 += acc[ai][bj][m][0]; x1 += acc[ai][bj][m][1];
                    *(f32x4*)xp = x0; *(f32x4*)(xp + 4) = x1;
                    u32x4 w; w.x = pk2(x0[0], x0[1]); w.y = pk2(x0[2], x0[3]); w.z = pk2(x1[0], x1[1]); w.w = pk2(x1[2], x1[3]);
                    *(u32x4*)(XB + (size_t)row * 1024 + col) = w;
                    sq += (x0[0] * x0[0] + x0[1] * x0[1]) + (x0[2] * x0[2] + x0[3] * x0[3]) + (x1[0] * x1[0] + x1[1] * x1[1]) + (x1[2] * x1[2] + x1[3] * x1[3]);
                }
                sq += __shfl_xor(sq, 16); sq += __shfl_xor(sq, 32);
                if (fq == 0) SS[(size_t)row * 16 + u.pn * 4 + wc] = sq;
            }
    }
};
struct EpiGU {
    bf16_t* H;
    __device__ __forceinline__ void operator()(AccRef acc, const Unit& u, int wr, int wc, int fr, int fq) const {
#pragma unroll
        for (int ai = 0; ai < 2; ++ai)
#pragma unroll
            for (int m = 0; m < 4; ++m) {
                const int row = u.pm * 256 + ai * 128 + wr * 64 + m * 16 + fr;
                float h[8];
#pragma unroll
                for (int n = 0; n < 2; ++n)
#pragma unroll
                    for (int j = 0; j < 4; ++j) { const float gt = acc[ai][0][m][n][j], up = acc[ai][1][m][n][j]; h[n * 4 + j] = gt * __builtin_amdgcn_rcpf(1.0f + __expf(-gt)) * up; }
                u32x4 w; w.x = pk2(h[0], h[1]); w.y = pk2(h[2], h[3]); w.z = pk2(h[4], h[5]); w.w = pk2(h[6], h[7]);
                *(u32x4*)(H + (size_t)row * 512 + u.pn * 128 + wc * 32 + 8 * fq) = w;
            }
    }
};
struct EpiDown {
    bf16_t* Y; const int* slot; const float* sw;
    __device__ __forceinline__ void operator()(AccRef acc, const Unit& u, int wr, int wc, int fr, int fq) const {
#pragma unroll
        for (int ai = 0; ai < 2; ++ai)
#pragma unroll
            for (int m = 0; m < 4; ++m) {
                const int row = u.pm * 256 + ai * 128 + wr * 64 + m * 16 + fr;
                const int s = slot[row]; const float wgt = sw[row];
                if (s >= 0) {
#pragma unroll
                    for (int bj = 0; bj < 2; ++bj) {
                        const int col = u.pn * 256 + bj * 128 + wc * 32 + 8 * fq;
                        const f32x4 v0 = acc[ai][bj][m][0] * wgt, v1 = acc[ai][bj][m][1] * wgt;
                        u32x4 w; w.x = pk2(v0[0], v0[1]); w.y = pk2(v0[2], v0[3]); w.z = pk2(v1[0], v1[1]); w.w = pk2(v1[2], v1[3]);
                        *(u32x4*)(Y + (size_t)s * 1024 + col) = w;
                    }
                }
            }
    }
};
}

#define WSP(type, off) ((type*)(a.ws + (off)))
__device__ __forceinline__ int oblk() { int t = blockIdx.x; asm volatile("" : "+s"(t)); return t; }
__device__ __forceinline__ int ogrid() { int t = gridDim.x; asm volatile("" : "+s"(t)); return t; }
__device__ __forceinline__ int otid() { int t = threadIdx.x; asm volatile("" : "+v"(t)); return t; }
constexpr int LDS_INTAB = LDS_MISC + 14336;
__device__ __forceinline__ const float* ldsin(LAS unsigned char* lds, int i) {
    const unsigned long long p = ((const LAS unsigned long long*)(lds + LDS_INTAB))[i];
    const unsigned lo = __builtin_amdgcn_readfirstlane((unsigned)p), hi = __builtin_amdgcn_readfirstlane((unsigned)(p >> 32));
    return (const float*)(((unsigned long long)hi << 32) | lo);
}
#define INP(i) ldsin(lds, (i))

template <int MAP>
__device__ __forceinline__ void conv_T(const float* __restrict__ src, int Ktot, int N, int Kper, bf16_t* __restrict__ dst, size_t estride,
                                       const float* __restrict__ gain, int goff, LAS float* tile) {
    const int tid = otid();
    const int ntn = N >> 6, ntiles = (Ktot >> 6) * ntn;
    for (int ti = oblk(); ti < ntiles; ti += ogrid()) {
        const int kt = ti / ntn, ntc = ti - kt * ntn, k0 = kt * 64, n0 = ntc * 64;
        const int e = k0 / Kper, kl0 = k0 - e * Kper;
#pragma unroll
        for (int i = 0; i < 2; ++i) {
            const int idx = tid + i * 512, kk = idx >> 4, n4 = (idx & 15) * 4;
            const f32x4 v = *(const f32x4*)(src + (size_t)(k0 + kk) * N + n0 + n4);
            float gsc = 1.0f;
            if (gain != nullptr && kl0 + kk >= goff) gsc = gain[kl0 + kk - goff];
            tile[kk * 65 + n4 + 0] = v[0] * gsc; tile[kk * 65 + n4 + 1] = v[1] * gsc; tile[kk * 65 + n4 + 2] = v[2] * gsc; tile[kk * 65 + n4 + 3] = v[3] * gsc;
        }
        __syncthreads();
        {
            const int nn = tid >> 3, kg = tid & 7;
            float v[8];
#pragma unroll
            for (int j = 0; j < 8; ++j) v[j] = tile[(kg * 8 + j) * 65 + nn];
            const int n = n0 + nn;
            const int nr = (MAP == 0) ? n : ((n >> 7) * 256 + (n & 127) + (MAP == 2 ? 128 : 0));
            u32x4 w; w.x = pk2(v[0], v[1]); w.y = pk2(v[2], v[3]); w.z = pk2(v[4], v[5]); w.w = pk2(v[6], v[7]);
            *(u32x4*)(dst + (size_t)e * estride + (size_t)nr * Kper + kl0 + kg * 8) = w;
        }
        __syncthreads();
    }
}

__device__ __forceinline__ void moe_convert(const PA a, int l, LAS unsigned char* lds) {
    LAS float* tile = (LAS float*)lds;
    conv_T<1>(INP(35) + (size_t)l * 32 * 1024 * 512, 32 * 1024, 512, 1024, WSP(bf16_t, WS_WGU), (size_t)1024 * 1024, INP(30) + l * 1024, 0, tile);
    conv_T<2>(INP(36) + (size_t)l * 32 * 1024 * 512, 32 * 1024, 512, 1024, WSP(bf16_t, WS_WGU), (size_t)1024 * 1024, INP(30) + l * 1024, 0, tile);
    conv_T<0>(INP(37) + (size_t)l * 32 * 512 * 1024, 32 * 512, 1024, 512, WSP(bf16_t, WS_WD), (size_t)1024 * 512, nullptr, 0, tile);
}

__device__ __forceinline__ void rows_convert(const float* __restrict__ src, float* __restrict__ dstf, bf16_t* __restrict__ dstb, float* __restrict__ ss, int nrows) {
    const int wave = otid() >> 6, lane = otid() & 63;
    for (int r = oblk() * 8 + wave; r < nrows; r += ogrid() * 8) {
        float sq = 0.f;
#pragma unroll
        for (int i = 0; i < 4; ++i) {
            const int c = i * 256 + lane * 4;
            const f32x4 v = *(const f32x4*)(src + (size_t)r * 1024 + c);
            if (dstf) *(f32x4*)(dstf + (size_t)r * 1024 + c) = v;
            u32x2 w; w.x = pk2(v[0], v[1]); w.y = pk2(v[2], v[3]);
            *(u32x2*)(dstb + (size_t)r * 1024 + c) = w;
            sq += (v[0] * v[0] + v[1] * v[1]) + (v[2] * v[2] + v[3] * v[3]);
        }
        sq = wsum(sq);
        if (lane < 16) ss[(size_t)r * 16 + lane] = (lane == 0) ? sq : 0.f;
    }
}

__device__ __forceinline__ void p0_prologue(const PA a, LAS unsigned char* lds) {
    LAS float* tile = (LAS float*)lds;
    for (int l = 0; l < NL; ++l) {
        conv_T<0>(INP(3) + (size_t)l * 1024 * INW, 1024, INW, 1024, WSP(bf16_t, WS_WIN) + (size_t)l * INW * 1024, 0, INP(2) + l * 1024, 0, tile);
        conv_T<0>(INP(22) + (size_t)l * 1024 * 1024, 1024, 1024, 1024, WSP(bf16_t, WS_WOUT) + (size_t)l * 1024 * 1024, 0, INP(21) + l * 512, 512, tile);
        conv_T<0>(INP(25) + (size_t)l * 1024 * 512, 1024, 512, 1024, WSP(bf16_t, WS_WQ) + (size_t)l * 512 * 1024, 0, INP(23) + l * 1024, 0, tile);
        conv_T<0>(INP(26) + (size_t)l * 1024 * 1024, 1024, 1024, 1024, WSP(bf16_t, WS_WKV) + (size_t)l * 1024 * 1024, 0, INP(24) + l * 1024, 0, tile);
        conv_T<0>(INP(27) + (size_t)l * 512 * 1024, 512, 1024, 512, WSP(bf16_t, WS_WO) + (size_t)l * 1024 * 512, 0, nullptr, 0, tile);
    }
    moe_convert(a, 0, lds);
    rows_convert(INP(0), a.out, WSP(bf16_t, WS_XB), WSP(float, WS_SS), T);
    rows_convert(INP(1), nullptr, WSP(bf16_t, WS_MEMB), WSP(float, WS_MEMSS), MROWS);
}

__device__ __forceinline__ void p2_knorm(const PA a, LAS unsigned char* lds) {
    const int wave = otid() >> 6, lane = otid() & 63;
    bf16_t* kv = WSP(bf16_t, WS_KV);
    for (int it = oblk() * 8 + wave; it < NL * MROWS * 4; it += ogrid() * 8) {
        const int h = it & 3, row = (it >> 2) & (MROWS - 1), l = it >> 14;
        unsigned* p = (unsigned*)(kv + ((size_t)l * MROWS + row) * 1024 + h * 128 + lane * 2);
        const unsigned w = *p; const float x0 = lo16(w), x1 = hi16(w);
        const float ssq = wsum(x0 * x0 + x1 * x1);
        const float rinv = rsqrtf(ssq * (1.0f / 128.0f) + 1e-6f);
        const float* gk = INP(29) + l * 128 + lane * 2;
        *p = pk2(x0 * rinv * gk[0], x1 * rinv * gk[1]);
    }
}

__device__ __forceinline__ void pb_prep(const PA a, int l, LAS unsigned char* lds) {
    LAS float* s_wl = (LAS float*)lds;
    LAS float* s_al = s_wl + 64;
    LAS float* s_gl = s_al + 64;
    LAS float* s_xv = s_gl + 128;
    LAS float* s_part = s_xv + 512;
    LAS float* s_t32 = s_part + 512;
    const int c = otid();
    bf16_t* proj = WSP(bf16_t, WS_PROJ);
    const float* mu = INP(4) + l * 1792;
    const float* w0 = INP(5) + l * 512;  const float* w2 = INP(6) + (size_t)l * 64 * 512;
    const float* a0 = INP(7) + l * 512;  const float* a2 = INP(8) + (size_t)l * 64 * 512;
    const float* g2 = INP(9) + (size_t)l * 128 * 512;
    const float* kkw = INP(10) + l * 512; const float* kaw = INP(11) + l * 512;
    const int lv = l > 0 ? l - 1 : 0;
    const float* v0 = INP(15) + lv * 512; const float* v1 = INP(16) + (size_t)lv * 512 * 32; const float* v2 = INP(17) + (size_t)lv * 32 * 512;
    const float qg = INP(18)[l * 64 + (c & 63)], kg_ = INP(19)[l * 64 + (c & 63)];
    bf16_t* SR = WSP(bf16_t, WS_SR); bf16_t* SK = WSP(bf16_t, WS_SK); bf16_t* SV = WSP(bf16_t, WS_SV);
    bf16_t* SA = WSP(bf16_t, WS_SA); bf16_t* SB = WSP(bf16_t, WS_SB); bf16_t* SG = WSP(bf16_t, WS_SG);
    float* SWD = WSP(float, WS_SWD); bf16_t* VF = WSP(bf16_t, WS_VF);
    const float mur = mu[c], muk = mu[512 + c], muv = mu[1024 + c];
    const float mux = c < 256 ? mu[1536 + c] : 0.f;
    for (int t = oblk(); t < T; t += ogrid()) {
        const bool hp = (t & (SEQ - 1)) != 0;
        const bf16_t* pu = proj + (size_t)t * INW;
        const bf16_t* pp = hp ? pu - INW : pu;
        const float hpf = hp ? 1.0f : 0.0f;
        float u, p;
        u = bf2f(pu[c]); p = bf2f(pp[c]) * hpf; const float xr = u + mur * (p - u);
        u = bf2f(pu[512 + c]); p = bf2f(pp[512 + c]) * hpf; const float xk = u + muk * (p - u);
        u = bf2f(pu[1024 + c]); p = bf2f(pp[1024 + c]) * hpf; float xv = u + muv * (p - u);
        if (c < 256) {
            u = bf2f(pu[1536 + c]); p = bf2f(pp[1536 + c]) * hpf; const float xx = u + mux * (p - u);
            if (c < 64) s_wl[c] = tanhf(xx);
            else if (c < 128) s_al[c - 64] = xx;
            else s_gl[c - 128] = sigmoidf_(xx);
        }
        s_xv[c] = xv;
        __syncthreads();
        float w = w0[c], av = a0[c], g = 0.f;
#pragma unroll 8
        for (int j = 0; j < 64; ++j) { w += s_wl[j] * w2[j * 512 + c]; av += s_al[j] * a2[j * 512 + c]; }
#pragma unroll 8
        for (int j = 0; j < 128; ++j) g += s_gl[j] * g2[j * 512 + c];
        av = sigmoidf_(av);
        if (l > 0) {
            { const int j = c & 31, kp = c >> 5; float s = 0.f;
#pragma unroll 8
              for (int k = 0; k < 32; ++k) s += s_xv[kp * 32 + k] * v1[(kp * 32 + k) * 32 + j];
              s_part[kp * 32 + j] = s; }
            __syncthreads();
            if (c < 32) { float s = 0.f;
#pragma unroll
              for (int kp = 0; kp < 16; ++kp) s += s_part[kp * 32 + c];
              s_t32[c] = s; }
            __syncthreads();
            float z = v0[c];
#pragma unroll 8
            for (int j = 0; j < 32; ++j) z += s_t32[j] * v2[j * 512 + c];
            const float vf = bf2f(VF[(size_t)t * 512 + c]);
            xv = xv + (vf - xv) * sigmoidf_(z);
        } else {
            VF[(size_t)t * 512 + c] = f2bf(xv);
        }
        const float nw = -w;
        const float sp = nw > 20.f ? nw : log1pf(__expf(nw));
        const float wl_ = -sp - 0.5f;
        const float decay = __expf(-__expf(wl_));
        float kk = xk * kkw[c];
        const float kss = wsum(kk * kk);
        kk = kk * rsqrtf(fmaxf(kss, 1e-24f));
        const float kmod = xk * (1.0f + (av - 1.0f) * kaw[c]);
        const size_t o = (size_t)t * 512 + c;
        SR[o] = f2bf(xr); SK[o] = f2bf(kmod); SV[o] = f2bf(xv); SA[o] = f2bf(-kk); SB[o] = f2bf(kk * av); SG[o] = f2bf(g); SWD[o] = decay;
        {
            bf16_t* pq = proj + (size_t)t * INW + 1792 + c;
            float q = bf2f(*pq); float ssq = wsum(q * q);
            *pq = f2bf(q * rsqrtf(ssq * (1.0f / 64.0f) + 1e-6f) * qg);
            bf16_t* pk = proj + (size_t)t * INW + 2304 + c;
            float k = bf2f(*pk); ssq = wsum(k * k);
            *pk = f2bf(k * rsqrtf(ssq * (1.0f / 64.0f) + 1e-6f) * kg_);
        }
        __syncthreads();
    }
}

__device__ __forceinline__ void scan_item(const PA a, int l, int bh, LAS unsigned char* lds) {
    const int tid = otid(), wave = tid >> 6, lane = tid & 63;
    const int b = bh >> 3, h = bh & 7;
    const int row = wave * 8 + (lane >> 3), kg = lane & 7;
    LAS float* ybuf = (LAS float*)(lds + 98304);
    const bf16_t* SR = WSP(bf16_t, WS_SR); const bf16_t* SK = WSP(bf16_t, WS_SK); const bf16_t* SV = WSP(bf16_t, WS_SV);
    const bf16_t* SA = WSP(bf16_t, WS_SA); const bf16_t* SB = WSP(bf16_t, WS_SB); const bf16_t* SG = WSP(bf16_t, WS_SG);
    const float* SWD = WSP(float, WS_SWD);
    bf16_t* YC = WSP(bf16_t, WS_YCAT);
    const size_t tok0 = (size_t)b * SEQ;
    const float lw = INP(13)[l * 512 + h * 64 + lane], lb = INP(14)[l * 512 + h * 64 + lane], rk = INP(12)[l * 512 + h * 64 + lane];
    u32x4 pre[4]; f32x4 prew;
    const int q0 = tid & 255, arrsel = tid >> 8;
    const int pstep = q0 >> 3, pc8 = (q0 & 7) * 8;
    const int wstep = tid >> 4, wc4 = (tid & 15) * 4;
#define SCAN_LOAD(cidx) do { const size_t tb = tok0 + (size_t)(cidx) * 32; \
        const size_t o = (tb + pstep) * 512 + h * 64 + pc8; \
        pre[0] = *(const u32x4*)((arrsel ? SK : SA) + o); pre[1] = *(const u32x4*)((arrsel ? SR : SB) + o); \
        if (tid < 256) pre[2] = *(const u32x4*)(SV + o); \
        prew = *(const f32x4*)(SWD + (tb + wstep) * 512 + h * 64 + wc4); } while (0)
#define SCAN_STORE(bufi) do { LAS float* bb = (LAS float*)(lds + (bufi) * 49152); \
        LAS float* d0 = bb + (arrsel ? 2 : 0) * 2048 + pstep * 64 + pc8; LAS float* d1 = bb + (arrsel ? 4 : 3) * 2048 + pstep * 64 + pc8; \
        _Pragma("unroll") for (int j = 0; j < 4; ++j) { d0[2 * j] = lo16(pre[0][j]); d0[2 * j + 1] = hi16(pre[0][j]); d1[2 * j] = lo16(pre[1][j]); d1[2 * j + 1] = hi16(pre[1][j]); } \
        if (tid < 256) { LAS float* d2 = bb + 5 * 2048 + pstep * 64 + pc8; _Pragma("unroll") for (int j = 0; j < 4; ++j) { d2[2 * j] = lo16(pre[2][j]); d2[2 * j + 1] = hi16(pre[2][j]); } } \
        *(LAS f32x4*)(bb + 1 * 2048 + wstep * 64 + wc4) = prew; } while (0)
    float S[8];
#pragma unroll
    for (int j = 0; j < 8; ++j) S[j] = 0.f;
    __syncthreads();
    SCAN_LOAD(0); SCAN_STORE(0);
    __syncthreads();
    for (int ch = 0; ch < SEQ / 32; ++ch) {
        const int cur = ch & 1;
        if (ch + 1 < SEQ / 32) SCAN_LOAD(ch + 1);
        LAS float* bb = (LAS float*)(lds + cur * 49152);
        for (int st = 0; st < 32; ++st) {
            const LAS float* pa = bb + st * 64 + kg * 8;
            const f32x4 a0 = *(const LAS f32x4*)(pa), a1 = *(const LAS f32x4*)(pa + 4);
            const f32x4 w0 = *(const LAS f32x4*)(pa + 2048), w1 = *(const LAS f32x4*)(pa + 2048 + 4);
            const f32x4 k0 = *(const LAS f32x4*)(pa + 4096), k1 = *(const LAS f32x4*)(pa + 4096 + 4);
            const f32x4 b0 = *(const LAS f32x4*)(pa + 6144), b1 = *(const LAS f32x4*)(pa + 6144 + 4);
            const f32x4 r0 = *(const LAS f32x4*)(pa + 8192), r1 = *(const LAS f32x4*)(pa + 8192 + 4);
            const float vv = bb[10240 + st * 64 + row];
            float sa = (S[0] * a0[0] + S[1] * a0[1]) + (S[2] * a0[2] + S[3] * a0[3]) + (S[4] * a1[0] + S[5] * a1[1]) + (S[6] * a1[2] + S[7] * a1[3]);
            sa += __shfl_xor(sa, 1); sa += __shfl_xor(sa, 2); sa += __shfl_xor(sa, 4);
#pragma unroll
            for (int j = 0; j < 4; ++j) {
                S[j] = S[j] * w0[j] + (sa * b0[j] + vv * k0[j]);
                S[4 + j] = S[4 + j] * w1[j] + (sa * b1[j] + vv * k1[j]);
            }
            float y = (S[0] * r0[0] + S[1] * r0[1]) + (S[2] * r0[2] + S[3] * r0[3]) + (S[4] * r1[0] + S[5] * r1[1]) + (S[6] * r1[2] + S[7] * r1[3]);
            y += __shfl_xor(y, 1); y += __shfl_xor(y, 2); y += __shfl_xor(y, 4);
            if (kg == 0) ybuf[st * 64 + row] = y;
        }
        __syncthreads();
#pragma unroll
        for (int s4 = 0; s4 < 4; ++s4) {
            const int st = wave * 4 + s4;
            const size_t t = tok0 + (size_t)ch * 32 + st;
            const float y = ybuf[st * 64 + lane];
            const float mean = wsum(y) * (1.0f / 64.0f);
            const float dlt = y - mean;
            const float var = wsum(dlt * dlt) * (1.0f / 64.0f);
            const float yn = dlt * rsqrtf(var + 64e-5f) * lw + lb;
            const float rr = bb[8192 + st * 64 + lane], kk = bb[4096 + st * 64 + lane], vv = bb[10240 + st * 64 + lane];
            const float bonus = wsum(rr * kk * rk) * vv;
            const float g = bf2f(SG[t * 512 + h * 64 + lane]);
            YC[t * 1024 + h * 64 + lane] = f2bf((yn + bonus) * g);
        }
        if (ch + 1 < SEQ / 32) SCAN_STORE(cur ^ 1);
        __syncthreads();
    }
#undef SCAN_LOAD
#undef SCAN_STORE
}

__device__ __forceinline__ void attn_item(const PA a, int l, int it, LAS unsigned char* lds) {
    const int tid = otid(), h = tid >> 6, i = tid & 63;
    const int b = it >> 5, c = it & 31;
    LAS float* sK = (LAS float*)lds;
    LAS float* sV = sK + 32 * 512;
    LAS float* s_bias = (LAS float*)(lds + LDS_MISC + 1024);
    LAS float* s_part = s_bias + 8 * 320;
    const bf16_t* proj = WSP(const bf16_t, WS_PROJ);
    const size_t t = (size_t)b * SEQ + c * 64 + i;
    float q[64], o[64];
    {
        const u32x4* qp = (const u32x4*)(proj + t * INW + 1792 + h * 64);
#pragma unroll
        for (int d8 = 0; d8 < 8; ++d8) { const u32x4 w = qp[d8];
#pragma unroll
            for (int j = 0; j < 4; ++j) { q[d8 * 8 + 2 * j] = lo16(w[j]) * 0.125f; q[d8 * 8 + 2 * j + 1] = hi16(w[j]) * 0.125f; } }
    }
#pragma unroll
    for (int d = 0; d < 64; ++d) o[d] = 0.f;
    float m = -1e30f, ls = 0.f;
    const int kc0 = c - 8 > 0 ? c - 8 : 0;
    for (int kc = kc0; kc <= c; ++kc) {
        for (int half = 0; half < 2; ++half) {
            __syncthreads();
            const size_t row0 = (size_t)b * SEQ + kc * 64 + half * 32;
#pragma unroll
            for (int i4 = 0; i4 < 4; ++i4) {
                const int p = tid + i4 * 512, r = p >> 6, c8 = (p & 63) * 8;
                const u32x4 wk = *(const u32x4*)(proj + (row0 + r) * INW + 2304 + c8);
                const u32x4 wv = *(const u32x4*)(proj + (row0 + r) * INW + 2816 + c8);
                LAS float* dk = sK + r * 512 + c8; LAS float* dv = sV + r * 512 + c8;
#pragma unroll
                for (int j = 0; j < 4; ++j) { dk[2 * j] = lo16(wk[j]); dk[2 * j + 1] = hi16(wk[j]); dv[2 * j] = lo16(wv[j]); dv[2 * j + 1] = hi16(wv[j]); }
            }
            __syncthreads();
#pragma unroll 1
            for (int j = 0; j < 32; ++j) {
                const LAS float* kp = sK + j * 512 + h * 64;
                float acc = 0.f;
#pragma unroll
                for (int d4 = 0; d4 < 16; ++d4) { const f32x4 kv = *(const LAS f32x4*)(kp + d4 * 4); acc += (q[d4 * 4] * kv[0] + q[d4 * 4 + 1] * kv[1]) + (q[d4 * 4 + 2] * kv[2] + q[d4 * 4 + 3] * kv[3]); }
                int dist = i - (half * 32 + j) + (c - kc) * 64; dist = dist > 256 ? 256 : dist;
                const float sc = acc + s_bias[h * 320 + dist + 63];
                const float mn = fmaxf(m, sc);
                const float alpha = __expf(m - mn), p = __expf(sc - mn);
                m = mn; ls = ls * alpha + p;
                const LAS float* vp = sV + j * 512 + h * 64;
#pragma unroll
                for (int d4 = 0; d4 < 16; ++d4) { const f32x4 vv = *(const LAS f32x4*)(vp + d4 * 4);
                    o[d4 * 4] = o[d4 * 4] * alpha + p * vv[0]; o[d4 * 4 + 1] = o[d4 * 4 + 1] * alpha + p * vv[1]; o[d4 * 4 + 2] = o[d4 * 4 + 2] * alpha + p * vv[2]; o[d4 * 4 + 3] = o[d4 * 4 + 3] * alpha + p * vv[3]; }
            }
        }
    }
    const float inv = 1.0f / ls;
    float ssq = 0.f;
#pragma unroll
    for (int d = 0; d < 64; ++d) { o[d] *= inv; ssq += o[d] * o[d]; }
    s_part[h * 64 + i] = ssq;
    __syncthreads();
    float tot = 0.f;
#pragma unroll
    for (int hh = 0; hh < 8; ++hh) tot += s_part[hh * 64 + i];
    const float rinv = rsqrtf(tot * (1.0f / 512.0f) + 1e-6f);
    bf16_t* yp = WSP(bf16_t, WS_YCAT) + t * 1024 + 512 + h * 64;
#pragma unroll
    for (int d8 = 0; d8 < 8; ++d8) {
        u32x4 w; w.x = pk2(o[d8 * 8] * rinv, o[d8 * 8 + 1] * rinv); w.y = pk2(o[d8 * 8 + 2] * rinv, o[d8 * 8 + 3] * rinv);
        w.z = pk2(o[d8 * 8 + 4] * rinv, o[d8 * 8 + 5] * rinv); w.w = pk2(o[d8 * 8 + 6] * rinv, o[d8 * 8 + 7] * rinv);
        *(u32x4*)(yp + d8 * 8) = w;
    }
    __syncthreads();
}

__device__ __forceinline__ void pc_mixer(const PA a, int l, LAS unsigned char* lds) {
    const int tid = otid();
    LAS float* s_bias = (LAS float*)(lds + LDS_MISC + 1024);
    volatile LAS int* s_item = (volatile LAS int*)(lds + LDS_MISC + 64);
    for (int i = tid; i < 8 * 320; i += 512) s_bias[i] = INP(20)[l * 8 * 320 + i];
    unsigned* qhead = WSP(unsigned, WS_CTL) + CW_QUEUE + l * 64;
    for (;;) {
        __syncthreads();
        if (tid == 0) *s_item = (int)__hip_atomic_fetch_add(qhead, 1u, __ATOMIC_RELAXED, __HIP_MEMORY_SCOPE_AGENT);
        __syncthreads();
        const int item = *s_item;
        if (item >= 128 + 512) break;
        if (item < 128) scan_item(a, l, item, lds);
        else attn_item(a, l, item - 128, lds);
    }
}

__device__ __forceinline__ void pe2_xattn(const PA a, int l, LAS unsigned char* lds) {
    const int tid = otid(), wave = tid >> 6, lane = tid & 63;
    const int h = wave & 3, tg = wave >> 2, tok = lane >> 1, half = lane & 1;
    const bf16_t* QX = WSP(const bf16_t, WS_QX); bf16_t* OX = WSP(bf16_t, WS_OX);
    const bf16_t* KV = WSP(const bf16_t, WS_KV) + (size_t)l * MROWS * 1024;
    const float* qgn = INP(28) + l * 128 + half * 64;
    for (int it = oblk(); it < T / 64; it += ogrid()) {
        const size_t t = (size_t)it * 64 + tg * 32 + tok;
        const int b = (int)(t >> 11);
        float q[64], o[64];
        float ssq = 0.f;
        {
            const u32x4* qp = (const u32x4*)(QX + t * 512 + h * 128 + half * 64);
#pragma unroll
            for (int d8 = 0; d8 < 8; ++d8) { const u32x4 w = qp[d8];
#pragma unroll
                for (int j = 0; j < 4; ++j) { q[d8 * 8 + 2 * j] = lo16(w[j]); q[d8 * 8 + 2 * j + 1] = hi16(w[j]); } }
#pragma unroll
            for (int d = 0; d < 64; ++d) ssq += q[d] * q[d];
            ssq += __shfl_xor(ssq, 1);
            const float rinv = rsqrtf(ssq * (1.0f / 128.0f) + 1e-6f) * 0.08838834764831845f;
#pragma unroll
            for (int d = 0; d < 64; ++d) q[d] = q[d] * rinv * qgn[d];
        }
#pragma unroll
        for (int d = 0; d < 64; ++d) o[d] = 0.f;
        float m = -1e30f, ls = 0.f;
        const bf16_t* kb = KV + (size_t)b * 256 * 1024 + h * 128 + half * 64;
#pragma unroll 1
        for (int j = 0; j < 256; ++j) {
            const u32x4* kp = (const u32x4*)(kb + (size_t)j * 1024);
            float acc = 0.f;
#pragma unroll
            for (int d8 = 0; d8 < 8; ++d8) { const u32x4 w = kp[d8];
#pragma unroll
                for (int jx = 0; jx < 4; ++jx) acc += q[d8 * 8 + 2 * jx] * lo16(w[jx]) + q[d8 * 8 + 2 * jx + 1] * hi16(w[jx]); }
            acc += __shfl_xor(acc, 1);
            const float mn = fmaxf(m, acc);
            const float alpha = __expf(m - mn), p = __expf(acc - mn);
            m = mn; ls = ls * alpha + p;
            const u32x4* vp = (const u32x4*)(kb + (size_t)j * 1024 + 512);
#pragma unroll
            for (int d8 = 0; d8 < 8; ++d8) { const u32x4 w = vp[d8];
#pragma unroll
                for (int jx = 0; jx < 4; ++jx) { o[d8 * 8 + 2 * jx] = o[d8 * 8 + 2 * jx] * alpha + p * lo16(w[jx]); o[d8 * 8 + 2 * jx + 1] = o[d8 * 8 + 2 * jx + 1] * alpha + p * hi16(w[jx]); } }
        }
        const float inv = 1.0f / ls;
        bf16_t* op = OX + t * 512 + h * 128 + half * 64;
#pragma unroll
        for (int d8 = 0; d8 < 8; ++d8) {
            u32x4 w; w.x = pk2(o[d8 * 8] * inv, o[d8 * 8 + 1] * inv); w.y = pk2(o[d8 * 8 + 2] * inv, o[d8 * 8 + 3] * inv);
            w.z = pk2(o[d8 * 8 + 4] * inv, o[d8 * 8 + 5] * inv); w.w = pk2(o[d8 * 8 + 6] * inv, o[d8 * 8 + 7] * inv);
            *(u32x4*)(op + d8 * 8) = w;
        }
    }
}

__device__ __forceinline__ void pf_router(const PA a, int l, LAS unsigned char* lds) {
    const int tid = otid(), wave = tid >> 6, lane = tid & 63;
    LAS float* s_log = (LAS float*)(lds) + wave * 64;
    const float* X = a.out; const float* SS = WSP(const float, WS_SS);
    const float* gn = INP(30) + l * 1024;
    const float* wg = INP(31) + (size_t)l * 1024 * 4; const float* bg = INP(32) + l * 4;
    const float* wr = INP(33) + (size_t)l * 1024 * 32; const float* br = INP(34) + l * 32;
    int* EID = WSP(int, WS_EID); float* EW = WSP(float, WS_EW); int* ERK = WSP(int, WS_ERK);
    unsigned* cnt = WSP(unsigned, WS_CTL) + CW_CNT + l * 32;
    for (int t = oblk() * 8 + wave; t < T; t += ogrid() * 8) {
        float tot = 0.f;
        if (lane < 16) tot = SS[(size_t)t * 16 + lane];
        tot = wsum(tot);
        const float rinv = rsqrtf(tot * (1.0f / 1024.0f) + 1e-6f);
        float acc[36];
#pragma unroll
        for (int n = 0; n < 36; ++n) acc[n] = 0.f;
#pragma unroll
        for (int i = 0; i < 4; ++i) {
            const int k0 = i * 256 + lane * 4;
            const f32x4 xv = *(const f32x4*)(X + (size_t)t * 1024 + k0);
            const f32x4 gv = *(const f32x4*)(gn + k0);
#pragma unroll
            for (int j = 0; j < 4; ++j) {
                const float hx = xv[j] * gv[j];
                const f32x4 g4 = *(const f32x4*)(wg + (size_t)(k0 + j) * 4);
                acc[0] += hx * g4[0]; acc[1] += hx * g4[1]; acc[2] += hx * g4[2]; acc[3] += hx * g4[3];
#pragma unroll
                for (int n4 = 0; n4 < 8; ++n4) { const f32x4 r4 = *(const f32x4*)(wr + (size_t)(k0 + j) * 32 + n4 * 4);
                    acc[4 + n4 * 4] += hx * r4[0]; acc[5 + n4 * 4] += hx * r4[1]; acc[6 + n4 * 4] += hx * r4[2]; acc[7 + n4 * 4] += hx * r4[3]; }
            }
        }
        float mine = 0.f;
#pragma unroll
        for (int n = 0; n < 36; ++n) { const float s = wsum(acc[n]); mine = (lane == n) ? s : mine; }
        if (lane < 36) s_log[lane] = mine * rinv + (lane < 4 ? bg[lane] : br[lane - 4]);
        __builtin_amdgcn_s_waitcnt(0);
        if (lane == 0) {
            float g0 = s_log[0]; int gt = 0;
            for (int i = 1; i < 4; ++i) { const float v = s_log[i]; if (v > g0) { g0 = v; gt = i; } }
            float gs = 0.f; for (int i = 0; i < 4; ++i) gs += __expf(s_log[i] - g0);
            const float ggate = 1.0f / gs;
            float l1 = -1e30f, l2 = -1e30f; int j1 = 0, j2 = 0;
            for (int i = 0; i < 8; ++i) { const float v = s_log[4 + gt * 8 + i];
                if (v > l1) { l2 = l1; j2 = j1; l1 = v; j1 = i; } else if (v > l2) { l2 = v; j2 = i; } }
            const float e2 = __expf(l2 - l1);
            const float p1 = 1.0f / (1.0f + e2), p2 = e2 / (1.0f + e2);
            const int e1i = gt * 8 + j1, e2i = gt * 8 + j2;
            const unsigned r1 = __hip_atomic_fetch_add(cnt + e1i, 1u, __ATOMIC_RELAXED, __HIP_MEMORY_SCOPE_AGENT);
            const unsigned r2 = __hip_atomic_fetch_add(cnt + e2i, 1u, __ATOMIC_RELAXED, __HIP_MEMORY_SCOPE_AGENT);
            EID[t * 2] = e1i; EID[t * 2 + 1] = e2i; EW[t * 2] = ggate * p1; EW[t * 2 + 1] = ggate * p2; ERK[t * 2] = (int)r1; ERK[t * 2 + 1] = (int)r2;
        }
    }
}

__device__ __forceinline__ void pg_gather(const PA a, int l, LAS unsigned char* lds) {
    const int tid = otid(), wave = tid >> 6, lane = tid & 63;
    LAS int* s_ps = (LAS int*)lds;
    const unsigned* cnt = WSP(const unsigned, WS_CTL) + CW_CNT + l * 32;
    int* SSLOT = WSP(int, WS_SSLOT); float* SW = WSP(float, WS_SW); int* MTE = WSP(int, WS_MTE);
    bf16_t* XS = WSP(bf16_t, WS_XS); const bf16_t* XB = WSP(const bf16_t, WS_XB);
    const float* SS = WSP(const float, WS_SS);
    const int* EID = WSP(const int, WS_EID); const float* EW = WSP(const float, WS_EW); const int* ERK = WSP(const int, WS_ERK);
    __syncthreads();
    if (tid == 0) {
        int acc = 0;
        for (int e = 0; e < 32; ++e) { s_ps[e] = acc; const int c = (int)__hip_atomic_load(cnt + e, __ATOMIC_RELAXED, __HIP_MEMORY_SCOPE_AGENT); acc += ((c + 255) >> 8) << 8; }
        s_ps[32] = acc;
    }
    __syncthreads();
    if (oblk() == 0) {
        if (tid < 32) { const int m0 = s_ps[tid] >> 8, m1 = s_ps[tid + 1] >> 8; for (int mt = m0; mt < m1; ++mt) MTE[mt] = tid; }
        if (tid == 0) MTE[511] = s_ps[32] >> 8;
    }
    for (int e = oblk(); e < 32; e += ogrid()) {
        const int c = (int)__hip_atomic_load(cnt + e, __ATOMIC_RELAXED, __HIP_MEMORY_SCOPE_AGENT);
        const int r0 = s_ps[e] + c, r1 = s_ps[e + 1];
        for (int r = r0 + wave; r < r1; r += 8) {
            if (lane == 0) { SSLOT[r] = -1; SW[r] = 0.f; }
            u32x4 z = {0u, 0u, 0u, 0u};
            *(u32x4*)(XS + (size_t)r * 1024 + lane * 8) = z; *(u32x4*)(XS + (size_t)r * 1024 + 512 + lane * 8) = z;
        }
    }
    for (int as = oblk() * 8 + wave; as < 2 * T; as += ogrid() * 8) {
        const int t = as >> 1;
        const int e = EID[as], rk = ERK[as];
        const int dest = s_ps[e] + rk;
        float tot = 0.f;
        if (lane < 16) tot = SS[(size_t)t * 16 + lane];
        tot = wsum(tot);
        const float rinv = rsqrtf(tot * (1.0f / 1024.0f) + 1e-6f);
        if (lane == 0) { SSLOT[dest] = as; SW[dest] = EW[as]; }
#pragma unroll
        for (int i = 0; i < 2; ++i) {
            const u32x4 w = *(const u32x4*)(XB + (size_t)t * 1024 + i * 512 + lane * 8);
            u32x4 o;
#pragma unroll
            for (int j = 0; j < 4; ++j) o[j] = pk2(lo16(w[j]) * rinv, hi16(w[j]) * rinv);
            *(u32x4*)(XS + (size_t)dest * 1024 + i * 512 + lane * 8) = o;
        }
    }
}

__device__ __forceinline__ void pj_finalize(const PA a) {
    const int wave = otid() >> 6, lane = otid() & 63;
    float* X = a.out; bf16_t* XB = WSP(bf16_t, WS_XB); float* SS = WSP(float, WS_SS);
    const bf16_t* Y = WSP(const bf16_t, WS_Y);
    for (int t = oblk() * 8 + wave; t < T; t += ogrid() * 8) {
        float sq = 0.f;
#pragma unroll
        for (int i = 0; i < 4; ++i) {
            const int c = i * 256 + lane * 4;
            f32x4 v = *(const f32x4*)(X + (size_t)t * 1024 + c);
            const u32x2 y0 = *(const u32x2*)(Y + (size_t)(2 * t) * 1024 + c), y1 = *(const u32x2*)(Y + (size_t)(2 * t + 1) * 1024 + c);
            v[0] += lo16(y0.x) + lo16(y1.x); v[1] += hi16(y0.x) + hi16(y1.x); v[2] += lo16(y0.y) + lo16(y1.y); v[3] += hi16(y0.y) + hi16(y1.y);
            *(f32x4*)(X + (size_t)t * 1024 + c) = v;
            u32x2 w; w.x = pk2(v[0], v[1]); w.y = pk2(v[2], v[3]);
            *(u32x2*)(XB + (size_t)t * 1024 + c) = w;
            sq += (v[0] * v[0] + v[1] * v[1]) + (v[2] * v[2] + v[3] * v[3]);
        }
        sq = wsum(sq);
        if (lane < 16) SS[(size_t)t * 16 + lane] = (lane == 0) ? sq : 0.f;
    }
}

#define SITE static __device__ __forceinline__ void
#define OPAQUE() do { asm volatile("" : "+s"(a.ws), "+s"(a.out)); } while (0)
__device__ __forceinline__ int opq(int v) { asm volatile("" : "+s"(v)); return v; }
SITE site_p0(PA a, LAS unsigned char* lds) { OPAQUE(); p0_prologue(a, lds); }
SITE site_kv(PA a, LAS unsigned char* lds) { OPAQUE();
    pg8::Gemm g{WSP(const bf16_t, WS_MEMB), WSP(const bf16_t, WS_WKV), 1024, (size_t)1024 * 1024};
    pg8::KvOrder S{opq((int)gridDim.x), opq((int)blockIdx.x)};
    pg8::EpiScale E{WSP(bf16_t, WS_KV), 1024, WSP(const float, WS_MEMSS), MROWS - 1};
    pg8::gemm_phase<pg8::EpiScale, pg8::KvOrder>(lds, g, S, E);
}
SITE site_knorm(PA a, LAS unsigned char* lds) { OPAQUE(); p2_knorm(a, lds); }
SITE site_inproj(PA a, int l, LAS unsigned char* lds) { OPAQUE();
    pg8::Gemm g{WSP(const bf16_t, WS_XB), WSP(const bf16_t, WS_WIN) + (size_t)l * INW * 1024, 1024, 0};
    pg8::StaticOrder S; S.init(T, INW, opq((int)gridDim.x), opq((int)blockIdx.x));
    pg8::EpiScale E{WSP(bf16_t, WS_PROJ), INW, WSP(const float, WS_SS), T - 1};
    pg8::gemm_phase<pg8::EpiScale, pg8::StaticOrder>(lds, g, S, E);
}
SITE site_prep(PA a, int l, LAS unsigned char* lds) { OPAQUE();
    if (l > 0) moe_convert(a, l, lds);
    __syncthreads();
    pb_prep(a, l, lds);
}
SITE site_mixer(PA a, int l, LAS unsigned char* lds) { OPAQUE(); pc_mixer(a, l, lds); }
SITE site_outproj(PA a, int l, LAS unsigned char* lds) { OPAQUE();
    pg8::Gemm g{WSP(const bf16_t, WS_YCAT), WSP(const bf16_t, WS_WOUT) + (size_t)l * 1024 * 1024, 1024, 0};
    pg8::StaticOrder S; S.init(T, 1024, opq((int)gridDim.x), opq((int)blockIdx.x));
    pg8::EpiRes E{a.out, WSP(bf16_t, WS_XB), WSP(float, WS_SS)};
    pg8::gemm_phase<pg8::EpiRes, pg8::StaticOrder>(lds, g, S, E);
}
SITE site_xq(PA a, int l, LAS unsigned char* lds) { OPAQUE();
    pg8::Gemm g{WSP(const bf16_t, WS_XB), WSP(const bf16_t, WS_WQ) + (size_t)l * 512 * 1024, 1024, 0};
    pg8::StaticOrder S; S.init(T, 512, opq((int)gridDim.x), opq((int)blockIdx.x));
    pg8::EpiScale E{WSP(bf16_t, WS_QX), 512, WSP(const float, WS_SS), T - 1};
    pg8::gemm_phase<pg8::EpiScale, pg8::StaticOrder>(lds, g, S, E);
}
SITE site_xattn(PA a, int l, LAS unsigned char* lds) { OPAQUE(); pe2_xattn(a, l, lds); }
SITE site_xo(PA a, int l, LAS unsigned char* lds) { OPAQUE();
    pg8::Gemm g{WSP(const bf16_t, WS_OX), WSP(const bf16_t, WS_WO) + (size_t)l * 1024 * 512, 512, 0};
    pg8::StaticOrder S; S.init(T, 1024, opq((int)gridDim.x), opq((int)blockIdx.x));
    pg8::EpiRes E{a.out, WSP(bf16_t, WS_XB), WSP(float, WS_SS)};
    pg8::gemm_phase<pg8::EpiRes, pg8::StaticOrder>(lds, g, S, E);
}
SITE site_router(PA a, int l, LAS unsigned char* lds) { OPAQUE(); pf_router(a, l, lds); }
SITE site_gather(PA a, int l, LAS unsigned char* lds) { OPAQUE(); pg_gather(a, l, lds); }
SITE site_gu(PA a, LAS unsigned char* lds) { OPAQUE();
    pg8::Gemm g{WSP(const bf16_t, WS_XS), WSP(const bf16_t, WS_WGU), 1024, (size_t)1024 * 1024};
    pg8::MoeOrder S{WSP(const int, WS_MTE), opq((int)gridDim.x), opq((int)blockIdx.x)};
    pg8::EpiGU E{WSP(bf16_t, WS_HB)};
    pg8::gemm_phase<pg8::EpiGU, pg8::MoeOrder>(lds, g, S, E);
}
SITE site_down(PA a, LAS unsigned char* lds) { OPAQUE();
    pg8::Gemm g{WSP(const bf16_t, WS_HB), WSP(const bf16_t, WS_WD), 512, (size_t)1024 * 512};
    pg8::MoeOrder S{WSP(const int, WS_MTE), opq((int)gridDim.x), opq((int)blockIdx.x)};
    pg8::EpiDown E{WSP(bf16_t, WS_Y), WSP(const int, WS_SSLOT), WSP(const float, WS_SW)};
    pg8::gemm_phase<pg8::EpiDown, pg8::MoeOrder>(lds, g, S, E);
}
SITE site_final(PA a, LAS unsigned char* lds) { OPAQUE(); pj_finalize(a); }

__global__ void __launch_bounds__(512, 2) mk_fwd(Args args) {
    extern __shared__ __attribute__((aligned(16))) unsigned char lds_raw[];
    LAS unsigned char* lds = (LAS unsigned char*)lds_raw;
    const int tid = threadIdx.x;
    const int lo = args.ph_lo, hi = args.ph_hi;
    PA a; a.out = args.out; a.ws = args.ws;
    if (tid < 16) ((LAS unsigned*)(lds + LDS_MISC))[tid] = 0u;
    if (tid == 64) {
        LAS unsigned long long* tab = (LAS unsigned long long*)(lds + LDS_INTAB);
#pragma unroll
        for (int i = 0; i < 38; ++i) tab[i] = (unsigned long long)args.in[i];
    }
    __syncthreads();
    XcdBarrier bar; bar.bar = WSP(unsigned, WS_CTL) + CW_BAR; bar.x = 0; bar.st = nullptr;
    if (!MK_PER_PHASE) bar = xcd_barrier_post(WSP(unsigned, WS_CTL) + CW_BAR, (volatile LAS unsigned*)(lds + LDS_MISC));
#define IN(k) (lo <= (k) && (k) < hi)
#define GRID_BAR() do { if (!MK_PER_PHASE) xcd_barrier(bar); } while (0)
    if (IN(0)) { site_p0(a, lds); GRID_BAR(); }
    if (IN(1)) { site_kv(a, lds); GRID_BAR(); }
    if (IN(2)) { site_knorm(a, lds); GRID_BAR(); }
    for (int l = 0; l < NL; ++l) {
        const int pb = 3 + 12 * l;
        if (IN(pb + 0)) { site_inproj(a, l, lds); GRID_BAR(); }
        if (IN(pb + 1)) { site_prep(a, l, lds); GRID_BAR(); }
        if (IN(pb + 2)) { site_mixer(a, l, lds); GRID_BAR(); }
        if (IN(pb + 3)) { site_outproj(a, l, lds); GRID_BAR(); }
        if (IN(pb + 4)) { site_xq(a, l, lds); GRID_BAR(); }
        if (IN(pb + 5)) { site_xattn(a, l, lds); GRID_BAR(); }
        if (IN(pb + 6)) { site_xo(a, l, lds); GRID_BAR(); }
        if (IN(pb + 7)) { site_router(a, l, lds); GRID_BAR(); }
        if (IN(pb + 8)) { site_gather(a, l, lds); GRID_BAR(); }
        if (IN(pb + 9)) { site_gu(a, lds); GRID_BAR(); }
        if (IN(pb + 10)) { site_down(a, lds); GRID_BAR(); }
        if (IN(pb + 11)) { site_final(a, lds); if (l + 1 < NL) GRID_BAR(); }
    }
#undef IN
#undef GRID_BAR
}

extern "C" void kernel_launch(void* const* d_in, const int* in_sizes, int n_in, void* d_out, int out_size, void* d_ws, size_t ws_size, hipStream_t stream) {
    static int grid = 0;
    if (grid == 0) {
        if (n_in != 38 || out_size != T * D || ws_size < WS_END) { fprintf(stderr, "kernel_launch: unexpected shapes (n_in %d out %d ws %zu need %zu)\n", n_in, out_size, ws_size, (size_t)WS_END); grid = -1; return; }
        int dev = 0, cus = 0, per_cu = 0;
        if (hipGetDevice(&dev) != hipSuccess || hipDeviceGetAttribute(&cus, hipDeviceAttributeMultiprocessorCount, dev) != hipSuccess) { grid = -1; return; }
        if (hipFuncSetAttribute((const void*)mk_fwd, hipFuncAttributeMaxDynamicSharedMemorySize, LDS_BYTES) != hipSuccess) { fprintf(stderr, "kernel_launch: hipFuncSetAttribute failed\n"); grid = -1; return; }
        if (hipOccupancyMaxActiveBlocksPerMultiprocessor(&per_cu, (const void*)mk_fwd, 512, LDS_BYTES) != hipSuccess || per_cu < 1) { fprintf(stderr, "kernel_launch: occupancy query says %d\n", per_cu); }
        (void)hipGetLastError();
        grid = cus;
    }
    if (grid < 0) return;
    (void)hipMemsetAsync((char*)d_ws + WS_CTL, 0, CTL_BYTES, stream);
    Args a{};
    for (int i = 0; i < 38; ++i) a.in[i] = (const float*)d_in[i];
    a.out = (float*)d_out; a.ws = (unsigned char*)d_ws;
#if MK_PER_PHASE
    for (int p = 0; p < NPH; ++p) { a.ph_lo = p; a.ph_hi = p + 1; hipLaunchKernelGGL(mk_fwd, dim3(grid), dim3(512), LDS_BYTES, stream, a); }
#else
    a.ph_lo = 0; a.ph_hi = NPH;
    hipLaunchKernelGGL(mk_fwd, dim3(grid), dim3(512), LDS_BYTES, stream, a);
#endif
}
```

```cpp
#include <hip/hip_runtime.h>
#include <cstdio>
#include <cstdint>

#ifndef MK_PER_PHASE
#define MK_PER_PHASE 0
#endif

#define LAS __attribute__((address_space(3)))
typedef unsigned short bf16_t;
typedef short bf16x8 __attribute__((ext_vector_type(8)));
typedef float f32x4 __attribute__((ext_vector_type(4)));
typedef unsigned u32x4 __attribute__((ext_vector_type(4)));
typedef unsigned u32x2 __attribute__((ext_vector_type(2)));

constexpr int T = 32768, D = 1024, SEQ = 2048, NL = 4;
constexpr int INW = 3328;
constexpr int MROWS = 4096;
constexpr int MAXROWS = 73728, MAXMT = 288;
constexpr int NPH = 3 + 12 * NL;

constexpr size_t WS_CTL   = 0;
constexpr size_t CTL_BYTES = 65536;
constexpr size_t WS_WIN   = WS_CTL + CTL_BYTES;
constexpr size_t WS_WOUT  = WS_WIN  + (size_t)4 * 3328 * 1024 * 2;
constexpr size_t WS_WQ    = WS_WOUT + (size_t)4 * 1024 * 1024 * 2;
constexpr size_t WS_WKV   = WS_WQ   + (size_t)4 * 512 * 1024 * 2;
constexpr size_t WS_WO    = WS_WKV  + (size_t)4 * 1024 * 1024 * 2;
constexpr size_t WS_WGU   = WS_WO   + (size_t)4 * 1024 * 512 * 2;
constexpr size_t WS_WD    = WS_WGU  + (size_t)32 * 1024 * 1024 * 2;
constexpr size_t WS_KV    = WS_WD   + (size_t)32 * 1024 * 512 * 2;
constexpr size_t WS_MEMB  = WS_KV   + (size_t)4 * 4096 * 1024 * 2;
constexpr size_t WS_MEMSS = WS_MEMB + (size_t)4096 * 1024 * 2;
constexpr size_t WS_XB    = WS_MEMSS + (size_t)4096 * 16 * 4;
constexpr size_t WS_SS    = WS_XB   + (size_t)T * 1024 * 2;
constexpr size_t WS_VF    = WS_SS   + (size_t)T * 16 * 4;
constexpr size_t WS_EID   = WS_VF   + (size_t)T * 512 * 2;
constexpr size_t WS_EW    = WS_EID  + (size_t)T * 2 * 4;
constexpr size_t WS_ERK   = WS_EW   + (size_t)T * 2 * 4;
constexpr size_t WS_SSLOT = WS_ERK  + (size_t)T * 2 * 4;
constexpr size_t WS_SW    = WS_SSLOT + (size_t)MAXROWS * 4;
constexpr size_t WS_MTE   = WS_SW   + (size_t)MAXROWS * 4;
constexpr size_t WS_U     = WS_MTE  + 2048;
constexpr size_t WS_PROJ  = WS_U;
constexpr size_t WS_SR    = WS_PROJ + (size_t)T * 3328 * 2;
constexpr size_t WS_SK    = WS_SR   + (size_t)T * 512 * 2;
constexpr size_t WS_SV    = WS_SK   + (size_t)T * 512 * 2;
constexpr size_t WS_SA    = WS_SV   + (size_t)T * 512 * 2;
constexpr size_t WS_SB    = WS_SA   + (size_t)T * 512 * 2;
constexpr size_t WS_SG    = WS_SB   + (size_t)T * 512 * 2;
constexpr size_t WS_SWD   = WS_SG   + (size_t)T * 512 * 2;
constexpr size_t WS_YCAT  = WS_SWD  + (size_t)T * 512 * 4;
constexpr size_t WS_UEND1 = WS_YCAT + (size_t)T * 1024 * 2;
constexpr size_t WS_QX    = WS_U;
constexpr size_t WS_OX    = WS_QX   + (size_t)T * 512 * 2;
constexpr size_t WS_XS    = WS_U;
constexpr size_t WS_HB    = WS_XS   + (size_t)MAXROWS * 1024 * 2;
constexpr size_t WS_Y     = WS_HB   + (size_t)MAXROWS * 512 * 2;
constexpr size_t WS_UEND2 = WS_Y    + (size_t)2 * T * 1024 * 2;
constexpr size_t WS_END   = WS_UEND1 > WS_UEND2 ? WS_UEND1 : WS_UEND2;

constexpr int CW_BAR = 0;
constexpr int CW_CNT = 4096;
constexpr int CW_QUEUE = 4096 + 256;

constexpr int LDS_MISC = 131072;
constexpr int LDS_BYTES = 131072 + 16384;

struct Args { const float* in[38]; float* out; unsigned char* ws; int ph_lo, ph_hi; };
struct PA { float* out; unsigned char* ws; };

__device__ __forceinline__ float bf2f(bf16_t b) { return __uint_as_float(((unsigned)b) << 16); }
__device__ __forceinline__ bf16_t f2bf(float f) { unsigned u = __float_as_uint(f); u += 0x7FFFu + ((u >> 16) & 1u); return (bf16_t)(u >> 16); }
__device__ __forceinline__ unsigned pk2(float lo, float hi) { unsigned r; asm volatile("v_cvt_pk_bf16_f32 %0, %1, %2" : "=v"(r) : "v"(lo), "v"(hi)); return r; }
__device__ __forceinline__ float lo16(unsigned u) { return __uint_as_float(u << 16); }
__device__ __forceinline__ float hi16(unsigned u) { return __uint_as_float(u & 0xffff0000u); }
__device__ __forceinline__ float wsum(float v) {
#pragma unroll
    for (int o = 32; o; o >>= 1) v += __shfl_xor(v, o);
    return v;
}
__device__ __forceinline__ float sigmoidf_(float x) { return 1.0f / (1.0f + __expf(-x)); }

#define XB_TMO      128
#define XB_XCNT(j)  (256  + 64 * (j))
#define XB_XSUB(j)  (1280 + 64 * (j))
#define XB_XGEN(j)  (2304 + 64 * (j))
#define XB_TOP      3328
#define XB_TOPGEN   3392
#define XCD_BAR_WORDS 3456
#define XB_SPIN_CAP (1u << 22)

__device__ __forceinline__ unsigned xb_ld(unsigned* p)              { return __hip_atomic_load(p, __ATOMIC_RELAXED, __HIP_MEMORY_SCOPE_AGENT); }
__device__ __forceinline__ unsigned xb_add(unsigned* p, unsigned v) { return __hip_atomic_fetch_add(p, v, __ATOMIC_RELAXED, __HIP_MEMORY_SCOPE_AGENT); }
__device__ __forceinline__ unsigned xb_xcc_id() { return (unsigned)__builtin_amdgcn_s_getreg((3 << 11) | 20) & 0xFu; }
#define XB_SPIN(cond, bar) do { unsigned _sp = 0; while (cond) { __builtin_amdgcn_s_sleep(1); \
    if ((++_sp & 255u) == 0u) { if (xb_ld(&(bar)[XB_TMO])) break; if (_sp > XB_SPIN_CAP) { atomicAdd(&(bar)[XB_TMO], 1u); break; } } } } while (0)

struct XcdBarrier { unsigned* bar; unsigned x; volatile LAS unsigned* st; };

__device__ __forceinline__ XcdBarrier xcd_barrier_post(unsigned* bar, volatile LAS unsigned* st) {
    XcdBarrier b; b.bar = bar; b.x = xb_xcc_id(); b.st = st;
    if (threadIdx.x == 0) (void)xb_add(&bar[XB_XCNT(b.x)], 1u);
    return b;
}
__device__ __forceinline__ void xcd_barrier_complete(unsigned* bar, unsigned x, unsigned& nloc, unsigned& nx) {
    const unsigned G = gridDim.x * gridDim.y * gridDim.z;
    unsigned sum, cnt, mine, sp = 0u;
    for (;;) {
        sum = 0u; cnt = 0u; mine = 0u;
#pragma unroll
        for (unsigned j = 0; j < 16; ++j) { const unsigned c = xb_ld(&bar[XB_XCNT(j)]); sum += c; cnt += (c > 0u) ? 1u : 0u; mine = (j == x) ? c : mine; }
        if (sum == G) break;
        __builtin_amdgcn_s_sleep(1);
        if ((++sp & 255u) == 0u) { if (xb_ld(&bar[XB_TMO])) break; if (sp > XB_SPIN_CAP) { atomicAdd(&bar[XB_TMO], 1u); break; } }
    }
    nloc = mine > 0u ? mine : 1u; nx = cnt > 0u ? cnt : 1u;
}
__device__ __forceinline__ void xcd_barrier(const XcdBarrier& b) {
    asm volatile("s_waitcnt vmcnt(0)" ::: "memory");
    __syncthreads();
    if (threadIdx.x == 0) {
        unsigned* bar = b.bar;
        __builtin_amdgcn_s_waitcnt(0);
        unsigned nloc = b.st[0], nx = b.st[1];
        if (nloc == 0u) { xcd_barrier_complete(bar, b.x, nloc, nx); b.st[0] = nloc; b.st[1] = nx; }
        const unsigned old = xb_add(&bar[XB_XSUB(b.x)], 1u);
        const unsigned gen = old / nloc;
        if (old + 1u == (gen + 1u) * nloc) {
            __builtin_amdgcn_fence(__ATOMIC_RELEASE, "agent");
            asm volatile("s_waitcnt vmcnt(0)" ::: "memory");
            const unsigned og = xb_add(&bar[XB_TOP], 1u);
            const unsigned tg = og / nx;
            if (og + 1u == (tg + 1u) * nx) xb_add(&bar[XB_TOPGEN], 1u);
            else XB_SPIN(xb_ld(&bar[XB_TOPGEN]) == tg, bar);
            __builtin_amdgcn_fence(__ATOMIC_ACQUIRE, "agent");
            xb_add(&bar[XB_XGEN(b.x)], 1u);
            asm volatile("s_waitcnt vmcnt(0)" ::: "memory");
        } else {
            XB_SPIN(xb_ld(&bar[XB_XGEN(b.x)]) == gen, bar);
            __builtin_amdgcn_fence(__ATOMIC_ACQUIRE, "agent");
            asm volatile("s_waitcnt vmcnt(0)" ::: "memory");
        }
    }
    __syncthreads();
}

namespace pg8 {
constexpr int BM = 256, BK = 64, HALF = 128, HTB = HALF * BK * 2, STAGE_BYTES = 8 * HTB, NXCD = 8, WGM = 8;
__host__ __device__ __forceinline__ int lds_byte(int r, int c) { const int st = (r >> 4) * 2 + (c >> 5), rr = r & 15, cc = c & 31, ob = rr * 64 + cc * 2; return st * 1024 + (ob ^ (((ob >> 9) & 1) << 5)); }
__host__ __device__ __forceinline__ void stage_rc(int b, int& R, int& C) { const int st = b / 1024, sb = b % 1024, swz = sb ^ (((sb >> 9) & 1) << 5); R = (st >> 1) * 16 + swz / 64; C = (st & 1) * 32 + (swz % 64) / 2; }
__host__ __device__ __forceinline__ int perm32(int rho) { const int n = rho >> 4, i = rho & 15; return 8 * (i >> 2) + 4 * n + (i & 3); }

struct Unit { int pm, pn, pa, z; };
struct Gemm { const bf16_t* A; const bf16_t* Bt; int K; size_t bz_stride; };

struct StaticOrder {
    int nM, nN, nwg, G, c;
    __device__ void init(int M, int N, int G_, int c_) { nM = M / BM; nN = N / BM; nwg = nM * nN; G = G_; c = c_; }
    __device__ bool next(int i, Unit& u) const {
        const long L = (long)i * G + c; if (L >= nwg) return false;
        int wgid = (int)L; { const int q = nwg / NXCD, r = nwg % NXCD, xcd = wgid % NXCD, off = wgid / NXCD; wgid = (xcd < r ? xcd * (q + 1) : r * (q + 1) + (xcd - r) * q) + off; }
        const int nig = WGM * nN, gid = wgid / nig, fm = gid * WGM, gsz = (nM - fm) < WGM ? (nM - fm) : WGM;
        u.pm = fm + ((wgid % nig) % gsz); u.pn = (wgid % nig) / gsz; u.pa = u.pm; u.z = 0; return true;
    }
};
struct KvOrder {
    int G, c;
    __device__ bool next(int i, Unit& u) const {
        const int L = i * G + c; if (L >= 256) return false;
        u.z = L >> 6; const int r = L & 63; u.pa = r >> 2; u.pn = r & 3; u.pm = u.z * 16 + u.pa; return true;
    }
};
struct MoeOrder {
    const int* mte; int G, c;
    __device__ bool next(int i, Unit& u) const {
        const int nunits = mte[511] * 4;
        const int L = i * G + c; if (L >= nunits) return false;
        u.pm = L >> 2; u.pa = u.pm; u.pn = L & 3; u.z = mte[u.pm]; return true;
    }
};

template <class Epi, class Sched, bool ALIGN_EPI = true>
__device__ __forceinline__ void gemm_phase(LAS unsigned char* lds, const Gemm g, const Sched& S, const Epi& E) {
    int tid_ = threadIdx.x; asm volatile("" : "+v"(tid_));
    const int tid = tid_, wid = __builtin_amdgcn_readfirstlane(tid >> 6), lane = tid & 63, wr = wid >> 2, wc = wid & 3, fr = lane & 15, fq = lane >> 4;
    const int K = g.K, nt = K / BK;
    unsigned voffA[2], voffB[2];
#pragma unroll
    for (int i = 0; i < 2; ++i) { int R, C; stage_rc(tid * 16 + i * 8192, R, C); const int Rb = ((R & ~31) + perm32(R & 31));
        voffA[i] = (unsigned)(R * K + C) * 2u; voffB[i] = (unsigned)(Rb * K + C) * 2u; }
    const size_t kstep = (size_t)(BK * 2);
    const size_t hstep = (size_t)HALF * K * 2;
    const size_t tstep = 2 * hstep;
    const unsigned ldsw = (unsigned)wid * 1024u;
    const int aoff = lds_byte(wr * 64 + fr, fq * 8), boff = lds_byte(wc * 32 + fr, fq * 8);
#define PG8_SA(b, h) (((b) * 2 + (h)) * HTB)
#define PG8_SB(b, h) ((4 + (b) * 2 + (h)) * HTB)
#define PG8_STAGE(bufoff, gbase, voff) do { _Pragma("unroll") for (int _i = 0; _i < 2; ++_i) \
        __builtin_amdgcn_global_load_lds((const unsigned*)((const char*)(gbase) + (voff)[_i]), (LAS unsigned*)(lds + (bufoff) + ldsw + _i * 8192), 16, 0, 0); } while (0)
#define PG8_LDA(dst, b, h) do { _Pragma("unroll") for (int m = 0; m < 4; ++m) _Pragma("unroll") for (int k = 0; k < 2; ++k) dst[m][k] = *(const LAS bf16x8*)(lds + PG8_SA(b, h) + aoff + m * 2048 + k * 1024); } while (0)
#define PG8_LDB(dst, b, h) do { _Pragma("unroll") for (int n = 0; n < 2; ++n) _Pragma("unroll") for (int k = 0; k < 2; ++k) dst[n][k] = *(const LAS bf16x8*)(lds + PG8_SB(b, h) + boff + n * 2048 + k * 1024); } while (0)
#define PG8_MMA(ai, bj, At, Bt) do { __builtin_amdgcn_s_setprio(1); _Pragma("unroll") for (int m = 0; m < 4; ++m) _Pragma("unroll") for (int n = 0; n < 2; ++n) _Pragma("unroll") for (int k = 0; k < 2; ++k) \
        acc[ai][bj][m][n] = __builtin_amdgcn_mfma_f32_16x16x32_bf16(Bt[n][k], At[m][k], acc[ai][bj][m][n], 0, 0, 0); __builtin_amdgcn_s_setprio(0); } while (0)
#define PG8_WAIT_V(n) asm volatile("s_waitcnt vmcnt(" #n ")" ::: "memory")
#define PG8_WAIT_L(n) asm volatile("s_waitcnt lgkmcnt(" #n ")" ::: "memory")
#define PG8_BAR __builtin_amdgcn_s_barrier()
#define PG8_SCHED __builtin_amdgcn_sched_barrier(0)
#define PG8_APTR(u) ((const char*)g.A + (size_t)(u).pa * tstep)
#define PG8_BPTR(u) ((const char*)g.Bt + ((size_t)(u).z * g.bz_stride) * 2 + (size_t)(u).pn * tstep)
    Unit cur, nxt; int ui = 0;
    if (!S.next(0, cur)) return;
    f32x4 acc[2][2][4][2];
#pragma unroll
    for (int a = 0; a < 2; ++a)
#pragma unroll
        for (int b = 0; b < 2; ++b)
#pragma unroll
            for (int m = 0; m < 4; ++m)
#pragma unroll
                for (int n = 0; n < 2; ++n) acc[a][b][m][n] = (f32x4){0.f, 0.f, 0.f, 0.f};
    bf16x8 At[4][2], B0[2][2], B1[2][2];
    const char* cA = PG8_APTR(cur); const char* cB = PG8_BPTR(cur);
    PG8_STAGE(PG8_SB(0, 0), cB, voffB); PG8_STAGE(PG8_SB(0, 1), cB + hstep, voffB); PG8_STAGE(PG8_SA(0, 0), cA, voffA); PG8_STAGE(PG8_SA(0, 1), cA + hstep, voffA);
    if (wr == 1) PG8_BAR;
    PG8_WAIT_V(2); PG8_BAR;
    PG8_STAGE(PG8_SB(1, 0), cB + kstep, voffB); PG8_STAGE(PG8_SA(1, 0), cA + kstep, voffA); PG8_STAGE(PG8_SB(1, 1), cB + hstep + kstep, voffB);
    PG8_WAIT_V(6); PG8_BAR;
    for (;;) {
        const bool has_next = S.next(ui + 1, nxt);
        const char* nA = has_next ? PG8_APTR(nxt) : cA; const char* nB = has_next ? PG8_BPTR(nxt) : cB;
        for (int t = 0; t < nt; t += 2) {
            const bool last = (t == nt - 2);
            const char* a1 = cA + (size_t)(t + 1) * kstep;
            const char* a2 = last ? nA : cA + (size_t)(t + 2) * kstep; const char* b2 = last ? nB : cB + (size_t)(t + 2) * kstep;
            const char* a3 = a2 + kstep; const char* b3 = b2 + kstep;
            PG8_LDB(B0, 0, 0); PG8_LDB(B1, 0, 1); PG8_SCHED; PG8_LDA(At, 0, 0); PG8_STAGE(PG8_SA(1, 1), a1 + hstep, voffA);
            PG8_WAIT_V(8); PG8_WAIT_L(0); PG8_BAR; PG8_MMA(0, 0, At, B0); PG8_MMA(0, 1, At, B1); PG8_BAR; PG8_SCHED;
            PG8_LDA(At, 0, 1); PG8_STAGE(PG8_SB(0, 0), b2, voffB); PG8_STAGE(PG8_SB(0, 1), b2 + hstep, voffB); PG8_STAGE(PG8_SA(0, 0), a2, voffA);
            PG8_WAIT_V(8); PG8_WAIT_L(0); PG8_BAR; PG8_MMA(1, 0, At, B0); PG8_MMA(1, 1, At, B1); PG8_BAR; PG8_SCHED;
            PG8_LDB(B0, 1, 0); PG8_LDB(B1, 1, 1); PG8_SCHED; PG8_LDA(At, 1, 0); PG8_STAGE(PG8_SA(0, 1), a2 + hstep, voffA);
            PG8_WAIT_V(8); PG8_WAIT_L(0); PG8_BAR; PG8_MMA(0, 0, At, B0); PG8_MMA(0, 1, At, B1); PG8_BAR; PG8_SCHED;
            PG8_LDA(At, 1, 1); PG8_STAGE(PG8_SB(1, 0), b3, voffB); PG8_STAGE(PG8_SB(1, 1), b3 + hstep, voffB); PG8_STAGE(PG8_SA(1, 0), a3, voffA);
            PG8_WAIT_V(8); PG8_WAIT_L(0); PG8_BAR; PG8_MMA(1, 0, At, B0); PG8_MMA(1, 1, At, B1); PG8_BAR; PG8_SCHED;
        }
        if constexpr (ALIGN_EPI) { if (wr == 0) PG8_BAR; }
        E(acc, cur, wr, wc, fr, fq);
        if (!has_next) break;
#pragma unroll
        for (int a = 0; a < 2; ++a)
#pragma unroll
            for (int b = 0; b < 2; ++b)
#pragma unroll
                for (int m = 0; m < 4; ++m)
#pragma unroll
                    for (int n = 0; n < 2; ++n) acc[a][b][m][n] = (f32x4){0.f, 0.f, 0.f, 0.f};
        cur = nxt; cA = nA; cB = nB; ++ui;
        if constexpr (ALIGN_EPI) { if (wr == 1) PG8_BAR; }
    }
    PG8_WAIT_V(0);
    if constexpr (!ALIGN_EPI) { if (wr == 0) PG8_BAR; }
    PG8_BAR;
#undef PG8_SA
#undef PG8_SB
#undef PG8_STAGE
#undef PG8_LDA
#undef PG8_LDB
#undef PG8_MMA
#undef PG8_WAIT_V
#undef PG8_WAIT_L
#undef PG8_BAR
#undef PG8_SCHED
#undef PG8_APTR
#undef PG8_BPTR
}

typedef const f32x4 (&AccRef)[2][2][4][2];

struct EpiScale {
    bf16_t* O; int ldc; const float* ss; int ssmask;
    __device__ __forceinline__ void operator()(AccRef acc, const Unit& u, int wr, int wc, int fr, int fq) const {
#pragma unroll
        for (int ai = 0; ai < 2; ++ai)
#pragma unroll
            for (int m = 0; m < 4; ++m) {
                const int row = u.pm * 256 + ai * 128 + wr * 64 + m * 16 + fr;
                const f32x4* sp = (const f32x4*)(ss + (size_t)(row & ssmask) * 16);
                const f32x4 s0 = sp[0], s1 = sp[1], s2 = sp[2], s3 = sp[3];
                const float tot = ((s0[0] + s0[1]) + (s0[2] + s0[3])) + ((s1[0] + s1[1]) + (s1[2] + s1[3])) + ((s2[0] + s2[1]) + (s2[2] + s2[3])) + ((s3[0] + s3[1]) + (s3[2] + s3[3]));
                const float rinv = rsqrtf(tot * (1.0f / 1024.0f) + 1e-6f);
#pragma unroll
                for (int bj = 0; bj < 2; ++bj) {
                    const int col = u.pn * 256 + bj * 128 + wc * 32 + 8 * fq;
                    const f32x4 v0 = acc[ai][bj][m][0] * rinv, v1 = acc[ai][bj][m][1] * rinv;
                    u32x4 w; w.x = pk2(v0[0], v0[1]); w.y = pk2(v0[2], v0[3]); w.z = pk2(v1[0], v1[1]); w.w = pk2(v1[2], v1[3]);
                    *(u32x4*)(O + (size_t)row * ldc + col) = w;
                }
            }
    }
};
struct EpiRes {
    float* X; bf16_t* XB; float* SS;
    __device__ __forceinline__ void operator()(AccRef acc, const Unit& u, int wr, int wc, int fr, int fq) const {
#pragma unroll
        for (int ai = 0; ai < 2; ++ai)
#pragma unroll
            for (int m = 0; m < 4; ++m) {
                const int row = u.pm * 256 + ai * 128 + wr * 64 + m * 16 + fr;
                float sq = 0.f;
#pragma unroll
                for (int bj = 0; bj < 2; ++bj) {
                    const int col = u.pn * 256 + bj * 128 + wc * 32 + 8 * fq;
                    float* xp = X + (size_t)row * 1024 + col;
                    f32x4 x0 = *(const f32x4*)xp, x1 = *(const f32x4*)(xp + 4);
                    x0 += acc[ai][bj][m][0]; x1 += acc[ai][bj][m][1];
                    *(f32x4*)xp = x0; *(f32x4*)(xp + 4) = x1;
                    u32x4 w; w.x = pk2(x0[0], x0[1]); w.y = pk2(x0[2], x0[3]); w.z = pk2(x1[0], x1[1]); w.w = pk2(x1[2], x1[3]);
                    *(u32x4*)(XB + (size_t)row * 1024 + col) = w;
                    sq += (x0[0] * x0[0] + x0[1] * x0[1]) + (x0[2] * x0[2] + x0[3] * x0[3]) + (x1[0] * x1[0] + x1[1] * x1[1]) + (x1[2] * x1[2] + x1[3] * x1[3]);
                }
                sq += __shfl_xor(sq, 16); sq += __shfl_xor(sq, 32);
                if (fq == 0) SS[(size_t)row * 16 + u.pn * 4 + wc] = sq;
            }
    }
};
struct EpiGU {
    bf16_t* H;
    __device__ __forceinline__ void operator()(AccRef acc, const Unit& u, int wr, int wc, int fr, int fq) const {
#pragma unroll
        for (int ai = 0; ai < 2; ++ai)
#pragma unroll
            for (int m = 0; m < 4; ++m) {
                const int row = u.pm * 256 + ai * 128 + wr * 64 + m * 16 + fr;
                float h[8];
#pragma unroll
                for (int n = 0; n < 2; ++n)
#pragma unroll
                    for (int j = 0; j < 4; ++j) { const float gt = acc[ai][0][m][n][j], up = acc[ai][1][m][n][j]; h[n * 4 + j] = gt * __builtin_amdgcn_rcpf(1.0f + __expf(-gt)) * up; }
                u32x4 w; w.x = pk2(h[0], h[1]); w.y = pk2(h[2], h[3]); w.z = pk2(h[4], h[5]); w.w = pk2(h[6], h[7]);
                *(u32x4*)(H + (size_t)row * 512 + u.pn * 128 + wc * 32 + 8 * fq) = w;
            }
    }
};
struct EpiDown {
    bf16_t* Y; const int* slot; const float* sw;
    __device__ __forceinline__ void operator()(AccRef acc, const Unit& u, int wr, int wc, int fr, int fq) const {
#pragma unroll
        for (int ai = 0; ai < 2; ++ai)
#pragma unroll
            for (int m = 0; m < 4; ++m) {
                const int row = u.pm * 256 + ai * 128 + wr * 64 + m * 16 + fr;
                const int s = slot[row]; const float wgt = sw[row];
                if (s >= 0) {
#pragma unroll
                    for (int bj = 0; bj < 2; ++bj) {
                        const int col = u.pn * 256 + bj * 128 + wc * 32 + 8 * fq;
                        const f32x4 v0 = acc[ai][bj][m][0] * wgt, v1 = acc[ai][bj][m][1] * wgt;
                        u32x4 w; w.x = pk2(v0[0], v0[1]); w.y = pk2(v0[2], v0[3]); w.z = pk2(v1[0], v1[1]); w.w = pk2(v1[2], v1[3]);
                        *(u32x4*)(Y + (size_t)s * 1024 + col) = w;
                    }
                }
            }
    }
};
}

#define WSP(type, off) ((type*)(a.ws + (off)))
__device__ __forceinline__ int oblk() { int t = blockIdx.x; asm volatile("" : "+s"(t)); return t; }
__device__ __forceinline__ int ogrid() { int t = gridDim.x; asm volatile("" : "+s"(t)); return t; }
__device__ __forceinline__ int otid() { int t = threadIdx.x; asm volatile("" : "+v"(t)); return t; }
constexpr int LDS_INTAB = LDS_MISC + 14336;
__device__ __forceinline__ const float* ldsin(LAS unsigned char* lds, int i) {
    const unsigned long long p = ((const LAS unsigned long long*)(lds + LDS_INTAB))[i];
    const unsigned lo = __builtin_amdgcn_readfirstlane((unsigned)p), hi = __builtin_amdgcn_readfirstlane((unsigned)(p >> 32));
    return (const float*)(((unsigned long long)hi << 32) | lo);
}
#define INP(i) ldsin(lds, (i))

template <int MAP>
__device__ __forceinline__ void conv_T(const float* __restrict__ src, int Ktot, int N, int Kper, bf16_t* __restrict__ dst, size_t estride,
                                       const float* __restrict__ gain, int goff, LAS float* tile) {
    const int tid = otid();
    const int ntn = N >> 6, ntiles = (Ktot >> 6) * ntn;
    for (int ti = oblk(); ti < ntiles; ti += ogrid()) {
        const int kt = ti / ntn, ntc = ti - kt * ntn, k0 = kt * 64, n0 = ntc * 64;
        const int e = k0 / Kper, kl0 = k0 - e * Kper;
#pragma unroll
        for (int i = 0; i < 2; ++i) {
            const int idx = tid + i * 512, kk = idx >> 4, n4 = (idx & 15) * 4;
            const f32x4 v = *(const f32x4*)(src + (size_t)(k0 + kk) * N + n0 + n4);
            float gsc = 1.0f;
            if (gain != nullptr && kl0 + kk >= goff) gsc = gain[kl0 + kk - goff];
            tile[kk * 65 + n4 + 0] = v[0] * gsc; tile[kk * 65 + n4 + 1] = v[1] * gsc; tile[kk * 65 + n4 + 2] = v[2] * gsc; tile[kk * 65 + n4 + 3] = v[3] * gsc;
        }
        __syncthreads();
        {
            const int nn = tid >> 3, kg = tid & 7;
            float v[8];
#pragma unroll
            for (int j = 0; j < 8; ++j) v[j] = tile[(kg * 8 + j) * 65 + nn];
            const int n = n0 + nn;
            const int nr = (MAP == 0) ? n : ((n >> 7) * 256 + (n & 127) + (MAP == 2 ? 128 : 0));
            u32x4 w; w.x = pk2(v[0], v[1]); w.y = pk2(v[2], v[3]); w.z = pk2(v[4], v[5]); w.w = pk2(v[6], v[7]);
            *(u32x4*)(dst + (size_t)e * estride + (size_t)nr * Kper + kl0 + kg * 8) = w;
        }
        __syncthreads();
    }
}

__device__ __forceinline__ void moe_convert(const PA a, int l, LAS unsigned char* lds) {
    LAS float* tile = (LAS float*)lds;
    conv_T<1>(INP(35) + (size_t)l * 32 * 1024 * 512, 32 * 1024, 512, 1024, WSP(bf16_t, WS_WGU), (size_t)1024 * 1024, INP(30) + l * 1024, 0, tile);
    conv_T<2>(INP(36) + (size_t)l * 32 * 1024 * 512, 32 * 1024, 512, 1024, WSP(bf16_t, WS_WGU), (size_t)1024 * 1024, INP(30) + l * 1024, 0, tile);
    conv_T<0>(INP(37) + (size_t)l * 32 * 512 * 1024, 32 * 512, 1024, 512, WSP(bf16_t, WS_WD), (size_t)1024 * 512, nullptr, 0, tile);
}

__device__ __forceinline__ void rows_convert(const float* __restrict__ src, float* __restrict__ dstf, bf16_t* __restrict__ dstb, float* __restrict__ ss, int nrows) {
    const int wave = otid() >> 6, lane = otid() & 63;
    for (int r = oblk() * 8 + wave; r < nrows; r += ogrid() * 8) {
        float sq = 0.f;
#pragma unroll
        for (int i = 0; i < 4; ++i) {
            const int c = i * 256 + lane * 4;
            const f32x4 v = *(const f32x4*)(src + (size_t)r * 1024 + c);
            if (dstf) *(f32x4*)(dstf + (size_t)r * 1024 + c) = v;
            u32x2 w; w.x = pk2(v[0], v[1]); w.y = pk2(v[2], v[3]);
            *(u32x2*)(dstb + (size_t)r * 1024 + c) = w;
            sq += (v[0] * v[0] + v[1] * v[1]) + (v[2] * v[2] + v[3] * v[3]);
        }
        sq = wsum(sq);
        if (lane < 16) ss[(size_t)r * 16 + lane] = (lane == 0) ? sq : 0.f;
    }
}

__device__ __forceinline__ void p0_prologue(const PA a, LAS unsigned char* lds) {
    LAS float* tile = (LAS float*)lds;
    for (int l = 0; l < NL; ++l) {
        conv_T<0>(INP(3) + (size_t)l * 1024 * INW, 1024, INW, 1024, WSP(bf16_t, WS_WIN) + (size_t)l * INW * 1024, 0, INP(2) + l * 1024, 0, tile);
        conv_T<0>(INP(22) + (size_t)l * 1024 * 1024, 1024, 1024, 1024, WSP(bf16_t, WS_WOUT) + (size_t)l * 1024 * 1024, 0, INP(21) + l * 512, 512, tile);
        conv_T<0>(INP(25) + (size_t)l * 1024 * 512, 1024, 512, 1024, WSP(bf16_t, WS_WQ) + (size_t)l * 512 * 1024, 0, INP(23) + l * 1024, 0, tile);
        conv_T<0>(INP(26) + (size_t)l * 1024 * 1024, 1024, 1024, 1024, WSP(bf16_t, WS_WKV) + (size_t)l * 1024 * 1024, 0, INP(24) + l * 1024, 0, tile);
        conv_T<0>(INP(27) + (size_t)l * 512 * 1024, 512, 1024, 512, WSP(bf16_t, WS_WO) + (size_t)l * 1024 * 512, 0, nullptr, 0, tile);
    }
    moe_convert(a, 0, lds);
    rows_convert(INP(0), a.out, WSP(bf16_t, WS_XB), WSP(float, WS_SS), T);
    rows_convert(INP(1), nullptr, WSP(bf16_t, WS_MEMB), WSP(float, WS_MEMSS), MROWS);
}

__device__ __forceinline__ void p2_knorm(const PA a, LAS unsigned char* lds) {
    const int wave = otid() >> 6, lane = otid() & 63;
    bf16_t* kv = WSP(bf16_t, WS_KV);
    for (int it = oblk() * 8 + wave; it < NL * MROWS * 4; it += ogrid() * 8) {
        const int h = it & 3, row = (it >> 2) & (MROWS - 1), l = it >> 14;
        unsigned* p = (unsigned*)(kv + ((size_t)l * MROWS + row) * 1024 + h * 128 + lane * 2);
        const unsigned w = *p; const float x0 = lo16(w), x1 = hi16(w);
        const float ssq = wsum(x0 * x0 + x1 * x1);
        const float rinv = rsqrtf(ssq * (1.0f / 128.0f) + 1e-6f);
        const float* gk = INP(29) + l * 128 + lane * 2;
        *p = pk2(x0 * rinv * gk[0], x1 * rinv * gk[1]);
    }
}

__device__ __forceinline__ void pb_prep(const PA a, int l, LAS unsigned char* lds) {
    LAS float* s_wl = (LAS float*)lds;
    LAS float* s_al = s_wl + 64;
    LAS float* s_gl = s_al + 64;
    LAS float* s_xv = s_gl + 128;
    LAS float* s_part = s_xv + 512;
    LAS float* s_t32 = s_part + 512;
    const int c = otid();
    bf16_t* proj = WSP(bf16_t, WS_PROJ);
    const float* mu = INP(4) + l * 1792;
    const float* w0 = INP(5) + l * 512;  const float* w2 = INP(6) + (size_t)l * 64 * 512;
    const float* a0 = INP(7) + l * 512;  const float* a2 = INP(8) + (size_t)l * 64 * 512;
    const float* g2 = INP(9) + (size_t)l * 128 * 512;
    const float* kkw = INP(10) + l * 512; const float* kaw = INP(11) + l * 512;
    const int lv = l > 0 ? l - 1 : 0;
    const float* v0 = INP(15) + lv * 512; const float* v1 = INP(16) + (size_t)lv * 512 * 32; const float* v2 = INP(17) + (size_t)lv * 32 * 512;
    const float qg = INP(18)[l * 64 + (c & 63)], kg_ = INP(19)[l * 64 + (c & 63)];
    bf16_t* SR = WSP(bf16_t, WS_SR); bf16_t* SK = WSP(bf16_t, WS_SK); bf16_t* SV = WSP(bf16_t, WS_SV);
    bf16_t* SA = WSP(bf16_t, WS_SA); bf16_t* SB = WSP(bf16_t, WS_SB); bf16_t* SG = WSP(bf16_t, WS_SG);
    float* SWD = WSP(float, WS_SWD); bf16_t* VF = WSP(bf16_t, WS_VF);
    const float mur = mu[c], muk = mu[512 + c], muv = mu[1024 + c];
    const float mux = c < 256 ? mu[1536 + c] : 0.f;
    for (int t = oblk(); t < T; t += ogrid()) {
        const bool hp = (t & (SEQ - 1)) != 0;
        const bf16_t* pu = proj + (size_t)t * INW;
        const bf16_t* pp = hp ? pu - INW : pu;
        const float hpf = hp ? 1.0f : 0.0f;
        float u, p;
        u = bf2f(pu[c]); p = bf2f(pp[c]) * hpf; const float xr = u + mur * (p - u);
        u = bf2f(pu[512 + c]); p = bf2f(pp[512 + c]) * hpf; const float xk = u + muk * (p - u);
        u = bf2f(pu[1024 + c]); p = bf2f(pp[1024 + c]) * hpf; float xv = u + muv * (p - u);
        if (c < 256) {
            u = bf2f(pu[1536 + c]); p = bf2f(pp[1536 + c]) * hpf; const float xx = u + mux * (p - u);
            if (c < 64) s_wl[c] = tanhf(xx);
            else if (c < 128) s_al[c - 64] = xx;
            else s_gl[c - 128] = sigmoidf_(xx);
        }
        s_xv[c] = xv;
        __syncthreads();
        float w = w0[c], av = a0[c], g = 0.f;
#pragma unroll 8
        for (int j = 0; j < 64; ++j) { w += s_wl[j] * w2[j * 512 + c]; av += s_al[j] * a2[j * 512 + c]; }
#pragma unroll 8
        for (int j = 0; j < 128; ++j) g += s_gl[j] * g2[j * 512 + c];
        av = sigmoidf_(av);
        if (l > 0) {
            { const int j = c & 31, kp = c >> 5; float s = 0.f;
#pragma unroll 8
              for (int k = 0; k < 32; ++k) s += s_xv[kp * 32 + k] * v1[(kp * 32 + k) * 32 + j];
              s_part[kp * 32 + j] = s; }
            __syncthreads();
            if (c < 32) { float s = 0.f;
#pragma unroll
              for (int kp = 0; kp < 16; ++kp) s += s_part[kp * 32 + c];
              s_t32[c] = s; }
            __syncthreads();
            float z = v0[c];
#pragma unroll 8
            for (int j = 0; j < 32; ++j) z += s_t32[j] * v2[j * 512 + c];
            const float vf = bf2f(VF[(size_t)t * 512 + c]);
            xv = xv + (vf - xv) * sigmoidf_(z);
        } else {
            VF[(size_t)t * 512 + c] = f2bf(xv);
        }
        const float nw = -w;
        const float sp = nw > 20.f ? nw : log1pf(__expf(nw));
        const float wl_ = -sp - 0.5f;
        const float decay = __expf(-__expf(wl_));
        float kk = xk * kkw[c];
        const float kss = wsum(kk * kk);
        kk = kk * rsqrtf(fmaxf(kss, 1e-24f));
        const float kmod = xk * (1.0f + (av - 1.0f) * kaw[c]);
        const size_t o = (size_t)t * 512 + c;
        SR[o] = f2bf(xr); SK[o] = f2bf(kmod); SV[o] = f2bf(xv); SA[o] = f2bf(-kk); SB[o] = f2bf(kk * av); SG[o] = f2bf(g); SWD[o] = decay;
        {
            bf16_t* pq = proj + (size_t)t * INW + 1792 + c;
            float q = bf2f(*pq); float ssq = wsum(q * q);
            *pq = f2bf(q * rsqrtf(ssq * (1.0f / 64.0f) + 1e-6f) * qg);
            bf16_t* pk = proj + (size_t)t * INW + 2304 + c;
            float k = bf2f(*pk); ssq = wsum(k * k);
            *pk = f2bf(k * rsqrtf(ssq * (1.0f / 64.0f) + 1e-6f) * kg_);
        }
        __syncthreads();
    }
}

__device__ __forceinline__ void scan_item(const PA a, int l, int bh, LAS unsigned char* lds) {
    const int tid = otid(), wave = tid >> 6, lane = tid & 63;
    const int b = bh >> 3, h = bh & 7;
    const int row = wave * 8 + (lane >> 3), kg = lane & 7;
    LAS float* ybuf = (LAS float*)(lds + 98304);
    const bf16_t* SR = WSP(bf16_t, WS_SR); const bf16_t* SK = WSP(bf16_t, WS_SK); const bf16_t* SV = WSP(bf16_t, WS_SV);
    const bf16_t* SA = WSP(bf16_t, WS_SA); const bf16_t* SB = WSP(bf16_t, WS_SB); const bf16_t* SG = WSP(bf16_t, WS_SG);
    const float* SWD = WSP(float, WS_SWD);
    bf16_t* YC = WSP(bf16_t, WS_YCAT);
    const size_t tok0 = (size_t)b * SEQ;
    const float lw = INP(13)[l * 512 + h * 64 + lane], lb = INP(14)[l * 512 + h * 64 + lane], rk = INP(12)[l * 512 + h * 64 + lane];
    u32x4 pre[4]; f32x4 prew;
    const int q0 = tid & 255, arrsel = tid >> 8;
    const int pstep = q0 >> 3, pc8 = (q0 & 7) * 8;
    const int wstep = tid >> 4, wc4 = (tid & 15) * 4;
#define SCAN_LOAD(cidx) do { const size_t tb = tok0 + (size_t)(cidx) * 32; \
        const size_t o = (tb + pstep) * 512 + h * 64 + pc8; \
        pre[0] = *(const u32x4*)((arrsel ? SK : SA) + o); pre[1] = *(const u32x4*)((arrsel ? SR : SB) + o); \
        if (tid < 256) pre[2] = *(const u32x4*)(SV + o); \
        prew = *(const f32x4*)(SWD + (tb + wstep) * 512 + h * 64 + wc4); } while (0)
#define SCAN_STORE(bufi) do { LAS float* bb = (LAS float*)(lds + (bufi) * 49152); \
        LAS float* d0 = bb + (arrsel ? 2 : 0) * 2048 + pstep * 64 + pc8; LAS float* d1 = bb + (arrsel ? 4 : 3) * 2048 + pstep * 64 + pc8; \
        _Pragma("unroll") for (int j = 0; j < 4; ++j) { d0[2 * j] = lo16(pre[0][j]); d0[2 * j + 1] = hi16(pre[0][j]); d1[2 * j] = lo16(pre[1][j]); d1[2 * j + 1] = hi16(pre[1][j]); } \
        if (tid < 256) { LAS float* d2 = bb + 5 * 2048 + pstep * 64 + pc8; _Pragma("unroll") for (int j = 0; j < 4; ++j) { d2[2 * j] = lo16(pre[2][j]); d2[2 * j + 1] = hi16(pre[2][j]); } } \
        *(LAS f32x4*)(bb + 1 * 2048 + wstep * 64 + wc4) = prew; } while (0)
    float S[8];
#pragma unroll
    for (int j = 0; j < 8; ++j) S[j] = 0.f;
    __syncthreads();
    SCAN_LOAD(0); SCAN_STORE(0);
    __syncthreads();
    for (int ch = 0; ch < SEQ / 32; ++ch) {
        const int cur = ch & 1;
        if (ch + 1 < SEQ / 32) SCAN_LOAD(ch + 1);
        LAS float* bb = (LAS float*)(lds + cur * 49152);
        for (int st = 0; st < 32; ++st) {
            const LAS float* pa = bb + st * 64 + kg * 8;
            const f32x4 a0 = *(const LAS f32x4*)(pa), a1 = *(const LAS f32x4*)(pa + 4);
            const f32x4 w0 = *(const LAS f32x4*)(pa + 2048), w1 = *(const LAS f32x4*)(pa + 2048 + 4);
            const f32x4 k0 = *(const LAS f32x4*)(pa + 4096), k1 = *(const LAS f32x4*)(pa + 4096 + 4);
            const f32x4 b0 = *(const LAS f32x4*)(pa + 6144), b1 = *(const LAS f32x4*)(pa + 6144 + 4);
            const f32x4 r0 = *(const LAS f32x4*)(pa + 8192), r1 = *(const LAS f32x4*)(pa + 8192 + 4);
            const float vv = bb[10240 + st * 64 + row];
            float sa = (S[0] * a0[0] + S[1] * a0[1]) + (S[2] * a0[2] + S[3] * a0[3]) + (S[4] * a1[0] + S[5] * a1[1]) + (S[6] * a1[2] + S[7] * a1[3]);
            sa += __shfl_xor(sa, 1); sa += __shfl_xor(sa, 2); sa += __shfl_xor(sa, 4);
#pragma unroll
            for (int j = 0; j < 4; ++j) {
                S[j] = S[j] * w0[j] + (sa * b0[j] + vv * k0[j]);
                S[4 + j] = S[4 + j] * w1[j] + (sa * b1[j] + vv * k1[j]);
            }
            float y = (S[0] * r0[0] + S[1] * r0[1]) + (S[2] * r0[2] + S[3] * r0[3]) + (S[4] * r1[0] + S[5] * r1[1]) + (S[6] * r1[2] + S[7] * r1[3]);
            y += __shfl_xor(y, 1); y += __shfl_xor(y, 2); y += __shfl_xor(y, 4);
            if (kg == 0) ybuf[st * 64 + row] = y;
        }
        __syncthreads();
#pragma unroll
        for (int s4 = 0; s4 < 4; ++s4) {
            const int st = wave * 4 + s4;
            const size_t t = tok0 + (size_t)ch * 32 + st;
            const float y = ybuf[st * 64 + lane];
            const float mean = wsum(y) * (1.0f / 64.0f);
            const float dlt = y - mean;
            const float var = wsum(dlt * dlt) * (1.0f / 64.0f);
            const float yn = dlt * rsqrtf(var + 64e-5f) * lw + lb;
            const float rr = bb[8192 + st * 64 + lane], kk = bb[4096 + st * 64 + lane], vv = bb[10240 + st * 64 + lane];
            const float bonus = wsum(rr * kk * rk) * vv;
            const float g = bf2f(SG[t * 512 + h * 64 + lane]);
            YC[t * 1024 + h * 64 + lane] = f2bf((yn + bonus) * g);
        }
        if (ch + 1 < SEQ / 32) SCAN_STORE(cur ^ 1);
        __syncthreads();
    }
#undef SCAN_LOAD
#undef SCAN_STORE
}

__device__ __forceinline__ void attn_item(const PA a, int l, int it, LAS unsigned char* lds) {
    const int tid = otid(), h = tid >> 6, i = tid & 63;
    const int b = it >> 5, c = it & 31;
    LAS float* sK = (LAS float*)lds;
    LAS float* sV = sK + 32 * 512;
    LAS float* s_bias = (LAS float*)(lds + LDS_MISC + 1024);
    LAS float* s_part = s_bias + 8 * 320;
    const bf16_t* proj = WSP(const bf16_t, WS_PROJ);
    const size_t t = (size_t)b * SEQ + c * 64 + i;
    float q[64], o[64];
    {
        const u32x4* qp = (const u32x4*)(proj + t * INW + 1792 + h * 64);
#pragma unroll
        for (int d8 = 0; d8 < 8; ++d8) { const u32x4 w = qp[d8];
#pragma unroll
            for (int j = 0; j < 4; ++j) { q[d8 * 8 + 2 * j] = lo16(w[j]) * 0.125f; q[d8 * 8 + 2 * j + 1] = hi16(w[j]) * 0.125f; } }
    }
#pragma unroll
    for (int d = 0; d < 64; ++d) o[d] = 0.f;
    float m = -1e30f, ls = 0.f;
    const int kc0 = c - 8 > 0 ? c - 8 : 0;
    for (int kc = kc0; kc <= c; ++kc) {
        for (int half = 0; half < 2; ++half) {
            __syncthreads();
            const size_t row0 = (size_t)b * SEQ + kc * 64 + half * 32;
#pragma unroll
            for (int i4 = 0; i4 < 4; ++i4) {
                const int p = tid + i4 * 512, r = p >> 6, c8 = (p & 63) * 8;
                const u32x4 wk = *(const u32x4*)(proj + (row0 + r) * INW + 2304 + c8);
                const u32x4 wv = *(const u32x4*)(proj + (row0 + r) * INW + 2816 + c8);
                LAS float* dk = sK + r * 512 + c8; LAS float* dv = sV + r * 512 + c8;
#pragma unroll
                for (int j = 0; j < 4; ++j) { dk[2 * j] = lo16(wk[j]); dk[2 * j + 1] = hi16(wk[j]); dv[2 * j] = lo16(wv[j]); dv[2 * j + 1] = hi16(wv[j]); }
            }
            __syncthreads();
#pragma unroll 1
            for (int j = 0; j < 32; ++j) {
                const LAS float* kp = sK + j * 512 + h * 64;
                float acc = 0.f;
#pragma unroll
                for (int d4 = 0; d4 < 16; ++d4) { const f32x4 kv = *(const LAS f32x4*)(kp + d4 * 4); acc += (q[d4 * 4] * kv[0] + q[d4 * 4 + 1] * kv[1]) + (q[d4 * 4 + 2] * kv[2] + q[d4 * 4 + 3] * kv[3]); }
                int dist = i - (half * 32 + j) + (c - kc) * 64; dist = dist > 256 ? 256 : dist;
                const float sc = acc + s_bias[h * 320 + dist + 63];
                const float mn = fmaxf(m, sc);
                const float alpha = __expf(m - mn), p = __expf(sc - mn);
                m = mn; ls = ls * alpha + p;
                const LAS float* vp = sV + j * 512 + h * 64;
#pragma unroll
                for (int d4 = 0; d4 < 16; ++d4) { const f32x4 vv = *(const LAS f32x4*)(vp + d4 * 4);
                    o[d4 * 4] = o[d4 * 4] * alpha + p * vv[0]; o[d4 * 4 + 1] = o[d4 * 4 + 1] * alpha + p * vv[1]; o[d4 * 4 + 2] = o[d4 * 4 + 2] * alpha + p * vv[2]; o[d4 * 4 + 3] = o[d4 * 4 + 3] * alpha + p * vv[3]; }
            }
        }
    }
    const float inv = 1.0f / ls;
    float ssq = 0.f;
#pragma unroll
    for (int d = 0; d < 64; ++d) { o[d] *= inv; ssq += o[d] * o[d]; }
    s_part[h * 64 + i] = ssq;
    __syncthreads();
    float tot = 0.f;
#pragma unroll
    for (int hh = 0; hh < 8; ++hh) tot += s_part[hh * 64 + i];
    const float rinv = rsqrtf(tot * (1.0f / 512.0f) + 1e-6f);
    bf16_t* yp = WSP(bf16_t, WS_YCAT) + t * 1024 + 512 + h * 64;
#pragma unroll
    for (int d8 = 0; d8 < 8; ++d8) {
        u32x4 w; w.x = pk2(o[d8 * 8] * rinv, o[d8 * 8 + 1] * rinv); w.y = pk2(o[d8 * 8 + 2] * rinv, o[d8 * 8 + 3] * rinv);
        w.z = pk2(o[d8 * 8 + 4] * rinv, o[d8 * 8 + 5] * rinv); w.w = pk2(o[d8 * 8 + 6] * rinv, o[d8 * 8 + 7] * rinv);
        *(u32x4*)(yp + d8 * 8) = w;
    }
    __syncthreads();
}

__device__ __forceinline__ void pc_mixer(const PA a, int l, LAS unsigned char* lds) {
    const int tid = otid();
    LAS float* s_bias = (LAS float*)(lds + LDS_MISC + 1024);
    volatile LAS int* s_item = (volatile LAS int*)(lds + LDS_MISC + 64);
    for (int i = tid; i < 8 * 320; i += 512) s_bias[i] = INP(20)[l * 8 * 320 + i];
    unsigned* qhead = WSP(unsigned, WS_CTL) + CW_QUEUE + l * 64;
    for (;;) {
        __syncthreads();
        if (tid == 0) *s_item = (int)__hip_atomic_fetch_add(qhead, 1u, __ATOMIC_RELAXED, __HIP_MEMORY_SCOPE_AGENT);
        __syncthreads();
        const int item = *s_item;
        if (item >= 128 + 512) break;
        if (item < 128) scan_item(a, l, item, lds);
        else attn_item(a, l, item - 128, lds);
    }
}

__device__ __forceinline__ void pe2_xattn(const PA a, int l, LAS unsigned char* lds) {
    const int tid = otid(), wave = tid >> 6, lane = tid & 63;
    const int h = wave & 3, tg = wave >> 2, tok = lane >> 1, half = lane & 1;
    const bf16_t* QX = WSP(const bf16_t, WS_QX); bf16_t* OX = WSP(bf16_t, WS_OX);
    const bf16_t* KV = WSP(const bf16_t, WS_KV) + (size_t)l * MROWS * 1024;
    const float* qgn = INP(28) + l * 128 + half * 64;
    for (int it = oblk(); it < T / 64; it += ogrid()) {
        const size_t t = (size_t)it * 64 + tg * 32 + tok;
        const int b = (int)(t >> 11);
        float q[64], o[64];
        float ssq = 0.f;
        {
            const u32x4* qp = (const u32x4*)(QX + t * 512 + h * 128 + half * 64);
#pragma unroll
            for (int d8 = 0; d8 < 8; ++d8) { const u32x4 w = qp[d8];
#pragma unroll
                for (int j = 0; j < 4; ++j) { q[d8 * 8 + 2 * j] = lo16(w[j]); q[d8 * 8 + 2 * j + 1] = hi16(w[j]); } }
#pragma unroll
            for (int d = 0; d < 64; ++d) ssq += q[d] * q[d];
            ssq += __shfl_xor(ssq, 1);
            const float rinv = rsqrtf(ssq * (1.0f / 128.0f) + 1e-6f) * 0.08838834764831845f;
#pragma unroll
            for (int d = 0; d < 64; ++d) q[d] = q[d] * rinv * qgn[d];
        }
#pragma unroll
        for (int d = 0; d < 64; ++d) o[d] = 0.f;
        float m = -1e30f, ls = 0.f;
        const bf16_t* kb = KV + (size_t)b * 256 * 1024 + h * 128 + half * 64;
#pragma unroll 1
        for (int j = 0; j < 256; ++j) {
            const u32x4* kp = (const u32x4*)(kb + (size_t)j * 1024);
            float acc = 0.f;
#pragma unroll
            for (int d8 = 0; d8 < 8; ++d8) { const u32x4 w = kp[d8];
#pragma unroll
                for (int jx = 0; jx < 4; ++jx) acc += q[d8 * 8 + 2 * jx] * lo16(w[jx]) + q[d8 * 8 + 2 * jx + 1] * hi16(w[jx]); }
            acc += __shfl_xor(acc, 1);
            const float mn = fmaxf(m, acc);
            const float alpha = __expf(m - mn), p = __expf(acc - mn);
            m = mn; ls = ls * alpha + p;
            const u32x4* vp = (const u32x4*)(kb + (size_t)j * 1024 + 512);
#pragma unroll
            for (int d8 = 0; d8 < 8; ++d8) { const u32x4 w = vp[d8];
#pragma unroll
                for (int jx = 0; jx < 4; ++jx) { o[d8 * 8 + 2 * jx] = o[d8 * 8 + 2 * jx] * alpha + p * lo16(w[jx]); o[d8 * 8 + 2 * jx + 1] = o[d8 * 8 + 2 * jx + 1] * alpha + p * hi16(w[jx]); } }
        }
        const float inv = 1.0f / ls;
        bf16_t* op = OX + t * 512 + h * 128 + half * 64;
#pragma unroll
        for (int d8 = 0; d8 < 8; ++d8) {
            u32x4 w; w.x = pk2(o[d8 * 8] * inv, o[d8 * 8 + 1] * inv); w.y = pk2(o[d8 * 8 + 2] * inv, o[d8 * 8 + 3] * inv);
            w.z = pk2(o[d8 * 8 + 4] * inv, o[d8 * 8 + 5] * inv); w.w = pk2(o[d8 * 8 + 6] * inv, o[d8 * 8 + 7] * inv);
            *(u32x4*)(op + d8 * 8) = w;
        }
    }
}

__device__ __forceinline__ void pf_router(const PA a, int l, LAS unsigned char* lds) {
    const int tid = otid(), wave = tid >> 6, lane = tid & 63;
    LAS float* s_log = (LAS float*)(lds) + wave * 64;
    const float* X = a.out; const float* SS = WSP(const float, WS_SS);
    const float* gn = INP(30) + l * 1024;
    const float* wg = INP(31) + (size_t)l * 1024 * 4; const float* bg = INP(32) + l * 4;
    const float* wr = INP(33) + (size_t)l * 1024 * 32; const float* br = INP(34) + l * 32;
    int* EID = WSP(int, WS_EID); float* EW = WSP(float, WS_EW); int* ERK = WSP(int, WS_ERK);
    unsigned* cnt = WSP(unsigned, WS_CTL) + CW_CNT + l * 32;
    for (int t = oblk() * 8 + wave; t < T; t += ogrid() * 8) {
        float tot = 0.f;
        if (lane < 16) tot = SS[(size_t)t * 16 + lane];
        tot = wsum(tot);
        const float rinv = rsqrtf(tot * (1.0f / 1024.0f) + 1e-6f);
        float acc[36];
#pragma unroll
        for (int n = 0; n < 36; ++n) acc[n] = 0.f;
#pragma unroll
        for (int i = 0; i < 4; ++i) {
            const int k0 = i * 256 + lane * 4;
            const f32x4 xv = *(const f32x4*)(X + (size_t)t * 1024 + k0);
            const f32x4 gv = *(const f32x4*)(gn + k0);
#pragma unroll
            for (int j = 0; j < 4; ++j) {
                const float hx = xv[j] * gv[j];
                const f32x4 g4 = *(const f32x4*)(wg + (size_t)(k0 + j) * 4);
                acc[0] += hx * g4[0]; acc[1] += hx * g4[1]; acc[2] += hx * g4[2]; acc[3] += hx * g4[3];
#pragma unroll
                for (int n4 = 0; n4 < 8; ++n4) { const f32x4 r4 = *(const f32x4*)(wr + (size_t)(k0 + j) * 32 + n4 * 4);
                    acc[4 + n4 * 4] += hx * r4[0]; acc[5 + n4 * 4] += hx * r4[1]; acc[6 + n4 * 4] += hx * r4[2]; acc[7 + n4 * 4] += hx * r4[3]; }
            }
        }
        float mine = 0.f;
#pragma unroll
        for (int n = 0; n < 36; ++n) { const float s = wsum(acc[n]); mine = (lane == n) ? s : mine; }
        if (lane < 36) s_log[lane] = mine * rinv + (lane < 4 ? bg[lane] : br[lane - 4]);
        __builtin_amdgcn_s_waitcnt(0);
        if (lane == 0) {
            float g0 = s_log[0]; int gt = 0;
            for (int i = 1; i < 4; ++i) { const float v = s_log[i]; if (v > g0) { g0 = v; gt = i; } }
            float gs = 0.f; for (int i = 0; i < 4; ++i) gs += __expf(s_log[i] - g0);
            const float ggate = 1.0f / gs;
            float l1 = -1e30f, l2 = -1e30f; int j1 = 0, j2 = 0;
            for (int i = 0; i < 8; ++i) { const float v = s_log[4 + gt * 8 + i];
                if (v > l1) { l2 = l1; j2 = j1; l1 = v; j1 = i; } else if (v > l2) { l2 = v; j2 = i; } }
            const float e2 = __expf(l2 - l1);
            const float p1 = 1.0f / (1.0f + e2), p2 = e2 / (1.0f + e2);
            const int e1i = gt * 8 + j1, e2i = gt * 8 + j2;
            const unsigned r1 = __hip_atomic_fetch_add(cnt + e1i, 1u, __ATOMIC_RELAXED, __HIP_MEMORY_SCOPE_AGENT);
            const unsigned r2 = __hip_atomic_fetch_add(cnt + e2i, 1u, __ATOMIC_RELAXED, __HIP_MEMORY_SCOPE_AGENT);
            EID[t * 2] = e1i; EID[t * 2 + 1] = e2i; EW[t * 2] = ggate * p1; EW[t * 2 + 1] = ggate * p2; ERK[t * 2] = (int)r1; ERK[t * 2 + 1] = (int)r2;
        }
    }
}

__device__ __forceinline__ void pg_gather(const PA a, int l, LAS unsigned char* lds) {
    const int tid = otid(), wave = tid >> 6, lane = tid & 63;
    LAS int* s_ps = (LAS int*)lds;
    const unsigned* cnt = WSP(const unsigned, WS_CTL) + CW_CNT + l * 32;
    int* SSLOT = WSP(int, WS_SSLOT); float* SW = WSP(float, WS_SW); int* MTE = WSP(int, WS_MTE);
    bf16_t* XS = WSP(bf16_t, WS_XS); const bf16_t* XB = WSP(const bf16_t, WS_XB);
    const float* SS = WSP(const float, WS_SS);
    const int* EID = WSP(const int, WS_EID); const float* EW = WSP(const float, WS_EW); const int* ERK = WSP(const int, WS_ERK);
    __syncthreads();
    if (tid == 0) {
        int acc = 0;
        for (int e = 0; e < 32; ++e) { s_ps[e] = acc; const int c = (int)__hip_atomic_load(cnt + e, __ATOMIC_RELAXED, __HIP_MEMORY_SCOPE_AGENT); acc += ((c + 255) >> 8) << 8; }
        s_ps[32] = acc;
    }
    __syncthreads();
    if (oblk() == 0) {
        if (tid < 32) { const int m0 = s_ps[tid] >> 8, m1 = s_ps[tid + 1] >> 8; for (int mt = m0; mt < m1; ++mt) MTE[mt] = tid; }
        if (tid == 0) MTE[511] = s_ps[32] >> 8;
    }
    for (int e = oblk(); e < 32; e += ogrid()) {
        const int c = (int)__hip_atomic_load(cnt + e, __ATOMIC_RELAXED, __HIP_MEMORY_SCOPE_AGENT);
        const int r0 = s_ps[e] + c, r1 = s_ps[e + 1];
        for (int r = r0 + wave; r < r1; r += 8) {
            if (lane == 0) { SSLOT[r] = -1; SW[r] = 0.f; }
            u32x4 z = {0u, 0u, 0u, 0u};
            *(u32x4*)(XS + (size_t)r * 1024 + lane * 8) = z; *(u32x4*)(XS + (size_t)r * 1024 + 512 + lane * 8) = z;
        }
    }
    for (int as = oblk() * 8 + wave; as < 2 * T; as += ogrid() * 8) {
        const int t = as >> 1;
        const int e = EID[as], rk = ERK[as];
        const int dest = s_ps[e] + rk;
        float tot = 0.f;
        if (lane < 16) tot = SS[(size_t)t * 16 + lane];
        tot = wsum(tot);
        const float rinv = rsqrtf(tot * (1.0f / 1024.0f) + 1e-6f);
        if (lane == 0) { SSLOT[dest] = as; SW[dest] = EW[as]; }
#pragma unroll
        for (int i = 0; i < 2; ++i) {
            const u32x4 w = *(const u32x4*)(XB + (size_t)t * 1024 + i * 512 + lane * 8);
            u32x4 o;
#pragma unroll
            for (int j = 0; j < 4; ++j) o[j] = pk2(lo16(w[j]) * rinv, hi16(w[j]) * rinv);
            *(u32x4*)(XS + (size_t)dest * 1024 + i * 512 + lane * 8) = o;
        }
    }
}

__device__ __forceinline__ void pj_finalize(const PA a) {
    const int wave = otid() >> 6, lane = otid() & 63;
    float* X = a.out; bf16_t* XB = WSP(bf16_t, WS_XB); float* SS = WSP(float, WS_SS);
    const bf16_t* Y = WSP(const bf16_t, WS_Y);
    for (int t = oblk() * 8 + wave; t < T; t += ogrid() * 8) {
        float sq = 0.f;
#pragma unroll
        for (int i = 0; i < 4; ++i) {
            const int c = i * 256 + lane * 4;
            f32x4 v = *(const f32x4*)(X + (size_t)t * 1024 + c);
            const u32x2 y0 = *(const u32x2*)(Y + (size_t)(2 * t) * 1024 + c), y1 = *(const u32x2*)(Y + (size_t)(2 * t + 1) * 1024 + c);
            v[0] += lo16(y0.x) + lo16(y1.x); v[1] += hi16(y0.x) + hi16(y1.x); v[2] += lo16(y0.y) + lo16(y1.y); v[3] += hi16(y0.y) + hi16(y1.y);
            *(f32x4*)(X + (size_t)t * 1024 + c) = v;
            u32x2 w; w.x = pk2(v[0], v[1]); w.y = pk2(v[2], v[3]);
            *(u32x2*)(XB + (size_t)t * 1024 + c) = w;
            sq += (v[0] * v[0] + v[1] * v[1]) + (v[2] * v[2] + v[3] * v[3]);
        }
        sq = wsum(sq);
        if (lane < 16) SS[(size_t)t * 16 + lane] = (lane == 0) ? sq : 0.f;
    }
}

#define SITE static __device__ __forceinline__ void
#define OPAQUE() do { asm volatile("" : "+s"(a.ws), "+s"(a.out)); } while (0)
__device__ __forceinline__ int opq(int v) { asm volatile("" : "+s"(v)); return v; }
SITE site_p0(PA a, LAS unsigned char* lds) { OPAQUE(); p0_prologue(a, lds); }
SITE site_kv(PA a, LAS unsigned char* lds) { OPAQUE();
    pg8::Gemm g{WSP(const bf16_t, WS_MEMB), WSP(const bf16_t, WS_WKV), 1024, (size_t)1024 * 1024};
    pg8::KvOrder S{opq((int)gridDim.x), opq((int)blockIdx.x)};
    pg8::EpiScale E{WSP(bf16_t, WS_KV), 1024, WSP(const float, WS_MEMSS), MROWS - 1};
    pg8::gemm_phase<pg8::EpiScale, pg8::KvOrder>(lds, g, S, E);
}
SITE site_knorm(PA a, LAS unsigned char* lds) { OPAQUE(); p2_knorm(a, lds); }
SITE site_inproj(PA a, int l, LAS unsigned char* lds) { OPAQUE();
    pg8::Gemm g{WSP(const bf16_t, WS_XB), WSP(const bf16_t, WS_WIN) + (size_t)l * INW * 1024, 1024, 0};
    pg8::StaticOrder S; S.init(T, INW, opq((int)gridDim.x), opq((int)blockIdx.x));
    pg8::EpiScale E{WSP(bf16_t, WS_PROJ), INW, WSP(const float, WS_SS), T - 1};
    pg8::gemm_phase<pg8::EpiScale, pg8::StaticOrder>(lds, g, S, E);
}
SITE site_prep(PA a, int l, LAS unsigned char* lds) { OPAQUE();
    if (l > 0) moe_convert(a, l, lds);
    __syncthreads();
    pb_prep(a, l, lds);
}
SITE site_mixer(PA a, int l, LAS unsigned char* lds) { OPAQUE(); pc_mixer(a, l, lds); }
SITE site_outproj(PA a, int l, LAS unsigned char* lds) { OPAQUE();
    pg8::Gemm g{WSP(const bf16_t, WS_YCAT), WSP(const bf16_t, WS_WOUT) + (size_t)l * 1024 * 1024, 1024, 0};
    pg8::StaticOrder S; S.init(T, 1024, opq((int)gridDim.x), opq((int)blockIdx.x));
    pg8::EpiRes E{a.out, WSP(bf16_t, WS_XB), WSP(float, WS_SS)};
    pg8::gemm_phase<pg8::EpiRes, pg8::StaticOrder>(lds, g, S, E);
}
SITE site_xq(PA a, int l, LAS unsigned char* lds) { OPAQUE();
    pg8::Gemm g{WSP(const bf16_t, WS_XB), WSP(const bf16_t, WS_WQ) + (size_t)l * 512 * 1024, 1024, 0};
    pg8::StaticOrder S; S.init(T, 512, opq((int)gridDim.x), opq((int)blockIdx.x));
    pg8::EpiScale E{WSP(bf16_t, WS_QX), 512, WSP(const float, WS_SS), T - 1};
    pg8::gemm_phase<pg8::EpiScale, pg8::StaticOrder>(lds, g, S, E);
}
SITE site_xattn(PA a, int l, LAS unsigned char* lds) { OPAQUE(); pe2_xattn(a, l, lds); }
SITE site_xo(PA a, int l, LAS unsigned char* lds) { OPAQUE();
    pg8::Gemm g{WSP(const bf16_t, WS_OX), WSP(const bf16_t, WS_WO) + (size_t)l * 1024 * 512, 512, 0};
    pg8::StaticOrder S; S.init(T, 1024, opq((int)gridDim.x), opq((int)blockIdx.x));
    pg8::EpiRes E{a.out, WSP(bf16_t, WS_XB), WSP(float, WS_SS)};
    pg8::gemm_phase<pg8::EpiRes, pg8::StaticOrder>(lds, g, S, E);
}
SITE site_router(PA a, int l, LAS unsigned char* lds) { OPAQUE(); pf_router(a, l, lds); }
SITE site_gather(PA a, int l, LAS unsigned char* lds) { OPAQUE(); pg_gather(a, l, lds); }
SITE site_gu(PA a, LAS unsigned char* lds) { OPAQUE();
    pg8::Gemm g{WSP(const bf16_t, WS_XS), WSP(const bf16_t, WS_WGU), 1024, (size_t)1024 * 1024};
    pg8::MoeOrder S{WSP(const int, WS_MTE), opq((int)gridDim.x), opq((int)blockIdx.x)};
    pg8::EpiGU E{WSP(bf16_t, WS_HB)};
    pg8::gemm_phase<pg8::EpiGU, pg8::MoeOrder>(lds, g, S, E);
}
SITE site_down(PA a, LAS unsigned char* lds) { OPAQUE();
    pg8::Gemm g{WSP(const bf16_t, WS_HB), WSP(const bf16_t, WS_WD), 512, (size_t)1024 * 512};
    pg8::MoeOrder S{WSP(const int, WS_MTE), opq((int)gridDim.x), opq((int)blockIdx.x)};
    pg8::EpiDown E{WSP(bf16_t, WS_Y), WSP(const int, WS_SSLOT), WSP(const float, WS_SW)};
    pg8::gemm_phase<pg8::EpiDown, pg8::MoeOrder>(lds, g, S, E);
}
SITE site_final(PA a, LAS unsigned char* lds) { OPAQUE(); pj_finalize(a); }

__global__ void __launch_bounds__(512, 2) mk_fwd(Args args) {
    extern __shared__ __attribute__((aligned(16))) unsigned char lds_raw[];
    LAS unsigned char* lds = (LAS unsigned char*)lds_raw;
    const int tid = threadIdx.x;
    const int lo = args.ph_lo, hi = args.ph_hi;
    PA a; a.out = args.out; a.ws = args.ws;
    if (tid < 16) ((LAS unsigned*)(lds + LDS_MISC))[tid] = 0u;
    if (tid == 64) {
        LAS unsigned long long* tab = (LAS unsigned long long*)(lds + LDS_INTAB);
#pragma unroll
        for (int i = 0; i < 38; ++i) tab[i] = (unsigned long long)args.in[i];
    }
    __syncthreads();
    XcdBarrier bar; bar.bar = WSP(unsigned, WS_CTL) + CW_BAR; bar.x = 0; bar.st = nullptr;
    if (!MK_PER_PHASE) bar = xcd_barrier_post(WSP(unsigned, WS_CTL) + CW_BAR, (volatile LAS unsigned*)(lds + LDS_MISC));
#define IN(k) (lo <= (k) && (k) < hi)
#define GRID_BAR() do { if (!MK_PER_PHASE) xcd_barrier(bar); } while (0)
    if (IN(0)) { site_p0(a, lds); GRID_BAR(); }
    if (IN(1)) { site_kv(a, lds); GRID_BAR(); }
    if (IN(2)) { site_knorm(a, lds); GRID_BAR(); }
    for (int l = 0; l < NL; ++l) {
        const int pb = 3 + 12 * l;
        if (IN(pb + 0)) { site_inproj(a, l, lds); GRID_BAR(); }
        if (IN(pb + 1)) { site_prep(a, l, lds); GRID_BAR(); }
        if (IN(pb + 2)) { site_mixer(a, l, lds); GRID_BAR(); }
        if (IN(pb + 3)) { site_outproj(a, l, lds); GRID_BAR(); }
        if (IN(pb + 4)) { site_xq(a, l, lds); GRID_BAR(); }
        if (IN(pb + 5)) { site_xattn(a, l, lds); GRID_BAR(); }
        if (IN(pb + 6)) { site_xo(a, l, lds); GRID_BAR(); }
        if (IN(pb + 7)) { site_router(a, l, lds); GRID_BAR(); }
        if (IN(pb + 8)) { site_gather(a, l, lds); GRID_BAR(); }
        if (IN(pb + 9)) { site_gu(a, lds); GRID_BAR(); }
        if (IN(pb + 10)) { site_down(a, lds); GRID_BAR(); }
        if (IN(pb + 11)) { site_final(a, lds); if (l + 1 < NL) GRID_BAR(); }
    }
#undef IN
#undef GRID_BAR
}

extern "C" void kernel_launch(void* const* d_in, const int* in_sizes, int n_in, void* d_out, int out_size, void* d_ws, size_t ws_size, hipStream_t stream) {
    static int grid = 0;
    if (grid == 0) {
        if (n_in != 38 || out_size != T * D || ws_size < WS_END) { fprintf(stderr, "kernel_launch: unexpected shapes (n_in %d out %d ws %zu need %zu)\n", n_in, out_size, ws_size, (size_t)WS_END); grid = -1; return; }
        int dev = 0, cus = 0, per_cu = 0;
        if (hipGetDevice(&dev) != hipSuccess || hipDeviceGetAttribute(&cus, hipDeviceAttributeMultiprocessorCount, dev) != hipSuccess) { grid = -1; return; }
        if (hipFuncSetAttribute((const void*)mk_fwd, hipFuncAttributeMaxDynamicSharedMemorySize, LDS_BYTES) != hipSuccess) { fprintf(stderr, "kernel_launch: hipFuncSetAttribute failed\n"); grid = -1; return; }
        if (hipOccupancyMaxActiveBlocksPerMultiprocessor(&per_cu, (const void*)mk_fwd, 512, LDS_BYTES) != hipSuccess || per_cu < 1) { fprintf(stderr, "kernel_launch: occupancy query says %d\n", per_cu); }
        (void)hipGetLastError();
        grid = cus;
    }
    if (grid < 0) return;
    (void)hipMemsetAsync((char*)d_ws + WS_CTL, 0, CTL_BYTES, stream);
    Args a{};
    for (int i = 0; i < 38; ++i) a.in[i] = (const float*)d_in[i];
    a.out = (float*)d_out; a.ws = (unsigned char*)d_ws;
#if MK_PER_PHASE
    for (int p = 0; p < NPH; ++p) { a.ph_lo = p; a.ph_hi = p + 1; hipLaunchKernelGGL(mk_fwd, dim3(grid), dim3(512), LDS_BYTES, stream, a); }
#else
    a.ph_lo = 0; a.ph_hi = NPH;
    hipLaunchKernelGGL(mk_fwd, dim3(grid), dim3(512), LDS_BYTES, stream, a);
#endif
}
```

```cpp
#include <hip/hip_runtime.h>
#include <cstdio>
#include <cstdint>

#ifndef MK_PER_PHASE
#define MK_PER_PHASE 0
#endif

#define LAS __attribute__((address_space(3)))
typedef unsigned short bf16_t;
typedef short bf16x8 __attribute__((ext_vector_type(8)));
typedef float f32x4 __attribute__((ext_vector_type(4)));
typedef unsigned u32x4 __attribute__((ext_vector_type(4)));
typedef unsigned u32x2 __attribute__((ext_vector_type(2)));

constexpr int T = 32768, D = 1024, SEQ = 2048, NL = 4;
constexpr int INW = 3328;
constexpr int MROWS = 4096;
constexpr int MAXROWS = 73728, MAXMT = 288;
constexpr int NPH = 3 + 12 * NL;

constexpr size_t WS_CTL   = 0;
constexpr size_t CTL_BYTES = 65536;
constexpr size_t WS_WIN   = WS_CTL + CTL_BYTES;
constexpr size_t WS_WOUT  = WS_WIN  + (size_t)4 * 3328 * 1024 * 2;
constexpr size_t WS_WQ    = WS_WOUT + (size_t)4 * 1024 * 1024 * 2;
constexpr size_t WS_WKV   = WS_WQ   + (size_t)4 * 512 * 1024 * 2;
constexpr size_t WS_WO    = WS_WKV  + (size_t)4 * 1024 * 1024 * 2;
constexpr size_t WS_WGU   = WS_WO   + (size_t)4 * 1024 * 512 * 2;
constexpr size_t WS_WD    = WS_WGU  + (size_t)32 * 1024 * 1024 * 2;
constexpr size_t WS_KV    = WS_WD   + (size_t)32 * 1024 * 512 * 2;
constexpr size_t WS_MEMB  = WS_KV   + (size_t)4 * 4096 * 1024 * 2;
constexpr size_t WS_MEMSS = WS_MEMB + (size_t)4096 * 1024 * 2;
constexpr size_t WS_VTX   = WS_MEMSS + (size_t)4096 * 16 * 4;
constexpr size_t WS_XB    = WS_VTX  + (size_t)4 * 4096 * 512 * 2;
constexpr size_t WS_SS    = WS_XB   + (size_t)T * 1024 * 2;
constexpr size_t WS_VF    = WS_SS   + (size_t)T * 16 * 4;
constexpr size_t WS_EID   = WS_VF   + (size_t)T * 512 * 2;
constexpr size_t WS_EW    = WS_EID  + (size_t)T * 2 * 4;
constexpr size_t WS_ERK   = WS_EW   + (size_t)T * 2 * 4;
constexpr size_t WS_SSLOT = WS_ERK  + (size_t)T * 2 * 4;
constexpr size_t WS_SW    = WS_SSLOT + (size_t)MAXROWS * 4;
constexpr size_t WS_MTE   = WS_SW   + (size_t)MAXROWS * 4;
constexpr size_t WS_U     = WS_MTE  + 2048;
constexpr size_t WS_PROJ  = WS_U;
constexpr size_t WS_SR    = WS_PROJ + (size_t)T * 3328 * 2;
constexpr size_t WS_SK    = WS_SR   + (size_t)T * 512 * 2;
constexpr size_t WS_SV    = WS_SK   + (size_t)T * 512 * 2;
constexpr size_t WS_SA    = WS_SV   + (size_t)T * 512 * 2;
constexpr size_t WS_SB    = WS_SA   + (size_t)T * 512 * 2;
constexpr size_t WS_SG    = WS_SB   + (size_t)T * 512 * 2;
constexpr size_t WS_SWD   = WS_SG   + (size_t)T * 512 * 2;
constexpr size_t WS_YCAT  = WS_SWD  + (size_t)T * 512 * 4;
constexpr size_t WS_VT    = WS_YCAT + (size_t)T * 1024 * 2;
constexpr size_t WS_UEND1 = WS_VT   + (size_t)T * 512 * 2;
constexpr size_t WS_QX    = WS_U;
constexpr size_t WS_OX    = WS_QX   + (size_t)T * 512 * 2;
constexpr size_t WS_XS    = WS_U;
constexpr size_t WS_HB    = WS_XS   + (size_t)MAXROWS * 1024 * 2;
constexpr size_t WS_Y     = WS_HB   + (size_t)MAXROWS * 512 * 2;
constexpr size_t WS_UEND2 = WS_Y    + (size_t)2 * T * 1024 * 2;
constexpr size_t WS_END   = WS_UEND1 > WS_UEND2 ? WS_UEND1 : WS_UEND2;

constexpr int CW_BAR = 0;
constexpr int CW_CNT = 4096;
constexpr int CW_QUEUE = 4096 + 256;

constexpr int LDS_MISC = 139264;
constexpr int LDS_BYTES = LDS_MISC + 16384;

struct Args { const float* in[38]; float* out; unsigned char* ws; int ph_lo, ph_hi; };
struct PA { float* out; unsigned char* ws; };

__device__ __forceinline__ float bf2f(bf16_t b) { return __uint_as_float(((unsigned)b) << 16); }
__device__ __forceinline__ bf16_t f2bf(float f) { unsigned u = __float_as_uint(f); u += 0x7FFFu + ((u >> 16) & 1u); return (bf16_t)(u >> 16); }
typedef __bf16 bf16v2 __attribute__((ext_vector_type(2)));
typedef float f32x2 __attribute__((ext_vector_type(2)));
__device__ __forceinline__ unsigned pk2(float lo, float hi) { f32x2 v = {lo, hi}; bf16v2 b = __builtin_convertvector(v, bf16v2); return __builtin_bit_cast(unsigned, b); }
__device__ __forceinline__ float lo16(unsigned u) { return __uint_as_float(u << 16); }
__device__ __forceinline__ float hi16(unsigned u) { return __uint_as_float(u & 0xffff0000u); }
__device__ __forceinline__ float wsum(float v) {
#pragma unroll
    for (int o = 32; o; o >>= 1) v += __shfl_xor(v, o);
    return v;
}
__device__ __forceinline__ float sigmoidf_(float x) { return 1.0f / (1.0f + __expf(-x)); }

#define XB_TMO      128
#define XB_XCNT(j)  (256  + 64 * (j))
#define XB_XSUB(j)  (1280 + 64 * (j))
#define XB_XGEN(j)  (2304 + 64 * (j))
#define XB_TOP      3328
#define XB_TOPGEN   3392
#define XCD_BAR_WORDS 3456
#define XB_SPIN_CAP (1u << 22)

__device__ __forceinline__ unsigned xb_ld(unsigned* p)              { return __hip_atomic_load(p, __ATOMIC_RELAXED, __HIP_MEMORY_SCOPE_AGENT); }
__device__ __forceinline__ unsigned xb_add(unsigned* p, unsigned v) { return __hip_atomic_fetch_add(p, v, __ATOMIC_RELAXED, __HIP_MEMORY_SCOPE_AGENT); }
__device__ __forceinline__ unsigned xb_xcc_id() { return (unsigned)__builtin_amdgcn_s_getreg((3 << 11) | 20) & 0xFu; }
#define XB_SPIN(cond, bar) do { unsigned _sp = 0; while (cond) { __builtin_amdgcn_s_sleep(1); \
    if ((++_sp & 255u) == 0u) { if (xb_ld(&(bar)[XB_TMO])) break; if (_sp > XB_SPIN_CAP) { atomicAdd(&(bar)[XB_TMO], 1u); break; } } } } while (0)

struct XcdBarrier { unsigned* bar; unsigned x; volatile LAS unsigned* st; };

__device__ __forceinline__ XcdBarrier xcd_barrier_post(unsigned* bar, volatile LAS unsigned* st) {
    XcdBarrier b; b.bar = bar; b.x = xb_xcc_id(); b.st = st;
    if (threadIdx.x == 0) (void)xb_add(&bar[XB_XCNT(b.x)], 1u);
    return b;
}
__device__ __forceinline__ void xcd_barrier_complete(unsigned* bar, unsigned x, unsigned& nloc, unsigned& nx) {
    const unsigned G = gridDim.x * gridDim.y * gridDim.z;
    unsigned sum, cnt, mine, sp = 0u;
    for (;;) {
        sum = 0u; cnt = 0u; mine = 0u;
#pragma unroll
        for (unsigned j = 0; j < 16; ++j) { const unsigned c = xb_ld(&bar[XB_XCNT(j)]); sum += c; cnt += (c > 0u) ? 1u : 0u; mine = (j == x) ? c : mine; }
        if (sum == G) break;
        __builtin_amdgcn_s_sleep(1);
        if ((++sp & 255u) == 0u) { if (xb_ld(&bar[XB_TMO])) break; if (sp > XB_SPIN_CAP) { atomicAdd(&bar[XB_TMO], 1u); break; } }
    }
    nloc = mine > 0u ? mine : 1u; nx = cnt > 0u ? cnt : 1u;
}
__device__ __forceinline__ void xcd_barrier(const XcdBarrier& b) {
    asm volatile("s_waitcnt vmcnt(0)" ::: "memory");
    __syncthreads();
    if (threadIdx.x == 0) {
        unsigned* bar = b.bar;
        __builtin_amdgcn_s_waitcnt(0);
        unsigned nloc = b.st[0], nx = b.st[1];
        if (nloc == 0u) { xcd_barrier_complete(bar, b.x, nloc, nx); b.st[0] = nloc; b.st[1] = nx; }
        const unsigned old = xb_add(&bar[XB_XSUB(b.x)], 1u);
        const unsigned gen = old / nloc;
        if (old + 1u == (gen + 1u) * nloc) {
            __builtin_amdgcn_fence(__ATOMIC_RELEASE, "agent");
            asm volatile("s_waitcnt vmcnt(0)" ::: "memory");
            const unsigned og = xb_add(&bar[XB_TOP], 1u);
            const unsigned tg = og / nx;
            if (og + 1u == (tg + 1u) * nx) xb_add(&bar[XB_TOPGEN], 1u);
            else XB_SPIN(xb_ld(&bar[XB_TOPGEN]) == tg, bar);
            __builtin_amdgcn_fence(__ATOMIC_ACQUIRE, "agent");
            xb_add(&bar[XB_XGEN(b.x)], 1u);
            asm volatile("s_waitcnt vmcnt(0)" ::: "memory");
        } else {
            XB_SPIN(xb_ld(&bar[XB_XGEN(b.x)]) == gen, bar);
            __builtin_amdgcn_fence(__ATOMIC_ACQUIRE, "agent");
            asm volatile("s_waitcnt vmcnt(0)" ::: "memory");
        }
    }
    __syncthreads();
}

namespace pg8 {
constexpr int BM = 256, BK = 64, HALF = 128, HTB = HALF * BK * 2, STAGE_BYTES = 8 * HTB, NXCD = 8, WGM = 8;
__host__ __device__ __forceinline__ int lds_byte(int r, int c) { const int st = (r >> 4) * 2 + (c >> 5), rr = r & 15, cc = c & 31, ob = rr * 64 + cc * 2; return st * 1024 + (ob ^ (((ob >> 9) & 1) << 5)); }
__host__ __device__ __forceinline__ void stage_rc(int b, int& R, int& C) { const int st = b / 1024, sb = b % 1024, swz = sb ^ (((sb >> 9) & 1) << 5); R = (st >> 1) * 16 + swz / 64; C = (st & 1) * 32 + (swz % 64) / 2; }
__host__ __device__ __forceinline__ int perm32(int rho) { const int n = rho >> 4, i = rho & 15; return 8 * (i >> 2) + 4 * n + (i & 3); }

struct Unit { int pm, pn, pa, z; };
struct Gemm { const bf16_t* A; const bf16_t* Bt; int K; size_t bz_stride; };

struct StaticOrder {
    int nM, nN, nwg, G, c;
    __device__ void init(int M, int N, int G_, int c_) { nM = M / BM; nN = N / BM; nwg = nM * nN; G = G_; c = c_; }
    __device__ bool next(int i, Unit& u) const {
        const long L = (long)i * G + c; if (L >= nwg) return false;
        int wgid = (int)L; { const int q = nwg / NXCD, r = nwg % NXCD, xcd = wgid % NXCD, off = wgid / NXCD; wgid = (xcd < r ? xcd * (q + 1) : r * (q + 1) + (xcd - r) * q) + off; }
        const int nig = WGM * nN, gid = wgid / nig, fm = gid * WGM, gsz = (nM - fm) < WGM ? (nM - fm) : WGM;
        u.pm = fm + ((wgid % nig) % gsz); u.pn = (wgid % nig) / gsz; u.pa = u.pm; u.z = 0; return true;
    }
};
struct KvOrder {
    int G, c;
    __device__ bool next(int i, Unit& u) const {
        const int L = i * G + c; if (L >= 256) return false;
        u.z = L >> 6; const int r = L & 63; u.pa = r >> 2; u.pn = r & 3; u.pm = u.z * 16 + u.pa; return true;
    }
};
struct MoeOrder {
    const int* mte; int G, c;
    __device__ bool next(int i, Unit& u) const {
        const int nunits = mte[511] * 4;
        const int L = i * G + c; if (L >= nunits) return false;
        u.pm = L >> 2; u.pa = u.pm; u.pn = L & 3; u.z = mte[u.pm]; return true;
    }
};

template <class Epi, class Sched, bool ALIGN_EPI = true>
__device__ __forceinline__ void gemm_phase(LAS unsigned char* lds, const Gemm g, const Sched& S, const Epi& E) {
    int tid_ = threadIdx.x; asm volatile("" : "+v"(tid_));
    const int tid = tid_, wid = __builtin_amdgcn_readfirstlane(tid >> 6), lane = tid & 63, wr = wid >> 2, wc = wid & 3, fr = lane & 15, fq = lane >> 4;
    const int K = g.K, nt = K / BK;
    unsigned voffA[2], voffB[2];
#pragma unroll
    for (int i = 0; i < 2; ++i) { int R, C; stage_rc(tid * 16 + i * 8192, R, C); const int Rb = ((R & ~31) + perm32(R & 31));
        voffA[i] = (unsigned)(R * K + C) * 2u; voffB[i] = (unsigned)(Rb * K + C) * 2u; }
    const size_t kstep = (size_t)(BK * 2);
    const size_t hstep = (size_t)HALF * K * 2;
    const size_t tstep = 2 * hstep;
    const unsigned ldsw = (unsigned)wid * 1024u;
    const int aoff = lds_byte(wr * 64 + fr, fq * 8), boff = lds_byte(wc * 32 + fr, fq * 8);
#define PG8_SA(b, h) (((b) * 2 + (h)) * HTB)
#define PG8_SB(b, h) ((4 + (b) * 2 + (h)) * HTB)
#define PG8_STAGE(bufoff, gbase, voff) do { _Pragma("unroll") for (int _i = 0; _i < 2; ++_i) \
        __builtin_amdgcn_global_load_lds((const unsigned*)((const char*)(gbase) + (voff)[_i]), (LAS unsigned*)(lds + (bufoff) + ldsw + _i * 8192), 16, 0, 0); } while (0)
#define PG8_LDA(dst, b, h) do { _Pragma("unroll") for (int m = 0; m < 4; ++m) _Pragma("unroll") for (int k = 0; k < 2; ++k) dst[m][k] = *(const LAS bf16x8*)(lds + PG8_SA(b, h) + aoff + m * 2048 + k * 1024); } while (0)
#define PG8_LDB(dst, b, h) do { _Pragma("unroll") for (int n = 0; n < 2; ++n) _Pragma("unroll") for (int k = 0; k < 2; ++k) dst[n][k] = *(const LAS bf16x8*)(lds + PG8_SB(b, h) + boff + n * 2048 + k * 1024); } while (0)
#define PG8_MMA(ai, bj, At, Bt) do { __builtin_amdgcn_s_setprio(1); _Pragma("unroll") for (int m = 0; m < 4; ++m) _Pragma("unroll") for (int n = 0; n < 2; ++n) _Pragma("unroll") for (int k = 0; k < 2; ++k) \
        acc[ai][bj][m][n] = __builtin_amdgcn_mfma_f32_16x16x32_bf16(Bt[n][k], At[m][k], acc[ai][bj][m][n], 0, 0, 0); __builtin_amdgcn_s_setprio(0); } while (0)
#define PG8_WAIT_V(n) asm volatile("s_waitcnt vmcnt(" #n ")" ::: "memory")
#define PG8_WAIT_L(n) asm volatile("s_waitcnt lgkmcnt(" #n ")" ::: "memory")
#define PG8_BAR __builtin_amdgcn_s_barrier()
#define PG8_SCHED __builtin_amdgcn_sched_barrier(0)
#define PG8_APTR(u) ((const char*)g.A + (size_t)(u).pa * tstep)
#define PG8_BPTR(u) ((const char*)g.Bt + ((size_t)(u).z * g.bz_stride) * 2 + (size_t)(u).pn * tstep)
    Unit cur, nxt; int ui = 0;
    if (!S.next(0, cur)) return;
    f32x4 acc[2][2][4][2];
#pragma unroll
    for (int a = 0; a < 2; ++a)
#pragma unroll
        for (int b = 0; b < 2; ++b)
#pragma unroll
            for (int m = 0; m < 4; ++m)
#pragma unroll
                for (int n = 0; n < 2; ++n) acc[a][b][m][n] = (f32x4){0.f, 0.f, 0.f, 0.f};
    bf16x8 At[4][2], B0[2][2], B1[2][2];
    const char* cA = PG8_APTR(cur); const char* cB = PG8_BPTR(cur);
    PG8_STAGE(PG8_SB(0, 0), cB, voffB); PG8_STAGE(PG8_SB(0, 1), cB + hstep, voffB); PG8_STAGE(PG8_SA(0, 0), cA, voffA); PG8_STAGE(PG8_SA(0, 1), cA + hstep, voffA);
    if (wr == 1) PG8_BAR;
    PG8_WAIT_V(2); PG8_BAR;
    PG8_STAGE(PG8_SB(1, 0), cB + kstep, voffB); PG8_STAGE(PG8_SA(1, 0), cA + kstep, voffA); PG8_STAGE(PG8_SB(1, 1), cB + hstep + kstep, voffB);
    PG8_WAIT_V(6); PG8_BAR;
    for (;;) {
        const bool has_next = S.next(ui + 1, nxt);
        const char* nA = has_next ? PG8_APTR(nxt) : cA; const char* nB = has_next ? PG8_BPTR(nxt) : cB;
        for (int t = 0; t < nt; t += 2) {
            const bool last = (t == nt - 2);
            const char* a1 = cA + (size_t)(t + 1) * kstep;
            const char* a2 = last ? nA : cA + (size_t)(t + 2) * kstep; const char* b2 = last ? nB : cB + (size_t)(t + 2) * kstep;
            const char* a3 = a2 + kstep; const char* b3 = b2 + kstep;
            PG8_LDB(B0, 0, 0); PG8_LDB(B1, 0, 1); PG8_SCHED; PG8_LDA(At, 0, 0); PG8_STAGE(PG8_SA(1, 1), a1 + hstep, voffA);
            PG8_WAIT_V(8); PG8_WAIT_L(0); PG8_BAR; PG8_MMA(0, 0, At, B0); PG8_MMA(0, 1, At, B1); PG8_BAR; PG8_SCHED;
            PG8_LDA(At, 0, 1); PG8_STAGE(PG8_SB(0, 0), b2, voffB); PG8_STAGE(PG8_SB(0, 1), b2 + hstep, voffB); PG8_STAGE(PG8_SA(0, 0), a2, voffA);
            PG8_WAIT_V(8); PG8_WAIT_L(0); PG8_BAR; PG8_MMA(1, 0, At, B0); PG8_MMA(1, 1, At, B1); PG8_BAR; PG8_SCHED;
            PG8_LDB(B0, 1, 0); PG8_LDB(B1, 1, 1); PG8_SCHED; PG8_LDA(At, 1, 0); PG8_STAGE(PG8_SA(0, 1), a2 + hstep, voffA);
            PG8_WAIT_V(8); PG8_WAIT_L(0); PG8_BAR; PG8_MMA(0, 0, At, B0); PG8_MMA(0, 1, At, B1); PG8_BAR; PG8_SCHED;
            PG8_LDA(At, 1, 1); PG8_STAGE(PG8_SB(1, 0), b3, voffB); PG8_STAGE(PG8_SB(1, 1), b3 + hstep, voffB); PG8_STAGE(PG8_SA(1, 0), a3, voffA);
            PG8_WAIT_V(8); PG8_WAIT_L(0); PG8_BAR; PG8_MMA(1, 0, At, B0); PG8_MMA(1, 1, At, B1); PG8_BAR; PG8_SCHED;
        }
        if constexpr (ALIGN_EPI) { if (wr == 0) PG8_BAR; }
        E(acc, cur, wr, wc, fr, fq);
        if (!has_next) break;
#pragma unroll
        for (int a = 0; a < 2; ++a)
#pragma unroll
            for (int b = 0; b < 2; ++b)
#pragma unroll
                for (int m = 0; m < 4; ++m)
#pragma unroll
                    for (int n = 0; n < 2; ++n) acc[a][b][m][n] = (f32x4){0.f, 0.f, 0.f, 0.f};
        cur = nxt; cA = nA; cB = nB; ++ui;
        if constexpr (ALIGN_EPI) { if (wr == 1) PG8_BAR; }
    }
    PG8_WAIT_V(0);
    if constexpr (!ALIGN_EPI) { if (wr == 0) PG8_BAR; }
    PG8_BAR;
#undef PG8_SA
#undef PG8_SB
#undef PG8_STAGE
#undef PG8_LDA
#undef PG8_LDB
#undef PG8_MMA
#undef PG8_WAIT_V
#undef PG8_WAIT_L
#undef PG8_BAR
#undef PG8_SCHED
#undef PG8_APTR
#undef PG8_BPTR
}

typedef const f32x4 (&AccRef)[2][2][4][2];

struct EpiScale {
    bf16_t* O; int ldc; const float* ss; int ssmask;
    __device__ __forceinline__ void operator()(AccRef acc, const Unit& u, int wr, int wc, int fr, int fq) const {
#pragma unroll
        for (int ai = 0; ai < 2; ++ai)
#pragma unroll
            for (int m = 0; m < 4; ++m) {
                const int row = u.pm * 256 + ai * 128 + wr * 64 + m * 16 + fr;
                const f32x4* sp = (const f32x4*)(ss + (size_t)(row & ssmask) * 16);
                const f32x4 s0 = sp[0], s1 = sp[1], s2 = sp[2], s3 = sp[3];
                const float tot = ((s0[0] + s0[1]) + (s0[2] + s0[3])) + ((s1[0] + s1[1]) + (s1[2] + s1[3])) + ((s2[0] + s2[1]) + (s2[2] + s2[3])) + ((s3[0] + s3[1]) + (s3[2] + s3[3]));
                const float rinv = rsqrtf(tot * (1.0f / 1024.0f) + 1e-6f);
#pragma unroll
                for (int bj = 0; bj < 2; ++bj) {
                    const int col = u.pn * 256 + bj * 128 + wc * 32 + 8 * fq;
                    const f32x4 v0 = acc[ai][bj][m][0] * rinv, v1 = acc[ai][bj][m][1] * rinv;
                    u32x4 w; w.x = pk2(v0[0], v0[1]); w.y = pk2(v0[2], v0[3]); w.z = pk2(v1[0], v1[1]); w.w = pk2(v1[2], v1[3]);
                    *(u32x4*)(O + (size_t)row * ldc + col) = w;
                }
            }
    }
};
struct EpiProj {
    bf16_t* O; bf16_t* VT; const float* ss;
    __device__ __forceinline__ void operator()(AccRef acc, const Unit& u, int wr, int wc, int fr, int fq) const {
#pragma unroll
        for (int ai = 0; ai < 2; ++ai)
#pragma unroll
            for (int m = 0; m < 4; ++m) {
                const int row = u.pm * 256 + ai * 128 + wr * 64 + m * 16 + fr;
                const f32x4* sp = (const f32x4*)(ss + (size_t)row * 16);
                const f32x4 s0 = sp[0], s1 = sp[1], s2 = sp[2], s3 = sp[3];
                const float tot = ((s0[0] + s0[1]) + (s0[2] + s0[3])) + ((s1[0] + s1[1]) + (s1[2] + s1[3])) + ((s2[0] + s2[1]) + (s2[2] + s2[3])) + ((s3[0] + s3[1]) + (s3[2] + s3[3]));
                const float rinv = rsqrtf(tot * (1.0f / 1024.0f) + 1e-6f);
#pragma unroll
                for (int bj = 0; bj < 2; ++bj) {
                    const int col = u.pn * 256 + bj * 128 + wc * 32 + 8 * fq;
                    const f32x4 v0 = acc[ai][bj][m][0] * rinv, v1 = acc[ai][bj][m][1] * rinv;
                    u32x4 w; w.x = pk2(v0[0], v0[1]); w.y = pk2(v0[2], v0[3]); w.z = pk2(v1[0], v1[1]); w.w = pk2(v1[2], v1[3]);
                    if (u.pn < 11) *(u32x4*)(O + (size_t)row * INW + col) = w;
                    else {
                        const int cv = col - 2816;
                        bf16_t* vp = VT + ((size_t)((row >> 11) * 8 + (cv >> 6)) * 64 + (cv & 63)) * 2048 + (row & 2047);
#pragma unroll
                        for (int e = 0; e < 4; ++e) { vp[(size_t)(2 * e) * 2048] = (bf16_t)(w[e] & 0xffffu); vp[(size_t)(2 * e + 1) * 2048] = (bf16_t)(w[e] >> 16); }
                    }
                }
            }
    }
};
struct EpiRes {
    float* X; bf16_t* XB; float* SS;
    __device__ __forceinline__ void operator()(AccRef acc, const Unit& u, int wr, int wc, int fr, int fq) const {
#pragma unroll
        for (int ai = 0; ai < 2; ++ai)
#pragma unroll
            for (int m = 0; m < 4; ++m) {
                const int row = u.pm * 256 + ai * 128 + wr * 64 + m * 16 + fr;
                float sq = 0.f;
#pragma unroll
                for (int bj = 0; bj < 2; ++bj) {
                    const int col = u.pn * 256 + bj * 128 + wc * 32 + 8 * fq;
                    float* xp = X + (size_t)row * 1024 + col;
                    f32x4 x0 = *(const f32x4*)xp, x1 = *(const f32x4*)(xp + 4);
                    x0 += acc[ai][bj][m][0]; x1 += acc[ai][bj][m][1];
                    *(f32x4*)xp = x0; *(f32x4*)(xp + 4) = x1;
                    u32x4 w; w.x = pk2(x0[0], x0[1]); w.y = pk2(x0[2], x0[3]); w.z = pk2(x1[0], x1[1]); w.w = pk2(x1[2], x1[3]);
                    *(u32x4*)(XB + (size_t)row * 1024 + col) = w;
                    sq += (x0[0] * x0[0] + x0[1] * x0[1]) + (x0[2] * x0[2] + x0[3] * x0[3]) + (x1[0] * x1[0] + x1[1] * x1[1]) + (x1[2] * x1[2] + x1[3] * x1[3]);
                }
                sq += __shfl_xor(sq, 16); sq += __shfl_xor(sq, 32);
                if (fq == 0) SS[(size_t)row * 16 + u.pn * 4 + wc] = sq;
            }
    }
};
struct EpiGU {
    bf16_t* H;
    __device__ __forceinline__ void operator()(AccRef acc, const Unit& u, int wr, int wc, int fr, int fq) const {
#pragma unroll
        for (int ai = 0; ai < 2; ++ai)
#pragma unroll
            for (int m = 0; m < 4; ++m) {
                const int row = u.pm * 256 + ai * 128 + wr * 64 + m * 16 + fr;
                float h[8];
#pragma unroll
                for (int n = 0; n < 2; ++n)
#pragma unroll
                    for (int j = 0; j < 4; ++j) { const float gt = acc[ai][0][m][n][j], up = acc[ai][1][m][n][j]; h[n * 4 + j] = gt * __builtin_amdgcn_rcpf(1.0f + __expf(-gt)) * up; }
                u32x4 w; w.x = pk2(h[0], h[1]); w.y = pk2(h[2], h[3]); w.z = pk2(h[4], h[5]); w.w = pk2(h[6], h[7]);
                *(u32x4*)(H + (size_t)row * 512 + u.pn * 128 + wc * 32 + 8 * fq) = w;
            }
    }
};
struct EpiDown {
    bf16_t* Y; const int* slot; const float* sw;
    __device__ __forceinline__ void operator()(AccRef acc, const Unit& u, int wr, int wc, int fr, int fq) const {
#pragma unroll
        for (int ai = 0; ai < 2; ++ai)
#pragma unroll
            for (int m = 0; m < 4; ++m) {
                const int row = u.pm * 256 + ai * 128 + wr * 64 + m * 16 + fr;
                const int s = slot[row]; const float wgt = sw[row];
                if (s >= 0) {
#pragma unroll
                    for (int bj = 0; bj < 2; ++bj) {
                        const int col = u.pn * 256 + bj * 128 + wc * 32 + 8 * fq;
                        const f32x4 v0 = acc[ai][bj][m][0] * wgt, v1 = acc[ai][bj][m][1] * wgt;
                        u32x4 w; w.x = pk2(v0[0], v0[1]); w.y = pk2(v0[2], v0[3]); w.z = pk2(v1[0], v1[1]); w.w = pk2(v1[2], v1[3]);
                        *(u32x4*)(Y + (size_t)s * 1024 + col) = w;
                    }
                }
            }
    }
};
}

#define WSP(type, off) ((type*)(a.ws + (off)))
__device__ __forceinline__ int oblk() { int t = blockIdx.x; asm volatile("" : "+s"(t)); return t; }
__device__ __forceinline__ int ogrid() { int t = gridDim.x; asm volatile("" : "+s"(t)); return t; }
__device__ __forceinline__ int otid() { int t = threadIdx.x; asm volatile("" : "+v"(t)); return t; }
constexpr int LDS_INTAB = LDS_MISC + 14336;
__device__ __forceinline__ const float* ldsin(LAS unsigned char* lds, int i) {
    const unsigned long long p = ((const LAS unsigned long long*)(lds + LDS_INTAB))[i];
    const unsigned lo = __builtin_amdgcn_readfirstlane((unsigned)p), hi = __builtin_amdgcn_readfirstlane((unsigned)(p >> 32));
    return (const float*)(((unsigned long long)hi << 32) | lo);
}
#define INP(i) ldsin(lds, (i))

template <int MAP>
__device__ __forceinline__ void conv_T(const float* __restrict__ src, int Ktot, int N, int Kper, bf16_t* __restrict__ dst, size_t estride,
                                       const float* __restrict__ gain, int goff, LAS float* tile) {
    const int tid = otid();
    const int ntn = N >> 6, ntiles = (Ktot >> 6) * ntn;
    for (int ti = oblk(); ti < ntiles; ti += ogrid()) {
        const int kt = ti / ntn, ntc = ti - kt * ntn, k0 = kt * 64, n0 = ntc * 64;
        const int e = k0 / Kper, kl0 = k0 - e * Kper;
#pragma unroll
        for (int i = 0; i < 2; ++i) {
            const int idx = tid + i * 512, kk = idx >> 4, n4 = (idx & 15) * 4;
            const f32x4 v = *(const f32x4*)(src + (size_t)(k0 + kk) * N + n0 + n4);
            float gsc = 1.0f;
            if (gain != nullptr && kl0 + kk >= goff) gsc = gain[kl0 + kk - goff];
            tile[kk * 65 + n4 + 0] = v[0] * gsc; tile[kk * 65 + n4 + 1] = v[1] * gsc; tile[kk * 65 + n4 + 2] = v[2] * gsc; tile[kk * 65 + n4 + 3] = v[3] * gsc;
        }
        __syncthreads();
        {
            const int nn = tid >> 3, kg = tid & 7;
            float v[8];
#pragma unroll
            for (int j = 0; j < 8; ++j) v[j] = tile[(kg * 8 + j) * 65 + nn];
            const int n = n0 + nn;
            const int nr = (MAP == 0) ? n : ((n >> 7) * 256 + (n & 127) + (MAP == 2 ? 128 : 0));
            u32x4 w; w.x = pk2(v[0], v[1]); w.y = pk2(v[2], v[3]); w.z = pk2(v[4], v[5]); w.w = pk2(v[6], v[7]);
            *(u32x4*)(dst + (size_t)e * estride + (size_t)nr * Kper + kl0 + kg * 8) = w;
        }
        __syncthreads();
    }
}

__device__ __forceinline__ void moe_convert(const PA a, int l, LAS unsigned char* lds) {
    LAS float* tile = (LAS float*)lds;
    conv_T<1>(INP(35) + (size_t)l * 32 * 1024 * 512, 32 * 1024, 512, 1024, WSP(bf16_t, WS_WGU), (size_t)1024 * 1024, INP(30) + l * 1024, 0, tile);
    conv_T<2>(INP(36) + (size_t)l * 32 * 1024 * 512, 32 * 1024, 512, 1024, WSP(bf16_t, WS_WGU), (size_t)1024 * 1024, INP(30) + l * 1024, 0, tile);
    conv_T<0>(INP(37) + (size_t)l * 32 * 512 * 1024, 32 * 512, 1024, 512, WSP(bf16_t, WS_WD), (size_t)1024 * 512, nullptr, 0, tile);
}

__device__ __forceinline__ void rows_convert(const float* __restrict__ src, float* __restrict__ dstf, bf16_t* __restrict__ dstb, float* __restrict__ ss, int nrows) {
    const int wave = otid() >> 6, lane = otid() & 63;
    for (int r = oblk() * 8 + wave; r < nrows; r += ogrid() * 8) {
        float sq = 0.f;
#pragma unroll
        for (int i = 0; i < 4; ++i) {
            const int c = i * 256 + lane * 4;
            const f32x4 v = *(const f32x4*)(src + (size_t)r * 1024 + c);
            if (dstf) *(f32x4*)(dstf + (size_t)r * 1024 + c) = v;
            u32x2 w; w.x = pk2(v[0], v[1]); w.y = pk2(v[2], v[3]);
            *(u32x2*)(dstb + (size_t)r * 1024 + c) = w;
            sq += (v[0] * v[0] + v[1] * v[1]) + (v[2] * v[2] + v[3] * v[3]);
        }
        sq = wsum(sq);
        if (lane < 16) ss[(size_t)r * 16 + lane] = (lane == 0) ? sq : 0.f;
    }
}

__device__ __forceinline__ void p0_prologue(const PA a, LAS unsigned char* lds) {
    LAS float* tile = (LAS float*)lds;
    for (int l = 0; l < NL; ++l) {
        conv_T<0>(INP(3) + (size_t)l * 1024 * INW, 1024, INW, 1024, WSP(bf16_t, WS_WIN) + (size_t)l * INW * 1024, 0, INP(2) + l * 1024, 0, tile);
        conv_T<0>(INP(22) + (size_t)l * 1024 * 1024, 1024, 1024, 1024, WSP(bf16_t, WS_WOUT) + (size_t)l * 1024 * 1024, 0, INP(21) + l * 512, 512, tile);
        conv_T<0>(INP(25) + (size_t)l * 1024 * 512, 1024, 512, 1024, WSP(bf16_t, WS_WQ) + (size_t)l * 512 * 1024, 0, INP(23) + l * 1024, 0, tile);
        conv_T<0>(INP(26) + (size_t)l * 1024 * 1024, 1024, 1024, 1024, WSP(bf16_t, WS_WKV) + (size_t)l * 1024 * 1024, 0, INP(24) + l * 1024, 0, tile);
        conv_T<0>(INP(27) + (size_t)l * 512 * 1024, 512, 1024, 512, WSP(bf16_t, WS_WO) + (size_t)l * 1024 * 512, 0, nullptr, 0, tile);
    }
    moe_convert(a, 0, lds);
    rows_convert(INP(0), a.out, WSP(bf16_t, WS_XB), WSP(float, WS_SS), T);
    rows_convert(INP(1), nullptr, WSP(bf16_t, WS_MEMB), WSP(float, WS_MEMSS), MROWS);
}

__device__ __forceinline__ void p2_knorm(const PA a, LAS unsigned char* lds) {
    const int wave = otid() >> 6, lane = otid() & 63;
    bf16_t* kv = WSP(bf16_t, WS_KV);
    for (int it = oblk() * 8 + wave; it < NL * MROWS * 4; it += ogrid() * 8) {
        const int h = it & 3, row = (it >> 2) & (MROWS - 1), l = it >> 14;
        unsigned* p = (unsigned*)(kv + ((size_t)l * MROWS + row) * 1024 + h * 128 + lane * 2);
        const unsigned w = *p; const float x0 = lo16(w), x1 = hi16(w);
        const float ssq = wsum(x0 * x0 + x1 * x1);
        const float rinv = rsqrtf(ssq * (1.0f / 128.0f) + 1e-6f);
        const float* gk = INP(29) + l * 128 + lane * 2;
        *p = pk2(x0 * rinv * gk[0], x1 * rinv * gk[1]);
    }
    bf16_t* vtx = WSP(bf16_t, WS_VTX);
    const int tid = otid();
    for (int it = oblk(); it < NL * 16 * 4; it += ogrid()) {
        const int h = it & 3, b = (it >> 2) & 15, l = it >> 6;
        const bf16_t* src = kv + ((size_t)l * MROWS + b * 256) * 1024 + 512 + h * 128;
        bf16_t* dst = vtx + (size_t)it * 128 * 256;
#pragma unroll 1
        for (int i = 0; i < 8; ++i) {
            const int p = tid + i * 512, d = p & 127, m8 = (p >> 7) * 8;
            unsigned short x[8];
#pragma unroll
            for (int j = 0; j < 8; ++j) x[j] = src[(size_t)(m8 + j) * 1024 + d];
            u32x4 w; w.x = x[0] | ((unsigned)x[1] << 16); w.y = x[2] | ((unsigned)x[3] << 16); w.z = x[4] | ((unsigned)x[5] << 16); w.w = x[6] | ((unsigned)x[7] << 16);
            *(u32x4*)(dst + (size_t)d * 256 + m8) = w;
        }
    }
}

__device__ __forceinline__ float fast_tanh(float x) { return 1.0f - 2.0f * __builtin_amdgcn_rcpf(1.0f + __expf(2.0f * x)); }
__device__ __forceinline__ float fast_sigmoid(float x) { return __builtin_amdgcn_rcpf(1.0f + __expf(-x)); }
template <int MODE>
__device__ __forceinline__ bf16x8 mixfrag(const bf16_t* pu, const bf16_t* pp, float hpf, const float* mu, int col) {
    const u32x4 u = *(const u32x4*)(pu + col), p = *(const u32x4*)(pp + col);
    const f32x4 m0 = *(const f32x4*)(mu + col), m1 = *(const f32x4*)(mu + col + 4);
    float x[8];
#pragma unroll
    for (int j = 0; j < 4; ++j) {
        const float u0 = lo16(u[j]), u1 = hi16(u[j]), p0 = lo16(p[j]) * hpf, p1 = hi16(p[j]) * hpf;
        const float ma = (j < 2) ? m0[2 * j] : m1[2 * j - 4], mb = (j < 2) ? m0[2 * j + 1] : m1[2 * j - 3];
        x[2 * j] = u0 + ma * (p0 - u0); x[2 * j + 1] = u1 + mb * (p1 - u1);
    }
#pragma unroll
    for (int j = 0; j < 8; ++j) { if (MODE == 1) x[j] = fast_tanh(x[j]); if (MODE == 2) x[j] = fast_sigmoid(x[j]); }
    u32x4 w; w.x = pk2(x[0], x[1]); w.y = pk2(x[2], x[3]); w.z = pk2(x[4], x[5]); w.w = pk2(x[6], x[7]);
    return __builtin_bit_cast(bf16x8, w);
}
__device__ __forceinline__ void pb_prep(const PA a, int l, LAS unsigned char* lds) {
    const int tid = otid(), wave = tid >> 6, lane = tid & 63, fr = lane & 15, fq = lane >> 4;
    const int G = ogrid(), blk = oblk();
    LAS bf16_t* s_w2 = (LAS bf16_t*)lds;
    LAS bf16_t* s_a2 = (LAS bf16_t*)(lds + 18432);
    LAS bf16_t* s_g2 = (LAS bf16_t*)(lds + 36864);
    LAS bf16_t* s_v2 = (LAS bf16_t*)(lds + 71680);
    LAS bf16_t* s_v1 = (LAS bf16_t*)(lds + 81920);
    bf16_t* proj = WSP(bf16_t, WS_PROJ);
    const float* mu = INP(4) + l * 1792;
    const float* w0 = INP(5) + l * 512;  const float* w2 = INP(6) + (size_t)l * 64 * 512;
    const float* a0 = INP(7) + l * 512;  const float* a2 = INP(8) + (size_t)l * 64 * 512;
    const float* g2 = INP(9) + (size_t)l * 128 * 512;
    const float* kkw = INP(10) + l * 512; const float* kaw = INP(11) + l * 512;
    const int lv = l > 0 ? l - 1 : 0;
    const float* v0 = INP(15) + lv * 512; const float* v1 = INP(16) + (size_t)lv * 512 * 32; const float* v2 = INP(17) + (size_t)lv * 32 * 512;
    const float* qgn = INP(18) + l * 64; const float* kgn = INP(19) + l * 64;
    bf16_t* SR = WSP(bf16_t, WS_SR); bf16_t* SK = WSP(bf16_t, WS_SK); bf16_t* SV = WSP(bf16_t, WS_SV);
    bf16_t* SA = WSP(bf16_t, WS_SA); bf16_t* SB = WSP(bf16_t, WS_SB); bf16_t* SG = WSP(bf16_t, WS_SG);
    float* SWD = WSP(float, WS_SWD); bf16_t* VF = WSP(bf16_t, WS_VF);
    int cur_hp = -1;
    for (int item = blk; item < 4 * (T / 128); item += G) {
        const int hp = item & 3, tt = item >> 2;
        if (hp != cur_hp) {
            __syncthreads();
            const int chb = hp * 128;
            for (int idx = tid; idx < 64 * 128; idx += 512) { const int ch = idx & 127, k = idx >> 7;
                s_w2[ch * 72 + k] = f2bf(w2[k * 512 + chb + ch]); s_a2[ch * 72 + k] = f2bf(a2[k * 512 + chb + ch]); }
            for (int idx = tid; idx < 128 * 128; idx += 512) { const int ch = idx & 127, k = idx >> 7; s_g2[ch * 136 + k] = f2bf(g2[k * 512 + chb + ch]); }
            if (l > 0) {
                for (int idx = tid; idx < 32 * 128; idx += 512) { const int ch = idx & 127, k = idx >> 7; s_v2[ch * 40 + k] = f2bf(v2[k * 512 + chb + ch]); }
                for (int idx = tid; idx < 512 * 32; idx += 512) { const int n = idx & 31, k = idx >> 5; s_v1[n * 520 + k] = f2bf(v1[k * 32 + n]); }
            }
            __syncthreads();
            cur_hp = hp;
        }
        const int t = tt * 128 + wave * 16 + fr;
        const bool hpv = (t & (SEQ - 1)) != 0;
        const bf16_t* pu = proj + (size_t)t * INW;
        const bf16_t* pp = hpv ? pu - INW : pu;
        const float hpf = hpv ? 1.0f : 0.0f;
        bf16x8 fwl[2], fal[2], fgl[4], ft32;
#pragma unroll
        for (int s = 0; s < 2; ++s) { fwl[s] = mixfrag<1>(pu, pp, hpf, mu, 1536 + 32 * s + 8 * fq); fal[s] = mixfrag<0>(pu, pp, hpf, mu, 1600 + 32 * s + 8 * fq); }
#pragma unroll
        for (int s = 0; s < 4; ++s) fgl[s] = mixfrag<2>(pu, pp, hpf, mu, 1664 + 32 * s + 8 * fq);
        ft32 = fwl[0];
        if (l > 0) {
            f32x4 c0 = {0.f, 0.f, 0.f, 0.f}, c1 = {0.f, 0.f, 0.f, 0.f};
#pragma unroll 4
            for (int s = 0; s < 16; ++s) {
                const bf16x8 xf = mixfrag<0>(pu, pp, hpf, mu, 1024 + 32 * s + 8 * fq);
                const bf16x8 wa = *(const LAS bf16x8*)(s_v1 + fr * 520 + 32 * s + 8 * fq), wb = *(const LAS bf16x8*)(s_v1 + (16 + fr) * 520 + 32 * s + 8 * fq);
                c0 = __builtin_amdgcn_mfma_f32_16x16x32_bf16(wa, xf, c0, 0, 0, 0);
                c1 = __builtin_amdgcn_mfma_f32_16x16x32_bf16(wb, xf, c1, 0, 0, 0);
            }
            u32x4 w; w.x = pk2(c0[0], c0[1]); w.y = pk2(c0[2], c0[3]); w.z = pk2(c1[0], c1[1]); w.w = pk2(c1[2], c1[3]);
            ft32 = __builtin_bit_cast(bf16x8, w);
        }
#pragma unroll 1
        for (int hh = 0; hh < 2; ++hh) {
            float kkv[4][4], avv[4][4];
            float kss = 0.f;
#pragma unroll
            for (int nt = 0; nt < 4; ++nt) {
                const int lc = hh * 64 + nt * 16, ch4 = hp * 128 + lc + 4 * fq;
                f32x4 aw = {0.f, 0.f, 0.f, 0.f}, aa = aw, ag = aw, az = aw;
#pragma unroll
                for (int s = 0; s < 2; ++s) {
                    aw = __builtin_amdgcn_mfma_f32_16x16x32_bf16(*(const LAS bf16x8*)(s_w2 + (lc + fr) * 72 + 32 * s + 8 * fq), fwl[s], aw, 0, 0, 0);
                    aa = __builtin_amdgcn_mfma_f32_16x16x32_bf16(*(const LAS bf16x8*)(s_a2 + (lc + fr) * 72 + 32 * s + 8 * fq), fal[s], aa, 0, 0, 0);
                }
#pragma unroll
                for (int s = 0; s < 4; ++s) ag = __builtin_amdgcn_mfma_f32_16x16x32_bf16(*(const LAS bf16x8*)(s_g2 + (lc + fr) * 136 + 32 * s + 8 * fq), fgl[s], ag, 0, 0, 0);
                if (l > 0) {
                    const u32x2 q0 = *(const LAS u32x2*)(s_v2 + (lc + fr) * 40 + 4 * fq), q1 = *(const LAS u32x2*)(s_v2 + (lc + fr) * 40 + 16 + 4 * fq);
                    u32x4 w; w.x = q0.x; w.y = q0.y; w.z = q1.x; w.w = q1.y;
                    az = __builtin_amdgcn_mfma_f32_16x16x32_bf16(__builtin_bit_cast(bf16x8, w), ft32, az, 0, 0, 0);
                }
                const u32x2 ur = *(const u32x2*)(pu + ch4), pr = *(const u32x2*)(pp + ch4);
                const u32x2 uk = *(const u32x2*)(pu + 512 + ch4), pk = *(const u32x2*)(pp + 512 + ch4);
                const u32x2 uv = *(const u32x2*)(pu + 1024 + ch4), pv = *(const u32x2*)(pp + 1024 + ch4);
                const f32x4 mr = *(const f32x4*)(mu + ch4), mk = *(const f32x4*)(mu + 512 + ch4), mv = *(const f32x4*)(mu + 1024 + ch4);
                const f32x4 w0v = *(const f32x4*)(w0 + ch4), a0v = *(const f32x4*)(a0 + ch4), kkwv = *(const f32x4*)(kkw + ch4), kawv = *(const f32x4*)(kaw + ch4);
                float xr[4], xk[4], xv[4];
                { const float u0 = lo16(ur.x), u1 = hi16(ur.x), u2 = lo16(ur.y), u3 = hi16(ur.y);
                  xr[0] = u0 + mr[0] * (lo16(pr.x) * hpf - u0); xr[1] = u1 + mr[1] * (hi16(pr.x) * hpf - u1); xr[2] = u2 + mr[2] * (lo16(pr.y) * hpf - u2); xr[3] = u3 + mr[3] * (hi16(pr.y) * hpf - u3); }
                { const float u0 = lo16(uk.x), u1 = hi16(uk.x), u2 = lo16(uk.y), u3 = hi16(uk.y);
                  xk[0] = u0 + mk[0] * (lo16(pk.x) * hpf - u0); xk[1] = u1 + mk[1] * (hi16(pk.x) * hpf - u1); xk[2] = u2 + mk[2] * (lo16(pk.y) * hpf - u2); xk[3] = u3 + mk[3] * (hi16(pk.y) * hpf - u3); }
                { const float u0 = lo16(uv.x), u1 = hi16(uv.x), u2 = lo16(uv.y), u3 = hi16(uv.y);
                  xv[0] = u0 + mv[0] * (lo16(pv.x) * hpf - u0); xv[1] = u1 + mv[1] * (hi16(pv.x) * hpf - u1); xv[2] = u2 + mv[2] * (lo16(pv.y) * hpf - u2); xv[3] = u3 + mv[3] * (hi16(pv.y) * hpf - u3); }
                const size_t o = (size_t)t * 512 + ch4;
                if (l > 0) {
                    const f32x4 v0v = *(const f32x4*)(v0 + ch4);
                    const u32x2 vfw = *(const u32x2*)(VF + o);
                    const float vf0 = lo16(vfw.x), vf1 = hi16(vfw.x), vf2 = lo16(vfw.y), vf3 = hi16(vfw.y);
                    xv[0] += (vf0 - xv[0]) * fast_sigmoid(v0v[0] + az[0]); xv[1] += (vf1 - xv[1]) * fast_sigmoid(v0v[1] + az[1]);
                    xv[2] += (vf2 - xv[2]) * fast_sigmoid(v0v[2] + az[2]); xv[3] += (vf3 - xv[3]) * fast_sigmoid(v0v[3] + az[3]);
                } else {
                    u32x2 w; w.x = pk2(xv[0], xv[1]); w.y = pk2(xv[2], xv[3]); *(u32x2*)(VF + o) = w;
                }
                f32x4 dec; float kmod[4];
#pragma unroll
                for (int j = 0; j < 4; ++j) {
                    dec[j] = __expf(-0.6065306597f * fast_sigmoid(w0v[j] + aw[j]));
                    const float av = fast_sigmoid(a0v[j] + aa[j]);
                    const float kk = xk[j] * kkwv[j];
                    kkv[nt][j] = kk; avv[nt][j] = av; kss += kk * kk;
                    kmod[j] = xk[j] * (1.0f + (av - 1.0f) * kawv[j]);
                }
                { u32x2 w; w.x = pk2(xr[0], xr[1]); w.y = pk2(xr[2], xr[3]); *(u32x2*)(SR + o) = w; }
                { u32x2 w; w.x = pk2(xv[0], xv[1]); w.y = pk2(xv[2], xv[3]); *(u32x2*)(SV + o) = w; }
                { u32x2 w; w.x = pk2(ag[0], ag[1]); w.y = pk2(ag[2], ag[3]); *(u32x2*)(SG + o) = w; }
                { u32x2 w; w.x = pk2(kmod[0], kmod[1]); w.y = pk2(kmod[2], kmod[3]); *(u32x2*)(SK + o) = w; }
                *(f32x4*)(SWD + o) = dec;
            }
            kss += __shfl_xor(kss, 16); kss += __shfl_xor(kss, 32);
            const float rn = rsqrtf(fmaxf(kss, 1e-24f));
#pragma unroll
            for (int nt = 0; nt < 4; ++nt) {
                const size_t o = (size_t)t * 512 + hp * 128 + hh * 64 + nt * 16 + 4 * fq;
                float kn[4];
#pragma unroll
                for (int j = 0; j < 4; ++j) kn[j] = kkv[nt][j] * rn;
                { u32x2 w; w.x = pk2(-kn[0], -kn[1]); w.y = pk2(-kn[2], -kn[3]); *(u32x2*)(SA + o) = w; }
                { u32x2 w; w.x = pk2(kn[0] * avv[nt][0], kn[1] * avv[nt][1]); w.y = pk2(kn[2] * avv[nt][2], kn[3] * avv[nt][3]); *(u32x2*)(SB + o) = w; }
            }
        }
#pragma unroll 1
        for (int qk = 0; qk < 4; ++qk) {
            const int col = 1792 + (qk & 1) * 512 + (hp * 2 + (qk >> 1)) * 64 + fq * 16;
            const float* gn = (qk & 1) ? kgn : qgn;
            bf16_t* p = proj + (size_t)t * INW + col;
            const u32x4 wa = *(const u32x4*)p, wb = *(const u32x4*)(p + 8);
            float x[16];
#pragma unroll
            for (int j = 0; j < 4; ++j) { x[2 * j] = lo16(wa[j]); x[2 * j + 1] = hi16(wa[j]); x[8 + 2 * j] = lo16(wb[j]); x[9 + 2 * j] = hi16(wb[j]); }
            float ssq = 0.f;
#pragma unroll
            for (int j = 0; j < 16; ++j) ssq += x[j] * x[j];
            ssq += __shfl_xor(ssq, 16); ssq += __shfl_xor(ssq, 32);
            const float rinv = rsqrtf(ssq * (1.0f / 64.0f) + 1e-6f);
            const float qsc = (qk & 1) ? rinv : rinv * 0.18033688011112042f;
#pragma unroll
            for (int j = 0; j < 16; ++j) x[j] = x[j] * qsc * gn[fq * 16 + j];
            u32x4 oa, ob;
#pragma unroll
            for (int j = 0; j < 4; ++j) { oa[j] = pk2(x[2 * j], x[2 * j + 1]); ob[j] = pk2(x[8 + 2 * j], x[9 + 2 * j]); }
            *(u32x4*)p = oa; *(u32x4*)(p + 8) = ob;
        }
    }
    __syncthreads();
}

__device__ __forceinline__ void scan_item(const PA a, int l, int bh, LAS unsigned char* lds) {
    const int tid = otid(), wave = tid >> 6, lane = tid & 63;
    const int b = bh >> 3, h = bh & 7;
    const int row = wave * 8 + (lane >> 3), kg = lane & 7;
    LAS float* ybuf = (LAS float*)(lds + 98304);
    const bf16_t* SR = WSP(bf16_t, WS_SR); const bf16_t* SK = WSP(bf16_t, WS_SK); const bf16_t* SV = WSP(bf16_t, WS_SV);
    const bf16_t* SA = WSP(bf16_t, WS_SA); const bf16_t* SB = WSP(bf16_t, WS_SB); const bf16_t* SG = WSP(bf16_t, WS_SG);
    const float* SWD = WSP(float, WS_SWD);
    bf16_t* YC = WSP(bf16_t, WS_YCAT);
    const size_t tok0 = (size_t)b * SEQ;
    const float lw = INP(13)[l * 512 + h * 64 + lane], lb = INP(14)[l * 512 + h * 64 + lane], rk = INP(12)[l * 512 + h * 64 + lane];
    u32x4 pre[4]; f32x4 prew;
    const int q0 = tid & 255, arrsel = tid >> 8;
    const int pstep = q0 >> 3, pc8 = (q0 & 7) * 8;
    const int wstep = tid >> 4, wc4 = (tid & 15) * 4;
#define SCAN_LOAD(cidx) do { const size_t tb = tok0 + (size_t)(cidx) * 32; \
        const size_t o = (tb + pstep) * 512 + h * 64 + pc8; \
        pre[0] = *(const u32x4*)((arrsel ? SK : SA) + o); pre[1] = *(const u32x4*)((arrsel ? SR : SB) + o); \
        if (tid < 256) pre[2] = *(const u32x4*)(SV + o); \
        prew = *(const f32x4*)(SWD + (tb + wstep) * 512 + h * 64 + wc4); } while (0)
#define SCAN_STORE(bufi) do { LAS float* bb = (LAS float*)(lds + (bufi) * 49152); \
        LAS float* d0 = bb + (arrsel ? 2 : 0) * 2048 + pstep * 64 + pc8; LAS float* d1 = bb + (arrsel ? 4 : 3) * 2048 + pstep * 64 + pc8; \
        _Pragma("unroll") for (int j = 0; j < 4; ++j) { d0[2 * j] = lo16(pre[0][j]); d0[2 * j + 1] = hi16(pre[0][j]); d1[2 * j] = lo16(pre[1][j]); d1[2 * j + 1] = hi16(pre[1][j]); } \
        if (tid < 256) { LAS float* d2 = bb + 5 * 2048 + pstep * 64 + pc8; _Pragma("unroll") for (int j = 0; j < 4; ++j) { d2[2 * j] = lo16(pre[2][j]); d2[2 * j + 1] = hi16(pre[2][j]); } } \
        *(LAS f32x4*)(bb + 1 * 2048 + wstep * 64 + wc4) = prew; } while (0)
    float S[8];
#pragma unroll
    for (int j = 0; j < 8; ++j) S[j] = 0.f;
    __syncthreads();
    SCAN_LOAD(0); SCAN_STORE(0);
    __syncthreads();
    for (int ch = 0; ch < SEQ / 32; ++ch) {
        const int cur = ch & 1;
        if (ch + 1 < SEQ / 32) SCAN_LOAD(ch + 1);
        LAS float* bb = (LAS float*)(lds + cur * 49152);
        for (int st = 0; st < 32; ++st) {
            const LAS float* pa = bb + st * 64 + kg * 8;
            const f32x4 a0 = *(const LAS f32x4*)(pa), a1 = *(const LAS f32x4*)(pa + 4);
            const f32x4 w0 = *(const LAS f32x4*)(pa + 2048), w1 = *(const LAS f32x4*)(pa + 2048 + 4);
            const f32x4 k0 = *(const LAS f32x4*)(pa + 4096), k1 = *(const LAS f32x4*)(pa + 4096 + 4);
            const f32x4 b0 = *(const LAS f32x4*)(pa + 6144), b1 = *(const LAS f32x4*)(pa + 6144 + 4);
            const f32x4 r0 = *(const LAS f32x4*)(pa + 8192), r1 = *(const LAS f32x4*)(pa + 8192 + 4);
            const float vv = bb[10240 + st * 64 + row];
            float sa = (S[0] * a0[0] + S[1] * a0[1]) + (S[2] * a0[2] + S[3] * a0[3]) + (S[4] * a1[0] + S[5] * a1[1]) + (S[6] * a1[2] + S[7] * a1[3]);
            sa += __shfl_xor(sa, 1); sa += __shfl_xor(sa, 2); sa += __shfl_xor(sa, 4);
#pragma unroll
            for (int j = 0; j < 4; ++j) {
                S[j] = S[j] * w0[j] + (sa * b0[j] + vv * k0[j]);
                S[4 + j] = S[4 + j] * w1[j] + (sa * b1[j] + vv * k1[j]);
            }
            float y = (S[0] * r0[0] + S[1] * r0[1]) + (S[2] * r0[2] + S[3] * r0[3]) + (S[4] * r1[0] + S[5] * r1[1]) + (S[6] * r1[2] + S[7] * r1[3]);
            y += __shfl_xor(y, 1); y += __shfl_xor(y, 2); y += __shfl_xor(y, 4);
            if (kg == 0) ybuf[st * 64 + row] = y;
        }
        __syncthreads();
#pragma unroll
        for (int s4 = 0; s4 < 4; ++s4) {
            const int st = wave * 4 + s4;
            const size_t t = tok0 + (size_t)ch * 32 + st;
            const float y = ybuf[st * 64 + lane];
            const float mean = wsum(y) * (1.0f / 64.0f);
            const float dlt = y - mean;
            const float var = wsum(dlt * dlt) * (1.0f / 64.0f);
            const float yn = dlt * rsqrtf(var + 64e-5f) * lw + lb;
            const float rr = bb[8192 + st * 64 + lane], kk = bb[4096 + st * 64 + lane], vv = bb[10240 + st * 64 + lane];
            const float bonus = wsum(rr * kk * rk) * vv;
            const float g = bf2f(SG[t * 512 + h * 64 + lane]);
            YC[t * 1024 + h * 64 + lane] = f2bf((yn + bonus) * g);
        }
        if (ch + 1 < SEQ / 32) SCAN_STORE(cur ^ 1);
        __syncthreads();
    }
#undef SCAN_LOAD
#undef SCAN_STORE
}

__device__ __forceinline__ void attn_item(const PA a, int l, int it, LAS unsigned char* lds) {
    const int tid = otid(), h = tid >> 6, lane = tid & 63, fr = lane & 15, fq = lane >> 4;
    const int b = it >> 5, c = it & 31;
    LAS float* s_bias = (LAS float*)(lds + LDS_MISC + 1024);
    LAS float* s_part = s_bias + 8 * 320;
    const bf16_t* proj = WSP(const bf16_t, WS_PROJ);
    const bf16_t* VT = WSP(const bf16_t, WS_VT) + (size_t)(b * 8 + h) * 64 * 2048;
    const size_t tq0 = (size_t)b * SEQ + c * 64;
    bf16x8 qf[4][2];
#pragma unroll
    for (int nt = 0; nt < 4; ++nt)
#pragma unroll
        for (int ks = 0; ks < 2; ++ks) qf[nt][ks] = *(const bf16x8*)(proj + (tq0 + nt * 16 + fr) * INW + 1792 + h * 64 + 32 * ks + 8 * fq);
    f32x4 o[4][4];
#pragma unroll
    for (int dt = 0; dt < 4; ++dt)
#pragma unroll
        for (int nt = 0; nt < 4; ++nt) o[dt][nt] = (f32x4){0.f, 0.f, 0.f, 0.f};
    float lsum[4] = {0.f, 0.f, 0.f, 0.f};
    const int kc0 = c - 8 > 0 ? c - 8 : 0;
    const int nsteps = (c - kc0 + 1) * 2;
    bf16x8 kf[2][2], kn[2][2]; u32x4 vf[4], vn[4];
#define ATT_LOAD(KF, VF, st) do { const int key0 = (kc0 * 64 + (st) * 32); const size_t tk = (size_t)b * SEQ + key0; \
        _Pragma("unroll") for (int mt = 0; mt < 2; ++mt) _Pragma("unroll") for (int ks = 0; ks < 2; ++ks) \
            KF[mt][ks] = *(const bf16x8*)(proj + (tk + mt * 16 + fr) * INW + 2304 + h * 64 + 32 * ks + 8 * fq); \
        _Pragma("unroll") for (int dt = 0; dt < 4; ++dt) { const bf16_t* vp = VT + (size_t)(dt * 16 + fr) * 2048 + key0 + 4 * fq; \
            const u32x2 v0 = *(const u32x2*)vp, v1 = *(const u32x2*)(vp + 16); VF[dt].x = v0.x; VF[dt].y = v0.y; VF[dt].z = v1.x; VF[dt].w = v1.y; } } while (0)
    ATT_LOAD(kf, vf, 0);
    for (int st = 0; st < nsteps; ++st) {
        const bool more = st + 1 < nsteps;
        if (more) ATT_LOAD(kn, vn, st + 1);
        f32x4 sacc[2][4];
#pragma unroll
        for (int mt = 0; mt < 2; ++mt)
#pragma unroll
            for (int nt = 0; nt < 4; ++nt) {
                f32x4 z = {0.f, 0.f, 0.f, 0.f};
                z = __builtin_amdgcn_mfma_f32_16x16x32_bf16(kf[mt][0], qf[nt][0], z, 0, 0, 0);
                sacc[mt][nt] = __builtin_amdgcn_mfma_f32_16x16x32_bf16(kf[mt][1], qf[nt][1], z, 0, 0, 0);
            }
        const int dk = c - (kc0 + (st >> 1)), half = st & 1;
        if (dk >= 5) {
            const float bc = s_bias[h * 320 + 319];
#pragma unroll
            for (int mt = 0; mt < 2; ++mt)
#pragma unroll
                for (int nt = 0; nt < 4; ++nt) sacc[mt][nt] += bc;
        } else {
#pragma unroll
            for (int mt = 0; mt < 2; ++mt)
#pragma unroll
                for (int nt = 0; nt < 4; ++nt)
#pragma unroll
                    for (int j = 0; j < 4; ++j) {
                        int idx = (nt * 16 + fr) - (half * 32 + mt * 16 + 4 * fq + j) + dk * 64; idx = idx > 256 ? 256 : idx;
                        sacc[mt][nt][j] += s_bias[h * 320 + idx + 63];
                    }
        }
        bf16x8 pf[4];
#pragma unroll
        for (int nt = 0; nt < 4; ++nt) {
            float p[8];
#pragma unroll
            for (int j = 0; j < 4; ++j) { p[j] = __builtin_amdgcn_exp2f(fminf(sacc[0][nt][j], 80.f)); p[4 + j] = __builtin_amdgcn_exp2f(fminf(sacc[1][nt][j], 80.f)); }
            lsum[nt] += ((p[0] + p[1]) + (p[2] + p[3])) + ((p[4] + p[5]) + (p[6] + p[7]));
            u32x4 w; w.x = pk2(p[0], p[1]); w.y = pk2(p[2], p[3]); w.z = pk2(p[4], p[5]); w.w = pk2(p[6], p[7]);
            pf[nt] = __builtin_bit_cast(bf16x8, w);
        }
#pragma unroll
        for (int dt = 0; dt < 4; ++dt)
#pragma unroll
            for (int nt = 0; nt < 4; ++nt) o[dt][nt] = __builtin_amdgcn_mfma_f32_16x16x32_bf16(__builtin_bit_cast(bf16x8, vf[dt]), pf[nt], o[dt][nt], 0, 0, 0);
        if (more) {
#pragma unroll
            for (int mt = 0; mt < 2; ++mt)
#pragma unroll
                for (int ks = 0; ks < 2; ++ks) kf[mt][ks] = kn[mt][ks];
#pragma unroll
            for (int dt = 0; dt < 4; ++dt) vf[dt] = vn[dt];
        }
    }
#undef ATT_LOAD
    float ssq[4];
#pragma unroll
    for (int nt = 0; nt < 4; ++nt) {
        float ls = lsum[nt]; ls += __shfl_xor(ls, 16); ls += __shfl_xor(ls, 32);
        const float inv = 1.0f / ls;
        float sq = 0.f;
#pragma unroll
        for (int dt = 0; dt < 4; ++dt) { o[dt][nt] *= inv; sq += (o[dt][nt][0] * o[dt][nt][0] + o[dt][nt][1] * o[dt][nt][1]) + (o[dt][nt][2] * o[dt][nt][2] + o[dt][nt][3] * o[dt][nt][3]); }
        sq += __shfl_xor(sq, 16); sq += __shfl_xor(sq, 32);
        ssq[nt] = sq;
        if (fq == 0) s_part[h * 64 + nt * 16 + fr] = sq;
    }
    __syncthreads();
#pragma unroll
    for (int nt = 0; nt < 4; ++nt) {
        float tot = 0.f;
#pragma unroll
        for (int hh = 0; hh < 8; ++hh) tot += s_part[hh * 64 + nt * 16 + fr];
        const float rinv = rsqrtf(tot * (1.0f / 512.0f) + 1e-6f);
        bf16_t* yp = WSP(bf16_t, WS_YCAT) + (tq0 + nt * 16 + fr) * 1024 + 512 + h * 64 + 4 * fq;
#pragma unroll
        for (int dt = 0; dt < 4; ++dt) { u32x2 w; w.x = pk2(o[dt][nt][0] * rinv, o[dt][nt][1] * rinv); w.y = pk2(o[dt][nt][2] * rinv, o[dt][nt][3] * rinv); *(u32x2*)(yp + dt * 16) = w; }
    }
    __syncthreads();
}

__device__ __forceinline__ void pc_mixer(const PA a, int l, LAS unsigned char* lds) {
    const int tid = otid();
    LAS float* s_bias = (LAS float*)(lds + LDS_MISC + 1024);
    volatile LAS int* s_item = (volatile LAS int*)(lds + LDS_MISC + 64);
    for (int i = tid; i < 8 * 320; i += 512) s_bias[i] = INP(20)[l * 8 * 320 + i] * 1.4426950408889634f;
    unsigned* qhead = WSP(unsigned, WS_CTL) + CW_QUEUE + l * 64;
    for (;;) {
        __syncthreads();
        if (tid == 0) *s_item = (int)__hip_atomic_fetch_add(qhead, 1u, __ATOMIC_RELAXED, __HIP_MEMORY_SCOPE_AGENT);
        __syncthreads();
        const int item = *s_item;
        if (item >= 128 + 512) break;
        if (item < 128) scan_item(a, l, item, lds);
        else attn_item(a, l, item - 128, lds);
    }
}

__device__ __forceinline__ void pe2_xattn(const PA a, int l, LAS unsigned char* lds) {
    const int tid = otid(), wave = tid >> 6, lane = tid & 63, fr = lane & 15, fq = lane >> 4;
    LAS bf16_t* sK = (LAS bf16_t*)lds;
    LAS bf16_t* sV = (LAS bf16_t*)(lds + 69632);
    const bf16_t* QX = WSP(const bf16_t, WS_QX); bf16_t* OX = WSP(bf16_t, WS_OX);
    const bf16_t* KV = WSP(const bf16_t, WS_KV) + (size_t)l * MROWS * 1024;
    const bf16_t* VTX = WSP(const bf16_t, WS_VTX) + (size_t)l * MROWS * 512;
    const float* qgn = INP(28) + l * 128;
    for (int it = oblk(); it < 256; it += ogrid()) {
        const int b = it >> 4, h = (it >> 2) & 3, qr = it & 3;
        __syncthreads();
#pragma unroll
        for (int i = 0; i < 8; ++i) {
            const int p = tid + i * 512, r = p >> 4, c8 = (p & 15) * 8;
            *(LAS u32x4*)(sK + r * 136 + c8) = *(const u32x4*)(KV + (size_t)(b * 256 + r) * 1024 + h * 128 + c8);
            const int d = p >> 5, m8 = (p & 31) * 8;
            *(LAS u32x4*)(sV + d * 264 + m8) = *(const u32x4*)(VTX + ((size_t)(b * 4 + h) * 128 + d) * 256 + m8);
        }
        __syncthreads();
#pragma unroll 1
        for (int iter = 0; iter < 2; ++iter) {
            const size_t q0 = (size_t)b * SEQ + qr * 512 + iter * 256 + wave * 32;
            bf16x8 qf[2][4];
#pragma unroll
            for (int nt = 0; nt < 2; ++nt) {
                const bf16_t* qp = QX + (q0 + nt * 16 + fr) * 512 + h * 128 + 8 * fq;
                u32x4 w[4]; float ssq = 0.f;
#pragma unroll
                for (int ks = 0; ks < 4; ++ks) { w[ks] = *(const u32x4*)(qp + 32 * ks);
#pragma unroll
                    for (int j = 0; j < 4; ++j) { const float x0 = lo16(w[ks][j]), x1 = hi16(w[ks][j]); ssq += x0 * x0 + x1 * x1; } }
                ssq += __shfl_xor(ssq, 16); ssq += __shfl_xor(ssq, 32);
                const float sc = rsqrtf(ssq * (1.0f / 128.0f) + 1e-6f) * 0.12751743f;
#pragma unroll
                for (int ks = 0; ks < 4; ++ks) {
                    const f32x4 g0 = *(const f32x4*)(qgn + 32 * ks + 8 * fq), g1 = *(const f32x4*)(qgn + 32 * ks + 8 * fq + 4);
                    u32x4 ow;
                    ow.x = pk2(lo16(w[ks][0]) * sc * g0[0], hi16(w[ks][0]) * sc * g0[1]); ow.y = pk2(lo16(w[ks][1]) * sc * g0[2], hi16(w[ks][1]) * sc * g0[3]);
                    ow.z = pk2(lo16(w[ks][2]) * sc * g1[0], hi16(w[ks][2]) * sc * g1[1]); ow.w = pk2(lo16(w[ks][3]) * sc * g1[2], hi16(w[ks][3]) * sc * g1[3]);
                    qf[nt][ks] = __builtin_bit_cast(bf16x8, ow);
                }
            }
            f32x4 o[8][2];
#pragma unroll
            for (int dt = 0; dt < 8; ++dt) { o[dt][0] = (f32x4){0.f, 0.f, 0.f, 0.f}; o[dt][1] = (f32x4){0.f, 0.f, 0.f, 0.f}; }
            float lsum[2] = {0.f, 0.f};
#pragma unroll 2
            for (int st = 0; st < 8; ++st) {
                const int k0 = st * 32;
                f32x4 sacc[2][2];
#pragma unroll
                for (int mt = 0; mt < 2; ++mt) {
                    sacc[mt][0] = (f32x4){0.f, 0.f, 0.f, 0.f}; sacc[mt][1] = (f32x4){0.f, 0.f, 0.f, 0.f};
#pragma unroll
                    for (int ks = 0; ks < 4; ++ks) {
                        const bf16x8 kfr = *(const LAS bf16x8*)(sK + (k0 + mt * 16 + fr) * 136 + 32 * ks + 8 * fq);
                        sacc[mt][0] = __builtin_amdgcn_mfma_f32_16x16x32_bf16(kfr, qf[0][ks], sacc[mt][0], 0, 0, 0);
                        sacc[mt][1] = __builtin_amdgcn_mfma_f32_16x16x32_bf16(kfr, qf[1][ks], sacc[mt][1], 0, 0, 0);
                    }
                }
                bf16x8 pf[2];
#pragma unroll
                for (int nt = 0; nt < 2; ++nt) {
                    float p[8];
#pragma unroll
                    for (int j = 0; j < 4; ++j) { p[j] = __builtin_amdgcn_exp2f(fminf(sacc[0][nt][j], 80.f)); p[4 + j] = __builtin_amdgcn_exp2f(fminf(sacc[1][nt][j], 80.f)); }
                    lsum[nt] += ((p[0] + p[1]) + (p[2] + p[3])) + ((p[4] + p[5]) + (p[6] + p[7]));
                    u32x4 w; w.x = pk2(p[0], p[1]); w.y = pk2(p[2], p[3]); w.z = pk2(p[4], p[5]); w.w = pk2(p[6], p[7]);
                    pf[nt] = __builtin_bit_cast(bf16x8, w);
                }
#pragma unroll
                for (int dt = 0; dt < 8; ++dt) {
                    const LAS bf16_t* vp = sV + (dt * 16 + fr) * 264 + k0 + 4 * fq;
                    const u32x2 v0 = *(const LAS u32x2*)vp, v1 = *(const LAS u32x2*)(vp + 16);
                    u32x4 w; w.x = v0.x; w.y = v0.y; w.z = v1.x; w.w = v1.y;
                    const bf16x8 vfr = __builtin_bit_cast(bf16x8, w);
                    o[dt][0] = __builtin_amdgcn_mfma_f32_16x16x32_bf16(vfr, pf[0], o[dt][0], 0, 0, 0);
                    o[dt][1] = __builtin_amdgcn_mfma_f32_16x16x32_bf16(vfr, pf[1], o[dt][1], 0, 0, 0);
                }
            }
#pragma unroll
            for (int nt = 0; nt < 2; ++nt) {
                float ls = lsum[nt]; ls += __shfl_xor(ls, 16); ls += __shfl_xor(ls, 32);
                const float inv = 1.0f / ls;
                bf16_t* op = OX + (q0 + nt * 16 + fr) * 512 + h * 128 + 4 * fq;
#pragma unroll
                for (int dt = 0; dt < 8; ++dt) { u32x2 w; w.x = pk2(o[dt][nt][0] * inv, o[dt][nt][1] * inv); w.y = pk2(o[dt][nt][2] * inv, o[dt][nt][3] * inv); *(u32x2*)(op + dt * 16) = w; }
            }
        }
    }
    __syncthreads();
}

__device__ __forceinline__ void pf_router(const PA a, int l, LAS unsigned char* lds) {
    const int tid = otid(), wave = tid >> 6, lane = tid & 63;
    LAS float* s_log = (LAS float*)(lds) + wave * 64;
    const float* X = a.out; const float* SS = WSP(const float, WS_SS);
    const float* gn = INP(30) + l * 1024;
    const float* wg = INP(31) + (size_t)l * 1024 * 4; const float* bg = INP(32) + l * 4;
    const float* wr = INP(33) + (size_t)l * 1024 * 32; const float* br = INP(34) + l * 32;
    int* EID = WSP(int, WS_EID); float* EW = WSP(float, WS_EW); int* ERK = WSP(int, WS_ERK);
    unsigned* cnt = WSP(unsigned, WS_CTL) + CW_CNT + l * 32;
    for (int t = oblk() * 8 + wave; t < T; t += ogrid() * 8) {
        float tot = 0.f;
        if (lane < 16) tot = SS[(size_t)t * 16 + lane];
        tot = wsum(tot);
        const float rinv = rsqrtf(tot * (1.0f / 1024.0f) + 1e-6f);
        float acc[36];
#pragma unroll
        for (int n = 0; n < 36; ++n) acc[n] = 0.f;
#pragma unroll
        for (int i = 0; i < 4; ++i) {
            const int k0 = i * 256 + lane * 4;
            const f32x4 xv = *(const f32x4*)(X + (size_t)t * 1024 + k0);
            const f32x4 gv = *(const f32x4*)(gn + k0);
#pragma unroll
            for (int j = 0; j < 4; ++j) {
                const float hx = xv[j] * gv[j];
                const f32x4 g4 = *(const f32x4*)(wg + (size_t)(k0 + j) * 4);
                acc[0] += hx * g4[0]; acc[1] += hx * g4[1]; acc[2] += hx * g4[2]; acc[3] += hx * g4[3];
#pragma unroll
                for (int n4 = 0; n4 < 8; ++n4) { const f32x4 r4 = *(const f32x4*)(wr + (size_t)(k0 + j) * 32 + n4 * 4);
                    acc[4 + n4 * 4] += hx * r4[0]; acc[5 + n4 * 4] += hx * r4[1]; acc[6 + n4 * 4] += hx * r4[2]; acc[7 + n4 * 4] += hx * r4[3]; }
            }
        }
        float mine = 0.f;
#pragma unroll
        for (int n = 0; n < 36; ++n) { const float s = wsum(acc[n]); mine = (lane == n) ? s : mine; }
        if (lane < 36) s_log[lane] = mine * rinv + (lane < 4 ? bg[lane] : br[lane - 4]);
        __builtin_amdgcn_s_waitcnt(0);
        if (lane == 0) {
            float g0 = s_log[0]; int gt = 0;
            for (int i = 1; i < 4; ++i) { const float v = s_log[i]; if (v > g0) { g0 = v; gt = i; } }
            float gs = 0.f; for (int i = 0; i < 4; ++i) gs += __expf(s_log[i] - g0);
            const float ggate = 1.0f / gs;
            float l1 = -1e30f, l2 = -1e30f; int j1 = 0, j2 = 0;
            for (int i = 0; i < 8; ++i) { const float v = s_log[4 + gt * 8 + i];
                if (v > l1) { l2 = l1; j2 = j1; l1 = v; j1 = i; } else if (v > l2) { l2 = v; j2 = i; } }
            const float e2 = __expf(l2 - l1);
            const float p1 = 1.0f / (1.0f + e2), p2 = e2 / (1.0f + e2);
            const int e1i = gt * 8 + j1, e2i = gt * 8 + j2;
            const unsigned r1 = __hip_atomic_fetch_add(cnt + e1i, 1u, __ATOMIC_RELAXED, __HIP_MEMORY_SCOPE_AGENT);
            const unsigned r2 = __hip_atomic_fetch_add(cnt + e2i, 1u, __ATOMIC_RELAXED, __HIP_MEMORY_SCOPE_AGENT);
            EID[t * 2] = e1i; EID[t * 2 + 1] = e2i; EW[t * 2] = ggate * p1; EW[t * 2 + 1] = ggate * p2; ERK[t * 2] = (int)r1; ERK[t * 2 + 1] = (int)r2;
        }
    }
}

__device__ __forceinline__ void pg_gather(const PA a, int l, LAS unsigned char* lds) {
    const int tid = otid(), wave = tid >> 6, lane = tid & 63;
    LAS int* s_ps = (LAS int*)lds;
    const unsigned* cnt = WSP(const unsigned, WS_CTL) + CW_CNT + l * 32;
    int* SSLOT = WSP(int, WS_SSLOT); float* SW = WSP(float, WS_SW); int* MTE = WSP(int, WS_MTE);
    bf16_t* XS = WSP(bf16_t, WS_XS); const bf16_t* XB = WSP(const bf16_t, WS_XB);
    const float* SS = WSP(const float, WS_SS);
    const int* EID = WSP(const int, WS_EID); const float* EW = WSP(const float, WS_EW); const int* ERK = WSP(const int, WS_ERK);
    __syncthreads();
    if (tid == 0) {
        int acc = 0;
        for (int e = 0; e < 32; ++e) { s_ps[e] = acc; const int c = (int)__hip_atomic_load(cnt + e, __ATOMIC_RELAXED, __HIP_MEMORY_SCOPE_AGENT); acc += ((c + 255) >> 8) << 8; }
        s_ps[32] = acc;
    }
    __syncthreads();
    if (oblk() == 0) {
        if (tid < 32) { const int m0 = s_ps[tid] >> 8, m1 = s_ps[tid + 1] >> 8; for (int mt = m0; mt < m1; ++mt) MTE[mt] = tid; }
        if (tid == 0) MTE[511] = s_ps[32] >> 8;
    }
    for (int e = oblk(); e < 32; e += ogrid()) {
        const int c = (int)__hip_atomic_load(cnt + e, __ATOMIC_RELAXED, __HIP_MEMORY_SCOPE_AGENT);
        const int r0 = s_ps[e] + c, r1 = s_ps[e + 1];
        for (int r = r0 + wave; r < r1; r += 8) {
            if (lane == 0) { SSLOT[r] = -1; SW[r] = 0.f; }
            u32x4 z = {0u, 0u, 0u, 0u};
            *(u32x4*)(XS + (size_t)r * 1024 + lane * 8) = z; *(u32x4*)(XS + (size_t)r * 1024 + 512 + lane * 8) = z;
        }
    }
    for (int as = oblk() * 8 + wave; as < 2 * T; as += ogrid() * 8) {
        const int t = as >> 1;
        const int e = EID[as], rk = ERK[as];
        const int dest = s_ps[e] + rk;
        float tot = 0.f;
        if (lane < 16) tot = SS[(size_t)t * 16 + lane];
        tot = wsum(tot);
        const float rinv = rsqrtf(tot * (1.0f / 1024.0f) + 1e-6f);
        if (lane == 0) { SSLOT[dest] = as; SW[dest] = EW[as]; }
#pragma unroll
        for (int i = 0; i < 2; ++i) {
            const u32x4 w = *(const u32x4*)(XB + (size_t)t * 1024 + i * 512 + lane * 8);
            u32x4 o;
#pragma unroll
            for (int j = 0; j < 4; ++j) o[j] = pk2(lo16(w[j]) * rinv, hi16(w[j]) * rinv);
            *(u32x4*)(XS + (size_t)dest * 1024 + i * 512 + lane * 8) = o;
        }
    }
}

__device__ __forceinline__ void pj_finalize(const PA a) {
    const int wave = otid() >> 6, lane = otid() & 63;
    float* X = a.out; bf16_t* XB = WSP(bf16_t, WS_XB); float* SS = WSP(float, WS_SS);
    const bf16_t* Y = WSP(const bf16_t, WS_Y);
    for (int t = oblk() * 8 + wave; t < T; t += ogrid() * 8) {
        float sq = 0.f;
#pragma unroll
        for (int i = 0; i < 4; ++i) {
            const int c = i * 256 + lane * 4;
            f32x4 v = *(const f32x4*)(X + (size_t)t * 1024 + c);
            const u32x2 y0 = *(const u32x2*)(Y + (size_t)(2 * t) * 1024 + c), y1 = *(const u32x2*)(Y + (size_t)(2 * t + 1) * 1024 + c);
            v[0] += lo16(y0.x) + lo16(y1.x); v[1] += hi16(y0.x) + hi16(y1.x); v[2] += lo16(y0.y) + lo16(y1.y); v[3] += hi16(y0.y) + hi16(y1.y);
            *(f32x4*)(X + (size_t)t * 1024 + c) = v;
            u32x2 w; w.x = pk2(v[0], v[1]); w.y = pk2(v[2], v[3]);
            *(u32x2*)(XB + (size_t)t * 1024 + c) = w;
            sq += (v[0] * v[0] + v[1] * v[1]) + (v[2] * v[2] + v[3] * v[3]);
        }
        sq = wsum(sq);
        if (lane < 16) SS[(size_t)t * 16 + lane] = (lane == 0) ? sq : 0.f;
    }
}

#define SITE static __device__ __forceinline__ void
#define OPAQUE() do { asm volatile("" : "+s"(a.ws), "+s"(a.out)); } while (0)
__device__ __forceinline__ int opq(int v) { asm volatile("" : "+s"(v)); return v; }
SITE site_p0(PA a, LAS unsigned char* lds) { OPAQUE(); p0_prologue(a, lds); }
SITE site_kv(PA a, LAS unsigned char* lds) { OPAQUE();
    pg8::Gemm g{WSP(const bf16_t, WS_MEMB), WSP(const bf16_t, WS_WKV), 1024, (size_t)1024 * 1024};
    pg8::KvOrder S{opq((int)gridDim.x), opq((int)blockIdx.x)};
    pg8::EpiScale E{WSP(bf16_t, WS_KV), 1024, WSP(const float, WS_MEMSS), MROWS - 1};
    pg8::gemm_phase<pg8::EpiScale, pg8::KvOrder>(lds, g, S, E);
}
SITE site_knorm(PA a, LAS unsigned char* lds) { OPAQUE(); p2_knorm(a, lds); }
SITE site_inproj(PA a, int l, LAS unsigned char* lds) { OPAQUE();
    pg8::Gemm g{WSP(const bf16_t, WS_XB), WSP(const bf16_t, WS_WIN) + (size_t)l * INW * 1024, 1024, 0};
    pg8::StaticOrder S; S.init(T, INW, opq((int)gridDim.x), opq((int)blockIdx.x));
    pg8::EpiProj E{WSP(bf16_t, WS_PROJ), WSP(bf16_t, WS_VT), WSP(const float, WS_SS)};
    pg8::gemm_phase<pg8::EpiProj, pg8::StaticOrder>(lds, g, S, E);
}
SITE site_prep(PA a, int l, LAS unsigned char* lds) { OPAQUE();
    if (l > 0) moe_convert(a, l, lds);
    __syncthreads();
    pb_prep(a, l, lds);
}
SITE site_mixer(PA a, int l, LAS unsigned char* lds) { OPAQUE(); pc_mixer(a, l, lds); }
SITE site_outproj(PA a, int l, LAS unsigned char* lds) { OPAQUE();
    pg8::Gemm g{WSP(const bf16_t, WS_YCAT), WSP(const bf16_t, WS_WOUT) + (size_t)l * 1024 * 1024, 1024, 0};
    pg8::StaticOrder S; S.init(T, 1024, opq((int)gridDim.x), opq((int)blockIdx.x));
    pg8::EpiRes E{a.out, WSP(bf16_t, WS_XB), WSP(float, WS_SS)};
    pg8::gemm_phase<pg8::EpiRes, pg8::StaticOrder>(lds, g, S, E);
}
SITE site_xq(PA a, int l, LAS unsigned char* lds) { OPAQUE();
    pg8::Gemm g{WSP(const bf16_t, WS_XB), WSP(const bf16_t, WS_WQ) + (size_t)l * 512 * 1024, 1024, 0};
    pg8::StaticOrder S; S.init(T, 512, opq((int)gridDim.x), opq((int)blockIdx.x));
    pg8::EpiScale E{WSP(bf16_t, WS_QX), 512, WSP(const float, WS_SS), T - 1};
    pg8::gemm_phase<pg8::EpiScale, pg8::StaticOrder>(lds, g, S, E);
}
SITE site_xattn(PA a, int l, LAS unsigned char* lds) { OPAQUE(); pe2_xattn(a, l, lds); }
SITE site_xo(PA a, int l, LAS unsigned char* lds) { OPAQUE();
    pg8::Gemm g{WSP(const bf16_t, WS_OX), WSP(const bf16_t, WS_WO) + (size_t)l * 1024 * 512, 512, 0};
    pg8::StaticOrder S; S.init(T, 1024, opq((int)gridDim.x), opq((int)blockIdx.x));
    pg8::EpiRes E{a.out, WSP(bf16_t, WS_XB), WSP(float, WS_SS)};
    pg8::gemm_phase<pg8::EpiRes, pg8::StaticOrder>(lds, g, S, E);
}
SITE site_router(PA a, int l, LAS unsigned char* lds) { OPAQUE(); pf_router(a, l, lds); }
SITE site_gather(PA a, int l, LAS unsigned char* lds) { OPAQUE(); pg_gather(a, l, lds); }
SITE site_gu(PA a, LAS unsigned char* lds) { OPAQUE();
    pg8::Gemm g{WSP(const bf16_t, WS_XS), WSP(const bf16_t, WS_WGU), 1024, (size_t)1024 * 1024};
    pg8::MoeOrder S{WSP(const int, WS_MTE), opq((int)gridDim.x), opq((int)blockIdx.x)};
    pg8::EpiGU E{WSP(bf16_t, WS_HB)};
    pg8::gemm_phase<pg8::EpiGU, pg8::MoeOrder>(lds, g, S, E);
}
SITE site_down(PA a, LAS unsigned char* lds) { OPAQUE();
    pg8::Gemm g{WSP(const bf16_t, WS_HB), WSP(const bf16_t, WS_WD), 512, (size_t)1024 * 512};
    pg8::MoeOrder S{WSP(const int, WS_MTE), opq((int)gridDim.x), opq((int)blockIdx.x)};
    pg8::EpiDown E{WSP(bf16_t, WS_Y), WSP(const int, WS_SSLOT), WSP(const float, WS_SW)};
    pg8::gemm_phase<pg8::EpiDown, pg8::MoeOrder>(lds, g, S, E);
}
SITE site_final(PA a, LAS unsigned char* lds) { OPAQUE(); pj_finalize(a); }

__global__ void __launch_bounds__(512, 2) mk_fwd(Args args) {
    extern __shared__ __attribute__((aligned(16))) unsigned char lds_raw[];
    LAS unsigned char* lds = (LAS unsigned char*)lds_raw;
    const int tid = threadIdx.x;
    const int lo = args.ph_lo, hi = args.ph_hi;
    PA a; a.out = args.out; a.ws = args.ws;
    if (tid < 16) ((LAS unsigned*)(lds + LDS_MISC))[tid] = 0u;
    if (tid == 64) {
        LAS unsigned long long* tab = (LAS unsigned long long*)(lds + LDS_INTAB);
#pragma unroll
        for (int i = 0; i < 38; ++i) tab[i] = (unsigned long long)args.in[i];
    }
    __syncthreads();
    XcdBarrier bar; bar.bar = WSP(unsigned, WS_CTL) + CW_BAR; bar.x = 0; bar.st = nullptr;
    if (!MK_PER_PHASE) bar = xcd_barrier_post(WSP(unsigned, WS_CTL) + CW_BAR, (volatile LAS unsigned*)(lds + LDS_MISC));
#define IN(k) (lo <= (k) && (k) < hi)
#define GRID_BAR() do { if (!MK_PER_PHASE) xcd_barrier(bar); } while (0)
    if (IN(0)) { site_p0(a, lds); GRID_BAR(); }
    if (IN(1)) { site_kv(a, lds); GRID_BAR(); }
    if (IN(2)) { site_knorm(a, lds); GRID_BAR(); }
    for (int l = 0; l < NL; ++l) {
        const int pb = 3 + 12 * l;
        if (IN(pb + 0)) { site_inproj(a, l, lds); GRID_BAR(); }
        if (IN(pb + 1)) { site_prep(a, l, lds); GRID_BAR(); }
        if (IN(pb + 2)) { site_mixer(a, l, lds); GRID_BAR(); }
        if (IN(pb + 3)) { site_outproj(a, l, lds); GRID_BAR(); }
        if (IN(pb + 4)) { site_xq(a, l, lds); GRID_BAR(); }
        if (IN(pb + 5)) { site_xattn(a, l, lds); GRID_BAR(); }
        if (IN(pb + 6)) { site_xo(a, l, lds); GRID_BAR(); }
        if (IN(pb + 7)) { site_router(a, l, lds); GRID_BAR(); }
        if (IN(pb + 8)) { site_gather(a, l, lds); GRID_BAR(); }
        if (IN(pb + 9)) { site_gu(a, lds); GRID_BAR(); }
        if (IN(pb + 10)) { site_down(a, lds); GRID_BAR(); }
        if (IN(pb + 11)) { site_final(a, lds); if (l + 1 < NL) GRID_BAR(); }
    }
#undef IN
#undef GRID_BAR
}

extern "C" void kernel_launch(void* const* d_in, const int* in_sizes, int n_in, void* d_out, int out_size, void* d_ws, size_t ws_size, hipStream_t stream) {
    static int grid = 0;
    if (grid == 0) {
        if (n_in != 38 || out_size != T * D || ws_size < WS_END) { fprintf(stderr, "kernel_launch: unexpected shapes (n_in %d out %d ws %zu need %zu)\n", n_in, out_size, ws_size, (size_t)WS_END); grid = -1; return; }
        int dev = 0, cus = 0, per_cu = 0;
        if (hipGetDevice(&dev) != hipSuccess || hipDeviceGetAttribute(&cus, hipDeviceAttributeMultiprocessorCount, dev) != hipSuccess) { grid = -1; return; }
        if (hipFuncSetAttribute((const void*)mk_fwd, hipFuncAttributeMaxDynamicSharedMemorySize, LDS_BYTES) != hipSuccess) { fprintf(stderr, "kernel_launch: hipFuncSetAttribute failed\n"); grid = -1; return; }
        if (hipOccupancyMaxActiveBlocksPerMultiprocessor(&per_cu, (const void*)mk_fwd, 512, LDS_BYTES) != hipSuccess || per_cu < 1) { fprintf(stderr, "kernel_launch: occupancy query says %d\n", per_cu); }
        (void)hipGetLastError();
        grid = cus;
    }
    if (grid < 0) return;
    (void)hipMemsetAsync((char*)d_ws + WS_CTL, 0, CTL_BYTES, stream);
    Args a{};
    for (int i = 0; i < 38; ++i) a.in[i] = (const float*)d_in[i];
    a.out = (float*)d_out; a.ws = (unsigned char*)d_ws;
#if MK_PER_PHASE
    for (int p = 0; p < NPH; ++p) { a.ph_lo = p; a.ph_hi = p + 1; hipLaunchKernelGGL(mk_fwd, dim3(grid), dim3(512), LDS_BYTES, stream, a); }
#else
    a.ph_lo = 0; a.ph_hi = NPH;
    hipLaunchKernelGGL(mk_fwd, dim3(grid), dim3(512), LDS_BYTES, stream, a);
#endif
}
```

```cpp
#include <hip/hip_runtime.h>
#include <cstdio>
#include <cstdint>

#ifndef MK_PER_PHASE
#define MK_PER_PHASE 0
#endif

#define LAS __attribute__((address_space(3)))
typedef unsigned short bf16_t;
typedef short bf16x8 __attribute__((ext_vector_type(8)));
typedef float f32x4 __attribute__((ext_vector_type(4)));
typedef unsigned u32x4 __attribute__((ext_vector_type(4)));
typedef unsigned u32x2 __attribute__((ext_vector_type(2)));

constexpr int T = 32768, D = 1024, SEQ = 2048, NL = 4;
constexpr int INW = 3328;
constexpr int MROWS = 4096;
constexpr int MAXROWS = 73728, MAXMT = 288;
constexpr int NPH = 3 + 12 * NL;

constexpr size_t WS_CTL   = 0;
constexpr size_t CTL_BYTES = 65536;
constexpr size_t WS_WIN   = WS_CTL + CTL_BYTES;
constexpr size_t WS_WOUT  = WS_WIN  + (size_t)4 * 3328 * 1024 * 2;
constexpr size_t WS_WQ    = WS_WOUT + (size_t)4 * 1024 * 1024 * 2;
constexpr size_t WS_WKV   = WS_WQ   + (size_t)4 * 512 * 1024 * 2;
constexpr size_t WS_WO    = WS_WKV  + (size_t)4 * 1024 * 1024 * 2;
constexpr size_t WS_WGU   = WS_WO   + (size_t)4 * 1024 * 512 * 2;
constexpr size_t WS_WD    = WS_WGU  + (size_t)32 * 1024 * 1024 * 2;
constexpr size_t WS_KV    = WS_WD   + (size_t)32 * 1024 * 512 * 2;
constexpr size_t WS_MEMB  = WS_KV   + (size_t)4 * 4096 * 1024 * 2;
constexpr size_t WS_MEMSS = WS_MEMB + (size_t)4096 * 1024 * 2;
constexpr size_t WS_VTX   = WS_MEMSS + (size_t)4096 * 16 * 4;
constexpr size_t WS_WRH   = WS_VTX  + (size_t)4 * 4096 * 512 * 2;
constexpr size_t WS_WRL   = WS_WRH  + (size_t)4 * 48 * 1024 * 2;
constexpr size_t WS_XB    = WS_WRL  + (size_t)4 * 48 * 1024 * 2;
constexpr size_t WS_SS    = WS_XB   + (size_t)T * 1024 * 2;
constexpr size_t WS_VF    = WS_SS   + (size_t)T * 16 * 4;
constexpr size_t WS_EID   = WS_VF   + (size_t)T * 512 * 2;
constexpr size_t WS_EW    = WS_EID  + (size_t)T * 2 * 4;
constexpr size_t WS_ERK   = WS_EW   + (size_t)T * 2 * 4;
constexpr size_t WS_SSLOT = WS_ERK  + (size_t)T * 2 * 4;
constexpr size_t WS_SW    = WS_SSLOT + (size_t)MAXROWS * 4;
constexpr size_t WS_MTE   = WS_SW   + (size_t)MAXROWS * 4;
constexpr size_t WS_U     = WS_MTE  + 2048;
constexpr size_t WS_PROJ  = WS_U;
constexpr size_t WS_SR    = WS_PROJ + (size_t)T * 3328 * 2;
constexpr size_t WS_SK    = WS_SR   + (size_t)T * 512 * 2;
constexpr size_t WS_SV    = WS_SK   + (size_t)T * 512 * 2;
constexpr size_t WS_SA    = WS_SV   + (size_t)T * 512 * 2;
constexpr size_t WS_SB    = WS_SA   + (size_t)T * 512 * 2;
constexpr size_t WS_SG    = WS_SB   + (size_t)T * 512 * 2;
constexpr size_t WS_SWD   = WS_SG   + (size_t)T * 512 * 2;
constexpr size_t WS_YCAT  = WS_SWD  + (size_t)T * 512 * 4;
constexpr size_t WS_VT    = WS_YCAT + (size_t)T * 1024 * 2;
constexpr int NCHUNK = 16 * 8 * 128;
constexpr size_t WS_BTT   = WS_VT   + (size_t)T * 512 * 2;
constexpr size_t WS_KTT   = WS_BTT  + (size_t)NCHUNK * 2048;
constexpr size_t WS_VST   = WS_KTT  + (size_t)NCHUNK * 2048;
constexpr size_t WS_NKA   = WS_VST  + (size_t)NCHUNK * 2048;
constexpr size_t WS_NBR   = WS_NKA  + (size_t)NCHUNK * 512;
constexpr size_t WS_NKR   = WS_NBR  + (size_t)NCHUNK * 512;
constexpr size_t WS_TMT   = WS_NKR  + (size_t)NCHUNK * 512;
constexpr size_t WS_PCK   = WS_TMT  + (size_t)NCHUNK * 512;
constexpr size_t WS_BS    = WS_PCK  + (size_t)NCHUNK * 256;
constexpr size_t WS_UEND1 = WS_BS   + (size_t)T * 8 * 4;
constexpr size_t WS_QX    = WS_U;
constexpr size_t WS_OX    = WS_QX   + (size_t)T * 512 * 2;
constexpr size_t WS_XS    = WS_U;
constexpr size_t WS_HB    = WS_XS   + (size_t)MAXROWS * 1024 * 2;
constexpr size_t WS_Y     = WS_HB   + (size_t)MAXROWS * 512 * 2;
constexpr size_t WS_UEND2 = WS_Y    + (size_t)2 * T * 1024 * 2;
constexpr size_t WS_END   = WS_UEND1 > WS_UEND2 ? WS_UEND1 : WS_UEND2;

constexpr int CW_BAR = 0;
constexpr int CW_CNT = 4096;
constexpr int CW_QUEUE = 4096 + 256;

constexpr int LDS_MISC = 139264;
constexpr int LDS_BYTES = LDS_MISC + 16384;

struct Args { const float* in[38]; float* out; unsigned char* ws; int ph_lo, ph_hi; };
struct PA { float* out; unsigned char* ws; };

__device__ __forceinline__ float bf2f(bf16_t b) { return __uint_as_float(((unsigned)b) << 16); }
__device__ __forceinline__ bf16_t f2bf(float f) { unsigned u = __float_as_uint(f); u += 0x7FFFu + ((u >> 16) & 1u); return (bf16_t)(u >> 16); }
typedef __bf16 bf16v2 __attribute__((ext_vector_type(2)));
typedef float f32x2 __attribute__((ext_vector_type(2)));
__device__ __forceinline__ unsigned pk2(float lo, float hi) { f32x2 v = {lo, hi}; bf16v2 b = __builtin_convertvector(v, bf16v2); return __builtin_bit_cast(unsigned, b); }
__device__ __forceinline__ float lo16(unsigned u) { return __uint_as_float(u << 16); }
__device__ __forceinline__ float hi16(unsigned u) { return __uint_as_float(u & 0xffff0000u); }
__device__ __forceinline__ float wsum(float v) {
#pragma unroll
    for (int o = 32; o; o >>= 1) v += __shfl_xor(v, o);
    return v;
}
__device__ __forceinline__ float sigmoidf_(float x) { return 1.0f / (1.0f + __expf(-x)); }

#define XB_TMO      128
#define XB_XCNT(j)  (256  + 64 * (j))
#define XB_XSUB(j)  (1280 + 64 * (j))
#define XB_XGEN(j)  (2304 + 64 * (j))
#define XB_TOP      3328
#define XB_TOPGEN   3392
#define XCD_BAR_WORDS 3456
#define XB_SPIN_CAP (1u << 22)

__device__ __forceinline__ unsigned xb_ld(unsigned* p)              { return __hip_atomic_load(p, __ATOMIC_RELAXED, __HIP_MEMORY_SCOPE_AGENT); }
__device__ __forceinline__ unsigned xb_add(unsigned* p, unsigned v) { return __hip_atomic_fetch_add(p, v, __ATOMIC_RELAXED, __HIP_MEMORY_SCOPE_AGENT); }
__device__ __forceinline__ unsigned xb_xcc_id() { return (unsigned)__builtin_amdgcn_s_getreg((3 << 11) | 20) & 0xFu; }
#define XB_SPIN(cond, bar) do { unsigned _sp = 0; while (cond) { __builtin_amdgcn_s_sleep(1); \
    if ((++_sp & 255u) == 0u) { if (xb_ld(&(bar)[XB_TMO])) break; if (_sp > XB_SPIN_CAP) { atomicAdd(&(bar)[XB_TMO], 1u); break; } } } } while (0)

struct XcdBarrier { unsigned* bar; unsigned x; volatile LAS unsigned* st; };

__device__ __forceinline__ XcdBarrier xcd_barrier_post(unsigned* bar, volatile LAS unsigned* st) {
    XcdBarrier b; b.bar = bar; b.x = xb_xcc_id(); b.st = st;
    if (threadIdx.x == 0) (void)xb_add(&bar[XB_XCNT(b.x)], 1u);
    return b;
}
__device__ __forceinline__ void xcd_barrier_complete(unsigned* bar, unsigned x, unsigned& nloc, unsigned& nx) {
    const unsigned G = gridDim.x * gridDim.y * gridDim.z;
    unsigned sum, cnt, mine, sp = 0u;
    for (;;) {
        sum = 0u; cnt = 0u; mine = 0u;
#pragma unroll
        for (unsigned j = 0; j < 16; ++j) { const unsigned c = xb_ld(&bar[XB_XCNT(j)]); sum += c; cnt += (c > 0u) ? 1u : 0u; mine = (j == x) ? c : mine; }
        if (sum == G) break;
        __builtin_amdgcn_s_sleep(1);
        if ((++sp & 255u) == 0u) { if (xb_ld(&bar[XB_TMO])) break; if (sp > XB_SPIN_CAP) { atomicAdd(&bar[XB_TMO], 1u); break; } }
    }
    nloc = mine > 0u ? mine : 1u; nx = cnt > 0u ? cnt : 1u;
}
__device__ __forceinline__ void xcd_barrier(const XcdBarrier& b) {
    asm volatile("s_waitcnt vmcnt(0)" ::: "memory");
    __syncthreads();
    if (threadIdx.x == 0) {
        unsigned* bar = b.bar;
        __builtin_amdgcn_s_waitcnt(0);
        unsigned nloc = b.st[0], nx = b.st[1];
        if (nloc == 0u) { xcd_barrier_complete(bar, b.x, nloc, nx); b.st[0] = nloc; b.st[1] = nx; }
        const unsigned old = xb_add(&bar[XB_XSUB(b.x)], 1u);
        const unsigned gen = old / nloc;
        if (old + 1u == (gen + 1u) * nloc) {
            __builtin_amdgcn_fence(__ATOMIC_RELEASE, "agent");
            asm volatile("s_waitcnt vmcnt(0)" ::: "memory");
            const unsigned og = xb_add(&bar[XB_TOP], 1u);
            const unsigned tg = og / nx;
            if (og + 1u == (tg + 1u) * nx) xb_add(&bar[XB_TOPGEN], 1u);
            else XB_SPIN(xb_ld(&bar[XB_TOPGEN]) == tg, bar);
            __builtin_amdgcn_fence(__ATOMIC_ACQUIRE, "agent");
            xb_add(&bar[XB_XGEN(b.x)], 1u);
            asm volatile("s_waitcnt vmcnt(0)" ::: "memory");
        } else {
            XB_SPIN(xb_ld(&bar[XB_XGEN(b.x)]) == gen, bar);
            __builtin_amdgcn_fence(__ATOMIC_ACQUIRE, "agent");
            asm volatile("s_waitcnt vmcnt(0)" ::: "memory");
        }
    }
    __syncthreads();
}

namespace pg8 {
constexpr int BM = 256, BK = 64, HALF = 128, HTB = HALF * BK * 2, STAGE_BYTES = 8 * HTB, NXCD = 8, WGM = 8;
__host__ __device__ __forceinline__ int lds_byte(int r, int c) { const int st = (r >> 4) * 2 + (c >> 5), rr = r & 15, cc = c & 31, ob = rr * 64 + cc * 2; return st * 1024 + (ob ^ (((ob >> 9) & 1) << 5)); }
__host__ __device__ __forceinline__ void stage_rc(int b, int& R, int& C) { const int st = b / 1024, sb = b % 1024, swz = sb ^ (((sb >> 9) & 1) << 5); R = (st >> 1) * 16 + swz / 64; C = (st & 1) * 32 + (swz % 64) / 2; }
__host__ __device__ __forceinline__ int perm32(int rho) { const int n = rho >> 4, i = rho & 15; return 8 * (i >> 2) + 4 * n + (i & 3); }

struct Unit { int pm, pn, pa, z; };
struct Gemm { const bf16_t* A; const bf16_t* Bt; int K; size_t bz_stride; };

struct StaticOrder {
    int nM, nN, nwg, G, c;
    __device__ void init(int M, int N, int G_, int c_) { nM = M / BM; nN = N / BM; nwg = nM * nN; G = G_; c = c_; }
    __device__ bool next(int i, Unit& u) const {
        const long L = (long)i * G + c; if (L >= nwg) return false;
        int wgid = (int)L; { const int q = nwg / NXCD, r = nwg % NXCD, xcd = wgid % NXCD, off = wgid / NXCD; wgid = (xcd < r ? xcd * (q + 1) : r * (q + 1) + (xcd - r) * q) + off; }
        const int nig = WGM * nN, gid = wgid / nig, fm = gid * WGM, gsz = (nM - fm) < WGM ? (nM - fm) : WGM;
        u.pm = fm + ((wgid % nig) % gsz); u.pn = (wgid % nig) / gsz; u.pa = u.pm; u.z = 0; return true;
    }
};
struct KvOrder {
    int G, c;
    __device__ bool next(int i, Unit& u) const {
        const int L = i * G + c; if (L >= 256) return false;
        u.z = L >> 6; const int r = L & 63; u.pa = r >> 2; u.pn = r & 3; u.pm = u.z * 16 + u.pa; return true;
    }
};
struct MoeOrder {
    const int* mte; int G, c;
    __device__ bool next(int i, Unit& u) const {
        const int nunits = mte[511] * 4;
        const int L = i * G + c; if (L >= nunits) return false;
        u.pm = L >> 2; u.pa = u.pm; u.pn = L & 3; u.z = mte[u.pm]; return true;
    }
};

template <class Epi, class Sched, bool ALIGN_EPI = true>
__device__ __forceinline__ void gemm_phase(LAS unsigned char* lds, const Gemm g, const Sched& S, const Epi& E) {
    int tid_ = threadIdx.x; asm volatile("" : "+v"(tid_));
    const int tid = tid_, wid = __builtin_amdgcn_readfirstlane(tid >> 6), lane = tid & 63, wr = wid >> 2, wc = wid & 3, fr = lane & 15, fq = lane >> 4;
    const int K = g.K, nt = K / BK;
    unsigned voffA[2], voffB[2];
#pragma unroll
    for (int i = 0; i < 2; ++i) { int R, C; stage_rc(tid * 16 + i * 8192, R, C); const int Rb = ((R & ~31) + perm32(R & 31));
        voffA[i] = (unsigned)(R * K + C) * 2u; voffB[i] = (unsigned)(Rb * K + C) * 2u; }
    const size_t kstep = (size_t)(BK * 2);
    const size_t hstep = (size_t)HALF * K * 2;
    const size_t tstep = 2 * hstep;
    const unsigned ldsw = (unsigned)wid * 1024u;
    const int aoff = lds_byte(wr * 64 + fr, fq * 8), boff = lds_byte(wc * 32 + fr, fq * 8);
#define PG8_SA(b, h) (((b) * 2 + (h)) * HTB)
#define PG8_SB(b, h) ((4 + (b) * 2 + (h)) * HTB)
#define PG8_STAGE(bufoff, gbase, voff) do { _Pragma("unroll") for (int _i = 0; _i < 2; ++_i) \
        __builtin_amdgcn_global_load_lds((const unsigned*)((const char*)(gbase) + (voff)[_i]), (LAS unsigned*)(lds + (bufoff) + ldsw + _i * 8192), 16, 0, 0); } while (0)
#define PG8_LDA(dst, b, h) do { _Pragma("unroll") for (int m = 0; m < 4; ++m) _Pragma("unroll") for (int k = 0; k < 2; ++k) dst[m][k] = *(const LAS bf16x8*)(lds + PG8_SA(b, h) + aoff + m * 2048 + k * 1024); } while (0)
#define PG8_LDB(dst, b, h) do { _Pragma("unroll") for (int n = 0; n < 2; ++n) _Pragma("unroll") for (int k = 0; k < 2; ++k) dst[n][k] = *(const LAS bf16x8*)(lds + PG8_SB(b, h) + boff + n * 2048 + k * 1024); } while (0)
#define PG8_MMA(ai, bj, At, Bt) do { __builtin_amdgcn_s_setprio(1); _Pragma("unroll") for (int m = 0; m < 4; ++m) _Pragma("unroll") for (int n = 0; n < 2; ++n) _Pragma("unroll") for (int k = 0; k < 2; ++k) \
        acc[ai][bj][m][n] = __builtin_amdgcn_mfma_f32_16x16x32_bf16(Bt[n][k], At[m][k], acc[ai][bj][m][n], 0, 0, 0); __builtin_amdgcn_s_setprio(0); } while (0)
#define PG8_WAIT_V(n) asm volatile("s_waitcnt vmcnt(" #n ")" ::: "memory")
#define PG8_WAIT_L(n) asm volatile("s_waitcnt lgkmcnt(" #n ")" ::: "memory")
#define PG8_BAR __builtin_amdgcn_s_barrier()
#define PG8_SCHED __builtin_amdgcn_sched_barrier(0)
#define PG8_APTR(u) ((const char*)g.A + (size_t)(u).pa * tstep)
#define PG8_BPTR(u) ((const char*)g.Bt + ((size_t)(u).z * g.bz_stride) * 2 + (size_t)(u).pn * tstep)
    Unit cur, nxt; int ui = 0;
    if (!S.next(0, cur)) return;
    f32x4 acc[2][2][4][2];
#pragma unroll
    for (int a = 0; a < 2; ++a)
#pragma unroll
        for (int b = 0; b < 2; ++b)
#pragma unroll
            for (int m = 0; m < 4; ++m)
#pragma unroll
                for (int n = 0; n < 2; ++n) acc[a][b][m][n] = (f32x4){0.f, 0.f, 0.f, 0.f};
    bf16x8 At[4][2], B0[2][2], B1[2][2];
    const char* cA = PG8_APTR(cur); const char* cB = PG8_BPTR(cur);
    PG8_STAGE(PG8_SB(0, 0), cB, voffB); PG8_STAGE(PG8_SB(0, 1), cB + hstep, voffB); PG8_STAGE(PG8_SA(0, 0), cA, voffA); PG8_STAGE(PG8_SA(0, 1), cA + hstep, voffA);
    if (wr == 1) PG8_BAR;
    PG8_WAIT_V(2); PG8_BAR;
    PG8_STAGE(PG8_SB(1, 0), cB + kstep, voffB); PG8_STAGE(PG8_SA(1, 0), cA + kstep, voffA); PG8_STAGE(PG8_SB(1, 1), cB + hstep + kstep, voffB);
    PG8_WAIT_V(6); PG8_BAR;
    for (;;) {
        const bool has_next = S.next(ui + 1, nxt);
        const char* nA = has_next ? PG8_APTR(nxt) : cA; const char* nB = has_next ? PG8_BPTR(nxt) : cB;
        for (int t = 0; t < nt; t += 2) {
            const bool last = (t == nt - 2);
            const char* a1 = cA + (size_t)(t + 1) * kstep;
            const char* a2 = last ? nA : cA + (size_t)(t + 2) * kstep; const char* b2 = last ? nB : cB + (size_t)(t + 2) * kstep;
            const char* a3 = a2 + kstep; const char* b3 = b2 + kstep;
            PG8_LDB(B0, 0, 0); PG8_LDB(B1, 0, 1); PG8_SCHED; PG8_LDA(At, 0, 0); PG8_STAGE(PG8_SA(1, 1), a1 + hstep, voffA);
            PG8_WAIT_V(8); PG8_WAIT_L(0); PG8_BAR; PG8_MMA(0, 0, At, B0); PG8_MMA(0, 1, At, B1); PG8_BAR; PG8_SCHED;
            PG8_LDA(At, 0, 1); PG8_STAGE(PG8_SB(0, 0), b2, voffB); PG8_STAGE(PG8_SB(0, 1), b2 + hstep, voffB); PG8_STAGE(PG8_SA(0, 0), a2, voffA);
            PG8_WAIT_V(8); PG8_WAIT_L(0); PG8_BAR; PG8_MMA(1, 0, At, B0); PG8_MMA(1, 1, At, B1); PG8_BAR; PG8_SCHED;
            PG8_LDB(B0, 1, 0); PG8_LDB(B1, 1, 1); PG8_SCHED; PG8_LDA(At, 1, 0); PG8_STAGE(PG8_SA(0, 1), a2 + hstep, voffA);
            PG8_WAIT_V(8); PG8_WAIT_L(0); PG8_BAR; PG8_MMA(0, 0, At, B0); PG8_MMA(0, 1, At, B1); PG8_BAR; PG8_SCHED;
            PG8_LDA(At, 1, 1); PG8_STAGE(PG8_SB(1, 0), b3, voffB); PG8_STAGE(PG8_SB(1, 1), b3 + hstep, voffB); PG8_STAGE(PG8_SA(1, 0), a3, voffA);
            PG8_WAIT_V(8); PG8_WAIT_L(0); PG8_BAR; PG8_MMA(1, 0, At, B0); PG8_MMA(1, 1, At, B1); PG8_BAR; PG8_SCHED;
        }
        if constexpr (ALIGN_EPI) { if (wr == 0) PG8_BAR; }
        E(acc, cur, wr, wc, fr, fq);
        if (!has_next) break;
#pragma unroll
        for (int a = 0; a < 2; ++a)
#pragma unroll
            for (int b = 0; b < 2; ++b)
#pragma unroll
                for (int m = 0; m < 4; ++m)
#pragma unroll
                    for (int n = 0; n < 2; ++n) acc[a][b][m][n] = (f32x4){0.f, 0.f, 0.f, 0.f};
        cur = nxt; cA = nA; cB = nB; ++ui;
        if constexpr (ALIGN_EPI) { if (wr == 1) PG8_BAR; }
    }
    PG8_WAIT_V(0);
    if constexpr (!ALIGN_EPI) { if (wr == 0) PG8_BAR; }
    PG8_BAR;
#undef PG8_SA
#undef PG8_SB
#undef PG8_STAGE
#undef PG8_LDA
#undef PG8_LDB
#undef PG8_MMA
#undef PG8_WAIT_V
#undef PG8_WAIT_L
#undef PG8_BAR
#undef PG8_SCHED
#undef PG8_APTR
#undef PG8_BPTR
}

typedef const f32x4 (&AccRef)[2][2][4][2];

struct EpiScale {
    bf16_t* O; int ldc; const float* ss; int ssmask;
    __device__ __forceinline__ void operator()(AccRef acc, const Unit& u, int wr, int wc, int fr, int fq) const {
#pragma unroll
        for (int ai = 0; ai < 2; ++ai)
#pragma unroll
            for (int m = 0; m < 4; ++m) {
                const int row = u.pm * 256 + ai * 128 + wr * 64 + m * 16 + fr;
                const f32x4* sp = (const f32x4*)(ss + (size_t)(row & ssmask) * 16);
                const f32x4 s0 = sp[0], s1 = sp[1], s2 = sp[2], s3 = sp[3];
                const float tot = ((s0[0] + s0[1]) + (s0[2] + s0[3])) + ((s1[0] + s1[1]) + (s1[2] + s1[3])) + ((s2[0] + s2[1]) + (s2[2] + s2[3])) + ((s3[0] + s3[1]) + (s3[2] + s3[3]));
                const float rinv = rsqrtf(tot * (1.0f / 1024.0f) + 1e-6f);
#pragma unroll
                for (int bj = 0; bj < 2; ++bj) {
                    const int col = u.pn * 256 + bj * 128 + wc * 32 + 8 * fq;
                    const f32x4 v0 = acc[ai][bj][m][0] * rinv, v1 = acc[ai][bj][m][1] * rinv;
                    u32x4 w; w.x = pk2(v0[0], v0[1]); w.y = pk2(v0[2], v0[3]); w.z = pk2(v1[0], v1[1]); w.w = pk2(v1[2], v1[3]);
                    *(u32x4*)(O + (size_t)row * ldc + col) = w;
                }
            }
    }
};
struct EpiProj {
    bf16_t* O; bf16_t* VT; const float* ss;
    __device__ __forceinline__ void operator()(AccRef acc, const Unit& u, int wr, int wc, int fr, int fq) const {
#pragma unroll
        for (int ai = 0; ai < 2; ++ai)
#pragma unroll
            for (int m = 0; m < 4; ++m) {
                const int row = u.pm * 256 + ai * 128 + wr * 64 + m * 16 + fr;
                const f32x4* sp = (const f32x4*)(ss + (size_t)row * 16);
                const f32x4 s0 = sp[0], s1 = sp[1], s2 = sp[2], s3 = sp[3];
                const float tot = ((s0[0] + s0[1]) + (s0[2] + s0[3])) + ((s1[0] + s1[1]) + (s1[2] + s1[3])) + ((s2[0] + s2[1]) + (s2[2] + s2[3])) + ((s3[0] + s3[1]) + (s3[2] + s3[3]));
                const float rinv = rsqrtf(tot * (1.0f / 1024.0f) + 1e-6f);
#pragma unroll
                for (int bj = 0; bj < 2; ++bj) {
                    const int col = u.pn * 256 + bj * 128 + wc * 32 + 8 * fq;
                    const f32x4 v0 = acc[ai][bj][m][0] * rinv, v1 = acc[ai][bj][m][1] * rinv;
                    u32x4 w; w.x = pk2(v0[0], v0[1]); w.y = pk2(v0[2], v0[3]); w.z = pk2(v1[0], v1[1]); w.w = pk2(v1[2], v1[3]);
                    if (u.pn < 11) *(u32x4*)(O + (size_t)row * INW + col) = w;
                    else {
                        const int cv = col - 2816;
                        bf16_t* vp = VT + ((size_t)((row >> 11) * 8 + (cv >> 6)) * 64 + (cv & 63)) * 2048 + (row & 2047);
#pragma unroll
                        for (int e = 0; e < 4; ++e) { vp[(size_t)(2 * e) * 2048] = (bf16_t)(w[e] & 0xffffu); vp[(size_t)(2 * e + 1) * 2048] = (bf16_t)(w[e] >> 16); }
                    }
                }
            }
    }
};
struct EpiRes {
    float* X; bf16_t* XB; float* SS;
    __device__ __forceinline__ void operator()(AccRef acc, const Unit& u, int wr, int wc, int fr, int fq) const {
#pragma unroll
        for (int ai = 0; ai < 2; ++ai)
#pragma unroll
            for (int m = 0; m < 4; ++m) {
                const int row = u.pm * 256 + ai * 128 + wr * 64 + m * 16 + fr;
                float sq = 0.f;
#pragma unroll
                for (int bj = 0; bj < 2; ++bj) {
                    const int col = u.pn * 256 + bj * 128 + wc * 32 + 8 * fq;
                    float* xp = X + (size_t)row * 1024 + col;
                    f32x4 x0 = *(const f32x4*)xp, x1 = *(const f32x4*)(xp + 4);
                    x0 += acc[ai][bj][m][0]; x1 += acc[ai][bj][m][1];
                    *(f32x4*)xp = x0; *(f32x4*)(xp + 4) = x1;
                    u32x4 w; w.x = pk2(x0[0], x0[1]); w.y = pk2(x0[2], x0[3]); w.z = pk2(x1[0], x1[1]); w.w = pk2(x1[2], x1[3]);
                    *(u32x4*)(XB + (size_t)row * 1024 + col) = w;
                    sq += (x0[0] * x0[0] + x0[1] * x0[1]) + (x0[2] * x0[2] + x0[3] * x0[3]) + (x1[0] * x1[0] + x1[1] * x1[1]) + (x1[2] * x1[2] + x1[3] * x1[3]);
                }
                sq += __shfl_xor(sq, 16); sq += __shfl_xor(sq, 32);
                if (fq == 0) SS[(size_t)row * 16 + u.pn * 4 + wc] = sq;
            }
    }
};
struct EpiGU {
    bf16_t* H;
    __device__ __forceinline__ void operator()(AccRef acc, const Unit& u, int wr, int wc, int fr, int fq) const {
#pragma unroll
        for (int ai = 0; ai < 2; ++ai)
#pragma unroll
            for (int m = 0; m < 4; ++m) {
                const int row = u.pm * 256 + ai * 128 + wr * 64 + m * 16 + fr;
                float h[8];
#pragma unroll
                for (int n = 0; n < 2; ++n)
#pragma unroll
                    for (int j = 0; j < 4; ++j) { const float gt = acc[ai][0][m][n][j], up = acc[ai][1][m][n][j]; h[n * 4 + j] = gt * __builtin_amdgcn_rcpf(1.0f + __expf(-gt)) * up; }
                u32x4 w; w.x = pk2(h[0], h[1]); w.y = pk2(h[2], h[3]); w.z = pk2(h[4], h[5]); w.w = pk2(h[6], h[7]);
                *(u32x4*)(H + (size_t)row * 512 + u.pn * 128 + wc * 32 + 8 * fq) = w;
            }
    }
};
struct EpiDown {
    bf16_t* Y; const int* slot; const float* sw;
    __device__ __forceinline__ void operator()(AccRef acc, const Unit& u, int wr, int wc, int fr, int fq) const {
#pragma unroll
        for (int ai = 0; ai < 2; ++ai)
#pragma unroll
            for (int m = 0; m < 4; ++m) {
                const int row = u.pm * 256 + ai * 128 + wr * 64 + m * 16 + fr;
                const int s = slot[row]; const float wgt = sw[row];
                if (s >= 0) {
#pragma unroll
                    for (int bj = 0; bj < 2; ++bj) {
                        const int col = u.pn * 256 + bj * 128 + wc * 32 + 8 * fq;
                        const f32x4 v0 = acc[ai][bj][m][0] * wgt, v1 = acc[ai][bj][m][1] * wgt;
                        u32x4 w; w.x = pk2(v0[0], v0[1]); w.y = pk2(v0[2], v0[3]); w.z = pk2(v1[0], v1[1]); w.w = pk2(v1[2], v1[3]);
                        *(u32x4*)(Y + (size_t)s * 1024 + col) = w;
                    }
                }
            }
    }
};
}

#define WSP(type, off) ((type*)(a.ws + (off)))
__device__ __forceinline__ int oblk() { int t = blockIdx.x; asm volatile("" : "+s"(t)); return t; }
__device__ __forceinline__ int ogrid() { int t = gridDim.x; asm volatile("" : "+s"(t)); return t; }
__device__ __forceinline__ int otid() { int t = threadIdx.x; asm volatile("" : "+v"(t)); return t; }
constexpr int LDS_INTAB = LDS_MISC + 14336;
__device__ __forceinline__ const float* ldsin(LAS unsigned char* lds, int i) {
    const unsigned long long p = ((const LAS unsigned long long*)(lds + LDS_INTAB))[i];
    const unsigned lo = __builtin_amdgcn_readfirstlane((unsigned)p), hi = __builtin_amdgcn_readfirstlane((unsigned)(p >> 32));
    return (const float*)(((unsigned long long)hi << 32) | lo);
}
#define INP(i) ldsin(lds, (i))

template <int MAP>
__device__ __forceinline__ void conv_slab(const float* __restrict__ src, int N, int Kper, bf16_t* __restrict__ dst, size_t estride,
                                          const float* __restrict__ gain, int goff, LAS float* tile, int slab) {
    const int tid = otid();
    const int nsn = N >> 8;
    const int kt = slab / nsn, ns = slab - kt * nsn, k0 = kt * 64, n0 = ns * 256;
    const int e = k0 / Kper, kl0 = k0 - e * Kper;
    f32x4 v[8];
#pragma unroll
    for (int i = 0; i < 8; ++i) { const int idx = tid + i * 512, kk = idx >> 6, n4 = (idx & 63) * 4; v[i] = *(const f32x4*)(src + (size_t)(k0 + kk) * N + n0 + n4); }
#pragma unroll
    for (int i = 0; i < 8; ++i) {
        const int idx = tid + i * 512, kk = idx >> 6, n4 = (idx & 63) * 4;
        float gsc = 1.0f;
        if (gain != nullptr && kl0 + kk >= goff) gsc = gain[kl0 + kk - goff];
        LAS float* tp = tile + kk * 257 + n4;
        tp[0] = v[i][0] * gsc; tp[1] = v[i][1] * gsc; tp[2] = v[i][2] * gsc; tp[3] = v[i][3] * gsc;
    }
    __syncthreads();
#pragma unroll
    for (int i = 0; i < 4; ++i) {
        const int p = tid + i * 512, nn = p >> 3, kg = p & 7;
        float x[8];
#pragma unroll
        for (int j = 0; j < 8; ++j) x[j] = tile[(kg * 8 + j) * 257 + nn];
        const int n = n0 + nn;
        const int nr = (MAP == 0) ? n : ((n >> 7) * 256 + (n & 127) + (MAP == 2 ? 128 : 0));
        u32x4 w; w.x = pk2(x[0], x[1]); w.y = pk2(x[2], x[3]); w.z = pk2(x[4], x[5]); w.w = pk2(x[6], x[7]);
        *(u32x4*)(dst + (size_t)e * estride + (size_t)nr * Kper + kl0 + kg * 8) = w;
    }
    __syncthreads();
}
template <int MAP>
__device__ __forceinline__ void conv_T(const float* __restrict__ src, int Ktot, int N, int Kper, bf16_t* __restrict__ dst, size_t estride,
                                       const float* __restrict__ gain, int goff, LAS float* tile) {
    const int nslab = (Ktot >> 6) * (N >> 8);
    for (int sl = oblk(); sl < nslab; sl += ogrid()) conv_slab<MAP>(src, N, Kper, dst, estride, gain, goff, tile, sl);
}
constexpr int MOE_CONV_ITEMS = 3 * 128;
__device__ __forceinline__ void moe_convert_item(const PA a, int l, LAS unsigned char* lds, int item) {
    LAS float* tile = (LAS float*)lds;
    const int which = item >> 7, s0 = (item & 127) * 8;
    const float* gn = INP(30) + l * 1024;
    for (int sl = s0; sl < s0 + 8; ++sl) {
        if (which == 0)      conv_slab<1>(INP(35) + (size_t)l * 32 * 1024 * 512, 512, 1024, WSP(bf16_t, WS_WGU), (size_t)1024 * 1024, gn, 0, tile, sl);
        else if (which == 1) conv_slab<2>(INP(36) + (size_t)l * 32 * 1024 * 512, 512, 1024, WSP(bf16_t, WS_WGU), (size_t)1024 * 1024, gn, 0, tile, sl);
        else                 conv_slab<0>(INP(37) + (size_t)l * 32 * 512 * 1024, 1024, 512, WSP(bf16_t, WS_WD), (size_t)1024 * 512, nullptr, 0, tile, sl);
    }
}

__device__ __forceinline__ void rows_convert(const float* __restrict__ src, float* __restrict__ dstf, bf16_t* __restrict__ dstb, float* __restrict__ ss, int nrows) {
    const int wave = otid() >> 6, lane = otid() & 63;
    for (int r = oblk() * 8 + wave; r < nrows; r += ogrid() * 8) {
        float sq = 0.f;
#pragma unroll
        for (int i = 0; i < 4; ++i) {
            const int c = i * 256 + lane * 4;
            const f32x4 v = *(const f32x4*)(src + (size_t)r * 1024 + c);
            if (dstf) *(f32x4*)(dstf + (size_t)r * 1024 + c) = v;
            u32x2 w; w.x = pk2(v[0], v[1]); w.y = pk2(v[2], v[3]);
            *(u32x2*)(dstb + (size_t)r * 1024 + c) = w;
            sq += (v[0] * v[0] + v[1] * v[1]) + (v[2] * v[2] + v[3] * v[3]);
        }
        sq = wsum(sq);
        if (lane < 16) ss[(size_t)r * 16 + lane] = (lane == 0) ? sq : 0.f;
    }
}

__device__ __forceinline__ void p0_prologue(const PA a, LAS unsigned char* lds) {
    LAS float* tile = (LAS float*)lds;
    for (int l = 0; l < NL; ++l) {
        conv_T<0>(INP(3) + (size_t)l * 1024 * INW, 1024, INW, 1024, WSP(bf16_t, WS_WIN) + (size_t)l * INW * 1024, 0, INP(2) + l * 1024, 0, tile);
        conv_T<0>(INP(22) + (size_t)l * 1024 * 1024, 1024, 1024, 1024, WSP(bf16_t, WS_WOUT) + (size_t)l * 1024 * 1024, 0, INP(21) + l * 512, 512, tile);
        conv_T<0>(INP(25) + (size_t)l * 1024 * 512, 1024, 512, 1024, WSP(bf16_t, WS_WQ) + (size_t)l * 512 * 1024, 0, INP(23) + l * 1024, 0, tile);
        conv_T<0>(INP(26) + (size_t)l * 1024 * 1024, 1024, 1024, 1024, WSP(bf16_t, WS_WKV) + (size_t)l * 1024 * 1024, 0, INP(24) + l * 1024, 0, tile);
        conv_T<0>(INP(27) + (size_t)l * 512 * 1024, 512, 1024, 512, WSP(bf16_t, WS_WO) + (size_t)l * 1024 * 512, 0, nullptr, 0, tile);
    }
    {
        bf16_t* wrh = WSP(bf16_t, WS_WRH); bf16_t* wrl = WSP(bf16_t, WS_WRL);
        for (int idx = oblk() * 512 + otid(); idx < NL * 48 * 1024; idx += ogrid() * 512) {
            const int k = idx & 1023, r = (idx >> 10) % 48, l = idx / (48 * 1024);
            float w;
            if (r < 16) w = INP(31)[((size_t)l * 1024 + k) * 4 + (r & 3)];
            else { const int ri = ((r >> 2) & 3) * 8 + ((r >> 4) - 1) * 4 + (r & 3); w = INP(33)[((size_t)l * 1024 + k) * 32 + ri]; }
            w *= INP(30)[l * 1024 + k];
            const bf16_t hi = f2bf(w);
            wrh[idx] = hi; wrl[idx] = f2bf(w - bf2f(hi));
        }
    }
    rows_convert(INP(0), a.out, WSP(bf16_t, WS_XB), WSP(float, WS_SS), T);
    rows_convert(INP(1), nullptr, WSP(bf16_t, WS_MEMB), WSP(float, WS_MEMSS), MROWS);
}

__device__ __forceinline__ void p2_knorm(const PA a, LAS unsigned char* lds) {
    const int wave = otid() >> 6, lane = otid() & 63;
    bf16_t* kv = WSP(bf16_t, WS_KV);
    for (int it = oblk() * 8 + wave; it < NL * MROWS * 4; it += ogrid() * 8) {
        const int h = it & 3, row = (it >> 2) & (MROWS - 1), l = it >> 14;
        unsigned* p = (unsigned*)(kv + ((size_t)l * MROWS + row) * 1024 + h * 128 + lane * 2);
        const unsigned w = *p; const float x0 = lo16(w), x1 = hi16(w);
        const float ssq = wsum(x0 * x0 + x1 * x1);
        const float rinv = rsqrtf(ssq * (1.0f / 128.0f) + 1e-6f);
        const float* gk = INP(29) + l * 128 + lane * 2;
        *p = pk2(x0 * rinv * gk[0], x1 * rinv * gk[1]);
    }
    bf16_t* vtx = WSP(bf16_t, WS_VTX);
    const int tid = otid();
    for (int it = oblk(); it < NL * 16 * 4; it += ogrid()) {
        const int h = it & 3, b = (it >> 2) & 15, l = it >> 6;
        const bf16_t* src = kv + ((size_t)l * MROWS + b * 256) * 1024 + 512 + h * 128;
        bf16_t* dst = vtx + (size_t)it * 128 * 256;
#pragma unroll 1
        for (int i = 0; i < 8; ++i) {
            const int p = tid + i * 512, d = p & 127, m8 = (p >> 7) * 8;
            unsigned short x[8];
#pragma unroll
            for (int j = 0; j < 8; ++j) x[j] = src[(size_t)(m8 + j) * 1024 + d];
            u32x4 w; w.x = x[0] | ((unsigned)x[1] << 16); w.y = x[2] | ((unsigned)x[3] << 16); w.z = x[4] | ((unsigned)x[5] << 16); w.w = x[6] | ((unsigned)x[7] << 16);
            *(u32x4*)(dst + (size_t)d * 256 + m8) = w;
        }
    }
}

__device__ __forceinline__ float fast_tanh(float x) { return 1.0f - 2.0f * __builtin_amdgcn_rcpf(1.0f + __expf(2.0f * x)); }
__device__ __forceinline__ float fast_sigmoid(float x) { return __builtin_amdgcn_rcpf(1.0f + __expf(-x)); }
template <int MODE>
__device__ __forceinline__ bf16x8 mixfrag(const bf16_t* pu, const bf16_t* pp, float hpf, const float* mu, int col) {
    const u32x4 u = *(const u32x4*)(pu + col), p = *(const u32x4*)(pp + col);
    const f32x4 m0 = *(const f32x4*)(mu + col), m1 = *(const f32x4*)(mu + col + 4);
    float x[8];
#pragma unroll
    for (int j = 0; j < 4; ++j) {
        const float u0 = lo16(u[j]), u1 = hi16(u[j]), p0 = lo16(p[j]) * hpf, p1 = hi16(p[j]) * hpf;
        const float ma = (j < 2) ? m0[2 * j] : m1[2 * j - 4], mb = (j < 2) ? m0[2 * j + 1] : m1[2 * j - 3];
        x[2 * j] = u0 + ma * (p0 - u0); x[2 * j + 1] = u1 + mb * (p1 - u1);
    }
#pragma unroll
    for (int j = 0; j < 8; ++j) { if (MODE == 1) x[j] = fast_tanh(x[j]); if (MODE == 2) x[j] = fast_sigmoid(x[j]); }
    u32x4 w; w.x = pk2(x[0], x[1]); w.y = pk2(x[2], x[3]); w.z = pk2(x[4], x[5]); w.w = pk2(x[6], x[7]);
    return __builtin_bit_cast(bf16x8, w);
}
__device__ __forceinline__ void pb_prep(const PA a, int l, LAS unsigned char* lds) {
    const int tid = otid(), wave = tid >> 6, lane = tid & 63, fr = lane & 15, fq = lane >> 4;
    const int G = ogrid(), blk = oblk();
    LAS bf16_t* s_w2 = (LAS bf16_t*)lds;
    LAS bf16_t* s_a2 = (LAS bf16_t*)(lds + 18432);
    LAS bf16_t* s_g2 = (LAS bf16_t*)(lds + 36864);
    LAS bf16_t* s_v2 = (LAS bf16_t*)(lds + 71680);
    LAS bf16_t* s_v1 = (LAS bf16_t*)(lds + 81920);
    bf16_t* proj = WSP(bf16_t, WS_PROJ);
    const float* mu = INP(4) + l * 1792;
    const float* w0 = INP(5) + l * 512;  const float* w2 = INP(6) + (size_t)l * 64 * 512;
    const float* a0 = INP(7) + l * 512;  const float* a2 = INP(8) + (size_t)l * 64 * 512;
    const float* g2 = INP(9) + (size_t)l * 128 * 512;
    const float* kkw = INP(10) + l * 512; const float* kaw = INP(11) + l * 512;
    const int lv = l > 0 ? l - 1 : 0;
    const float* v0 = INP(15) + lv * 512; const float* v1 = INP(16) + (size_t)lv * 512 * 32; const float* v2 = INP(17) + (size_t)lv * 32 * 512;
    const float* qgn = INP(18) + l * 64; const float* kgn = INP(19) + l * 64;
    bf16_t* SR = WSP(bf16_t, WS_SR); bf16_t* SK = WSP(bf16_t, WS_SK); bf16_t* SV = WSP(bf16_t, WS_SV);
    bf16_t* SA = WSP(bf16_t, WS_SA); bf16_t* SB = WSP(bf16_t, WS_SB); bf16_t* SG = WSP(bf16_t, WS_SG);
    float* SWD = WSP(float, WS_SWD); bf16_t* VF = WSP(bf16_t, WS_VF);
    int cur_hp = -1;
    for (int item = blk; item < 4 * (T / 128); item += G) {
        const int hp = item & 3, tt = item >> 2;
        if (hp != cur_hp) {
            __syncthreads();
            const int chb = hp * 128;
            for (int idx = tid; idx < 64 * 128; idx += 512) { const int ch = idx & 127, k = idx >> 7;
                s_w2[ch * 72 + k] = f2bf(w2[k * 512 + chb + ch]); s_a2[ch * 72 + k] = f2bf(a2[k * 512 + chb + ch]); }
            for (int idx = tid; idx < 128 * 128; idx += 512) { const int ch = idx & 127, k = idx >> 7; s_g2[ch * 136 + k] = f2bf(g2[k * 512 + chb + ch]); }
            if (l > 0) {
                for (int idx = tid; idx < 32 * 128; idx += 512) { const int ch = idx & 127, k = idx >> 7; s_v2[ch * 40 + k] = f2bf(v2[k * 512 + chb + ch]); }
                for (int idx = tid; idx < 512 * 32; idx += 512) { const int n = idx & 31, k = idx >> 5; s_v1[n * 520 + k] = f2bf(v1[k * 32 + n]); }
            }
            __syncthreads();
            cur_hp = hp;
        }
        const int t = tt * 128 + wave * 16 + fr;
        const bool hpv = (t & (SEQ - 1)) != 0;
        const bf16_t* pu = proj + (size_t)t * INW;
        const bf16_t* pp = hpv ? pu - INW : pu;
        const float hpf = hpv ? 1.0f : 0.0f;
        bf16x8 fwl[2], fal[2], fgl[4], ft32;
#pragma unroll
        for (int s = 0; s < 2; ++s) { fwl[s] = mixfrag<1>(pu, pp, hpf, mu, 1536 + 32 * s + 8 * fq); fal[s] = mixfrag<0>(pu, pp, hpf, mu, 1600 + 32 * s + 8 * fq); }
#pragma unroll
        for (int s = 0; s < 4; ++s) fgl[s] = mixfrag<2>(pu, pp, hpf, mu, 1664 + 32 * s + 8 * fq);
        ft32 = fwl[0];
        if (l > 0) {
            f32x4 c0 = {0.f, 0.f, 0.f, 0.f}, c1 = {0.f, 0.f, 0.f, 0.f};
#pragma unroll 4
            for (int s = 0; s < 16; ++s) {
                const bf16x8 xf = mixfrag<0>(pu, pp, hpf, mu, 1024 + 32 * s + 8 * fq);
                const bf16x8 wa = *(const LAS bf16x8*)(s_v1 + fr * 520 + 32 * s + 8 * fq), wb = *(const LAS bf16x8*)(s_v1 + (16 + fr) * 520 + 32 * s + 8 * fq);
                c0 = __builtin_amdgcn_mfma_f32_16x16x32_bf16(wa, xf, c0, 0, 0, 0);
                c1 = __builtin_amdgcn_mfma_f32_16x16x32_bf16(wb, xf, c1, 0, 0, 0);
            }
            u32x4 w; w.x = pk2(c0[0], c0[1]); w.y = pk2(c0[2], c0[3]); w.z = pk2(c1[0], c1[1]); w.w = pk2(c1[2], c1[3]);
            ft32 = __builtin_bit_cast(bf16x8, w);
        }
#pragma unroll 1
        for (int hh = 0; hh < 2; ++hh) {
            float kkv[4][4], avv[4][4];
            float kss = 0.f;
#pragma unroll
            for (int nt = 0; nt < 4; ++nt) {
                const int lc = hh * 64 + nt * 16, ch4 = hp * 128 + lc + 4 * fq;
                f32x4 aw = {0.f, 0.f, 0.f, 0.f}, aa = aw, ag = aw, az = aw;
#pragma unroll
                for (int s = 0; s < 2; ++s) {
                    aw = __builtin_amdgcn_mfma_f32_16x16x32_bf16(*(const LAS bf16x8*)(s_w2 + (lc + fr) * 72 + 32 * s + 8 * fq), fwl[s], aw, 0, 0, 0);
                    aa = __builtin_amdgcn_mfma_f32_16x16x32_bf16(*(const LAS bf16x8*)(s_a2 + (lc + fr) * 72 + 32 * s + 8 * fq), fal[s], aa, 0, 0, 0);
                }
#pragma unroll
                for (int s = 0; s < 4; ++s) ag = __builtin_amdgcn_mfma_f32_16x16x32_bf16(*(const LAS bf16x8*)(s_g2 + (lc + fr) * 136 + 32 * s + 8 * fq), fgl[s], ag, 0, 0, 0);
                if (l > 0) {
                    const u32x2 q0 = *(const LAS u32x2*)(s_v2 + (lc + fr) * 40 + 4 * fq), q1 = *(const LAS u32x2*)(s_v2 + (lc + fr) * 40 + 16 + 4 * fq);
                    u32x4 w; w.x = q0.x; w.y = q0.y; w.z = q1.x; w.w = q1.y;
                    az = __builtin_amdgcn_mfma_f32_16x16x32_bf16(__builtin_bit_cast(bf16x8, w), ft32, az, 0, 0, 0);
                }
                const u32x2 ur = *(const u32x2*)(pu + ch4), pr = *(const u32x2*)(pp + ch4);
                const u32x2 uk = *(const u32x2*)(pu + 512 + ch4), pk = *(const u32x2*)(pp + 512 + ch4);
                const u32x2 uv = *(const u32x2*)(pu + 1024 + ch4), pv = *(const u32x2*)(pp + 1024 + ch4);
                const f32x4 mr = *(const f32x4*)(mu + ch4), mk = *(const f32x4*)(mu + 512 + ch4), mv = *(const f32x4*)(mu + 1024 + ch4);
                const f32x4 w0v = *(const f32x4*)(w0 + ch4), a0v = *(const f32x4*)(a0 + ch4), kkwv = *(const f32x4*)(kkw + ch4), kawv = *(const f32x4*)(kaw + ch4);
                float xr[4], xk[4], xv[4];
                { const float u0 = lo16(ur.x), u1 = hi16(ur.x), u2 = lo16(ur.y), u3 = hi16(ur.y);
                  xr[0] = u0 + mr[0] * (lo16(pr.x) * hpf - u0); xr[1] = u1 + mr[1] * (hi16(pr.x) * hpf - u1); xr[2] = u2 + mr[2] * (lo16(pr.y) * hpf - u2); xr[3] = u3 + mr[3] * (hi16(pr.y) * hpf - u3); }
                { const float u0 = lo16(uk.x), u1 = hi16(uk.x), u2 = lo16(uk.y), u3 = hi16(uk.y);
                  xk[0] = u0 + mk[0] * (lo16(pk.x) * hpf - u0); xk[1] = u1 + mk[1] * (hi16(pk.x) * hpf - u1); xk[2] = u2 + mk[2] * (lo16(pk.y) * hpf - u2); xk[3] = u3 + mk[3] * (hi16(pk.y) * hpf - u3); }
                { const float u0 = lo16(uv.x), u1 = hi16(uv.x), u2 = lo16(uv.y), u3 = hi16(uv.y);
                  xv[0] = u0 + mv[0] * (lo16(pv.x) * hpf - u0); xv[1] = u1 + mv[1] * (hi16(pv.x) * hpf - u1); xv[2] = u2 + mv[2] * (lo16(pv.y) * hpf - u2); xv[3] = u3 + mv[3] * (hi16(pv.y) * hpf - u3); }
                const size_t o = (size_t)t * 512 + ch4;
                if (l > 0) {
                    const f32x4 v0v = *(const f32x4*)(v0 + ch4);
                    const u32x2 vfw = *(const u32x2*)(VF + o);
                    const float vf0 = lo16(vfw.x), vf1 = hi16(vfw.x), vf2 = lo16(vfw.y), vf3 = hi16(vfw.y);
                    xv[0] += (vf0 - xv[0]) * fast_sigmoid(v0v[0] + az[0]); xv[1] += (vf1 - xv[1]) * fast_sigmoid(v0v[1] + az[1]);
                    xv[2] += (vf2 - xv[2]) * fast_sigmoid(v0v[2] + az[2]); xv[3] += (vf3 - xv[3]) * fast_sigmoid(v0v[3] + az[3]);
                } else {
                    u32x2 w; w.x = pk2(xv[0], xv[1]); w.y = pk2(xv[2], xv[3]); *(u32x2*)(VF + o) = w;
                }
                f32x4 dec; float kmod[4];
#pragma unroll
                for (int j = 0; j < 4; ++j) {
                    dec[j] = __expf(-0.6065306597f * fast_sigmoid(w0v[j] + aw[j]));
                    const float av = fast_sigmoid(a0v[j] + aa[j]);
                    const float kk = xk[j] * kkwv[j];
                    kkv[nt][j] = kk; avv[nt][j] = av; kss += kk * kk;
                    kmod[j] = xk[j] * (1.0f + (av - 1.0f) * kawv[j]);
                }
                { u32x2 w; w.x = pk2(xr[0], xr[1]); w.y = pk2(xr[2], xr[3]); *(u32x2*)(SR + o) = w; }
                { u32x2 w; w.x = pk2(xv[0], xv[1]); w.y = pk2(xv[2], xv[3]); *(u32x2*)(SV + o) = w; }
                { u32x2 w; w.x = pk2(ag[0], ag[1]); w.y = pk2(ag[2], ag[3]); *(u32x2*)(SG + o) = w; }
                { u32x2 w; w.x = pk2(kmod[0], kmod[1]); w.y = pk2(kmod[2], kmod[3]); *(u32x2*)(SK + o) = w; }
                *(f32x4*)(SWD + o) = dec;
            }
            kss += __shfl_xor(kss, 16); kss += __shfl_xor(kss, 32);
            const float rn = rsqrtf(fmaxf(kss, 1e-24f));
#pragma unroll
            for (int nt = 0; nt < 4; ++nt) {
                const size_t o = (size_t)t * 512 + hp * 128 + hh * 64 + nt * 16 + 4 * fq;
                float kn[4];
#pragma unroll
                for (int j = 0; j < 4; ++j) kn[j] = kkv[nt][j] * rn;
                { u32x2 w; w.x = pk2(-kn[0], -kn[1]); w.y = pk2(-kn[2], -kn[3]); *(u32x2*)(SA + o) = w; }
                { u32x2 w; w.x = pk2(kn[0] * avv[nt][0], kn[1] * avv[nt][1]); w.y = pk2(kn[2] * avv[nt][2], kn[3] * avv[nt][3]); *(u32x2*)(SB + o) = w; }
            }
        }
#pragma unroll 1
        for (int qk = 0; qk < 4; ++qk) {
            const int col = 1792 + (qk & 1) * 512 + (hp * 2 + (qk >> 1)) * 64 + fq * 16;
            const float* gn = (qk & 1) ? kgn : qgn;
            bf16_t* p = proj + (size_t)t * INW + col;
            const u32x4 wa = *(const u32x4*)p, wb = *(const u32x4*)(p + 8);
            float x[16];
#pragma unroll
            for (int j = 0; j < 4; ++j) { x[2 * j] = lo16(wa[j]); x[2 * j + 1] = hi16(wa[j]); x[8 + 2 * j] = lo16(wb[j]); x[9 + 2 * j] = hi16(wb[j]); }
            float ssq = 0.f;
#pragma unroll
            for (int j = 0; j < 16; ++j) ssq += x[j] * x[j];
            ssq += __shfl_xor(ssq, 16); ssq += __shfl_xor(ssq, 32);
            const float rinv = rsqrtf(ssq * (1.0f / 64.0f) + 1e-6f);
            const float qsc = (qk & 1) ? rinv : rinv * 0.18033688011112042f;
#pragma unroll
            for (int j = 0; j < 16; ++j) x[j] = x[j] * qsc * gn[fq * 16 + j];
            u32x4 oa, ob;
#pragma unroll
            for (int j = 0; j < 4; ++j) { oa[j] = pk2(x[2 * j], x[2 * j + 1]); ob[j] = pk2(x[8 + 2 * j], x[9 + 2 * j]); }
            *(u32x4*)p = oa; *(u32x4*)(p + 8) = ob;
        }
    }
    __syncthreads();
}

__device__ __forceinline__ void pb2_chunks(const PA a, int l, LAS unsigned char* lds) {
    const int tid = otid(), wave = tid >> 6, lane = tid & 63, fr = lane & 15, fq = lane >> 4;
    LAS bf16_t* sA = (LAS bf16_t*)(lds + wave * 11520);
    LAS bf16_t* sR = sA + 1152; LAS bf16_t* sB = sR + 1152; LAS bf16_t* sK = sB + 1152; LAS bf16_t* sX = sK + 1152;
    LAS float* nb = (LAS float*)(lds + 8 * 11520) + wave * 256;
    bf16_t* SR = WSP(bf16_t, WS_SR); bf16_t* SK = WSP(bf16_t, WS_SK); bf16_t* SV = WSP(bf16_t, WS_SV);
    bf16_t* SA = WSP(bf16_t, WS_SA); bf16_t* SB = WSP(bf16_t, WS_SB); const float* SWD = WSP(const float, WS_SWD);
    const float* rkp = INP(12) + l * 512;
    for (int cid = oblk() * 8 + wave; cid < NCHUNK; cid += ogrid() * 8) {
        const int b = cid >> 10, h = (cid >> 7) & 7, c = cid & 127;
        const size_t tok0 = (size_t)b * SEQ + c * 16;
        const size_t e0 = tok0 * 512 + h * 64 + lane;
        const float rkv = rkp[h * 64 + lane];
        float P = 1.0f;
        unsigned bt2[8], kt2[8], vt2[8];
#pragma unroll
        for (int hf = 0; hf < 2; ++hf) {
            bf16_t r16[8], k16[8], a16[8], b16[8], v16[8]; float w32[8];
#pragma unroll
            for (int t8 = 0; t8 < 8; ++t8) { const size_t e = e0 + (size_t)(hf * 8 + t8) * 512; r16[t8] = SR[e]; k16[t8] = SK[e]; a16[t8] = SA[e]; b16[t8] = SB[e]; v16[t8] = SV[e]; w32[t8] = SWD[e]; }
#pragma unroll
            for (int t8 = 0; t8 < 8; ++t8) {
                const int t = hf * 8 + t8;
                const float rr = bf2f(r16[t8]), kk = bf2f(k16[t8]), aa = bf2f(a16[t8]), bb = bf2f(b16[t8]);
                const float Pm = P; P *= w32[t8]; const float ip = 1.0f / P;
                const unsigned ar = pk2(aa * Pm, rr * P), bk = pk2(bb * ip, kk * ip);
                const bf16_t at = (bf16_t)(ar & 0xffffu), rt = (bf16_t)(ar >> 16), btv = (bf16_t)(bk & 0xffffu), ktv = (bf16_t)(bk >> 16);
                { const size_t es = tok0 * 512 + (size_t)t * 512 + h * 64 + (lane ^ ((t & 7) << 3)); SA[es] = at; SR[es] = rt; }
                sA[t * 72 + lane] = at; sR[t * 72 + lane] = rt; sB[t * 72 + lane] = btv; sK[t * 72 + lane] = ktv;
                sX[t * 72 + lane] = (bf16_t)(pk2(rr * kk * rkv, 0.f) & 0xffffu);
                if (t & 1) { bt2[t >> 1] |= (unsigned)btv << 16; kt2[t >> 1] |= (unsigned)ktv << 16; vt2[t >> 1] |= (unsigned)v16[t8] << 16; }
                else       { bt2[t >> 1] = btv; kt2[t >> 1] = ktv; vt2[t >> 1] = v16[t8]; }
            }
        }
        WSP(float, WS_PCK)[(size_t)cid * 64 + lane] = P;
        {
            u32x4* pb_ = (u32x4*)(WSP(bf16_t, WS_BTT) + (size_t)cid * 1024 + lane * 16);
            u32x4* pk_ = (u32x4*)(WSP(bf16_t, WS_KTT) + (size_t)cid * 1024 + lane * 16);
            u32x4* pv_ = (u32x4*)(WSP(bf16_t, WS_VST) + (size_t)cid * 1024 + lane * 16);
            pb_[0] = (u32x4){bt2[0], bt2[1], bt2[2], bt2[3]}; pb_[1] = (u32x4){bt2[4], bt2[5], bt2[6], bt2[7]};
            pk_[0] = (u32x4){kt2[0], kt2[1], kt2[2], kt2[3]}; pk_[1] = (u32x4){kt2[4], kt2[5], kt2[6], kt2[7]};
            pv_[0] = (u32x4){vt2[0], vt2[1], vt2[2], vt2[3]}; pv_[1] = (u32x4){vt2[4], vt2[5], vt2[6], vt2[7]};
        }
        bf16x8 fA[2], fR[2], fB[2], fK[2], fX[2];
#pragma unroll
        for (int s_ = 0; s_ < 2; ++s_) {
            fA[s_] = *(const LAS bf16x8*)(sA + fr * 72 + 32 * s_ + 8 * fq); fR[s_] = *(const LAS bf16x8*)(sR + fr * 72 + 32 * s_ + 8 * fq);
            fB[s_] = *(const LAS bf16x8*)(sB + fr * 72 + 32 * s_ + 8 * fq); fK[s_] = *(const LAS bf16x8*)(sK + fr * 72 + 32 * s_ + 8 * fq);
            fX[s_] = *(const LAS bf16x8*)(sX + fr * 72 + 32 * s_ + 8 * fq);
        }
        const f32x4 z4 = {0.f, 0.f, 0.f, 0.f};
        const bf16x8 ones = {0x3f80, 0x3f80, 0x3f80, 0x3f80, 0x3f80, 0x3f80, 0x3f80, 0x3f80};
        const f32x4 nka = __builtin_amdgcn_mfma_f32_16x16x32_bf16(fA[1], fK[1], __builtin_amdgcn_mfma_f32_16x16x32_bf16(fA[0], fK[0], z4, 0, 0, 0), 0, 0, 0);
        const f32x4 nbr = __builtin_amdgcn_mfma_f32_16x16x32_bf16(fR[1], fB[1], __builtin_amdgcn_mfma_f32_16x16x32_bf16(fR[0], fB[0], z4, 0, 0, 0), 0, 0, 0);
        const f32x4 nkr = __builtin_amdgcn_mfma_f32_16x16x32_bf16(fR[1], fK[1], __builtin_amdgcn_mfma_f32_16x16x32_bf16(fR[0], fK[0], z4, 0, 0, 0), 0, 0, 0);
        const f32x4 nba = __builtin_amdgcn_mfma_f32_16x16x32_bf16(fB[1], fA[1], __builtin_amdgcn_mfma_f32_16x16x32_bf16(fB[0], fA[0], z4, 0, 0, 0), 0, 0, 0);
        const f32x4 bsm = __builtin_amdgcn_mfma_f32_16x16x32_bf16(fX[1], ones, __builtin_amdgcn_mfma_f32_16x16x32_bf16(fX[0], ones, z4, 0, 0, 0), 0, 0, 0);
        bf16_t* gka = WSP(bf16_t, WS_NKA) + (size_t)cid * 256; bf16_t* gbr = WSP(bf16_t, WS_NBR) + (size_t)cid * 256; bf16_t* gkr = WSP(bf16_t, WS_NKR) + (size_t)cid * 256;
#pragma unroll
        for (int j = 0; j < 4; ++j) {
            const int row = 4 * fq + j;
            gka[row * 16 + fr] = f2bf(fr < row ? nka[j] : 0.f);
            gbr[row * 16 + fr] = f2bf(fr <= row ? nbr[j] : 0.f);
            gkr[row * 16 + fr] = f2bf(fr <= row ? nkr[j] : 0.f);
            nb[row * 16 + fr] = (row < fr) ? nba[j] : 0.f;
            if (fr == 0) WSP(float, WS_BS)[(tok0 + row) * 8 + h] = bsm[j];
        }
        if (lane < 16) {
            float X[16];
            bf16_t* gtm = WSP(bf16_t, WS_TMT) + (size_t)cid * 256;
#pragma unroll
            for (int tcol = 0; tcol < 16; ++tcol) {
                float acc = (lane == tcol) ? 1.0f : 0.0f;
#pragma unroll
                for (int i = 0; i < tcol; ++i) acc += X[i] * nb[i * 16 + tcol];
                X[tcol] = acc;
                gtm[tcol * 16 + lane] = f2bf(acc);
            }
        }
    }
    __syncthreads();
}

__device__ __forceinline__ void scan_item(const PA a, int l, int bh, LAS unsigned char* lds) {
    const int tid = otid(), wave = __builtin_amdgcn_readfirstlane(tid >> 6), lane = tid & 63, fr = lane & 15, fq = lane >> 4;
    const int b = __builtin_amdgcn_readfirstlane(bh >> 3), h = __builtin_amdgcn_readfirstlane(bh & 7);
    constexpr int SLOT = 17152, NS = 7, DPF = 5;
    constexpr int OA = 0, OR_ = 2048, OBT = 4096, OKT = 6144, OVT = 8192, ON = 10240, OPC = 12288, OBS = 12544, OSV = 13056, OSG = 15104;
    LAS float* ybuf = (LAS float*)(lds + NS * SLOT);
    LAS float* pbuf = ybuf + 2048;
    const size_t tokb = (size_t)b * SEQ;
    const int cid0 = (b * 8 + h) * 128;
    const unsigned char* gA = (const unsigned char*)WSP(const bf16_t, WS_SA); const unsigned char* gR = (const unsigned char*)WSP(const bf16_t, WS_SR);
    const unsigned char* gV = (const unsigned char*)WSP(const bf16_t, WS_SV); const unsigned char* gG = (const unsigned char*)WSP(const bf16_t, WS_SG);
    const unsigned char* gBT = (const unsigned char*)WSP(const bf16_t, WS_BTT); const unsigned char* gKT = (const unsigned char*)WSP(const bf16_t, WS_KTT);
    const unsigned char* gVT = (const unsigned char*)WSP(const bf16_t, WS_VST); const unsigned char* gN = (const unsigned char*)WSP(const bf16_t, WS_NKA);
    const unsigned char* gPC = (const unsigned char*)WSP(const float, WS_PCK); const unsigned char* gBS = (const unsigned char*)WSP(const float, WS_BS);
#define DMA16(gp, ldsoff) __builtin_amdgcn_global_load_lds((const unsigned*)(gp), (LAS unsigned*)(lds + (ldsoff)), 16, 0, 0)
    const unsigned rowoff0 = (unsigned)(((lane >> 3) * 512 + (lane & 7) * 8) * 2), rowoff1 = rowoff0 + 8u * 512u * 2u;
#define DMA_CHUNK(c_) do { const int cid_ = cid0 + (c_); const int so_ = ((c_) % NS) * SLOT; \
        const size_t rb_ = ((tokb + (size_t)(c_) * 16) * 512 + h * 64) * 2; \
        if (wave == 4) { \
            DMA16(gA + rb_ + rowoff0, so_ + OA); DMA16(gA + rb_ + rowoff1, so_ + OA + 1024); DMA16(gR + rb_ + rowoff0, so_ + OR_); DMA16(gR + rb_ + rowoff1, so_ + OR_ + 1024); \
            DMA16(gBT + (size_t)cid_ * 2048 + lane * 16, so_ + OBT); DMA16(gBT + (size_t)cid_ * 2048 + 1024 + lane * 16, so_ + OBT + 1024); \
            DMA16(gKT + (size_t)cid_ * 2048 + lane * 16, so_ + OKT); DMA16(gKT + (size_t)cid_ * 2048 + 1024 + lane * 16, so_ + OKT + 1024); \
            if (lane < 16) DMA16(gPC + (size_t)cid_ * 256 + lane * 16, so_ + OPC); \
        } else { \
            DMA16(gVT + (size_t)cid_ * 2048 + lane * 16, so_ + OVT); DMA16(gVT + (size_t)cid_ * 2048 + 1024 + lane * 16, so_ + OVT + 1024); \
            DMA16(gN + (size_t)(lane >> 5) * ((size_t)NCHUNK * 512) + (size_t)cid_ * 512 + (lane & 31) * 16, so_ + ON); \
            DMA16(gN + (size_t)(2 + (lane >> 5)) * ((size_t)NCHUNK * 512) + (size_t)cid_ * 512 + (lane & 31) * 16, so_ + ON + 1024); \
            DMA16(gV + rb_ + rowoff0, so_ + OSV); DMA16(gV + rb_ + rowoff1, so_ + OSV + 1024); DMA16(gG + rb_ + rowoff0, so_ + OSG); DMA16(gG + rb_ + rowoff1, so_ + OSG + 1024); \
            if (lane < 32) DMA16(gBS + (tokb + (size_t)(c_) * 16) * 32 + lane * 16, so_ + OBS); \
        } } while (0)
#define FR8(lo_, hi_) __builtin_bit_cast(bf16x8, (u32x4){(lo_).x, (lo_).y, (hi_).x, (hi_).y})
#define FR4(lo_) __builtin_bit_cast(bf16x8, (u32x4){(lo_).x, (lo_).y, 0u, 0u})
#define MF(a_, b_, c_) __builtin_amdgcn_mfma_f32_16x16x32_bf16((a_), (b_), (c_), 0, 0, 0)
#define LD8(off_) (*(const LAS u32x2*)(sl + (off_)))
#define DPP_F(v, ctrl) __int_as_float(__builtin_amdgcn_update_dpp(0, __float_as_int(v), (ctrl), 0xF, 0xF, true))
#define RED16(v) do { v += DPP_F(v, 0xB1); v += DPP_F(v, 0x4E); v += DPP_F(v, 0x141); v += DPP_F(v, 0x140); } while (0)
    const int swz = fr & 7, rowb = fr * 128 + (fq & 1) * 8, q0 = fq >> 1;
    const int aoff0 = rowb + ((q0) ^ swz) * 16, aoff1 = rowb + ((q0 + 2) ^ swz) * 16, aoff2 = rowb + ((q0 + 4) ^ swz) * 16, aoff3 = rowb + ((q0 + 6) ^ swz) * 16;
    const int moff = fr * 32 + 8 * fq, voff = ((wave & 3) * 16 + fr) * 32 + 8 * fq;
    const float lw = INP(13)[l * 512 + h * 64 + lane], lb = INP(14)[l * 512 + h * 64 + lane];
    bf16_t* YC = WSP(bf16_t, WS_YCAT);
    f32x4 S[4];
#pragma unroll
    for (int kt = 0; kt < 4; ++kt) S[kt] = (f32x4){0.f, 0.f, 0.f, 0.f};
    __syncthreads();
    if (wave == 4 || wave == 5) {
#pragma unroll 1
        for (int c = 0; c < DPF; ++c) DMA_CHUNK(c);
        asm volatile("s_waitcnt vmcnt(0)" ::: "memory");
    }
    __syncthreads();
#pragma unroll 1
    for (int c = 0; c < 128; ++c) {
        if (wave < 4) {
            const LAS unsigned char* sl = lds + (c % NS) * SLOT;
            u32x4 s0w, s1w; s0w.x = pk2(S[0][0], S[0][1]); s0w.y = pk2(S[0][2], S[0][3]); s0w.z = pk2(S[1][0], S[1][1]); s0w.w = pk2(S[1][2], S[1][3]);
            s1w.x = pk2(S[2][0], S[2][1]); s1w.y = pk2(S[2][2], S[2][3]); s1w.z = pk2(S[3][0], S[3][1]); s1w.w = pk2(S[3][2], S[3][3]);
            const bf16x8 Sf0 = __builtin_bit_cast(bf16x8, s0w), Sf1 = __builtin_bit_cast(bf16x8, s1w);
            const bf16x8 Vf = FR4(LD8(OVT + voff));
            const f32x4 z4 = {0.f, 0.f, 0.f, 0.f};
            f32x4 Wt = MF(FR8(LD8(OA + aoff0), LD8(OA + aoff1)), Sf0, z4); Wt = MF(FR8(LD8(OA + aoff2), LD8(OA + aoff3)), Sf1, Wt); Wt = MF(FR4(LD8(ON + moff)), Vf, Wt);
            u32x2 ww; ww.x = pk2(Wt[0], Wt[1]); ww.y = pk2(Wt[2], Wt[3]);
            const f32x4 Ut = MF(FR4(LD8(ON + 1536 + moff)), FR4(ww), z4);
            u32x2 uw; uw.x = pk2(Ut[0], Ut[1]); uw.y = pk2(Ut[2], Ut[3]);
            const bf16x8 Uf = FR4(uw);
            f32x4 Yt = MF(FR8(LD8(OR_ + aoff0), LD8(OR_ + aoff1)), Sf0, z4); Yt = MF(FR8(LD8(OR_ + aoff2), LD8(OR_ + aoff3)), Sf1, Yt);
            Yt = MF(FR4(LD8(ON + 512 + moff)), Uf, Yt); Yt = MF(FR4(LD8(ON + 1024 + moff)), Vf, Yt);
#pragma unroll
            for (int kt = 0; kt < 4; ++kt) {
                f32x4 Dk = MF(FR4(LD8(OBT + kt * 512 + moff)), Uf, z4); Dk = MF(FR4(LD8(OKT + kt * 512 + moff)), Vf, Dk);
                const f32x4 pc = *(const LAS f32x4*)(sl + OPC + (kt * 16 + 4 * fq) * 4);
                S[kt] = (S[kt] + Dk) * pc;
            }
            LAS float* yb = ybuf + (c & 1) * 1024 + (wave & 3) * 16 + fr;
            LAS float* pb = pbuf + (c & 1) * 128 + (wave & 3) * 32;
#pragma unroll
            for (int j = 0; j < 4; ++j) {
                yb[(4 * fq + j) * 64] = Yt[j];
                float sy = Yt[j], sq = Yt[j] * Yt[j];
                RED16(sy); RED16(sq);
                if (fr == 0) *(LAS f32x2*)(pb + (4 * fq + j) * 2) = (f32x2){sy, sq};
            }
            asm volatile("s_waitcnt lgkmcnt(0)" ::: "memory");
        } else if (wave < 6) {
            if (c + DPF < 128) DMA_CHUNK(c + DPF);
            if (c >= DPF && c + DPF < 128) asm volatile("s_waitcnt vmcnt(36)" ::: "memory"); else asm volatile("s_waitcnt vmcnt(0)" ::: "memory");
        } else if (c > 0) {
            const int cp = c - 1;
            const LAS unsigned char* sl = lds + (cp % NS) * SLOT;
            const LAS float* yb = ybuf + (cp & 1) * 1024; const LAS float* pb = pbuf + (cp & 1) * 128;
#pragma unroll
            for (int i = 0; i < 8; ++i) {
                const int t = (wave - 6) * 8 + i; const size_t tok = tokb + (size_t)cp * 16 + t;
                const f32x2 p0 = *(const LAS f32x2*)(pb + t * 2), p1 = *(const LAS f32x2*)(pb + 32 + t * 2), p2 = *(const LAS f32x2*)(pb + 64 + t * 2), p3 = *(const LAS f32x2*)(pb + 96 + t * 2);
                const float mean = ((p0.x + p1.x) + (p2.x + p3.x)) * (1.0f / 64.0f);
                const float var = fmaxf(((p0.y + p1.y) + (p2.y + p3.y)) * (1.0f / 64.0f) - mean * mean, 0.f);
                const float y = yb[t * 64 + lane];
                const float bsv = *(const LAS float*)(sl + OBS + t * 32 + h * 4);
                const float vv = bf2f(*(const LAS bf16_t*)(sl + OSV + t * 128 + lane * 2)), g = bf2f(*(const LAS bf16_t*)(sl + OSG + t * 128 + lane * 2));
                const float yn = (y - mean) * rsqrtf(var + 64e-5f) * lw + lb;
                YC[tok * 1024 + h * 64 + lane] = f2bf((yn + bsv * vv) * g);
            }
        }
        asm volatile("" ::: "memory"); __builtin_amdgcn_s_barrier(); asm volatile("" ::: "memory");
    }
    if (wave >= 6) {
        const int cp = 127;
        const LAS unsigned char* sl = lds + (cp % NS) * SLOT;
        const LAS float* yb = ybuf + (cp & 1) * 1024; const LAS float* pb = pbuf + (cp & 1) * 128;
#pragma unroll
        for (int i = 0; i < 8; ++i) {
            const int t = (wave - 6) * 8 + i; const size_t tok = tokb + (size_t)cp * 16 + t;
            const f32x2 p0 = *(const LAS f32x2*)(pb + t * 2), p1 = *(const LAS f32x2*)(pb + 32 + t * 2), p2 = *(const LAS f32x2*)(pb + 64 + t * 2), p3 = *(const LAS f32x2*)(pb + 96 + t * 2);
            const float mean = ((p0.x + p1.x) + (p2.x + p3.x)) * (1.0f / 64.0f);
            const float var = fmaxf(((p0.y + p1.y) + (p2.y + p3.y)) * (1.0f / 64.0f) - mean * mean, 0.f);
            const float y = yb[t * 64 + lane];
            const float bsv = *(const LAS float*)(sl + OBS + t * 32 + h * 4);
            const float vv = bf2f(*(const LAS bf16_t*)(sl + OSV + t * 128 + lane * 2)), g = bf2f(*(const LAS bf16_t*)(sl + OSG + t * 128 + lane * 2));
            const float yn = (y - mean) * rsqrtf(var + 64e-5f) * lw + lb;
            YC[tok * 1024 + h * 64 + lane] = f2bf((yn + bsv * vv) * g);
        }
    }
    asm volatile("s_waitcnt vmcnt(0)" ::: "memory");
    __syncthreads();
#undef DMA16
#undef DMA_CHUNK
#undef FR8
#undef FR4
#undef MF
#undef LD8
#undef DPP_F
#undef RED16
}

__device__ __forceinline__ void attn_item(const PA a, int l, int it, LAS unsigned char* lds) {
    const int tid = otid(), h = tid >> 6, lane = tid & 63, fr = lane & 15, fq = lane >> 4;
    const int b = it >> 5, c = it & 31;
    LAS float* s_bias = (LAS float*)(lds + LDS_MISC + 1024);
    LAS float* s_part = s_bias + 8 * 320;
    const bf16_t* proj = WSP(const bf16_t, WS_PROJ);
    const bf16_t* VT = WSP(const bf16_t, WS_VT) + (size_t)(b * 8 + h) * 64 * 2048;
    const size_t tq0 = (size_t)b * SEQ + c * 64;
    bf16x8 qf[4][2];
#pragma unroll
    for (int nt = 0; nt < 4; ++nt)
#pragma unroll
        for (int ks = 0; ks < 2; ++ks) qf[nt][ks] = *(const bf16x8*)(proj + (tq0 + nt * 16 + fr) * INW + 1792 + h * 64 + 32 * ks + 8 * fq);
    f32x4 o[4][4];
#pragma unroll
    for (int dt = 0; dt < 4; ++dt)
#pragma unroll
        for (int nt = 0; nt < 4; ++nt) o[dt][nt] = (f32x4){0.f, 0.f, 0.f, 0.f};
    float lsum[4] = {0.f, 0.f, 0.f, 0.f};
    const int kc0 = c - 8 > 0 ? c - 8 : 0;
    const int nsteps = (c - kc0 + 1) * 2;
    bf16x8 kf[2][2], kn[2][2]; u32x4 vf[4], vn[4];
#define ATT_LOAD(KF, VF, st) do { const int key0 = (kc0 * 64 + (st) * 32); const size_t tk = (size_t)b * SEQ + key0; \
        _Pragma("unroll") for (int mt = 0; mt < 2; ++mt) _Pragma("unroll") for (int ks = 0; ks < 2; ++ks) \
            KF[mt][ks] = *(const bf16x8*)(proj + (tk + mt * 16 + fr) * INW + 2304 + h * 64 + 32 * ks + 8 * fq); \
        _Pragma("unroll") for (int dt = 0; dt < 4; ++dt) { const bf16_t* vp = VT + (size_t)(dt * 16 + fr) * 2048 + key0 + 4 * fq; \
            const u32x2 v0 = *(const u32x2*)vp, v1 = *(const u32x2*)(vp + 16); VF[dt].x = v0.x; VF[dt].y = v0.y; VF[dt].z = v1.x; VF[dt].w = v1.y; } } while (0)
    ATT_LOAD(kf, vf, 0);
    for (int st = 0; st < nsteps; ++st) {
        const bool more = st + 1 < nsteps;
        if (more) ATT_LOAD(kn, vn, st + 1);
        f32x4 sacc[2][4];
#pragma unroll
        for (int mt = 0; mt < 2; ++mt)
#pragma unroll
            for (int nt = 0; nt < 4; ++nt) {
                f32x4 z = {0.f, 0.f, 0.f, 0.f};
                z = __builtin_amdgcn_mfma_f32_16x16x32_bf16(kf[mt][0], qf[nt][0], z, 0, 0, 0);
                sacc[mt][nt] = __builtin_amdgcn_mfma_f32_16x16x32_bf16(kf[mt][1], qf[nt][1], z, 0, 0, 0);
            }
        const int dk = c - (kc0 + (st >> 1)), half = st & 1;
        if (dk >= 5) {
            const float bc = s_bias[h * 320 + 319];
#pragma unroll
            for (int mt = 0; mt < 2; ++mt)
#pragma unroll
                for (int nt = 0; nt < 4; ++nt) sacc[mt][nt] += bc;
        } else {
#pragma unroll
            for (int mt = 0; mt < 2; ++mt)
#pragma unroll
                for (int nt = 0; nt < 4; ++nt)
#pragma unroll
                    for (int j = 0; j < 4; ++j) {
                        int idx = (nt * 16 + fr) - (half * 32 + mt * 16 + 4 * fq + j) + dk * 64; idx = idx > 256 ? 256 : idx;
                        sacc[mt][nt][j] += s_bias[h * 320 + idx + 63];
                    }
        }
        bf16x8 pf[4];
#pragma unroll
        for (int nt = 0; nt < 4; ++nt) {
            float p[8];
#pragma unroll
            for (int j = 0; j < 4; ++j) { p[j] = __builtin_amdgcn_exp2f(fminf(sacc[0][nt][j], 80.f)); p[4 + j] = __builtin_amdgcn_exp2f(fminf(sacc[1][nt][j], 80.f)); }
            lsum[nt] += ((p[0] + p[1]) + (p[2] + p[3])) + ((p[4] + p[5]) + (p[6] + p[7]));
            u32x4 w; w.x = pk2(p[0], p[1]); w.y = pk2(p[2], p[3]); w.z = pk2(p[4], p[5]); w.w = pk2(p[6], p[7]);
            pf[nt] = __builtin_bit_cast(bf16x8, w);
        }
#pragma unroll
        for (int dt = 0; dt < 4; ++dt)
#pragma unroll
            for (int nt = 0; nt < 4; ++nt) o[dt][nt] = __builtin_amdgcn_mfma_f32_16x16x32_bf16(__builtin_bit_cast(bf16x8, vf[dt]), pf[nt], o[dt][nt], 0, 0, 0);
        if (more) {
#pragma unroll
            for (int mt = 0; mt < 2; ++mt)
#pragma unroll
                for (int ks = 0; ks < 2; ++ks) kf[mt][ks] = kn[mt][ks];
#pragma unroll
            for (int dt = 0; dt < 4; ++dt) vf[dt] = vn[dt];
        }
    }
#undef ATT_LOAD
    float ssq[4];
#pragma unroll
    for (int nt = 0; nt < 4; ++nt) {
        float ls = lsum[nt]; ls += __shfl_xor(ls, 16); ls += __shfl_xor(ls, 32);
        const float inv = 1.0f / ls;
        float sq = 0.f;
#pragma unroll
        for (int dt = 0; dt < 4; ++dt) { o[dt][nt] *= inv; sq += (o[dt][nt][0] * o[dt][nt][0] + o[dt][nt][1] * o[dt][nt][1]) + (o[dt][nt][2] * o[dt][nt][2] + o[dt][nt][3] * o[dt][nt][3]); }
        sq += __shfl_xor(sq, 16); sq += __shfl_xor(sq, 32);
        ssq[nt] = sq;
        if (fq == 0) s_part[h * 64 + nt * 16 + fr] = sq;
    }
    __syncthreads();
#pragma unroll
    for (int nt = 0; nt < 4; ++nt) {
        float tot = 0.f;
#pragma unroll
        for (int hh = 0; hh < 8; ++hh) tot += s_part[hh * 64 + nt * 16 + fr];
        const float rinv = rsqrtf(tot * (1.0f / 512.0f) + 1e-6f);
        bf16_t* yp = WSP(bf16_t, WS_YCAT) + (tq0 + nt * 16 + fr) * 1024 + 512 + h * 64 + 4 * fq;
#pragma unroll
        for (int dt = 0; dt < 4; ++dt) { u32x2 w; w.x = pk2(o[dt][nt][0] * rinv, o[dt][nt][1] * rinv); w.y = pk2(o[dt][nt][2] * rinv, o[dt][nt][3] * rinv); *(u32x2*)(yp + dt * 16) = w; }
    }
    __syncthreads();
}

__device__ __forceinline__ void pc_mixer(const PA a, int l, LAS unsigned char* lds) {
    const int tid = otid();
    LAS float* s_bias = (LAS float*)(lds + LDS_MISC + 1024);
    volatile LAS int* s_item = (volatile LAS int*)(lds + LDS_MISC + 64);
    for (int i = tid; i < 8 * 320; i += 512) s_bias[i] = INP(20)[l * 8 * 320 + i] * 1.4426950408889634f;
    unsigned* qhead = WSP(unsigned, WS_CTL) + CW_QUEUE + l * 64;
    for (;;) {
        __syncthreads();
        if (tid == 0) *s_item = (int)__hip_atomic_fetch_add(qhead, 1u, __ATOMIC_RELAXED, __HIP_MEMORY_SCOPE_AGENT);
        __syncthreads();
        const int item = __builtin_amdgcn_readfirstlane(*s_item);
        if (item >= 128 + 512 + MOE_CONV_ITEMS) break;
        if (item < 128) scan_item(a, l, item, lds);
        else if (item < 128 + 512) attn_item(a, l, item - 128, lds);
        else moe_convert_item(a, l, lds, item - 640);
    }
}

__device__ __forceinline__ void pe2_xattn(const PA a, int l, LAS unsigned char* lds) {
    const int tid = otid(), wave = tid >> 6, lane = tid & 63, fr = lane & 15, fq = lane >> 4;
    LAS bf16_t* sK = (LAS bf16_t*)lds;
    LAS bf16_t* sV = (LAS bf16_t*)(lds + 69632);
    const bf16_t* QX = WSP(const bf16_t, WS_QX); bf16_t* OX = WSP(bf16_t, WS_OX);
    const bf16_t* KV = WSP(const bf16_t, WS_KV) + (size_t)l * MROWS * 1024;
    const bf16_t* VTX = WSP(const bf16_t, WS_VTX) + (size_t)l * MROWS * 512;
    const float* qgn = INP(28) + l * 128;
    for (int it = oblk(); it < 256; it += ogrid()) {
        const int b = it >> 4, h = (it >> 2) & 3, qr = it & 3;
        __syncthreads();
#pragma unroll
        for (int i = 0; i < 8; ++i) {
            const int p = tid + i * 512, r = p >> 4, c8 = (p & 15) * 8;
            *(LAS u32x4*)(sK + r * 136 + c8) = *(const u32x4*)(KV + (size_t)(b * 256 + r) * 1024 + h * 128 + c8);
            const int d = p >> 5, m8 = (p & 31) * 8;
            *(LAS u32x4*)(sV + d * 264 + m8) = *(const u32x4*)(VTX + ((size_t)(b * 4 + h) * 128 + d) * 256 + m8);
        }
        __syncthreads();
#pragma unroll 1
        for (int iter = 0; iter < 2; ++iter) {
            const size_t q0 = (size_t)b * SEQ + qr * 512 + iter * 256 + wave * 32;
            bf16x8 qf[2][4];
#pragma unroll
            for (int nt = 0; nt < 2; ++nt) {
                const bf16_t* qp = QX + (q0 + nt * 16 + fr) * 512 + h * 128 + 8 * fq;
                u32x4 w[4]; float ssq = 0.f;
#pragma unroll
                for (int ks = 0; ks < 4; ++ks) { w[ks] = *(const u32x4*)(qp + 32 * ks);
#pragma unroll
                    for (int j = 0; j < 4; ++j) { const float x0 = lo16(w[ks][j]), x1 = hi16(w[ks][j]); ssq += x0 * x0 + x1 * x1; } }
                ssq += __shfl_xor(ssq, 16); ssq += __shfl_xor(ssq, 32);
                const float sc = rsqrtf(ssq * (1.0f / 128.0f) + 1e-6f) * 0.12751743f;
#pragma unroll
                for (int ks = 0; ks < 4; ++ks) {
                    const f32x4 g0 = *(const f32x4*)(qgn + 32 * ks + 8 * fq), g1 = *(const f32x4*)(qgn + 32 * ks + 8 * fq + 4);
                    u32x4 ow;
                    ow.x = pk2(lo16(w[ks][0]) * sc * g0[0], hi16(w[ks][0]) * sc * g0[1]); ow.y = pk2(lo16(w[ks][1]) * sc * g0[2], hi16(w[ks][1]) * sc * g0[3]);
                    ow.z = pk2(lo16(w[ks][2]) * sc * g1[0], hi16(w[ks][2]) * sc * g1[1]); ow.w = pk2(lo16(w[ks][3]) * sc * g1[2], hi16(w[ks][3]) * sc * g1[3]);
                    qf[nt][ks] = __builtin_bit_cast(bf16x8, ow);
                }
            }
            f32x4 o[8][2];
#pragma unroll
            for (int dt = 0; dt < 8; ++dt) { o[dt][0] = (f32x4){0.f, 0.f, 0.f, 0.f}; o[dt][1] = (f32x4){0.f, 0.f, 0.f, 0.f}; }
            float lsum[2] = {0.f, 0.f};
#pragma unroll 2
            for (int st = 0; st < 8; ++st) {
                const int k0 = st * 32;
                f32x4 sacc[2][2];
#pragma unroll
                for (int mt = 0; mt < 2; ++mt) {
                    sacc[mt][0] = (f32x4){0.f, 0.f, 0.f, 0.f}; sacc[mt][1] = (f32x4){0.f, 0.f, 0.f, 0.f};
#pragma unroll
                    for (int ks = 0; ks < 4; ++ks) {
                        const bf16x8 kfr = *(const LAS bf16x8*)(sK + (k0 + mt * 16 + fr) * 136 + 32 * ks + 8 * fq);
                        sacc[mt][0] = __builtin_amdgcn_mfma_f32_16x16x32_bf16(kfr, qf[0][ks], sacc[mt][0], 0, 0, 0);
                        sacc[mt][1] = __builtin_amdgcn_mfma_f32_16x16x32_bf16(kfr, qf[1][ks], sacc[mt][1], 0, 0, 0);
                    }
                }
                bf16x8 pf[2];
#pragma unroll
                for (int nt = 0; nt < 2; ++nt) {
                    float p[8];
#pragma unroll
                    for (int j = 0; j < 4; ++j) { p[j] = __builtin_amdgcn_exp2f(fminf(sacc[0][nt][j], 80.f)); p[4 + j] = __builtin_amdgcn_exp2f(fminf(sacc[1][nt][j], 80.f)); }
                    lsum[nt] += ((p[0] + p[1]) + (p[2] + p[3])) + ((p[4] + p[5]) + (p[6] + p[7]));
                    u32x4 w; w.x = pk2(p[0], p[1]); w.y = pk2(p[2], p[3]); w.z = pk2(p[4], p[5]); w.w = pk2(p[6], p[7]);
                    pf[nt] = __builtin_bit_cast(bf16x8, w);
                }
#pragma unroll
                for (int dt = 0; dt < 8; ++dt) {
                    const LAS bf16_t* vp = sV + (dt * 16 + fr) * 264 + k0 + 4 * fq;
                    const u32x2 v0 = *(const LAS u32x2*)vp, v1 = *(const LAS u32x2*)(vp + 16);
                    u32x4 w; w.x = v0.x; w.y = v0.y; w.z = v1.x; w.w = v1.y;
                    const bf16x8 vfr = __builtin_bit_cast(bf16x8, w);
                    o[dt][0] = __builtin_amdgcn_mfma_f32_16x16x32_bf16(vfr, pf[0], o[dt][0], 0, 0, 0);
                    o[dt][1] = __builtin_amdgcn_mfma_f32_16x16x32_bf16(vfr, pf[1], o[dt][1], 0, 0, 0);
                }
            }
#pragma unroll
            for (int nt = 0; nt < 2; ++nt) {
                float ls = lsum[nt]; ls += __shfl_xor(ls, 16); ls += __shfl_xor(ls, 32);
                const float inv = 1.0f / ls;
                bf16_t* op = OX + (q0 + nt * 16 + fr) * 512 + h * 128 + 4 * fq;
#pragma unroll
                for (int dt = 0; dt < 8; ++dt) { u32x2 w; w.x = pk2(o[dt][nt][0] * inv, o[dt][nt][1] * inv); w.y = pk2(o[dt][nt][2] * inv, o[dt][nt][3] * inv); *(u32x2*)(op + dt * 16) = w; }
            }
        }
    }
    __syncthreads();
}

__device__ __forceinline__ void pf_router(const PA a, int l, LAS unsigned char* lds) {
    const int tid = otid(), wave = tid >> 6, lane = tid & 63, fr = lane & 15, fq = lane >> 4;
    LAS int* s_cnt = (LAS int*)lds;
    LAS int* s_base = s_cnt + 32;
    LAS int* s_e = s_base + 32;
    LAS int* s_rk = s_e + 256;
    LAS float* s_w = (LAS float*)(s_rk + 256);
    const float* X = a.out; const float* SS = WSP(const float, WS_SS);
    const bf16_t* wrh = WSP(const bf16_t, WS_WRH) + (size_t)l * 48 * 1024; const bf16_t* wrl = WSP(const bf16_t, WS_WRL) + (size_t)l * 48 * 1024;
    const float* bg = INP(32) + l * 4; const float* br = INP(34) + l * 32;
    int* EID = WSP(int, WS_EID); float* EW = WSP(float, WS_EW); int* ERK = WSP(int, WS_ERK);
    unsigned* cnt = WSP(unsigned, WS_CTL) + CW_CNT + l * 32;
    for (int tile = oblk(); tile < T / 128; tile += ogrid()) {
        __syncthreads();
        if (tid < 32) s_cnt[tid] = 0;
        __syncthreads();
        const int t = tile * 128 + wave * 16 + fr;
        f32x4 acc[3];
#pragma unroll
        for (int mt = 0; mt < 3; ++mt) acc[mt] = (f32x4){0.f, 0.f, 0.f, 0.f};
        const float* xr = X + (size_t)t * 1024 + 8 * fq;
#pragma unroll 4
        for (int s_ = 0; s_ < 32; ++s_) {
            const f32x4 x0 = *(const f32x4*)(xr + 32 * s_), x1 = *(const f32x4*)(xr + 32 * s_ + 4);
            u32x4 hw; hw.x = pk2(x0[0], x0[1]); hw.y = pk2(x0[2], x0[3]); hw.z = pk2(x1[0], x1[1]); hw.w = pk2(x1[2], x1[3]);
            u32x4 lw; lw.x = pk2(x0[0] - lo16(hw.x), x0[1] - hi16(hw.x)); lw.y = pk2(x0[2] - lo16(hw.y), x0[3] - hi16(hw.y));
            lw.z = pk2(x1[0] - lo16(hw.z), x1[1] - hi16(hw.z)); lw.w = pk2(x1[2] - lo16(hw.w), x1[3] - hi16(hw.w));
            const bf16x8 xh = __builtin_bit_cast(bf16x8, hw), xl = __builtin_bit_cast(bf16x8, lw);
#pragma unroll
            for (int mt = 0; mt < 3; ++mt) {
                const bf16x8 wh = *(const bf16x8*)(wrh + (size_t)(mt * 16 + fr) * 1024 + 32 * s_ + 8 * fq);
                const bf16x8 wl = *(const bf16x8*)(wrl + (size_t)(mt * 16 + fr) * 1024 + 32 * s_ + 8 * fq);
                acc[mt] = __builtin_amdgcn_mfma_f32_16x16x32_bf16(wh, xh, acc[mt], 0, 0, 0);
                acc[mt] = __builtin_amdgcn_mfma_f32_16x16x32_bf16(wh, xl, acc[mt], 0, 0, 0);
                acc[mt] = __builtin_amdgcn_mfma_f32_16x16x32_bf16(wl, xh, acc[mt], 0, 0, 0);
            }
        }
        const f32x4* sp = (const f32x4*)(SS + (size_t)t * 16);
        const f32x4 s0 = sp[0], s1 = sp[1], s2 = sp[2], s3 = sp[3];
        const float tot = ((s0[0] + s0[1]) + (s0[2] + s0[3])) + ((s1[0] + s1[1]) + (s1[2] + s1[3])) + ((s2[0] + s2[1]) + (s2[2] + s2[3])) + ((s3[0] + s3[1]) + (s3[2] + s3[3]));
        const float rinv = rsqrtf(tot * (1.0f / 1024.0f) + 1e-6f);
        float lg[4], lr[8];
#pragma unroll
        for (int j = 0; j < 4; ++j) { lg[j] = acc[0][j] * rinv + bg[j]; lr[j] = acc[1][j] * rinv + br[fq * 8 + j]; lr[4 + j] = acc[2][j] * rinv + br[fq * 8 + 4 + j]; }
        float g0 = lg[0]; int gt = 0;
#pragma unroll
        for (int j = 1; j < 4; ++j) { if (lg[j] > g0) { g0 = lg[j]; gt = j; } }
        if (fq == gt) {
            float gs = 0.f;
#pragma unroll
            for (int j = 0; j < 4; ++j) gs += __expf(lg[j] - g0);
            const float ggate = 1.0f / gs;
            float l1 = -1e30f, l2 = -1e30f; int j1 = 0, j2 = 0;
#pragma unroll
            for (int j = 0; j < 8; ++j) { const float v = lr[j];
                if (v > l1) { l2 = l1; j2 = j1; l1 = v; j1 = j; } else if (v > l2) { l2 = v; j2 = j; } }
            const float e2 = __expf(l2 - l1);
            const float p1 = 1.0f / (1.0f + e2), p2 = e2 / (1.0f + e2);
            const int e1i = gt * 8 + j1, e2i = gt * 8 + j2;
            const int r1 = atomicAdd((int*)(s_cnt + e1i), 1), r2 = atomicAdd((int*)(s_cnt + e2i), 1);
            const int sl = (wave * 16 + fr) * 2;
            s_e[sl] = e1i; s_e[sl + 1] = e2i; s_rk[sl] = r1; s_rk[sl + 1] = r2; s_w[sl] = ggate * p1; s_w[sl + 1] = ggate * p2;
        }
        __syncthreads();
        if (tid < 32) s_base[tid] = (int)__hip_atomic_fetch_add(cnt + tid, (unsigned)s_cnt[tid], __ATOMIC_RELAXED, __HIP_MEMORY_SCOPE_AGENT);
        __syncthreads();
        if (tid < 256) { const int e = s_e[tid]; const size_t o = (size_t)tile * 256 + tid; EID[o] = e; EW[o] = s_w[tid]; ERK[o] = s_base[e] + s_rk[tid]; }
    }
    __syncthreads();
}

__device__ __forceinline__ void pg_gather(const PA a, int l, LAS unsigned char* lds) {
    const int tid = otid(), wave = tid >> 6, lane = tid & 63;
    LAS int* s_ps = (LAS int*)lds;
    const unsigned* cnt = WSP(const unsigned, WS_CTL) + CW_CNT + l * 32;
    int* SSLOT = WSP(int, WS_SSLOT); float* SW = WSP(float, WS_SW); int* MTE = WSP(int, WS_MTE);
    bf16_t* XS = WSP(bf16_t, WS_XS); const bf16_t* XB = WSP(const bf16_t, WS_XB);
    const float* SS = WSP(const float, WS_SS);
    const int* EID = WSP(const int, WS_EID); const float* EW = WSP(const float, WS_EW); const int* ERK = WSP(const int, WS_ERK);
    __syncthreads();
    if (tid == 0) {
        int acc = 0;
        for (int e = 0; e < 32; ++e) { s_ps[e] = acc; const int c = (int)__hip_atomic_load(cnt + e, __ATOMIC_RELAXED, __HIP_MEMORY_SCOPE_AGENT); acc += ((c + 255) >> 8) << 8; }
        s_ps[32] = acc;
    }
    __syncthreads();
    if (oblk() == 0) {
        if (tid < 32) { const int m0 = s_ps[tid] >> 8, m1 = s_ps[tid + 1] >> 8; for (int mt = m0; mt < m1; ++mt) MTE[mt] = tid; }
        if (tid == 0) MTE[511] = s_ps[32] >> 8;
    }
    for (int e = oblk(); e < 32; e += ogrid()) {
        const int c = (int)__hip_atomic_load(cnt + e, __ATOMIC_RELAXED, __HIP_MEMORY_SCOPE_AGENT);
        const int r0 = s_ps[e] + c, r1 = s_ps[e + 1];
        for (int r = r0 + wave; r < r1; r += 8) {
            if (lane == 0) { SSLOT[r] = -1; SW[r] = 0.f; }
            unsigned zz = 0u; asm volatile("" : "+v"(zz));
            u32x4 z = {zz, zz, zz, zz};
            *(u32x4*)(XS + (size_t)r * 1024 + lane * 8) = z; *(u32x4*)(XS + (size_t)r * 1024 + 512 + lane * 8) = z;
        }
    }
    for (int as = oblk() * 8 + wave; as < 2 * T; as += ogrid() * 8) {
        const int t = as >> 1;
        const int e = EID[as], rk = ERK[as];
        const int dest = s_ps[e] + rk;
        float tot = 0.f;
        if (lane < 16) tot = SS[(size_t)t * 16 + lane];
        tot = wsum(tot);
        const float rinv = rsqrtf(tot * (1.0f / 1024.0f) + 1e-6f);
        if (lane == 0) { SSLOT[dest] = as; SW[dest] = EW[as]; }
#pragma unroll
        for (int i = 0; i < 2; ++i) {
            const u32x4 w = *(const u32x4*)(XB + (size_t)t * 1024 + i * 512 + lane * 8);
            u32x4 o;
#pragma unroll
            for (int j = 0; j < 4; ++j) o[j] = pk2(lo16(w[j]) * rinv, hi16(w[j]) * rinv);
            *(u32x4*)(XS + (size_t)dest * 1024 + i * 512 + lane * 8) = o;
        }
    }
}

__device__ __forceinline__ void pj_finalize(const PA a) {
    const int wave = otid() >> 6, lane = otid() & 63;
    float* X = a.out; bf16_t* XB = WSP(bf16_t, WS_XB); float* SS = WSP(float, WS_SS);
    const bf16_t* Y = WSP(const bf16_t, WS_Y);
    for (int t = oblk() * 8 + wave; t < T; t += ogrid() * 8) {
        float sq = 0.f;
#pragma unroll
        for (int i = 0; i < 4; ++i) {
            const int c = i * 256 + lane * 4;
            f32x4 v = *(const f32x4*)(X + (size_t)t * 1024 + c);
            const u32x2 y0 = *(const u32x2*)(Y + (size_t)(2 * t) * 1024 + c), y1 = *(const u32x2*)(Y + (size_t)(2 * t + 1) * 1024 + c);
            v[0] += lo16(y0.x) + lo16(y1.x); v[1] += hi16(y0.x) + hi16(y1.x); v[2] += lo16(y0.y) + lo16(y1.y); v[3] += hi16(y0.y) + hi16(y1.y);
            *(f32x4*)(X + (size_t)t * 1024 + c) = v;
            u32x2 w; w.x = pk2(v[0], v[1]); w.y = pk2(v[2], v[3]);
            *(u32x2*)(XB + (size_t)t * 1024 + c) = w;
            sq += (v[0] * v[0] + v[1] * v[1]) + (v[2] * v[2] + v[3] * v[3]);
        }
        sq = wsum(sq);
        if (lane < 16) SS[(size_t)t * 16 + lane] = (lane == 0) ? sq : 0.f;
    }
}

#define SITE static __device__ __forceinline__ void
#define OPAQUE() do { a.out = (float*)ldsin(lds, 38); a.ws = (unsigned char*)ldsin(lds, 39); } while (0)
__device__ __forceinline__ int opq(int v) { asm volatile("" : "+s"(v)); return v; }
SITE site_p0(PA a, LAS unsigned char* lds) { OPAQUE(); p0_prologue(a, lds); }
SITE site_kv(PA a, LAS unsigned char* lds) { OPAQUE();
    pg8::Gemm g{WSP(const bf16_t, WS_MEMB), WSP(const bf16_t, WS_WKV), 1024, (size_t)1024 * 1024};
    pg8::KvOrder S{opq((int)gridDim.x), opq((int)blockIdx.x)};
    pg8::EpiScale E{WSP(bf16_t, WS_KV), 1024, WSP(const float, WS_MEMSS), MROWS - 1};
    pg8::gemm_phase<pg8::EpiScale, pg8::KvOrder>(lds, g, S, E);
}
SITE site_knorm(PA a, LAS unsigned char* lds) { OPAQUE(); p2_knorm(a, lds); }
SITE site_inproj(PA a, int l, LAS unsigned char* lds) { OPAQUE();
    pg8::Gemm g{WSP(const bf16_t, WS_XB), WSP(const bf16_t, WS_WIN) + (size_t)l * INW * 1024, 1024, 0};
    pg8::StaticOrder S; S.init(T, INW, opq((int)gridDim.x), opq((int)blockIdx.x));
    pg8::EpiProj E{WSP(bf16_t, WS_PROJ), WSP(bf16_t, WS_VT), WSP(const float, WS_SS)};
    pg8::gemm_phase<pg8::EpiProj, pg8::StaticOrder>(lds, g, S, E);
}
SITE site_prep(PA a, int l, LAS unsigned char* lds) { OPAQUE();
    pb_prep(a, l, lds);
}
SITE site_chunks(PA a, int l, LAS unsigned char* lds) { OPAQUE(); pb2_chunks(a, l, lds); }
SITE site_mixer(PA a, int l, LAS unsigned char* lds) { OPAQUE(); pc_mixer(a, l, lds); }
SITE site_outproj(PA a, int l, LAS unsigned char* lds) { OPAQUE();
    pg8::Gemm g{WSP(const bf16_t, WS_YCAT), WSP(const bf16_t, WS_WOUT) + (size_t)l * 1024 * 1024, 1024, 0};
    pg8::StaticOrder S; S.init(T, 1024, opq((int)gridDim.x), opq((int)blockIdx.x));
    pg8::EpiRes E{a.out, WSP(bf16_t, WS_XB), WSP(float, WS_SS)};
    pg8::gemm_phase<pg8::EpiRes, pg8::StaticOrder>(lds, g, S, E);
}
SITE site_xq(PA a, int l, LAS unsigned char* lds) { OPAQUE();
    pg8::Gemm g{WSP(const bf16_t, WS_XB), WSP(const bf16_t, WS_WQ) + (size_t)l * 512 * 1024, 1024, 0};
    pg8::StaticOrder S; S.init(T, 512, opq((int)gridDim.x), opq((int)blockIdx.x));
    pg8::EpiScale E{WSP(bf16_t, WS_QX), 512, WSP(const float, WS_SS), T - 1};
    pg8::gemm_phase<pg8::EpiScale, pg8::StaticOrder>(lds, g, S, E);
}
SITE site_xattn(PA a, int l, LAS unsigned char* lds) { OPAQUE(); pe2_xattn(a, l, lds); }
SITE site_xo(PA a, int l, LAS unsigned char* lds) { OPAQUE();
    pg8::Gemm g{WSP(const bf16_t, WS_OX), WSP(const bf16_t, WS_WO) + (size_t)l * 1024 * 512, 512, 0};
    pg8::StaticOrder S; S.init(T, 1024, opq((int)gridDim.x), opq((int)blockIdx.x));
    pg8::EpiRes E{a.out, WSP(bf16_t, WS_XB), WSP(float, WS_SS)};
    pg8::gemm_phase<pg8::EpiRes, pg8::StaticOrder>(lds, g, S, E);
}
SITE site_router(PA a, int l, LAS unsigned char* lds) { OPAQUE(); pf_router(a, l, lds); }
SITE site_gather(PA a, int l, LAS unsigned char* lds) { OPAQUE(); pg_gather(a, l, lds); }
SITE site_gu(PA a, LAS unsigned char* lds) { OPAQUE();
    pg8::Gemm g{WSP(const bf16_t, WS_XS), WSP(const bf16_t, WS_WGU), 1024, (size_t)1024 * 1024};
    pg8::MoeOrder S{WSP(const int, WS_MTE), opq((int)gridDim.x), opq((int)blockIdx.x)};
    pg8::EpiGU E{WSP(bf16_t, WS_HB)};
    pg8::gemm_phase<pg8::EpiGU, pg8::MoeOrder>(lds, g, S, E);
}
SITE site_down(PA a, LAS unsigned char* lds) { OPAQUE();
    pg8::Gemm g{WSP(const bf16_t, WS_HB), WSP(const bf16_t, WS_WD), 512, (size_t)1024 * 512};
    pg8::MoeOrder S{WSP(const int, WS_MTE), opq((int)gridDim.x), opq((int)blockIdx.x)};
    pg8::EpiDown E{WSP(bf16_t, WS_Y), WSP(const int, WS_SSLOT), WSP(const float, WS_SW)};
    pg8::gemm_phase<pg8::EpiDown, pg8::MoeOrder>(lds, g, S, E);
}
SITE site_final(PA a, LAS unsigned char* lds) { OPAQUE(); pj_finalize(a); }

__global__ void __launch_bounds__(512, 2) mk_fwd(Args args) {
    extern __shared__ __attribute__((aligned(16))) unsigned char lds_raw[];
    LAS unsigned char* lds = (LAS unsigned char*)lds_raw;
    const int tid = threadIdx.x;
    const int lo = args.ph_lo, hi = args.ph_hi;
    PA a; a.out = args.out; a.ws = args.ws;
    if (tid < 16) ((LAS unsigned*)(lds + LDS_MISC))[tid] = 0u;
    if (tid == 64) {
        LAS unsigned long long* tab = (LAS unsigned long long*)(lds + LDS_INTAB);
#pragma unroll
        for (int i = 0; i < 38; ++i) tab[i] = (unsigned long long)args.in[i];
        tab[38] = (unsigned long long)args.out; tab[39] = (unsigned long long)args.ws;
    }
    __syncthreads();
    XcdBarrier bar; bar.bar = WSP(unsigned, WS_CTL) + CW_BAR; bar.x = 0; bar.st = nullptr;
    if (!MK_PER_PHASE) bar = xcd_barrier_post(WSP(unsigned, WS_CTL) + CW_BAR, (volatile LAS unsigned*)(lds + LDS_MISC));
#define IN(k) (lo <= (k) && (k) < hi)
#define GRID_BAR() do { if (!MK_PER_PHASE) xcd_barrier(bar); } while (0)
#ifdef PROBE_MASK
    unsigned long long pr_acc = 0ull, pr_t0 = 0ull; const unsigned long long pr_start = wall_clock64();
#define PR0() do { pr_t0 = wall_clock64(); } while (0)
#define PR1(p) do { if ((PROBE_MASK >> (p)) & 1) pr_acc += wall_clock64() - pr_t0; } while (0)
#else
#define PR0() do { } while (0)
#define PR1(p) do { } while (0)
#endif
    PR0(); if (IN(0)) { site_p0(a, lds); GRID_BAR(); } PR1(12);
    PR0(); if (IN(1)) { site_kv(a, lds); GRID_BAR(); } PR1(13);
    PR0(); if (IN(2)) { site_knorm(a, lds); GRID_BAR(); } PR1(14);
    for (int l = 0; l < NL; ++l) {
        const int pb = 3 + 12 * l;
        PR0(); if (IN(pb + 0)) { site_inproj(a, l, lds); GRID_BAR(); } PR1(0);
        PR0(); if (IN(pb + 1)) { site_prep(a, l, lds); GRID_BAR(); site_chunks(a, l, lds); GRID_BAR(); } PR1(1);
        PR0(); if (IN(pb + 2)) { site_mixer(a, l, lds); GRID_BAR(); } PR1(2);
        PR0(); if (IN(pb + 3)) { site_outproj(a, l, lds); GRID_BAR(); } PR1(3);
        PR0(); if (IN(pb + 4)) { site_xq(a, l, lds); GRID_BAR(); } PR1(4);
        PR0(); if (IN(pb + 5)) { site_xattn(a, l, lds); GRID_BAR(); } PR1(5);
        PR0(); if (IN(pb + 6)) { site_xo(a, l, lds); GRID_BAR(); } PR1(6);
        PR0(); if (IN(pb + 7)) { site_router(a, l, lds); GRID_BAR(); } PR1(7);
        PR0(); if (IN(pb + 8)) { site_gather(a, l, lds); GRID_BAR(); } PR1(8);
        PR0(); if (IN(pb + 9)) { site_gu(a, lds); GRID_BAR(); } PR1(9);
        PR0(); if (IN(pb + 10)) { site_down(a, lds); GRID_BAR(); } PR1(10);
#ifdef PROBE_MASK
        PR0(); if (IN(pb + 11)) { site_final(a, lds); GRID_BAR(); } PR1(11);
#else
        if (IN(pb + 11)) { site_final(a, lds); if (l + 1 < NL) GRID_BAR(); }
#endif
    }
#ifdef PROBE_MASK
    {
        unsigned long long* pw = (unsigned long long*)(WSP(unsigned, WS_CTL) + 8192);
        if (blockIdx.x == 0 && tid == 0) __hip_atomic_store(pw, pr_acc, __ATOMIC_RELAXED, __HIP_MEMORY_SCOPE_AGENT);
        GRID_BAR();
        const unsigned long long tgt = 1600000ull + __hip_atomic_load(pw, __ATOMIC_RELAXED, __HIP_MEMORY_SCOPE_AGENT) * (unsigned long long)PROBE_MULT;
        while (wall_clock64() - pr_start < tgt) __builtin_amdgcn_s_sleep(16);
    }
#endif
#undef IN
#undef GRID_BAR
}

extern "C" void kernel_launch(void* const* d_in, const int* in_sizes, int n_in, void* d_out, int out_size, void* d_ws, size_t ws_size, hipStream_t stream) {
    static int grid = 0;
    if (grid == 0) {
        if (n_in != 38 || out_size != T * D || ws_size < WS_END) { fprintf(stderr, "kernel_launch: unexpected shapes (n_in %d out %d ws %zu need %zu)\n", n_in, out_size, ws_size, (size_t)WS_END); grid = -1; return; }
        int dev = 0, cus = 0, per_cu = 0;
        if (hipGetDevice(&dev) != hipSuccess || hipDeviceGetAttribute(&cus, hipDeviceAttributeMultiprocessorCount, dev) != hipSuccess) { grid = -1; return; }
        if (hipFuncSetAttribute((const void*)mk_fwd, hipFuncAttributeMaxDynamicSharedMemorySize, LDS_BYTES) != hipSuccess) { fprintf(stderr, "kernel_launch: hipFuncSetAttribute failed\n"); grid = -1; return; }
        if (hipOccupancyMaxActiveBlocksPerMultiprocessor(&per_cu, (const void*)mk_fwd, 512, LDS_BYTES) != hipSuccess || per_cu < 1) { fprintf(stderr, "kernel_launch: occupancy query says %d\n", per_cu); }
        (void)hipGetLastError();
        grid = cus;
    }
    if (grid < 0) return;
    (void)hipMemsetAsync((char*)d_ws + WS_CTL, 0, CTL_BYTES, stream);
    Args a{};
    for (int i = 0; i < 38; ++i) a.in[i] = (const float*)d_in[i];
    a.out = (float*)d_out; a.ws = (unsigned char*)d_ws;
#if MK_PER_PHASE
    for (int p = 0; p < NPH; ++p) { a.ph_lo = p; a.ph_hi = p + 1; hipLaunchKernelGGL(mk_fwd, dim3(grid), dim3(512), LDS_BYTES, stream, a); }
#else
    a.ph_lo = 0; a.ph_hi = NPH;
    hipLaunchKernelGGL(mk_fwd, dim3(grid), dim3(512), LDS_BYTES, stream, a);
#endif
}
```

```cpp
#include <hip/hip_runtime.h>
#include <cstdio>
#include <cstdint>

#ifndef MK_PER_PHASE
#define MK_PER_PHASE 0
#endif

#define LAS __attribute__((address_space(3)))
typedef unsigned short bf16_t;
typedef short bf16x8 __attribute__((ext_vector_type(8)));
typedef float f32x4 __attribute__((ext_vector_type(4)));
typedef unsigned u32x4 __attribute__((ext_vector_type(4)));
typedef unsigned u32x2 __attribute__((ext_vector_type(2)));

constexpr int T = 32768, D = 1024, SEQ = 2048, NL = 4;
constexpr int INW = 3328;
constexpr int MROWS = 4096;
constexpr int MAXROWS = 73728, MAXMT = 288;
constexpr int NPH = 3 + 12 * NL;

constexpr size_t WS_CTL   = 0;
constexpr size_t CTL_BYTES = 65536;
constexpr size_t WS_WIN   = WS_CTL + CTL_BYTES;
constexpr size_t WS_WOUT  = WS_WIN  + (size_t)4 * 3328 * 1024 * 2;
constexpr size_t WS_WQ    = WS_WOUT + (size_t)4 * 1024 * 1024 * 2;
constexpr size_t WS_WKV   = WS_WQ   + (size_t)4 * 512 * 1024 * 2;
constexpr size_t WS_WO    = WS_WKV  + (size_t)4 * 1024 * 1024 * 2;
constexpr size_t WS_WGU   = WS_WO   + (size_t)4 * 1024 * 512 * 2;
constexpr size_t WS_WD    = WS_WGU  + (size_t)32 * 1024 * 1024 * 2;
constexpr size_t WS_KV    = WS_WD   + (size_t)32 * 1024 * 512 * 2;
constexpr size_t WS_MEMB  = WS_KV   + (size_t)4 * 4096 * 1024 * 2;
constexpr size_t WS_MEMSS = WS_MEMB + (size_t)4096 * 1024 * 2;
constexpr size_t WS_VTX   = WS_MEMSS + (size_t)4096 * 16 * 4;
constexpr size_t WS_WRH   = WS_VTX  + (size_t)4 * 4096 * 512 * 2;
constexpr size_t WS_WRL   = WS_WRH  + (size_t)4 * 48 * 1024 * 2;
constexpr size_t WS_XB    = WS_WRL  + (size_t)4 * 48 * 1024 * 2;
constexpr size_t WS_SS    = WS_XB   + (size_t)T * 1024 * 2;
constexpr size_t WS_VF    = WS_SS   + (size_t)T * 16 * 4;
constexpr size_t WS_EID   = WS_VF   + (size_t)T * 512 * 2;
constexpr size_t WS_EW    = WS_EID  + (size_t)T * 2 * 4;
constexpr size_t WS_ERK   = WS_EW   + (size_t)T * 2 * 4;
constexpr size_t WS_SSLOT = WS_ERK  + (size_t)T * 2 * 4;
constexpr size_t WS_SW    = WS_SSLOT + (size_t)MAXROWS * 4;
constexpr size_t WS_MTE   = WS_SW   + (size_t)MAXROWS * 4;
constexpr size_t WS_U     = WS_MTE  + 2048;
constexpr size_t WS_PROJ  = WS_U;
constexpr size_t WS_SR    = WS_PROJ + (size_t)T * 3328 * 2;
constexpr size_t WS_SK    = WS_SR   + (size_t)T * 512 * 2;
constexpr size_t WS_SV    = WS_SK   + (size_t)T * 512 * 2;
constexpr size_t WS_SA    = WS_SV   + (size_t)T * 512 * 2;
constexpr size_t WS_SB    = WS_SA   + (size_t)T * 512 * 2;
constexpr size_t WS_SG    = WS_SB   + (size_t)T * 512 * 2;
constexpr size_t WS_SWD   = WS_SG   + (size_t)T * 512 * 2;
constexpr size_t WS_YCAT  = WS_SWD  + (size_t)T * 512 * 4;
constexpr size_t WS_VT    = WS_YCAT + (size_t)T * 1024 * 2;
constexpr int NCHUNK = 16 * 8 * 128;
constexpr size_t WS_BTT   = WS_VT   + (size_t)T * 512 * 2;
constexpr size_t WS_KTT   = WS_BTT  + (size_t)NCHUNK * 2048;
constexpr size_t WS_VST   = WS_KTT  + (size_t)NCHUNK * 2048;
constexpr size_t WS_NKA   = WS_VST  + (size_t)NCHUNK * 2048;
constexpr size_t WS_NBR   = WS_NKA  + (size_t)NCHUNK * 512;
constexpr size_t WS_NKR   = WS_NBR  + (size_t)NCHUNK * 512;
constexpr size_t WS_TMT   = WS_NKR  + (size_t)NCHUNK * 512;
constexpr size_t WS_PCK   = WS_TMT  + (size_t)NCHUNK * 512;
constexpr size_t WS_BS    = WS_PCK  + (size_t)NCHUNK * 256;
constexpr size_t WS_UEND1 = WS_BS   + (size_t)T * 8 * 4;
constexpr size_t WS_QX    = WS_U;
constexpr size_t WS_OX    = WS_QX   + (size_t)T * 512 * 2;
constexpr size_t WS_XS    = WS_U;
constexpr size_t WS_HB    = WS_XS   + (size_t)MAXROWS * 1024 * 2;
constexpr size_t WS_Y     = WS_HB   + (size_t)MAXROWS * 512 * 2;
constexpr size_t WS_UEND2 = WS_Y    + (size_t)2 * T * 1024 * 2;
constexpr size_t WS_END   = WS_UEND1 > WS_UEND2 ? WS_UEND1 : WS_UEND2;

constexpr int CW_BAR = 0;
constexpr int CW_CNT = 4096;
constexpr int CW_QUEUE = 4096 + 256;

constexpr int LDS_MISC = 139264;
constexpr int LDS_BYTES = LDS_MISC + 16384;

struct Args { const float* in[38]; float* out; unsigned char* ws; int ph_lo, ph_hi; };
struct PA { float* out; unsigned char* ws; };

__device__ __forceinline__ float bf2f(bf16_t b) { return __uint_as_float(((unsigned)b) << 16); }
__device__ __forceinline__ bf16_t f2bf(float f) { unsigned u = __float_as_uint(f); u += 0x7FFFu + ((u >> 16) & 1u); return (bf16_t)(u >> 16); }
typedef __bf16 bf16v2 __attribute__((ext_vector_type(2)));
typedef float f32x2 __attribute__((ext_vector_type(2)));
__device__ __forceinline__ unsigned pk2(float lo, float hi) { f32x2 v = {lo, hi}; bf16v2 b = __builtin_convertvector(v, bf16v2); return __builtin_bit_cast(unsigned, b); }
__device__ __forceinline__ float lo16(unsigned u) { return __uint_as_float(u << 16); }
__device__ __forceinline__ float hi16(unsigned u) { return __uint_as_float(u & 0xffff0000u); }
__device__ __forceinline__ float wsum(float v) {
#pragma unroll
    for (int o = 32; o; o >>= 1) v += __shfl_xor(v, o);
    return v;
}
__device__ __forceinline__ float sigmoidf_(float x) { return 1.0f / (1.0f + __expf(-x)); }

#define XB_TMO      128
#define XB_XCNT(j)  (256  + 64 * (j))
#define XB_XSUB(j)  (1280 + 64 * (j))
#define XB_XGEN(j)  (2304 + 64 * (j))
#define XB_TOP      3328
#define XB_TOPGEN   3392
#define XCD_BAR_WORDS 3456
#define XB_SPIN_CAP (1u << 22)

__device__ __forceinline__ unsigned xb_ld(unsigned* p)              { return __hip_atomic_load(p, __ATOMIC_RELAXED, __HIP_MEMORY_SCOPE_AGENT); }
__device__ __forceinline__ unsigned xb_add(unsigned* p, unsigned v) { return __hip_atomic_fetch_add(p, v, __ATOMIC_RELAXED, __HIP_MEMORY_SCOPE_AGENT); }
__device__ __forceinline__ unsigned xb_xcc_id() { return (unsigned)__builtin_amdgcn_s_getreg((3 << 11) | 20) & 0xFu; }
#define XB_SPIN(cond, bar) do { unsigned _sp = 0; while (cond) { __builtin_amdgcn_s_sleep(1); \
    if ((++_sp & 255u) == 0u) { if (xb_ld(&(bar)[XB_TMO])) break; if (_sp > XB_SPIN_CAP) { atomicAdd(&(bar)[XB_TMO], 1u); break; } } } } while (0)

struct XcdBarrier { unsigned* bar; unsigned x; volatile LAS unsigned* st; };

__device__ __forceinline__ XcdBarrier xcd_barrier_post(unsigned* bar, volatile LAS unsigned* st) {
    XcdBarrier b; b.bar = bar; b.x = xb_xcc_id(); b.st = st;
    if (threadIdx.x == 0) (void)xb_add(&bar[XB_XCNT(b.x)], 1u);
    return b;
}
__device__ __forceinline__ void xcd_barrier_complete(unsigned* bar, unsigned x, unsigned& nloc, unsigned& nx) {
    const unsigned G = gridDim.x * gridDim.y * gridDim.z;
    unsigned sum, cnt, mine, sp = 0u;
    for (;;) {
        sum = 0u; cnt = 0u; mine = 0u;
#pragma unroll
        for (unsigned j = 0; j < 16; ++j) { const unsigned c = xb_ld(&bar[XB_XCNT(j)]); sum += c; cnt += (c > 0u) ? 1u : 0u; mine = (j == x) ? c : mine; }
        if (sum == G) break;
        __builtin_amdgcn_s_sleep(1);
        if ((++sp & 255u) == 0u) { if (xb_ld(&bar[XB_TMO])) break; if (sp > XB_SPIN_CAP) { atomicAdd(&bar[XB_TMO], 1u); break; } }
    }
    nloc = mine > 0u ? mine : 1u; nx = cnt > 0u ? cnt : 1u;
}
__device__ __forceinline__ void xcd_barrier(const XcdBarrier& b) {
    asm volatile("s_waitcnt vmcnt(0)" ::: "memory");
    __syncthreads();
    if (threadIdx.x == 0) {
        unsigned* bar = b.bar;
        __builtin_amdgcn_s_waitcnt(0);
        unsigned nloc = b.st[0], nx = b.st[1];
        if (nloc == 0u) { xcd_barrier_complete(bar, b.x, nloc, nx); b.st[0] = nloc; b.st[1] = nx; }
        const unsigned old = xb_add(&bar[XB_XSUB(b.x)], 1u);
        const unsigned gen = old / nloc;
        if (old + 1u == (gen + 1u) * nloc) {
            __builtin_amdgcn_fence(__ATOMIC_RELEASE, "agent");
            asm volatile("s_waitcnt vmcnt(0)" ::: "memory");
            const unsigned og = xb_add(&bar[XB_TOP], 1u);
            const unsigned tg = og / nx;
            if (og + 1u == (tg + 1u) * nx) xb_add(&bar[XB_TOPGEN], 1u);
            else XB_SPIN(xb_ld(&bar[XB_TOPGEN]) == tg, bar);
            __builtin_amdgcn_fence(__ATOMIC_ACQUIRE, "agent");
            xb_add(&bar[XB_XGEN(b.x)], 1u);
            asm volatile("s_waitcnt vmcnt(0)" ::: "memory");
        } else {
            XB_SPIN(xb_ld(&bar[XB_XGEN(b.x)]) == gen, bar);
            __builtin_amdgcn_fence(__ATOMIC_ACQUIRE, "agent");
            asm volatile("s_waitcnt vmcnt(0)" ::: "memory");
        }
    }
    __syncthreads();
}

namespace pg8 {
constexpr int BM = 256, BK = 64, HALF = 128, HTB = HALF * BK * 2, STAGE_BYTES = 8 * HTB, NXCD = 8, WGM = 8;
__host__ __device__ __forceinline__ int lds_byte(int r, int c) { const int st = (r >> 4) * 2 + (c >> 5), rr = r & 15, cc = c & 31, ob = rr * 64 + cc * 2; return st * 1024 + (ob ^ (((ob >> 9) & 1) << 5)); }
__host__ __device__ __forceinline__ void stage_rc(int b, int& R, int& C) { const int st = b / 1024, sb = b % 1024, swz = sb ^ (((sb >> 9) & 1) << 5); R = (st >> 1) * 16 + swz / 64; C = (st & 1) * 32 + (swz % 64) / 2; }
__host__ __device__ __forceinline__ int perm32(int rho) { const int n = rho >> 4, i = rho & 15; return 8 * (i >> 2) + 4 * n + (i & 3); }

struct Unit { int pm, pn, pa, z; };
struct Gemm { const bf16_t* A; const bf16_t* Bt; int K; size_t bz_stride; };

struct StaticOrder {
    int nM, nN, nwg, G, c;
    __device__ void init(int M, int N, int G_, int c_) { nM = M / BM; nN = N / BM; nwg = nM * nN; G = G_; c = c_; }
    __device__ bool next(int i, Unit& u) const {
        const long L = (long)i * G + c; if (L >= nwg) return false;
        int wgid = (int)L; { const int q = nwg / NXCD, r = nwg % NXCD, xcd = wgid % NXCD, off = wgid / NXCD; wgid = (xcd < r ? xcd * (q + 1) : r * (q + 1) + (xcd - r) * q) + off; }
        const int nig = WGM * nN, gid = wgid / nig, fm = gid * WGM, gsz = (nM - fm) < WGM ? (nM - fm) : WGM;
        u.pm = fm + ((wgid % nig) % gsz); u.pn = (wgid % nig) / gsz; u.pa = u.pm; u.z = 0; return true;
    }
};
struct KvOrder {
    int G, c;
    __device__ bool next(int i, Unit& u) const {
        const int L = i * G + c; if (L >= 256) return false;
        u.z = L >> 6; const int r = L & 63; u.pa = r >> 2; u.pn = r & 3; u.pm = u.z * 16 + u.pa; return true;
    }
};
struct MoeOrder {
    const int* mte; int G, c;
    __device__ bool next(int i, Unit& u) const {
        const int nunits = mte[511] * 4;
        const int L = i * G + c; if (L >= nunits) return false;
        u.pm = L >> 2; u.pa = u.pm; u.pn = L & 3; u.z = mte[u.pm]; return true;
    }
};

template <class Epi, class Sched, bool ALIGN_EPI = true>
__device__ __forceinline__ void gemm_phase(LAS unsigned char* lds, const Gemm g, const Sched& S, const Epi& E) {
    int tid_ = threadIdx.x; asm volatile("" : "+v"(tid_));
    const int tid = tid_, wid = __builtin_amdgcn_readfirstlane(tid >> 6), lane = tid & 63, wr = wid >> 2, wc = wid & 3, fr = lane & 15, fq = lane >> 4;
    const int K = g.K, nt = K / BK;
    unsigned voffA[2], voffB[2];
#pragma unroll
    for (int i = 0; i < 2; ++i) { int R, C; stage_rc(tid * 16 + i * 8192, R, C); const int Rb = ((R & ~31) + perm32(R & 31));
        voffA[i] = (unsigned)(R * K + C) * 2u; voffB[i] = (unsigned)(Rb * K + C) * 2u; }
    const size_t kstep = (size_t)(BK * 2);
    const size_t hstep = (size_t)HALF * K * 2;
    const size_t tstep = 2 * hstep;
    const unsigned ldsw = (unsigned)wid * 1024u;
    const int aoff = lds_byte(wr * 64 + fr, fq * 8), boff = lds_byte(wc * 32 + fr, fq * 8);
#define PG8_SA(b, h) (((b) * 2 + (h)) * HTB)
#define PG8_SB(b, h) ((4 + (b) * 2 + (h)) * HTB)
#define PG8_STAGE(bufoff, gbase, voff) do { _Pragma("unroll") for (int _i = 0; _i < 2; ++_i) \
        __builtin_amdgcn_global_load_lds((const unsigned*)((const char*)(gbase) + (voff)[_i]), (LAS unsigned*)(lds + (bufoff) + ldsw + _i * 8192), 16, 0, 0); } while (0)
#define PG8_LDA(dst, b, h) do { _Pragma("unroll") for (int m = 0; m < 4; ++m) _Pragma("unroll") for (int k = 0; k < 2; ++k) dst[m][k] = *(const LAS bf16x8*)(lds + PG8_SA(b, h) + aoff + m * 2048 + k * 1024); } while (0)
#define PG8_LDB(dst, b, h) do { _Pragma("unroll") for (int n = 0; n < 2; ++n) _Pragma("unroll") for (int k = 0; k < 2; ++k) dst[n][k] = *(const LAS bf16x8*)(lds + PG8_SB(b, h) + boff + n * 2048 + k * 1024); } while (0)
#define PG8_MMA(ai, bj, At, Bt) do { __builtin_amdgcn_s_setprio(1); _Pragma("unroll") for (int m = 0; m < 4; ++m) _Pragma("unroll") for (int n = 0; n < 2; ++n) _Pragma("unroll") for (int k = 0; k < 2; ++k) \
        acc[ai][bj][m][n] = __builtin_amdgcn_mfma_f32_16x16x32_bf16(Bt[n][k], At[m][k], acc[ai][bj][m][n], 0, 0, 0); __builtin_amdgcn_s_setprio(0); } while (0)
#define PG8_WAIT_V(n) asm volatile("s_waitcnt vmcnt(" #n ")" ::: "memory")
#define PG8_WAIT_L(n) asm volatile("s_waitcnt lgkmcnt(" #n ")" ::: "memory")
#define PG8_BAR __builtin_amdgcn_s_barrier()
#define PG8_SCHED __builtin_amdgcn_sched_barrier(0)
#define PG8_APTR(u) ((const char*)g.A + (size_t)(u).pa * tstep)
#define PG8_BPTR(u) ((const char*)g.Bt + ((size_t)(u).z * g.bz_stride) * 2 + (size_t)(u).pn * tstep)
    Unit cur, nxt; int ui = 0;
    if (!S.next(0, cur)) return;
    f32x4 acc[2][2][4][2];
#pragma unroll
    for (int a = 0; a < 2; ++a)
#pragma unroll
        for (int b = 0; b < 2; ++b)
#pragma unroll
            for (int m = 0; m < 4; ++m)
#pragma unroll
                for (int n = 0; n < 2; ++n) acc[a][b][m][n] = (f32x4){0.f, 0.f, 0.f, 0.f};
    bf16x8 At[4][2], B0[2][2], B1[2][2];
    const char* cA = PG8_APTR(cur); const char* cB = PG8_BPTR(cur);
    PG8_STAGE(PG8_SB(0, 0), cB, voffB); PG8_STAGE(PG8_SB(0, 1), cB + hstep, voffB); PG8_STAGE(PG8_SA(0, 0), cA, voffA); PG8_STAGE(PG8_SA(0, 1), cA + hstep, voffA);
    if (wr == 1) PG8_BAR;
    PG8_WAIT_V(2); PG8_BAR;
    PG8_STAGE(PG8_SB(1, 0), cB + kstep, voffB); PG8_STAGE(PG8_SA(1, 0), cA + kstep, voffA); PG8_STAGE(PG8_SB(1, 1), cB + hstep + kstep, voffB);
    PG8_WAIT_V(6); PG8_BAR;
    for (;;) {
        const bool has_next = S.next(ui + 1, nxt);
        const char* nA = has_next ? PG8_APTR(nxt) : cA; const char* nB = has_next ? PG8_BPTR(nxt) : cB;
        for (int t = 0; t < nt; t += 2) {
            const bool last = (t == nt - 2);
            const char* a1 = cA + (size_t)(t + 1) * kstep;
            const char* a2 = last ? nA : cA + (size_t)(t + 2) * kstep; const char* b2 = last ? nB : cB + (size_t)(t + 2) * kstep;
            const char* a3 = a2 + kstep; const char* b3 = b2 + kstep;
            PG8_LDB(B0, 0, 0); PG8_LDB(B1, 0, 1); PG8_SCHED; PG8_LDA(At, 0, 0); PG8_STAGE(PG8_SA(1, 1), a1 + hstep, voffA);
            PG8_WAIT_V(8); PG8_WAIT_L(0); PG8_BAR; PG8_MMA(0, 0, At, B0); PG8_MMA(0, 1, At, B1); PG8_BAR; PG8_SCHED;
            PG8_LDA(At, 0, 1); PG8_STAGE(PG8_SB(0, 0), b2, voffB); PG8_STAGE(PG8_SB(0, 1), b2 + hstep, voffB); PG8_STAGE(PG8_SA(0, 0), a2, voffA);
            PG8_WAIT_V(8); PG8_WAIT_L(0); PG8_BAR; PG8_MMA(1, 0, At, B0); PG8_MMA(1, 1, At, B1); PG8_BAR; PG8_SCHED;
            PG8_LDB(B0, 1, 0); PG8_LDB(B1, 1, 1); PG8_SCHED; PG8_LDA(At, 1, 0); PG8_STAGE(PG8_SA(0, 1), a2 + hstep, voffA);
            PG8_WAIT_V(8); PG8_WAIT_L(0); PG8_BAR; PG8_MMA(0, 0, At, B0); PG8_MMA(0, 1, At, B1); PG8_BAR; PG8_SCHED;
            PG8_LDA(At, 1, 1); PG8_STAGE(PG8_SB(1, 0), b3, voffB); PG8_STAGE(PG8_SB(1, 1), b3 + hstep, voffB); PG8_STAGE(PG8_SA(1, 0), a3, voffA);
            PG8_WAIT_V(8); PG8_WAIT_L(0); PG8_BAR; PG8_MMA(1, 0, At, B0); PG8_MMA(1, 1, At, B1); PG8_BAR; PG8_SCHED;
        }
        if constexpr (ALIGN_EPI) { if (wr == 0) PG8_BAR; }
        E(acc, cur, wr, wc, fr, fq);
        if (!has_next) break;
#pragma unroll
        for (int a = 0; a < 2; ++a)
#pragma unroll
            for (int b = 0; b < 2; ++b)
#pragma unroll
                for (int m = 0; m < 4; ++m)
#pragma unroll
                    for (int n = 0; n < 2; ++n) acc[a][b][m][n] = (f32x4){0.f, 0.f, 0.f, 0.f};
        cur = nxt; cA = nA; cB = nB; ++ui;
        if constexpr (ALIGN_EPI) { if (wr == 1) PG8_BAR; }
    }
    PG8_WAIT_V(0);
    if constexpr (!ALIGN_EPI) { if (wr == 0) PG8_BAR; }
    PG8_BAR;
#undef PG8_SA
#undef PG8_SB
#undef PG8_STAGE
#undef PG8_LDA
#undef PG8_LDB
#undef PG8_MMA
#undef PG8_WAIT_V
#undef PG8_WAIT_L
#undef PG8_BAR
#undef PG8_SCHED
#undef PG8_APTR
#undef PG8_BPTR
}

typedef const f32x4 (&AccRef)[2][2][4][2];

struct EpiScale {
    bf16_t* O; int ldc; const float* ss; int ssmask;
    __device__ __forceinline__ void operator()(AccRef acc, const Unit& u, int wr, int wc, int fr, int fq) const {
#pragma unroll
        for (int ai = 0; ai < 2; ++ai)
#pragma unroll
            for (int m = 0; m < 4; ++m) {
                const int row = u.pm * 256 + ai * 128 + wr * 64 + m * 16 + fr;
                const f32x4* sp = (const f32x4*)(ss + (size_t)(row & ssmask) * 16);
                const f32x4 s0 = sp[0], s1 = sp[1], s2 = sp[2], s3 = sp[3];
                const float tot = ((s0[0] + s0[1]) + (s0[2] + s0[3])) + ((s1[0] + s1[1]) + (s1[2] + s1[3])) + ((s2[0] + s2[1]) + (s2[2] + s2[3])) + ((s3[0] + s3[1]) + (s3[2] + s3[3]));
                const float rinv = rsqrtf(tot * (1.0f / 1024.0f) + 1e-6f);
#pragma unroll
                for (int bj = 0; bj < 2; ++bj) {
                    const int col = u.pn * 256 + bj * 128 + wc * 32 + 8 * fq;
                    const f32x4 v0 = acc[ai][bj][m][0] * rinv, v1 = acc[ai][bj][m][1] * rinv;
                    u32x4 w; w.x = pk2(v0[0], v0[1]); w.y = pk2(v0[2], v0[3]); w.z = pk2(v1[0], v1[1]); w.w = pk2(v1[2], v1[3]);
                    *(u32x4*)(O + (size_t)row * ldc + col) = w;
                }
            }
    }
};
struct EpiProj {
    bf16_t* O; bf16_t* VT; const float* ss;
    __device__ __forceinline__ void operator()(AccRef acc, const Unit& u, int wr, int wc, int fr, int fq) const {
#pragma unroll
        for (int ai = 0; ai < 2; ++ai)
#pragma unroll
            for (int m = 0; m < 4; ++m) {
                const int row = u.pm * 256 + ai * 128 + wr * 64 + m * 16 + fr;
                const f32x4* sp = (const f32x4*)(ss + (size_t)row * 16);
                const f32x4 s0 = sp[0], s1 = sp[1], s2 = sp[2], s3 = sp[3];
                const float tot = ((s0[0] + s0[1]) + (s0[2] + s0[3])) + ((s1[0] + s1[1]) + (s1[2] + s1[3])) + ((s2[0] + s2[1]) + (s2[2] + s2[3])) + ((s3[0] + s3[1]) + (s3[2] + s3[3]));
                const float rinv = rsqrtf(tot * (1.0f / 1024.0f) + 1e-6f);
#pragma unroll
                for (int bj = 0; bj < 2; ++bj) {
                    const int col = u.pn * 256 + bj * 128 + wc * 32 + 8 * fq;
                    const f32x4 v0 = acc[ai][bj][m][0] * rinv, v1 = acc[ai][bj][m][1] * rinv;
                    u32x4 w; w.x = pk2(v0[0], v0[1]); w.y = pk2(v0[2], v0[3]); w.z = pk2(v1[0], v1[1]); w.w = pk2(v1[2], v1[3]);
                    if (u.pn < 11) *(u32x4*)(O + (size_t)row * INW + col) = w;
                    else {
                        const int cv = col - 2816;
                        bf16_t* vp = VT + ((size_t)((row >> 11) * 8 + (cv >> 6)) * 64 + (cv & 63)) * 2048 + (row & 2047);
#pragma unroll
                        for (int e = 0; e < 4; ++e) { vp[(size_t)(2 * e) * 2048] = (bf16_t)(w[e] & 0xffffu); vp[(size_t)(2 * e + 1) * 2048] = (bf16_t)(w[e] >> 16); }
                    }
                }
            }
    }
};
struct EpiRes {
    float* X; bf16_t* XB; float* SS;
    __device__ __forceinline__ void operator()(AccRef acc, const Unit& u, int wr, int wc, int fr, int fq) const {
#pragma unroll
        for (int ai = 0; ai < 2; ++ai)
#pragma unroll
            for (int m = 0; m < 4; ++m) {
                const int row = u.pm * 256 + ai * 128 + wr * 64 + m * 16 + fr;
                float sq = 0.f;
#pragma unroll
                for (int bj = 0; bj < 2; ++bj) {
                    const int col = u.pn * 256 + bj * 128 + wc * 32 + 8 * fq;
                    float* xp = X + (size_t)row * 1024 + col;
                    f32x4 x0 = *(const f32x4*)xp, x1 = *(const f32x4*)(xp + 4);
                    x0 += acc[ai][bj][m][0]; x1 += acc[ai][bj][m][1];
                    *(f32x4*)xp = x0; *(f32x4*)(xp + 4) = x1;
                    u32x4 w; w.x = pk2(x0[0], x0[1]); w.y = pk2(x0[2], x0[3]); w.z = pk2(x1[0], x1[1]); w.w = pk2(x1[2], x1[3]);
                    *(u32x4*)(XB + (size_t)row * 1024 + col) = w;
                    sq += (x0[0] * x0[0] + x0[1] * x0[1]) + (x0[2] * x0[2] + x0[3] * x0[3]) + (x1[0] * x1[0] + x1[1] * x1[1]) + (x1[2] * x1[2] + x1[3] * x1[3]);
                }
                sq += __shfl_xor(sq, 16); sq += __shfl_xor(sq, 32);
                if (fq == 0) SS[(size_t)row * 16 + u.pn * 4 + wc] = sq;
            }
    }
};
struct EpiGU {
    bf16_t* H;
    __device__ __forceinline__ void operator()(AccRef acc, const Unit& u, int wr, int wc, int fr, int fq) const {
#pragma unroll
        for (int ai = 0; ai < 2; ++ai)
#pragma unroll
            for (int m = 0; m < 4; ++m) {
                const int row = u.pm * 256 + ai * 128 + wr * 64 + m * 16 + fr;
                float h[8];
#pragma unroll
                for (int n = 0; n < 2; ++n)
#pragma unroll
                    for (int j = 0; j < 4; ++j) { const float gt = acc[ai][0][m][n][j], up = acc[ai][1][m][n][j]; h[n * 4 + j] = gt * __builtin_amdgcn_rcpf(1.0f + __expf(-gt)) * up; }
                u32x4 w; w.x = pk2(h[0], h[1]); w.y = pk2(h[2], h[3]); w.z = pk2(h[4], h[5]); w.w = pk2(h[6], h[7]);
                *(u32x4*)(H + (size_t)row * 512 + u.pn * 128 + wc * 32 + 8 * fq) = w;
            }
    }
};
struct EpiDown {
    bf16_t* Y; const int* slot; const float* sw;
    __device__ __forceinline__ void operator()(AccRef acc, const Unit& u, int wr, int wc, int fr, int fq) const {
#pragma unroll
        for (int ai = 0; ai < 2; ++ai)
#pragma unroll
            for (int m = 0; m < 4; ++m) {
                const int row = u.pm * 256 + ai * 128 + wr * 64 + m * 16 + fr;
                const int s = slot[row]; const float wgt = sw[row];
                if (s >= 0) {
#pragma unroll
                    for (int bj = 0; bj < 2; ++bj) {
                        const int col = u.pn * 256 + bj * 128 + wc * 32 + 8 * fq;
                        const f32x4 v0 = acc[ai][bj][m][0] * wgt, v1 = acc[ai][bj][m][1] * wgt;
                        u32x4 w; w.x = pk2(v0[0], v0[1]); w.y = pk2(v0[2], v0[3]); w.z = pk2(v1[0], v1[1]); w.w = pk2(v1[2], v1[3]);
                        *(u32x4*)(Y + (size_t)s * 1024 + col) = w;
                    }
                }
            }
    }
};
}

#define WSP(type, off) ((type*)(a.ws + (off)))
__device__ __forceinline__ int oblk() { int t = blockIdx.x; asm volatile("" : "+s"(t)); return t; }
__device__ __forceinline__ int ogrid() { int t = gridDim.x; asm volatile("" : "+s"(t)); return t; }
__device__ __forceinline__ int otid() { int t = threadIdx.x; asm volatile("" : "+v"(t)); return t; }
constexpr int LDS_INTAB = LDS_MISC + 14336;
__device__ __forceinline__ const float* ldsin(LAS unsigned char* lds, int i) {
    const unsigned long long p = ((const LAS unsigned long long*)(lds + LDS_INTAB))[i];
    const unsigned lo = __builtin_amdgcn_readfirstlane((unsigned)p), hi = __builtin_amdgcn_readfirstlane((unsigned)(p >> 32));
    return (const float*)(__attribute__((address_space(1))) const float*)(((unsigned long long)hi << 32) | lo);
}
#define INP(i) ldsin(lds, (i))

template <int MAP>
__device__ __forceinline__ void conv_slab(const float* __restrict__ src, int N, int Kper, bf16_t* __restrict__ dst, size_t estride,
                                          const float* __restrict__ gain, int goff, LAS float* tile, int slab) {
    const int tid = otid();
    const int nsn = N >> 8;
    const int kt = slab / nsn, ns = slab - kt * nsn, k0 = kt * 64, n0 = ns * 256;
    const int e = k0 / Kper, kl0 = k0 - e * Kper;
    f32x4 v[8];
#pragma unroll
    for (int i = 0; i < 8; ++i) { const int idx = tid + i * 512, kk = idx >> 6, n4 = (idx & 63) * 4; v[i] = *(const f32x4*)(src + (size_t)(k0 + kk) * N + n0 + n4); }
#pragma unroll
    for (int i = 0; i < 8; ++i) {
        const int idx = tid + i * 512, kk = idx >> 6, n4 = (idx & 63) * 4;
        float gsc = 1.0f;
        if (gain != nullptr && kl0 + kk >= goff) gsc = gain[kl0 + kk - goff];
        LAS float* tp = tile + kk * 257 + n4;
        tp[0] = v[i][0] * gsc; tp[1] = v[i][1] * gsc; tp[2] = v[i][2] * gsc; tp[3] = v[i][3] * gsc;
    }
    __syncthreads();
#pragma unroll
    for (int i = 0; i < 4; ++i) {
        const int p = tid + i * 512, nn = p >> 3, kg = p & 7;
        float x[8];
#pragma unroll
        for (int j = 0; j < 8; ++j) x[j] = tile[(kg * 8 + j) * 257 + nn];
        const int n = n0 + nn;
        const int nr = (MAP == 0) ? n : ((n >> 7) * 256 + (n & 127) + (MAP == 2 ? 128 : 0));
        u32x4 w; w.x = pk2(x[0], x[1]); w.y = pk2(x[2], x[3]); w.z = pk2(x[4], x[5]); w.w = pk2(x[6], x[7]);
        *(u32x4*)(dst + (size_t)e * estride + (size_t)nr * Kper + kl0 + kg * 8) = w;
    }
    __syncthreads();
}
template <int MAP>
__device__ __forceinline__ void conv_T(const float* __restrict__ src, int Ktot, int N, int Kper, bf16_t* __restrict__ dst, size_t estride,
                                       const float* __restrict__ gain, int goff, LAS float* tile) {
    const int nslab = (Ktot >> 6) * (N >> 8);
    for (int sl = oblk(); sl < nslab; sl += ogrid()) conv_slab<MAP>(src, N, Kper, dst, estride, gain, goff, tile, sl);
}
constexpr int MOE_CONV_ITEMS = 3 * 128;
__device__ __forceinline__ void moe_convert_item(const PA a, int l, LAS unsigned char* lds, int item) {
    LAS float* tile = (LAS float*)lds;
    const int which = item >> 7, s0 = (item & 127) * 8;
    const float* gn = INP(30) + l * 1024;
    for (int sl = s0; sl < s0 + 8; ++sl) {
        if (which == 0)      conv_slab<1>(INP(35) + (size_t)l * 32 * 1024 * 512, 512, 1024, WSP(bf16_t, WS_WGU), (size_t)1024 * 1024, gn, 0, tile, sl);
        else if (which == 1) conv_slab<2>(INP(36) + (size_t)l * 32 * 1024 * 512, 512, 1024, WSP(bf16_t, WS_WGU), (size_t)1024 * 1024, gn, 0, tile, sl);
        else                 conv_slab<0>(INP(37) + (size_t)l * 32 * 512 * 1024, 1024, 512, WSP(bf16_t, WS_WD), (size_t)1024 * 512, nullptr, 0, tile, sl);
    }
}

__device__ __forceinline__ void rows_convert(const float* __restrict__ src, float* __restrict__ dstf, bf16_t* __restrict__ dstb, float* __restrict__ ss, int nrows) {
    const int wave = otid() >> 6, lane = otid() & 63;
    for (int r = oblk() * 8 + wave; r < nrows; r += ogrid() * 8) {
        float sq = 0.f;
#pragma unroll
        for (int i = 0; i < 4; ++i) {
            const int c = i * 256 + lane * 4;
            const f32x4 v = *(const f32x4*)(src + (size_t)r * 1024 + c);
            if (dstf) *(f32x4*)(dstf + (size_t)r * 1024 + c) = v;
            u32x2 w; w.x = pk2(v[0], v[1]); w.y = pk2(v[2], v[3]);
            *(u32x2*)(dstb + (size_t)r * 1024 + c) = w;
            sq += (v[0] * v[0] + v[1] * v[1]) + (v[2] * v[2] + v[3] * v[3]);
        }
        sq = wsum(sq);
        if (lane < 16) ss[(size_t)r * 16 + lane] = (lane == 0) ? sq : 0.f;
    }
}

__device__ __forceinline__ void p0_prologue(const PA a, LAS unsigned char* lds) {
    LAS float* tile = (LAS float*)lds;
    for (int l = 0; l < NL; ++l) {
        conv_T<0>(INP(3) + (size_t)l * 1024 * INW, 1024, INW, 1024, WSP(bf16_t, WS_WIN) + (size_t)l * INW * 1024, 0, INP(2) + l * 1024, 0, tile);
        conv_T<0>(INP(22) + (size_t)l * 1024 * 1024, 1024, 1024, 1024, WSP(bf16_t, WS_WOUT) + (size_t)l * 1024 * 1024, 0, INP(21) + l * 512, 512, tile);
        conv_T<0>(INP(25) + (size_t)l * 1024 * 512, 1024, 512, 1024, WSP(bf16_t, WS_WQ) + (size_t)l * 512 * 1024, 0, INP(23) + l * 1024, 0, tile);
        conv_T<0>(INP(26) + (size_t)l * 1024 * 1024, 1024, 1024, 1024, WSP(bf16_t, WS_WKV) + (size_t)l * 1024 * 1024, 0, INP(24) + l * 1024, 0, tile);
        conv_T<0>(INP(27) + (size_t)l * 512 * 1024, 512, 1024, 512, WSP(bf16_t, WS_WO) + (size_t)l * 1024 * 512, 0, nullptr, 0, tile);
    }
    {
        bf16_t* wrh = WSP(bf16_t, WS_WRH); bf16_t* wrl = WSP(bf16_t, WS_WRL);
        for (int idx = oblk() * 512 + otid(); idx < NL * 48 * 1024; idx += ogrid() * 512) {
            const int k = idx & 1023, r = (idx >> 10) % 48, l = idx / (48 * 1024);
            float w;
            if (r < 16) w = INP(31)[((size_t)l * 1024 + k) * 4 + (r & 3)];
            else { const int ri = ((r >> 2) & 3) * 8 + ((r >> 4) - 1) * 4 + (r & 3); w = INP(33)[((size_t)l * 1024 + k) * 32 + ri]; }
            w *= INP(30)[l * 1024 + k];
            const bf16_t hi = f2bf(w);
            wrh[idx] = hi; wrl[idx] = f2bf(w - bf2f(hi));
        }
    }
    rows_convert(INP(0), a.out, WSP(bf16_t, WS_XB), WSP(float, WS_SS), T);
    rows_convert(INP(1), nullptr, WSP(bf16_t, WS_MEMB), WSP(float, WS_MEMSS), MROWS);
}

__device__ __forceinline__ void p2_knorm(const PA a, LAS unsigned char* lds) {
    const int wave = otid() >> 6, lane = otid() & 63;
    bf16_t* kv = WSP(bf16_t, WS_KV);
    for (int it = oblk() * 8 + wave; it < NL * MROWS * 4; it += ogrid() * 8) {
        const int h = it & 3, row = (it >> 2) & (MROWS - 1), l = it >> 14;
        unsigned* p = (unsigned*)(kv + ((size_t)l * MROWS + row) * 1024 + h * 128 + lane * 2);
        const unsigned w = *p; const float x0 = lo16(w), x1 = hi16(w);
        const float ssq = wsum(x0 * x0 + x1 * x1);
        const float rinv = rsqrtf(ssq * (1.0f / 128.0f) + 1e-6f);
        const float* gk = INP(29) + l * 128 + lane * 2;
        *p = pk2(x0 * rinv * gk[0], x1 * rinv * gk[1]);
    }
    bf16_t* vtx = WSP(bf16_t, WS_VTX);
    const int tid = otid();
    for (int it = oblk(); it < NL * 16 * 4; it += ogrid()) {
        const int h = it & 3, b = (it >> 2) & 15, l = it >> 6;
        const bf16_t* src = kv + ((size_t)l * MROWS + b * 256) * 1024 + 512 + h * 128;
        bf16_t* dst = vtx + (size_t)it * 128 * 256;
#pragma unroll 1
        for (int i = 0; i < 8; ++i) {
            const int p = tid + i * 512, d = p & 127, m8 = (p >> 7) * 8;
            unsigned short x[8];
#pragma unroll
            for (int j = 0; j < 8; ++j) x[j] = src[(size_t)(m8 + j) * 1024 + d];
            u32x4 w; w.x = x[0] | ((unsigned)x[1] << 16); w.y = x[2] | ((unsigned)x[3] << 16); w.z = x[4] | ((unsigned)x[5] << 16); w.w = x[6] | ((unsigned)x[7] << 16);
            *(u32x4*)(dst + (size_t)d * 256 + m8) = w;
        }
    }
}

__device__ __forceinline__ float fast_tanh(float x) { return 1.0f - 2.0f * __builtin_amdgcn_rcpf(1.0f + __expf(2.0f * x)); }
__device__ __forceinline__ float fast_sigmoid(float x) { return __builtin_amdgcn_rcpf(1.0f + __expf(-x)); }
template <int MODE>
__device__ __forceinline__ bf16x8 mixfrag(const bf16_t* pu, const bf16_t* pp, float hpf, const float* mu, int col) {
    const u32x4 u = *(const u32x4*)(pu + col), p = *(const u32x4*)(pp + col);
    const f32x4 m0 = *(const f32x4*)(mu + col), m1 = *(const f32x4*)(mu + col + 4);
    float x[8];
#pragma unroll
    for (int j = 0; j < 4; ++j) {
        const float u0 = lo16(u[j]), u1 = hi16(u[j]), p0 = lo16(p[j]) * hpf, p1 = hi16(p[j]) * hpf;
        const float ma = (j < 2) ? m0[2 * j] : m1[2 * j - 4], mb = (j < 2) ? m0[2 * j + 1] : m1[2 * j - 3];
        x[2 * j] = u0 + ma * (p0 - u0); x[2 * j + 1] = u1 + mb * (p1 - u1);
    }
#pragma unroll
    for (int j = 0; j < 8; ++j) { if (MODE == 1) x[j] = fast_tanh(x[j]); if (MODE == 2) x[j] = fast_sigmoid(x[j]); }
    u32x4 w; w.x = pk2(x[0], x[1]); w.y = pk2(x[2], x[3]); w.z = pk2(x[4], x[5]); w.w = pk2(x[6], x[7]);
    return __builtin_bit_cast(bf16x8, w);
}
__device__ __forceinline__ void pb_prep(const PA a, int l, LAS unsigned char* lds) {
    const int tid = otid(), wave = tid >> 6, lane = tid & 63, fr = lane & 15, fq = lane >> 4;
    const int G = ogrid(), blk = oblk();
    LAS bf16_t* s_w2 = (LAS bf16_t*)lds;
    LAS bf16_t* s_a2 = (LAS bf16_t*)(lds + 18432);
    LAS bf16_t* s_g2 = (LAS bf16_t*)(lds + 36864);
    LAS bf16_t* s_v2 = (LAS bf16_t*)(lds + 71680);
    LAS bf16_t* s_v1 = (LAS bf16_t*)(lds + 81920);
    bf16_t* proj = WSP(bf16_t, WS_PROJ);
    const float* mu = INP(4) + l * 1792;
    const float* w0 = INP(5) + l * 512;  const float* w2 = INP(6) + (size_t)l * 64 * 512;
    const float* a0 = INP(7) + l * 512;  const float* a2 = INP(8) + (size_t)l * 64 * 512;
    const float* g2 = INP(9) + (size_t)l * 128 * 512;
    const float* kkw = INP(10) + l * 512; const float* kaw = INP(11) + l * 512;
    const int lv = l > 0 ? l - 1 : 0;
    const float* v0 = INP(15) + lv * 512; const float* v1 = INP(16) + (size_t)lv * 512 * 32; const float* v2 = INP(17) + (size_t)lv * 32 * 512;
    const float* qgn = INP(18) + l * 64; const float* kgn = INP(19) + l * 64;
    bf16_t* SR = WSP(bf16_t, WS_SR); bf16_t* SK = WSP(bf16_t, WS_SK); bf16_t* SV = WSP(bf16_t, WS_SV);
    bf16_t* SA = WSP(bf16_t, WS_SA); bf16_t* SB = WSP(bf16_t, WS_SB); bf16_t* SG = WSP(bf16_t, WS_SG);
    float* SWD = WSP(float, WS_SWD); bf16_t* VF = WSP(bf16_t, WS_VF);
    int cur_hp = -1;
    for (int item = blk; item < 4 * (T / 128); item += G) {
        const int hp = item & 3, tt = item >> 2;
        if (hp != cur_hp) {
            __syncthreads();
            const int chb = hp * 128;
            for (int idx = tid; idx < 64 * 128; idx += 512) { const int ch = idx & 127, k = idx >> 7;
                s_w2[ch * 72 + k] = f2bf(w2[k * 512 + chb + ch]); s_a2[ch * 72 + k] = f2bf(a2[k * 512 + chb + ch]); }
            for (int idx = tid; idx < 128 * 128; idx += 512) { const int ch = idx & 127, k = idx >> 7; s_g2[ch * 136 + k] = f2bf(g2[k * 512 + chb + ch]); }
            if (l > 0) {
                for (int idx = tid; idx < 32 * 128; idx += 512) { const int ch = idx & 127, k = idx >> 7; s_v2[ch * 40 + k] = f2bf(v2[k * 512 + chb + ch]); }
                for (int idx = tid; idx < 512 * 32; idx += 512) { const int n = idx & 31, k = idx >> 5; s_v1[n * 520 + k] = f2bf(v1[k * 32 + n]); }
            }
            __syncthreads();
            cur_hp = hp;
        }
        const int t = tt * 128 + wave * 16 + fr;
        const bool hpv = (t & (SEQ - 1)) != 0;
        const bf16_t* pu = proj + (size_t)t * INW;
        const bf16_t* pp = hpv ? pu - INW : pu;
        const float hpf = hpv ? 1.0f : 0.0f;
        bf16x8 fwl[2], fal[2], fgl[4], ft32;
#pragma unroll
        for (int s = 0; s < 2; ++s) { fwl[s] = mixfrag<1>(pu, pp, hpf, mu, 1536 + 32 * s + 8 * fq); fal[s] = mixfrag<0>(pu, pp, hpf, mu, 1600 + 32 * s + 8 * fq); }
#pragma unroll
        for (int s = 0; s < 4; ++s) fgl[s] = mixfrag<2>(pu, pp, hpf, mu, 1664 + 32 * s + 8 * fq);
        ft32 = fwl[0];
        if (l > 0) {
            f32x4 c0 = {0.f, 0.f, 0.f, 0.f}, c1 = {0.f, 0.f, 0.f, 0.f};
#pragma unroll 4
            for (int s = 0; s < 16; ++s) {
                const bf16x8 xf = mixfrag<0>(pu, pp, hpf, mu, 1024 + 32 * s + 8 * fq);
                const bf16x8 wa = *(const LAS bf16x8*)(s_v1 + fr * 520 + 32 * s + 8 * fq), wb = *(const LAS bf16x8*)(s_v1 + (16 + fr) * 520 + 32 * s + 8 * fq);
                c0 = __builtin_amdgcn_mfma_f32_16x16x32_bf16(wa, xf, c0, 0, 0, 0);
                c1 = __builtin_amdgcn_mfma_f32_16x16x32_bf16(wb, xf, c1, 0, 0, 0);
            }
            u32x4 w; w.x = pk2(c0[0], c0[1]); w.y = pk2(c0[2], c0[3]); w.z = pk2(c1[0], c1[1]); w.w = pk2(c1[2], c1[3]);
            ft32 = __builtin_bit_cast(bf16x8, w);
        }
#pragma unroll 1
        for (int hh = 0; hh < 2; ++hh) {
            float kkv[4][4], avv[4][4];
            float kss = 0.f;
#pragma unroll
            for (int nt = 0; nt < 4; ++nt) {
                const int lc = hh * 64 + nt * 16, ch4 = hp * 128 + lc + 4 * fq;
                f32x4 aw = {0.f, 0.f, 0.f, 0.f}, aa = aw, ag = aw, az = aw;
#pragma unroll
                for (int s = 0; s < 2; ++s) {
                    aw = __builtin_amdgcn_mfma_f32_16x16x32_bf16(*(const LAS bf16x8*)(s_w2 + (lc + fr) * 72 + 32 * s + 8 * fq), fwl[s], aw, 0, 0, 0);
                    aa = __builtin_amdgcn_mfma_f32_16x16x32_bf16(*(const LAS bf16x8*)(s_a2 + (lc + fr) * 72 + 32 * s + 8 * fq), fal[s], aa, 0, 0, 0);
                }
#pragma unroll
                for (int s = 0; s < 4; ++s) ag = __builtin_amdgcn_mfma_f32_16x16x32_bf16(*(const LAS bf16x8*)(s_g2 + (lc + fr) * 136 + 32 * s + 8 * fq), fgl[s], ag, 0, 0, 0);
                if (l > 0) {
                    const u32x2 q0 = *(const LAS u32x2*)(s_v2 + (lc + fr) * 40 + 4 * fq), q1 = *(const LAS u32x2*)(s_v2 + (lc + fr) * 40 + 16 + 4 * fq);
                    u32x4 w; w.x = q0.x; w.y = q0.y; w.z = q1.x; w.w = q1.y;
                    az = __builtin_amdgcn_mfma_f32_16x16x32_bf16(__builtin_bit_cast(bf16x8, w), ft32, az, 0, 0, 0);
                }
                const u32x2 ur = *(const u32x2*)(pu + ch4), pr = *(const u32x2*)(pp + ch4);
                const u32x2 uk = *(const u32x2*)(pu + 512 + ch4), pk = *(const u32x2*)(pp + 512 + ch4);
                const u32x2 uv = *(const u32x2*)(pu + 1024 + ch4), pv = *(const u32x2*)(pp + 1024 + ch4);
                const f32x4 mr = *(const f32x4*)(mu + ch4), mk = *(const f32x4*)(mu + 512 + ch4), mv = *(const f32x4*)(mu + 1024 + ch4);
                const f32x4 w0v = *(const f32x4*)(w0 + ch4), a0v = *(const f32x4*)(a0 + ch4), kkwv = *(const f32x4*)(kkw + ch4), kawv = *(const f32x4*)(kaw + ch4);
                float xr[4], xk[4], xv[4];
                { const float u0 = lo16(ur.x), u1 = hi16(ur.x), u2 = lo16(ur.y), u3 = hi16(ur.y);
                  xr[0] = u0 + mr[0] * (lo16(pr.x) * hpf - u0); xr[1] = u1 + mr[1] * (hi16(pr.x) * hpf - u1); xr[2] = u2 + mr[2] * (lo16(pr.y) * hpf - u2); xr[3] = u3 + mr[3] * (hi16(pr.y) * hpf - u3); }
                { const float u0 = lo16(uk.x), u1 = hi16(uk.x), u2 = lo16(uk.y), u3 = hi16(uk.y);
                  xk[0] = u0 + mk[0] * (lo16(pk.x) * hpf - u0); xk[1] = u1 + mk[1] * (hi16(pk.x) * hpf - u1); xk[2] = u2 + mk[2] * (lo16(pk.y) * hpf - u2); xk[3] = u3 + mk[3] * (hi16(pk.y) * hpf - u3); }
                { const float u0 = lo16(uv.x), u1 = hi16(uv.x), u2 = lo16(uv.y), u3 = hi16(uv.y);
                  xv[0] = u0 + mv[0] * (lo16(pv.x) * hpf - u0); xv[1] = u1 + mv[1] * (hi16(pv.x) * hpf - u1); xv[2] = u2 + mv[2] * (lo16(pv.y) * hpf - u2); xv[3] = u3 + mv[3] * (hi16(pv.y) * hpf - u3); }
                const size_t o = (size_t)t * 512 + ch4;
                if (l > 0) {
                    const f32x4 v0v = *(const f32x4*)(v0 + ch4);
                    const u32x2 vfw = *(const u32x2*)(VF + o);
                    const float vf0 = lo16(vfw.x), vf1 = hi16(vfw.x), vf2 = lo16(vfw.y), vf3 = hi16(vfw.y);
                    xv[0] += (vf0 - xv[0]) * fast_sigmoid(v0v[0] + az[0]); xv[1] += (vf1 - xv[1]) * fast_sigmoid(v0v[1] + az[1]);
                    xv[2] += (vf2 - xv[2]) * fast_sigmoid(v0v[2] + az[2]); xv[3] += (vf3 - xv[3]) * fast_sigmoid(v0v[3] + az[3]);
                } else {
                    u32x2 w; w.x = pk2(xv[0], xv[1]); w.y = pk2(xv[2], xv[3]); *(u32x2*)(VF + o) = w;
                }
                f32x4 dec; float kmod[4];
#pragma unroll
                for (int j = 0; j < 4; ++j) {
                    dec[j] = __expf(-0.6065306597f * fast_sigmoid(w0v[j] + aw[j]));
                    const float av = fast_sigmoid(a0v[j] + aa[j]);
                    const float kk = xk[j] * kkwv[j];
                    kkv[nt][j] = kk; avv[nt][j] = av; kss += kk * kk;
                    kmod[j] = xk[j] * (1.0f + (av - 1.0f) * kawv[j]);
                }
                { u32x2 w; w.x = pk2(xr[0], xr[1]); w.y = pk2(xr[2], xr[3]); *(u32x2*)(SR + o) = w; }
                { u32x2 w; w.x = pk2(xv[0], xv[1]); w.y = pk2(xv[2], xv[3]); *(u32x2*)(SV + o) = w; }
                { u32x2 w; w.x = pk2(ag[0], ag[1]); w.y = pk2(ag[2], ag[3]); *(u32x2*)(SG + o) = w; }
                { u32x2 w; w.x = pk2(kmod[0], kmod[1]); w.y = pk2(kmod[2], kmod[3]); *(u32x2*)(SK + o) = w; }
                *(f32x4*)(SWD + o) = dec;
            }
            kss += __shfl_xor(kss, 16); kss += __shfl_xor(kss, 32);
            const float rn = rsqrtf(fmaxf(kss, 1e-24f));
#pragma unroll
            for (int nt = 0; nt < 4; ++nt) {
                const size_t o = (size_t)t * 512 + hp * 128 + hh * 64 + nt * 16 + 4 * fq;
                float kn[4];
#pragma unroll
                for (int j = 0; j < 4; ++j) kn[j] = kkv[nt][j] * rn;
                { u32x2 w; w.x = pk2(-kn[0], -kn[1]); w.y = pk2(-kn[2], -kn[3]); *(u32x2*)(SA + o) = w; }
                { u32x2 w; w.x = pk2(kn[0] * avv[nt][0], kn[1] * avv[nt][1]); w.y = pk2(kn[2] * avv[nt][2], kn[3] * avv[nt][3]); *(u32x2*)(SB + o) = w; }
            }
        }
#pragma unroll 1
        for (int qk = 0; qk < 4; ++qk) {
            const int col = 1792 + (qk & 1) * 512 + (hp * 2 + (qk >> 1)) * 64 + fq * 16;
            const float* gn = (qk & 1) ? kgn : qgn;
            bf16_t* p = proj + (size_t)t * INW + col;
            const u32x4 wa = *(const u32x4*)p, wb = *(const u32x4*)(p + 8);
            float x[16];
#pragma unroll
            for (int j = 0; j < 4; ++j) { x[2 * j] = lo16(wa[j]); x[2 * j + 1] = hi16(wa[j]); x[8 + 2 * j] = lo16(wb[j]); x[9 + 2 * j] = hi16(wb[j]); }
            float ssq = 0.f;
#pragma unroll
            for (int j = 0; j < 16; ++j) ssq += x[j] * x[j];
            ssq += __shfl_xor(ssq, 16); ssq += __shfl_xor(ssq, 32);
            const float rinv = rsqrtf(ssq * (1.0f / 64.0f) + 1e-6f);
            const float qsc = (qk & 1) ? rinv : rinv * 0.18033688011112042f;
#pragma unroll
            for (int j = 0; j < 16; ++j) x[j] = x[j] * qsc * gn[fq * 16 + j];
            u32x4 oa, ob;
#pragma unroll
            for (int j = 0; j < 4; ++j) { oa[j] = pk2(x[2 * j], x[2 * j + 1]); ob[j] = pk2(x[8 + 2 * j], x[9 + 2 * j]); }
            *(u32x4*)p = oa; *(u32x4*)(p + 8) = ob;
        }
    }
    __syncthreads();
}

__device__ __forceinline__ void pb2_chunks(const PA a, int l, LAS unsigned char* lds) {
    const int tid = otid(), wave = tid >> 6, lane = tid & 63, fr = lane & 15, fq = lane >> 4;
    LAS bf16_t* sA = (LAS bf16_t*)(lds + wave * 11520);
    LAS bf16_t* sR = sA + 1152; LAS bf16_t* sB = sR + 1152; LAS bf16_t* sK = sB + 1152; LAS bf16_t* sX = sK + 1152;
    LAS float* nb = (LAS float*)(lds + 8 * 11520) + wave * 256;
    bf16_t* SR = WSP(bf16_t, WS_SR); bf16_t* SK = WSP(bf16_t, WS_SK); bf16_t* SV = WSP(bf16_t, WS_SV);
    bf16_t* SA = WSP(bf16_t, WS_SA); bf16_t* SB = WSP(bf16_t, WS_SB); const float* SWD = WSP(const float, WS_SWD);
    const float* rkp = INP(12) + l * 512;
    for (int cid = oblk() * 8 + wave; cid < NCHUNK; cid += ogrid() * 8) {
        const int b = cid >> 10, h = (cid >> 7) & 7, c = cid & 127;
        const size_t tok0 = (size_t)b * SEQ + c * 16;
        const size_t e0 = tok0 * 512 + h * 64 + lane;
        const float rkv = rkp[h * 64 + lane];
        float P = 1.0f;
        unsigned bt2[8], kt2[8], vt2[8];
#pragma unroll
        for (int hf = 0; hf < 2; ++hf) {
            bf16_t r16[8], k16[8], a16[8], b16[8], v16[8]; float w32[8];
#pragma unroll
            for (int t8 = 0; t8 < 8; ++t8) { const size_t e = e0 + (size_t)(hf * 8 + t8) * 512; r16[t8] = SR[e]; k16[t8] = SK[e]; a16[t8] = SA[e]; b16[t8] = SB[e]; v16[t8] = SV[e]; w32[t8] = SWD[e]; }
#pragma unroll
            for (int t8 = 0; t8 < 8; ++t8) {
                const int t = hf * 8 + t8;
                const float rr = bf2f(r16[t8]), kk = bf2f(k16[t8]), aa = bf2f(a16[t8]), bb = bf2f(b16[t8]);
                const float Pm = P; P *= w32[t8]; const float ip = 1.0f / P;
                const unsigned ar = pk2(aa * Pm, rr * P), bk = pk2(bb * ip, kk * ip);
                const bf16_t at = (bf16_t)(ar & 0xffffu), rt = (bf16_t)(ar >> 16), btv = (bf16_t)(bk & 0xffffu), ktv = (bf16_t)(bk >> 16);
                { const size_t es = tok0 * 512 + (size_t)t * 512 + h * 64 + (lane ^ ((t & 7) << 3)); SA[es] = at; SR[es] = rt; }
                sA[t * 72 + lane] = at; sR[t * 72 + lane] = rt; sB[t * 72 + lane] = btv; sK[t * 72 + lane] = ktv;
                sX[t * 72 + lane] = (bf16_t)(pk2(rr * kk * rkv, 0.f) & 0xffffu);
                if (t & 1) { bt2[t >> 1] |= (unsigned)btv << 16; kt2[t >> 1] |= (unsigned)ktv << 16; vt2[t >> 1] |= (unsigned)v16[t8] << 16; }
                else       { bt2[t >> 1] = btv; kt2[t >> 1] = ktv; vt2[t >> 1] = v16[t8]; }
            }
        }
        WSP(float, WS_PCK)[(size_t)cid * 64 + lane] = P;
        {
            u32x4* pb_ = (u32x4*)(WSP(bf16_t, WS_BTT) + (size_t)cid * 1024 + lane * 16);
            u32x4* pk_ = (u32x4*)(WSP(bf16_t, WS_KTT) + (size_t)cid * 1024 + lane * 16);
            u32x4* pv_ = (u32x4*)(WSP(bf16_t, WS_VST) + (size_t)cid * 1024 + lane * 16);
            pb_[0] = (u32x4){bt2[0], bt2[1], bt2[2], bt2[3]}; pb_[1] = (u32x4){bt2[4], bt2[5], bt2[6], bt2[7]};
            pk_[0] = (u32x4){kt2[0], kt2[1], kt2[2], kt2[3]}; pk_[1] = (u32x4){kt2[4], kt2[5], kt2[6], kt2[7]};
            pv_[0] = (u32x4){vt2[0], vt2[1], vt2[2], vt2[3]}; pv_[1] = (u32x4){vt2[4], vt2[5], vt2[6], vt2[7]};
        }
        bf16x8 fA[2], fR[2], fB[2], fK[2], fX[2];
#pragma unroll
        for (int s_ = 0; s_ < 2; ++s_) {
            fA[s_] = *(const LAS bf16x8*)(sA + fr * 72 + 32 * s_ + 8 * fq); fR[s_] = *(const LAS bf16x8*)(sR + fr * 72 + 32 * s_ + 8 * fq);
            fB[s_] = *(const LAS bf16x8*)(sB + fr * 72 + 32 * s_ + 8 * fq); fK[s_] = *(const LAS bf16x8*)(sK + fr * 72 + 32 * s_ + 8 * fq);
            fX[s_] = *(const LAS bf16x8*)(sX + fr * 72 + 32 * s_ + 8 * fq);
        }
        const f32x4 z4 = {0.f, 0.f, 0.f, 0.f};
        const bf16x8 ones = {0x3f80, 0x3f80, 0x3f80, 0x3f80, 0x3f80, 0x3f80, 0x3f80, 0x3f80};
        const f32x4 nka = __builtin_amdgcn_mfma_f32_16x16x32_bf16(fA[1], fK[1], __builtin_amdgcn_mfma_f32_16x16x32_bf16(fA[0], fK[0], z4, 0, 0, 0), 0, 0, 0);
        const f32x4 nbr = __builtin_amdgcn_mfma_f32_16x16x32_bf16(fR[1], fB[1], __builtin_amdgcn_mfma_f32_16x16x32_bf16(fR[0], fB[0], z4, 0, 0, 0), 0, 0, 0);
        const f32x4 nkr = __builtin_amdgcn_mfma_f32_16x16x32_bf16(fR[1], fK[1], __builtin_amdgcn_mfma_f32_16x16x32_bf16(fR[0], fK[0], z4, 0, 0, 0), 0, 0, 0);
        const f32x4 nba = __builtin_amdgcn_mfma_f32_16x16x32_bf16(fB[1], fA[1], __builtin_amdgcn_mfma_f32_16x16x32_bf16(fB[0], fA[0], z4, 0, 0, 0), 0, 0, 0);
        const f32x4 bsm = __builtin_amdgcn_mfma_f32_16x16x32_bf16(fX[1], ones, __builtin_amdgcn_mfma_f32_16x16x32_bf16(fX[0], ones, z4, 0, 0, 0), 0, 0, 0);
        bf16_t* gka = WSP(bf16_t, WS_NKA) + (size_t)cid * 256; bf16_t* gbr = WSP(bf16_t, WS_NBR) + (size_t)cid * 256; bf16_t* gkr = WSP(bf16_t, WS_NKR) + (size_t)cid * 256;
#pragma unroll
        for (int j = 0; j < 4; ++j) {
            const int row = 4 * fq + j;
            gka[row * 16 + fr] = f2bf(fr < row ? nka[j] : 0.f);
            gbr[row * 16 + fr] = f2bf(fr <= row ? nbr[j] : 0.f);
            gkr[row * 16 + fr] = f2bf(fr <= row ? nkr[j] : 0.f);
            nb[row * 16 + fr] = (row < fr) ? nba[j] : 0.f;
            if (fr == 0) WSP(float, WS_BS)[(tok0 + row) * 8 + h] = bsm[j];
        }
        if (lane < 16) {
            float X[16];
            bf16_t* gtm = WSP(bf16_t, WS_TMT) + (size_t)cid * 256;
#pragma unroll
            for (int tcol = 0; tcol < 16; ++tcol) {
                float acc = (lane == tcol) ? 1.0f : 0.0f;
#pragma unroll
                for (int i = 0; i < tcol; ++i) acc += X[i] * nb[i * 16 + tcol];
                X[tcol] = acc;
                gtm[tcol * 16 + lane] = f2bf(acc);
            }
        }
    }
    __syncthreads();
}

__device__ __forceinline__ void scan_item(const PA a, int l, int bh, LAS unsigned char* lds) {
    const int tid = otid(), wave = __builtin_amdgcn_readfirstlane(tid >> 6), lane = tid & 63, fr = lane & 15, fq = lane >> 4;
    const int b = __builtin_amdgcn_readfirstlane(bh >> 3), h = __builtin_amdgcn_readfirstlane(bh & 7);
    constexpr int SLOT = 17152, NS = 7, DPF = 5;
    constexpr int OA = 0, OR_ = 2048, OBT = 4096, OKT = 6144, OVT = 8192, ON = 10240, OPC = 12288, OBS = 12544, OSV = 13056, OSG = 15104;
    LAS float* ybuf = (LAS float*)(lds + NS * SLOT);
    LAS float* pbuf = ybuf + 2048;
    const size_t tokb = (size_t)b * SEQ;
    const int cid0 = (b * 8 + h) * 128;
    const unsigned char* gA = (const unsigned char*)WSP(const bf16_t, WS_SA); const unsigned char* gR = (const unsigned char*)WSP(const bf16_t, WS_SR);
    const unsigned char* gV = (const unsigned char*)WSP(const bf16_t, WS_SV); const unsigned char* gG = (const unsigned char*)WSP(const bf16_t, WS_SG);
    const unsigned char* gBT = (const unsigned char*)WSP(const bf16_t, WS_BTT); const unsigned char* gKT = (const unsigned char*)WSP(const bf16_t, WS_KTT);
    const unsigned char* gVT = (const unsigned char*)WSP(const bf16_t, WS_VST); const unsigned char* gN = (const unsigned char*)WSP(const bf16_t, WS_NKA);
    const unsigned char* gPC = (const unsigned char*)WSP(const float, WS_PCK); const unsigned char* gBS = (const unsigned char*)WSP(const float, WS_BS);
#define DMA16(gp, ldsoff) __builtin_amdgcn_global_load_lds((const unsigned*)(gp), (LAS unsigned*)(lds + (ldsoff)), 16, 0, 0)
    const unsigned rowoff0 = (unsigned)(((lane >> 3) * 512 + (lane & 7) * 8) * 2), rowoff1 = rowoff0 + 8u * 512u * 2u;
#define DMA_CHUNK(c_) do { const int cid_ = cid0 + (c_); const int so_ = ((c_) % NS) * SLOT; \
        const size_t rb_ = ((tokb + (size_t)(c_) * 16) * 512 + h * 64) * 2; \
        if (wave == 4) { \
            DMA16(gA + rb_ + rowoff0, so_ + OA); DMA16(gA + rb_ + rowoff1, so_ + OA + 1024); DMA16(gR + rb_ + rowoff0, so_ + OR_); DMA16(gR + rb_ + rowoff1, so_ + OR_ + 1024); \
            DMA16(gBT + (size_t)cid_ * 2048 + lane * 16, so_ + OBT); DMA16(gBT + (size_t)cid_ * 2048 + 1024 + lane * 16, so_ + OBT + 1024); \
            DMA16(gKT + (size_t)cid_ * 2048 + lane * 16, so_ + OKT); DMA16(gKT + (size_t)cid_ * 2048 + 1024 + lane * 16, so_ + OKT + 1024); \
            if (lane < 16) DMA16(gPC + (size_t)cid_ * 256 + lane * 16, so_ + OPC); \
        } else { \
            DMA16(gVT + (size_t)cid_ * 2048 + lane * 16, so_ + OVT); DMA16(gVT + (size_t)cid_ * 2048 + 1024 + lane * 16, so_ + OVT + 1024); \
            DMA16(gN + (size_t)(lane >> 5) * ((size_t)NCHUNK * 512) + (size_t)cid_ * 512 + (lane & 31) * 16, so_ + ON); \
            DMA16(gN + (size_t)(2 + (lane >> 5)) * ((size_t)NCHUNK * 512) + (size_t)cid_ * 512 + (lane & 31) * 16, so_ + ON + 1024); \
            DMA16(gV + rb_ + rowoff0, so_ + OSV); DMA16(gV + rb_ + rowoff1, so_ + OSV + 1024); DMA16(gG + rb_ + rowoff0, so_ + OSG); DMA16(gG + rb_ + rowoff1, so_ + OSG + 1024); \
            if (lane < 32) DMA16(gBS + (tokb + (size_t)(c_) * 16) * 32 + lane * 16, so_ + OBS); \
        } } while (0)
#define FR8(lo_, hi_) __builtin_bit_cast(bf16x8, (u32x4){(lo_).x, (lo_).y, (hi_).x, (hi_).y})
#define FR4(lo_) __builtin_bit_cast(bf16x8, (u32x4){(lo_).x, (lo_).y, 0u, 0u})
#define MF(a_, b_, c_) __builtin_amdgcn_mfma_f32_16x16x32_bf16((a_), (b_), (c_), 0, 0, 0)
#define LD8(off_) (*(const LAS u32x2*)(sl + (off_)))
#define DPP_F(v, ctrl) __int_as_float(__builtin_amdgcn_update_dpp(0, __float_as_int(v), (ctrl), 0xF, 0xF, true))
#define RED16(v) do { v += DPP_F(v, 0xB1); v += DPP_F(v, 0x4E); v += DPP_F(v, 0x141); v += DPP_F(v, 0x140); } while (0)
    const int swz = fr & 7, rowb = fr * 128 + (fq & 1) * 8, q0 = fq >> 1;
    const int aoff0 = rowb + ((q0) ^ swz) * 16, aoff1 = rowb + ((q0 + 2) ^ swz) * 16, aoff2 = rowb + ((q0 + 4) ^ swz) * 16, aoff3 = rowb + ((q0 + 6) ^ swz) * 16;
    const int moff = fr * 32 + 8 * fq, voff = ((wave & 3) * 16 + fr) * 32 + 8 * fq;
    const float lw = INP(13)[l * 512 + h * 64 + lane], lb = INP(14)[l * 512 + h * 64 + lane];
    bf16_t* YC = WSP(bf16_t, WS_YCAT);
#define SCAN_EPI(cp_) do { const int cp = (cp_); \
        const unsigned slb = (unsigned)(unsigned long long)(lds + (cp % NS) * SLOT), ybb = (unsigned)(unsigned long long)(ybuf + (cp & 1) * 1024), pbb = (unsigned)(unsigned long long)(pbuf + (cp & 1) * 128); \
        f32x2 eP0[8], eP1[8], eP2[8], eP3[8]; float eY[8], eB[8]; unsigned eV[8], eG[8]; \
        _Pragma("unroll") for (int i = 0; i < 8; ++i) { const int t = (wave - 6) * 8 + i; \
            const unsigned ap_ = pbb + t * 8, ay_ = ybb + (t * 64 + lane) * 4, ab_ = slb + OBS + t * 32 + h * 4, av_ = slb + OSV + t * 128 + lane * 2, ag_ = slb + OSG + t * 128 + lane * 2; \
            asm volatile("ds_read_b64 %0, %8\n\tds_read_b64 %1, %8 offset:128\n\tds_read_b64 %2, %8 offset:256\n\tds_read_b64 %3, %8 offset:384\n\t" \
                         "ds_read_b32 %4, %9\n\tds_read_b32 %5, %10\n\tds_read_u16 %6, %11\n\tds_read_u16 %7, %12" \
                         : "=&v"(eP0[i]), "=&v"(eP1[i]), "=&v"(eP2[i]), "=&v"(eP3[i]), "=&v"(eY[i]), "=&v"(eB[i]), "=&v"(eV[i]), "=&v"(eG[i]) \
                         : "v"(ap_), "v"(ay_), "v"(ab_), "v"(av_), "v"(ag_) : "memory"); } \
        asm volatile("s_waitcnt lgkmcnt(0)" ::: "memory"); \
        _Pragma("unroll") for (int i = 0; i < 8; ++i) { \
            asm volatile("" : "+v"(eP0[i]), "+v"(eP1[i]), "+v"(eP2[i]), "+v"(eP3[i]), "+v"(eY[i]), "+v"(eB[i]), "+v"(eV[i]), "+v"(eG[i])); \
            const int t = (wave - 6) * 8 + i; const size_t tok = tokb + (size_t)cp * 16 + t; \
            const float mean = ((eP0[i].x + eP1[i].x) + (eP2[i].x + eP3[i].x)) * (1.0f / 64.0f); \
            const float var = fmaxf(((eP0[i].y + eP1[i].y) + (eP2[i].y + eP3[i].y)) * (1.0f / 64.0f) - mean * mean, 0.f); \
            const float vv = __uint_as_float(eV[i] << 16), g = __uint_as_float(eG[i] << 16); \
            const float yn = (eY[i] - mean) * rsqrtf(var + 64e-5f) * lw + lb; \
            YC[tok * 1024 + h * 64 + lane] = f2bf((yn + eB[i] * vv) * g); } } while (0)
    f32x4 S[4];
#pragma unroll
    for (int kt = 0; kt < 4; ++kt) S[kt] = (f32x4){0.f, 0.f, 0.f, 0.f};
    __syncthreads();
    if (wave == 4 || wave == 5) {
#pragma unroll 1
        for (int c = 0; c < DPF; ++c) DMA_CHUNK(c);
        asm volatile("s_waitcnt vmcnt(0)" ::: "memory");
    }
    __syncthreads();
#pragma unroll 1
    for (int c = 0; c < 128; ++c) {
        if (wave < 4) {
            const LAS unsigned char* sl = lds + (c % NS) * SLOT;
            u32x4 s0w, s1w; s0w.x = pk2(S[0][0], S[0][1]); s0w.y = pk2(S[0][2], S[0][3]); s0w.z = pk2(S[1][0], S[1][1]); s0w.w = pk2(S[1][2], S[1][3]);
            s1w.x = pk2(S[2][0], S[2][1]); s1w.y = pk2(S[2][2], S[2][3]); s1w.z = pk2(S[3][0], S[3][1]); s1w.w = pk2(S[3][2], S[3][3]);
            const bf16x8 Sf0 = __builtin_bit_cast(bf16x8, s0w), Sf1 = __builtin_bit_cast(bf16x8, s1w);
            const bf16x8 Vf = FR4(LD8(OVT + voff));
            const f32x4 z4 = {0.f, 0.f, 0.f, 0.f};
            f32x4 Wt = MF(FR8(LD8(OA + aoff0), LD8(OA + aoff1)), Sf0, z4); Wt = MF(FR8(LD8(OA + aoff2), LD8(OA + aoff3)), Sf1, Wt); Wt = MF(FR4(LD8(ON + moff)), Vf, Wt);
            u32x2 ww; ww.x = pk2(Wt[0], Wt[1]); ww.y = pk2(Wt[2], Wt[3]);
            const f32x4 Ut = MF(FR4(LD8(ON + 1536 + moff)), FR4(ww), z4);
            u32x2 uw; uw.x = pk2(Ut[0], Ut[1]); uw.y = pk2(Ut[2], Ut[3]);
            const bf16x8 Uf = FR4(uw);
            f32x4 Yt = MF(FR8(LD8(OR_ + aoff0), LD8(OR_ + aoff1)), Sf0, z4); Yt = MF(FR8(LD8(OR_ + aoff2), LD8(OR_ + aoff3)), Sf1, Yt);
            Yt = MF(FR4(LD8(ON + 512 + moff)), Uf, Yt); Yt = MF(FR4(LD8(ON + 1024 + moff)), Vf, Yt);
#pragma unroll
            for (int kt = 0; kt < 4; ++kt) {
                f32x4 Dk = MF(FR4(LD8(OBT + kt * 512 + moff)), Uf, z4); Dk = MF(FR4(LD8(OKT + kt * 512 + moff)), Vf, Dk);
                const f32x4 pc = *(const LAS f32x4*)(sl + OPC + (kt * 16 + 4 * fq) * 4);
                S[kt] = (S[kt] + Dk) * pc;
            }
            LAS float* yb = ybuf + (c & 1) * 1024 + (wave & 3) * 16 + fr;
            LAS float* pb = pbuf + (c & 1) * 128 + (wave & 3) * 32;
#pragma unroll
            for (int j = 0; j < 4; ++j) {
                yb[(4 * fq + j) * 64] = Yt[j];
                float sy = Yt[j], sq = Yt[j] * Yt[j];
                RED16(sy); RED16(sq);
                if (fr == 0) *(LAS f32x2*)(pb + (4 * fq + j) * 2) = (f32x2){sy, sq};
            }
            asm volatile("s_waitcnt lgkmcnt(0)" ::: "memory");
        } else if (wave < 6) {
            if (c + DPF < 128) DMA_CHUNK(c + DPF);
            if (c >= DPF && c + DPF < 128) asm volatile("s_waitcnt vmcnt(36)" ::: "memory"); else asm volatile("s_waitcnt vmcnt(0)" ::: "memory");
        } else if (c > 0) {
            SCAN_EPI(c - 1);
        }
        asm volatile("" ::: "memory"); __builtin_amdgcn_s_barrier(); asm volatile("" ::: "memory");
    }
    if (wave >= 6) { SCAN_EPI(127); }
    asm volatile("s_waitcnt vmcnt(0)" ::: "memory");
    __syncthreads();
#undef SCAN_EPI
#undef DMA16
#undef DMA_CHUNK
#undef FR8
#undef FR4
#undef MF
#undef LD8
#undef DPP_F
#undef RED16
}

__device__ __forceinline__ void attn_item(const PA a, int l, int it, LAS unsigned char* lds) {
    const int tid = otid(), h = tid >> 6, lane = tid & 63, fr = lane & 15, fq = lane >> 4;
    const int b = it >> 5, c = it & 31;
    LAS float* s_bias = (LAS float*)(lds + LDS_MISC + 1024);
    LAS float* s_part = s_bias + 8 * 320;
    const bf16_t* proj = WSP(const bf16_t, WS_PROJ);
    const bf16_t* VT = WSP(const bf16_t, WS_VT) + (size_t)(b * 8 + h) * 64 * 2048;
    const size_t tq0 = (size_t)b * SEQ + c * 64;
    bf16x8 qf[4][2];
#pragma unroll
    for (int nt = 0; nt < 4; ++nt)
#pragma unroll
        for (int ks = 0; ks < 2; ++ks) qf[nt][ks] = *(const bf16x8*)(proj + (tq0 + nt * 16 + fr) * INW + 1792 + h * 64 + 32 * ks + 8 * fq);
    f32x4 o[4][4];
#pragma unroll
    for (int dt = 0; dt < 4; ++dt)
#pragma unroll
        for (int nt = 0; nt < 4; ++nt) o[dt][nt] = (f32x4){0.f, 0.f, 0.f, 0.f};
    float lsum[4] = {0.f, 0.f, 0.f, 0.f};
    const int kc0 = c - 8 > 0 ? c - 8 : 0;
    const int nsteps = (c - kc0 + 1) * 2;
    bf16x8 kf[2][2], kn[2][2]; u32x4 vf[4], vn[4];
#define ATT_LOAD(KF, VF, st) do { const int key0 = (kc0 * 64 + (st) * 32); const size_t tk = (size_t)b * SEQ + key0; \
        _Pragma("unroll") for (int mt = 0; mt < 2; ++mt) _Pragma("unroll") for (int ks = 0; ks < 2; ++ks) \
            KF[mt][ks] = *(const bf16x8*)(proj + (tk + mt * 16 + fr) * INW + 2304 + h * 64 + 32 * ks + 8 * fq); \
        _Pragma("unroll") for (int dt = 0; dt < 4; ++dt) { const bf16_t* vp = VT + (size_t)(dt * 16 + fr) * 2048 + key0 + 4 * fq; \
            const u32x2 v0 = *(const u32x2*)vp, v1 = *(const u32x2*)(vp + 16); VF[dt].x = v0.x; VF[dt].y = v0.y; VF[dt].z = v1.x; VF[dt].w = v1.y; } } while (0)
    ATT_LOAD(kf, vf, 0);
    for (int st = 0; st < nsteps; ++st) {
        const bool more = st + 1 < nsteps;
        if (more) ATT_LOAD(kn, vn, st + 1);
        f32x4 sacc[2][4];
#pragma unroll
        for (int mt = 0; mt < 2; ++mt)
#pragma unroll
            for (int nt = 0; nt < 4; ++nt) {
                f32x4 z = {0.f, 0.f, 0.f, 0.f};
                z = __builtin_amdgcn_mfma_f32_16x16x32_bf16(kf[mt][0], qf[nt][0], z, 0, 0, 0);
                sacc[mt][nt] = __builtin_amdgcn_mfma_f32_16x16x32_bf16(kf[mt][1], qf[nt][1], z, 0, 0, 0);
            }
        const int dk = c - (kc0 + (st >> 1)), half = st & 1;
        if (dk >= 5) {
            const float bc = s_bias[h * 320 + 319];
#pragma unroll
            for (int mt = 0; mt < 2; ++mt)
#pragma unroll
                for (int nt = 0; nt < 4; ++nt) sacc[mt][nt] += bc;
        } else {
#pragma unroll
            for (int mt = 0; mt < 2; ++mt)
#pragma unroll
                for (int nt = 0; nt < 4; ++nt)
#pragma unroll
                    for (int j = 0; j < 4; ++j) {
                        int idx = (nt * 16 + fr) - (half * 32 + mt * 16 + 4 * fq + j) + dk * 64; idx = idx > 256 ? 256 : idx;
                        sacc[mt][nt][j] += s_bias[h * 320 + idx + 63];
                    }
        }
        bf16x8 pf[4];
#pragma unroll
        for (int nt = 0; nt < 4; ++nt) {
            float p[8];
#pragma unroll
            for (int j = 0; j < 4; ++j) { p[j] = __builtin_amdgcn_exp2f(fminf(sacc[0][nt][j], 80.f)); p[4 + j] = __builtin_amdgcn_exp2f(fminf(sacc[1][nt][j], 80.f)); }
            lsum[nt] += ((p[0] + p[1]) + (p[2] + p[3])) + ((p[4] + p[5]) + (p[6] + p[7]));
            u32x4 w; w.x = pk2(p[0], p[1]); w.y = pk2(p[2], p[3]); w.z = pk2(p[4], p[5]); w.w = pk2(p[6], p[7]);
            pf[nt] = __builtin_bit_cast(bf16x8, w);
        }
#pragma unroll
        for (int dt = 0; dt < 4; ++dt)
#pragma unroll
            for (int nt = 0; nt < 4; ++nt) o[dt][nt] = __builtin_amdgcn_mfma_f32_16x16x32_bf16(__builtin_bit_cast(bf16x8, vf[dt]), pf[nt], o[dt][nt], 0, 0, 0);
        if (more) {
#pragma unroll
            for (int mt = 0; mt < 2; ++mt)
#pragma unroll
                for (int ks = 0; ks < 2; ++ks) kf[mt][ks] = kn[mt][ks];
#pragma unroll
            for (int dt = 0; dt < 4; ++dt) vf[dt] = vn[dt];
        }
    }
#undef ATT_LOAD
    float ssq[4];
#pragma unroll
    for (int nt = 0; nt < 4; ++nt) {
        float ls = lsum[nt]; ls += __shfl_xor(ls, 16); ls += __shfl_xor(ls, 32);
        const float inv = 1.0f / ls;
        float sq = 0.f;
#pragma unroll
        for (int dt = 0; dt < 4; ++dt) { o[dt][nt] *= inv; sq += (o[dt][nt][0] * o[dt][nt][0] + o[dt][nt][1] * o[dt][nt][1]) + (o[dt][nt][2] * o[dt][nt][2] + o[dt][nt][3] * o[dt][nt][3]); }
        sq += __shfl_xor(sq, 16); sq += __shfl_xor(sq, 32);
        ssq[nt] = sq;
        if (fq == 0) s_part[h * 64 + nt * 16 + fr] = sq;
    }
    __syncthreads();
#pragma unroll
    for (int nt = 0; nt < 4; ++nt) {
        float tot = 0.f;
#pragma unroll
        for (int hh = 0; hh < 8; ++hh) tot += s_part[hh * 64 + nt * 16 + fr];
        const float rinv = rsqrtf(tot * (1.0f / 512.0f) + 1e-6f);
        bf16_t* yp = WSP(bf16_t, WS_YCAT) + (tq0 + nt * 16 + fr) * 1024 + 512 + h * 64 + 4 * fq;
#pragma unroll
        for (int dt = 0; dt < 4; ++dt) { u32x2 w; w.x = pk2(o[dt][nt][0] * rinv, o[dt][nt][1] * rinv); w.y = pk2(o[dt][nt][2] * rinv, o[dt][nt][3] * rinv); *(u32x2*)(yp + dt * 16) = w; }
    }
    __syncthreads();
}

__device__ __forceinline__ void pc_mixer(const PA a, int l, LAS unsigned char* lds) {
    const int tid = otid();
    LAS float* s_bias = (LAS float*)(lds + LDS_MISC + 1024);
    volatile LAS int* s_item = (volatile LAS int*)(lds + LDS_MISC + 64);
    for (int i = tid; i < 8 * 320; i += 512) s_bias[i] = INP(20)[l * 8 * 320 + i] * 1.4426950408889634f;
    unsigned* qhead = WSP(unsigned, WS_CTL) + CW_QUEUE + l * 64;
    for (;;) {
        __syncthreads();
        if (tid == 0) *s_item = (int)__hip_atomic_fetch_add(qhead, 1u, __ATOMIC_RELAXED, __HIP_MEMORY_SCOPE_AGENT);
        __syncthreads();
        const int item = __builtin_amdgcn_readfirstlane(*s_item);
        if (item >= 128 + 512 + MOE_CONV_ITEMS) break;
        if (item < 128) scan_item(a, l, item, lds);
        else if (item < 128 + 512) attn_item(a, l, item - 128, lds);
        else moe_convert_item(a, l, lds, item - 640);
    }
}

__device__ __forceinline__ void pe2_xattn(const PA a, int l, LAS unsigned char* lds) {
    const int tid = otid(), wave = tid >> 6, lane = tid & 63, fr = lane & 15, fq = lane >> 4;
    LAS bf16_t* sK = (LAS bf16_t*)lds;
    LAS bf16_t* sV = (LAS bf16_t*)(lds + 69632);
    const bf16_t* QX = WSP(const bf16_t, WS_QX); bf16_t* OX = WSP(bf16_t, WS_OX);
    const bf16_t* KV = WSP(const bf16_t, WS_KV) + (size_t)l * MROWS * 1024;
    const bf16_t* VTX = WSP(const bf16_t, WS_VTX) + (size_t)l * MROWS * 512;
    const float* qgn = INP(28) + l * 128;
    for (int it = oblk(); it < 256; it += ogrid()) {
        const int b = it >> 4, h = (it >> 2) & 3, qr = it & 3;
        __syncthreads();
#pragma unroll
        for (int i = 0; i < 8; ++i) {
            const int p = tid + i * 512, r = p >> 4, c8 = (p & 15) * 8;
            *(LAS u32x4*)(sK + r * 136 + c8) = *(const u32x4*)(KV + (size_t)(b * 256 + r) * 1024 + h * 128 + c8);
            const int d = p >> 5, m8 = (p & 31) * 8;
            *(LAS u32x4*)(sV + d * 264 + m8) = *(const u32x4*)(VTX + ((size_t)(b * 4 + h) * 128 + d) * 256 + m8);
        }
        __syncthreads();
#pragma unroll 1
        for (int iter = 0; iter < 2; ++iter) {
            const size_t q0 = (size_t)b * SEQ + qr * 512 + iter * 256 + wave * 32;
            bf16x8 qf[2][4];
#pragma unroll
            for (int nt = 0; nt < 2; ++nt) {
                const bf16_t* qp = QX + (q0 + nt * 16 + fr) * 512 + h * 128 + 8 * fq;
                u32x4 w[4]; float ssq = 0.f;
#pragma unroll
                for (int ks = 0; ks < 4; ++ks) { w[ks] = *(const u32x4*)(qp + 32 * ks);
#pragma unroll
                    for (int j = 0; j < 4; ++j) { const float x0 = lo16(w[ks][j]), x1 = hi16(w[ks][j]); ssq += x0 * x0 + x1 * x1; } }
                ssq += __shfl_xor(ssq, 16); ssq += __shfl_xor(ssq, 32);
                const float sc = rsqrtf(ssq * (1.0f / 128.0f) + 1e-6f) * 0.12751743f;
#pragma unroll
                for (int ks = 0; ks < 4; ++ks) {
                    const f32x4 g0 = *(const f32x4*)(qgn + 32 * ks + 8 * fq), g1 = *(const f32x4*)(qgn + 32 * ks + 8 * fq + 4);
                    u32x4 ow;
                    ow.x = pk2(lo16(w[ks][0]) * sc * g0[0], hi16(w[ks][0]) * sc * g0[1]); ow.y = pk2(lo16(w[ks][1]) * sc * g0[2], hi16(w[ks][1]) * sc * g0[3]);
                    ow.z = pk2(lo16(w[ks][2]) * sc * g1[0], hi16(w[ks][2]) * sc * g1[1]); ow.w = pk2(lo16(w[ks][3]) * sc * g1[2], hi16(w[ks][3]) * sc * g1[3]);
                    qf[nt][ks] = __builtin_bit_cast(bf16x8, ow);
                }
            }
            f32x4 o[8][2];
#pragma unroll
            for (int dt = 0; dt < 8; ++dt) { o[dt][0] = (f32x4){0.f, 0.f, 0.f, 0.f}; o[dt][1] = (f32x4){0.f, 0.f, 0.f, 0.f}; }
            float lsum[2] = {0.f, 0.f};
#pragma unroll 2
            for (int st = 0; st < 8; ++st) {
                const int k0 = st * 32;
                f32x4 sacc[2][2];
#pragma unroll
                for (int mt = 0; mt < 2; ++mt) {
                    sacc[mt][0] = (f32x4){0.f, 0.f, 0.f, 0.f}; sacc[mt][1] = (f32x4){0.f, 0.f, 0.f, 0.f};
#pragma unroll
                    for (int ks = 0; ks < 4; ++ks) {
                        const bf16x8 kfr = *(const LAS bf16x8*)(sK + (k0 + mt * 16 + fr) * 136 + 32 * ks + 8 * fq);
                        sacc[mt][0] = __builtin_amdgcn_mfma_f32_16x16x32_bf16(kfr, qf[0][ks], sacc[mt][0], 0, 0, 0);
                        sacc[mt][1] = __builtin_amdgcn_mfma_f32_16x16x32_bf16(kfr, qf[1][ks], sacc[mt][1], 0, 0, 0);
                    }
                }
                bf16x8 pf[2];
#pragma unroll
                for (int nt = 0; nt < 2; ++nt) {
                    float p[8];
#pragma unroll
                    for (int j = 0; j < 4; ++j) { p[j] = __builtin_amdgcn_exp2f(fminf(sacc[0][nt][j], 80.f)); p[4 + j] = __builtin_amdgcn_exp2f(fminf(sacc[1][nt][j], 80.f)); }
                    lsum[nt] += ((p[0] + p[1]) + (p[2] + p[3])) + ((p[4] + p[5]) + (p[6] + p[7]));
                    u32x4 w; w.x = pk2(p[0], p[1]); w.y = pk2(p[2], p[3]); w.z = pk2(p[4], p[5]); w.w = pk2(p[6], p[7]);
                    pf[nt] = __builtin_bit_cast(bf16x8, w);
                }
#pragma unroll
                for (int dt = 0; dt < 8; ++dt) {
                    const LAS bf16_t* vp = sV + (dt * 16 + fr) * 264 + k0 + 4 * fq;
                    const u32x2 v0 = *(const LAS u32x2*)vp, v1 = *(const LAS u32x2*)(vp + 16);
                    u32x4 w; w.x = v0.x; w.y = v0.y; w.z = v1.x; w.w = v1.y;
                    const bf16x8 vfr = __builtin_bit_cast(bf16x8, w);
                    o[dt][0] = __builtin_amdgcn_mfma_f32_16x16x32_bf16(vfr, pf[0], o[dt][0], 0, 0, 0);
                    o[dt][1] = __builtin_amdgcn_mfma_f32_16x16x32_bf16(vfr, pf[1], o[dt][1], 0, 0, 0);
                }
            }
#pragma unroll
            for (int nt = 0; nt < 2; ++nt) {
                float ls = lsum[nt]; ls += __shfl_xor(ls, 16); ls += __shfl_xor(ls, 32);
                const float inv = 1.0f / ls;
                bf16_t* op = OX + (q0 + nt * 16 + fr) * 512 + h * 128 + 4 * fq;
#pragma unroll
                for (int dt = 0; dt < 8; ++dt) { u32x2 w; w.x = pk2(o[dt][nt][0] * inv, o[dt][nt][1] * inv); w.y = pk2(o[dt][nt][2] * inv, o[dt][nt][3] * inv); *(u32x2*)(op + dt * 16) = w; }
            }
        }
    }
    __syncthreads();
}

__device__ __forceinline__ void pf_router(const PA a, int l, LAS unsigned char* lds) {
    const int tid = otid(), wave = tid >> 6, lane = tid & 63, fr = lane & 15, fq = lane >> 4;
    LAS int* s_cnt = (LAS int*)lds;
    LAS int* s_base = s_cnt + 32;
    LAS int* s_e = s_base + 32;
    LAS int* s_rk = s_e + 256;
    LAS float* s_w = (LAS float*)(s_rk + 256);
    const float* X = a.out; const float* SS = WSP(const float, WS_SS);
    const bf16_t* wrh = WSP(const bf16_t, WS_WRH) + (size_t)l * 48 * 1024; const bf16_t* wrl = WSP(const bf16_t, WS_WRL) + (size_t)l * 48 * 1024;
    const float* bg = INP(32) + l * 4; const float* br = INP(34) + l * 32;
    int* EID = WSP(int, WS_EID); float* EW = WSP(float, WS_EW); int* ERK = WSP(int, WS_ERK);
    unsigned* cnt = WSP(unsigned, WS_CTL) + CW_CNT + l * 32;
    for (int tile = oblk(); tile < T / 128; tile += ogrid()) {
        __syncthreads();
        if (tid < 32) s_cnt[tid] = 0;
        __syncthreads();
        const int t = tile * 128 + wave * 16 + fr;
        f32x4 acc[3];
#pragma unroll
        for (int mt = 0; mt < 3; ++mt) acc[mt] = (f32x4){0.f, 0.f, 0.f, 0.f};
        const float* xr = X + (size_t)t * 1024 + 8 * fq;
#pragma unroll 4
        for (int s_ = 0; s_ < 32; ++s_) {
            const f32x4 x0 = *(const f32x4*)(xr + 32 * s_), x1 = *(const f32x4*)(xr + 32 * s_ + 4);
            u32x4 hw; hw.x = pk2(x0[0], x0[1]); hw.y = pk2(x0[2], x0[3]); hw.z = pk2(x1[0], x1[1]); hw.w = pk2(x1[2], x1[3]);
            u32x4 lw; lw.x = pk2(x0[0] - lo16(hw.x), x0[1] - hi16(hw.x)); lw.y = pk2(x0[2] - lo16(hw.y), x0[3] - hi16(hw.y));
            lw.z = pk2(x1[0] - lo16(hw.z), x1[1] - hi16(hw.z)); lw.w = pk2(x1[2] - lo16(hw.w), x1[3] - hi16(hw.w));
            const bf16x8 xh = __builtin_bit_cast(bf16x8, hw), xl = __builtin_bit_cast(bf16x8, lw);
#pragma unroll
            for (int mt = 0; mt < 3; ++mt) {
                const bf16x8 wh = *(const bf16x8*)(wrh + (size_t)(mt * 16 + fr) * 1024 + 32 * s_ + 8 * fq);
                const bf16x8 wl = *(const bf16x8*)(wrl + (size_t)(mt * 16 + fr) * 1024 + 32 * s_ + 8 * fq);
                acc[mt] = __builtin_amdgcn_mfma_f32_16x16x32_bf16(wh, xh, acc[mt], 0, 0, 0);
                acc[mt] = __builtin_amdgcn_mfma_f32_16x16x32_bf16(wh, xl, acc[mt], 0, 0, 0);
                acc[mt] = __builtin_amdgcn_mfma_f32_16x16x32_bf16(wl, xh, acc[mt], 0, 0, 0);
            }
        }
        const f32x4* sp = (const f32x4*)(SS + (size_t)t * 16);
        const f32x4 s0 = sp[0], s1 = sp[1], s2 = sp[2], s3 = sp[3];
        const float tot = ((s0[0] + s0[1]) + (s0[2] + s0[3])) + ((s1[0] + s1[1]) + (s1[2] + s1[3])) + ((s2[0] + s2[1]) + (s2[2] + s2[3])) + ((s3[0] + s3[1]) + (s3[2] + s3[3]));
        const float rinv = rsqrtf(tot * (1.0f / 1024.0f) + 1e-6f);
        float lg[4], lr[8];
#pragma unroll
        for (int j = 0; j < 4; ++j) { lg[j] = acc[0][j] * rinv + bg[j]; lr[j] = acc[1][j] * rinv + br[fq * 8 + j]; lr[4 + j] = acc[2][j] * rinv + br[fq * 8 + 4 + j]; }
        float g0 = lg[0]; int gt = 0;
#pragma unroll
        for (int j = 1; j < 4; ++j) { if (lg[j] > g0) { g0 = lg[j]; gt = j; } }
        if (fq == gt) {
            float gs = 0.f;
#pragma unroll
            for (int j = 0; j < 4; ++j) gs += __expf(lg[j] - g0);
            const float ggate = 1.0f / gs;
            float l1 = -1e30f, l2 = -1e30f; int j1 = 0, j2 = 0;
#pragma unroll
            for (int j = 0; j < 8; ++j) { const float v = lr[j];
                if (v > l1) { l2 = l1; j2 = j1; l1 = v; j1 = j; } else if (v > l2) { l2 = v; j2 = j; } }
            const float e2 = __expf(l2 - l1);
            const float p1 = 1.0f / (1.0f + e2), p2 = e2 / (1.0f + e2);
            const int e1i = gt * 8 + j1, e2i = gt * 8 + j2;
            const int r1 = atomicAdd((int*)(s_cnt + e1i), 1), r2 = atomicAdd((int*)(s_cnt + e2i), 1);
            const int sl = (wave * 16 + fr) * 2;
            s_e[sl] = e1i; s_e[sl + 1] = e2i; s_rk[sl] = r1; s_rk[sl + 1] = r2; s_w[sl] = ggate * p1; s_w[sl + 1] = ggate * p2;
        }
        __syncthreads();
        if (tid < 32) s_base[tid] = (int)__hip_atomic_fetch_add(cnt + tid, (unsigned)s_cnt[tid], __ATOMIC_RELAXED, __HIP_MEMORY_SCOPE_AGENT);
        __syncthreads();
        if (tid < 256) { const int e = s_e[tid]; const size_t o = (size_t)tile * 256 + tid; EID[o] = e; EW[o] = s_w[tid]; ERK[o] = s_base[e] + s_rk[tid]; }
    }
    __syncthreads();
}

__device__ __forceinline__ void pg_gather(const PA a, int l, LAS unsigned char* lds) {
    const int tid = otid(), wave = tid >> 6, lane = tid & 63;
    LAS int* s_ps = (LAS int*)lds;
    const unsigned* cnt = WSP(const unsigned, WS_CTL) + CW_CNT + l * 32;
    int* SSLOT = WSP(int, WS_SSLOT); float* SW = WSP(float, WS_SW); int* MTE = WSP(int, WS_MTE);
    bf16_t* XS = WSP(bf16_t, WS_XS); const bf16_t* XB = WSP(const bf16_t, WS_XB);
    const float* SS = WSP(const float, WS_SS);
    const int* EID = WSP(const int, WS_EID); const float* EW = WSP(const float, WS_EW); const int* ERK = WSP(const int, WS_ERK);
    __syncthreads();
    if (tid == 0) {
        int acc = 0;
        for (int e = 0; e < 32; ++e) { s_ps[e] = acc; const int c = (int)__hip_atomic_load(cnt + e, __ATOMIC_RELAXED, __HIP_MEMORY_SCOPE_AGENT); acc += ((c + 255) >> 8) << 8; }
        s_ps[32] = acc;
    }
    __syncthreads();
    if (oblk() == 0) {
        if (tid < 32) { const int m0 = s_ps[tid] >> 8, m1 = s_ps[tid + 1] >> 8; for (int mt = m0; mt < m1; ++mt) MTE[mt] = tid; }
        if (tid == 0) MTE[511] = s_ps[32] >> 8;
    }
    for (int e = oblk(); e < 32; e += ogrid()) {
        const int c = (int)__hip_atomic_load(cnt + e, __ATOMIC_RELAXED, __HIP_MEMORY_SCOPE_AGENT);
        const int r0 = s_ps[e] + c, r1 = s_ps[e + 1];
        for (int r = r0 + wave; r < r1; r += 8) {
            if (lane == 0) { SSLOT[r] = -1; SW[r] = 0.f; }
            unsigned zz = 0u; asm volatile("" : "+v"(zz));
            u32x4 z = {zz, zz, zz, zz};
            *(u32x4*)(XS + (size_t)r * 1024 + lane * 8) = z; *(u32x4*)(XS + (size_t)r * 1024 + 512 + lane * 8) = z;
        }
    }
    for (int as = oblk() * 8 + wave; as < 2 * T; as += ogrid() * 8) {
        const int t = as >> 1;
        const int e = EID[as], rk = ERK[as];
        const int dest = s_ps[e] + rk;
        float tot = 0.f;
        if (lane < 16) tot = SS[(size_t)t * 16 + lane];
        tot = wsum(tot);
        const float rinv = rsqrtf(tot * (1.0f / 1024.0f) + 1e-6f);
        if (lane == 0) { SSLOT[dest] = as; SW[dest] = EW[as]; }
#pragma unroll
        for (int i = 0; i < 2; ++i) {
            const u32x4 w = *(const u32x4*)(XB + (size_t)t * 1024 + i * 512 + lane * 8);
            u32x4 o;
#pragma unroll
            for (int j = 0; j < 4; ++j) o[j] = pk2(lo16(w[j]) * rinv, hi16(w[j]) * rinv);
            *(u32x4*)(XS + (size_t)dest * 1024 + i * 512 + lane * 8) = o;
        }
    }
}

__device__ __forceinline__ void pj_finalize(const PA a) {
    const int wave = otid() >> 6, lane = otid() & 63;
    float* X = a.out; bf16_t* XB = WSP(bf16_t, WS_XB); float* SS = WSP(float, WS_SS);
    const bf16_t* Y = WSP(const bf16_t, WS_Y);
    for (int t = oblk() * 8 + wave; t < T; t += ogrid() * 8) {
        float sq = 0.f;
#pragma unroll
        for (int i = 0; i < 4; ++i) {
            const int c = i * 256 + lane * 4;
            f32x4 v = *(const f32x4*)(X + (size_t)t * 1024 + c);
            const u32x2 y0 = *(const u32x2*)(Y + (size_t)(2 * t) * 1024 + c), y1 = *(const u32x2*)(Y + (size_t)(2 * t + 1) * 1024 + c);
            v[0] += lo16(y0.x) + lo16(y1.x); v[1] += hi16(y0.x) + hi16(y1.x); v[2] += lo16(y0.y) + lo16(y1.y); v[3] += hi16(y0.y) + hi16(y1.y);
            *(f32x4*)(X + (size_t)t * 1024 + c) = v;
            u32x2 w; w.x = pk2(v[0], v[1]); w.y = pk2(v[2], v[3]);
            *(u32x2*)(XB + (size_t)t * 1024 + c) = w;
            sq += (v[0] * v[0] + v[1] * v[1]) + (v[2] * v[2] + v[3] * v[3]);
        }
        sq = wsum(sq);
        if (lane < 16) SS[(size_t)t * 16 + lane] = (lane == 0) ? sq : 0.f;
    }
}

#define SITE static __device__ __forceinline__ void
#define OPAQUE() do { a.out = (float*)ldsin(lds, 38); a.ws = (unsigned char*)ldsin(lds, 39); } while (0)
__device__ __forceinline__ int opq(int v) { asm volatile("" : "+s"(v)); return v; }
SITE site_p0(PA a, LAS unsigned char* lds) { OPAQUE(); p0_prologue(a, lds); }
SITE site_kv(PA a, LAS unsigned char* lds) { OPAQUE();
    pg8::Gemm g{WSP(const bf16_t, WS_MEMB), WSP(const bf16_t, WS_WKV), 1024, (size_t)1024 * 1024};
    pg8::KvOrder S{opq((int)gridDim.x), opq((int)blockIdx.x)};
    pg8::EpiScale E{WSP(bf16_t, WS_KV), 1024, WSP(const float, WS_MEMSS), MROWS - 1};
    pg8::gemm_phase<pg8::EpiScale, pg8::KvOrder>(lds, g, S, E);
}
SITE site_knorm(PA a, LAS unsigned char* lds) { OPAQUE(); p2_knorm(a, lds); }
SITE site_inproj(PA a, int l, LAS unsigned char* lds) { OPAQUE();
    pg8::Gemm g{WSP(const bf16_t, WS_XB), WSP(const bf16_t, WS_WIN) + (size_t)l * INW * 1024, 1024, 0};
    pg8::StaticOrder S; S.init(T, INW, opq((int)gridDim.x), opq((int)blockIdx.x));
    pg8::EpiProj E{WSP(bf16_t, WS_PROJ), WSP(bf16_t, WS_VT), WSP(const float, WS_SS)};
    pg8::gemm_phase<pg8::EpiProj, pg8::StaticOrder>(lds, g, S, E);
}
SITE site_prep(PA a, int l, LAS unsigned char* lds) { OPAQUE();
    pb_prep(a, l, lds);
}
SITE site_chunks(PA a, int l, LAS unsigned char* lds) { OPAQUE(); pb2_chunks(a, l, lds); }
SITE site_mixer(PA a, int l, LAS unsigned char* lds) { OPAQUE(); pc_mixer(a, l, lds); }
SITE site_outproj(PA a, int l, LAS unsigned char* lds) { OPAQUE();
    pg8::Gemm g{WSP(const bf16_t, WS_YCAT), WSP(const bf16_t, WS_WOUT) + (size_t)l * 1024 * 1024, 1024, 0};
    pg8::StaticOrder S; S.init(T, 1024, opq((int)gridDim.x), opq((int)blockIdx.x));
    pg8::EpiRes E{a.out, WSP(bf16_t, WS_XB), WSP(float, WS_SS)};
    pg8::gemm_phase<pg8::EpiRes, pg8::StaticOrder>(lds, g, S, E);
}
SITE site_xq(PA a, int l, LAS unsigned char* lds) { OPAQUE();
    pg8::Gemm g{WSP(const bf16_t, WS_XB), WSP(const bf16_t, WS_WQ) + (size_t)l * 512 * 1024, 1024, 0};
    pg8::StaticOrder S; S.init(T, 512, opq((int)gridDim.x), opq((int)blockIdx.x));
    pg8::EpiScale E{WSP(bf16_t, WS_QX), 512, WSP(const float, WS_SS), T - 1};
    pg8::gemm_phase<pg8::EpiScale, pg8::StaticOrder>(lds, g, S, E);
}
SITE site_xattn(PA a, int l, LAS unsigned char* lds) { OPAQUE(); pe2_xattn(a, l, lds); }
SITE site_xo(PA a, int l, LAS unsigned char* lds) { OPAQUE();
    pg8::Gemm g{WSP(const bf16_t, WS_OX), WSP(const bf16_t, WS_WO) + (size_t)l * 1024 * 512, 512, 0};
    pg8::StaticOrder S; S.init(T, 1024, opq((int)gridDim.x), opq((int)blockIdx.x));
    pg8::EpiRes E{a.out, WSP(bf16_t, WS_XB), WSP(float, WS_SS)};
    pg8::gemm_phase<pg8::EpiRes, pg8::StaticOrder>(lds, g, S, E);
}
SITE site_router(PA a, int l, LAS unsigned char* lds) { OPAQUE(); pf_router(a, l, lds); }
SITE site_gather(PA a, int l, LAS unsigned char* lds) { OPAQUE(); pg_gather(a, l, lds); }
SITE site_gu(PA a, LAS unsigned char* lds) { OPAQUE();
    pg8::Gemm g{WSP(const bf16_t, WS_XS), WSP(const bf16_t, WS_WGU), 1024, (size_t)1024 * 1024};
    pg8::MoeOrder S{WSP(const int, WS_MTE), opq((int)gridDim.x), opq((int)blockIdx.x)};
    pg8::EpiGU E{WSP(bf16_t, WS_HB)};
    pg8::gemm_phase<pg8::EpiGU, pg8::MoeOrder>(lds, g, S, E);
}
SITE site_down(PA a, LAS unsigned char* lds) { OPAQUE();
    pg8::Gemm g{WSP(const bf16_t, WS_HB), WSP(const bf16_t, WS_WD), 512, (size_t)1024 * 512};
    pg8::MoeOrder S{WSP(const int, WS_MTE), opq((int)gridDim.x), opq((int)blockIdx.x)};
    pg8::EpiDown E{WSP(bf16_t, WS_Y), WSP(const int, WS_SSLOT), WSP(const float, WS_SW)};
    pg8::gemm_phase<pg8::EpiDown, pg8::MoeOrder>(lds, g, S, E);
}
SITE site_final(PA a, LAS unsigned char* lds) { OPAQUE(); pj_finalize(a); }

__global__ void __launch_bounds__(512, 2) mk_fwd(Args args) {
    extern __shared__ __attribute__((aligned(16))) unsigned char lds_raw[];
    LAS unsigned char* lds = (LAS unsigned char*)lds_raw;
    const int tid = threadIdx.x;
    const int lo = args.ph_lo, hi = args.ph_hi;
    PA a; a.out = args.out; a.ws = args.ws;
    if (tid < 16) ((LAS unsigned*)(lds + LDS_MISC))[tid] = 0u;
    if (tid == 64) {
        LAS unsigned long long* tab = (LAS unsigned long long*)(lds + LDS_INTAB);
#pragma unroll
        for (int i = 0; i < 38; ++i) tab[i] = (unsigned long long)args.in[i];
        tab[38] = (unsigned long long)args.out; tab[39] = (unsigned long long)args.ws;
    }
    __syncthreads();
    XcdBarrier bar; bar.bar = WSP(unsigned, WS_CTL) + CW_BAR; bar.x = 0; bar.st = nullptr;
    if (!MK_PER_PHASE) bar = xcd_barrier_post(WSP(unsigned, WS_CTL) + CW_BAR, (volatile LAS unsigned*)(lds + LDS_MISC));
#define IN(k) (lo <= (k) && (k) < hi)
#define GRID_BAR() do { if (!MK_PER_PHASE) xcd_barrier(bar); } while (0)
#ifdef PROBE_MASK
    unsigned long long pr_acc = 0ull, pr_t0 = 0ull; const unsigned long long pr_start = wall_clock64();
#define PR0() do { pr_t0 = wall_clock64(); } while (0)
#define PR1(p) do { if ((PROBE_MASK >> (p)) & 1) pr_acc += wall_clock64() - pr_t0; } while (0)
#else
#define PR0() do { } while (0)
#define PR1(p) do { } while (0)
#endif
    PR0(); if (IN(0)) { site_p0(a, lds); GRID_BAR(); } PR1(12);
    PR0(); if (IN(1)) { site_kv(a, lds); GRID_BAR(); } PR1(13);
    PR0(); if (IN(2)) { site_knorm(a, lds); GRID_BAR(); } PR1(14);
    for (int l = 0; l < NL; ++l) {
        const int pb = 3 + 12 * l;
        PR0(); if (IN(pb + 0)) { site_inproj(a, l, lds); GRID_BAR(); } PR1(0);
        PR0(); if (IN(pb + 1)) { site_prep(a, l, lds); GRID_BAR(); site_chunks(a, l, lds); GRID_BAR(); } PR1(1);
        PR0(); if (IN(pb + 2)) { site_mixer(a, l, lds); GRID_BAR(); } PR1(2);
        PR0(); if (IN(pb + 3)) { site_outproj(a, l, lds); GRID_BAR(); } PR1(3);
        PR0(); if (IN(pb + 4)) { site_xq(a, l, lds); GRID_BAR(); } PR1(4);
        PR0(); if (IN(pb + 5)) { site_xattn(a, l, lds); GRID_BAR(); } PR1(5);
        PR0(); if (IN(pb + 6)) { site_xo(a, l, lds); GRID_BAR(); } PR1(6);
        PR0(); if (IN(pb + 7)) { site_router(a, l, lds); GRID_BAR(); } PR1(7);
        PR0(); if (IN(pb + 8)) { site_gather(a, l, lds); GRID_BAR(); } PR1(8);
        PR0(); if (IN(pb + 9)) { site_gu(a, lds); GRID_BAR(); } PR1(9);
        PR0(); if (IN(pb + 10)) { site_down(a, lds); GRID_BAR(); } PR1(10);
#ifdef PROBE_MASK
        PR0(); if (IN(pb + 11)) { site_final(a, lds); GRID_BAR(); } PR1(11);
#else
        if (IN(pb + 11)) { site_final(a, lds); if (l + 1 < NL) GRID_BAR(); }
#endif
    }
#ifdef PROBE_MASK
    {
        unsigned long long* pw = (unsigned long long*)(WSP(unsigned, WS_CTL) + 8192);
        if (blockIdx.x == 0 && tid == 0) __hip_atomic_store(pw, pr_acc, __ATOMIC_RELAXED, __HIP_MEMORY_SCOPE_AGENT);
        GRID_BAR();
        const unsigned long long tgt = 1600000ull + __hip_atomic_load(pw, __ATOMIC_RELAXED, __HIP_MEMORY_SCOPE_AGENT) * (unsigned long long)PROBE_MULT;
        while (wall_clock64() - pr_start < tgt) __builtin_amdgcn_s_sleep(16);
    }
#endif
#undef IN
#undef GRID_BAR
}

extern "C" void kernel_launch(void* const* d_in, const int* in_sizes, int n_in, void* d_out, int out_size, void* d_ws, size_t ws_size, hipStream_t stream) {
    static int grid = 0;
    if (grid == 0) {
        if (n_in != 38 || out_size != T * D || ws_size < WS_END) { fprintf(stderr, "kernel_launch: unexpected shapes (n_in %d out %d ws %zu need %zu)\n", n_in, out_size, ws_size, (size_t)WS_END); grid = -1; return; }
        int dev = 0, cus = 0, per_cu = 0;
        if (hipGetDevice(&dev) != hipSuccess || hipDeviceGetAttribute(&cus, hipDeviceAttributeMultiprocessorCount, dev) != hipSuccess) { grid = -1; return; }
        if (hipFuncSetAttribute((const void*)mk_fwd, hipFuncAttributeMaxDynamicSharedMemorySize, LDS_BYTES) != hipSuccess) { fprintf(stderr, "kernel_launch: hipFuncSetAttribute failed\n"); grid = -1; return; }
        if (hipOccupancyMaxActiveBlocksPerMultiprocessor(&per_cu, (const void*)mk_fwd, 512, LDS_BYTES) != hipSuccess || per_cu < 1) { fprintf(stderr, "kernel_launch: occupancy query says %d\n", per_cu); }
        (void)hipGetLastError();
        grid = cus;
    }
    if (grid < 0) return;
    (void)hipMemsetAsync((char*)d_ws + WS_CTL, 0, CTL_BYTES, stream);
    Args a{};
    for (int i = 0; i < 38; ++i) a.in[i] = (const float*)d_in[i];
    a.out = (float*)d_out; a.ws = (unsigned char*)d_ws;
#if MK_PER_PHASE
    for (int p = 0; p < NPH; ++p) { a.ph_lo = p; a.ph_hi = p + 1; hipLaunchKernelGGL(mk_fwd, dim3(grid), dim3(512), LDS_BYTES, stream, a); }
#else
    a.ph_lo = 0; a.ph_hi = NPH;
    hipLaunchKernelGGL(mk_fwd, dim3(grid), dim3(512), LDS_BYTES, stream, a);
#endif
}
```

```cpp
#include <hip/hip_runtime.h>
#include <cstdio>
#include <cstdint>

#ifndef MK_PER_PHASE
#define MK_PER_PHASE 0
#endif

#define LAS __attribute__((address_space(3)))
typedef unsigned short bf16_t;
typedef short bf16x8 __attribute__((ext_vector_type(8)));
typedef float f32x4 __attribute__((ext_vector_type(4)));
typedef unsigned u32x4 __attribute__((ext_vector_type(4)));
typedef unsigned u32x2 __attribute__((ext_vector_type(2)));

constexpr int T = 32768, D = 1024, SEQ = 2048, NL = 4;
constexpr int INW = 3328;
constexpr int MROWS = 4096;
constexpr int MAXROWS = 73728, MAXMT = 288;
constexpr int NPH = 3 + 12 * NL;

constexpr size_t WS_CTL   = 0;
constexpr size_t CTL_BYTES = 65536;
constexpr size_t WS_WIN   = WS_CTL + CTL_BYTES;
constexpr size_t WS_WOUT  = WS_WIN  + (size_t)4 * 3328 * 1024 * 2;
constexpr size_t WS_WQ    = WS_WOUT + (size_t)4 * 1024 * 1024 * 2;
constexpr size_t WS_WKV   = WS_WQ   + (size_t)4 * 512 * 1024 * 2;
constexpr size_t WS_WO    = WS_WKV  + (size_t)4 * 1024 * 1024 * 2;
constexpr size_t WS_WGU   = WS_WO   + (size_t)4 * 1024 * 512 * 2;
constexpr size_t WS_WD    = WS_WGU  + (size_t)32 * 1024 * 1024 * 2;
constexpr size_t WS_KV    = WS_WD   + (size_t)32 * 1024 * 512 * 2;
constexpr size_t WS_MEMB  = WS_KV   + (size_t)4 * 4096 * 1024 * 2;
constexpr size_t WS_MEMSS = WS_MEMB + (size_t)4096 * 1024 * 2;
constexpr size_t WS_VTX   = WS_MEMSS + (size_t)4096 * 16 * 4;
constexpr size_t WS_WRH   = WS_VTX  + (size_t)4 * 4096 * 512 * 2;
constexpr size_t WS_WRL   = WS_WRH  + (size_t)4 * 48 * 1024 * 2;
constexpr size_t WS_XB    = WS_WRL  + (size_t)4 * 48 * 1024 * 2;
constexpr size_t WS_SS    = WS_XB   + (size_t)T * 1024 * 2;
constexpr size_t WS_VF    = WS_SS   + (size_t)T * 16 * 4;
constexpr size_t WS_EID   = WS_VF   + (size_t)T * 512 * 2;
constexpr size_t WS_EW    = WS_EID  + (size_t)T * 2 * 4;
constexpr size_t WS_ERK   = WS_EW   + (size_t)T * 2 * 4;
constexpr size_t WS_SSLOT = WS_ERK  + (size_t)T * 2 * 4;
constexpr size_t WS_SW    = WS_SSLOT + (size_t)MAXROWS * 4;
constexpr size_t WS_MTE   = WS_SW   + (size_t)MAXROWS * 4;
constexpr size_t WS_U     = WS_MTE  + 2048;
constexpr size_t WS_PROJ  = WS_U;
constexpr size_t WS_SR    = WS_PROJ + (size_t)T * 3328 * 2;
constexpr size_t WS_SK    = WS_SR   + (size_t)T * 512 * 2;
constexpr size_t WS_SV    = WS_SK   + (size_t)T * 512 * 2;
constexpr size_t WS_SA    = WS_SV   + (size_t)T * 512 * 2;
constexpr size_t WS_SB    = WS_SA   + (size_t)T * 512 * 2;
constexpr size_t WS_SG    = WS_SB   + (size_t)T * 512 * 2;
constexpr size_t WS_SWD   = WS_SG   + (size_t)T * 512 * 2;
constexpr size_t WS_YCAT  = WS_SWD  + (size_t)T * 512 * 4;
constexpr size_t WS_VT    = WS_YCAT + (size_t)T * 1024 * 2;
constexpr int NCHUNK = 16 * 8 * 128;
constexpr size_t WS_BTT   = WS_VT   + (size_t)T * 512 * 2;
constexpr size_t WS_KTT   = WS_BTT  + (size_t)NCHUNK * 2048;
constexpr size_t WS_VST   = WS_KTT  + (size_t)NCHUNK * 2048;
constexpr size_t WS_NKA   = WS_VST  + (size_t)NCHUNK * 2048;
constexpr size_t WS_NBR   = WS_NKA  + (size_t)NCHUNK * 512;
constexpr size_t WS_NKR   = WS_NBR  + (size_t)NCHUNK * 512;
constexpr size_t WS_TMT   = WS_NKR  + (size_t)NCHUNK * 512;
constexpr size_t WS_PCK   = WS_TMT  + (size_t)NCHUNK * 512;
constexpr size_t WS_BS    = WS_PCK  + (size_t)NCHUNK * 256;
constexpr size_t WS_UEND1 = WS_BS   + (size_t)T * 8 * 4;
constexpr size_t WS_QX    = WS_U;
constexpr size_t WS_OX    = WS_QX   + (size_t)T * 512 * 2;
constexpr size_t WS_XS    = WS_U;
constexpr size_t WS_HB    = WS_XS   + (size_t)MAXROWS * 1024 * 2;
constexpr size_t WS_Y     = WS_HB   + (size_t)MAXROWS * 512 * 2;
constexpr size_t WS_UEND2 = WS_Y    + (size_t)2 * T * 1024 * 2;
constexpr size_t WS_END   = WS_UEND1 > WS_UEND2 ? WS_UEND1 : WS_UEND2;

constexpr int CW_BAR = 0;
constexpr int CW_CNT = 4096;
constexpr int CW_QUEUE = 4096 + 256;

constexpr int LDS_MISC = 139264;
constexpr int LDS_BYTES = LDS_MISC + 16384;

struct Args { const float* in[38]; float* out; unsigned char* ws; int ph_lo, ph_hi; };
struct PA { float* out; unsigned char* ws; };

__device__ __forceinline__ float bf2f(bf16_t b) { return __uint_as_float(((unsigned)b) << 16); }
__device__ __forceinline__ bf16_t f2bf(float f) { unsigned u = __float_as_uint(f); u += 0x7FFFu + ((u >> 16) & 1u); return (bf16_t)(u >> 16); }
typedef __bf16 bf16v2 __attribute__((ext_vector_type(2)));
typedef float f32x2 __attribute__((ext_vector_type(2)));
__device__ __forceinline__ unsigned pk2(float lo, float hi) { f32x2 v = {lo, hi}; bf16v2 b = __builtin_convertvector(v, bf16v2); return __builtin_bit_cast(unsigned, b); }
__device__ __forceinline__ float lo16(unsigned u) { return __uint_as_float(u << 16); }
__device__ __forceinline__ float hi16(unsigned u) { return __uint_as_float(u & 0xffff0000u); }
__device__ __forceinline__ float wsum(float v) {
#pragma unroll
    for (int o = 32; o; o >>= 1) v += __shfl_xor(v, o);
    return v;
}
__device__ __forceinline__ float sigmoidf_(float x) { return 1.0f / (1.0f + __expf(-x)); }

#define XB_TMO      128
#define XB_XCNT(j)  (256  + 64 * (j))
#define XB_XSUB(j)  (1280 + 64 * (j))
#define XB_XGEN(j)  (2304 + 64 * (j))
#define XB_TOP      3328
#define XB_TOPGEN   3392
#define XCD_BAR_WORDS 3456
#define XB_SPIN_CAP (1u << 22)

__device__ __forceinline__ unsigned xb_ld(unsigned* p)              { return __hip_atomic_load(p, __ATOMIC_RELAXED, __HIP_MEMORY_SCOPE_AGENT); }
__device__ __forceinline__ unsigned xb_add(unsigned* p, unsigned v) { return __hip_atomic_fetch_add(p, v, __ATOMIC_RELAXED, __HIP_MEMORY_SCOPE_AGENT); }
__device__ __forceinline__ unsigned xb_xcc_id() { return (unsigned)__builtin_amdgcn_s_getreg((3 << 11) | 20) & 0xFu; }
#define XB_SPIN(cond, bar) do { unsigned _sp = 0; while (cond) { __builtin_amdgcn_s_sleep(1); \
    if ((++_sp & 255u) == 0u) { if (xb_ld(&(bar)[XB_TMO])) break; if (_sp > XB_SPIN_CAP) { atomicAdd(&(bar)[XB_TMO], 1u); break; } } } } while (0)

struct XcdBarrier { unsigned* bar; unsigned x; volatile LAS unsigned* st; };

__device__ __forceinline__ XcdBarrier xcd_barrier_post(unsigned* bar, volatile LAS unsigned* st) {
    XcdBarrier b; b.bar = bar; b.x = xb_xcc_id(); b.st = st;
    if (threadIdx.x == 0) (void)xb_add(&bar[XB_XCNT(b.x)], 1u);
    return b;
}
__device__ __forceinline__ void xcd_barrier_complete(unsigned* bar, unsigned x, unsigned& nloc, unsigned& nx) {
    const unsigned G = gridDim.x * gridDim.y * gridDim.z;
    unsigned sum, cnt, mine, sp = 0u;
    for (;;) {
        sum = 0u; cnt = 0u; mine = 0u;
#pragma unroll
        for (unsigned j = 0; j < 16; ++j) { const unsigned c = xb_ld(&bar[XB_XCNT(j)]); sum += c; cnt += (c > 0u) ? 1u : 0u; mine = (j == x) ? c : mine; }
        if (sum == G) break;
        __builtin_amdgcn_s_sleep(1);
        if ((++sp & 255u) == 0u) { if (xb_ld(&bar[XB_TMO])) break; if (sp > XB_SPIN_CAP) { atomicAdd(&bar[XB_TMO], 1u); break; } }
    }
    nloc = mine > 0u ? mine : 1u; nx = cnt > 0u ? cnt : 1u;
}
__device__ __forceinline__ void xcd_barrier(const XcdBarrier& b) {
    asm volatile("s_waitcnt vmcnt(0)" ::: "memory");
    __syncthreads();
    if (threadIdx.x == 0) {
        unsigned* bar = b.bar;
        __builtin_amdgcn_s_waitcnt(0);
        unsigned nloc = b.st[0], nx = b.st[1];
        if (nloc == 0u) { xcd_barrier_complete(bar, b.x, nloc, nx); b.st[0] = nloc; b.st[1] = nx; }
        const unsigned old = xb_add(&bar[XB_XSUB(b.x)], 1u);
        const unsigned gen = old / nloc;
        if (old + 1u == (gen + 1u) * nloc) {
            __builtin_amdgcn_fence(__ATOMIC_RELEASE, "agent");
            asm volatile("s_waitcnt vmcnt(0)" ::: "memory");
            const unsigned og = xb_add(&bar[XB_TOP], 1u);
            const unsigned tg = og / nx;
            if (og + 1u == (tg + 1u) * nx) xb_add(&bar[XB_TOPGEN], 1u);
            else XB_SPIN(xb_ld(&bar[XB_TOPGEN]) == tg, bar);
            __builtin_amdgcn_fence(__ATOMIC_ACQUIRE, "agent");
            xb_add(&bar[XB_XGEN(b.x)], 1u);
            asm volatile("s_waitcnt vmcnt(0)" ::: "memory");
        } else {
            XB_SPIN(xb_ld(&bar[XB_XGEN(b.x)]) == gen, bar);
            __builtin_amdgcn_fence(__ATOMIC_ACQUIRE, "agent");
            asm volatile("s_waitcnt vmcnt(0)" ::: "memory");
        }
    }
    __syncthreads();
}

namespace pg8 {
constexpr int BM = 256, BK = 64, HALF = 128, HTB = HALF * BK * 2, STAGE_BYTES = 8 * HTB, NXCD = 8, WGM = 8;
__host__ __device__ __forceinline__ int lds_byte(int r, int c) { const int st = (r >> 4) * 2 + (c >> 5), rr = r & 15, cc = c & 31, ob = rr * 64 + cc * 2; return st * 1024 + (ob ^ (((ob >> 9) & 1) << 5)); }
__host__ __device__ __forceinline__ void stage_rc(int b, int& R, int& C) { const int st = b / 1024, sb = b % 1024, swz = sb ^ (((sb >> 9) & 1) << 5); R = (st >> 1) * 16 + swz / 64; C = (st & 1) * 32 + (swz % 64) / 2; }
__host__ __device__ __forceinline__ int perm32(int rho) { const int n = rho >> 4, i = rho & 15; return 8 * (i >> 2) + 4 * n + (i & 3); }

struct Unit { int pm, pn, pa, z; };
struct Gemm { const bf16_t* A; const bf16_t* Bt; int K; size_t bz_stride; };

struct StaticOrder {
    int nM, nN, nwg, G, c;
    __device__ void init(int M, int N, int G_, int c_) { nM = M / BM; nN = N / BM; nwg = nM * nN; G = G_; c = c_; }
    __device__ bool next(int i, Unit& u) const {
        const long L = (long)i * G + c; if (L >= nwg) return false;
        int wgid = (int)L; { const int q = nwg / NXCD, r = nwg % NXCD, xcd = wgid % NXCD, off = wgid / NXCD; wgid = (xcd < r ? xcd * (q + 1) : r * (q + 1) + (xcd - r) * q) + off; }
        const int nig = WGM * nN, gid = wgid / nig, fm = gid * WGM, gsz = (nM - fm) < WGM ? (nM - fm) : WGM;
        u.pm = fm + ((wgid % nig) % gsz); u.pn = (wgid % nig) / gsz; u.pa = u.pm; u.z = 0; return true;
    }
};
struct KvOrder {
    int G, c;
    __device__ bool next(int i, Unit& u) const {
        const int L = i * G + c; if (L >= 256) return false;
        u.z = L >> 6; const int r = L & 63; u.pa = r >> 2; u.pn = r & 3; u.pm = u.z * 16 + u.pa; return true;
    }
};
struct MoeOrder {
    const int* mte; int G, c;
    __device__ bool next(int i, Unit& u) const {
        const int nunits = mte[511] * 4;
        const int L = i * G + c; if (L >= nunits) return false;
        u.pm = L >> 2; u.pa = u.pm; u.pn = L & 3; u.z = mte[u.pm]; return true;
    }
};

template <class Epi, class Sched, bool ALIGN_EPI = true>
__device__ __forceinline__ void gemm_phase(LAS unsigned char* lds, const Gemm g, const Sched& S, const Epi& E) {
    int tid_ = threadIdx.x; asm volatile("" : "+v"(tid_));
    const int tid = tid_, wid = __builtin_amdgcn_readfirstlane(tid >> 6), lane = tid & 63, wr = wid >> 2, wc = wid & 3, fr = lane & 15, fq = lane >> 4;
    const int K = g.K, nt = K / BK;
    unsigned voffA[2], voffB[2];
#pragma unroll
    for (int i = 0; i < 2; ++i) { int R, C; stage_rc(tid * 16 + i * 8192, R, C); const int Rb = ((R & ~31) + perm32(R & 31));
        voffA[i] = (unsigned)(R * K + C) * 2u; voffB[i] = (unsigned)(Rb * K + C) * 2u; }
    const size_t kstep = (size_t)(BK * 2);
    const size_t hstep = (size_t)HALF * K * 2;
    const size_t tstep = 2 * hstep;
    const unsigned ldsw = (unsigned)wid * 1024u;
    const int aoff = lds_byte(wr * 64 + fr, fq * 8), boff = lds_byte(wc * 32 + fr, fq * 8);
#define PG8_SA(b, h) (((b) * 2 + (h)) * HTB)
#define PG8_SB(b, h) ((4 + (b) * 2 + (h)) * HTB)
#define PG8_STAGE(bufoff, gbase, voff) do { _Pragma("unroll") for (int _i = 0; _i < 2; ++_i) \
        __builtin_amdgcn_global_load_lds((const unsigned*)((const char*)(gbase) + (voff)[_i]), (LAS unsigned*)(lds + (bufoff) + ldsw + _i * 8192), 16, 0, 0); } while (0)
#define PG8_LDA(dst, b, h) do { _Pragma("unroll") for (int m = 0; m < 4; ++m) _Pragma("unroll") for (int k = 0; k < 2; ++k) dst[m][k] = *(const LAS bf16x8*)(lds + PG8_SA(b, h) + aoff + m * 2048 + k * 1024); } while (0)
#define PG8_LDB(dst, b, h) do { _Pragma("unroll") for (int n = 0; n < 2; ++n) _Pragma("unroll") for (int k = 0; k < 2; ++k) dst[n][k] = *(const LAS bf16x8*)(lds + PG8_SB(b, h) + boff + n * 2048 + k * 1024); } while (0)
#define PG8_MMA(ai, bj, At, Bt) do { __builtin_amdgcn_s_setprio(1); _Pragma("unroll") for (int m = 0; m < 4; ++m) _Pragma("unroll") for (int n = 0; n < 2; ++n) _Pragma("unroll") for (int k = 0; k < 2; ++k) \
        acc[ai][bj][m][n] = __builtin_amdgcn_mfma_f32_16x16x32_bf16(Bt[n][k], At[m][k], acc[ai][bj][m][n], 0, 0, 0); __builtin_amdgcn_s_setprio(0); } while (0)
#define PG8_WAIT_V(n) asm volatile("s_waitcnt vmcnt(" #n ")" ::: "memory")
#define PG8_WAIT_L(n) asm volatile("s_waitcnt lgkmcnt(" #n ")" ::: "memory")
#define PG8_BAR __builtin_amdgcn_s_barrier()
#define PG8_SCHED __builtin_amdgcn_sched_barrier(0)
#define PG8_APTR(u) ((const char*)g.A + (size_t)(u).pa * tstep)
#define PG8_BPTR(u) ((const char*)g.Bt + ((size_t)(u).z * g.bz_stride) * 2 + (size_t)(u).pn * tstep)
    Unit cur, nxt; int ui = 0;
    if (!S.next(0, cur)) return;
    f32x4 acc[2][2][4][2];
#pragma unroll
    for (int a = 0; a < 2; ++a)
#pragma unroll
        for (int b = 0; b < 2; ++b)
#pragma unroll
            for (int m = 0; m < 4; ++m)
#pragma unroll
                for (int n = 0; n < 2; ++n) acc[a][b][m][n] = (f32x4){0.f, 0.f, 0.f, 0.f};
    bf16x8 At[4][2], B0[2][2], B1[2][2];
    const char* cA = PG8_APTR(cur); const char* cB = PG8_BPTR(cur);
    PG8_STAGE(PG8_SB(0, 0), cB, voffB); PG8_STAGE(PG8_SB(0, 1), cB + hstep, voffB); PG8_STAGE(PG8_SA(0, 0), cA, voffA); PG8_STAGE(PG8_SA(0, 1), cA + hstep, voffA);
    if (wr == 1) PG8_BAR;
    PG8_WAIT_V(2); PG8_BAR;
    PG8_STAGE(PG8_SB(1, 0), cB + kstep, voffB); PG8_STAGE(PG8_SA(1, 0), cA + kstep, voffA); PG8_STAGE(PG8_SB(1, 1), cB + hstep + kstep, voffB);
    PG8_WAIT_V(6); PG8_BAR;
    for (;;) {
        const bool has_next = S.next(ui + 1, nxt);
        const char* nA = has_next ? PG8_APTR(nxt) : cA; const char* nB = has_next ? PG8_BPTR(nxt) : cB;
        for (int t = 0; t < nt; t += 2) {
            const bool last = (t == nt - 2);
            const char* a1 = cA + (size_t)(t + 1) * kstep;
            const char* a2 = last ? nA : cA + (size_t)(t + 2) * kstep; const char* b2 = last ? nB : cB + (size_t)(t + 2) * kstep;
            const char* a3 = a2 + kstep; const char* b3 = b2 + kstep;
            PG8_LDB(B0, 0, 0); PG8_LDB(B1, 0, 1); PG8_SCHED; PG8_LDA(At, 0, 0); PG8_STAGE(PG8_SA(1, 1), a1 + hstep, voffA);
            PG8_WAIT_V(8); PG8_WAIT_L(0); PG8_BAR; PG8_MMA(0, 0, At, B0); PG8_MMA(0, 1, At, B1); PG8_BAR; PG8_SCHED;
            PG8_LDA(At, 0, 1); PG8_STAGE(PG8_SB(0, 0), b2, voffB); PG8_STAGE(PG8_SB(0, 1), b2 + hstep, voffB); PG8_STAGE(PG8_SA(0, 0), a2, voffA);
            PG8_WAIT_V(8); PG8_WAIT_L(0); PG8_BAR; PG8_MMA(1, 0, At, B0); PG8_MMA(1, 1, At, B1); PG8_BAR; PG8_SCHED;
            PG8_LDB(B0, 1, 0); PG8_LDB(B1, 1, 1); PG8_SCHED; PG8_LDA(At, 1, 0); PG8_STAGE(PG8_SA(0, 1), a2 + hstep, voffA);
            PG8_WAIT_V(8); PG8_WAIT_L(0); PG8_BAR; PG8_MMA(0, 0, At, B0); PG8_MMA(0, 1, At, B1); PG8_BAR; PG8_SCHED;
            PG8_LDA(At, 1, 1); PG8_STAGE(PG8_SB(1, 0), b3, voffB); PG8_STAGE(PG8_SB(1, 1), b3 + hstep, voffB); PG8_STAGE(PG8_SA(1, 0), a3, voffA);
            PG8_WAIT_V(8); PG8_WAIT_L(0); PG8_BAR; PG8_MMA(1, 0, At, B0); PG8_MMA(1, 1, At, B1); PG8_BAR; PG8_SCHED;
        }
        if constexpr (ALIGN_EPI) { if (wr == 0) PG8_BAR; }
        E(acc, cur, wr, wc, fr, fq);
        if (!has_next) break;
#pragma unroll
        for (int a = 0; a < 2; ++a)
#pragma unroll
            for (int b = 0; b < 2; ++b)
#pragma unroll
                for (int m = 0; m < 4; ++m)
#pragma unroll
                    for (int n = 0; n < 2; ++n) acc[a][b][m][n] = (f32x4){0.f, 0.f, 0.f, 0.f};
        cur = nxt; cA = nA; cB = nB; ++ui;
        if constexpr (ALIGN_EPI) { if (wr == 1) PG8_BAR; }
    }
    PG8_WAIT_V(0);
    if constexpr (!ALIGN_EPI) { if (wr == 0) PG8_BAR; }
    PG8_BAR;
#undef PG8_SA
#undef PG8_SB
#undef PG8_STAGE
#undef PG8_LDA
#undef PG8_LDB
#undef PG8_MMA
#undef PG8_WAIT_V
#undef PG8_WAIT_L
#undef PG8_BAR
#undef PG8_SCHED
#undef PG8_APTR
#undef PG8_BPTR
}

typedef const f32x4 (&AccRef)[2][2][4][2];

struct EpiScale {
    bf16_t* O; int ldc; const float* ss; int ssmask;
    __device__ __forceinline__ void operator()(AccRef acc, const Unit& u, int wr, int wc, int fr, int fq) const {
#pragma unroll
        for (int ai = 0; ai < 2; ++ai)
#pragma unroll
            for (int m = 0; m < 4; ++m) {
                const int row = u.pm * 256 + ai * 128 + wr * 64 + m * 16 + fr;
                const f32x4* sp = (const f32x4*)(ss + (size_t)(row & ssmask) * 16);
                const f32x4 s0 = sp[0], s1 = sp[1], s2 = sp[2], s3 = sp[3];
                const float tot = ((s0[0] + s0[1]) + (s0[2] + s0[3])) + ((s1[0] + s1[1]) + (s1[2] + s1[3])) + ((s2[0] + s2[1]) + (s2[2] + s2[3])) + ((s3[0] + s3[1]) + (s3[2] + s3[3]));
                const float rinv = rsqrtf(tot * (1.0f / 1024.0f) + 1e-6f);
#pragma unroll
                for (int bj = 0; bj < 2; ++bj) {
                    const int col = u.pn * 256 + bj * 128 + wc * 32 + 8 * fq;
                    const f32x4 v0 = acc[ai][bj][m][0] * rinv, v1 = acc[ai][bj][m][1] * rinv;
                    u32x4 w; w.x = pk2(v0[0], v0[1]); w.y = pk2(v0[2], v0[3]); w.z = pk2(v1[0], v1[1]); w.w = pk2(v1[2], v1[3]);
                    *(u32x4*)(O + (size_t)row * ldc + col) = w;
                }
            }
    }
};
struct EpiProj {
    bf16_t* O; bf16_t* VT; const float* ss;
    __device__ __forceinline__ void operator()(AccRef acc, const Unit& u, int wr, int wc, int fr, int fq) const {
#pragma unroll
        for (int ai = 0; ai < 2; ++ai)
#pragma unroll
            for (int m = 0; m < 4; ++m) {
                const int row = u.pm * 256 + ai * 128 + wr * 64 + m * 16 + fr;
                const f32x4* sp = (const f32x4*)(ss + (size_t)row * 16);
                const f32x4 s0 = sp[0], s1 = sp[1], s2 = sp[2], s3 = sp[3];
                const float tot = ((s0[0] + s0[1]) + (s0[2] + s0[3])) + ((s1[0] + s1[1]) + (s1[2] + s1[3])) + ((s2[0] + s2[1]) + (s2[2] + s2[3])) + ((s3[0] + s3[1]) + (s3[2] + s3[3]));
                const float rinv = rsqrtf(tot * (1.0f / 1024.0f) + 1e-6f);
#pragma unroll
                for (int bj = 0; bj < 2; ++bj) {
                    const int col = u.pn * 256 + bj * 128 + wc * 32 + 8 * fq;
                    const f32x4 v0 = acc[ai][bj][m][0] * rinv, v1 = acc[ai][bj][m][1] * rinv;
                    u32x4 w; w.x = pk2(v0[0], v0[1]); w.y = pk2(v0[2], v0[3]); w.z = pk2(v1[0], v1[1]); w.w = pk2(v1[2], v1[3]);
                    if (u.pn < 11) *(u32x4*)(O + (size_t)row * INW + col) = w;
                    else {
                        const int cv = col - 2816;
                        bf16_t* vp = VT + ((size_t)((row >> 11) * 8 + (cv >> 6)) * 64 + (cv & 63)) * 2048 + (row & 2047);
#pragma unroll
                        for (int e = 0; e < 4; ++e) { vp[(size_t)(2 * e) * 2048] = (bf16_t)(w[e] & 0xffffu); vp[(size_t)(2 * e + 1) * 2048] = (bf16_t)(w[e] >> 16); }
                    }
                }
            }
    }
};
struct EpiRes {
    float* X; bf16_t* XB; float* SS;
    __device__ __forceinline__ void operator()(AccRef acc, const Unit& u, int wr, int wc, int fr, int fq) const {
#pragma unroll
        for (int ai = 0; ai < 2; ++ai)
#pragma unroll
            for (int m = 0; m < 4; ++m) {
                const int row = u.pm * 256 + ai * 128 + wr * 64 + m * 16 + fr;
                float sq = 0.f;
#pragma unroll
                for (int bj = 0; bj < 2; ++bj) {
                    const int col = u.pn * 256 + bj * 128 + wc * 32 + 8 * fq;
                    float* xp = X + (size_t)row * 1024 + col;
                    f32x4 x0 = *(const f32x4*)xp, x1 = *(const f32x4*)(xp + 4);
                    x0 += acc[ai][bj][m][0]; x1 += acc[ai][bj][m][1];
                    *(f32x4*)xp = x0; *(f32x4*)(xp + 4) = x1;
                    u32x4 w; w.x = pk2(x0[0], x0[1]); w.y = pk2(x0[2], x0[3]); w.z = pk2(x1[0], x1[1]); w.w = pk2(x1[2], x1[3]);
                    *(u32x4*)(XB + (size_t)row * 1024 + col) = w;
                    sq += (x0[0] * x0[0] + x0[1] * x0[1]) + (x0[2] * x0[2] + x0[3] * x0[3]) + (x1[0] * x1[0] + x1[1] * x1[1]) + (x1[2] * x1[2] + x1[3] * x1[3]);
                }
                sq += __shfl_xor(sq, 16); sq += __shfl_xor(sq, 32);
                if (fq == 0) SS[(size_t)row * 16 + u.pn * 4 + wc] = sq;
            }
    }
};
struct EpiGU {
    bf16_t* H;
    __device__ __forceinline__ void operator()(AccRef acc, const Unit& u, int wr, int wc, int fr, int fq) const {
#pragma unroll
        for (int ai = 0; ai < 2; ++ai)
#pragma unroll
            for (int m = 0; m < 4; ++m) {
                const int row = u.pm * 256 + ai * 128 + wr * 64 + m * 16 + fr;
                float h[8];
#pragma unroll
                for (int n = 0; n < 2; ++n)
#pragma unroll
                    for (int j = 0; j < 4; ++j) { const float gt = acc[ai][0][m][n][j], up = acc[ai][1][m][n][j]; h[n * 4 + j] = gt * __builtin_amdgcn_rcpf(1.0f + __expf(-gt)) * up; }
                u32x4 w; w.x = pk2(h[0], h[1]); w.y = pk2(h[2], h[3]); w.z = pk2(h[4], h[5]); w.w = pk2(h[6], h[7]);
                *(u32x4*)(H + (size_t)row * 512 + u.pn * 128 + wc * 32 + 8 * fq) = w;
            }
    }
};
struct EpiDown {
    bf16_t* Y; const int* slot; const float* sw;
    __device__ __forceinline__ void operator()(AccRef acc, const Unit& u, int wr, int wc, int fr, int fq) const {
#pragma unroll
        for (int ai = 0; ai < 2; ++ai)
#pragma unroll
            for (int m = 0; m < 4; ++m) {
                const int row = u.pm * 256 + ai * 128 + wr * 64 + m * 16 + fr;
                const int s = slot[row]; const float wgt = sw[row];
                if (s >= 0) {
#pragma unroll
                    for (int bj = 0; bj < 2; ++bj) {
                        const int col = u.pn * 256 + bj * 128 + wc * 32 + 8 * fq;
                        const f32x4 v0 = acc[ai][bj][m][0] * wgt, v1 = acc[ai][bj][m][1] * wgt;
                        u32x4 w; w.x = pk2(v0[0], v0[1]); w.y = pk2(v0[2], v0[3]); w.z = pk2(v1[0], v1[1]); w.w = pk2(v1[2], v1[3]);
                        *(u32x4*)(Y + (size_t)s * 1024 + col) = w;
                    }
                }
            }
    }
};
}

#define WSP(type, off) ((type*)(a.ws + (off)))
__device__ __forceinline__ int oblk() { int t = blockIdx.x; asm volatile("" : "+s"(t)); return t; }
__device__ __forceinline__ int ogrid() { int t = gridDim.x; asm volatile("" : "+s"(t)); return t; }
__device__ __forceinline__ int otid() { int t = threadIdx.x; asm volatile("" : "+v"(t)); return t; }
constexpr int LDS_INTAB = LDS_MISC + 14336;
__device__ __forceinline__ const float* ldsin(LAS unsigned char* lds, int i) {
    const unsigned long long p = ((const LAS unsigned long long*)(lds + LDS_INTAB))[i];
    const unsigned lo = __builtin_amdgcn_readfirstlane((unsigned)p), hi = __builtin_amdgcn_readfirstlane((unsigned)(p >> 32));
    return (const float*)(__attribute__((address_space(1))) const float*)(((unsigned long long)hi << 32) | lo);
}
#define INP(i) ldsin(lds, (i))

template <int MAP>
__device__ __forceinline__ void conv_slab(const float* __restrict__ src, int N, int Kper, bf16_t* __restrict__ dst, size_t estride,
                                          const float* __restrict__ gain, int goff, LAS float* tile, int slab) {
    const int tid = otid();
    const int nsn = N >> 8;
    const int kt = slab / nsn, ns = slab - kt * nsn, k0 = kt * 64, n0 = ns * 256;
    const int e = k0 / Kper, kl0 = k0 - e * Kper;
    f32x4 v[8];
#pragma unroll
    for (int i = 0; i < 8; ++i) { const int idx = tid + i * 512, kk = idx >> 6, n4 = (idx & 63) * 4; v[i] = *(const f32x4*)(src + (size_t)(k0 + kk) * N + n0 + n4); }
#pragma unroll
    for (int i = 0; i < 8; ++i) {
        const int idx = tid + i * 512, kk = idx >> 6, n4 = (idx & 63) * 4;
        float gsc = 1.0f;
        if (gain != nullptr && kl0 + kk >= goff) gsc = gain[kl0 + kk - goff];
        LAS float* tp = tile + kk * 257 + n4;
        tp[0] = v[i][0] * gsc; tp[1] = v[i][1] * gsc; tp[2] = v[i][2] * gsc; tp[3] = v[i][3] * gsc;
    }
    __syncthreads();
#pragma unroll
    for (int i = 0; i < 4; ++i) {
        const int p = tid + i * 512, nn = p >> 3, kg = p & 7;
        float x[8];
#pragma unroll
        for (int j = 0; j < 8; ++j) x[j] = tile[(kg * 8 + j) * 257 + nn];
        const int n = n0 + nn;
        const int nr = (MAP == 0) ? n : ((n >> 7) * 256 + (n & 127) + (MAP == 2 ? 128 : 0));
        u32x4 w; w.x = pk2(x[0], x[1]); w.y = pk2(x[2], x[3]); w.z = pk2(x[4], x[5]); w.w = pk2(x[6], x[7]);
        *(u32x4*)(dst + (size_t)e * estride + (size_t)nr * Kper + kl0 + kg * 8) = w;
    }
    __syncthreads();
}
template <int MAP>
__device__ __forceinline__ void conv_T(const float* __restrict__ src, int Ktot, int N, int Kper, bf16_t* __restrict__ dst, size_t estride,
                                       const float* __restrict__ gain, int goff, LAS float* tile) {
    const int nslab = (Ktot >> 6) * (N >> 8);
    for (int sl = oblk(); sl < nslab; sl += ogrid()) conv_slab<MAP>(src, N, Kper, dst, estride, gain, goff, tile, sl);
}
constexpr int MOE_CONV_ITEMS = 3 * 128;
__device__ __forceinline__ void moe_convert_item(const PA a, int l, LAS unsigned char* lds, int item) {
    LAS float* tile = (LAS float*)lds;
    const int which = item >> 7, s0 = (item & 127) * 8;
    const float* gn = INP(30) + l * 1024;
    for (int sl = s0; sl < s0 + 8; ++sl) {
        if (which == 0)      conv_slab<1>(INP(35) + (size_t)l * 32 * 1024 * 512, 512, 1024, WSP(bf16_t, WS_WGU), (size_t)1024 * 1024, gn, 0, tile, sl);
        else if (which == 1) conv_slab<2>(INP(36) + (size_t)l * 32 * 1024 * 512, 512, 1024, WSP(bf16_t, WS_WGU), (size_t)1024 * 1024, gn, 0, tile, sl);
        else                 conv_slab<0>(INP(37) + (size_t)l * 32 * 512 * 1024, 1024, 512, WSP(bf16_t, WS_WD), (size_t)1024 * 512, nullptr, 0, tile, sl);
    }
}

__device__ __forceinline__ void rows_convert(const float* __restrict__ src, float* __restrict__ dstf, bf16_t* __restrict__ dstb, float* __restrict__ ss, int nrows) {
    const int wave = otid() >> 6, lane = otid() & 63;
    for (int r = oblk() * 8 + wave; r < nrows; r += ogrid() * 8) {
        float sq = 0.f;
#pragma unroll
        for (int i = 0; i < 4; ++i) {
            const int c = i * 256 + lane * 4;
            const f32x4 v = *(const f32x4*)(src + (size_t)r * 1024 + c);
            if (dstf) *(f32x4*)(dstf + (size_t)r * 1024 + c) = v;
            u32x2 w; w.x = pk2(v[0], v[1]); w.y = pk2(v[2], v[3]);
            *(u32x2*)(dstb + (size_t)r * 1024 + c) = w;
            sq += (v[0] * v[0] + v[1] * v[1]) + (v[2] * v[2] + v[3] * v[3]);
        }
        sq = wsum(sq);
        if (lane < 16) ss[(size_t)r * 16 + lane] = (lane == 0) ? sq : 0.f;
    }
}

__device__ __forceinline__ void p0_prologue(const PA a, LAS unsigned char* lds) {
    LAS float* tile = (LAS float*)lds;
    for (int l = 0; l < NL; ++l) {
        conv_T<0>(INP(3) + (size_t)l * 1024 * INW, 1024, INW, 1024, WSP(bf16_t, WS_WIN) + (size_t)l * INW * 1024, 0, INP(2) + l * 1024, 0, tile);
        conv_T<0>(INP(22) + (size_t)l * 1024 * 1024, 1024, 1024, 1024, WSP(bf16_t, WS_WOUT) + (size_t)l * 1024 * 1024, 0, INP(21) + l * 512, 512, tile);
        conv_T<0>(INP(25) + (size_t)l * 1024 * 512, 1024, 512, 1024, WSP(bf16_t, WS_WQ) + (size_t)l * 512 * 1024, 0, INP(23) + l * 1024, 0, tile);
        conv_T<0>(INP(26) + (size_t)l * 1024 * 1024, 1024, 1024, 1024, WSP(bf16_t, WS_WKV) + (size_t)l * 1024 * 1024, 0, INP(24) + l * 1024, 0, tile);
        conv_T<0>(INP(27) + (size_t)l * 512 * 1024, 512, 1024, 512, WSP(bf16_t, WS_WO) + (size_t)l * 1024 * 512, 0, nullptr, 0, tile);
    }
    {
        bf16_t* wrh = WSP(bf16_t, WS_WRH); bf16_t* wrl = WSP(bf16_t, WS_WRL);
        for (int idx = oblk() * 512 + otid(); idx < NL * 48 * 1024; idx += ogrid() * 512) {
            const int k = idx & 1023, r = (idx >> 10) % 48, l = idx / (48 * 1024);
            float w;
            if (r < 16) w = INP(31)[((size_t)l * 1024 + k) * 4 + (r & 3)];
            else { const int ri = ((r >> 2) & 3) * 8 + ((r >> 4) - 1) * 4 + (r & 3); w = INP(33)[((size_t)l * 1024 + k) * 32 + ri]; }
            w *= INP(30)[l * 1024 + k];
            const bf16_t hi = f2bf(w);
            wrh[idx] = hi; wrl[idx] = f2bf(w - bf2f(hi));
        }
    }
    rows_convert(INP(0), a.out, WSP(bf16_t, WS_XB), WSP(float, WS_SS), T);
    rows_convert(INP(1), nullptr, WSP(bf16_t, WS_MEMB), WSP(float, WS_MEMSS), MROWS);
}

__device__ __forceinline__ void p2_knorm(const PA a, LAS unsigned char* lds) {
    const int wave = otid() >> 6, lane = otid() & 63;
    bf16_t* kv = WSP(bf16_t, WS_KV);
    for (int it = oblk() * 8 + wave; it < NL * MROWS * 4; it += ogrid() * 8) {
        const int h = it & 3, row = (it >> 2) & (MROWS - 1), l = it >> 14;
        unsigned* p = (unsigned*)(kv + ((size_t)l * MROWS + row) * 1024 + h * 128 + lane * 2);
        const unsigned w = *p; const float x0 = lo16(w), x1 = hi16(w);
        const float ssq = wsum(x0 * x0 + x1 * x1);
        const float rinv = rsqrtf(ssq * (1.0f / 128.0f) + 1e-6f);
        const float* gk = INP(29) + l * 128 + lane * 2;
        *p = pk2(x0 * rinv * gk[0], x1 * rinv * gk[1]);
    }
    bf16_t* vtx = WSP(bf16_t, WS_VTX);
    const int tid = otid();
    for (int it = oblk(); it < NL * 16 * 4; it += ogrid()) {
        const int h = it & 3, b = (it >> 2) & 15, l = it >> 6;
        const bf16_t* src = kv + ((size_t)l * MROWS + b * 256) * 1024 + 512 + h * 128;
        bf16_t* dst = vtx + (size_t)it * 128 * 256;
#pragma unroll 1
        for (int i = 0; i < 8; ++i) {
            const int p = tid + i * 512, d = p & 127, m8 = (p >> 7) * 8;
            unsigned short x[8];
#pragma unroll
            for (int j = 0; j < 8; ++j) x[j] = src[(size_t)(m8 + j) * 1024 + d];
            u32x4 w; w.x = x[0] | ((unsigned)x[1] << 16); w.y = x[2] | ((unsigned)x[3] << 16); w.z = x[4] | ((unsigned)x[5] << 16); w.w = x[6] | ((unsigned)x[7] << 16);
            *(u32x4*)(dst + (size_t)d * 256 + m8) = w;
        }
    }
}

__device__ __forceinline__ float fast_tanh(float x) { return 1.0f - 2.0f * __builtin_amdgcn_rcpf(1.0f + __expf(2.0f * x)); }
__device__ __forceinline__ float fast_sigmoid(float x) { return __builtin_amdgcn_rcpf(1.0f + __expf(-x)); }
template <int MODE>
__device__ __forceinline__ bf16x8 mixfrag(const bf16_t* pu, const bf16_t* pp, float hpf, const LAS float* mu, int col) {
    const u32x4 u = *(const u32x4*)(pu + col), p = *(const u32x4*)(pp + col);
    const f32x4 m0 = *(const LAS f32x4*)(mu + col), m1 = *(const LAS f32x4*)(mu + col + 4);
    float x[8];
#pragma unroll
    for (int j = 0; j < 4; ++j) {
        const float u0 = lo16(u[j]), u1 = hi16(u[j]), p0 = lo16(p[j]) * hpf, p1 = hi16(p[j]) * hpf;
        const float ma = (j < 2) ? m0[2 * j] : m1[2 * j - 4], mb = (j < 2) ? m0[2 * j + 1] : m1[2 * j - 3];
        x[2 * j] = u0 + ma * (p0 - u0); x[2 * j + 1] = u1 + mb * (p1 - u1);
    }
#pragma unroll
    for (int j = 0; j < 8; ++j) { if (MODE == 1) x[j] = fast_tanh(x[j]); if (MODE == 2) x[j] = fast_sigmoid(x[j]); }
    u32x4 w; w.x = pk2(x[0], x[1]); w.y = pk2(x[2], x[3]); w.z = pk2(x[4], x[5]); w.w = pk2(x[6], x[7]);
    return __builtin_bit_cast(bf16x8, w);
}
__device__ __forceinline__ void pb_prep(const PA a, int l, LAS unsigned char* lds) {
    const int tid = otid(), wave = tid >> 6, lane = tid & 63, fr = lane & 15, fq = lane >> 4;
    const int G = ogrid(), blk = oblk();
    LAS bf16_t* s_w2 = (LAS bf16_t*)lds;
    LAS bf16_t* s_a2 = (LAS bf16_t*)(lds + 18432);
    LAS bf16_t* s_g2 = (LAS bf16_t*)(lds + 36864);
    LAS bf16_t* s_v2 = (LAS bf16_t*)(lds + 71680);
    LAS bf16_t* s_v1 = (LAS bf16_t*)(lds + 81920);
    LAS float* s_par = (LAS float*)(lds + 115200);
    LAS float* s_mux = s_par + 1024;
    bf16_t* proj = WSP(bf16_t, WS_PROJ);
    const float* mu = INP(4) + l * 1792;
    const float* w0 = INP(5) + l * 512;  const float* w2 = INP(6) + (size_t)l * 64 * 512;
    const float* a0 = INP(7) + l * 512;  const float* a2 = INP(8) + (size_t)l * 64 * 512;
    const float* g2 = INP(9) + (size_t)l * 128 * 512;
    const float* kkw = INP(10) + l * 512; const float* kaw = INP(11) + l * 512;
    const int lv = l > 0 ? l - 1 : 0;
    const float* v0 = INP(15) + lv * 512; const float* v1 = INP(16) + (size_t)lv * 512 * 32; const float* v2 = INP(17) + (size_t)lv * 32 * 512;
    const float* qgn = INP(18) + l * 64; const float* kgn = INP(19) + l * 64;
    bf16_t* SR = WSP(bf16_t, WS_SR); bf16_t* SK = WSP(bf16_t, WS_SK); bf16_t* SV = WSP(bf16_t, WS_SV);
    bf16_t* SA = WSP(bf16_t, WS_SA); bf16_t* SB = WSP(bf16_t, WS_SB); bf16_t* SG = WSP(bf16_t, WS_SG);
    float* SWD = WSP(float, WS_SWD); bf16_t* VF = WSP(bf16_t, WS_VF);
    int cur_hp = -1;
    for (int item = blk; item < 4 * (T / 128); item += G) {
        const int hp = item & 3, tt = item >> 2;
        if (hp != cur_hp) {
            __syncthreads();
            const int chb = hp * 128;
            for (int idx = tid; idx < 64 * 128; idx += 512) { const int ch = idx & 127, k = idx >> 7;
                s_w2[ch * 72 + k] = f2bf(w2[k * 512 + chb + ch]); s_a2[ch * 72 + k] = f2bf(a2[k * 512 + chb + ch]); }
            for (int idx = tid; idx < 128 * 128; idx += 512) { const int ch = idx & 127, k = idx >> 7; s_g2[ch * 136 + k] = f2bf(g2[k * 512 + chb + ch]); }
            if (l > 0) {
                for (int idx = tid; idx < 32 * 128; idx += 512) { const int ch = idx & 127, k = idx >> 7; s_v2[ch * 40 + k] = f2bf(v2[k * 512 + chb + ch]); }
                for (int idx = tid; idx < 512 * 32; idx += 512) { const int n = idx & 31, k = idx >> 5; s_v1[n * 520 + k] = f2bf(v1[k * 32 + n]); }
            }
            if (tid < 128) { s_par[tid] = mu[chb + tid]; s_par[128 + tid] = mu[512 + chb + tid]; s_par[256 + tid] = mu[1024 + chb + tid]; s_par[384 + tid] = w0[chb + tid];
                             s_par[512 + tid] = a0[chb + tid]; s_par[640 + tid] = kkw[chb + tid]; s_par[768 + tid] = kaw[chb + tid]; s_par[896 + tid] = v0[chb + tid]; }
            for (int idx = tid; idx < 768; idx += 512) s_mux[idx] = mu[1024 + idx];
            __syncthreads();
            cur_hp = hp;
        }
        const int t = tt * 128 + wave * 16 + fr;
        const bool hpv = (t & (SEQ - 1)) != 0;
        const bf16_t* pu = proj + (size_t)t * INW;
        const bf16_t* pp = hpv ? pu - INW : pu;
        const float hpf = hpv ? 1.0f : 0.0f;
        bf16x8 fwl[2], fal[2], fgl[4], ft32;
#pragma unroll
        for (int s = 0; s < 2; ++s) { fwl[s] = mixfrag<1>(pu, pp, hpf, s_mux - 1024, 1536 + 32 * s + 8 * fq); fal[s] = mixfrag<0>(pu, pp, hpf, s_mux - 1024, 1600 + 32 * s + 8 * fq); }
#pragma unroll
        for (int s = 0; s < 4; ++s) fgl[s] = mixfrag<2>(pu, pp, hpf, s_mux - 1024, 1664 + 32 * s + 8 * fq);
        ft32 = fwl[0];
        if (l > 0) {
            f32x4 c0 = {0.f, 0.f, 0.f, 0.f}, c1 = {0.f, 0.f, 0.f, 0.f};
#pragma unroll 8
            for (int s = 0; s < 16; ++s) {
                const bf16x8 xf = mixfrag<0>(pu, pp, hpf, s_mux - 1024, 1024 + 32 * s + 8 * fq);
                const bf16x8 wa = *(const LAS bf16x8*)(s_v1 + fr * 520 + 32 * s + 8 * fq), wb = *(const LAS bf16x8*)(s_v1 + (16 + fr) * 520 + 32 * s + 8 * fq);
                c0 = __builtin_amdgcn_mfma_f32_16x16x32_bf16(wa, xf, c0, 0, 0, 0);
                c1 = __builtin_amdgcn_mfma_f32_16x16x32_bf16(wb, xf, c1, 0, 0, 0);
            }
            u32x4 w; w.x = pk2(c0[0], c0[1]); w.y = pk2(c0[2], c0[3]); w.z = pk2(c1[0], c1[1]); w.w = pk2(c1[2], c1[3]);
            ft32 = __builtin_bit_cast(bf16x8, w);
        }
#pragma unroll 1
        for (int hh = 0; hh < 2; ++hh) {
            float kkv[4][4], avv[4][4];
            float kss = 0.f;
            u32x2 Lur[4], Lpr[4], Luk[4], Lpk[4], Luv[4], Lpv[4], Lvf[4];
#pragma unroll
            for (int nt = 0; nt < 4; ++nt) {
                const int ch4 = hp * 128 + hh * 64 + nt * 16 + 4 * fq;
                Lur[nt] = *(const u32x2*)(pu + ch4); Lpr[nt] = *(const u32x2*)(pp + ch4);
                Luk[nt] = *(const u32x2*)(pu + 512 + ch4); Lpk[nt] = *(const u32x2*)(pp + 512 + ch4);
                Luv[nt] = *(const u32x2*)(pu + 1024 + ch4); Lpv[nt] = *(const u32x2*)(pp + 1024 + ch4);
                Lvf[nt] = (l > 0) ? *(const u32x2*)(VF + (size_t)t * 512 + ch4) : (u32x2){0u, 0u};
            }
#pragma unroll
            for (int nt = 0; nt < 4; ++nt) {
                const int lc = hh * 64 + nt * 16, ch4 = hp * 128 + lc + 4 * fq;
                f32x4 aw = {0.f, 0.f, 0.f, 0.f}, aa = aw, ag = aw, az = aw;
#pragma unroll
                for (int s = 0; s < 2; ++s) {
                    aw = __builtin_amdgcn_mfma_f32_16x16x32_bf16(*(const LAS bf16x8*)(s_w2 + (lc + fr) * 72 + 32 * s + 8 * fq), fwl[s], aw, 0, 0, 0);
                    aa = __builtin_amdgcn_mfma_f32_16x16x32_bf16(*(const LAS bf16x8*)(s_a2 + (lc + fr) * 72 + 32 * s + 8 * fq), fal[s], aa, 0, 0, 0);
                }
#pragma unroll
                for (int s = 0; s < 4; ++s) ag = __builtin_amdgcn_mfma_f32_16x16x32_bf16(*(const LAS bf16x8*)(s_g2 + (lc + fr) * 136 + 32 * s + 8 * fq), fgl[s], ag, 0, 0, 0);
                if (l > 0) {
                    const u32x2 q0 = *(const LAS u32x2*)(s_v2 + (lc + fr) * 40 + 4 * fq), q1 = *(const LAS u32x2*)(s_v2 + (lc + fr) * 40 + 16 + 4 * fq);
                    u32x4 w; w.x = q0.x; w.y = q0.y; w.z = q1.x; w.w = q1.y;
                    az = __builtin_amdgcn_mfma_f32_16x16x32_bf16(__builtin_bit_cast(bf16x8, w), ft32, az, 0, 0, 0);
                }
                const u32x2 ur = Lur[nt], pr = Lpr[nt], uk = Luk[nt], pk = Lpk[nt], uv = Luv[nt], pv = Lpv[nt];
                const int pc4 = lc + 4 * fq;
                const f32x4 mr = *(const LAS f32x4*)(s_par + pc4), mk = *(const LAS f32x4*)(s_par + 128 + pc4), mv = *(const LAS f32x4*)(s_par + 256 + pc4);
                const f32x4 w0v = *(const LAS f32x4*)(s_par + 384 + pc4), a0v = *(const LAS f32x4*)(s_par + 512 + pc4), kkwv = *(const LAS f32x4*)(s_par + 640 + pc4), kawv = *(const LAS f32x4*)(s_par + 768 + pc4);
                float xr[4], xk[4], xv[4];
                { const float u0 = lo16(ur.x), u1 = hi16(ur.x), u2 = lo16(ur.y), u3 = hi16(ur.y);
                  xr[0] = u0 + mr[0] * (lo16(pr.x) * hpf - u0); xr[1] = u1 + mr[1] * (hi16(pr.x) * hpf - u1); xr[2] = u2 + mr[2] * (lo16(pr.y) * hpf - u2); xr[3] = u3 + mr[3] * (hi16(pr.y) * hpf - u3); }
                { const float u0 = lo16(uk.x), u1 = hi16(uk.x), u2 = lo16(uk.y), u3 = hi16(uk.y);
                  xk[0] = u0 + mk[0] * (lo16(pk.x) * hpf - u0); xk[1] = u1 + mk[1] * (hi16(pk.x) * hpf - u1); xk[2] = u2 + mk[2] * (lo16(pk.y) * hpf - u2); xk[3] = u3 + mk[3] * (hi16(pk.y) * hpf - u3); }
                { const float u0 = lo16(uv.x), u1 = hi16(uv.x), u2 = lo16(uv.y), u3 = hi16(uv.y);
                  xv[0] = u0 + mv[0] * (lo16(pv.x) * hpf - u0); xv[1] = u1 + mv[1] * (hi16(pv.x) * hpf - u1); xv[2] = u2 + mv[2] * (lo16(pv.y) * hpf - u2); xv[3] = u3 + mv[3] * (hi16(pv.y) * hpf - u3); }
                const size_t o = (size_t)t * 512 + ch4;
                if (l > 0) {
                    const f32x4 v0v = *(const LAS f32x4*)(s_par + 896 + pc4);
                    const u32x2 vfw = Lvf[nt];
                    const float vf0 = lo16(vfw.x), vf1 = hi16(vfw.x), vf2 = lo16(vfw.y), vf3 = hi16(vfw.y);
                    xv[0] += (vf0 - xv[0]) * fast_sigmoid(v0v[0] + az[0]); xv[1] += (vf1 - xv[1]) * fast_sigmoid(v0v[1] + az[1]);
                    xv[2] += (vf2 - xv[2]) * fast_sigmoid(v0v[2] + az[2]); xv[3] += (vf3 - xv[3]) * fast_sigmoid(v0v[3] + az[3]);
                } else {
                    u32x2 w; w.x = pk2(xv[0], xv[1]); w.y = pk2(xv[2], xv[3]); *(u32x2*)(VF + o) = w;
                }
                f32x4 dec; float kmod[4];
#pragma unroll
                for (int j = 0; j < 4; ++j) {
                    dec[j] = __expf(-0.6065306597f * fast_sigmoid(w0v[j] + aw[j]));
                    const float av = fast_sigmoid(a0v[j] + aa[j]);
                    const float kk = xk[j] * kkwv[j];
                    kkv[nt][j] = kk; avv[nt][j] = av; kss += kk * kk;
                    kmod[j] = xk[j] * (1.0f + (av - 1.0f) * kawv[j]);
                }
                { u32x2 w; w.x = pk2(xr[0], xr[1]); w.y = pk2(xr[2], xr[3]); *(u32x2*)(SR + o) = w; }
                { u32x2 w; w.x = pk2(xv[0], xv[1]); w.y = pk2(xv[2], xv[3]); *(u32x2*)(SV + o) = w; }
                { u32x2 w; w.x = pk2(ag[0], ag[1]); w.y = pk2(ag[2], ag[3]); *(u32x2*)(SG + o) = w; }
                { u32x2 w; w.x = pk2(kmod[0], kmod[1]); w.y = pk2(kmod[2], kmod[3]); *(u32x2*)(SK + o) = w; }
                *(f32x4*)(SWD + o) = dec;
            }
            kss += __shfl_xor(kss, 16); kss += __shfl_xor(kss, 32);
            const float rn = rsqrtf(fmaxf(kss, 1e-24f));
#pragma unroll
            for (int nt = 0; nt < 4; ++nt) {
                const size_t o = (size_t)t * 512 + hp * 128 + hh * 64 + nt * 16 + 4 * fq;
                float kn[4];
#pragma unroll
                for (int j = 0; j < 4; ++j) kn[j] = kkv[nt][j] * rn;
                { u32x2 w; w.x = pk2(-kn[0], -kn[1]); w.y = pk2(-kn[2], -kn[3]); *(u32x2*)(SA + o) = w; }
                { u32x2 w; w.x = pk2(kn[0] * avv[nt][0], kn[1] * avv[nt][1]); w.y = pk2(kn[2] * avv[nt][2], kn[3] * avv[nt][3]); *(u32x2*)(SB + o) = w; }
            }
        }
        {
            u32x4 Lq[4][2];
#pragma unroll
            for (int qk = 0; qk < 4; ++qk) {
                const bf16_t* p = proj + (size_t)t * INW + 1792 + (qk & 1) * 512 + (hp * 2 + (qk >> 1)) * 64 + fq * 16;
                Lq[qk][0] = *(const u32x4*)p; Lq[qk][1] = *(const u32x4*)(p + 8);
            }
#pragma unroll
            for (int qk = 0; qk < 4; ++qk) {
                const float* gn = (qk & 1) ? kgn : qgn;
                bf16_t* p = proj + (size_t)t * INW + 1792 + (qk & 1) * 512 + (hp * 2 + (qk >> 1)) * 64 + fq * 16;
                const u32x4 wa = Lq[qk][0], wb = Lq[qk][1];
                float x[16];
#pragma unroll
                for (int j = 0; j < 4; ++j) { x[2 * j] = lo16(wa[j]); x[2 * j + 1] = hi16(wa[j]); x[8 + 2 * j] = lo16(wb[j]); x[9 + 2 * j] = hi16(wb[j]); }
                float ssq = 0.f;
#pragma unroll
                for (int j = 0; j < 16; ++j) ssq += x[j] * x[j];
                ssq += __shfl_xor(ssq, 16); ssq += __shfl_xor(ssq, 32);
                const float rinv = rsqrtf(ssq * (1.0f / 64.0f) + 1e-6f);
                const float qsc = (qk & 1) ? rinv : rinv * 0.18033688011112042f;
#pragma unroll
                for (int j = 0; j < 16; ++j) x[j] = x[j] * qsc * gn[fq * 16 + j];
                u32x4 oa, ob;
#pragma unroll
                for (int j = 0; j < 4; ++j) { oa[j] = pk2(x[2 * j], x[2 * j + 1]); ob[j] = pk2(x[8 + 2 * j], x[9 + 2 * j]); }
                *(u32x4*)p = oa; *(u32x4*)(p + 8) = ob;
            }
        }
    }
    __syncthreads();
}

__device__ __forceinline__ void pb2_chunks(const PA a, int l, LAS unsigned char* lds) {
    const int tid = otid(), wave = tid >> 6, lane = tid & 63, fr = lane & 15, fq = lane >> 4;
    LAS bf16_t* sA = (LAS bf16_t*)(lds + wave * 11520);
    LAS bf16_t* sR = sA + 1152; LAS bf16_t* sB = sR + 1152; LAS bf16_t* sK = sB + 1152; LAS bf16_t* sX = sK + 1152;
    LAS float* nb = (LAS float*)(lds + 8 * 11520) + wave * 256;
    bf16_t* SR = WSP(bf16_t, WS_SR); bf16_t* SK = WSP(bf16_t, WS_SK); bf16_t* SV = WSP(bf16_t, WS_SV);
    bf16_t* SA = WSP(bf16_t, WS_SA); bf16_t* SB = WSP(bf16_t, WS_SB); const float* SWD = WSP(const float, WS_SWD);
    const float* rkp = INP(12) + l * 512;
    for (int cid = oblk() * 8 + wave; cid < NCHUNK; cid += ogrid() * 8) {
        const int b = cid >> 10, h = (cid >> 7) & 7, c = cid & 127;
        const size_t tok0 = (size_t)b * SEQ + c * 16;
        const size_t e0 = tok0 * 512 + h * 64 + lane;
        const float rkv = rkp[h * 64 + lane];
        const int posl = (lane & 32) | (((lane & 15) >> 2) << 3) | (((lane >> 4) & 1) << 2) | (lane & 3);
        float P = 1.0f;
        unsigned bt2[8], kt2[8], vt2[8];
#pragma unroll
        for (int hf = 0; hf < 2; ++hf) {
            bf16_t r16[8], k16[8], a16[8], b16[8], v16[8]; float w32[8];
#pragma unroll
            for (int t8 = 0; t8 < 8; ++t8) { const size_t e = e0 + (size_t)(hf * 8 + t8) * 512; r16[t8] = SR[e]; k16[t8] = SK[e]; a16[t8] = SA[e]; b16[t8] = SB[e]; v16[t8] = SV[e]; w32[t8] = SWD[e]; }
#pragma unroll
            for (int t8 = 0; t8 < 8; ++t8) {
                const int t = hf * 8 + t8;
                const float rr = bf2f(r16[t8]), kk = bf2f(k16[t8]), aa = bf2f(a16[t8]), bb = bf2f(b16[t8]);
                const float Pm = P; P *= w32[t8]; const float ip = 1.0f / P;
                const unsigned ar = pk2(aa * Pm, rr * P), bk = pk2(bb * ip, kk * ip);
                const bf16_t at = (bf16_t)(ar & 0xffffu), rt = (bf16_t)(ar >> 16), btv = (bf16_t)(bk & 0xffffu), ktv = (bf16_t)(bk >> 16);
                { const size_t es = tok0 * 512 + (size_t)t * 512 + h * 64 + (posl ^ ((t & 7) << 3)); SA[es] = at; SR[es] = rt; }
                sA[t * 72 + lane] = at; sR[t * 72 + lane] = rt; sB[t * 72 + lane] = btv; sK[t * 72 + lane] = ktv;
                sX[t * 72 + lane] = (bf16_t)(pk2(rr * kk * rkv, 0.f) & 0xffffu);
                if (t & 1) { bt2[t >> 1] |= (unsigned)btv << 16; kt2[t >> 1] |= (unsigned)ktv << 16; vt2[t >> 1] |= (unsigned)v16[t8] << 16; }
                else       { bt2[t >> 1] = btv; kt2[t >> 1] = ktv; vt2[t >> 1] = v16[t8]; }
            }
        }
        WSP(float, WS_PCK)[(size_t)cid * 64 + lane] = P;
        {
            u32x4* pb_ = (u32x4*)(WSP(bf16_t, WS_BTT) + (size_t)cid * 2048 + lane * 32);
            u32x4* pv_ = (u32x4*)(WSP(bf16_t, WS_VST) + (size_t)cid * 1024 + lane * 16);
#pragma unroll
            for (int q = 0; q < 4; ++q) pb_[q] = (u32x4){bt2[2 * q], bt2[2 * q + 1], kt2[2 * q], kt2[2 * q + 1]};
            pv_[0] = (u32x4){vt2[0], vt2[1], vt2[2], vt2[3]}; pv_[1] = (u32x4){vt2[4], vt2[5], vt2[6], vt2[7]};
        }
        bf16x8 fA[2], fR[2], fB[2], fK[2], fX[2];
#pragma unroll
        for (int s_ = 0; s_ < 2; ++s_) {
            fA[s_] = *(const LAS bf16x8*)(sA + fr * 72 + 32 * s_ + 8 * fq); fR[s_] = *(const LAS bf16x8*)(sR + fr * 72 + 32 * s_ + 8 * fq);
            fB[s_] = *(const LAS bf16x8*)(sB + fr * 72 + 32 * s_ + 8 * fq); fK[s_] = *(const LAS bf16x8*)(sK + fr * 72 + 32 * s_ + 8 * fq);
            fX[s_] = *(const LAS bf16x8*)(sX + fr * 72 + 32 * s_ + 8 * fq);
        }
        const f32x4 z4 = {0.f, 0.f, 0.f, 0.f};
        const bf16x8 ones = {0x3f80, 0x3f80, 0x3f80, 0x3f80, 0x3f80, 0x3f80, 0x3f80, 0x3f80};
        const f32x4 nka = __builtin_amdgcn_mfma_f32_16x16x32_bf16(fA[1], fK[1], __builtin_amdgcn_mfma_f32_16x16x32_bf16(fA[0], fK[0], z4, 0, 0, 0), 0, 0, 0);
        const f32x4 nbr = __builtin_amdgcn_mfma_f32_16x16x32_bf16(fR[1], fB[1], __builtin_amdgcn_mfma_f32_16x16x32_bf16(fR[0], fB[0], z4, 0, 0, 0), 0, 0, 0);
        const f32x4 nkr = __builtin_amdgcn_mfma_f32_16x16x32_bf16(fR[1], fK[1], __builtin_amdgcn_mfma_f32_16x16x32_bf16(fR[0], fK[0], z4, 0, 0, 0), 0, 0, 0);
        const f32x4 nba = __builtin_amdgcn_mfma_f32_16x16x32_bf16(fB[1], fA[1], __builtin_amdgcn_mfma_f32_16x16x32_bf16(fB[0], fA[0], z4, 0, 0, 0), 0, 0, 0);
        const f32x4 bsm = __builtin_amdgcn_mfma_f32_16x16x32_bf16(fX[1], ones, __builtin_amdgcn_mfma_f32_16x16x32_bf16(fX[0], ones, z4, 0, 0, 0), 0, 0, 0);
        bf16_t* gim = WSP(bf16_t, WS_NKA) + (size_t)cid * 1024;
        const int ncol = (fr >> 2) * 8 + (fr & 3);
#pragma unroll
        for (int j = 0; j < 4; ++j) {
            const int row = 4 * fq + j;
            gim[row * 32 + ncol + 4] = f2bf(fr < row ? nka[j] : 0.f);
            gim[512 + row * 32 + ncol] = f2bf(fr <= row ? nbr[j] : 0.f);
            gim[512 + row * 32 + ncol + 4] = f2bf(fr <= row ? nkr[j] : 0.f);
            nb[row * 16 + fr] = (row < fr) ? nba[j] : 0.f;
            if (fr == 0) WSP(float, WS_BS)[(tok0 + row) * 8 + h] = bsm[j];
        }
        if (lane < 16) {
            float X[16];
            bf16_t* gtm = WSP(bf16_t, WS_NKA) + (size_t)cid * 1024; const int tcolp = (lane >> 2) * 8 + (lane & 3);
#pragma unroll
            for (int tcol = 0; tcol < 16; ++tcol) {
                float acc = (lane == tcol) ? 1.0f : 0.0f;
#pragma unroll
                for (int i = 0; i < tcol; ++i) acc += X[i] * nb[i * 16 + tcol];
                X[tcol] = acc;
                gtm[tcol * 32 + tcolp] = f2bf(acc);
            }
        }
    }
    __syncthreads();
}

__device__ __forceinline__ void scan_item(const PA a, int l, int bh, LAS unsigned char* lds) {
    const int tid = otid(), wave = __builtin_amdgcn_readfirstlane(tid >> 6), lane = tid & 63, fr = lane & 15, fq = lane >> 4;
    const int b = __builtin_amdgcn_readfirstlane(bh >> 3), h = __builtin_amdgcn_readfirstlane(bh & 7);
    constexpr int SLOT = 15104, NS = 8, DPF = 6;
    constexpr int OA = 0, OR_ = 2048, OBK = 4096, OVT = 8192, ON = 10240, OPC = 12288, OBS = 12544, OSG = 13056;
    constexpr int YBO = NS * SLOT;
    const size_t tokb = (size_t)b * SEQ;
    const int cid0 = (b * 8 + h) * 128;
    const unsigned char* gA = (const unsigned char*)WSP(const bf16_t, WS_SA); const unsigned char* gR = (const unsigned char*)WSP(const bf16_t, WS_SR);
    const unsigned char* gG = (const unsigned char*)WSP(const bf16_t, WS_SG);
    const unsigned char* gBK = (const unsigned char*)WSP(const bf16_t, WS_BTT);
    const unsigned char* gVT = (const unsigned char*)WSP(const bf16_t, WS_VST); const unsigned char* gN = (const unsigned char*)WSP(const bf16_t, WS_NKA);
    const unsigned char* gPC = (const unsigned char*)WSP(const float, WS_PCK); const unsigned char* gBS = (const unsigned char*)WSP(const float, WS_BS);
#define DMA16(gp, ldsoff) __builtin_amdgcn_global_load_lds((const unsigned*)(gp), (LAS unsigned*)(lds + (ldsoff)), 16, 0, 0)
    const unsigned rowoff0 = (unsigned)(((lane >> 3) * 512 + (lane & 7) * 8) * 2), rowoff1 = rowoff0 + 8u * 512u * 2u;
#define DMA_CHUNK(c_) do { const int cid_ = cid0 + (c_); const int so_ = ((c_) % NS) * SLOT; \
        const size_t rb_ = ((tokb + (size_t)(c_) * 16) * 512 + h * 64) * 2; \
        if (wave == 4) { \
            DMA16(gA + rb_ + rowoff0, so_ + OA); DMA16(gA + rb_ + rowoff1, so_ + OA + 1024); DMA16(gR + rb_ + rowoff0, so_ + OR_); DMA16(gR + rb_ + rowoff1, so_ + OR_ + 1024); \
            DMA16(gBK + (size_t)cid_ * 4096 + lane * 16, so_ + OBK); DMA16(gBK + (size_t)cid_ * 4096 + 1024 + lane * 16, so_ + OBK + 1024); \
            DMA16(gBK + (size_t)cid_ * 4096 + 2048 + lane * 16, so_ + OBK + 2048); DMA16(gBK + (size_t)cid_ * 4096 + 3072 + lane * 16, so_ + OBK + 3072); \
            if (lane < 16) DMA16(gPC + (size_t)cid_ * 256 + lane * 16, so_ + OPC); \
        } else { \
            DMA16(gVT + (size_t)cid_ * 2048 + lane * 16, so_ + OVT); DMA16(gVT + (size_t)cid_ * 2048 + 1024 + lane * 16, so_ + OVT + 1024); \
            DMA16(gN + (size_t)cid_ * 2048 + lane * 16, so_ + ON); DMA16(gN + (size_t)cid_ * 2048 + 1024 + lane * 16, so_ + ON + 1024); \
            DMA16(gG + rb_ + rowoff0, so_ + OSG); DMA16(gG + rb_ + rowoff1, so_ + OSG + 1024); \
            if (lane < 32) DMA16(gBS + (tokb + (size_t)(c_) * 16) * 32 + lane * 16, so_ + OBS); \
            if (lane < 1) DMA16(gPC + (size_t)cid_ * 256, so_ + OPC); if (lane < 1) DMA16(gPC + (size_t)cid_ * 256, so_ + OPC); \
        } } while (0)
#define MF(a_, b_, c_) __builtin_amdgcn_mfma_f32_16x16x32_bf16((a_), (b_), (c_), 0, 0, 0)
#define LDF(off_) (*(const LAS bf16x8*)(sl + (off_)))
    const int swz = fr & 7;
    const int aoff0 = fr * 128 + ((fq) ^ swz) * 16, aoff1 = fr * 128 + ((4 + fq) ^ swz) * 16;
    const int noff = fr * 64 + fq * 16, voff = ((wave & 3) * 16 + fr) * 32 + 8 * fq;
    const float lw = INP(13)[l * 512 + h * 64 + lane], lb = INP(14)[l * 512 + h * 64 + lane];
    bf16_t* YC = WSP(bf16_t, WS_YCAT);
#define SCAN_EPI(cp_) do { const int cp = (cp_); \
        const unsigned slb = (unsigned)(unsigned long long)(lds + (cp % NS) * SLOT), ybb = (unsigned)(unsigned long long)(lds + YBO + (cp & 1) * 4352); \
          \
        f32x4 y0, y1, y2, y3; { const unsigned ya = ybb + fr * 272 + fq * 32; \
            asm volatile("ds_read_b128 %0, %4\n\tds_read_b128 %1, %4 offset:16\n\tds_read_b128 %2, %4 offset:128\n\tds_read_b128 %3, %4 offset:144\n\ts_waitcnt lgkmcnt(0)" \
                         : "=&v"(y0), "=&v"(y1), "=&v"(y2), "=&v"(y3) : "v"(ya) : "memory"); } \
        u32x4 f0, f1, g0, g1; \
        f0.x = pk2(y0[0], y0[1]); f0.y = pk2(y0[2], y0[3]); f0.z = pk2(y1[0], y1[1]); f0.w = pk2(y1[2], y1[3]); f1.x = pk2(y2[0], y2[1]); f1.y = pk2(y2[2], y2[3]); f1.z = pk2(y3[0], y3[1]); f1.w = pk2(y3[2], y3[3]); \
        g0.x = pk2(y0[0] * y0[0], y0[1] * y0[1]); g0.y = pk2(y0[2] * y0[2], y0[3] * y0[3]); g0.z = pk2(y1[0] * y1[0], y1[1] * y1[1]); g0.w = pk2(y1[2] * y1[2], y1[3] * y1[3]); \
        g1.x = pk2(y2[0] * y2[0], y2[1] * y2[1]); g1.y = pk2(y2[2] * y2[2], y2[3] * y2[3]); g1.z = pk2(y3[0] * y3[0], y3[1] * y3[1]); g1.w = pk2(y3[2] * y3[2], y3[3] * y3[3]); \
        const bf16x8 ones = {0x3f80, 0x3f80, 0x3f80, 0x3f80, 0x3f80, 0x3f80, 0x3f80, 0x3f80}; const f32x4 z4 = {0.f, 0.f, 0.f, 0.f}; \
        const f32x4 ssum = MF(__builtin_bit_cast(bf16x8, f1), ones, MF(__builtin_bit_cast(bf16x8, f0), ones, z4));        \
        const f32x4 sqsm = MF(__builtin_bit_cast(bf16x8, g1), ones, MF(__builtin_bit_cast(bf16x8, g0), ones, z4)); \
        float eY[8], eB[8]; unsigned eV[8], eG[8]; \
        _Pragma("unroll") for (int i = 0; i < 8; ++i) { const int t = (wave - 6) * 8 + i; \
            const unsigned ay_ = ybb + (t * 68 + lane) * 4, ab_ = slb + OBS + t * 32 + h * 4, av_ = slb + OVT + lane * 32 + t * 2, ag_ = slb + OSG + t * 128 + lane * 2; \
            asm volatile("ds_read_b32 %0, %4\n\tds_read_b32 %1, %5\n\tds_read_u16 %2, %6\n\tds_read_u16 %3, %7" \
                         : "=&v"(eY[i]), "=&v"(eB[i]), "=&v"(eV[i]), "=&v"(eG[i]) : "v"(ay_), "v"(ab_), "v"(av_), "v"(ag_) : "memory"); } \
        asm volatile("s_waitcnt lgkmcnt(0)" ::: "memory"); \
        _Pragma("unroll") for (int i = 0; i < 8; ++i) { \
            asm volatile("" : "+v"(eY[i]), "+v"(eB[i]), "+v"(eV[i]), "+v"(eG[i])); \
            const int t = (wave - 6) * 8 + i; const size_t tok = tokb + (size_t)cp * 16 + t; \
            const float tsum = __int_as_float(__builtin_amdgcn_readlane(__float_as_int(ssum[i & 3]), ((wave - 6) * 2 + (i >> 2)) * 16)); \
            const float tsq = __int_as_float(__builtin_amdgcn_readlane(__float_as_int(sqsm[i & 3]), ((wave - 6) * 2 + (i >> 2)) * 16)); \
            const float mean = tsum * (1.0f / 64.0f); \
            const float var = fmaxf(tsq * (1.0f / 64.0f) - mean * mean, 0.f); \
            const float vv = __uint_as_float(eV[i] << 16), g = __uint_as_float(eG[i] << 16); \
            const float yn = (eY[i] - mean) * rsqrtf(var + 64e-5f) * lw + lb; \
            YC[tok * 1024 + h * 64 + lane] = (bf16_t)(pk2((yn + eB[i] * vv) * g, 0.f) & 0xffffu); } } while (0)
    f32x4 S[4];
#pragma unroll
    for (int kt = 0; kt < 4; ++kt) S[kt] = (f32x4){0.f, 0.f, 0.f, 0.f};
    __syncthreads();
    if (wave == 4 || wave == 5) {
#pragma unroll 1
        for (int c = 0; c < DPF; ++c) DMA_CHUNK(c);
        asm volatile("s_waitcnt vmcnt(0)" ::: "memory");
    }
    __syncthreads();
#pragma unroll 1
    for (int c = 0; c < 128; ++c) {
        if (wave < 4) {
            const LAS unsigned char* sl = lds + (c % NS) * SLOT;
            u32x4 s0w, s1w; s0w.x = pk2(S[0][0], S[0][1]); s0w.y = pk2(S[0][2], S[0][3]); s0w.z = pk2(S[1][0], S[1][1]); s0w.w = pk2(S[1][2], S[1][3]);
            s1w.x = pk2(S[2][0], S[2][1]); s1w.y = pk2(S[2][2], S[2][3]); s1w.z = pk2(S[3][0], S[3][1]); s1w.w = pk2(S[3][2], S[3][3]);
            const bf16x8 Sf0 = __builtin_bit_cast(bf16x8, s0w), Sf1 = __builtin_bit_cast(bf16x8, s1w);
            const u32x2 vm = *(const LAS u32x2*)(sl + OVT + voff);
            const bf16x8 TN = LDF(ON + noff), BN = LDF(ON + 1024 + noff);
            const f32x4 z4 = {0.f, 0.f, 0.f, 0.f};
            const bf16x8 ZV = __builtin_bit_cast(bf16x8, (u32x4){0u, 0u, vm.x, vm.y});
            f32x4 Wt = MF(LDF(OA + aoff0), Sf0, z4); Wt = MF(LDF(OA + aoff1), Sf1, Wt); Wt = MF(TN, ZV, Wt);
            const bf16x8 WZ = __builtin_bit_cast(bf16x8, (u32x4){pk2(Wt[0], Wt[1]), pk2(Wt[2], Wt[3]), 0u, 0u});
            const f32x4 Ut = MF(TN, WZ, z4);
            const bf16x8 UV = __builtin_bit_cast(bf16x8, (u32x4){pk2(Ut[0], Ut[1]), pk2(Ut[2], Ut[3]), vm.x, vm.y});
            f32x4 Yt = MF(LDF(OR_ + aoff0), Sf0, z4); Yt = MF(LDF(OR_ + aoff1), Sf1, Yt); Yt = MF(BN, UV, Yt);
#pragma unroll
            for (int kt = 0; kt < 4; ++kt) {
                const f32x4 pc = *(const LAS f32x4*)(sl + OPC + (kt * 16 + 4 * fq) * 4);
                S[kt] = MF(LDF(OBK + kt * 1024 + noff), UV, S[kt]) * pc;
            }
            LAS float* yb = (LAS float*)(lds + YBO + (c & 1) * 4352) + (wave & 3) * 16 + fr;
#pragma unroll
            for (int j = 0; j < 4; ++j) yb[(4 * fq + j) * 68] = Yt[j];
            asm volatile("s_waitcnt lgkmcnt(0)" ::: "memory");
        } else if (wave < 6) {
            if (c + DPF < 128) DMA_CHUNK(c + DPF);
            if (c >= DPF && c + DPF < 128) asm volatile("s_waitcnt vmcnt(45)" ::: "memory"); else asm volatile("s_waitcnt vmcnt(0)" ::: "memory");
        } else if (c > 0) {
            SCAN_EPI(c - 1);
        }
        asm volatile("" ::: "memory"); __builtin_amdgcn_s_barrier(); asm volatile("" ::: "memory");
    }
    if (wave >= 6) { SCAN_EPI(127); }
    asm volatile("s_waitcnt vmcnt(0)" ::: "memory");
    __syncthreads();
#undef SCAN_EPI
#undef DMA16
#undef DMA_CHUNK
#undef MF
#undef LDF
}

__device__ __forceinline__ void attn_item(const PA a, int l, int it, LAS unsigned char* lds) {
    const int tid = otid(), h = tid >> 6, lane = tid & 63, fr = lane & 15, fq = lane >> 4;
    const int b = it >> 5, c = it & 31;
    LAS float* s_bias = (LAS float*)(lds + LDS_MISC + 1024);
    LAS float* s_part = s_bias + 8 * 320;
    const bf16_t* proj = WSP(const bf16_t, WS_PROJ);
    const bf16_t* VT = WSP(const bf16_t, WS_VT) + (size_t)(b * 8 + h) * 64 * 2048;
    const size_t tq0 = (size_t)b * SEQ + c * 64;
    bf16x8 qf[4][2];
#pragma unroll
    for (int nt = 0; nt < 4; ++nt)
#pragma unroll
        for (int ks = 0; ks < 2; ++ks) qf[nt][ks] = *(const bf16x8*)(proj + (tq0 + nt * 16 + fr) * INW + 1792 + h * 64 + 32 * ks + 8 * fq);
    f32x4 o[4][4];
#pragma unroll
    for (int dt = 0; dt < 4; ++dt)
#pragma unroll
        for (int nt = 0; nt < 4; ++nt) o[dt][nt] = (f32x4){0.f, 0.f, 0.f, 0.f};
    float lsum[4] = {0.f, 0.f, 0.f, 0.f};
    const int kc0 = c - 8 > 0 ? c - 8 : 0;
    const int nsteps = (c - kc0 + 1) * 2;
    bf16x8 kf[2][2], kn[2][2]; u32x4 vf[4], vn[4];
#define ATT_LOAD(KF, VF, st) do { const int key0 = (kc0 * 64 + (st) * 32); const size_t tk = (size_t)b * SEQ + key0; \
        _Pragma("unroll") for (int mt = 0; mt < 2; ++mt) _Pragma("unroll") for (int ks = 0; ks < 2; ++ks) \
            KF[mt][ks] = *(const bf16x8*)(proj + (tk + mt * 16 + fr) * INW + 2304 + h * 64 + 32 * ks + 8 * fq); \
        _Pragma("unroll") for (int dt = 0; dt < 4; ++dt) { const bf16_t* vp = VT + (size_t)(dt * 16 + fr) * 2048 + key0 + 4 * fq; \
            const u32x2 v0 = *(const u32x2*)vp, v1 = *(const u32x2*)(vp + 16); VF[dt].x = v0.x; VF[dt].y = v0.y; VF[dt].z = v1.x; VF[dt].w = v1.y; } } while (0)
    ATT_LOAD(kf, vf, 0);
    for (int st = 0; st < nsteps; ++st) {
        const bool more = st + 1 < nsteps;
        if (more) ATT_LOAD(kn, vn, st + 1);
        f32x4 sacc[2][4];
#pragma unroll
        for (int mt = 0; mt < 2; ++mt)
#pragma unroll
            for (int nt = 0; nt < 4; ++nt) {
                f32x4 z = {0.f, 0.f, 0.f, 0.f};
                z = __builtin_amdgcn_mfma_f32_16x16x32_bf16(kf[mt][0], qf[nt][0], z, 0, 0, 0);
                sacc[mt][nt] = __builtin_amdgcn_mfma_f32_16x16x32_bf16(kf[mt][1], qf[nt][1], z, 0, 0, 0);
            }
        const int dk = c - (kc0 + (st >> 1)), half = st & 1;
        if (dk >= 5) {
            const float bc = s_bias[h * 320 + 319];
#pragma unroll
            for (int mt = 0; mt < 2; ++mt)
#pragma unroll
                for (int nt = 0; nt < 4; ++nt) sacc[mt][nt] += bc;
        } else {
#pragma unroll
            for (int mt = 0; mt < 2; ++mt)
#pragma unroll
                for (int nt = 0; nt < 4; ++nt)
#pragma unroll
                    for (int j = 0; j < 4; ++j) {
                        int idx = (nt * 16 + fr) - (half * 32 + mt * 16 + 4 * fq + j) + dk * 64; idx = idx > 256 ? 256 : idx;
                        sacc[mt][nt][j] += s_bias[h * 320 + idx + 63];
                    }
        }
        bf16x8 pf[4];
#pragma unroll
        for (int nt = 0; nt < 4; ++nt) {
            float p[8];
#pragma unroll
            for (int j = 0; j < 4; ++j) { p[j] = __builtin_amdgcn_exp2f(fminf(sacc[0][nt][j], 80.f)); p[4 + j] = __builtin_amdgcn_exp2f(fminf(sacc[1][nt][j], 80.f)); }
            lsum[nt] += ((p[0] + p[1]) + (p[2] + p[3])) + ((p[4] + p[5]) + (p[6] + p[7]));
            u32x4 w; w.x = pk2(p[0], p[1]); w.y = pk2(p[2], p[3]); w.z = pk2(p[4], p[5]); w.w = pk2(p[6], p[7]);
            pf[nt] = __builtin_bit_cast(bf16x8, w);
        }
#pragma unroll
        for (int dt = 0; dt < 4; ++dt)
#pragma unroll
            for (int nt = 0; nt < 4; ++nt) o[dt][nt] = __builtin_amdgcn_mfma_f32_16x16x32_bf16(__builtin_bit_cast(bf16x8, vf[dt]), pf[nt], o[dt][nt], 0, 0, 0);
        if (more) {
#pragma unroll
            for (int mt = 0; mt < 2; ++mt)
#pragma unroll
                for (int ks = 0; ks < 2; ++ks) kf[mt][ks] = kn[mt][ks];
#pragma unroll
            for (int dt = 0; dt < 4; ++dt) vf[dt] = vn[dt];
        }
    }
#undef ATT_LOAD
    float ssq[4];
#pragma unroll
    for (int nt = 0; nt < 4; ++nt) {
        float ls = lsum[nt]; ls += __shfl_xor(ls, 16); ls += __shfl_xor(ls, 32);
        const float inv = 1.0f / ls;
        float sq = 0.f;
#pragma unroll
        for (int dt = 0; dt < 4; ++dt) { o[dt][nt] *= inv; sq += (o[dt][nt][0] * o[dt][nt][0] + o[dt][nt][1] * o[dt][nt][1]) + (o[dt][nt][2] * o[dt][nt][2] + o[dt][nt][3] * o[dt][nt][3]); }
        sq += __shfl_xor(sq, 16); sq += __shfl_xor(sq, 32);
        ssq[nt] = sq;
        if (fq == 0) s_part[h * 64 + nt * 16 + fr] = sq;
    }
    __syncthreads();
#pragma unroll
    for (int nt = 0; nt < 4; ++nt) {
        float tot = 0.f;
#pragma unroll
        for (int hh = 0; hh < 8; ++hh) tot += s_part[hh * 64 + nt * 16 + fr];
        const float rinv = rsqrtf(tot * (1.0f / 512.0f) + 1e-6f);
        bf16_t* yp = WSP(bf16_t, WS_YCAT) + (tq0 + nt * 16 + fr) * 1024 + 512 + h * 64 + 4 * fq;
#pragma unroll
        for (int dt = 0; dt < 4; ++dt) { u32x2 w; w.x = pk2(o[dt][nt][0] * rinv, o[dt][nt][1] * rinv); w.y = pk2(o[dt][nt][2] * rinv, o[dt][nt][3] * rinv); *(u32x2*)(yp + dt * 16) = w; }
    }
    __syncthreads();
}

__device__ __forceinline__ void pc_mixer(const PA a, int l, LAS unsigned char* lds) {
    const int tid = otid();
    LAS float* s_bias = (LAS float*)(lds + LDS_MISC + 1024);
    volatile LAS int* s_item = (volatile LAS int*)(lds + LDS_MISC + 64);
    for (int i = tid; i < 8 * 320; i += 512) s_bias[i] = INP(20)[l * 8 * 320 + i] * 1.4426950408889634f;
    unsigned* qhead = WSP(unsigned, WS_CTL) + CW_QUEUE + l * 64;
    for (;;) {
        __syncthreads();
        if (tid == 0) *s_item = (int)__hip_atomic_fetch_add(qhead, 1u, __ATOMIC_RELAXED, __HIP_MEMORY_SCOPE_AGENT);
        __syncthreads();
        const int item = __builtin_amdgcn_readfirstlane(*s_item);
        if (item >= 128 + 512 + MOE_CONV_ITEMS) break;
        if (item < 128) scan_item(a, l, item, lds);
        else if (item < 128 + 512) attn_item(a, l, item - 128, lds);
        else moe_convert_item(a, l, lds, item - 640);
    }
}

__device__ __forceinline__ void pe2_xattn(const PA a, int l, LAS unsigned char* lds) {
    const int tid = otid(), wave = tid >> 6, lane = tid & 63, fr = lane & 15, fq = lane >> 4;
    LAS bf16_t* sK = (LAS bf16_t*)lds;
    LAS bf16_t* sV = (LAS bf16_t*)(lds + 69632);
    const bf16_t* QX = WSP(const bf16_t, WS_QX); bf16_t* OX = WSP(bf16_t, WS_OX);
    const bf16_t* KV = WSP(const bf16_t, WS_KV) + (size_t)l * MROWS * 1024;
    const bf16_t* VTX = WSP(const bf16_t, WS_VTX) + (size_t)l * MROWS * 512;
    const float* qgn = INP(28) + l * 128;
    for (int it = oblk(); it < 256; it += ogrid()) {
        const int b = it >> 4, h = (it >> 2) & 3, qr = it & 3;
        __syncthreads();
#pragma unroll
        for (int i = 0; i < 8; ++i) {
            const int p = tid + i * 512, r = p >> 4, c8 = (p & 15) * 8;
            *(LAS u32x4*)(sK + r * 136 + c8) = *(const u32x4*)(KV + (size_t)(b * 256 + r) * 1024 + h * 128 + c8);
            const int d = p >> 5, m8 = (p & 31) * 8;
            *(LAS u32x4*)(sV + d * 264 + m8) = *(const u32x4*)(VTX + ((size_t)(b * 4 + h) * 128 + d) * 256 + m8);
        }
        __syncthreads();
#pragma unroll 1
        for (int iter = 0; iter < 2; ++iter) {
            const size_t q0 = (size_t)b * SEQ + qr * 512 + iter * 256 + wave * 32;
            bf16x8 qf[2][4];
#pragma unroll
            for (int nt = 0; nt < 2; ++nt) {
                const bf16_t* qp = QX + (q0 + nt * 16 + fr) * 512 + h * 128 + 8 * fq;
                u32x4 w[4]; float ssq = 0.f;
#pragma unroll
                for (int ks = 0; ks < 4; ++ks) { w[ks] = *(const u32x4*)(qp + 32 * ks);
#pragma unroll
                    for (int j = 0; j < 4; ++j) { const float x0 = lo16(w[ks][j]), x1 = hi16(w[ks][j]); ssq += x0 * x0 + x1 * x1; } }
                ssq += __shfl_xor(ssq, 16); ssq += __shfl_xor(ssq, 32);
                const float sc = rsqrtf(ssq * (1.0f / 128.0f) + 1e-6f) * 0.12751743f;
#pragma unroll
                for (int ks = 0; ks < 4; ++ks) {
                    const f32x4 g0 = *(const f32x4*)(qgn + 32 * ks + 8 * fq), g1 = *(const f32x4*)(qgn + 32 * ks + 8 * fq + 4);
                    u32x4 ow;
                    ow.x = pk2(lo16(w[ks][0]) * sc * g0[0], hi16(w[ks][0]) * sc * g0[1]); ow.y = pk2(lo16(w[ks][1]) * sc * g0[2], hi16(w[ks][1]) * sc * g0[3]);
                    ow.z = pk2(lo16(w[ks][2]) * sc * g1[0], hi16(w[ks][2]) * sc * g1[1]); ow.w = pk2(lo16(w[ks][3]) * sc * g1[2], hi16(w[ks][3]) * sc * g1[3]);
                    qf[nt][ks] = __builtin_bit_cast(bf16x8, ow);
                }
            }
            f32x4 o[8][2];
#pragma unroll
            for (int dt = 0; dt < 8; ++dt) { o[dt][0] = (f32x4){0.f, 0.f, 0.f, 0.f}; o[dt][1] = (f32x4){0.f, 0.f, 0.f, 0.f}; }
            float lsum[2] = {0.f, 0.f};
#pragma unroll 2
            for (int st = 0; st < 8; ++st) {
                const int k0 = st * 32;
                f32x4 sacc[2][2];
#pragma unroll
                for (int mt = 0; mt < 2; ++mt) {
                    sacc[mt][0] = (f32x4){0.f, 0.f, 0.f, 0.f}; sacc[mt][1] = (f32x4){0.f, 0.f, 0.f, 0.f};
#pragma unroll
                    for (int ks = 0; ks < 4; ++ks) {
                        const bf16x8 kfr = *(const LAS bf16x8*)(sK + (k0 + mt * 16 + fr) * 136 + 32 * ks + 8 * fq);
                        sacc[mt][0] = __builtin_amdgcn_mfma_f32_16x16x32_bf16(kfr, qf[0][ks], sacc[mt][0], 0, 0, 0);
                        sacc[mt][1] = __builtin_amdgcn_mfma_f32_16x16x32_bf16(kfr, qf[1][ks], sacc[mt][1], 0, 0, 0);
                    }
                }
                bf16x8 pf[2];
#pragma unroll
                for (int nt = 0; nt < 2; ++nt) {
                    float p[8];
#pragma unroll
                    for (int j = 0; j < 4; ++j) { p[j] = __builtin_amdgcn_exp2f(fminf(sacc[0][nt][j], 80.f)); p[4 + j] = __builtin_amdgcn_exp2f(fminf(sacc[1][nt][j], 80.f)); }
                    lsum[nt] += ((p[0] + p[1]) + (p[2] + p[3])) + ((p[4] + p[5]) + (p[6] + p[7]));
                    u32x4 w; w.x = pk2(p[0], p[1]); w.y = pk2(p[2], p[3]); w.z = pk2(p[4], p[5]); w.w = pk2(p[6], p[7]);
                    pf[nt] = __builtin_bit_cast(bf16x8, w);
                }
#pragma unroll
                for (int dt = 0; dt < 8; ++dt) {
                    const LAS bf16_t* vp = sV + (dt * 16 + fr) * 264 + k0 + 4 * fq;
                    const u32x2 v0 = *(const LAS u32x2*)vp, v1 = *(const LAS u32x2*)(vp + 16);
                    u32x4 w; w.x = v0.x; w.y = v0.y; w.z = v1.x; w.w = v1.y;
                    const bf16x8 vfr = __builtin_bit_cast(bf16x8, w);
                    o[dt][0] = __builtin_amdgcn_mfma_f32_16x16x32_bf16(vfr, pf[0], o[dt][0], 0, 0, 0);
                    o[dt][1] = __builtin_amdgcn_mfma_f32_16x16x32_bf16(vfr, pf[1], o[dt][1], 0, 0, 0);
                }
            }
#pragma unroll
            for (int nt = 0; nt < 2; ++nt) {
                float ls = lsum[nt]; ls += __shfl_xor(ls, 16); ls += __shfl_xor(ls, 32);
                const float inv = 1.0f / ls;
                bf16_t* op = OX + (q0 + nt * 16 + fr) * 512 + h * 128 + 4 * fq;
#pragma unroll
                for (int dt = 0; dt < 8; ++dt) { u32x2 w; w.x = pk2(o[dt][nt][0] * inv, o[dt][nt][1] * inv); w.y = pk2(o[dt][nt][2] * inv, o[dt][nt][3] * inv); *(u32x2*)(op + dt * 16) = w; }
            }
        }
    }
    __syncthreads();
}

__device__ __forceinline__ void pf_router(const PA a, int l, LAS unsigned char* lds) {
    const int tid = otid(), wave = tid >> 6, lane = tid & 63, fr = lane & 15, fq = lane >> 4;
    LAS int* s_cnt = (LAS int*)lds;
    LAS int* s_base = s_cnt + 32;
    LAS int* s_e = s_base + 32;
    LAS int* s_rk = s_e + 256;
    LAS float* s_w = (LAS float*)(s_rk + 256);
    const float* X = a.out; const float* SS = WSP(const float, WS_SS);
    const bf16_t* wrh = WSP(const bf16_t, WS_WRH) + (size_t)l * 48 * 1024; const bf16_t* wrl = WSP(const bf16_t, WS_WRL) + (size_t)l * 48 * 1024;
    const float* bg = INP(32) + l * 4; const float* br = INP(34) + l * 32;
    int* EID = WSP(int, WS_EID); float* EW = WSP(float, WS_EW); int* ERK = WSP(int, WS_ERK);
    unsigned* cnt = WSP(unsigned, WS_CTL) + CW_CNT + l * 32;
    for (int tile = oblk(); tile < T / 128; tile += ogrid()) {
        __syncthreads();
        if (tid < 32) s_cnt[tid] = 0;
        __syncthreads();
        const int t = tile * 128 + wave * 16 + fr;
        f32x4 acc[3];
#pragma unroll
        for (int mt = 0; mt < 3; ++mt) acc[mt] = (f32x4){0.f, 0.f, 0.f, 0.f};
        const float* xr = X + (size_t)t * 1024 + 8 * fq;
#pragma unroll 8
        for (int s_ = 0; s_ < 32; ++s_) {
            const f32x4 x0 = *(const f32x4*)(xr + 32 * s_), x1 = *(const f32x4*)(xr + 32 * s_ + 4);
            u32x4 hw; hw.x = pk2(x0[0], x0[1]); hw.y = pk2(x0[2], x0[3]); hw.z = pk2(x1[0], x1[1]); hw.w = pk2(x1[2], x1[3]);
            u32x4 lw; lw.x = pk2(x0[0] - lo16(hw.x), x0[1] - hi16(hw.x)); lw.y = pk2(x0[2] - lo16(hw.y), x0[3] - hi16(hw.y));
            lw.z = pk2(x1[0] - lo16(hw.z), x1[1] - hi16(hw.z)); lw.w = pk2(x1[2] - lo16(hw.w), x1[3] - hi16(hw.w));
            const bf16x8 xh = __builtin_bit_cast(bf16x8, hw), xl = __builtin_bit_cast(bf16x8, lw);
#pragma unroll
            for (int mt = 0; mt < 3; ++mt) {
                const bf16x8 wh = *(const bf16x8*)(wrh + (size_t)(mt * 16 + fr) * 1024 + 32 * s_ + 8 * fq);
                const bf16x8 wl = *(const bf16x8*)(wrl + (size_t)(mt * 16 + fr) * 1024 + 32 * s_ + 8 * fq);
                acc[mt] = __builtin_amdgcn_mfma_f32_16x16x32_bf16(wh, xh, acc[mt], 0, 0, 0);
                acc[mt] = __builtin_amdgcn_mfma_f32_16x16x32_bf16(wh, xl, acc[mt], 0, 0, 0);
                acc[mt] = __builtin_amdgcn_mfma_f32_16x16x32_bf16(wl, xh, acc[mt], 0, 0, 0);
            }
        }
        const f32x4* sp = (const f32x4*)(SS + (size_t)t * 16);
        const f32x4 s0 = sp[0], s1 = sp[1], s2 = sp[2], s3 = sp[3];
        const float tot = ((s0[0] + s0[1]) + (s0[2] + s0[3])) + ((s1[0] + s1[1]) + (s1[2] + s1[3])) + ((s2[0] + s2[1]) + (s2[2] + s2[3])) + ((s3[0] + s3[1]) + (s3[2] + s3[3]));
        const float rinv = rsqrtf(tot * (1.0f / 1024.0f) + 1e-6f);
        float lg[4], lr[8];
#pragma unroll
        for (int j = 0; j < 4; ++j) { lg[j] = acc[0][j] * rinv + bg[j]; lr[j] = acc[1][j] * rinv + br[fq * 8 + j]; lr[4 + j] = acc[2][j] * rinv + br[fq * 8 + 4 + j]; }
        float g0 = lg[0]; int gt = 0;
#pragma unroll
        for (int j = 1; j < 4; ++j) { if (lg[j] > g0) { g0 = lg[j]; gt = j; } }
        if (fq == gt) {
            float gs = 0.f;
#pragma unroll
            for (int j = 0; j < 4; ++j) gs += __expf(lg[j] - g0);
            const float ggate = 1.0f / gs;
            float l1 = -1e30f, l2 = -1e30f; int j1 = 0, j2 = 0;
#pragma unroll
            for (int j = 0; j < 8; ++j) { const float v = lr[j];
                if (v > l1) { l2 = l1; j2 = j1; l1 = v; j1 = j; } else if (v > l2) { l2 = v; j2 = j; } }
            const float e2 = __expf(l2 - l1);
            const float p1 = 1.0f / (1.0f + e2), p2 = e2 / (1.0f + e2);
            const int e1i = gt * 8 + j1, e2i = gt * 8 + j2;
            const int r1 = atomicAdd((int*)(s_cnt + e1i), 1), r2 = atomicAdd((int*)(s_cnt + e2i), 1);
            const int sl = (wave * 16 + fr) * 2;
            s_e[sl] = e1i; s_e[sl + 1] = e2i; s_rk[sl] = r1; s_rk[sl + 1] = r2; s_w[sl] = ggate * p1; s_w[sl + 1] = ggate * p2;
        }
        __syncthreads();
        if (tid < 32) s_base[tid] = (int)__hip_atomic_fetch_add(cnt + tid, (unsigned)s_cnt[tid], __ATOMIC_RELAXED, __HIP_MEMORY_SCOPE_AGENT);
        __syncthreads();
        if (tid < 256) { const int e = s_e[tid]; const size_t o = (size_t)tile * 256 + tid; EID[o] = e; EW[o] = s_w[tid]; ERK[o] = s_base[e] + s_rk[tid]; }
    }
    __syncthreads();
}

__device__ __forceinline__ void pg_gather(const PA a, int l, LAS unsigned char* lds) {
    const int tid = otid(), wave = tid >> 6, lane = tid & 63;
    LAS int* s_ps = (LAS int*)lds;
    const unsigned* cnt = WSP(const unsigned, WS_CTL) + CW_CNT + l * 32;
    int* SSLOT = WSP(int, WS_SSLOT); float* SW = WSP(float, WS_SW); int* MTE = WSP(int, WS_MTE);
    bf16_t* XS = WSP(bf16_t, WS_XS); const bf16_t* XB = WSP(const bf16_t, WS_XB);
    const float* SS = WSP(const float, WS_SS);
    const int* EID = WSP(const int, WS_EID); const float* EW = WSP(const float, WS_EW); const int* ERK = WSP(const int, WS_ERK);
    __syncthreads();
    if (tid == 0) {
        int acc = 0;
        for (int e = 0; e < 32; ++e) { s_ps[e] = acc; const int c = (int)__hip_atomic_load(cnt + e, __ATOMIC_RELAXED, __HIP_MEMORY_SCOPE_AGENT); acc += ((c + 255) >> 8) << 8; }
        s_ps[32] = acc;
    }
    __syncthreads();
    if (oblk() == 0) {
        if (tid < 32) { const int m0 = s_ps[tid] >> 8, m1 = s_ps[tid + 1] >> 8; for (int mt = m0; mt < m1; ++mt) MTE[mt] = tid; }
        if (tid == 0) MTE[511] = s_ps[32] >> 8;
    }
    for (int e = oblk(); e < 32; e += ogrid()) {
        const int c = (int)__hip_atomic_load(cnt + e, __ATOMIC_RELAXED, __HIP_MEMORY_SCOPE_AGENT);
        const int r0 = s_ps[e] + c, r1 = s_ps[e + 1];
        for (int r = r0 + wave; r < r1; r += 8) {
            if (lane == 0) { SSLOT[r] = -1; SW[r] = 0.f; }
            unsigned zz = 0u; asm volatile("" : "+v"(zz));
            u32x4 z = {zz, zz, zz, zz};
            *(u32x4*)(XS + (size_t)r * 1024 + lane * 8) = z; *(u32x4*)(XS + (size_t)r * 1024 + 512 + lane * 8) = z;
        }
    }
    for (int t0 = (oblk() * 8 + wave) * 4; t0 < T; t0 += ogrid() * 32) {
        int e8 = 0, rk8 = 0; float w8 = 0.f;
        if (lane < 8) { e8 = EID[t0 * 2 + lane]; rk8 = ERK[t0 * 2 + lane]; w8 = EW[t0 * 2 + lane]; }
        const float ssl = SS[(size_t)t0 * 16 + lane];
        u32x4 xw[4][2];
#pragma unroll
        for (int q = 0; q < 4; ++q) { xw[q][0] = *(const u32x4*)(XB + (size_t)(t0 + q) * 1024 + lane * 8); xw[q][1] = *(const u32x4*)(XB + (size_t)(t0 + q) * 1024 + 512 + lane * 8); }
        float tot = ssl;
        tot += __shfl_xor(tot, 1); tot += __shfl_xor(tot, 2); tot += __shfl_xor(tot, 4); tot += __shfl_xor(tot, 8);
        int dest8 = 0;
        if (lane < 8) { dest8 = s_ps[e8] + rk8; SSLOT[dest8] = t0 * 2 + lane; SW[dest8] = w8; }
#pragma unroll
        for (int q = 0; q < 4; ++q) {
            const float rinv = rsqrtf(__shfl(tot, q * 16) * (1.0f / 1024.0f) + 1e-6f);
            u32x4 o0, o1;
#pragma unroll
            for (int j = 0; j < 4; ++j) { o0[j] = pk2(lo16(xw[q][0][j]) * rinv, hi16(xw[q][0][j]) * rinv); o1[j] = pk2(lo16(xw[q][1][j]) * rinv, hi16(xw[q][1][j]) * rinv); }
#pragma unroll
            for (int k = 0; k < 2; ++k) {
                const int dest = __shfl(dest8, q * 2 + k);
                *(u32x4*)(XS + (size_t)dest * 1024 + lane * 8) = o0; *(u32x4*)(XS + (size_t)dest * 1024 + 512 + lane * 8) = o1;
            }
        }
    }
}

__device__ __forceinline__ void pj_finalize(const PA a) {
    const int wave = otid() >> 6, lane = otid() & 63;
    float* X = a.out; bf16_t* XB = WSP(bf16_t, WS_XB); float* SS = WSP(float, WS_SS);
    const bf16_t* Y = WSP(const bf16_t, WS_Y);
    for (int t = oblk() * 8 + wave; t < T; t += ogrid() * 8) {
        float sq = 0.f;
#pragma unroll
        for (int i = 0; i < 4; ++i) {
            const int c = i * 256 + lane * 4;
            f32x4 v = *(const f32x4*)(X + (size_t)t * 1024 + c);
            const u32x2 y0 = *(const u32x2*)(Y + (size_t)(2 * t) * 1024 + c), y1 = *(const u32x2*)(Y + (size_t)(2 * t + 1) * 1024 + c);
            v[0] += lo16(y0.x) + lo16(y1.x); v[1] += hi16(y0.x) + hi16(y1.x); v[2] += lo16(y0.y) + lo16(y1.y); v[3] += hi16(y0.y) + hi16(y1.y);
            *(f32x4*)(X + (size_t)t * 1024 + c) = v;
            u32x2 w; w.x = pk2(v[0], v[1]); w.y = pk2(v[2], v[3]);
            *(u32x2*)(XB + (size_t)t * 1024 + c) = w;
            sq += (v[0] * v[0] + v[1] * v[1]) + (v[2] * v[2] + v[3] * v[3]);
        }
        sq = wsum(sq);
        if (lane < 16) SS[(size_t)t * 16 + lane] = (lane == 0) ? sq : 0.f;
    }
}

#define SITE static __device__ __forceinline__ void
#define OPAQUE() do { a.out = (float*)ldsin(lds, 38); a.ws = (unsigned char*)ldsin(lds, 39); } while (0)
__device__ __forceinline__ int opq(int v) { asm volatile("" : "+s"(v)); return v; }
SITE site_p0(PA a, LAS unsigned char* lds) { OPAQUE(); p0_prologue(a, lds); }
SITE site_kv(PA a, LAS unsigned char* lds) { OPAQUE();
    pg8::Gemm g{WSP(const bf16_t, WS_MEMB), WSP(const bf16_t, WS_WKV), 1024, (size_t)1024 * 1024};
    pg8::KvOrder S{opq((int)gridDim.x), opq((int)blockIdx.x)};
    pg8::EpiScale E{WSP(bf16_t, WS_KV), 1024, WSP(const float, WS_MEMSS), MROWS - 1};
    pg8::gemm_phase<pg8::EpiScale, pg8::KvOrder>(lds, g, S, E);
}
SITE site_knorm(PA a, LAS unsigned char* lds) { OPAQUE(); p2_knorm(a, lds); }
SITE site_inproj(PA a, int l, LAS unsigned char* lds) { OPAQUE();
    pg8::Gemm g{WSP(const bf16_t, WS_XB), WSP(const bf16_t, WS_WIN) + (size_t)l * INW * 1024, 1024, 0};
    pg8::StaticOrder S; S.init(T, INW, opq((int)gridDim.x), opq((int)blockIdx.x));
    pg8::EpiProj E{WSP(bf16_t, WS_PROJ), WSP(bf16_t, WS_VT), WSP(const float, WS_SS)};
    pg8::gemm_phase<pg8::EpiProj, pg8::StaticOrder>(lds, g, S, E);
}
SITE site_prep(PA a, int l, LAS unsigned char* lds) { OPAQUE();
    pb_prep(a, l, lds);
}
SITE site_chunks(PA a, int l, LAS unsigned char* lds) { OPAQUE(); pb2_chunks(a, l, lds); }
SITE site_mixer(PA a, int l, LAS unsigned char* lds) { OPAQUE(); pc_mixer(a, l, lds); }
SITE site_outproj(PA a, int l, LAS unsigned char* lds) { OPAQUE();
    pg8::Gemm g{WSP(const bf16_t, WS_YCAT), WSP(const bf16_t, WS_WOUT) + (size_t)l * 1024 * 1024, 1024, 0};
    pg8::StaticOrder S; S.init(T, 1024, opq((int)gridDim.x), opq((int)blockIdx.x));
    pg8::EpiRes E{a.out, WSP(bf16_t, WS_XB), WSP(float, WS_SS)};
    pg8::gemm_phase<pg8::EpiRes, pg8::StaticOrder>(lds, g, S, E);
}
SITE site_xq(PA a, int l, LAS unsigned char* lds) { OPAQUE();
    pg8::Gemm g{WSP(const bf16_t, WS_XB), WSP(const bf16_t, WS_WQ) + (size_t)l * 512 * 1024, 1024, 0};
    pg8::StaticOrder S; S.init(T, 512, opq((int)gridDim.x), opq((int)blockIdx.x));
    pg8::EpiScale E{WSP(bf16_t, WS_QX), 512, WSP(const float, WS_SS), T - 1};
    pg8::gemm_phase<pg8::EpiScale, pg8::StaticOrder>(lds, g, S, E);
}
SITE site_xattn(PA a, int l, LAS unsigned char* lds) { OPAQUE(); pe2_xattn(a, l, lds); }
SITE site_xo(PA a, int l, LAS unsigned char* lds) { OPAQUE();
    pg8::Gemm g{WSP(const bf16_t, WS_OX), WSP(const bf16_t, WS_WO) + (size_t)l * 1024 * 512, 512, 0};
    pg8::StaticOrder S; S.init(T, 1024, opq((int)gridDim.x), opq((int)blockIdx.x));
    pg8::EpiRes E{a.out, WSP(bf16_t, WS_XB), WSP(float, WS_SS)};
    pg8::gemm_phase<pg8::EpiRes, pg8::StaticOrder>(lds, g, S, E);
}
SITE site_router(PA a, int l, LAS unsigned char* lds) { OPAQUE(); pf_router(a, l, lds); }
SITE site_gather(PA a, int l, LAS unsigned char* lds) { OPAQUE(); pg_gather(a, l, lds); }
SITE site_gu(PA a, LAS unsigned char* lds) { OPAQUE();
    pg8::Gemm g{WSP(const bf16_t, WS_XS), WSP(const bf16_t, WS_WGU), 1024, (size_t)1024 * 1024};
    pg8::MoeOrder S{WSP(const int, WS_MTE), opq((int)gridDim.x), opq((int)blockIdx.x)};
    pg8::EpiGU E{WSP(bf16_t, WS_HB)};
    pg8::gemm_phase<pg8::EpiGU, pg8::MoeOrder>(lds, g, S, E);
}
SITE site_down(PA a, LAS unsigned char* lds) { OPAQUE();
    pg8::Gemm g{WSP(const bf16_t, WS_HB), WSP(const bf16_t, WS_WD), 512, (size_t)1024 * 512};
    pg8::MoeOrder S{WSP(const int, WS_MTE), opq((int)gridDim.x), opq((int)blockIdx.x)};
    pg8::EpiDown E{WSP(bf16_t, WS_Y), WSP(const int, WS_SSLOT), WSP(const float, WS_SW)};
    pg8::gemm_phase<pg8::EpiDown, pg8::MoeOrder>(lds, g, S, E);
}
SITE site_final(PA a, LAS unsigned char* lds) { OPAQUE(); pj_finalize(a); }

__global__ void __launch_bounds__(512, 2) mk_fwd(Args args) {
    extern __shared__ __attribute__((aligned(16))) unsigned char lds_raw[];
    LAS unsigned char* lds = (LAS unsigned char*)lds_raw;
    const int tid = threadIdx.x;
    const int lo = args.ph_lo, hi = args.ph_hi;
    PA a; a.out = args.out; a.ws = args.ws;
    if (tid < 16) ((LAS unsigned*)(lds + LDS_MISC))[tid] = 0u;
    if (tid == 64) {
        LAS unsigned long long* tab = (LAS unsigned long long*)(lds + LDS_INTAB);
#pragma unroll
        for (int i = 0; i < 38; ++i) tab[i] = (unsigned long long)args.in[i];
        tab[38] = (unsigned long long)args.out; tab[39] = (unsigned long long)args.ws;
    }
    __syncthreads();
    XcdBarrier bar; bar.bar = WSP(unsigned, WS_CTL) + CW_BAR; bar.x = 0; bar.st = nullptr;
    if (!MK_PER_PHASE) bar = xcd_barrier_post(WSP(unsigned, WS_CTL) + CW_BAR, (volatile LAS unsigned*)(lds + LDS_MISC));
#define IN(k) (lo <= (k) && (k) < hi)
#define GRID_BAR() do { if (!MK_PER_PHASE) xcd_barrier(bar); } while (0)
#ifdef PROBE_MASK
    unsigned long long pr_acc = 0ull, pr_t0 = 0ull; const unsigned long long pr_start = wall_clock64();
#define PR0() do { pr_t0 = wall_clock64(); } while (0)
#define PR1(p) do { if ((PROBE_MASK >> (p)) & 1) pr_acc += wall_clock64() - pr_t0; } while (0)
#else
#define PR0() do { } while (0)
#define PR1(p) do { } while (0)
#endif
    PR0(); if (IN(0)) { site_p0(a, lds); GRID_BAR(); } PR1(12);
    PR0(); if (IN(1)) { site_kv(a, lds); GRID_BAR(); } PR1(13);
    PR0(); if (IN(2)) { site_knorm(a, lds); GRID_BAR(); } PR1(14);
    for (int l = 0; l < NL; ++l) {
        const int pb = 3 + 12 * l;
        PR0(); if (IN(pb + 0)) { site_inproj(a, l, lds); GRID_BAR(); } PR1(0);
        PR0(); if (IN(pb + 1)) { site_prep(a, l, lds); GRID_BAR(); } PR1(1);
        PR0(); if (IN(pb + 1)) { site_chunks(a, l, lds); GRID_BAR(); } PR1(15);
        PR0(); if (IN(pb + 2)) { site_mixer(a, l, lds); GRID_BAR(); } PR1(2);
        PR0(); if (IN(pb + 3)) { site_outproj(a, l, lds); GRID_BAR(); } PR1(3);
        PR0(); if (IN(pb + 4)) { site_xq(a, l, lds); GRID_BAR(); } PR1(4);
        PR0(); if (IN(pb + 5)) { site_xattn(a, l, lds); GRID_BAR(); } PR1(5);
        PR0(); if (IN(pb + 6)) { site_xo(a, l, lds); GRID_BAR(); } PR1(6);
        PR0(); if (IN(pb + 7)) { site_router(a, l, lds); GRID_BAR(); } PR1(7);
        PR0(); if (IN(pb + 8)) { site_gather(a, l, lds); GRID_BAR(); } PR1(8);
        PR0(); if (IN(pb + 9)) { site_gu(a, lds); GRID_BAR(); } PR1(9);
        PR0(); if (IN(pb + 10)) { site_down(a, lds); GRID_BAR(); } PR1(10);
#ifdef PROBE_MASK
        PR0(); if (IN(pb + 11)) { site_final(a, lds); GRID_BAR(); } PR1(11);
#else
        if (IN(pb + 11)) { site_final(a, lds); if (l + 1 < NL) GRID_BAR(); }
#endif
    }
#ifdef PROBE_MASK
    {
        unsigned long long* pw = (unsigned long long*)(WSP(unsigned, WS_CTL) + 8192);
        if (blockIdx.x == 0 && tid == 0) __hip_atomic_store(pw, pr_acc, __ATOMIC_RELAXED, __HIP_MEMORY_SCOPE_AGENT);
        GRID_BAR();
        const unsigned long long tgt = 1600000ull + __hip_atomic_load(pw, __ATOMIC_RELAXED, __HIP_MEMORY_SCOPE_AGENT) * (unsigned long long)PROBE_MULT;
        while (wall_clock64() - pr_start < tgt) __builtin_amdgcn_s_sleep(16);
    }
#endif
#undef IN
#undef GRID_BAR
}

extern "C" void kernel_launch(void* const* d_in, const int* in_sizes, int n_in, void* d_out, int out_size, void* d_ws, size_t ws_size, hipStream_t stream) {
    static int grid = 0;
    if (grid == 0) {
        if (n_in != 38 || out_size != T * D || ws_size < WS_END) { fprintf(stderr, "kernel_launch: unexpected shapes (n_in %d out %d ws %zu need %zu)\n", n_in, out_size, ws_size, (size_t)WS_END); grid = -1; return; }
        int dev = 0, cus = 0, per_cu = 0;
        if (hipGetDevice(&dev) != hipSuccess || hipDeviceGetAttribute(&cus, hipDeviceAttributeMultiprocessorCount, dev) != hipSuccess) { grid = -1; return; }
        if (hipFuncSetAttribute((const void*)mk_fwd, hipFuncAttributeMaxDynamicSharedMemorySize, LDS_BYTES) != hipSuccess) { fprintf(stderr, "kernel_launch: hipFuncSetAttribute failed\n"); grid = -1; return; }
        if (hipOccupancyMaxActiveBlocksPerMultiprocessor(&per_cu, (const void*)mk_fwd, 512, LDS_BYTES) != hipSuccess || per_cu < 1) { fprintf(stderr, "kernel_launch: occupancy query says %d\n", per_cu); }
        (void)hipGetLastError();
        grid = cus;
    }
    if (grid < 0) return;
    (void)hipMemsetAsync((char*)d_ws + WS_CTL, 0, CTL_BYTES, stream);
    Args a{};
    for (int i = 0; i < 38; ++i) a.in[i] = (const float*)d_in[i];
    a.out = (float*)d_out; a.ws = (unsigned char*)d_ws;
#if MK_PER_PHASE
    for (int p = 0; p < NPH; ++p) { a.ph_lo = p; a.ph_hi = p + 1; hipLaunchKernelGGL(mk_fwd, dim3(grid), dim3(512), LDS_BYTES, stream, a); }
#else
    a.ph_lo = 0; a.ph_hi = NPH;
    hipLaunchKernelGGL(mk_fwd, dim3(grid), dim3(512), LDS_BYTES, stream, a);
#endif
}
```

```cpp
#include <hip/hip_runtime.h>
#include <cstdio>
#include <cstdint>

#ifndef MK_PER_PHASE
#define MK_PER_PHASE 0
#endif

#define LAS __attribute__((address_space(3)))
typedef unsigned short bf16_t;
typedef short bf16x8 __attribute__((ext_vector_type(8)));
typedef float f32x4 __attribute__((ext_vector_type(4)));
typedef unsigned u32x4 __attribute__((ext_vector_type(4)));
typedef unsigned u32x2 __attribute__((ext_vector_type(2)));

constexpr int T = 32768, D = 1024, SEQ = 2048, NL = 4;
constexpr int INW = 3328;
constexpr int MROWS = 4096;
constexpr int MAXROWS = 73728, MAXMT = 288;
constexpr int NPH = 3 + 12 * NL;

constexpr size_t WS_CTL   = 0;
constexpr size_t CTL_BYTES = 65536;
constexpr size_t WS_WIN   = WS_CTL + CTL_BYTES;
constexpr size_t WS_WOUT  = WS_WIN  + (size_t)4 * 3328 * 1024 * 2;
constexpr size_t WS_WQ    = WS_WOUT + (size_t)4 * 1024 * 1024 * 2;
constexpr size_t WS_WKV   = WS_WQ   + (size_t)4 * 512 * 1024 * 2;
constexpr size_t WS_WO    = WS_WKV  + (size_t)4 * 1024 * 1024 * 2;
constexpr size_t WS_WGU   = WS_WO   + (size_t)4 * 1024 * 512 * 2;
constexpr size_t WS_WD    = WS_WGU  + (size_t)32 * 1024 * 1024 * 2;
constexpr size_t WS_KV    = WS_WD   + (size_t)32 * 1024 * 512 * 2;
constexpr size_t WS_MEMB  = WS_KV   + (size_t)4 * 4096 * 1024 * 2;
constexpr size_t WS_MEMSS = WS_MEMB + (size_t)4096 * 1024 * 2;
constexpr size_t WS_VTX   = WS_MEMSS + (size_t)4096 * 16 * 4;
constexpr size_t WS_WRH   = WS_VTX  + (size_t)4 * 4096 * 512 * 2;
constexpr size_t WS_WRL   = WS_WRH  + (size_t)4 * 48 * 1024 * 2;
constexpr size_t WS_XB    = WS_WRL  + (size_t)4 * 48 * 1024 * 2;
constexpr size_t WS_SS    = WS_XB   + (size_t)T * 1024 * 2;
constexpr size_t WS_VF    = WS_SS   + (size_t)T * 16 * 4;
constexpr size_t WS_EID   = WS_VF   + (size_t)T * 512 * 2;
constexpr size_t WS_EW    = WS_EID  + (size_t)T * 2 * 4;
constexpr size_t WS_ERK   = WS_EW   + (size_t)T * 2 * 4;
constexpr size_t WS_SSLOT = WS_ERK  + (size_t)T * 2 * 4;
constexpr size_t WS_SW    = WS_SSLOT + (size_t)MAXROWS * 4;
constexpr size_t WS_MTE   = WS_SW   + (size_t)MAXROWS * 4;
constexpr size_t WS_U     = WS_MTE  + 2048;
constexpr size_t WS_PROJ  = WS_U;
constexpr size_t WS_SR    = WS_PROJ + (size_t)T * 3328 * 2;
constexpr size_t WS_SK    = WS_SR   + (size_t)T * 512 * 2;
constexpr size_t WS_SV    = WS_SK   + (size_t)T * 512 * 2;
constexpr size_t WS_SA    = WS_SV   + (size_t)T * 512 * 2;
constexpr size_t WS_SB    = WS_SA   + (size_t)T * 512 * 2;
constexpr size_t WS_SG    = WS_SB   + (size_t)T * 512 * 2;
constexpr size_t WS_SWD   = WS_SG   + (size_t)T * 512 * 2;
constexpr size_t WS_YCAT  = WS_SWD  + (size_t)T * 512 * 4;
constexpr size_t WS_VT    = WS_YCAT + (size_t)T * 1024 * 2;
constexpr int NCHUNK = 16 * 8 * 128;
constexpr size_t WS_BTT   = WS_VT   + (size_t)T * 512 * 2;
constexpr size_t WS_KTT   = WS_BTT  + (size_t)NCHUNK * 2048;
constexpr size_t WS_VST   = WS_KTT  + (size_t)NCHUNK * 2048;
constexpr size_t WS_NKA   = WS_VST  + (size_t)NCHUNK * 2048;
constexpr size_t WS_NBR   = WS_NKA  + (size_t)NCHUNK * 512;
constexpr size_t WS_NKR   = WS_NBR  + (size_t)NCHUNK * 512;
constexpr size_t WS_TMT   = WS_NKR  + (size_t)NCHUNK * 512;
constexpr size_t WS_PCK   = WS_TMT  + (size_t)NCHUNK * 512;
constexpr size_t WS_BS    = WS_PCK  + (size_t)NCHUNK * 256;
constexpr size_t WS_UEND1 = WS_BS   + (size_t)T * 8 * 4;
constexpr size_t WS_QX    = WS_U;
constexpr size_t WS_OX    = WS_QX   + (size_t)T * 512 * 2;
constexpr size_t WS_XS    = WS_U;
constexpr size_t WS_HB    = WS_XS   + (size_t)MAXROWS * 1024 * 2;
constexpr size_t WS_Y     = WS_HB   + (size_t)MAXROWS * 512 * 2;
constexpr size_t WS_UEND2 = WS_Y    + (size_t)2 * T * 1024 * 2;
constexpr size_t WS_END   = WS_UEND1 > WS_UEND2 ? WS_UEND1 : WS_UEND2;

constexpr int CW_BAR = 0;
constexpr int CW_CNT = 4096;
constexpr int CW_QUEUE = 4096 + 256;

constexpr int LDS_MISC = 139264;
constexpr int LDS_BYTES = LDS_MISC + 16384;

struct Args { const float* in[38]; float* out; unsigned char* ws; int ph_lo, ph_hi; };
struct PA { float* out; unsigned char* ws; };

__device__ __forceinline__ float bf2f(bf16_t b) { return __uint_as_float(((unsigned)b) << 16); }
__device__ __forceinline__ bf16_t f2bf(float f) { unsigned u = __float_as_uint(f); u += 0x7FFFu + ((u >> 16) & 1u); return (bf16_t)(u >> 16); }
typedef __bf16 bf16v2 __attribute__((ext_vector_type(2)));
typedef float f32x2 __attribute__((ext_vector_type(2)));
__device__ __forceinline__ unsigned pk2(float lo, float hi) { f32x2 v = {lo, hi}; bf16v2 b = __builtin_convertvector(v, bf16v2); return __builtin_bit_cast(unsigned, b); }
__device__ __forceinline__ float lo16(unsigned u) { return __uint_as_float(u << 16); }
__device__ __forceinline__ float hi16(unsigned u) { return __uint_as_float(u & 0xffff0000u); }
__device__ __forceinline__ float wsum(float v) {
#pragma unroll
    for (int o = 32; o; o >>= 1) v += __shfl_xor(v, o);
    return v;
}
__device__ __forceinline__ float sigmoidf_(float x) { return 1.0f / (1.0f + __expf(-x)); }

#define XB_TMO      128
#define XB_XCNT(j)  (256  + 64 * (j))
#define XB_XSUB(j)  (1280 + 64 * (j))
#define XB_XGEN(j)  (2304 + 64 * (j))
#define XB_TOP      3328
#define XB_TOPGEN   3392
#define XCD_BAR_WORDS 3456
#define XB_SPIN_CAP (1u << 22)

__device__ __forceinline__ unsigned xb_ld(unsigned* p)              { return __hip_atomic_load(p, __ATOMIC_RELAXED, __HIP_MEMORY_SCOPE_AGENT); }
__device__ __forceinline__ unsigned xb_add(unsigned* p, unsigned v) { return __hip_atomic_fetch_add(p, v, __ATOMIC_RELAXED, __HIP_MEMORY_SCOPE_AGENT); }
__device__ __forceinline__ unsigned xb_xcc_id() { return (unsigned)__builtin_amdgcn_s_getreg((3 << 11) | 20) & 0xFu; }
#define XB_SPIN(cond, bar) do { unsigned _sp = 0; while (cond) { __builtin_amdgcn_s_sleep(1); \
    if ((++_sp & 255u) == 0u) { if (xb_ld(&(bar)[XB_TMO])) break; if (_sp > XB_SPIN_CAP) { atomicAdd(&(bar)[XB_TMO], 1u); break; } } } } while (0)

struct XcdBarrier { unsigned* bar; unsigned x; volatile LAS unsigned* st; };

__device__ __forceinline__ XcdBarrier xcd_barrier_post(unsigned* bar, volatile LAS unsigned* st) {
    XcdBarrier b; b.bar = bar; b.x = xb_xcc_id(); b.st = st;
    if (threadIdx.x == 0) (void)xb_add(&bar[XB_XCNT(b.x)], 1u);
    return b;
}
__device__ __forceinline__ void xcd_barrier_complete(unsigned* bar, unsigned x, unsigned& nloc, unsigned& nx) {
    const unsigned G = gridDim.x * gridDim.y * gridDim.z;
    unsigned sum, cnt, mine, sp = 0u;
    for (;;) {
        sum = 0u; cnt = 0u; mine = 0u;
#pragma unroll
        for (unsigned j = 0; j < 16; ++j) { const unsigned c = xb_ld(&bar[XB_XCNT(j)]); sum += c; cnt += (c > 0u) ? 1u : 0u; mine = (j == x) ? c : mine; }
        if (sum == G) break;
        __builtin_amdgcn_s_sleep(1);
        if ((++sp & 255u) == 0u) { if (xb_ld(&bar[XB_TMO])) break; if (sp > XB_SPIN_CAP) { atomicAdd(&bar[XB_TMO], 1u); break; } }
    }
    nloc = mine > 0u ? mine : 1u; nx = cnt > 0u ? cnt : 1u;
}
__device__ __forceinline__ void xcd_barrier(const XcdBarrier& b) {
    asm volatile("s_waitcnt vmcnt(0)" ::: "memory");
    __syncthreads();
    if (threadIdx.x == 0) {
        unsigned* bar = b.bar;
        __builtin_amdgcn_s_waitcnt(0);
        unsigned nloc = b.st[0], nx = b.st[1];
        if (nloc == 0u) { xcd_barrier_complete(bar, b.x, nloc, nx); b.st[0] = nloc; b.st[1] = nx; }
        const unsigned old = xb_add(&bar[XB_XSUB(b.x)], 1u);
        const unsigned gen = old / nloc;
        if (old + 1u == (gen + 1u) * nloc) {
            __builtin_amdgcn_fence(__ATOMIC_RELEASE, "agent");
            asm volatile("s_waitcnt vmcnt(0)" ::: "memory");
            const unsigned og = xb_add(&bar[XB_TOP], 1u);
            const unsigned tg = og / nx;
            if (og + 1u == (tg + 1u) * nx) xb_add(&bar[XB_TOPGEN], 1u);
            else XB_SPIN(xb_ld(&bar[XB_TOPGEN]) == tg, bar);
            __builtin_amdgcn_fence(__ATOMIC_ACQUIRE, "agent");
            xb_add(&bar[XB_XGEN(b.x)], 1u);
            asm volatile("s_waitcnt vmcnt(0)" ::: "memory");
        } else {
            XB_SPIN(xb_ld(&bar[XB_XGEN(b.x)]) == gen, bar);
            __builtin_amdgcn_fence(__ATOMIC_ACQUIRE, "agent");
            asm volatile("s_waitcnt vmcnt(0)" ::: "memory");
        }
    }
    __syncthreads();
}

namespace pg8 {
constexpr int BM = 256, BK = 64, HALF = 128, HTB = HALF * BK * 2, STAGE_BYTES = 8 * HTB, NXCD = 8, WGM = 8;
__host__ __device__ __forceinline__ int lds_byte(int r, int c) { const int st = (r >> 4) * 2 + (c >> 5), rr = r & 15, cc = c & 31, ob = rr * 64 + cc * 2; return st * 1024 + (ob ^ (((ob >> 9) & 1) << 5)); }
__host__ __device__ __forceinline__ void stage_rc(int b, int& R, int& C) { const int st = b / 1024, sb = b % 1024, swz = sb ^ (((sb >> 9) & 1) << 5); R = (st >> 1) * 16 + swz / 64; C = (st & 1) * 32 + (swz % 64) / 2; }
__host__ __device__ __forceinline__ int perm32(int rho) { const int n = rho >> 4, i = rho & 15; return 8 * (i >> 2) + 4 * n + (i & 3); }

struct Unit { int pm, pn, pa, z; };
struct Gemm { const bf16_t* A; const bf16_t* Bt; int K; size_t bz_stride; };

struct StaticOrder {
    int nM, nN, nwg, G, c;
    __device__ void init(int M, int N, int G_, int c_) { nM = M / BM; nN = N / BM; nwg = nM * nN; G = G_; c = c_; }
    __device__ bool next(int i, Unit& u) const {
        const long L = (long)i * G + c; if (L >= nwg) return false;
        int wgid = (int)L; { const int q = nwg / NXCD, r = nwg % NXCD, xcd = wgid % NXCD, off = wgid / NXCD; wgid = (xcd < r ? xcd * (q + 1) : r * (q + 1) + (xcd - r) * q) + off; }
        const int nig = WGM * nN, gid = wgid / nig, fm = gid * WGM, gsz = (nM - fm) < WGM ? (nM - fm) : WGM;
        u.pm = fm + ((wgid % nig) % gsz); u.pn = (wgid % nig) / gsz; u.pa = u.pm; u.z = 0; return true;
    }
};
struct KvOrder {
    int G, c;
    __device__ bool next(int i, Unit& u) const {
        const int L = i * G + c; if (L >= 256) return false;
        u.z = L >> 6; const int r = L & 63; u.pa = r >> 2; u.pn = r & 3; u.pm = u.z * 16 + u.pa; return true;
    }
};
struct MoeOrder {
    const int* mte; int G, c;
    __device__ bool next(int i, Unit& u) const {
        if ((G & 7) != 0) {
            const int nunits = mte[511] * 4;
            const int L = i * G + c; if (L >= nunits) return false;
            u.pm = L >> 2; u.pa = u.pm; u.pn = L & 3; u.z = mte[u.pm]; return true;
        }
        const int x = c & 7; int q = i * (G >> 3) + (c >> 3);
#pragma unroll
        for (int k = 0; k < 4; ++k) {
            const int e = x + 8 * k; const int m0 = mte[400 + e], m1 = mte[401 + e]; const int n = (m1 - m0) * 4;
            if (q < n) { u.pm = m0 + (q >> 2); u.pa = u.pm; u.pn = q & 3; u.z = e; return true; }
            q -= n;
        }
        return false;
    }
};

template <class Epi, class Sched, bool ALIGN_EPI = true>
__device__ __forceinline__ void gemm_phase(LAS unsigned char* lds, const Gemm g, const Sched& S, const Epi& E) {
    int tid_ = threadIdx.x; asm volatile("" : "+v"(tid_));
    const int tid = tid_, wid = __builtin_amdgcn_readfirstlane(tid >> 6), lane = tid & 63, wr = wid >> 2, wc = wid & 3, fr = lane & 15, fq = lane >> 4;
    const int K = g.K, nt = K / BK;
    unsigned voffA[2], voffB[2];
#pragma unroll
    for (int i = 0; i < 2; ++i) { int R, C; stage_rc(tid * 16 + i * 8192, R, C); const int Rb = ((R & ~31) + perm32(R & 31));
        voffA[i] = (unsigned)(R * K + C) * 2u; voffB[i] = (unsigned)(Rb * K + C) * 2u; }
    const size_t kstep = (size_t)(BK * 2);
    const size_t hstep = (size_t)HALF * K * 2;
    const size_t tstep = 2 * hstep;
    const unsigned ldsw = (unsigned)wid * 1024u;
    const int aoff = lds_byte(wr * 64 + fr, fq * 8), boff = lds_byte(wc * 32 + fr, fq * 8);
#define PG8_SA(b, h) (((b) * 2 + (h)) * HTB)
#define PG8_SB(b, h) ((4 + (b) * 2 + (h)) * HTB)
#define PG8_STAGE(bufoff, gbase, voff) do { _Pragma("unroll") for (int _i = 0; _i < 2; ++_i) \
        __builtin_amdgcn_global_load_lds((const unsigned*)((const char*)(gbase) + (voff)[_i]), (LAS unsigned*)(lds + (bufoff) + ldsw + _i * 8192), 16, 0, 0); } while (0)
#define PG8_LDA(dst, b, h) do { _Pragma("unroll") for (int m = 0; m < 4; ++m) _Pragma("unroll") for (int k = 0; k < 2; ++k) dst[m][k] = *(const LAS bf16x8*)(lds + PG8_SA(b, h) + aoff + m * 2048 + k * 1024); } while (0)
#define PG8_LDB(dst, b, h) do { _Pragma("unroll") for (int n = 0; n < 2; ++n) _Pragma("unroll") for (int k = 0; k < 2; ++k) dst[n][k] = *(const LAS bf16x8*)(lds + PG8_SB(b, h) + boff + n * 2048 + k * 1024); } while (0)
#define PG8_MMA(ai, bj, At, Bt) do { __builtin_amdgcn_s_setprio(1); _Pragma("unroll") for (int m = 0; m < 4; ++m) _Pragma("unroll") for (int n = 0; n < 2; ++n) _Pragma("unroll") for (int k = 0; k < 2; ++k) \
        acc[ai][bj][m][n] = __builtin_amdgcn_mfma_f32_16x16x32_bf16(Bt[n][k], At[m][k], acc[ai][bj][m][n], 0, 0, 0); __builtin_amdgcn_s_setprio(0); } while (0)
#define PG8_WAIT_V(n) asm volatile("s_waitcnt vmcnt(" #n ")" ::: "memory")
#define PG8_WAIT_L(n) asm volatile("s_waitcnt lgkmcnt(" #n ")" ::: "memory")
#define PG8_BAR __builtin_amdgcn_s_barrier()
#define PG8_SCHED __builtin_amdgcn_sched_barrier(0)
#define PG8_APTR(u) ((const char*)g.A + (size_t)(u).pa * tstep)
#define PG8_BPTR(u) ((const char*)g.Bt + ((size_t)(u).z * g.bz_stride) * 2 + (size_t)(u).pn * tstep)
    Unit cur, nxt; int ui = 0;
    if (!S.next(0, cur)) return;
    f32x4 acc[2][2][4][2];
#pragma unroll
    for (int a = 0; a < 2; ++a)
#pragma unroll
        for (int b = 0; b < 2; ++b)
#pragma unroll
            for (int m = 0; m < 4; ++m)
#pragma unroll
                for (int n = 0; n < 2; ++n) acc[a][b][m][n] = (f32x4){0.f, 0.f, 0.f, 0.f};
    bf16x8 At[4][2], B0[2][2], B1[2][2];
    const char* cA = PG8_APTR(cur); const char* cB = PG8_BPTR(cur);
    PG8_STAGE(PG8_SB(0, 0), cB, voffB); PG8_STAGE(PG8_SB(0, 1), cB + hstep, voffB); PG8_STAGE(PG8_SA(0, 0), cA, voffA); PG8_STAGE(PG8_SA(0, 1), cA + hstep, voffA);
    if (wr == 1) PG8_BAR;
    PG8_WAIT_V(2); PG8_BAR;
    PG8_STAGE(PG8_SB(1, 0), cB + kstep, voffB); PG8_STAGE(PG8_SA(1, 0), cA + kstep, voffA); PG8_STAGE(PG8_SB(1, 1), cB + hstep + kstep, voffB);
    PG8_WAIT_V(6); PG8_BAR;
    for (;;) {
        const bool has_next = S.next(ui + 1, nxt);
        const char* nA = has_next ? PG8_APTR(nxt) : cA; const char* nB = has_next ? PG8_BPTR(nxt) : cB;
        for (int t = 0; t < nt; t += 2) {
            const bool last = (t == nt - 2);
            const char* a1 = cA + (size_t)(t + 1) * kstep;
            const char* a2 = last ? nA : cA + (size_t)(t + 2) * kstep; const char* b2 = last ? nB : cB + (size_t)(t + 2) * kstep;
            const char* a3 = a2 + kstep; const char* b3 = b2 + kstep;
            PG8_LDB(B0, 0, 0); PG8_LDB(B1, 0, 1); PG8_SCHED; PG8_LDA(At, 0, 0); PG8_STAGE(PG8_SA(1, 1), a1 + hstep, voffA);
            PG8_WAIT_V(8); PG8_WAIT_L(0); PG8_BAR; PG8_MMA(0, 0, At, B0); PG8_MMA(0, 1, At, B1); PG8_BAR; PG8_SCHED;
            PG8_LDA(At, 0, 1); PG8_STAGE(PG8_SB(0, 0), b2, voffB); PG8_STAGE(PG8_SB(0, 1), b2 + hstep, voffB); PG8_STAGE(PG8_SA(0, 0), a2, voffA);
            PG8_WAIT_V(8); PG8_WAIT_L(0); PG8_BAR; PG8_MMA(1, 0, At, B0); PG8_MMA(1, 1, At, B1); PG8_BAR; PG8_SCHED;
            PG8_LDB(B0, 1, 0); PG8_LDB(B1, 1, 1); PG8_SCHED; PG8_LDA(At, 1, 0); PG8_STAGE(PG8_SA(0, 1), a2 + hstep, voffA);
            PG8_WAIT_V(8); PG8_WAIT_L(0); PG8_BAR; PG8_MMA(0, 0, At, B0); PG8_MMA(0, 1, At, B1); PG8_BAR; PG8_SCHED;
            PG8_LDA(At, 1, 1); PG8_STAGE(PG8_SB(1, 0), b3, voffB); PG8_STAGE(PG8_SB(1, 1), b3 + hstep, voffB); PG8_STAGE(PG8_SA(1, 0), a3, voffA);
            PG8_WAIT_V(8); PG8_WAIT_L(0); PG8_BAR; PG8_MMA(1, 0, At, B0); PG8_MMA(1, 1, At, B1); PG8_BAR; PG8_SCHED;
        }
        if constexpr (ALIGN_EPI) { if (wr == 0) PG8_BAR; }
        E(acc, cur, wr, wc, fr, fq);
        if (!has_next) break;
#pragma unroll
        for (int a = 0; a < 2; ++a)
#pragma unroll
            for (int b = 0; b < 2; ++b)
#pragma unroll
                for (int m = 0; m < 4; ++m)
#pragma unroll
                    for (int n = 0; n < 2; ++n) acc[a][b][m][n] = (f32x4){0.f, 0.f, 0.f, 0.f};
        cur = nxt; cA = nA; cB = nB; ++ui;
        if constexpr (ALIGN_EPI) { if (wr == 1) PG8_BAR; }
    }
    PG8_WAIT_V(0);
    if constexpr (!ALIGN_EPI) { if (wr == 0) PG8_BAR; }
    PG8_BAR;
#undef PG8_SA
#undef PG8_SB
#undef PG8_STAGE
#undef PG8_LDA
#undef PG8_LDB
#undef PG8_MMA
#undef PG8_WAIT_V
#undef PG8_WAIT_L
#undef PG8_BAR
#undef PG8_SCHED
#undef PG8_APTR
#undef PG8_BPTR
}

typedef const f32x4 (&AccRef)[2][2][4][2];

struct EpiScale {
    bf16_t* O; int ldc; const float* ss; int ssmask;
    __device__ __forceinline__ void operator()(AccRef acc, const Unit& u, int wr, int wc, int fr, int fq) const {
#pragma unroll
        for (int ai = 0; ai < 2; ++ai)
#pragma unroll
            for (int m = 0; m < 4; ++m) {
                const int row = u.pm * 256 + ai * 128 + wr * 64 + m * 16 + fr;
                const f32x4* sp = (const f32x4*)(ss + (size_t)(row & ssmask) * 16);
                const f32x4 s0 = sp[0], s1 = sp[1], s2 = sp[2], s3 = sp[3];
                const float tot = ((s0[0] + s0[1]) + (s0[2] + s0[3])) + ((s1[0] + s1[1]) + (s1[2] + s1[3])) + ((s2[0] + s2[1]) + (s2[2] + s2[3])) + ((s3[0] + s3[1]) + (s3[2] + s3[3]));
                const float rinv = rsqrtf(tot * (1.0f / 1024.0f) + 1e-6f);
#pragma unroll
                for (int bj = 0; bj < 2; ++bj) {
                    const int col = u.pn * 256 + bj * 128 + wc * 32 + 8 * fq;
                    const f32x4 v0 = acc[ai][bj][m][0] * rinv, v1 = acc[ai][bj][m][1] * rinv;
                    u32x4 w; w.x = pk2(v0[0], v0[1]); w.y = pk2(v0[2], v0[3]); w.z = pk2(v1[0], v1[1]); w.w = pk2(v1[2], v1[3]);
                    *(u32x4*)(O + (size_t)row * ldc + col) = w;
                }
            }
    }
};
struct EpiProj {
    bf16_t* O; bf16_t* VT; const float* ss;
    __device__ __forceinline__ void operator()(AccRef acc, const Unit& u, int wr, int wc, int fr, int fq) const {
#pragma unroll
        for (int ai = 0; ai < 2; ++ai)
#pragma unroll
            for (int m = 0; m < 4; ++m) {
                const int row = u.pm * 256 + ai * 128 + wr * 64 + m * 16 + fr;
                const f32x4* sp = (const f32x4*)(ss + (size_t)row * 16);
                const f32x4 s0 = sp[0], s1 = sp[1], s2 = sp[2], s3 = sp[3];
                const float tot = ((s0[0] + s0[1]) + (s0[2] + s0[3])) + ((s1[0] + s1[1]) + (s1[2] + s1[3])) + ((s2[0] + s2[1]) + (s2[2] + s2[3])) + ((s3[0] + s3[1]) + (s3[2] + s3[3]));
                const float rinv = rsqrtf(tot * (1.0f / 1024.0f) + 1e-6f);
#pragma unroll
                for (int bj = 0; bj < 2; ++bj) {
                    const int col = u.pn * 256 + bj * 128 + wc * 32 + 8 * fq;
                    const f32x4 v0 = acc[ai][bj][m][0] * rinv, v1 = acc[ai][bj][m][1] * rinv;
                    u32x4 w; w.x = pk2(v0[0], v0[1]); w.y = pk2(v0[2], v0[3]); w.z = pk2(v1[0], v1[1]); w.w = pk2(v1[2], v1[3]);
                    if (u.pn < 11) *(u32x4*)(O + (size_t)row * INW + col) = w;
                    else {
                        const int cv = col - 2816;
                        const int sq_ = row & 2047;
                        const int sp_ = (sq_ & ~31) | (((sq_ >> 2) & 3) << 3) | (((sq_ >> 4) & 1) << 2) | (sq_ & 3);
                        bf16_t* vp = VT + ((size_t)((row >> 11) * 8 + (cv >> 6)) * 64 + (cv & 63)) * 2048 + sp_;
#pragma unroll
                        for (int e = 0; e < 4; ++e) { vp[(size_t)(2 * e) * 2048] = (bf16_t)(w[e] & 0xffffu); vp[(size_t)(2 * e + 1) * 2048] = (bf16_t)(w[e] >> 16); }
                    }
                }
            }
    }
};
struct EpiRes {
    float* X; bf16_t* XB; float* SS;
    __device__ __forceinline__ void operator()(AccRef acc, const Unit& u, int wr, int wc, int fr, int fq) const {
#pragma unroll
        for (int ai = 0; ai < 2; ++ai)
#pragma unroll
            for (int m = 0; m < 4; ++m) {
                const int row = u.pm * 256 + ai * 128 + wr * 64 + m * 16 + fr;
                float sq = 0.f;
#pragma unroll
                for (int bj = 0; bj < 2; ++bj) {
                    const int col = u.pn * 256 + bj * 128 + wc * 32 + 8 * fq;
                    float* xp = X + (size_t)row * 1024 + col;
                    f32x4 x0 = *(const f32x4*)xp, x1 = *(const f32x4*)(xp + 4);
                    x0 += acc[ai][bj][m][0]; x1 += acc[ai][bj][m][1];
                    *(f32x4*)xp = x0; *(f32x4*)(xp + 4) = x1;
                    u32x4 w; w.x = pk2(x0[0], x0[1]); w.y = pk2(x0[2], x0[3]); w.z = pk2(x1[0], x1[1]); w.w = pk2(x1[2], x1[3]);
                    *(u32x4*)(XB + (size_t)row * 1024 + col) = w;
                    sq += (x0[0] * x0[0] + x0[1] * x0[1]) + (x0[2] * x0[2] + x0[3] * x0[3]) + (x1[0] * x1[0] + x1[1] * x1[1]) + (x1[2] * x1[2] + x1[3] * x1[3]);
                }
                sq += __shfl_xor(sq, 16); sq += __shfl_xor(sq, 32);
                if (fq == 0) SS[(size_t)row * 16 + u.pn * 4 + wc] = sq;
            }
    }
};
struct EpiGU {
    bf16_t* H;
    __device__ __forceinline__ void operator()(AccRef acc, const Unit& u, int wr, int wc, int fr, int fq) const {
#pragma unroll
        for (int ai = 0; ai < 2; ++ai)
#pragma unroll
            for (int m = 0; m < 4; ++m) {
                const int row = u.pm * 256 + ai * 128 + wr * 64 + m * 16 + fr;
                float h[8];
#pragma unroll
                for (int n = 0; n < 2; ++n)
#pragma unroll
                    for (int j = 0; j < 4; ++j) { const float gt = acc[ai][0][m][n][j], up = acc[ai][1][m][n][j]; h[n * 4 + j] = gt * __builtin_amdgcn_rcpf(1.0f + __expf(-gt)) * up; }
                u32x4 w; w.x = pk2(h[0], h[1]); w.y = pk2(h[2], h[3]); w.z = pk2(h[4], h[5]); w.w = pk2(h[6], h[7]);
                *(u32x4*)(H + (size_t)row * 512 + u.pn * 128 + wc * 32 + 8 * fq) = w;
            }
    }
};
struct EpiDown {
    bf16_t* Y; const int* slot; const float* sw;
    __device__ __forceinline__ void operator()(AccRef acc, const Unit& u, int wr, int wc, int fr, int fq) const {
#pragma unroll
        for (int ai = 0; ai < 2; ++ai)
#pragma unroll
            for (int m = 0; m < 4; ++m) {
                const int row = u.pm * 256 + ai * 128 + wr * 64 + m * 16 + fr;
                const int s = slot[row]; const float wgt = sw[row];
                if (s >= 0) {
#pragma unroll
                    for (int bj = 0; bj < 2; ++bj) {
                        const int col = u.pn * 256 + bj * 128 + wc * 32 + 8 * fq;
                        const f32x4 v0 = acc[ai][bj][m][0] * wgt, v1 = acc[ai][bj][m][1] * wgt;
                        u32x4 w; w.x = pk2(v0[0], v0[1]); w.y = pk2(v0[2], v0[3]); w.z = pk2(v1[0], v1[1]); w.w = pk2(v1[2], v1[3]);
                        *(u32x4*)(Y + (size_t)s * 1024 + col) = w;
                    }
                }
            }
    }
};
}

#define WSP(type, off) ((type*)(a.ws + (off)))
__device__ __forceinline__ int oblk() { int t = blockIdx.x; asm volatile("" : "+s"(t)); return t; }
__device__ __forceinline__ int ogrid() { int t = gridDim.x; asm volatile("" : "+s"(t)); return t; }
__device__ __forceinline__ int otid() { int t = threadIdx.x; asm volatile("" : "+v"(t)); return t; }
constexpr int LDS_INTAB = LDS_MISC + 14336;
__device__ __forceinline__ const float* ldsin(LAS unsigned char* lds, int i) {
    const unsigned long long p = ((const LAS unsigned long long*)(lds + LDS_INTAB))[i];
    const unsigned lo = __builtin_amdgcn_readfirstlane((unsigned)p), hi = __builtin_amdgcn_readfirstlane((unsigned)(p >> 32));
    return (const float*)(__attribute__((address_space(1))) const float*)(((unsigned long long)hi << 32) | lo);
}
#define INP(i) ldsin(lds, (i))

template <int MAP>
__device__ __forceinline__ void conv_slab(const float* __restrict__ src, int N, int Kper, bf16_t* __restrict__ dst, size_t estride,
                                          const float* __restrict__ gain, int goff, LAS float* tile, int slab) {
    const int tid = otid();
    const int nsn = N >> 8;
    const int kt = slab / nsn, ns = slab - kt * nsn, k0 = kt * 64, n0 = ns * 256;
    const int e = k0 / Kper, kl0 = k0 - e * Kper;
    f32x4 v[8];
#pragma unroll
    for (int i = 0; i < 8; ++i) { const int idx = tid + i * 512, kk = idx >> 6, n4 = (idx & 63) * 4; v[i] = *(const f32x4*)(src + (size_t)(k0 + kk) * N + n0 + n4); }
#pragma unroll
    for (int i = 0; i < 8; ++i) {
        const int idx = tid + i * 512, kk = idx >> 6, n4 = (idx & 63) * 4;
        float gsc = 1.0f;
        if (gain != nullptr && kl0 + kk >= goff) gsc = gain[kl0 + kk - goff];
        LAS float* tp = tile + kk * 257 + n4;
        tp[0] = v[i][0] * gsc; tp[1] = v[i][1] * gsc; tp[2] = v[i][2] * gsc; tp[3] = v[i][3] * gsc;
    }
    __syncthreads();
#pragma unroll
    for (int i = 0; i < 4; ++i) {
        const int p = tid + i * 512, nn = p >> 3, kg = p & 7;
        float x[8];
#pragma unroll
        for (int j = 0; j < 8; ++j) x[j] = tile[(kg * 8 + j) * 257 + nn];
        const int n = n0 + nn;
        const int nr = (MAP == 0) ? n : ((n >> 7) * 256 + (n & 127) + (MAP == 2 ? 128 : 0));
        u32x4 w; w.x = pk2(x[0], x[1]); w.y = pk2(x[2], x[3]); w.z = pk2(x[4], x[5]); w.w = pk2(x[6], x[7]);
        *(u32x4*)(dst + (size_t)e * estride + (size_t)nr * Kper + kl0 + kg * 8) = w;
    }
    __syncthreads();
}
template <int MAP>
__device__ __forceinline__ void conv_T(const float* __restrict__ src, int Ktot, int N, int Kper, bf16_t* __restrict__ dst, size_t estride,
                                       const float* __restrict__ gain, int goff, LAS float* tile) {
    const int nslab = (Ktot >> 6) * (N >> 8);
    for (int sl = oblk(); sl < nslab; sl += ogrid()) conv_slab<MAP>(src, N, Kper, dst, estride, gain, goff, tile, sl);
}
constexpr int MOE_CONV_ITEMS = 3 * 128;
__device__ __forceinline__ void moe_convert_item(const PA a, int l, LAS unsigned char* lds, int item) {
    LAS float* tile = (LAS float*)lds;
    const int which = item >> 7, s0 = (item & 127) * 8;
    const float* gn = INP(30) + l * 1024;
    for (int sl = s0; sl < s0 + 8; ++sl) {
        if (which == 0)      conv_slab<1>(INP(35) + (size_t)l * 32 * 1024 * 512, 512, 1024, WSP(bf16_t, WS_WGU), (size_t)1024 * 1024, gn, 0, tile, sl);
        else if (which == 1) conv_slab<2>(INP(36) + (size_t)l * 32 * 1024 * 512, 512, 1024, WSP(bf16_t, WS_WGU), (size_t)1024 * 1024, gn, 0, tile, sl);
        else                 conv_slab<0>(INP(37) + (size_t)l * 32 * 512 * 1024, 1024, 512, WSP(bf16_t, WS_WD), (size_t)1024 * 512, nullptr, 0, tile, sl);
    }
}

__device__ __forceinline__ void rows_convert(const float* __restrict__ src, float* __restrict__ dstf, bf16_t* __restrict__ dstb, float* __restrict__ ss, int nrows) {
    const int wave = otid() >> 6, lane = otid() & 63;
    for (int r = oblk() * 8 + wave; r < nrows; r += ogrid() * 8) {
        float sq = 0.f;
#pragma unroll
        for (int i = 0; i < 4; ++i) {
            const int c = i * 256 + lane * 4;
            const f32x4 v = *(const f32x4*)(src + (size_t)r * 1024 + c);
            if (dstf) *(f32x4*)(dstf + (size_t)r * 1024 + c) = v;
            u32x2 w; w.x = pk2(v[0], v[1]); w.y = pk2(v[2], v[3]);
            *(u32x2*)(dstb + (size_t)r * 1024 + c) = w;
            sq += (v[0] * v[0] + v[1] * v[1]) + (v[2] * v[2] + v[3] * v[3]);
        }
        sq = wsum(sq);
        if (lane < 16) ss[(size_t)r * 16 + lane] = (lane == 0) ? sq : 0.f;
    }
}

__device__ __forceinline__ void p0_prologue(const PA a, LAS unsigned char* lds) {
    LAS float* tile = (LAS float*)lds;
    for (int l = 0; l < NL; ++l) {
        conv_T<0>(INP(3) + (size_t)l * 1024 * INW, 1024, INW, 1024, WSP(bf16_t, WS_WIN) + (size_t)l * INW * 1024, 0, INP(2) + l * 1024, 0, tile);
        conv_T<0>(INP(22) + (size_t)l * 1024 * 1024, 1024, 1024, 1024, WSP(bf16_t, WS_WOUT) + (size_t)l * 1024 * 1024, 0, INP(21) + l * 512, 512, tile);
        conv_T<0>(INP(25) + (size_t)l * 1024 * 512, 1024, 512, 1024, WSP(bf16_t, WS_WQ) + (size_t)l * 512 * 1024, 0, INP(23) + l * 1024, 0, tile);
        conv_T<0>(INP(26) + (size_t)l * 1024 * 1024, 1024, 1024, 1024, WSP(bf16_t, WS_WKV) + (size_t)l * 1024 * 1024, 0, INP(24) + l * 1024, 0, tile);
        conv_T<0>(INP(27) + (size_t)l * 512 * 1024, 512, 1024, 512, WSP(bf16_t, WS_WO) + (size_t)l * 1024 * 512, 0, nullptr, 0, tile);
    }
    {
        bf16_t* wrh = WSP(bf16_t, WS_WRH); bf16_t* wrl = WSP(bf16_t, WS_WRL);
        for (int idx = oblk() * 512 + otid(); idx < NL * 48 * 1024; idx += ogrid() * 512) {
            const int k = idx & 1023, r = (idx >> 10) % 48, l = idx / (48 * 1024);
            float w;
            if (r < 16) w = INP(31)[((size_t)l * 1024 + k) * 4 + (r & 3)];
            else { const int ri = ((r >> 2) & 3) * 8 + ((r >> 4) - 1) * 4 + (r & 3); w = INP(33)[((size_t)l * 1024 + k) * 32 + ri]; }
            w *= INP(30)[l * 1024 + k];
            const bf16_t hi = f2bf(w);
            wrh[idx] = hi; wrl[idx] = f2bf(w - bf2f(hi));
        }
    }
    rows_convert(INP(0), a.out, WSP(bf16_t, WS_XB), WSP(float, WS_SS), T);
    rows_convert(INP(1), nullptr, WSP(bf16_t, WS_MEMB), WSP(float, WS_MEMSS), MROWS);
}

__device__ __forceinline__ void p2_knorm(const PA a, LAS unsigned char* lds) {
    const int wave = otid() >> 6, lane = otid() & 63;
    bf16_t* kv = WSP(bf16_t, WS_KV);
    for (int it = oblk() * 8 + wave; it < NL * MROWS * 4; it += ogrid() * 8) {
        const int h = it & 3, row = (it >> 2) & (MROWS - 1), l = it >> 14;
        unsigned* p = (unsigned*)(kv + ((size_t)l * MROWS + row) * 1024 + h * 128 + lane * 2);
        const unsigned w = *p; const float x0 = lo16(w), x1 = hi16(w);
        const float ssq = wsum(x0 * x0 + x1 * x1);
        const float rinv = rsqrtf(ssq * (1.0f / 128.0f) + 1e-6f);
        const float* gk = INP(29) + l * 128 + lane * 2;
        *p = pk2(x0 * rinv * gk[0], x1 * rinv * gk[1]);
    }
    bf16_t* vtx = WSP(bf16_t, WS_VTX);
    const int tid = otid();
    for (int it = oblk(); it < NL * 16 * 4; it += ogrid()) {
        const int h = it & 3, b = (it >> 2) & 15, l = it >> 6;
        const bf16_t* src = kv + ((size_t)l * MROWS + b * 256) * 1024 + 512 + h * 128;
        bf16_t* dst = vtx + (size_t)it * 128 * 256;
#pragma unroll 1
        for (int i = 0; i < 8; ++i) {
            const int p = tid + i * 512, d = p & 127, m8 = (p >> 7) * 8;
            unsigned short x[8];
#pragma unroll
            for (int j = 0; j < 8; ++j) x[j] = src[(size_t)(m8 + j) * 1024 + d];
            u32x4 w; w.x = x[0] | ((unsigned)x[1] << 16); w.y = x[2] | ((unsigned)x[3] << 16); w.z = x[4] | ((unsigned)x[5] << 16); w.w = x[6] | ((unsigned)x[7] << 16);
            *(u32x4*)(dst + (size_t)d * 256 + m8) = w;
        }
    }
}

__device__ __forceinline__ float fast_tanh(float x) { return 1.0f - 2.0f * __builtin_amdgcn_rcpf(1.0f + __expf(2.0f * x)); }
__device__ __forceinline__ float fast_sigmoid(float x) { return __builtin_amdgcn_rcpf(1.0f + __expf(-x)); }
template <int MODE>
__device__ __forceinline__ bf16x8 mixfrag(const bf16_t* pu, const bf16_t* pp, float hpf, const LAS float* mu, int col) {
    const u32x4 u = *(const u32x4*)(pu + col), p = *(const u32x4*)(pp + col);
    const f32x4 m0 = *(const LAS f32x4*)(mu + col), m1 = *(const LAS f32x4*)(mu + col + 4);
    float x[8];
#pragma unroll
    for (int j = 0; j < 4; ++j) {
        const float u0 = lo16(u[j]), u1 = hi16(u[j]), p0 = lo16(p[j]) * hpf, p1 = hi16(p[j]) * hpf;
        const float ma = (j < 2) ? m0[2 * j] : m1[2 * j - 4], mb = (j < 2) ? m0[2 * j + 1] : m1[2 * j - 3];
        x[2 * j] = u0 + ma * (p0 - u0); x[2 * j + 1] = u1 + mb * (p1 - u1);
    }
#pragma unroll
    for (int j = 0; j < 8; ++j) { if (MODE == 1) x[j] = fast_tanh(x[j]); if (MODE == 2) x[j] = fast_sigmoid(x[j]); }
    u32x4 w; w.x = pk2(x[0], x[1]); w.y = pk2(x[2], x[3]); w.z = pk2(x[4], x[5]); w.w = pk2(x[6], x[7]);
    return __builtin_bit_cast(bf16x8, w);
}
__device__ __forceinline__ void pb_prep(const PA a, int l, LAS unsigned char* lds) {
    const int tid = otid(), wave = tid >> 6, lane = tid & 63, fr = lane & 15, fq = lane >> 4;
    const int G = ogrid(), blk = oblk();
    LAS bf16_t* s_w2 = (LAS bf16_t*)lds;
    LAS bf16_t* s_a2 = (LAS bf16_t*)(lds + 18432);
    LAS bf16_t* s_g2 = (LAS bf16_t*)(lds + 36864);
    LAS bf16_t* s_v2 = (LAS bf16_t*)(lds + 71680);
    LAS bf16_t* s_v1 = (LAS bf16_t*)(lds + 81920);
    LAS float* s_par = (LAS float*)(lds + 115200);
    LAS float* s_mux = s_par + 1024;
    bf16_t* proj = WSP(bf16_t, WS_PROJ);
    const float* mu = INP(4) + l * 1792;
    const float* w0 = INP(5) + l * 512;  const float* w2 = INP(6) + (size_t)l * 64 * 512;
    const float* a0 = INP(7) + l * 512;  const float* a2 = INP(8) + (size_t)l * 64 * 512;
    const float* g2 = INP(9) + (size_t)l * 128 * 512;
    const float* kkw = INP(10) + l * 512; const float* kaw = INP(11) + l * 512;
    const int lv = l > 0 ? l - 1 : 0;
    const float* v0 = INP(15) + lv * 512; const float* v1 = INP(16) + (size_t)lv * 512 * 32; const float* v2 = INP(17) + (size_t)lv * 32 * 512;
    const float* qgn = INP(18) + l * 64; const float* kgn = INP(19) + l * 64;
    bf16_t* SR = WSP(bf16_t, WS_SR); bf16_t* SK = WSP(bf16_t, WS_SK); bf16_t* SV = WSP(bf16_t, WS_SV);
    bf16_t* SA = WSP(bf16_t, WS_SA); bf16_t* SB = WSP(bf16_t, WS_SB); bf16_t* SG = WSP(bf16_t, WS_SG);
    float* SWD = WSP(float, WS_SWD); bf16_t* VF = WSP(bf16_t, WS_VF);
    int cur_hp = -1;
    for (int item = blk; item < 4 * (T / 128); item += G) {
        const int hp = item & 3, tt = item >> 2;
        if (hp != cur_hp) {
            __syncthreads();
            const int chb = hp * 128;
            for (int idx = tid; idx < 64 * 128; idx += 512) { const int ch = idx & 127, k = idx >> 7;
                s_w2[ch * 72 + k] = f2bf(w2[k * 512 + chb + ch]); s_a2[ch * 72 + k] = f2bf(a2[k * 512 + chb + ch]); }
            for (int idx = tid; idx < 128 * 128; idx += 512) { const int ch = idx & 127, k = idx >> 7; s_g2[ch * 136 + k] = f2bf(g2[k * 512 + chb + ch]); }
            if (l > 0) {
                for (int idx = tid; idx < 32 * 128; idx += 512) { const int ch = idx & 127, k = idx >> 7; s_v2[ch * 40 + k] = f2bf(v2[k * 512 + chb + ch]); }
                for (int idx = tid; idx < 512 * 32; idx += 512) { const int n = idx & 31, k = idx >> 5; s_v1[n * 520 + k] = f2bf(v1[k * 32 + n]); }
            }
            if (tid < 128) { s_par[tid] = mu[chb + tid]; s_par[128 + tid] = mu[512 + chb + tid]; s_par[256 + tid] = mu[1024 + chb + tid]; s_par[384 + tid] = w0[chb + tid];
                             s_par[512 + tid] = a0[chb + tid]; s_par[640 + tid] = kkw[chb + tid]; s_par[768 + tid] = kaw[chb + tid]; s_par[896 + tid] = v0[chb + tid]; }
            for (int idx = tid; idx < 768; idx += 512) s_mux[idx] = mu[1024 + idx];
            __syncthreads();
            cur_hp = hp;
        }
        const int t = tt * 128 + wave * 16 + fr;
        const bool hpv = (t & (SEQ - 1)) != 0;
        const bf16_t* pu = proj + (size_t)t * INW;
        const bf16_t* pp = hpv ? pu - INW : pu;
        const float hpf = hpv ? 1.0f : 0.0f;
        bf16x8 fwl[2], fal[2], fgl[4], ft32;
#pragma unroll
        for (int s = 0; s < 2; ++s) { fwl[s] = mixfrag<1>(pu, pp, hpf, s_mux - 1024, 1536 + 32 * s + 8 * fq); fal[s] = mixfrag<0>(pu, pp, hpf, s_mux - 1024, 1600 + 32 * s + 8 * fq); }
#pragma unroll
        for (int s = 0; s < 4; ++s) fgl[s] = mixfrag<2>(pu, pp, hpf, s_mux - 1024, 1664 + 32 * s + 8 * fq);
        ft32 = fwl[0];
        if (l > 0) {
            f32x4 c0 = {0.f, 0.f, 0.f, 0.f}, c1 = {0.f, 0.f, 0.f, 0.f};
#pragma unroll 8
            for (int s = 0; s < 16; ++s) {
                const bf16x8 xf = mixfrag<0>(pu, pp, hpf, s_mux - 1024, 1024 + 32 * s + 8 * fq);
                const bf16x8 wa = *(const LAS bf16x8*)(s_v1 + fr * 520 + 32 * s + 8 * fq), wb = *(const LAS bf16x8*)(s_v1 + (16 + fr) * 520 + 32 * s + 8 * fq);
                c0 = __builtin_amdgcn_mfma_f32_16x16x32_bf16(wa, xf, c0, 0, 0, 0);
                c1 = __builtin_amdgcn_mfma_f32_16x16x32_bf16(wb, xf, c1, 0, 0, 0);
            }
            u32x4 w; w.x = pk2(c0[0], c0[1]); w.y = pk2(c0[2], c0[3]); w.z = pk2(c1[0], c1[1]); w.w = pk2(c1[2], c1[3]);
            ft32 = __builtin_bit_cast(bf16x8, w);
        }
#pragma unroll 1
        for (int hh = 0; hh < 2; ++hh) {
            float kkv[4][4], avv[4][4];
            float kss = 0.f;
            u32x2 Lur[4], Lpr[4], Luk[4], Lpk[4], Luv[4], Lpv[4], Lvf[4];
#pragma unroll
            for (int nt = 0; nt < 4; ++nt) {
                const int ch4 = hp * 128 + hh * 64 + nt * 16 + 4 * fq;
                Lur[nt] = *(const u32x2*)(pu + ch4); Lpr[nt] = *(const u32x2*)(pp + ch4);
                Luk[nt] = *(const u32x2*)(pu + 512 + ch4); Lpk[nt] = *(const u32x2*)(pp + 512 + ch4);
                Luv[nt] = *(const u32x2*)(pu + 1024 + ch4); Lpv[nt] = *(const u32x2*)(pp + 1024 + ch4);
                Lvf[nt] = (l > 0) ? *(const u32x2*)(VF + (size_t)t * 512 + ch4) : (u32x2){0u, 0u};
            }
#pragma unroll
            for (int nt = 0; nt < 4; ++nt) {
                const int lc = hh * 64 + nt * 16, ch4 = hp * 128 + lc + 4 * fq;
                f32x4 aw = {0.f, 0.f, 0.f, 0.f}, aa = aw, ag = aw, az = aw;
#pragma unroll
                for (int s = 0; s < 2; ++s) {
                    aw = __builtin_amdgcn_mfma_f32_16x16x32_bf16(*(const LAS bf16x8*)(s_w2 + (lc + fr) * 72 + 32 * s + 8 * fq), fwl[s], aw, 0, 0, 0);
                    aa = __builtin_amdgcn_mfma_f32_16x16x32_bf16(*(const LAS bf16x8*)(s_a2 + (lc + fr) * 72 + 32 * s + 8 * fq), fal[s], aa, 0, 0, 0);
                }
#pragma unroll
                for (int s = 0; s < 4; ++s) ag = __builtin_amdgcn_mfma_f32_16x16x32_bf16(*(const LAS bf16x8*)(s_g2 + (lc + fr) * 136 + 32 * s + 8 * fq), fgl[s], ag, 0, 0, 0);
                if (l > 0) {
                    const u32x2 q0 = *(const LAS u32x2*)(s_v2 + (lc + fr) * 40 + 4 * fq), q1 = *(const LAS u32x2*)(s_v2 + (lc + fr) * 40 + 16 + 4 * fq);
                    u32x4 w; w.x = q0.x; w.y = q0.y; w.z = q1.x; w.w = q1.y;
                    az = __builtin_amdgcn_mfma_f32_16x16x32_bf16(__builtin_bit_cast(bf16x8, w), ft32, az, 0, 0, 0);
                }
                const u32x2 ur = Lur[nt], pr = Lpr[nt], uk = Luk[nt], pk = Lpk[nt], uv = Luv[nt], pv = Lpv[nt];
                const int pc4 = lc + 4 * fq;
                const f32x4 mr = *(const LAS f32x4*)(s_par + pc4), mk = *(const LAS f32x4*)(s_par + 128 + pc4), mv = *(const LAS f32x4*)(s_par + 256 + pc4);
                const f32x4 w0v = *(const LAS f32x4*)(s_par + 384 + pc4), a0v = *(const LAS f32x4*)(s_par + 512 + pc4), kkwv = *(const LAS f32x4*)(s_par + 640 + pc4), kawv = *(const LAS f32x4*)(s_par + 768 + pc4);
                float xr[4], xk[4], xv[4];
                { const float u0 = lo16(ur.x), u1 = hi16(ur.x), u2 = lo16(ur.y), u3 = hi16(ur.y);
                  xr[0] = u0 + mr[0] * (lo16(pr.x) * hpf - u0); xr[1] = u1 + mr[1] * (hi16(pr.x) * hpf - u1); xr[2] = u2 + mr[2] * (lo16(pr.y) * hpf - u2); xr[3] = u3 + mr[3] * (hi16(pr.y) * hpf - u3); }
                { const float u0 = lo16(uk.x), u1 = hi16(uk.x), u2 = lo16(uk.y), u3 = hi16(uk.y);
                  xk[0] = u0 + mk[0] * (lo16(pk.x) * hpf - u0); xk[1] = u1 + mk[1] * (hi16(pk.x) * hpf - u1); xk[2] = u2 + mk[2] * (lo16(pk.y) * hpf - u2); xk[3] = u3 + mk[3] * (hi16(pk.y) * hpf - u3); }
                { const float u0 = lo16(uv.x), u1 = hi16(uv.x), u2 = lo16(uv.y), u3 = hi16(uv.y);
                  xv[0] = u0 + mv[0] * (lo16(pv.x) * hpf - u0); xv[1] = u1 + mv[1] * (hi16(pv.x) * hpf - u1); xv[2] = u2 + mv[2] * (lo16(pv.y) * hpf - u2); xv[3] = u3 + mv[3] * (hi16(pv.y) * hpf - u3); }
                const size_t o = (size_t)t * 512 + ch4;
                if (l > 0) {
                    const f32x4 v0v = *(const LAS f32x4*)(s_par + 896 + pc4);
                    const u32x2 vfw = Lvf[nt];
                    const float vf0 = lo16(vfw.x), vf1 = hi16(vfw.x), vf2 = lo16(vfw.y), vf3 = hi16(vfw.y);
                    xv[0] += (vf0 - xv[0]) * fast_sigmoid(v0v[0] + az[0]); xv[1] += (vf1 - xv[1]) * fast_sigmoid(v0v[1] + az[1]);
                    xv[2] += (vf2 - xv[2]) * fast_sigmoid(v0v[2] + az[2]); xv[3] += (vf3 - xv[3]) * fast_sigmoid(v0v[3] + az[3]);
                } else {
                    u32x2 w; w.x = pk2(xv[0], xv[1]); w.y = pk2(xv[2], xv[3]); *(u32x2*)(VF + o) = w;
                }
                f32x4 dec; float kmod[4];
#pragma unroll
                for (int j = 0; j < 4; ++j) {
                    dec[j] = __expf(-0.6065306597f * fast_sigmoid(w0v[j] + aw[j]));
                    const float av = fast_sigmoid(a0v[j] + aa[j]);
                    const float kk = xk[j] * kkwv[j];
                    kkv[nt][j] = kk; avv[nt][j] = av; kss += kk * kk;
                    kmod[j] = xk[j] * (1.0f + (av - 1.0f) * kawv[j]);
                }
                { u32x2 w; w.x = pk2(xr[0], xr[1]); w.y = pk2(xr[2], xr[3]); *(u32x2*)(SR + o) = w; }
                { u32x2 w; w.x = pk2(xv[0], xv[1]); w.y = pk2(xv[2], xv[3]); *(u32x2*)(SV + o) = w; }
                { u32x2 w; w.x = pk2(ag[0], ag[1]); w.y = pk2(ag[2], ag[3]); *(u32x2*)(SG + o) = w; }
                { u32x2 w; w.x = pk2(kmod[0], kmod[1]); w.y = pk2(kmod[2], kmod[3]); *(u32x2*)(SK + o) = w; }
                *(f32x4*)(SWD + o) = dec;
            }
            kss += __shfl_xor(kss, 16); kss += __shfl_xor(kss, 32);
            const float rn = rsqrtf(fmaxf(kss, 1e-24f));
#pragma unroll
            for (int nt = 0; nt < 4; ++nt) {
                const size_t o = (size_t)t * 512 + hp * 128 + hh * 64 + nt * 16 + 4 * fq;
                float kn[4];
#pragma unroll
                for (int j = 0; j < 4; ++j) kn[j] = kkv[nt][j] * rn;
                { u32x2 w; w.x = pk2(-kn[0], -kn[1]); w.y = pk2(-kn[2], -kn[3]); *(u32x2*)(SA + o) = w; }
                { u32x2 w; w.x = pk2(kn[0] * avv[nt][0], kn[1] * avv[nt][1]); w.y = pk2(kn[2] * avv[nt][2], kn[3] * avv[nt][3]); *(u32x2*)(SB + o) = w; }
            }
        }
        {
            u32x4 Lq[4][2];
#pragma unroll
            for (int qk = 0; qk < 4; ++qk) {
                const bf16_t* p = proj + (size_t)t * INW + 1792 + (qk & 1) * 512 + (hp * 2 + (qk >> 1)) * 64 + fq * 16;
                Lq[qk][0] = *(const u32x4*)p; Lq[qk][1] = *(const u32x4*)(p + 8);
            }
#pragma unroll
            for (int qk = 0; qk < 4; ++qk) {
                const float* gn = (qk & 1) ? kgn : qgn;
                bf16_t* p = proj + (size_t)t * INW + 1792 + (qk & 1) * 512 + (hp * 2 + (qk >> 1)) * 64 + fq * 16;
                const u32x4 wa = Lq[qk][0], wb = Lq[qk][1];
                float x[16];
#pragma unroll
                for (int j = 0; j < 4; ++j) { x[2 * j] = lo16(wa[j]); x[2 * j + 1] = hi16(wa[j]); x[8 + 2 * j] = lo16(wb[j]); x[9 + 2 * j] = hi16(wb[j]); }
                float ssq = 0.f;
#pragma unroll
                for (int j = 0; j < 16; ++j) ssq += x[j] * x[j];
                ssq += __shfl_xor(ssq, 16); ssq += __shfl_xor(ssq, 32);
                const float rinv = rsqrtf(ssq * (1.0f / 64.0f) + 1e-6f);
                const float qsc = (qk & 1) ? rinv : rinv * 0.18033688011112042f;
#pragma unroll
                for (int j = 0; j < 16; ++j) x[j] = x[j] * qsc * gn[fq * 16 + j];
                u32x4 oa, ob;
#pragma unroll
                for (int j = 0; j < 4; ++j) { oa[j] = pk2(x[2 * j], x[2 * j + 1]); ob[j] = pk2(x[8 + 2 * j], x[9 + 2 * j]); }
                *(u32x4*)p = oa; *(u32x4*)(p + 8) = ob;
            }
        }
    }
    __syncthreads();
}

__device__ __forceinline__ void pb2_chunks(const PA a, int l, LAS unsigned char* lds) {
    const int tid = otid(), wave = tid >> 6, lane = tid & 63, fr = lane & 15, fq = lane >> 4;
    LAS bf16_t* sA = (LAS bf16_t*)(lds + wave * 11520);
    LAS bf16_t* sR = sA + 1152; LAS bf16_t* sB = sR + 1152; LAS bf16_t* sK = sB + 1152; LAS bf16_t* sX = sK + 1152;
    LAS float* nb = (LAS float*)(lds + 8 * 11520) + wave * 256;
    bf16_t* SR = WSP(bf16_t, WS_SR); bf16_t* SK = WSP(bf16_t, WS_SK); bf16_t* SV = WSP(bf16_t, WS_SV);
    bf16_t* SA = WSP(bf16_t, WS_SA); bf16_t* SB = WSP(bf16_t, WS_SB); const float* SWD = WSP(const float, WS_SWD);
    const float* rkp = INP(12) + l * 512;
    for (int cid = oblk() * 8 + wave; cid < NCHUNK; cid += ogrid() * 8) {
        const int b = cid >> 10, h = (cid >> 7) & 7, c = cid & 127;
        const size_t tok0 = (size_t)b * SEQ + c * 16;
        const size_t e0 = tok0 * 512 + h * 64 + lane;
        const float rkv = rkp[h * 64 + lane];
        const int posl = (lane & 32) | (((lane & 15) >> 2) << 3) | (((lane >> 4) & 1) << 2) | (lane & 3);
        float P = 1.0f;
        unsigned bt2[8], kt2[8], vt2[8];
#pragma unroll
        for (int hf = 0; hf < 2; ++hf) {
            bf16_t r16[8], k16[8], a16[8], b16[8], v16[8]; float w32[8];
#pragma unroll
            for (int t8 = 0; t8 < 8; ++t8) { const size_t e = e0 + (size_t)(hf * 8 + t8) * 512; r16[t8] = SR[e]; k16[t8] = SK[e]; a16[t8] = SA[e]; b16[t8] = SB[e]; v16[t8] = SV[e]; w32[t8] = SWD[e]; }
#pragma unroll
            for (int t8 = 0; t8 < 8; ++t8) {
                const int t = hf * 8 + t8;
                const float rr = bf2f(r16[t8]), kk = bf2f(k16[t8]), aa = bf2f(a16[t8]), bb = bf2f(b16[t8]);
                const float Pm = P; P *= w32[t8]; const float ip = 1.0f / P;
                const unsigned ar = pk2(aa * Pm, rr * P), bk = pk2(bb * ip, kk * ip);
                const bf16_t at = (bf16_t)(ar & 0xffffu), rt = (bf16_t)(ar >> 16), btv = (bf16_t)(bk & 0xffffu), ktv = (bf16_t)(bk >> 16);
                { const size_t es = tok0 * 512 + (size_t)t * 512 + h * 64 + (posl ^ ((t & 7) << 3)); SA[es] = at; SR[es] = rt; }
                sA[t * 72 + lane] = at; sR[t * 72 + lane] = rt; sB[t * 72 + lane] = btv; sK[t * 72 + lane] = ktv;
                sX[t * 72 + lane] = (bf16_t)(pk2(rr * kk * rkv, 0.f) & 0xffffu);
                if (t & 1) { bt2[t >> 1] |= (unsigned)btv << 16; kt2[t >> 1] |= (unsigned)ktv << 16; vt2[t >> 1] |= (unsigned)v16[t8] << 16; }
                else       { bt2[t >> 1] = btv; kt2[t >> 1] = ktv; vt2[t >> 1] = v16[t8]; }
            }
        }
        WSP(float, WS_PCK)[(size_t)cid * 64 + lane] = P;
        {
            u32x4* pb_ = (u32x4*)(WSP(bf16_t, WS_BTT) + (size_t)cid * 2048 + lane * 32);
            u32x4* pv_ = (u32x4*)(WSP(bf16_t, WS_VST) + (size_t)cid * 1024 + lane * 16);
#pragma unroll
            for (int q = 0; q < 4; ++q) pb_[q] = (u32x4){bt2[2 * q], bt2[2 * q + 1], kt2[2 * q], kt2[2 * q + 1]};
            pv_[0] = (u32x4){vt2[0], vt2[1], vt2[2], vt2[3]}; pv_[1] = (u32x4){vt2[4], vt2[5], vt2[6], vt2[7]};
        }
        bf16x8 fA[2], fR[2], fB[2], fK[2], fX[2];
#pragma unroll
        for (int s_ = 0; s_ < 2; ++s_) {
            fA[s_] = *(const LAS bf16x8*)(sA + fr * 72 + 32 * s_ + 8 * fq); fR[s_] = *(const LAS bf16x8*)(sR + fr * 72 + 32 * s_ + 8 * fq);
            fB[s_] = *(const LAS bf16x8*)(sB + fr * 72 + 32 * s_ + 8 * fq); fK[s_] = *(const LAS bf16x8*)(sK + fr * 72 + 32 * s_ + 8 * fq);
            fX[s_] = *(const LAS bf16x8*)(sX + fr * 72 + 32 * s_ + 8 * fq);
        }
        const f32x4 z4 = {0.f, 0.f, 0.f, 0.f};
        const bf16x8 ones = {0x3f80, 0x3f80, 0x3f80, 0x3f80, 0x3f80, 0x3f80, 0x3f80, 0x3f80};
        const f32x4 nka = __builtin_amdgcn_mfma_f32_16x16x32_bf16(fA[1], fK[1], __builtin_amdgcn_mfma_f32_16x16x32_bf16(fA[0], fK[0], z4, 0, 0, 0), 0, 0, 0);
        const f32x4 nbr = __builtin_amdgcn_mfma_f32_16x16x32_bf16(fR[1], fB[1], __builtin_amdgcn_mfma_f32_16x16x32_bf16(fR[0], fB[0], z4, 0, 0, 0), 0, 0, 0);
        const f32x4 nkr = __builtin_amdgcn_mfma_f32_16x16x32_bf16(fR[1], fK[1], __builtin_amdgcn_mfma_f32_16x16x32_bf16(fR[0], fK[0], z4, 0, 0, 0), 0, 0, 0);
        const f32x4 nba = __builtin_amdgcn_mfma_f32_16x16x32_bf16(fB[1], fA[1], __builtin_amdgcn_mfma_f32_16x16x32_bf16(fB[0], fA[0], z4, 0, 0, 0), 0, 0, 0);
        const f32x4 bsm = __builtin_amdgcn_mfma_f32_16x16x32_bf16(fX[1], ones, __builtin_amdgcn_mfma_f32_16x16x32_bf16(fX[0], ones, z4, 0, 0, 0), 0, 0, 0);
        bf16_t* gim = WSP(bf16_t, WS_NKA) + (size_t)cid * 1024;
        const int ncol = (fr >> 2) * 8 + (fr & 3);
#pragma unroll
        for (int j = 0; j < 4; ++j) {
            const int row = 4 * fq + j;
            gim[row * 32 + ncol + 4] = f2bf(fr < row ? nka[j] : 0.f);
            gim[512 + row * 32 + ncol] = f2bf(fr <= row ? nbr[j] : 0.f);
            gim[512 + row * 32 + ncol + 4] = f2bf(fr <= row ? nkr[j] : 0.f);
            nb[row * 16 + fr] = (row < fr) ? nba[j] : 0.f;
            if (fr == 0) WSP(float, WS_BS)[(tok0 + row) * 8 + h] = bsm[j];
        }
        if (lane < 16) {
            float X[16];
            bf16_t* gtm = WSP(bf16_t, WS_NKA) + (size_t)cid * 1024; const int tcolp = (lane >> 2) * 8 + (lane & 3);
#pragma unroll
            for (int tcol = 0; tcol < 16; ++tcol) {
                float acc = (lane == tcol) ? 1.0f : 0.0f;
#pragma unroll
                for (int i = 0; i < tcol; ++i) acc += X[i] * nb[i * 16 + tcol];
                X[tcol] = acc;
                gtm[tcol * 32 + tcolp] = f2bf(acc);
            }
        }
    }
    __syncthreads();
}

__device__ __forceinline__ void scan_item(const PA a, int l, int bh, LAS unsigned char* lds) {
    const int tid = otid(), wave = __builtin_amdgcn_readfirstlane(tid >> 6), lane = tid & 63, fr = lane & 15, fq = lane >> 4;
    const int b = __builtin_amdgcn_readfirstlane(bh >> 3), h = __builtin_amdgcn_readfirstlane(bh & 7);
    constexpr int SLOT = 15104, NS = 8, DPF = 6;
    constexpr int OA = 0, OR_ = 2048, OBK = 4096, OVT = 8192, ON = 10240, OPC = 12288, OBS = 12544, OSG = 13056;
    constexpr int YBO = NS * SLOT;
    const size_t tokb = (size_t)b * SEQ;
    const int cid0 = (b * 8 + h) * 128;
    const unsigned char* gA = (const unsigned char*)WSP(const bf16_t, WS_SA); const unsigned char* gR = (const unsigned char*)WSP(const bf16_t, WS_SR);
    const unsigned char* gG = (const unsigned char*)WSP(const bf16_t, WS_SG);
    const unsigned char* gBK = (const unsigned char*)WSP(const bf16_t, WS_BTT);
    const unsigned char* gVT = (const unsigned char*)WSP(const bf16_t, WS_VST); const unsigned char* gN = (const unsigned char*)WSP(const bf16_t, WS_NKA);
    const unsigned char* gPC = (const unsigned char*)WSP(const float, WS_PCK); const unsigned char* gBS = (const unsigned char*)WSP(const float, WS_BS);
#define DMA16(gp, ldsoff) __builtin_amdgcn_global_load_lds((const unsigned*)(gp), (LAS unsigned*)(lds + (ldsoff)), 16, 0, 0)
    const unsigned rowoff0 = (unsigned)(((lane >> 3) * 512 + (lane & 7) * 8) * 2), rowoff1 = rowoff0 + 8u * 512u * 2u;
#define DMA_CHUNK(c_) do { const int cid_ = cid0 + (c_); const int so_ = ((c_) % NS) * SLOT; \
        const size_t rb_ = ((tokb + (size_t)(c_) * 16) * 512 + h * 64) * 2; \
        if (wave == 4) { \
            DMA16(gA + rb_ + rowoff0, so_ + OA); DMA16(gA + rb_ + rowoff1, so_ + OA + 1024); DMA16(gR + rb_ + rowoff0, so_ + OR_); DMA16(gR + rb_ + rowoff1, so_ + OR_ + 1024); \
            DMA16(gBK + (size_t)cid_ * 4096 + lane * 16, so_ + OBK); DMA16(gBK + (size_t)cid_ * 4096 + 1024 + lane * 16, so_ + OBK + 1024); \
            DMA16(gBK + (size_t)cid_ * 4096 + 2048 + lane * 16, so_ + OBK + 2048); DMA16(gBK + (size_t)cid_ * 4096 + 3072 + lane * 16, so_ + OBK + 3072); \
            if (lane < 16) DMA16(gPC + (size_t)cid_ * 256 + lane * 16, so_ + OPC); \
        } else { \
            DMA16(gVT + (size_t)cid_ * 2048 + lane * 16, so_ + OVT); DMA16(gVT + (size_t)cid_ * 2048 + 1024 + lane * 16, so_ + OVT + 1024); \
            DMA16(gN + (size_t)cid_ * 2048 + lane * 16, so_ + ON); DMA16(gN + (size_t)cid_ * 2048 + 1024 + lane * 16, so_ + ON + 1024); \
            DMA16(gG + rb_ + rowoff0, so_ + OSG); DMA16(gG + rb_ + rowoff1, so_ + OSG + 1024); \
            if (lane < 32) DMA16(gBS + (tokb + (size_t)(c_) * 16) * 32 + lane * 16, so_ + OBS); \
            if (lane < 1) DMA16(gPC + (size_t)cid_ * 256, so_ + OPC); if (lane < 1) DMA16(gPC + (size_t)cid_ * 256, so_ + OPC); \
        } } while (0)
#define MF(a_, b_, c_) __builtin_amdgcn_mfma_f32_16x16x32_bf16((a_), (b_), (c_), 0, 0, 0)
#define LDF(off_) (*(const LAS bf16x8*)(sl + (off_)))
    const int swz = fr & 7;
    const int aoff0 = fr * 128 + ((fq) ^ swz) * 16, aoff1 = fr * 128 + ((4 + fq) ^ swz) * 16;
    const int noff = fr * 64 + fq * 16, voff = ((wave & 3) * 16 + fr) * 32 + 8 * fq;
    const float lw = INP(13)[l * 512 + h * 64 + lane], lb = INP(14)[l * 512 + h * 64 + lane];
    bf16_t* YC = WSP(bf16_t, WS_YCAT);
#define SCAN_EPI(cp_) do { const int cp = (cp_); \
        const unsigned slb = (unsigned)(unsigned long long)(lds + (cp % NS) * SLOT), ybb = (unsigned)(unsigned long long)(lds + YBO + (cp & 1) * 4352); \
          \
        f32x4 y0, y1, y2, y3; { const unsigned ya = ybb + fr * 272 + fq * 32; \
            asm volatile("ds_read_b128 %0, %4\n\tds_read_b128 %1, %4 offset:16\n\tds_read_b128 %2, %4 offset:128\n\tds_read_b128 %3, %4 offset:144\n\ts_waitcnt lgkmcnt(0)" \
                         : "=&v"(y0), "=&v"(y1), "=&v"(y2), "=&v"(y3) : "v"(ya) : "memory"); } \
        u32x4 f0, f1, g0, g1; \
        f0.x = pk2(y0[0], y0[1]); f0.y = pk2(y0[2], y0[3]); f0.z = pk2(y1[0], y1[1]); f0.w = pk2(y1[2], y1[3]); f1.x = pk2(y2[0], y2[1]); f1.y = pk2(y2[2], y2[3]); f1.z = pk2(y3[0], y3[1]); f1.w = pk2(y3[2], y3[3]); \
        g0.x = pk2(y0[0] * y0[0], y0[1] * y0[1]); g0.y = pk2(y0[2] * y0[2], y0[3] * y0[3]); g0.z = pk2(y1[0] * y1[0], y1[1] * y1[1]); g0.w = pk2(y1[2] * y1[2], y1[3] * y1[3]); \
        g1.x = pk2(y2[0] * y2[0], y2[1] * y2[1]); g1.y = pk2(y2[2] * y2[2], y2[3] * y2[3]); g1.z = pk2(y3[0] * y3[0], y3[1] * y3[1]); g1.w = pk2(y3[2] * y3[2], y3[3] * y3[3]); \
        const bf16x8 ones = {0x3f80, 0x3f80, 0x3f80, 0x3f80, 0x3f80, 0x3f80, 0x3f80, 0x3f80}; const f32x4 z4 = {0.f, 0.f, 0.f, 0.f}; \
        const f32x4 ssum = MF(__builtin_bit_cast(bf16x8, f1), ones, MF(__builtin_bit_cast(bf16x8, f0), ones, z4));        \
        const f32x4 sqsm = MF(__builtin_bit_cast(bf16x8, g1), ones, MF(__builtin_bit_cast(bf16x8, g0), ones, z4)); \
          \
        f32x4 rs4, mr4; \
        _Pragma("unroll") for (int j = 0; j < 4; ++j) { const float mean = ssum[j] * (1.0f / 64.0f); const float var = fmaxf(sqsm[j] * (1.0f / 64.0f) - mean * mean, 0.f); \
            rs4[j] = rsqrtf(var + 64e-5f); mr4[j] = -mean * rs4[j]; } \
        float eY[8], eB[8]; unsigned eV[8], eG[8]; \
        _Pragma("unroll") for (int i = 0; i < 8; ++i) { const int t = (wave - 6) * 8 + i; \
            const unsigned ay_ = ybb + (t * 68 + lane) * 4, ab_ = slb + OBS + t * 32 + h * 4, av_ = slb + OVT + lane * 32 + t * 2, ag_ = slb + OSG + t * 128 + lane * 2; \
            asm volatile("ds_read_b32 %0, %4\n\tds_read_b32 %1, %5\n\tds_read_u16 %2, %6\n\tds_read_u16 %3, %7" \
                         : "=&v"(eY[i]), "=&v"(eB[i]), "=&v"(eV[i]), "=&v"(eG[i]) : "v"(ay_), "v"(ab_), "v"(av_), "v"(ag_) : "memory"); } \
        asm volatile("s_waitcnt lgkmcnt(0)" ::: "memory"); \
        bf16_t* yrow = YC + (tokb + (size_t)cp * 16 + (wave - 6) * 8) * 1024 + h * 64;       \
        _Pragma("unroll") for (int i = 0; i < 8; ++i) { \
            asm volatile("" : "+v"(eY[i]), "+v"(eB[i]), "+v"(eV[i]), "+v"(eG[i])); \
            const int sl_ = ((wave - 6) * 2 + (i >> 2)) * 16; \
            const float rstd = __int_as_float(__builtin_amdgcn_readlane(__float_as_int(rs4[i & 3]), sl_)); \
            const float nmr = __int_as_float(__builtin_amdgcn_readlane(__float_as_int(mr4[i & 3]), sl_)); \
            const float vv = __uint_as_float(eV[i] << 16), g = __uint_as_float(eG[i] << 16); \
            const float o_ = (eY[i] * (rstd * lw) + (nmr * lw + lb) + eB[i] * vv) * g; \
            *(bf16_t*)((char*)(yrow + (size_t)i * 1024) + (unsigned)(lane * 2)) = (bf16_t)(pk2(o_, 0.f) & 0xffffu); } } while (0)
    f32x4 S[4];
#pragma unroll
    for (int kt = 0; kt < 4; ++kt) S[kt] = (f32x4){0.f, 0.f, 0.f, 0.f};
    __syncthreads();
    if (wave == 4 || wave == 5) {
#pragma unroll 1
        for (int c = 0; c < DPF; ++c) DMA_CHUNK(c);
        asm volatile("s_waitcnt vmcnt(0)" ::: "memory");
    }
    __syncthreads();
#pragma unroll 1
    for (int c = 0; c < 128; ++c) {
        if (wave < 4) {
            const LAS unsigned char* sl = lds + (c % NS) * SLOT;
            u32x4 s0w, s1w; s0w.x = pk2(S[0][0], S[0][1]); s0w.y = pk2(S[0][2], S[0][3]); s0w.z = pk2(S[1][0], S[1][1]); s0w.w = pk2(S[1][2], S[1][3]);
            s1w.x = pk2(S[2][0], S[2][1]); s1w.y = pk2(S[2][2], S[2][3]); s1w.z = pk2(S[3][0], S[3][1]); s1w.w = pk2(S[3][2], S[3][3]);
            const bf16x8 Sf0 = __builtin_bit_cast(bf16x8, s0w), Sf1 = __builtin_bit_cast(bf16x8, s1w);
            const u32x2 vm = *(const LAS u32x2*)(sl + OVT + voff);
            const bf16x8 TN = LDF(ON + noff), BN = LDF(ON + 1024 + noff);
            const f32x4 z4 = {0.f, 0.f, 0.f, 0.f};
            const bf16x8 ZV = __builtin_bit_cast(bf16x8, (u32x4){0u, 0u, vm.x, vm.y});
            f32x4 Wt = MF(LDF(OA + aoff0), Sf0, z4); Wt = MF(LDF(OA + aoff1), Sf1, Wt); Wt = MF(TN, ZV, Wt);
            const bf16x8 WZ = __builtin_bit_cast(bf16x8, (u32x4){pk2(Wt[0], Wt[1]), pk2(Wt[2], Wt[3]), 0u, 0u});
            const f32x4 Ut = MF(TN, WZ, z4);
            const bf16x8 UV = __builtin_bit_cast(bf16x8, (u32x4){pk2(Ut[0], Ut[1]), pk2(Ut[2], Ut[3]), vm.x, vm.y});
            f32x4 Yt = MF(LDF(OR_ + aoff0), Sf0, z4); Yt = MF(LDF(OR_ + aoff1), Sf1, Yt); Yt = MF(BN, UV, Yt);
#pragma unroll
            for (int kt = 0; kt < 4; ++kt) {
                const f32x4 pc = *(const LAS f32x4*)(sl + OPC + (kt * 16 + 4 * fq) * 4);
                S[kt] = MF(LDF(OBK + kt * 1024 + noff), UV, S[kt]) * pc;
            }
            LAS float* yb = (LAS float*)(lds + YBO + (c & 1) * 4352) + (wave & 3) * 16 + fr;
#pragma unroll
            for (int j = 0; j < 4; ++j) yb[(4 * fq + j) * 68] = Yt[j];
            asm volatile("s_waitcnt lgkmcnt(0)" ::: "memory");
        } else if (wave < 6) {
            if (c + DPF < 128) DMA_CHUNK(c + DPF);
            if (c >= DPF && c + DPF < 128) asm volatile("s_waitcnt vmcnt(45)" ::: "memory"); else asm volatile("s_waitcnt vmcnt(0)" ::: "memory");
        } else if (c > 0) {
            SCAN_EPI(c - 1);
        }
        asm volatile("" ::: "memory"); __builtin_amdgcn_s_barrier(); asm volatile("" ::: "memory");
    }
    if (wave >= 6) { SCAN_EPI(127); }
    asm volatile("s_waitcnt vmcnt(0)" ::: "memory");
    __syncthreads();
#undef SCAN_EPI
#undef DMA16
#undef DMA_CHUNK
#undef MF
#undef LDF
}

__device__ __forceinline__ void attn_item(const PA a, int l, int it, LAS unsigned char* lds) {
    const int tid = otid(), h = __builtin_amdgcn_readfirstlane(tid >> 6), lane = tid & 63, fr = lane & 15, fq = lane >> 4;
    const int b = it >> 5, c = it & 31;
    LAS float* s_bias = (LAS float*)(lds + LDS_MISC + 1024);
    LAS float* s_part = s_bias + 8 * 320;
    LAS float* tb = (LAS float*)lds + h * 1600;
    __syncthreads();
    for (int e = lane; e < 1600; e += 64) { const int r = e / 400, y = e - r * 400; int idx = 383 - (y + r); idx = idx > 319 ? 319 : (idx < 0 ? 0 : idx); tb[e] = s_bias[h * 320 + idx]; }
    const bf16_t* proj = WSP(const bf16_t, WS_PROJ);
    const bf16_t* VT = WSP(const bf16_t, WS_VT) + (size_t)(b * 8 + h) * 64 * 2048;
    const size_t tq0 = (size_t)b * SEQ + c * 64;
    bf16x8 qf[4][2];
#pragma unroll
    for (int nt = 0; nt < 4; ++nt)
#pragma unroll
        for (int ks = 0; ks < 2; ++ks) qf[nt][ks] = *(const bf16x8*)(proj + (tq0 + nt * 16 + fr) * INW + 1792 + h * 64 + 32 * ks + 8 * fq);
    f32x4 o[5][4];
#pragma unroll
    for (int dt = 0; dt < 5; ++dt)
#pragma unroll
        for (int nt = 0; nt < 4; ++nt) o[dt][nt] = (f32x4){0.f, 0.f, 0.f, 0.f};
    const int kc0 = c - 8 > 0 ? c - 8 : 0;
    const int nsteps = (c - kc0 + 1) * 2;
    const bf16x8 ones = {0x3f80, 0x3f80, 0x3f80, 0x3f80, 0x3f80, 0x3f80, 0x3f80, 0x3f80};
    const int rr = (4 - (fr & 3)) & 3;
    const unsigned tbl = (unsigned)(unsigned long long)(tb + rr * 400) + (unsigned)((320 - fr + 4 * fq - rr - 48) * 4);
    const bf16_t* kbase = proj + ((size_t)b * SEQ + kc0 * 64) * INW + 2304 + h * 64;
    const unsigned koff = (unsigned)((fr * INW + 8 * fq) * 2), voffb = (unsigned)((fr * 2048 + 8 * fq) * 2);
    const bf16_t* vbase = VT + kc0 * 64;
    bf16x8 kfA[2][2], kfB[2][2]; u32x4 vfA[4], vfB[4];
#define ATT_LOAD(KF, VF, st) do { unsigned ko_ = koff, vo_ = voffb; asm volatile("" : "+v"(ko_), "+v"(vo_)); \
        const char* kp_ = (const char*)(kbase + (size_t)(st) * 32 * INW); const char* vp_ = (const char*)(vbase + (st) * 32); \
        _Pragma("unroll") for (int mt = 0; mt < 2; ++mt) _Pragma("unroll") for (int ks = 0; ks < 2; ++ks) \
            KF[mt][ks] = *(const bf16x8*)(kp_ + (size_t)(mt * 16 * INW + 32 * ks) * 2 + ko_); \
        _Pragma("unroll") for (int dt = 0; dt < 4; ++dt) VF[dt] = *(const u32x4*)(vp_ + (size_t)(dt * 16 * 2048) * 2 + vo_); } while (0)
#define MF(a_, b_, c_) __builtin_amdgcn_mfma_f32_16x16x32_bf16((a_), (b_), (c_), 0, 0, 0)
#define ATT_STEP(KF, VF, st) do { \
        f32x4 sacc[2][4]; const f32x4 z4 = {0.f, 0.f, 0.f, 0.f}; \
        _Pragma("unroll") for (int mt = 0; mt < 2; ++mt) _Pragma("unroll") for (int nt = 0; nt < 4; ++nt) sacc[mt][nt] = MF(KF[mt][1], qf[nt][1], MF(KF[mt][0], qf[nt][0], z4)); \
        const int dk = c - (kc0 + ((st) >> 1)), half = (st) & 1; \
        if (dk >= 5) { const float bc = s_bias[h * 320 + 319]; \
            _Pragma("unroll") for (int mt = 0; mt < 2; ++mt) _Pragma("unroll") for (int nt = 0; nt < 4; ++nt) sacc[mt][nt] += bc; \
        } else { \
            const unsigned ta = tbl + (unsigned)((32 * half - 64 * dk + 256) * 4); f32x4 bv[5]; \
            _Pragma("unroll") for (int dd = 0; dd < 5; ++dd) bv[dd] = *(const LAS f32x4*)(unsigned long long)(ta - 1024u + (unsigned)((3 - (dd - 1)) * 64)); \
            _Pragma("unroll") for (int mt = 0; mt < 2; ++mt) _Pragma("unroll") for (int nt = 0; nt < 4; ++nt) sacc[mt][nt] += bv[nt - mt + 1]; } \
        bf16x8 pf[4]; \
        _Pragma("unroll") for (int nt = 0; nt < 4; ++nt) { \
            u32x4 w; w.x = pk2(__builtin_amdgcn_exp2f(sacc[0][nt][0]), __builtin_amdgcn_exp2f(sacc[0][nt][1])); w.y = pk2(__builtin_amdgcn_exp2f(sacc[0][nt][2]), __builtin_amdgcn_exp2f(sacc[0][nt][3])); \
            w.z = pk2(__builtin_amdgcn_exp2f(sacc[1][nt][0]), __builtin_amdgcn_exp2f(sacc[1][nt][1])); w.w = pk2(__builtin_amdgcn_exp2f(sacc[1][nt][2]), __builtin_amdgcn_exp2f(sacc[1][nt][3])); \
            pf[nt] = __builtin_bit_cast(bf16x8, w); } \
        _Pragma("unroll") for (int nt = 0; nt < 4; ++nt) { \
            _Pragma("unroll") for (int dt = 0; dt < 4; ++dt) o[dt][nt] = MF(__builtin_bit_cast(bf16x8, VF[dt]), pf[nt], o[dt][nt]); \
            o[4][nt] = MF(ones, pf[nt], o[4][nt]); } } while (0)
    ATT_LOAD(kfA, vfA, 0);
    __syncthreads();
#pragma unroll 1
    for (int st = 0; st < nsteps; st += 2) {
        ATT_LOAD(kfB, vfB, st + 1);
        ATT_STEP(kfA, vfA, st);
        if (st + 2 < nsteps) ATT_LOAD(kfA, vfA, st + 2);
        ATT_STEP(kfB, vfB, st + 1);
    }
#undef ATT_LOAD
#undef ATT_STEP
#undef MF
#pragma unroll
    for (int nt = 0; nt < 4; ++nt) {
        const float inv = 1.0f / o[4][nt][0];
        float sq = 0.f;
#pragma unroll
        for (int dt = 0; dt < 4; ++dt) { o[dt][nt] *= inv; sq += (o[dt][nt][0] * o[dt][nt][0] + o[dt][nt][1] * o[dt][nt][1]) + (o[dt][nt][2] * o[dt][nt][2] + o[dt][nt][3] * o[dt][nt][3]); }
        sq += __shfl_xor(sq, 16); sq += __shfl_xor(sq, 32);
        if (fq == 0) s_part[h * 64 + nt * 16 + fr] = sq;
    }
    __syncthreads();
#pragma unroll
    for (int nt = 0; nt < 4; ++nt) {
        float tot = 0.f;
#pragma unroll
        for (int hh = 0; hh < 8; ++hh) tot += s_part[hh * 64 + nt * 16 + fr];
        const float rinv = rsqrtf(tot * (1.0f / 512.0f) + 1e-6f);
        bf16_t* yp = WSP(bf16_t, WS_YCAT) + (tq0 + nt * 16 + fr) * 1024 + 512 + h * 64 + 4 * fq;
#pragma unroll
        for (int dt = 0; dt < 4; ++dt) { u32x2 w; w.x = pk2(o[dt][nt][0] * rinv, o[dt][nt][1] * rinv); w.y = pk2(o[dt][nt][2] * rinv, o[dt][nt][3] * rinv); *(u32x2*)(yp + dt * 16) = w; }
    }
    __syncthreads();
}

__device__ __forceinline__ void pc_mixer(const PA a, int l, LAS unsigned char* lds) {
    const int tid = otid();
    LAS float* s_bias = (LAS float*)(lds + LDS_MISC + 1024);
    volatile LAS int* s_item = (volatile LAS int*)(lds + LDS_MISC + 64);
    for (int i = tid; i < 8 * 320; i += 512) s_bias[i] = INP(20)[l * 8 * 320 + i] * 1.4426950408889634f;
    unsigned* qhead = WSP(unsigned, WS_CTL) + CW_QUEUE + l * 64;
    for (;;) {
        __syncthreads();
        if (tid == 0) *s_item = (int)__hip_atomic_fetch_add(qhead, 1u, __ATOMIC_RELAXED, __HIP_MEMORY_SCOPE_AGENT);
        __syncthreads();
        const int item = __builtin_amdgcn_readfirstlane(*s_item);
        if (item >= 128 + 512 + MOE_CONV_ITEMS) break;
        if (item < 128) scan_item(a, l, item, lds);
        else if (item < 128 + 512) attn_item(a, l, item - 128, lds);
        else moe_convert_item(a, l, lds, item - 640);
    }
}

__device__ __forceinline__ void pe2_xattn(const PA a, int l, LAS unsigned char* lds) {
    const int tid = otid(), wave = tid >> 6, lane = tid & 63, fr = lane & 15, fq = lane >> 4;
    LAS bf16_t* sK = (LAS bf16_t*)lds;
    LAS bf16_t* sV = (LAS bf16_t*)(lds + 69632);
    const bf16_t* QX = WSP(const bf16_t, WS_QX); bf16_t* OX = WSP(bf16_t, WS_OX);
    const bf16_t* KV = WSP(const bf16_t, WS_KV) + (size_t)l * MROWS * 1024;
    const bf16_t* VTX = WSP(const bf16_t, WS_VTX) + (size_t)l * MROWS * 512;
    const float* qgn = INP(28) + l * 128;
    for (int it = oblk(); it < 256; it += ogrid()) {
        const int b = it >> 4, h = (it >> 2) & 3, qr = it & 3;
        __syncthreads();
#pragma unroll
        for (int i = 0; i < 8; ++i) {
            const int p = tid + i * 512, r = p >> 4, c8 = (p & 15) * 8;
            *(LAS u32x4*)(sK + r * 136 + c8) = *(const u32x4*)(KV + (size_t)(b * 256 + r) * 1024 + h * 128 + c8);
            const int d = p >> 5, m8 = (p & 31) * 8;
            *(LAS u32x4*)(sV + d * 264 + m8) = *(const u32x4*)(VTX + ((size_t)(b * 4 + h) * 128 + d) * 256 + m8);
        }
        __syncthreads();
#pragma unroll 1
        for (int iter = 0; iter < 2; ++iter) {
            const size_t q0 = (size_t)b * SEQ + qr * 512 + iter * 256 + wave * 32;
            bf16x8 qf[2][4];
#pragma unroll
            for (int nt = 0; nt < 2; ++nt) {
                const bf16_t* qp = QX + (q0 + nt * 16 + fr) * 512 + h * 128 + 8 * fq;
                u32x4 w[4]; float ssq = 0.f;
#pragma unroll
                for (int ks = 0; ks < 4; ++ks) { w[ks] = *(const u32x4*)(qp + 32 * ks);
#pragma unroll
                    for (int j = 0; j < 4; ++j) { const float x0 = lo16(w[ks][j]), x1 = hi16(w[ks][j]); ssq += x0 * x0 + x1 * x1; } }
                ssq += __shfl_xor(ssq, 16); ssq += __shfl_xor(ssq, 32);
                const float sc = rsqrtf(ssq * (1.0f / 128.0f) + 1e-6f) * 0.12751743f;
#pragma unroll
                for (int ks = 0; ks < 4; ++ks) {
                    const f32x4 g0 = *(const f32x4*)(qgn + 32 * ks + 8 * fq), g1 = *(const f32x4*)(qgn + 32 * ks + 8 * fq + 4);
                    u32x4 ow;
                    ow.x = pk2(lo16(w[ks][0]) * sc * g0[0], hi16(w[ks][0]) * sc * g0[1]); ow.y = pk2(lo16(w[ks][1]) * sc * g0[2], hi16(w[ks][1]) * sc * g0[3]);
                    ow.z = pk2(lo16(w[ks][2]) * sc * g1[0], hi16(w[ks][2]) * sc * g1[1]); ow.w = pk2(lo16(w[ks][3]) * sc * g1[2], hi16(w[ks][3]) * sc * g1[3]);
                    qf[nt][ks] = __builtin_bit_cast(bf16x8, ow);
                }
            }
            f32x4 o[8][2];
#pragma unroll
            for (int dt = 0; dt < 8; ++dt) { o[dt][0] = (f32x4){0.f, 0.f, 0.f, 0.f}; o[dt][1] = (f32x4){0.f, 0.f, 0.f, 0.f}; }
            float lsum[2] = {0.f, 0.f};
#pragma unroll 2
            for (int st = 0; st < 8; ++st) {
                const int k0 = st * 32;
                f32x4 sacc[2][2];
#pragma unroll
                for (int mt = 0; mt < 2; ++mt) {
                    sacc[mt][0] = (f32x4){0.f, 0.f, 0.f, 0.f}; sacc[mt][1] = (f32x4){0.f, 0.f, 0.f, 0.f};
#pragma unroll
                    for (int ks = 0; ks < 4; ++ks) {
                        const bf16x8 kfr = *(const LAS bf16x8*)(sK + (k0 + mt * 16 + fr) * 136 + 32 * ks + 8 * fq);
                        sacc[mt][0] = __builtin_amdgcn_mfma_f32_16x16x32_bf16(kfr, qf[0][ks], sacc[mt][0], 0, 0, 0);
                        sacc[mt][1] = __builtin_amdgcn_mfma_f32_16x16x32_bf16(kfr, qf[1][ks], sacc[mt][1], 0, 0, 0);
                    }
                }
                bf16x8 pf[2];
#pragma unroll
                for (int nt = 0; nt < 2; ++nt) {
                    float p[8];
#pragma unroll
                    for (int j = 0; j < 4; ++j) { p[j] = __builtin_amdgcn_exp2f(fminf(sacc[0][nt][j], 80.f)); p[4 + j] = __builtin_amdgcn_exp2f(fminf(sacc[1][nt][j], 80.f)); }
                    lsum[nt] += ((p[0] + p[1]) + (p[2] + p[3])) + ((p[4] + p[5]) + (p[6] + p[7]));
                    u32x4 w; w.x = pk2(p[0], p[1]); w.y = pk2(p[2], p[3]); w.z = pk2(p[4], p[5]); w.w = pk2(p[6], p[7]);
                    pf[nt] = __builtin_bit_cast(bf16x8, w);
                }
#pragma unroll
                for (int dt = 0; dt < 8; ++dt) {
                    const LAS bf16_t* vp = sV + (dt * 16 + fr) * 264 + k0 + 4 * fq;
                    const u32x2 v0 = *(const LAS u32x2*)vp, v1 = *(const LAS u32x2*)(vp + 16);
                    u32x4 w; w.x = v0.x; w.y = v0.y; w.z = v1.x; w.w = v1.y;
                    const bf16x8 vfr = __builtin_bit_cast(bf16x8, w);
                    o[dt][0] = __builtin_amdgcn_mfma_f32_16x16x32_bf16(vfr, pf[0], o[dt][0], 0, 0, 0);
                    o[dt][1] = __builtin_amdgcn_mfma_f32_16x16x32_bf16(vfr, pf[1], o[dt][1], 0, 0, 0);
                }
            }
#pragma unroll
            for (int nt = 0; nt < 2; ++nt) {
                float ls = lsum[nt]; ls += __shfl_xor(ls, 16); ls += __shfl_xor(ls, 32);
                const float inv = 1.0f / ls;
                bf16_t* op = OX + (q0 + nt * 16 + fr) * 512 + h * 128 + 4 * fq;
#pragma unroll
                for (int dt = 0; dt < 8; ++dt) { u32x2 w; w.x = pk2(o[dt][nt][0] * inv, o[dt][nt][1] * inv); w.y = pk2(o[dt][nt][2] * inv, o[dt][nt][3] * inv); *(u32x2*)(op + dt * 16) = w; }
            }
        }
    }
    __syncthreads();
}

__device__ __forceinline__ void pf_router(const PA a, int l, LAS unsigned char* lds) {
    const int tid = otid(), wave = tid >> 6, lane = tid & 63, fr = lane & 15, fq = lane >> 4;
    LAS int* s_cnt = (LAS int*)lds;
    LAS int* s_base = s_cnt + 32;
    LAS int* s_e = s_base + 32;
    LAS int* s_rk = s_e + 256;
    LAS float* s_w = (LAS float*)(s_rk + 256);
    const float* X = a.out; const float* SS = WSP(const float, WS_SS);
    const bf16_t* wrh = WSP(const bf16_t, WS_WRH) + (size_t)l * 48 * 1024; const bf16_t* wrl = WSP(const bf16_t, WS_WRL) + (size_t)l * 48 * 1024;
    const float* bg = INP(32) + l * 4; const float* br = INP(34) + l * 32;
    int* EID = WSP(int, WS_EID); float* EW = WSP(float, WS_EW); int* ERK = WSP(int, WS_ERK);
    unsigned* cnt = WSP(unsigned, WS_CTL) + CW_CNT + l * 32;
    for (int tile = oblk(); tile < T / 128; tile += ogrid()) {
        __syncthreads();
        if (tid < 32) s_cnt[tid] = 0;
        __syncthreads();
        const int t = tile * 128 + wave * 16 + fr;
        f32x4 acc[3];
#pragma unroll
        for (int mt = 0; mt < 3; ++mt) acc[mt] = (f32x4){0.f, 0.f, 0.f, 0.f};
        const float* xr = X + (size_t)t * 1024 + 8 * fq;
#pragma unroll 8
        for (int s_ = 0; s_ < 32; ++s_) {
            const f32x4 x0 = *(const f32x4*)(xr + 32 * s_), x1 = *(const f32x4*)(xr + 32 * s_ + 4);
            u32x4 hw; hw.x = pk2(x0[0], x0[1]); hw.y = pk2(x0[2], x0[3]); hw.z = pk2(x1[0], x1[1]); hw.w = pk2(x1[2], x1[3]);
            u32x4 lw; lw.x = pk2(x0[0] - lo16(hw.x), x0[1] - hi16(hw.x)); lw.y = pk2(x0[2] - lo16(hw.y), x0[3] - hi16(hw.y));
            lw.z = pk2(x1[0] - lo16(hw.z), x1[1] - hi16(hw.z)); lw.w = pk2(x1[2] - lo16(hw.w), x1[3] - hi16(hw.w));
            const bf16x8 xh = __builtin_bit_cast(bf16x8, hw), xl = __builtin_bit_cast(bf16x8, lw);
#pragma unroll
            for (int mt = 0; mt < 3; ++mt) {
                const bf16x8 wh = *(const bf16x8*)(wrh + (size_t)(mt * 16 + fr) * 1024 + 32 * s_ + 8 * fq);
                const bf16x8 wl = *(const bf16x8*)(wrl + (size_t)(mt * 16 + fr) * 1024 + 32 * s_ + 8 * fq);
                acc[mt] = __builtin_amdgcn_mfma_f32_16x16x32_bf16(wh, xh, acc[mt], 0, 0, 0);
                acc[mt] = __builtin_amdgcn_mfma_f32_16x16x32_bf16(wh, xl, acc[mt], 0, 0, 0);
                acc[mt] = __builtin_amdgcn_mfma_f32_16x16x32_bf16(wl, xh, acc[mt], 0, 0, 0);
            }
        }
        const f32x4* sp = (const f32x4*)(SS + (size_t)t * 16);
        const f32x4 s0 = sp[0], s1 = sp[1], s2 = sp[2], s3 = sp[3];
        const float tot = ((s0[0] + s0[1]) + (s0[2] + s0[3])) + ((s1[0] + s1[1]) + (s1[2] + s1[3])) + ((s2[0] + s2[1]) + (s2[2] + s2[3])) + ((s3[0] + s3[1]) + (s3[2] + s3[3]));
        const float rinv = rsqrtf(tot * (1.0f / 1024.0f) + 1e-6f);
        float lg[4], lr[8];
#pragma unroll
        for (int j = 0; j < 4; ++j) { lg[j] = acc[0][j] * rinv + bg[j]; lr[j] = acc[1][j] * rinv + br[fq * 8 + j]; lr[4 + j] = acc[2][j] * rinv + br[fq * 8 + 4 + j]; }
        float g0 = lg[0]; int gt = 0;
#pragma unroll
        for (int j = 1; j < 4; ++j) { if (lg[j] > g0) { g0 = lg[j]; gt = j; } }
        if (fq == gt) {
            float gs = 0.f;
#pragma unroll
            for (int j = 0; j < 4; ++j) gs += __expf(lg[j] - g0);
            const float ggate = 1.0f / gs;
            float l1 = -1e30f, l2 = -1e30f; int j1 = 0, j2 = 0;
#pragma unroll
            for (int j = 0; j < 8; ++j) { const float v = lr[j];
                if (v > l1) { l2 = l1; j2 = j1; l1 = v; j1 = j; } else if (v > l2) { l2 = v; j2 = j; } }
            const float e2 = __expf(l2 - l1);
            const float p1 = 1.0f / (1.0f + e2), p2 = e2 / (1.0f + e2);
            const int e1i = gt * 8 + j1, e2i = gt * 8 + j2;
            const int r1 = atomicAdd((int*)(s_cnt + e1i), 1), r2 = atomicAdd((int*)(s_cnt + e2i), 1);
            const int sl = (wave * 16 + fr) * 2;
            s_e[sl] = e1i; s_e[sl + 1] = e2i; s_rk[sl] = r1; s_rk[sl + 1] = r2; s_w[sl] = ggate * p1; s_w[sl + 1] = ggate * p2;
        }
        __syncthreads();
        if (tid < 32) s_base[tid] = (int)__hip_atomic_fetch_add(cnt + tid, (unsigned)s_cnt[tid], __ATOMIC_RELAXED, __HIP_MEMORY_SCOPE_AGENT);
        __syncthreads();
        if (tid < 256) { const int e = s_e[tid]; const size_t o = (size_t)tile * 256 + tid; EID[o] = e; EW[o] = s_w[tid]; ERK[o] = s_base[e] + s_rk[tid]; }
    }
    __syncthreads();
}

__device__ __forceinline__ void pg_gather(const PA a, int l, LAS unsigned char* lds) {
    const int tid = otid(), wave = tid >> 6, lane = tid & 63;
    LAS int* s_ps = (LAS int*)lds;
    const unsigned* cnt = WSP(const unsigned, WS_CTL) + CW_CNT + l * 32;
    int* SSLOT = WSP(int, WS_SSLOT); float* SW = WSP(float, WS_SW); int* MTE = WSP(int, WS_MTE);
    bf16_t* XS = WSP(bf16_t, WS_XS); const bf16_t* XB = WSP(const bf16_t, WS_XB);
    const float* SS = WSP(const float, WS_SS);
    const int* EID = WSP(const int, WS_EID); const float* EW = WSP(const float, WS_EW); const int* ERK = WSP(const int, WS_ERK);
    __syncthreads();
    if (tid == 0) {
        int acc = 0;
        for (int e = 0; e < 32; ++e) { s_ps[e] = acc; const int c = (int)__hip_atomic_load(cnt + e, __ATOMIC_RELAXED, __HIP_MEMORY_SCOPE_AGENT); acc += ((c + 255) >> 8) << 8; }
        s_ps[32] = acc;
    }
    __syncthreads();
    if (oblk() == 0) {
        if (tid < 32) { const int m0 = s_ps[tid] >> 8, m1 = s_ps[tid + 1] >> 8; for (int mt = m0; mt < m1; ++mt) MTE[mt] = tid; }
        if (tid == 0) MTE[511] = s_ps[32] >> 8;
        if (tid < 33) MTE[400 + tid] = s_ps[tid] >> 8;
    }
    for (int e = oblk(); e < 32; e += ogrid()) {
        const int c = (int)__hip_atomic_load(cnt + e, __ATOMIC_RELAXED, __HIP_MEMORY_SCOPE_AGENT);
        const int r0 = s_ps[e] + c, r1 = s_ps[e + 1];
        for (int r = r0 + wave; r < r1; r += 8) {
            if (lane == 0) { SSLOT[r] = -1; SW[r] = 0.f; }
            unsigned zz = 0u; asm volatile("" : "+v"(zz));
            u32x4 z = {zz, zz, zz, zz};
            *(u32x4*)(XS + (size_t)r * 1024 + lane * 8) = z; *(u32x4*)(XS + (size_t)r * 1024 + 512 + lane * 8) = z;
        }
    }
    for (int t0 = (oblk() * 8 + wave) * 4; t0 < T; t0 += ogrid() * 32) {
        int e8 = 0, rk8 = 0; float w8 = 0.f;
        if (lane < 8) { e8 = EID[t0 * 2 + lane]; rk8 = ERK[t0 * 2 + lane]; w8 = EW[t0 * 2 + lane]; }
        const float ssl = SS[(size_t)t0 * 16 + lane];
        u32x4 xw[4][2];
#pragma unroll
        for (int q = 0; q < 4; ++q) { xw[q][0] = *(const u32x4*)(XB + (size_t)(t0 + q) * 1024 + lane * 8); xw[q][1] = *(const u32x4*)(XB + (size_t)(t0 + q) * 1024 + 512 + lane * 8); }
        float tot = ssl;
        tot += __shfl_xor(tot, 1); tot += __shfl_xor(tot, 2); tot += __shfl_xor(tot, 4); tot += __shfl_xor(tot, 8);
        int dest8 = 0;
        if (lane < 8) { dest8 = s_ps[e8] + rk8; SSLOT[dest8] = t0 * 2 + lane; SW[dest8] = w8; }
#pragma unroll
        for (int q = 0; q < 4; ++q) {
            const float rinv = rsqrtf(__shfl(tot, q * 16) * (1.0f / 1024.0f) + 1e-6f);
            u32x4 o0, o1;
#pragma unroll
            for (int j = 0; j < 4; ++j) { o0[j] = pk2(lo16(xw[q][0][j]) * rinv, hi16(xw[q][0][j]) * rinv); o1[j] = pk2(lo16(xw[q][1][j]) * rinv, hi16(xw[q][1][j]) * rinv); }
#pragma unroll
            for (int k = 0; k < 2; ++k) {
                const int dest = __shfl(dest8, q * 2 + k);
                *(u32x4*)(XS + (size_t)dest * 1024 + lane * 8) = o0; *(u32x4*)(XS + (size_t)dest * 1024 + 512 + lane * 8) = o1;
            }
        }
    }
}

__device__ __forceinline__ void pj_finalize(const PA a) {
    const int wave = otid() >> 6, lane = otid() & 63;
    float* X = a.out; bf16_t* XB = WSP(bf16_t, WS_XB); float* SS = WSP(float, WS_SS);
    const bf16_t* Y = WSP(const bf16_t, WS_Y);
    for (int t = oblk() * 8 + wave; t < T; t += ogrid() * 8) {
        float sq = 0.f;
#pragma unroll
        for (int i = 0; i < 4; ++i) {
            const int c = i * 256 + lane * 4;
            f32x4 v = *(const f32x4*)(X + (size_t)t * 1024 + c);
            const u32x2 y0 = *(const u32x2*)(Y + (size_t)(2 * t) * 1024 + c), y1 = *(const u32x2*)(Y + (size_t)(2 * t + 1) * 1024 + c);
            v[0] += lo16(y0.x) + lo16(y1.x); v[1] += hi16(y0.x) + hi16(y1.x); v[2] += lo16(y0.y) + lo16(y1.y); v[3] += hi16(y0.y) + hi16(y1.y);
            *(f32x4*)(X + (size_t)t * 1024 + c) = v;
            u32x2 w; w.x = pk2(v[0], v[1]); w.y = pk2(v[2], v[3]);
            *(u32x2*)(XB + (size_t)t * 1024 + c) = w;
            sq += (v[0] * v[0] + v[1] * v[1]) + (v[2] * v[2] + v[3] * v[3]);
        }
        sq = wsum(sq);
        if (lane < 16) SS[(size_t)t * 16 + lane] = (lane == 0) ? sq : 0.f;
    }
}

#define SITE static __device__ __forceinline__ void
#define OPAQUE() do { a.out = (float*)ldsin(lds, 38); a.ws = (unsigned char*)ldsin(lds, 39); } while (0)
__device__ __forceinline__ int opq(int v) { asm volatile("" : "+s"(v)); return v; }
SITE site_p0(PA a, LAS unsigned char* lds) { OPAQUE(); p0_prologue(a, lds); }
SITE site_kv(PA a, LAS unsigned char* lds) { OPAQUE();
    pg8::Gemm g{WSP(const bf16_t, WS_MEMB), WSP(const bf16_t, WS_WKV), 1024, (size_t)1024 * 1024};
    pg8::KvOrder S{opq((int)gridDim.x), opq((int)blockIdx.x)};
    pg8::EpiScale E{WSP(bf16_t, WS_KV), 1024, WSP(const float, WS_MEMSS), MROWS - 1};
    pg8::gemm_phase<pg8::EpiScale, pg8::KvOrder>(lds, g, S, E);
}
SITE site_knorm(PA a, LAS unsigned char* lds) { OPAQUE(); p2_knorm(a, lds); }
SITE site_inproj(PA a, int l, LAS unsigned char* lds) { OPAQUE();
    pg8::Gemm g{WSP(const bf16_t, WS_XB), WSP(const bf16_t, WS_WIN) + (size_t)l * INW * 1024, 1024, 0};
    pg8::StaticOrder S; S.init(T, INW, opq((int)gridDim.x), opq((int)blockIdx.x));
    pg8::EpiProj E{WSP(bf16_t, WS_PROJ), WSP(bf16_t, WS_VT), WSP(const float, WS_SS)};
    pg8::gemm_phase<pg8::EpiProj, pg8::StaticOrder>(lds, g, S, E);
}
SITE site_prep(PA a, int l, LAS unsigned char* lds) { OPAQUE();
    pb_prep(a, l, lds);
}
SITE site_chunks(PA a, int l, LAS unsigned char* lds) { OPAQUE(); pb2_chunks(a, l, lds); }
SITE site_mixer(PA a, int l, LAS unsigned char* lds) { OPAQUE(); pc_mixer(a, l, lds); }
SITE site_outproj(PA a, int l, LAS unsigned char* lds) { OPAQUE();
    pg8::Gemm g{WSP(const bf16_t, WS_YCAT), WSP(const bf16_t, WS_WOUT) + (size_t)l * 1024 * 1024, 1024, 0};
    pg8::StaticOrder S; S.init(T, 1024, opq((int)gridDim.x), opq((int)blockIdx.x));
    pg8::EpiRes E{a.out, WSP(bf16_t, WS_XB), WSP(float, WS_SS)};
    pg8::gemm_phase<pg8::EpiRes, pg8::StaticOrder>(lds, g, S, E);
}
SITE site_xq(PA a, int l, LAS unsigned char* lds) { OPAQUE();
    pg8::Gemm g{WSP(const bf16_t, WS_XB), WSP(const bf16_t, WS_WQ) + (size_t)l * 512 * 1024, 1024, 0};
    pg8::StaticOrder S; S.init(T, 512, opq((int)gridDim.x), opq((int)blockIdx.x));
    pg8::EpiScale E{WSP(bf16_t, WS_QX), 512, WSP(const float, WS_SS), T - 1};
    pg8::gemm_phase<pg8::EpiScale, pg8::StaticOrder>(lds, g, S, E);
}
SITE site_xattn(PA a, int l, LAS unsigned char* lds) { OPAQUE(); pe2_xattn(a, l, lds); }
SITE site_xo(PA a, int l, LAS unsigned char* lds) { OPAQUE();
    pg8::Gemm g{WSP(const bf16_t, WS_OX), WSP(const bf16_t, WS_WO) + (size_t)l * 1024 * 512, 512, 0};
    pg8::StaticOrder S; S.init(T, 1024, opq((int)gridDim.x), opq((int)blockIdx.x));
    pg8::EpiRes E{a.out, WSP(bf16_t, WS_XB), WSP(float, WS_SS)};
    pg8::gemm_phase<pg8::EpiRes, pg8::StaticOrder>(lds, g, S, E);
}
SITE site_router(PA a, int l, LAS unsigned char* lds) { OPAQUE(); pf_router(a, l, lds); }
SITE site_gather(PA a, int l, LAS unsigned char* lds) { OPAQUE(); pg_gather(a, l, lds); }
SITE site_gu(PA a, LAS unsigned char* lds) { OPAQUE();
    pg8::Gemm g{WSP(const bf16_t, WS_XS), WSP(const bf16_t, WS_WGU), 1024, (size_t)1024 * 1024};
    pg8::MoeOrder S{WSP(const int, WS_MTE), opq((int)gridDim.x), opq((int)blockIdx.x)};
    pg8::EpiGU E{WSP(bf16_t, WS_HB)};
    pg8::gemm_phase<pg8::EpiGU, pg8::MoeOrder>(lds, g, S, E);
}
SITE site_down(PA a, LAS unsigned char* lds) { OPAQUE();
    pg8::Gemm g{WSP(const bf16_t, WS_HB), WSP(const bf16_t, WS_WD), 512, (size_t)1024 * 512};
    pg8::MoeOrder S{WSP(const int, WS_MTE), opq((int)gridDim.x), opq((int)blockIdx.x)};
    pg8::EpiDown E{WSP(bf16_t, WS_Y), WSP(const int, WS_SSLOT), WSP(const float, WS_SW)};
    pg8::gemm_phase<pg8::EpiDown, pg8::MoeOrder>(lds, g, S, E);
}
SITE site_final(PA a, LAS unsigned char* lds) { OPAQUE(); pj_finalize(a); }

__global__ void __launch_bounds__(512, 2) mk_fwd(Args args) {
    extern __shared__ __attribute__((aligned(16))) unsigned char lds_raw[];
    LAS unsigned char* lds = (LAS unsigned char*)lds_raw;
    const int tid = threadIdx.x;
    const int lo = args.ph_lo, hi = args.ph_hi;
    PA a; a.out = args.out; a.ws = args.ws;
    if (tid < 16) ((LAS unsigned*)(lds + LDS_MISC))[tid] = 0u;
    if (tid == 64) {
        LAS unsigned long long* tab = (LAS unsigned long long*)(lds + LDS_INTAB);
#pragma unroll
        for (int i = 0; i < 38; ++i) tab[i] = (unsigned long long)args.in[i];
        tab[38] = (unsigned long long)args.out; tab[39] = (unsigned long long)args.ws;
    }
    __syncthreads();
    XcdBarrier bar; bar.bar = WSP(unsigned, WS_CTL) + CW_BAR; bar.x = 0; bar.st = nullptr;
    if (!MK_PER_PHASE) bar = xcd_barrier_post(WSP(unsigned, WS_CTL) + CW_BAR, (volatile LAS unsigned*)(lds + LDS_MISC));
#define IN(k) (lo <= (k) && (k) < hi)
#define GRID_BAR() do { if (!MK_PER_PHASE) xcd_barrier(bar); } while (0)
#ifdef PROBE_MASK
    unsigned long long pr_acc = 0ull, pr_t0 = 0ull; const unsigned long long pr_start = wall_clock64();
#define PR0() do { pr_t0 = wall_clock64(); } while (0)
#define PR1(p) do { if ((PROBE_MASK >> (p)) & 1) pr_acc += wall_clock64() - pr_t0; } while (0)
#else
#define PR0() do { } while (0)
#define PR1(p) do { } while (0)
#endif
    PR0(); if (IN(0)) { site_p0(a, lds); GRID_BAR(); } PR1(12);
    PR0(); if (IN(1)) { site_kv(a, lds); GRID_BAR(); } PR1(13);
    PR0(); if (IN(2)) { site_knorm(a, lds); GRID_BAR(); } PR1(14);
    for (int l = 0; l < NL; ++l) {
        const int pb = 3 + 12 * l;
        PR0(); if (IN(pb + 0)) { site_inproj(a, l, lds); GRID_BAR(); } PR1(0);
        PR0(); if (IN(pb + 1)) { site_prep(a, l, lds); GRID_BAR(); } PR1(1);
        PR0(); if (IN(pb + 1)) { site_chunks(a, l, lds); GRID_BAR(); } PR1(15);
        PR0(); if (IN(pb + 2)) { site_mixer(a, l, lds); GRID_BAR(); } PR1(2);
        PR0(); if (IN(pb + 3)) { site_outproj(a, l, lds); GRID_BAR(); } PR1(3);
        PR0(); if (IN(pb + 4)) { site_xq(a, l, lds); GRID_BAR(); } PR1(4);
        PR0(); if (IN(pb + 5)) { site_xattn(a, l, lds); GRID_BAR(); } PR1(5);
        PR0(); if (IN(pb + 6)) { site_xo(a, l, lds); GRID_BAR(); } PR1(6);
        PR0(); if (IN(pb + 7)) { site_router(a, l, lds); GRID_BAR(); } PR1(7);
        PR0(); if (IN(pb + 8)) { site_gather(a, l, lds); GRID_BAR(); } PR1(8);
        PR0(); if (IN(pb + 9)) { site_gu(a, lds); GRID_BAR(); } PR1(9);
        PR0(); if (IN(pb + 10)) { site_down(a, lds); GRID_BAR(); } PR1(10);
#ifdef PROBE_MASK
        PR0(); if (IN(pb + 11)) { site_final(a, lds); GRID_BAR(); } PR1(11);
#else
        if (IN(pb + 11)) { site_final(a, lds); if (l + 1 < NL) GRID_BAR(); }
#endif
    }
#ifdef PROBE_MASK
    {
        unsigned long long* pw = (unsigned long long*)(WSP(unsigned, WS_CTL) + 8192);
        if (blockIdx.x == 0 && tid == 0) __hip_atomic_store(pw, pr_acc, __ATOMIC_RELAXED, __HIP_MEMORY_SCOPE_AGENT);
        GRID_BAR();
        const unsigned long long tgt = 1600000ull + __hip_atomic_load(pw, __ATOMIC_RELAXED, __HIP_MEMORY_SCOPE_AGENT) * (unsigned long long)PROBE_MULT;
        while (wall_clock64() - pr_start < tgt) __builtin_amdgcn_s_sleep(16);
    }
#endif
#undef IN
#undef GRID_BAR
}

extern "C" void kernel_launch(void* const* d_in, const int* in_sizes, int n_in, void* d_out, int out_size, void* d_ws, size_t ws_size, hipStream_t stream) {
    static int grid = 0;
    if (grid == 0) {
        if (n_in != 38 || out_size != T * D || ws_size < WS_END) { fprintf(stderr, "kernel_launch: unexpected shapes (n_in %d out %d ws %zu need %zu)\n", n_in, out_size, ws_size, (size_t)WS_END); grid = -1; return; }
        int dev = 0, cus = 0, per_cu = 0;
        if (hipGetDevice(&dev) != hipSuccess || hipDeviceGetAttribute(&cus, hipDeviceAttributeMultiprocessorCount, dev) != hipSuccess) { grid = -1; return; }
        if (hipFuncSetAttribute((const void*)mk_fwd, hipFuncAttributeMaxDynamicSharedMemorySize, LDS_BYTES) != hipSuccess) { fprintf(stderr, "kernel_launch: hipFuncSetAttribute failed\n"); grid = -1; return; }
        if (hipOccupancyMaxActiveBlocksPerMultiprocessor(&per_cu, (const void*)mk_fwd, 512, LDS_BYTES) != hipSuccess || per_cu < 1) { fprintf(stderr, "kernel_launch: occupancy query says %d\n", per_cu); }
        (void)hipGetLastError();
        grid = cus;
    }
    if (grid < 0) return;
    (void)hipMemsetAsync((char*)d_ws + WS_CTL, 0, CTL_BYTES, stream);
    Args a{};
    for (int i = 0; i < 38; ++i) a.in[i] = (const float*)d_in[i];
    a.out = (float*)d_out; a.ws = (unsigned char*)d_ws;
#if MK_PER_PHASE
    for (int p = 0; p < NPH; ++p) { a.ph_lo = p; a.ph_hi = p + 1; hipLaunchKernelGGL(mk_fwd, dim3(grid), dim3(512), LDS_BYTES, stream, a); }
#else
    a.ph_lo = 0; a.ph_hi = NPH;
    hipLaunchKernelGGL(mk_fwd, dim3(grid), dim3(512), LDS_BYTES, stream, a);
#endif
}
```

```cpp
#include <hip/hip_runtime.h>
#include <cstdio>
#include <cstdint>

#ifndef MK_PER_PHASE
#define MK_PER_PHASE 0
#endif

#define LAS __attribute__((address_space(3)))
typedef unsigned short bf16_t;
typedef short bf16x8 __attribute__((ext_vector_type(8)));
typedef float f32x4 __attribute__((ext_vector_type(4)));
typedef unsigned u32x4 __attribute__((ext_vector_type(4)));
typedef unsigned u32x2 __attribute__((ext_vector_type(2)));

constexpr int T = 32768, D = 1024, SEQ = 2048, NL = 4;
constexpr int INW = 3328;
constexpr int MROWS = 4096;
constexpr int MAXROWS = 73728, MAXMT = 288;
constexpr int NPH = 3 + 12 * NL;

constexpr size_t WS_CTL   = 0;
constexpr size_t CTL_BYTES = 65536;
constexpr size_t WS_WIN   = WS_CTL + CTL_BYTES;
constexpr size_t WS_WOUT  = WS_WIN  + (size_t)4 * 3328 * 1024 * 2;
constexpr size_t WS_WQ    = WS_WOUT + (size_t)4 * 1024 * 1024 * 2;
constexpr size_t WS_WKV   = WS_WQ   + (size_t)4 * 512 * 1024 * 2;
constexpr size_t WS_WO    = WS_WKV  + (size_t)4 * 1024 * 1024 * 2;
constexpr size_t WS_WGU   = WS_WO   + (size_t)4 * 1024 * 512 * 2;
constexpr size_t WS_WD    = WS_WGU  + (size_t)32 * 1024 * 1024 * 2;
constexpr size_t WS_KV    = WS_WD   + (size_t)32 * 1024 * 512 * 2;
constexpr size_t WS_MEMB  = WS_KV   + (size_t)4 * 4096 * 1024 * 2;
constexpr size_t WS_MEMSS = WS_MEMB + (size_t)4096 * 1024 * 2;
constexpr size_t WS_VTX   = WS_MEMSS + (size_t)4096 * 16 * 4;
constexpr size_t WS_WRH   = WS_VTX  + (size_t)4 * 4096 * 512 * 2;
constexpr size_t WS_WRL   = WS_WRH  + (size_t)4 * 48 * 1024 * 2;
constexpr size_t WS_PBI   = WS_WRL  + (size_t)4 * 48 * 1024 * 2;
constexpr int PBI_BYTES = 122880;
constexpr size_t WS_XB    = WS_PBI  + (size_t)16 * PBI_BYTES;
constexpr size_t WS_SS    = WS_XB   + (size_t)T * 1024 * 2;
constexpr size_t WS_VF    = WS_SS   + (size_t)T * 16 * 4;
constexpr size_t WS_EID   = WS_VF   + (size_t)T * 512 * 2;
constexpr size_t WS_EW    = WS_EID  + (size_t)T * 2 * 4;
constexpr size_t WS_ERK   = WS_EW   + (size_t)T * 2 * 4;
constexpr size_t WS_SSLOT = WS_ERK  + (size_t)T * 2 * 4;
constexpr size_t WS_SW    = WS_SSLOT + (size_t)MAXROWS * 4;
constexpr size_t WS_MTE   = WS_SW   + (size_t)MAXROWS * 4;
constexpr size_t WS_STOK  = WS_MTE  + 2048;
constexpr size_t WS_SRINV = WS_STOK + (size_t)MAXROWS * 4;
constexpr size_t WS_U     = WS_SRINV + (size_t)MAXROWS * 4;
constexpr size_t WS_PROJ  = WS_U;
constexpr size_t WS_SR    = WS_PROJ + (size_t)T * 3328 * 2;
constexpr size_t WS_SK    = WS_SR   + (size_t)T * 512 * 2;
constexpr size_t WS_SV    = WS_SK   + (size_t)T * 512 * 2;
constexpr size_t WS_SA    = WS_SV   + (size_t)T * 512 * 2;
constexpr size_t WS_SB    = WS_SA   + (size_t)T * 512 * 2;
constexpr size_t WS_SG    = WS_SB   + (size_t)T * 512 * 2;
constexpr size_t WS_SWD   = WS_SG   + (size_t)T * 512 * 2;
constexpr size_t WS_YCAT  = WS_SWD  + (size_t)T * 512 * 4;
constexpr size_t WS_VT    = WS_YCAT + (size_t)T * 1024 * 2;
constexpr int NCHUNK = 16 * 8 * 128;
constexpr size_t WS_BTT   = WS_VT   + (size_t)T * 512 * 2;
constexpr size_t WS_KTT   = WS_BTT  + (size_t)NCHUNK * 2048;
constexpr size_t WS_VST   = WS_KTT  + (size_t)NCHUNK * 2048;
constexpr size_t WS_NKA   = WS_VST  + (size_t)NCHUNK * 2048;
constexpr size_t WS_NBR   = WS_NKA  + (size_t)NCHUNK * 512;
constexpr size_t WS_NKR   = WS_NBR  + (size_t)NCHUNK * 512;
constexpr size_t WS_TMT   = WS_NKR  + (size_t)NCHUNK * 512;
constexpr size_t WS_PCK   = WS_TMT  + (size_t)NCHUNK * 512;
constexpr size_t WS_BS    = WS_PCK  + (size_t)NCHUNK * 256;
constexpr size_t WS_UEND1 = WS_BS   + (size_t)T * 8 * 4;
constexpr size_t WS_QX    = WS_U;
constexpr size_t WS_OX    = WS_QX   + (size_t)T * 512 * 2;
constexpr size_t WS_XS    = WS_U;
constexpr size_t WS_HB    = WS_XS   + (size_t)MAXROWS * 1024 * 2;
constexpr size_t WS_Y     = WS_HB   + (size_t)MAXROWS * 512 * 2;
constexpr size_t WS_UEND2 = WS_Y    + (size_t)2 * T * 1024 * 2;
constexpr size_t WS_END   = WS_UEND1 > WS_UEND2 ? WS_UEND1 : WS_UEND2;

constexpr int CW_BAR = 0;
constexpr int CW_CNT = 4096;
constexpr int CW_QUEUE = 4096 + 256;

constexpr int LDS_MISC = 139264;
constexpr int LDS_BYTES = LDS_MISC + 16384;

struct Args { const float* in[38]; float* out; unsigned char* ws; int ph_lo, ph_hi; };
struct PA { float* out; unsigned char* ws; };

__device__ __forceinline__ float bf2f(bf16_t b) { return __uint_as_float(((unsigned)b) << 16); }
__device__ __forceinline__ bf16_t f2bf(float f) { unsigned u = __float_as_uint(f); u += 0x7FFFu + ((u >> 16) & 1u); return (bf16_t)(u >> 16); }
typedef __bf16 bf16v2 __attribute__((ext_vector_type(2)));
typedef float f32x2 __attribute__((ext_vector_type(2)));
__device__ __forceinline__ unsigned pk2(float lo, float hi) { f32x2 v = {lo, hi}; bf16v2 b = __builtin_convertvector(v, bf16v2); return __builtin_bit_cast(unsigned, b); }
__device__ __forceinline__ float lo16(unsigned u) { return __uint_as_float(u << 16); }
__device__ __forceinline__ float hi16(unsigned u) { return __uint_as_float(u & 0xffff0000u); }
__device__ __forceinline__ float wsum(float v) {
#pragma unroll
    for (int o = 32; o; o >>= 1) v += __shfl_xor(v, o);
    return v;
}
__device__ __forceinline__ float sigmoidf_(float x) { return 1.0f / (1.0f + __expf(-x)); }

#define XB_TMO      128
#define XB_XCNT(j)  (256  + 64 * (j))
#define XB_XSUB(j)  (1280 + 64 * (j))
#define XB_XGEN(j)  (2304 + 64 * (j))
#define XB_TOP      3328
#define XB_TOPGEN   3392
#define XCD_BAR_WORDS 3456
#define XB_SPIN_CAP (1u << 22)

__device__ __forceinline__ unsigned xb_ld(unsigned* p)              { return __hip_atomic_load(p, __ATOMIC_RELAXED, __HIP_MEMORY_SCOPE_AGENT); }
__device__ __forceinline__ unsigned xb_add(unsigned* p, unsigned v) { return __hip_atomic_fetch_add(p, v, __ATOMIC_RELAXED, __HIP_MEMORY_SCOPE_AGENT); }
__device__ __forceinline__ unsigned xb_xcc_id() { return (unsigned)__builtin_amdgcn_s_getreg((3 << 11) | 20) & 0xFu; }
#define XB_SPIN(cond, bar) do { unsigned _sp = 0; while (cond) { __builtin_amdgcn_s_sleep(1); \
    if ((++_sp & 255u) == 0u) { if (xb_ld(&(bar)[XB_TMO])) break; if (_sp > XB_SPIN_CAP) { atomicAdd(&(bar)[XB_TMO], 1u); break; } } } } while (0)

struct XcdBarrier { unsigned* bar; unsigned x; volatile LAS unsigned* st; };

__device__ __forceinline__ XcdBarrier xcd_barrier_post(unsigned* bar, volatile LAS unsigned* st) {
    XcdBarrier b; b.bar = bar; b.x = xb_xcc_id(); b.st = st;
    if (threadIdx.x == 0) (void)xb_add(&bar[XB_XCNT(b.x)], 1u);
    return b;
}
__device__ __forceinline__ void xcd_barrier_complete(unsigned* bar, unsigned x, unsigned& nloc, unsigned& nx) {
    const unsigned G = gridDim.x * gridDim.y * gridDim.z;
    unsigned sum, cnt, mine, sp = 0u;
    for (;;) {
        sum = 0u; cnt = 0u; mine = 0u;
#pragma unroll
        for (unsigned j = 0; j < 16; ++j) { const unsigned c = xb_ld(&bar[XB_XCNT(j)]); sum += c; cnt += (c > 0u) ? 1u : 0u; mine = (j == x) ? c : mine; }
        if (sum == G) break;
        __builtin_amdgcn_s_sleep(1);
        if ((++sp & 255u) == 0u) { if (xb_ld(&bar[XB_TMO])) break; if (sp > XB_SPIN_CAP) { atomicAdd(&bar[XB_TMO], 1u); break; } }
    }
    nloc = mine > 0u ? mine : 1u; nx = cnt > 0u ? cnt : 1u;
}
__device__ __forceinline__ void xcd_barrier(const XcdBarrier& b) {
    asm volatile("s_waitcnt vmcnt(0)" ::: "memory");
    __syncthreads();
    if (threadIdx.x == 0) {
        unsigned* bar = b.bar;
        __builtin_amdgcn_s_waitcnt(0);
        unsigned nloc = b.st[0], nx = b.st[1];
        if (nloc == 0u) { xcd_barrier_complete(bar, b.x, nloc, nx); b.st[0] = nloc; b.st[1] = nx; }
        const unsigned old = xb_add(&bar[XB_XSUB(b.x)], 1u);
        const unsigned gen = old / nloc;
        if (old + 1u == (gen + 1u) * nloc) {
            __builtin_amdgcn_fence(__ATOMIC_RELEASE, "agent");
            asm volatile("s_waitcnt vmcnt(0)" ::: "memory");
            const unsigned og = xb_add(&bar[XB_TOP], 1u);
            const unsigned tg = og / nx;
            if (og + 1u == (tg + 1u) * nx) xb_add(&bar[XB_TOPGEN], 1u);
            else XB_SPIN(xb_ld(&bar[XB_TOPGEN]) == tg, bar);
            __builtin_amdgcn_fence(__ATOMIC_ACQUIRE, "agent");
            xb_add(&bar[XB_XGEN(b.x)], 1u);
            asm volatile("s_waitcnt vmcnt(0)" ::: "memory");
        } else {
            XB_SPIN(xb_ld(&bar[XB_XGEN(b.x)]) == gen, bar);
            __builtin_amdgcn_fence(__ATOMIC_ACQUIRE, "agent");
            asm volatile("s_waitcnt vmcnt(0)" ::: "memory");
        }
    }
    __syncthreads();
}

namespace pg8 {
constexpr int BM = 256, BK = 64, HALF = 128, HTB = HALF * BK * 2, STAGE_BYTES = 8 * HTB, NXCD = 8, WGM = 8;
__host__ __device__ __forceinline__ int lds_byte(int r, int c) { const int st = (r >> 4) * 2 + (c >> 5), rr = r & 15, cc = c & 31, ob = rr * 64 + cc * 2; return st * 1024 + (ob ^ (((ob >> 9) & 1) << 5)); }
__host__ __device__ __forceinline__ void stage_rc(int b, int& R, int& C) { const int st = b / 1024, sb = b % 1024, swz = sb ^ (((sb >> 9) & 1) << 5); R = (st >> 1) * 16 + swz / 64; C = (st & 1) * 32 + (swz % 64) / 2; }
__host__ __device__ __forceinline__ int perm32(int rho) { const int n = rho >> 4, i = rho & 15; return 8 * (i >> 2) + 4 * n + (i & 3); }

struct Unit { int pm, pn, pa, z; };
struct Gemm { const bf16_t* A; const bf16_t* Bt; int K; size_t bz_stride; const int* rowidx; };

struct StaticOrder {
    int nM, nN, nwg, G, c;
    __device__ void init(int M, int N, int G_, int c_) { nM = M / BM; nN = N / BM; nwg = nM * nN; G = G_; c = c_; }
    __device__ bool next(int i, Unit& u) const {
        const long L = (long)i * G + c; if (L >= nwg) return false;
        int wgid = (int)L; { const int q = nwg / NXCD, r = nwg % NXCD, xcd = wgid % NXCD, off = wgid / NXCD; wgid = (xcd < r ? xcd * (q + 1) : r * (q + 1) + (xcd - r) * q) + off; }
        const int nig = WGM * nN, gid = wgid / nig, fm = gid * WGM, gsz = (nM - fm) < WGM ? (nM - fm) : WGM;
        u.pm = fm + ((wgid % nig) % gsz); u.pn = (wgid % nig) / gsz; u.pa = u.pm; u.z = 0; return true;
    }
};
struct KvOrder {
    int G, c;
    __device__ bool next(int i, Unit& u) const {
        const int L = i * G + c; if (L >= 256) return false;
        u.z = L >> 6; const int r = L & 63; u.pa = r >> 2; u.pn = r & 3; u.pm = u.z * 16 + u.pa; return true;
    }
};
struct MoeOrder {
    const int* mte; int G, c;
    __device__ bool next(int i, Unit& u) const {
        if ((G & 7) != 0) {
            const int nunits = mte[511] * 4;
            const int L = i * G + c; if (L >= nunits) return false;
            u.pm = L >> 2; u.pa = u.pm; u.pn = L & 3; u.z = mte[u.pm]; return true;
        }
        const int x = c & 7; int q = i * (G >> 3) + (c >> 3);
#pragma unroll
        for (int k = 0; k < 4; ++k) {
            const int e = x + 8 * k; const int m0 = mte[400 + e], m1 = mte[401 + e]; const int n = (m1 - m0) * 4;
            if (q < n) { u.pm = m0 + (q >> 2); u.pa = u.pm; u.pn = q & 3; u.z = e; return true; }
            q -= n;
        }
        return false;
    }
};

template <class Epi, class Sched, bool ALIGN_EPI = true, bool GATHER = false>
__device__ __forceinline__ void gemm_phase(LAS unsigned char* lds, const Gemm g, const Sched& S, const Epi& E) {
    int tid_ = threadIdx.x; asm volatile("" : "+v"(tid_));
    const int tid = tid_, wid = __builtin_amdgcn_readfirstlane(tid >> 6), lane = tid & 63, wr = wid >> 2, wc = wid & 3, fr = lane & 15, fq = lane >> 4;
    const int K = g.K, nt = K / BK;
    unsigned voffA[2], voffB[2], gcol[2]; int grow[2];
#pragma unroll
    for (int i = 0; i < 2; ++i) { int R, C; stage_rc(tid * 16 + i * 8192, R, C); const int Rb = ((R & ~31) + perm32(R & 31));
        voffA[i] = (unsigned)(R * K + C) * 2u; voffB[i] = (unsigned)(Rb * K + C) * 2u; grow[i] = R; gcol[i] = (unsigned)C * 2u; }
    const size_t kstep = (size_t)(BK * 2);
    const size_t hstep = (size_t)HALF * K * 2;
    const size_t tstep = 2 * hstep;
    const unsigned ldsw = (unsigned)wid * 1024u;
    const int aoff = lds_byte(wr * 64 + fr, fq * 8), boff = lds_byte(wc * 32 + fr, fq * 8);
#define PG8_SA(b, h) (((b) * 2 + (h)) * HTB)
#define PG8_SB(b, h) ((4 + (b) * 2 + (h)) * HTB)
#define PG8_STAGE(bufoff, gbase, voff) do { _Pragma("unroll") for (int _i = 0; _i < 2; ++_i) \
        __builtin_amdgcn_global_load_lds((const unsigned*)((const char*)(gbase) + (voff)[_i]), (LAS unsigned*)(lds + (bufoff) + ldsw + _i * 8192), 16, 0, 0); } while (0)
#define PG8_LDA(dst, b, h) do { _Pragma("unroll") for (int m = 0; m < 4; ++m) _Pragma("unroll") for (int k = 0; k < 2; ++k) dst[m][k] = *(const LAS bf16x8*)(lds + PG8_SA(b, h) + aoff + m * 2048 + k * 1024); } while (0)
#define PG8_LDB(dst, b, h) do { _Pragma("unroll") for (int n = 0; n < 2; ++n) _Pragma("unroll") for (int k = 0; k < 2; ++k) dst[n][k] = *(const LAS bf16x8*)(lds + PG8_SB(b, h) + boff + n * 2048 + k * 1024); } while (0)
#define PG8_MMA(ai, bj, At, Bt) do { __builtin_amdgcn_s_setprio(1); _Pragma("unroll") for (int m = 0; m < 4; ++m) _Pragma("unroll") for (int n = 0; n < 2; ++n) _Pragma("unroll") for (int k = 0; k < 2; ++k) \
        acc[ai][bj][m][n] = __builtin_amdgcn_mfma_f32_16x16x32_bf16(Bt[n][k], At[m][k], acc[ai][bj][m][n], 0, 0, 0); __builtin_amdgcn_s_setprio(0); } while (0)
#define PG8_WAIT_V(n) asm volatile("s_waitcnt vmcnt(" #n ")" ::: "memory")
#define PG8_WAIT_L(n) asm volatile("s_waitcnt lgkmcnt(" #n ")" ::: "memory")
#define PG8_BAR __builtin_amdgcn_s_barrier()
#define PG8_SCHED __builtin_amdgcn_sched_barrier(0)
#define PG8_APTR(u) ((const char*)g.A + (size_t)(u).pa * tstep)
#define PG8_BPTR(u) ((const char*)g.Bt + ((size_t)(u).z * g.bz_stride) * 2 + (size_t)(u).pn * tstep)
    Unit cur, nxt; int ui = 0;
    if (!S.next(0, cur)) return;
    f32x4 acc[2][2][4][2];
#pragma unroll
    for (int a = 0; a < 2; ++a)
#pragma unroll
        for (int b = 0; b < 2; ++b)
#pragma unroll
            for (int m = 0; m < 4; ++m)
#pragma unroll
                for (int n = 0; n < 2; ++n) acc[a][b][m][n] = (f32x4){0.f, 0.f, 0.f, 0.f};
    bf16x8 At[4][2], B0[2][2], B1[2][2];
    const char* cA = GATHER ? (const char*)g.A : PG8_APTR(cur); const char* cB = PG8_BPTR(cur);
    unsigned gcu[2][2] = {{0u, 0u}, {0u, 0u}}, gnx[2][2] = {{0u, 0u}, {0u, 0u}};
#define PG8_GOFF(dst, u) do { _Pragma("unroll") for (int h_ = 0; h_ < 2; ++h_) _Pragma("unroll") for (int i_ = 0; i_ < 2; ++i_) \
        dst[h_][i_] = (unsigned)g.rowidx[(u).pa * 256 + h_ * 128 + grow[i_]] * (unsigned)(K * 2) + gcol[i_]; } while (0)
    if constexpr (GATHER) PG8_GOFF(gcu, cur);
#define PG8_STAGE_A(bufoff, h_, nonGatherPtr, gatherBase, GO) do { if constexpr (GATHER) { PG8_STAGE(bufoff, gatherBase, GO[h_]); } else { PG8_STAGE(bufoff, nonGatherPtr, voffA); } } while (0)
    PG8_STAGE(PG8_SB(0, 0), cB, voffB); PG8_STAGE(PG8_SB(0, 1), cB + hstep, voffB); PG8_STAGE_A(PG8_SA(0, 0), 0, cA, cA, gcu); PG8_STAGE_A(PG8_SA(0, 1), 1, cA + hstep, cA, gcu);
    if (wr == 1) PG8_BAR;
    PG8_WAIT_V(2); PG8_BAR;
    PG8_STAGE(PG8_SB(1, 0), cB + kstep, voffB); PG8_STAGE_A(PG8_SA(1, 0), 0, cA + kstep, cA + kstep, gcu); PG8_STAGE(PG8_SB(1, 1), cB + hstep + kstep, voffB);
    PG8_WAIT_V(6); PG8_BAR;
    for (;;) {
        const bool has_next = S.next(ui + 1, nxt);
        const char* nA = GATHER ? cA : (has_next ? PG8_APTR(nxt) : cA); const char* nB = has_next ? PG8_BPTR(nxt) : cB;
        if constexpr (GATHER) { if (has_next) PG8_GOFF(gnx, nxt); else { _Pragma("unroll") for (int h_ = 0; h_ < 2; ++h_) _Pragma("unroll") for (int i_ = 0; i_ < 2; ++i_) gnx[h_][i_] = gcu[h_][i_]; } }
        for (int t = 0; t < nt; t += 2) {
            const bool last = (t == nt - 2);
            const char* a1 = cA + (size_t)(t + 1) * kstep;
            const char* a2 = last ? nA : cA + (size_t)(t + 2) * kstep; const char* b2 = last ? nB : cB + (size_t)(t + 2) * kstep;
            const char* a3 = a2 + kstep; const char* b3 = b2 + kstep;
            unsigned gse[2][2];
            _Pragma("unroll") for (int h_ = 0; h_ < 2; ++h_) _Pragma("unroll") for (int i_ = 0; i_ < 2; ++i_) gse[h_][i_] = last ? gnx[h_][i_] : gcu[h_][i_];
            PG8_LDB(B0, 0, 0); PG8_LDB(B1, 0, 1); PG8_SCHED; PG8_LDA(At, 0, 0); PG8_STAGE_A(PG8_SA(1, 1), 1, a1 + hstep, a1, gcu);
            PG8_WAIT_V(8); PG8_WAIT_L(0); PG8_BAR; PG8_MMA(0, 0, At, B0); PG8_MMA(0, 1, At, B1); PG8_BAR; PG8_SCHED;
            PG8_LDA(At, 0, 1); PG8_STAGE(PG8_SB(0, 0), b2, voffB); PG8_STAGE(PG8_SB(0, 1), b2 + hstep, voffB); PG8_STAGE_A(PG8_SA(0, 0), 0, a2, a2, gse);
            PG8_WAIT_V(8); PG8_WAIT_L(0); PG8_BAR; PG8_MMA(1, 0, At, B0); PG8_MMA(1, 1, At, B1); PG8_BAR; PG8_SCHED;
            PG8_LDB(B0, 1, 0); PG8_LDB(B1, 1, 1); PG8_SCHED; PG8_LDA(At, 1, 0); PG8_STAGE_A(PG8_SA(0, 1), 1, a2 + hstep, a2, gse);
            PG8_WAIT_V(8); PG8_WAIT_L(0); PG8_BAR; PG8_MMA(0, 0, At, B0); PG8_MMA(0, 1, At, B1); PG8_BAR; PG8_SCHED;
            PG8_LDA(At, 1, 1); PG8_STAGE(PG8_SB(1, 0), b3, voffB); PG8_STAGE(PG8_SB(1, 1), b3 + hstep, voffB); PG8_STAGE_A(PG8_SA(1, 0), 0, a3, a3, gse);
            PG8_WAIT_V(8); PG8_WAIT_L(0); PG8_BAR; PG8_MMA(1, 0, At, B0); PG8_MMA(1, 1, At, B1); PG8_BAR; PG8_SCHED;
        }
        if constexpr (ALIGN_EPI) { if (wr == 0) PG8_BAR; }
        E(acc, cur, wr, wc, fr, fq);
        if (!has_next) break;
#pragma unroll
        for (int a = 0; a < 2; ++a)
#pragma unroll
            for (int b = 0; b < 2; ++b)
#pragma unroll
                for (int m = 0; m < 4; ++m)
#pragma unroll
                    for (int n = 0; n < 2; ++n) acc[a][b][m][n] = (f32x4){0.f, 0.f, 0.f, 0.f};
        cur = nxt; cA = nA; cB = nB; ++ui;
        if constexpr (GATHER) { _Pragma("unroll") for (int h_ = 0; h_ < 2; ++h_) _Pragma("unroll") for (int i_ = 0; i_ < 2; ++i_) gcu[h_][i_] = gnx[h_][i_]; }
        if constexpr (ALIGN_EPI) { if (wr == 1) PG8_BAR; }
    }
    PG8_WAIT_V(0);
    if constexpr (!ALIGN_EPI) { if (wr == 0) PG8_BAR; }
    PG8_BAR;
#undef PG8_SA
#undef PG8_SB
#undef PG8_STAGE
#undef PG8_LDA
#undef PG8_LDB
#undef PG8_MMA
#undef PG8_WAIT_V
#undef PG8_WAIT_L
#undef PG8_BAR
#undef PG8_SCHED
#undef PG8_APTR
#undef PG8_BPTR
#undef PG8_GOFF
#undef PG8_STAGE_A
}

typedef const f32x4 (&AccRef)[2][2][4][2];

struct EpiScale {
    bf16_t* O; int ldc; const float* ss; int ssmask;
    __device__ __forceinline__ void operator()(AccRef acc, const Unit& u, int wr, int wc, int fr, int fq) const {
#pragma unroll
        for (int ai = 0; ai < 2; ++ai)
#pragma unroll
            for (int m = 0; m < 4; ++m) {
                const int row = u.pm * 256 + ai * 128 + wr * 64 + m * 16 + fr;
                const f32x4* sp = (const f32x4*)(ss + (size_t)(row & ssmask) * 16);
                const f32x4 s0 = sp[0], s1 = sp[1], s2 = sp[2], s3 = sp[3];
                const float tot = ((s0[0] + s0[1]) + (s0[2] + s0[3])) + ((s1[0] + s1[1]) + (s1[2] + s1[3])) + ((s2[0] + s2[1]) + (s2[2] + s2[3])) + ((s3[0] + s3[1]) + (s3[2] + s3[3]));
                const float rinv = rsqrtf(tot * (1.0f / 1024.0f) + 1e-6f);
#pragma unroll
                for (int bj = 0; bj < 2; ++bj) {
                    const int col = u.pn * 256 + bj * 128 + wc * 32 + 8 * fq;
                    const f32x4 v0 = acc[ai][bj][m][0] * rinv, v1 = acc[ai][bj][m][1] * rinv;
                    u32x4 w; w.x = pk2(v0[0], v0[1]); w.y = pk2(v0[2], v0[3]); w.z = pk2(v1[0], v1[1]); w.w = pk2(v1[2], v1[3]);
                    *(u32x4*)(O + (size_t)row * ldc + col) = w;
                }
            }
    }
};
struct EpiProj {
    bf16_t* O; bf16_t* VT; const float* ss;
    __device__ __forceinline__ void operator()(AccRef acc, const Unit& u, int wr, int wc, int fr, int fq) const {
#pragma unroll
        for (int ai = 0; ai < 2; ++ai)
#pragma unroll
            for (int m = 0; m < 4; ++m) {
                const int row = u.pm * 256 + ai * 128 + wr * 64 + m * 16 + fr;
                const f32x4* sp = (const f32x4*)(ss + (size_t)row * 16);
                const f32x4 s0 = sp[0], s1 = sp[1], s2 = sp[2], s3 = sp[3];
                const float tot = ((s0[0] + s0[1]) + (s0[2] + s0[3])) + ((s1[0] + s1[1]) + (s1[2] + s1[3])) + ((s2[0] + s2[1]) + (s2[2] + s2[3])) + ((s3[0] + s3[1]) + (s3[2] + s3[3]));
                const float rinv = rsqrtf(tot * (1.0f / 1024.0f) + 1e-6f);
#pragma unroll
                for (int bj = 0; bj < 2; ++bj) {
                    const int col = u.pn * 256 + bj * 128 + wc * 32 + 8 * fq;
                    const f32x4 v0 = acc[ai][bj][m][0] * rinv, v1 = acc[ai][bj][m][1] * rinv;
                    u32x4 w; w.x = pk2(v0[0], v0[1]); w.y = pk2(v0[2], v0[3]); w.z = pk2(v1[0], v1[1]); w.w = pk2(v1[2], v1[3]);
                    if (u.pn < 11) *(u32x4*)(O + (size_t)row * INW + col) = w;
                    else {
                        const int cv = col - 2816;
                        const int sq_ = row & 2047;
                        const int sp_ = (sq_ & ~31) | (((sq_ >> 2) & 3) << 3) | (((sq_ >> 4) & 1) << 2) | (sq_ & 3);
                        bf16_t* vp = VT + ((size_t)((row >> 11) * 8 + (cv >> 6)) * 64 + (cv & 63)) * 2048 + sp_;
#pragma unroll
                        for (int e = 0; e < 4; ++e) { vp[(size_t)(2 * e) * 2048] = (bf16_t)(w[e] & 0xffffu); vp[(size_t)(2 * e + 1) * 2048] = (bf16_t)(w[e] >> 16); }
                    }
                }
            }
    }
};
struct EpiRes {
    float* X; bf16_t* XB; float* SS;
    __device__ __forceinline__ void operator()(AccRef acc, const Unit& u, int wr, int wc, int fr, int fq) const {
#pragma unroll
        for (int ai = 0; ai < 2; ++ai)
#pragma unroll
            for (int m = 0; m < 4; ++m) {
                const int row = u.pm * 256 + ai * 128 + wr * 64 + m * 16 + fr;
                float sq = 0.f;
#pragma unroll
                for (int bj = 0; bj < 2; ++bj) {
                    const int col = u.pn * 256 + bj * 128 + wc * 32 + 8 * fq;
                    float* xp = X + (size_t)row * 1024 + col;
                    f32x4 x0 = *(const f32x4*)xp, x1 = *(const f32x4*)(xp + 4);
                    x0 += acc[ai][bj][m][0]; x1 += acc[ai][bj][m][1];
                    *(f32x4*)xp = x0; *(f32x4*)(xp + 4) = x1;
                    u32x4 w; w.x = pk2(x0[0], x0[1]); w.y = pk2(x0[2], x0[3]); w.z = pk2(x1[0], x1[1]); w.w = pk2(x1[2], x1[3]);
                    *(u32x4*)(XB + (size_t)row * 1024 + col) = w;
                    sq += (x0[0] * x0[0] + x0[1] * x0[1]) + (x0[2] * x0[2] + x0[3] * x0[3]) + (x1[0] * x1[0] + x1[1] * x1[1]) + (x1[2] * x1[2] + x1[3] * x1[3]);
                }
                sq += __shfl_xor(sq, 16); sq += __shfl_xor(sq, 32);
                if (fq == 0) SS[(size_t)row * 16 + u.pn * 4 + wc] = sq;
            }
    }
};
struct EpiGU {
    bf16_t* H; const float* rinv;
    __device__ __forceinline__ void operator()(AccRef acc, const Unit& u, int wr, int wc, int fr, int fq) const {
#pragma unroll
        for (int ai = 0; ai < 2; ++ai)
#pragma unroll
            for (int m = 0; m < 4; ++m) {
                const int row = u.pm * 256 + ai * 128 + wr * 64 + m * 16 + fr;
                const float rs = rinv[row];
                float h[8];
#pragma unroll
                for (int n = 0; n < 2; ++n)
#pragma unroll
                    for (int j = 0; j < 4; ++j) { const float gt = acc[ai][0][m][n][j] * rs, up = acc[ai][1][m][n][j] * rs; h[n * 4 + j] = gt * __builtin_amdgcn_rcpf(1.0f + __expf(-gt)) * up; }
                u32x4 w; w.x = pk2(h[0], h[1]); w.y = pk2(h[2], h[3]); w.z = pk2(h[4], h[5]); w.w = pk2(h[6], h[7]);
                *(u32x4*)(H + (size_t)row * 512 + u.pn * 128 + wc * 32 + 8 * fq) = w;
            }
    }
};
struct EpiDown {
    bf16_t* Y; const int* slot; const float* sw;
    __device__ __forceinline__ void operator()(AccRef acc, const Unit& u, int wr, int wc, int fr, int fq) const {
#pragma unroll
        for (int ai = 0; ai < 2; ++ai)
#pragma unroll
            for (int m = 0; m < 4; ++m) {
                const int row = u.pm * 256 + ai * 128 + wr * 64 + m * 16 + fr;
                const int s = slot[row]; const float wgt = sw[row];
                if (s >= 0) {
#pragma unroll
                    for (int bj = 0; bj < 2; ++bj) {
                        const int col = u.pn * 256 + bj * 128 + wc * 32 + 8 * fq;
                        const f32x4 v0 = acc[ai][bj][m][0] * wgt, v1 = acc[ai][bj][m][1] * wgt;
                        u32x4 w; w.x = pk2(v0[0], v0[1]); w.y = pk2(v0[2], v0[3]); w.z = pk2(v1[0], v1[1]); w.w = pk2(v1[2], v1[3]);
                        *(u32x4*)(Y + (size_t)s * 1024 + col) = w;
                    }
                }
            }
    }
};
}

#define WSP(type, off) ((type*)(a.ws + (off)))
__device__ __forceinline__ int oblk() { int t = blockIdx.x; asm volatile("" : "+s"(t)); return t; }
__device__ __forceinline__ int ogrid() { int t = gridDim.x; asm volatile("" : "+s"(t)); return t; }
__device__ __forceinline__ int otid() { int t = threadIdx.x; asm volatile("" : "+v"(t)); return t; }
constexpr int LDS_INTAB = LDS_MISC + 14336;
__device__ __forceinline__ const float* ldsin(LAS unsigned char* lds, int i) {
    const unsigned long long p = ((const LAS unsigned long long*)(lds + LDS_INTAB))[i];
    const unsigned lo = __builtin_amdgcn_readfirstlane((unsigned)p), hi = __builtin_amdgcn_readfirstlane((unsigned)(p >> 32));
    return (const float*)(__attribute__((address_space(1))) const float*)(((unsigned long long)hi << 32) | lo);
}
#define INP(i) ldsin(lds, (i))

template <int MAP>
__device__ __forceinline__ void conv_slab(const float* __restrict__ src, int N, int Kper, bf16_t* __restrict__ dst, size_t estride,
                                          const float* __restrict__ gain, int goff, LAS float* tile, int slab) {
    const int tid = otid();
    const int nsn = N >> 8;
    const int kt = slab / nsn, ns = slab - kt * nsn, k0 = kt * 64, n0 = ns * 256;
    const int e = k0 / Kper, kl0 = k0 - e * Kper;
    f32x4 v[8];
#pragma unroll
    for (int i = 0; i < 8; ++i) { const int idx = tid + i * 512, kk = idx >> 6, n4 = (idx & 63) * 4; v[i] = *(const f32x4*)(src + (size_t)(k0 + kk) * N + n0 + n4); }
#pragma unroll
    for (int i = 0; i < 8; ++i) {
        const int idx = tid + i * 512, kk = idx >> 6, n4 = (idx & 63) * 4;
        float gsc = 1.0f;
        if (gain != nullptr && kl0 + kk >= goff) gsc = gain[kl0 + kk - goff];
        LAS float* tp = tile + kk * 257 + n4;
        tp[0] = v[i][0] * gsc; tp[1] = v[i][1] * gsc; tp[2] = v[i][2] * gsc; tp[3] = v[i][3] * gsc;
    }
    __syncthreads();
#pragma unroll
    for (int i = 0; i < 4; ++i) {
        const int p = tid + i * 512, nn = p >> 3, kg = p & 7;
        float x[8];
#pragma unroll
        for (int j = 0; j < 8; ++j) x[j] = tile[(kg * 8 + j) * 257 + nn];
        const int n = n0 + nn;
        const int nr = (MAP == 0) ? n : ((n >> 7) * 256 + (n & 127) + (MAP == 2 ? 128 : 0));
        u32x4 w; w.x = pk2(x[0], x[1]); w.y = pk2(x[2], x[3]); w.z = pk2(x[4], x[5]); w.w = pk2(x[6], x[7]);
        *(u32x4*)(dst + (size_t)e * estride + (size_t)nr * Kper + kl0 + kg * 8) = w;
    }
    __syncthreads();
}
template <int MAP>
__device__ __forceinline__ void conv_T(const float* __restrict__ src, int Ktot, int N, int Kper, bf16_t* __restrict__ dst, size_t estride,
                                       const float* __restrict__ gain, int goff, LAS float* tile) {
    const int nslab = (Ktot >> 6) * (N >> 8);
    for (int sl = oblk(); sl < nslab; sl += ogrid()) conv_slab<MAP>(src, N, Kper, dst, estride, gain, goff, tile, sl);
}
constexpr int MOE_CONV_ITEMS = 3 * 128;
__device__ __forceinline__ void moe_convert_item(const PA a, int l, LAS unsigned char* lds, int item) {
    LAS float* tile = (LAS float*)lds;
    const int which = item >> 7, s0 = (item & 127) * 8;
    const float* gn = INP(30) + l * 1024;
    for (int sl = s0; sl < s0 + 8; ++sl) {
        if (which == 0)      conv_slab<1>(INP(35) + (size_t)l * 32 * 1024 * 512, 512, 1024, WSP(bf16_t, WS_WGU), (size_t)1024 * 1024, gn, 0, tile, sl);
        else if (which == 1) conv_slab<2>(INP(36) + (size_t)l * 32 * 1024 * 512, 512, 1024, WSP(bf16_t, WS_WGU), (size_t)1024 * 1024, gn, 0, tile, sl);
        else                 conv_slab<0>(INP(37) + (size_t)l * 32 * 512 * 1024, 1024, 512, WSP(bf16_t, WS_WD), (size_t)1024 * 512, nullptr, 0, tile, sl);
    }
}

__device__ __forceinline__ void rows_convert(const float* __restrict__ src, float* __restrict__ dstf, bf16_t* __restrict__ dstb, float* __restrict__ ss, int nrows) {
    const int wave = otid() >> 6, lane = otid() & 63;
    for (int r = oblk() * 8 + wave; r < nrows; r += ogrid() * 8) {
        float sq = 0.f;
#pragma unroll
        for (int i = 0; i < 4; ++i) {
            const int c = i * 256 + lane * 4;
            const f32x4 v = *(const f32x4*)(src + (size_t)r * 1024 + c);
            if (dstf) *(f32x4*)(dstf + (size_t)r * 1024 + c) = v;
            u32x2 w; w.x = pk2(v[0], v[1]); w.y = pk2(v[2], v[3]);
            *(u32x2*)(dstb + (size_t)r * 1024 + c) = w;
            sq += (v[0] * v[0] + v[1] * v[1]) + (v[2] * v[2] + v[3] * v[3]);
        }
        sq = wsum(sq);
        if (lane < 16) ss[(size_t)r * 16 + lane] = (lane == 0) ? sq : 0.f;
    }
}

__device__ __forceinline__ void p0_prologue(const PA a, LAS unsigned char* lds) {
    LAS float* tile = (LAS float*)lds;
    for (int l = 0; l < NL; ++l) {
        conv_T<0>(INP(3) + (size_t)l * 1024 * INW, 1024, INW, 1024, WSP(bf16_t, WS_WIN) + (size_t)l * INW * 1024, 0, INP(2) + l * 1024, 0, tile);
        conv_T<0>(INP(22) + (size_t)l * 1024 * 1024, 1024, 1024, 1024, WSP(bf16_t, WS_WOUT) + (size_t)l * 1024 * 1024, 0, INP(21) + l * 512, 512, tile);
        conv_T<0>(INP(25) + (size_t)l * 1024 * 512, 1024, 512, 1024, WSP(bf16_t, WS_WQ) + (size_t)l * 512 * 1024, 0, INP(23) + l * 1024, 0, tile);
        conv_T<0>(INP(26) + (size_t)l * 1024 * 1024, 1024, 1024, 1024, WSP(bf16_t, WS_WKV) + (size_t)l * 1024 * 1024, 0, INP(24) + l * 1024, 0, tile);
        conv_T<0>(INP(27) + (size_t)l * 512 * 1024, 512, 1024, 512, WSP(bf16_t, WS_WO) + (size_t)l * 1024 * 512, 0, nullptr, 0, tile);
    }
    {
        bf16_t* wrh = WSP(bf16_t, WS_WRH); bf16_t* wrl = WSP(bf16_t, WS_WRL);
        for (int idx = oblk() * 512 + otid(); idx < NL * 48 * 1024; idx += ogrid() * 512) {
            const int k = idx & 1023, r = (idx >> 10) % 48, l = idx / (48 * 1024);
            float w;
            if (r < 16) w = INP(31)[((size_t)l * 1024 + k) * 4 + (r & 3)];
            else { const int ri = ((r >> 2) & 3) * 8 + ((r >> 4) - 1) * 4 + (r & 3); w = INP(33)[((size_t)l * 1024 + k) * 32 + ri]; }
            w *= INP(30)[l * 1024 + k];
            const bf16_t hi = f2bf(w);
            wrh[idx] = hi; wrl[idx] = f2bf(w - bf2f(hi));
        }
    }
    {
        const int gt = oblk() * 512 + otid(), gs = ogrid() * 512;
        for (int e = gt; e < 16 * 8192; e += gs) { const int im = e >> 13, idx = e & 8191, ch = idx & 127, k = idx >> 7, l = im >> 2, chb = (im & 3) * 128;
            bf16_t* ib = (bf16_t*)(a.ws + WS_PBI + (size_t)im * PBI_BYTES);
            ib[ch * 72 + k] = f2bf(INP(6)[(size_t)l * 64 * 512 + k * 512 + chb + ch]); ib[9216 + ch * 72 + k] = f2bf(INP(8)[(size_t)l * 64 * 512 + k * 512 + chb + ch]); }
        for (int e = gt; e < 16 * 16384; e += gs) { const int im = e >> 14, idx = e & 16383, ch = idx & 127, k = idx >> 7, l = im >> 2, chb = (im & 3) * 128;
            bf16_t* ib = (bf16_t*)(a.ws + WS_PBI + (size_t)im * PBI_BYTES);
            ib[18432 + ch * 136 + k] = f2bf(INP(9)[(size_t)l * 128 * 512 + k * 512 + chb + ch]); }
        for (int e = gt; e < 16 * 4096; e += gs) { const int im = e >> 12, idx = e & 4095, ch = idx & 127, k = idx >> 7, l = im >> 2, chb = (im & 3) * 128;
            bf16_t* ib = (bf16_t*)(a.ws + WS_PBI + (size_t)im * PBI_BYTES);
            ib[35840 + ch * 40 + k] = l > 0 ? f2bf(INP(17)[(size_t)(l - 1) * 32 * 512 + k * 512 + chb + ch]) : (bf16_t)0; }
        for (int e = gt; e < 16 * 16384; e += gs) { const int im = e >> 14, idx = e & 16383, n = idx & 31, k = idx >> 5, l = im >> 2;
            bf16_t* ib = (bf16_t*)(a.ws + WS_PBI + (size_t)im * PBI_BYTES);
            ib[40960 + n * 520 + k] = l > 0 ? f2bf(INP(16)[(size_t)(l - 1) * 512 * 32 + k * 32 + n]) : (bf16_t)0; }
        for (int e = gt; e < 16 * 1920; e += gs) { const int im = e / 1920, idx = e - im * 1920, l = im >> 2, chb = (im & 3) * 128;
            float* fb = (float*)(a.ws + WS_PBI + (size_t)im * PBI_BYTES + 115200);
            float v;
            if (idx < 1152) { const int arr = idx >> 7, cc = chb + (idx & 127);
                v = arr == 0 ? INP(4)[l * 1792 + cc] : arr == 1 ? INP(4)[l * 1792 + 512 + cc] : arr == 2 ? INP(4)[l * 1792 + 1024 + cc] : arr == 3 ? INP(5)[l * 512 + cc]
                  : arr == 4 ? INP(7)[l * 512 + cc] : arr == 5 ? INP(10)[l * 512 + cc] : arr == 6 ? INP(11)[l * 512 + cc] : arr == 7 ? (l > 0 ? INP(15)[(l - 1) * 512 + cc] : 0.f) : INP(12)[l * 512 + cc]; }
            else v = INP(4)[l * 1792 + 1024 + (idx - 1152)];
            fb[idx] = v; }
    }
    rows_convert(INP(0), a.out, WSP(bf16_t, WS_XB), WSP(float, WS_SS), T);
    rows_convert(INP(1), nullptr, WSP(bf16_t, WS_MEMB), WSP(float, WS_MEMSS), MROWS);
}

__device__ __forceinline__ void p2_knorm(const PA a, LAS unsigned char* lds) {
    const int wave = otid() >> 6, lane = otid() & 63;
    bf16_t* kv = WSP(bf16_t, WS_KV);
    for (int it = oblk() * 8 + wave; it < NL * MROWS * 4; it += ogrid() * 8) {
        const int h = it & 3, row = (it >> 2) & (MROWS - 1), l = it >> 14;
        unsigned* p = (unsigned*)(kv + ((size_t)l * MROWS + row) * 1024 + h * 128 + lane * 2);
        const unsigned w = *p; const float x0 = lo16(w), x1 = hi16(w);
        const float ssq = wsum(x0 * x0 + x1 * x1);
        const float rinv = rsqrtf(ssq * (1.0f / 128.0f) + 1e-6f);
        const float* gk = INP(29) + l * 128 + lane * 2;
        *p = pk2(x0 * rinv * gk[0], x1 * rinv * gk[1]);
    }
    bf16_t* vtx = WSP(bf16_t, WS_VTX);
    const int tid = otid();
    for (int it = oblk(); it < NL * 16 * 4; it += ogrid()) {
        const int h = it & 3, b = (it >> 2) & 15, l = it >> 6;
        const bf16_t* src = kv + ((size_t)l * MROWS + b * 256) * 1024 + 512 + h * 128;
        bf16_t* dst = vtx + (size_t)it * 128 * 256;
#pragma unroll 1
        for (int i = 0; i < 8; ++i) {
            const int p = tid + i * 512, d = p & 127, m8 = (p >> 7) * 8;
            unsigned short x[8];
#pragma unroll
            for (int j = 0; j < 8; ++j) x[j] = src[(size_t)(m8 + j) * 1024 + d];
            u32x4 w; w.x = x[0] | ((unsigned)x[1] << 16); w.y = x[2] | ((unsigned)x[3] << 16); w.z = x[4] | ((unsigned)x[5] << 16); w.w = x[6] | ((unsigned)x[7] << 16);
            *(u32x4*)(dst + (size_t)d * 256 + m8) = w;
        }
    }
}

__device__ __forceinline__ float fast_tanh(float x) { return 1.0f - 2.0f * __builtin_amdgcn_rcpf(1.0f + __expf(2.0f * x)); }
__device__ __forceinline__ float fast_sigmoid(float x) { return __builtin_amdgcn_rcpf(1.0f + __expf(-x)); }
template <int MODE>
__device__ __forceinline__ bf16x8 mixfrag(const bf16_t* pu, const bf16_t* pp, float hpf, unsigned mub, int colc, int col) {
    const u32x4 u = *(const u32x4*)(pu + col), p = *(const u32x4*)(pp + col);
    const f32x4 m0 = *(const LAS f32x4*)(unsigned long long)(mub + (unsigned)colc * 4u), m1 = *(const LAS f32x4*)(unsigned long long)(mub + (unsigned)colc * 4u + 16u);
    float x[8];
#pragma unroll
    for (int j = 0; j < 4; ++j) {
        const float u0 = lo16(u[j]), u1 = hi16(u[j]), p0 = lo16(p[j]) * hpf, p1 = hi16(p[j]) * hpf;
        const float ma = (j < 2) ? m0[2 * j] : m1[2 * j - 4], mb = (j < 2) ? m0[2 * j + 1] : m1[2 * j - 3];
        x[2 * j] = u0 + ma * (p0 - u0); x[2 * j + 1] = u1 + mb * (p1 - u1);
    }
#pragma unroll
    for (int j = 0; j < 8; ++j) { if (MODE == 1) x[j] = fast_tanh(x[j]); if (MODE == 2) x[j] = fast_sigmoid(x[j]); }
    u32x4 w; w.x = pk2(x[0], x[1]); w.y = pk2(x[2], x[3]); w.z = pk2(x[4], x[5]); w.w = pk2(x[6], x[7]);
    return __builtin_bit_cast(bf16x8, w);
}
__device__ __forceinline__ void pb_prep(const PA a, int l, LAS unsigned char* lds) {
    const int tid = otid(), wave = __builtin_amdgcn_readfirstlane(tid >> 6), lane0 = tid & 63, fr0 = lane0 & 15, fq0 = lane0 >> 4;
    const int G = ogrid(), blk = oblk();
    LAS bf16_t* s_w2 = (LAS bf16_t*)lds;
    LAS bf16_t* s_a2 = (LAS bf16_t*)(lds + 18432);
    LAS bf16_t* s_g2 = (LAS bf16_t*)(lds + 36864);
    LAS bf16_t* s_v2 = (LAS bf16_t*)(lds + 71680);
    LAS bf16_t* s_v1 = (LAS bf16_t*)(lds + 81920);
    LAS float* s_par = (LAS float*)(lds + 115200);
    LAS float* s_mux = s_par + 1152;
    bf16_t* proj = WSP(bf16_t, WS_PROJ);
    const float* mu = INP(4) + l * 1792;
    const float* w0 = INP(5) + l * 512;  const float* w2 = INP(6) + (size_t)l * 64 * 512;
    const float* a0 = INP(7) + l * 512;  const float* a2 = INP(8) + (size_t)l * 64 * 512;
    const float* g2 = INP(9) + (size_t)l * 128 * 512;
    const float* kkw = INP(10) + l * 512; const float* kaw = INP(11) + l * 512;
    const int lv = l > 0 ? l - 1 : 0;
    const float* v0 = INP(15) + lv * 512; const float* v1 = INP(16) + (size_t)lv * 512 * 32; const float* v2 = INP(17) + (size_t)lv * 32 * 512;
    const float* qgn = INP(18) + l * 64; const float* kgn = INP(19) + l * 64;
    bf16_t* SR = WSP(bf16_t, WS_SR); bf16_t* SK = WSP(bf16_t, WS_SK); bf16_t* SV = WSP(bf16_t, WS_SV);
    bf16_t* SA = WSP(bf16_t, WS_SA); bf16_t* SB = WSP(bf16_t, WS_SB); bf16_t* SG = WSP(bf16_t, WS_SG);
    bf16_t* SWD = WSP(bf16_t, WS_SWD); bf16_t* VF = WSP(bf16_t, WS_VF);
    int cur_hp = -1;
    for (int item = blk; item < 4 * (T / 128); item += G) {
        const int hp = item & 3, tt = item >> 2;
        if (hp != cur_hp) {
            __syncthreads();
            const unsigned char* img = a.ws + WS_PBI + (size_t)(l * 4 + hp) * PBI_BYTES;
            for (int p = tid; p < PBI_BYTES / 16; p += 512) *(LAS u32x4*)(lds + p * 16) = *(const u32x4*)(img + (size_t)p * 16);
            __syncthreads();
            cur_hp = hp;
        }
        const int lane = otid() & 63, fr = lane & 15, fq = lane >> 4;
        const int t = tt * 128 + wave * 16 + fr;
        const bool hpv = (t & (SEQ - 1)) != 0;
        const bf16_t* pu = proj + (size_t)t * INW;
        const bf16_t* pp = hpv ? pu - INW : pu;
        const float hpf = hpv ? 1.0f : 0.0f;
        unsigned mub = (unsigned)(unsigned long long)s_mux - 4096u + (unsigned)(fq * 32); asm volatile("" : "+v"(mub));
        bf16x8 fwl[2], fal[2], fgl[4], ft32;
#pragma unroll
        for (int s = 0; s < 2; ++s) { fwl[s] = mixfrag<1>(pu, pp, hpf, mub, 1536 + 32 * s, 1536 + 32 * s + 8 * fq); fal[s] = mixfrag<0>(pu, pp, hpf, mub, 1600 + 32 * s, 1600 + 32 * s + 8 * fq); }
#pragma unroll
        for (int s = 0; s < 4; ++s) fgl[s] = mixfrag<2>(pu, pp, hpf, mub, 1664 + 32 * s, 1664 + 32 * s + 8 * fq);
        {
#pragma unroll
            for (int n8 = 0; n8 < 8; ++n8) {
                f32x4 ag = {0.f, 0.f, 0.f, 0.f};
#pragma unroll
                for (int s = 0; s < 4; ++s) ag = __builtin_amdgcn_mfma_f32_16x16x32_bf16(*(const LAS bf16x8*)(s_g2 + (n8 * 16 + fr) * 136 + 32 * s + 8 * fq), fgl[s], ag, 0, 0, 0);
                u32x2 w; w.x = pk2(ag[0], ag[1]); w.y = pk2(ag[2], ag[3]); *(u32x2*)(SG + (size_t)t * 512 + hp * 128 + n8 * 16 + 4 * fq) = w;
            }
        }
        ft32 = fwl[0];
        if (l > 0) {
            f32x4 c0 = {0.f, 0.f, 0.f, 0.f}, c1 = {0.f, 0.f, 0.f, 0.f};
#pragma unroll 8
            for (int s = 0; s < 16; ++s) {
                const bf16x8 xf = mixfrag<0>(pu, pp, hpf, mub, 1024 + 32 * s, 1024 + 32 * s + 8 * fq);
                const bf16x8 wa = *(const LAS bf16x8*)(s_v1 + fr * 520 + 32 * s + 8 * fq), wb = *(const LAS bf16x8*)(s_v1 + (16 + fr) * 520 + 32 * s + 8 * fq);
                c0 = __builtin_amdgcn_mfma_f32_16x16x32_bf16(wa, xf, c0, 0, 0, 0);
                c1 = __builtin_amdgcn_mfma_f32_16x16x32_bf16(wb, xf, c1, 0, 0, 0);
            }
            u32x4 w; w.x = pk2(c0[0], c0[1]); w.y = pk2(c0[2], c0[3]); w.z = pk2(c1[0], c1[1]); w.w = pk2(c1[2], c1[3]);
            ft32 = __builtin_bit_cast(bf16x8, w);
        }
#pragma unroll 1
        for (int hh = 0; hh < 2; ++hh) {
            u32x2 kkp[4], avp[4], dcp[4];
            u32x2 xrp[4], kmp[4], xvp[4];
            float kss = 0.f, bsum = 0.f;
            u32x2 Lur[4], Lpr[4], Luk[4], Lpk[4], Luv[4], Lpv[4], Lvf[4];
#pragma unroll
            for (int nt = 0; nt < 4; ++nt) {
                if ((nt & 1) == 0) {
#pragma unroll
                    for (int n2 = nt; n2 < nt + 2; ++n2) {
                        const int c4 = hp * 128 + hh * 64 + n2 * 16 + 4 * fq;
                        Lur[n2] = *(const u32x2*)(pu + c4); Lpr[n2] = *(const u32x2*)(pp + c4);
                        Luk[n2] = *(const u32x2*)(pu + 512 + c4); Lpk[n2] = *(const u32x2*)(pp + 512 + c4);
                        Luv[n2] = *(const u32x2*)(pu + 1024 + c4); Lpv[n2] = *(const u32x2*)(pp + 1024 + c4);
                        Lvf[n2] = (l > 0) ? *(const u32x2*)(VF + (size_t)t * 512 + c4) : (u32x2){0u, 0u};
                    }
                    __builtin_amdgcn_sched_barrier(0);
                }
                const int lc = hh * 64 + nt * 16, ch4 = hp * 128 + lc + 4 * fq;
                f32x4 aw = {0.f, 0.f, 0.f, 0.f}, aa = aw, az = aw;
#pragma unroll
                for (int s = 0; s < 2; ++s) {
                    aw = __builtin_amdgcn_mfma_f32_16x16x32_bf16(*(const LAS bf16x8*)(s_w2 + (lc + fr) * 72 + 32 * s + 8 * fq), fwl[s], aw, 0, 0, 0);
                    aa = __builtin_amdgcn_mfma_f32_16x16x32_bf16(*(const LAS bf16x8*)(s_a2 + (lc + fr) * 72 + 32 * s + 8 * fq), fal[s], aa, 0, 0, 0);
                }
                if (l > 0) {
                    const u32x2 q0 = *(const LAS u32x2*)(s_v2 + (lc + fr) * 40 + 4 * fq), q1 = *(const LAS u32x2*)(s_v2 + (lc + fr) * 40 + 16 + 4 * fq);
                    u32x4 w; w.x = q0.x; w.y = q0.y; w.z = q1.x; w.w = q1.y;
                    az = __builtin_amdgcn_mfma_f32_16x16x32_bf16(__builtin_bit_cast(bf16x8, w), ft32, az, 0, 0, 0);
                }
                const u32x2 ur = Lur[nt], pr = Lpr[nt], uk = Luk[nt], pk = Lpk[nt], uv = Luv[nt], pv = Lpv[nt];
                const int pc4 = lc + 4 * fq;
                const f32x4 mr = *(const LAS f32x4*)(s_par + pc4), mk = *(const LAS f32x4*)(s_par + 128 + pc4), mv = *(const LAS f32x4*)(s_par + 256 + pc4);
                const f32x4 w0v = *(const LAS f32x4*)(s_par + 384 + pc4), a0v = *(const LAS f32x4*)(s_par + 512 + pc4), kkwv = *(const LAS f32x4*)(s_par + 640 + pc4), kawv = *(const LAS f32x4*)(s_par + 768 + pc4);
                float xr[4], xk[4], xv[4];
                { const float u0 = lo16(ur.x), u1 = hi16(ur.x), u2 = lo16(ur.y), u3 = hi16(ur.y);
                  xr[0] = u0 + mr[0] * (lo16(pr.x) * hpf - u0); xr[1] = u1 + mr[1] * (hi16(pr.x) * hpf - u1); xr[2] = u2 + mr[2] * (lo16(pr.y) * hpf - u2); xr[3] = u3 + mr[3] * (hi16(pr.y) * hpf - u3); }
                { const float u0 = lo16(uk.x), u1 = hi16(uk.x), u2 = lo16(uk.y), u3 = hi16(uk.y);
                  xk[0] = u0 + mk[0] * (lo16(pk.x) * hpf - u0); xk[1] = u1 + mk[1] * (hi16(pk.x) * hpf - u1); xk[2] = u2 + mk[2] * (lo16(pk.y) * hpf - u2); xk[3] = u3 + mk[3] * (hi16(pk.y) * hpf - u3); }
                { const float u0 = lo16(uv.x), u1 = hi16(uv.x), u2 = lo16(uv.y), u3 = hi16(uv.y);
                  xv[0] = u0 + mv[0] * (lo16(pv.x) * hpf - u0); xv[1] = u1 + mv[1] * (hi16(pv.x) * hpf - u1); xv[2] = u2 + mv[2] * (lo16(pv.y) * hpf - u2); xv[3] = u3 + mv[3] * (hi16(pv.y) * hpf - u3); }
                const size_t o = (size_t)t * 512 + ch4;
                if (l > 0) {
                    const f32x4 v0v = *(const LAS f32x4*)(s_par + 896 + pc4);
                    const u32x2 vfw = Lvf[nt];
                    const float vf0 = lo16(vfw.x), vf1 = hi16(vfw.x), vf2 = lo16(vfw.y), vf3 = hi16(vfw.y);
                    xv[0] += (vf0 - xv[0]) * fast_sigmoid(v0v[0] + az[0]); xv[1] += (vf1 - xv[1]) * fast_sigmoid(v0v[1] + az[1]);
                    xv[2] += (vf2 - xv[2]) * fast_sigmoid(v0v[2] + az[2]); xv[3] += (vf3 - xv[3]) * fast_sigmoid(v0v[3] + az[3]);
                } else {
                    u32x2 w; w.x = pk2(xv[0], xv[1]); w.y = pk2(xv[2], xv[3]); *(u32x2*)(VF + o) = w;
                }
                const f32x4 rkv = *(const LAS f32x4*)(s_par + 1024 + pc4);
                float kmod[4], dcj[4], kkj[4], avj[4];
#pragma unroll
                for (int j = 0; j < 4; ++j) {
                    dcj[j] = 0.8750387749f * fast_sigmoid(w0v[j] + aw[j]);
                    avj[j] = fast_sigmoid(a0v[j] + aa[j]);
                    kkj[j] = xk[j] * kkwv[j];
                    kss += kkj[j] * kkj[j];
                    kmod[j] = xk[j] * (1.0f + (avj[j] - 1.0f) * kawv[j]);
                }
                dcp[nt].x = pk2(dcj[0], dcj[1]); dcp[nt].y = pk2(dcj[2], dcj[3]);
                kkp[nt].x = pk2(kkj[0], kkj[1]); kkp[nt].y = pk2(kkj[2], kkj[3]); avp[nt].x = pk2(avj[0], avj[1]); avp[nt].y = pk2(avj[2], avj[3]);
                xrp[nt].x = pk2(xr[0], xr[1]); xrp[nt].y = pk2(xr[2], xr[3]); kmp[nt].x = pk2(kmod[0], kmod[1]); kmp[nt].y = pk2(kmod[2], kmod[3]);
                xvp[nt].x = pk2(xv[0], xv[1]); xvp[nt].y = pk2(xv[2], xv[3]);
                bsum += lo16(xrp[nt].x) * lo16(kmp[nt].x) * rkv[0] + hi16(xrp[nt].x) * hi16(kmp[nt].x) * rkv[1] + lo16(xrp[nt].y) * lo16(kmp[nt].y) * rkv[2] + hi16(xrp[nt].y) * hi16(kmp[nt].y) * rkv[3];
            }
            kss += __shfl_xor(kss, 16); kss += __shfl_xor(kss, 32);
            bsum += __shfl_xor(bsum, 16); bsum += __shfl_xor(bsum, 32);
            const float rn = rsqrtf(fmaxf(kss, 1e-24f));
            const int t0w = tt * 128 + wave * 16, hd = hp * 2 + hh;
            const int cid = ((t0w >> 11) * 8 + hd) * 128 + ((t0w & (SEQ - 1)) >> 4);
            if (fq == 0) WSP(float, WS_BS)[(size_t)t * 8 + hd] = bsum;
            bf16x8 fA[2], fR[2], fB[2], fK[2], fV[2];
#define DPP1(x, ctrl) __int_as_float(__builtin_amdgcn_update_dpp(0x3f800000, __float_as_int(x), (ctrl), 0xF, 0xF, false))
#pragma unroll
            for (int nt = 0; nt < 4; ++nt) {
                float P[4], at[4], rt[4], bt[4], kt[4];
                const float xr4[4] = {lo16(xrp[nt].x), hi16(xrp[nt].x), lo16(xrp[nt].y), hi16(xrp[nt].y)};
                const float km4[4] = {lo16(kmp[nt].x), hi16(kmp[nt].x), lo16(kmp[nt].y), hi16(kmp[nt].y)};
                const float dc4[4] = {lo16(dcp[nt].x), hi16(dcp[nt].x), lo16(dcp[nt].y), hi16(dcp[nt].y)};
                const float kk4[4] = {lo16(kkp[nt].x), hi16(kkp[nt].x), lo16(kkp[nt].y), hi16(kkp[nt].y)};
                const float av4[4] = {lo16(avp[nt].x), hi16(avp[nt].x), lo16(avp[nt].y), hi16(avp[nt].y)};
#pragma unroll
                for (int j = 0; j < 4; ++j) {
                    float p = __builtin_amdgcn_exp2f(-dc4[j]);
                    p *= DPP1(p, 0x111); p *= DPP1(p, 0x112); p *= DPP1(p, 0x114); p *= DPP1(p, 0x118);
                    const float pm = DPP1(p, 0x111);
                    const float ip = 1.0f / p;
                    const float kn = kk4[j] * rn;
                    P[j] = p; at[j] = -kn * pm; rt[j] = xr4[j] * p; bt[j] = kn * av4[j] * ip; kt[j] = km4[j] * ip;
                }
                u32x2 wa, wr_, wb, wk;
                wa.x = pk2(at[0], at[1]); wa.y = pk2(at[2], at[3]); wr_.x = pk2(rt[0], rt[1]); wr_.y = pk2(rt[2], rt[3]);
                wb.x = pk2(bt[0], bt[1]); wb.y = pk2(bt[2], bt[3]); wk.x = pk2(kt[0], kt[1]); wk.y = pk2(kt[2], kt[3]);
                if (fr == 15) *(f32x4*)(WSP(float, WS_PCK) + (size_t)cid * 64 + nt * 16 + 4 * fq) = (f32x4){P[0], P[1], P[2], P[3]};
                u32x4 w;
                if ((nt & 1) == 0) { w = (u32x4){wa.x, wa.y, 0u, 0u}; fA[nt >> 1] = __builtin_bit_cast(bf16x8, w); w = (u32x4){wr_.x, wr_.y, 0u, 0u}; fR[nt >> 1] = __builtin_bit_cast(bf16x8, w);
                                     w = (u32x4){wb.x, wb.y, 0u, 0u}; fB[nt >> 1] = __builtin_bit_cast(bf16x8, w); w = (u32x4){wk.x, wk.y, 0u, 0u}; fK[nt >> 1] = __builtin_bit_cast(bf16x8, w);
                                     w = (u32x4){xvp[nt].x, xvp[nt].y, 0u, 0u}; fV[nt >> 1] = __builtin_bit_cast(bf16x8, w); }
                else { w = __builtin_bit_cast(u32x4, fA[nt >> 1]); w.z = wa.x; w.w = wa.y; fA[nt >> 1] = __builtin_bit_cast(bf16x8, w);
                       w = __builtin_bit_cast(u32x4, fR[nt >> 1]); w.z = wr_.x; w.w = wr_.y; fR[nt >> 1] = __builtin_bit_cast(bf16x8, w);
                       w = __builtin_bit_cast(u32x4, fB[nt >> 1]); w.z = wb.x; w.w = wb.y; fB[nt >> 1] = __builtin_bit_cast(bf16x8, w);
                       w = __builtin_bit_cast(u32x4, fK[nt >> 1]); w.z = wk.x; w.w = wk.y; fK[nt >> 1] = __builtin_bit_cast(bf16x8, w);
                       w = __builtin_bit_cast(u32x4, fV[nt >> 1]); w.z = xvp[nt].x; w.w = xvp[nt].y; fV[nt >> 1] = __builtin_bit_cast(bf16x8, w); }
            }
#undef DPP1
            {
                int frv = fr, fqv = fq, lanev = lane; asm volatile("" : "+v"(frv), "+v"(fqv), "+v"(lanev));
                const unsigned rowo = (unsigned)(frv * 1024);
                char* ua = (char*)(SA + ((size_t)t0w * 512 + hd * 64)); char* ur = (char*)(SR + ((size_t)t0w * 512 + hd * 64));
#pragma unroll
                for (int s_ = 0; s_ < 2; ++s_) { const unsigned co = rowo + (unsigned)((((4 * s_ + fqv) ^ (frv & 7))) * 16);
                    *(u32x4*)(ua + co) = __builtin_bit_cast(u32x4, fA[s_]); *(u32x4*)(ur + co) = __builtin_bit_cast(u32x4, fR[s_]); }
                const f32x4 z4 = {0.f, 0.f, 0.f, 0.f};
#define MF(a_, b_, c_) __builtin_amdgcn_mfma_f32_16x16x32_bf16((a_), (b_), (c_), 0, 0, 0)
                const f32x4 nka = MF(fA[1], fK[1], MF(fA[0], fK[0], z4));
                const f32x4 nbr = MF(fR[1], fB[1], MF(fR[0], fB[0], z4));
                const f32x4 nkr = MF(fR[1], fK[1], MF(fR[0], fK[0], z4));
                const f32x4 nba = MF(fB[1], fA[1], MF(fB[0], fA[0], z4));
                unsigned nbu = (unsigned)(unsigned long long)((LAS float*)(lds + PBI_BYTES) + wave * 256); asm volatile("" : "+v"(nbu));
                LAS float* nb = (LAS float*)(unsigned long long)nbu;
                bf16_t* gim = WSP(bf16_t, WS_NKA) + (size_t)cid * 1024;
                const int ncol = (frv >> 2) * 8 + (frv & 3);
#pragma unroll
                for (int j = 0; j < 4; ++j) {
                    const int row = 4 * fqv + j;
                    gim[row * 32 + ncol + 4] = f2bf(frv < row ? nka[j] : 0.f);
                    gim[512 + row * 32 + ncol] = f2bf(frv <= row ? nbr[j] : 0.f);
                    gim[512 + row * 32 + ncol + 4] = f2bf(frv <= row ? nkr[j] : 0.f);
                    nb[row * 16 + frv] = (row < frv) ? nba[j] : 0.f;
                }
                const unsigned idv = (fqv == (frv >> 2)) ? (0x3f80u << (16 * (frv & 1))) : 0u;
                u32x4 idA = {0u, 0u, 0u, 0u}, idB = {0u, 0u, 0u, 0u};
                if ((frv & 3) < 2) { idA.x = idv; idB.z = idv; } else { idA.y = idv; idB.w = idv; }
                char* ubk = (char*)(WSP(bf16_t, WS_BTT) + (size_t)cid * 2048); char* uvs = (char*)(WSP(bf16_t, WS_VST) + (size_t)cid * 1024);
                const unsigned bko = (unsigned)(frv * 64 + fqv * 16), vso = (unsigned)(frv * 32 + fqv * 8);
#pragma unroll
                for (int n_ = 0; n_ < 4; ++n_) {
                    const bf16x8 idf = __builtin_bit_cast(bf16x8, (n_ & 1) ? idB : idA);
                    const f32x4 bT = MF(fB[n_ >> 1], idf, z4), kT = MF(fK[n_ >> 1], idf, z4), vT = MF(fV[n_ >> 1], idf, z4);
                    *(u32x4*)(ubk + n_ * 1024 + bko) = (u32x4){pk2(bT[0], bT[1]), pk2(bT[2], bT[3]), pk2(kT[0], kT[1]), pk2(kT[2], kT[3])};
                    *(u32x2*)(uvs + n_ * 512 + vso) = (u32x2){pk2(vT[0], vT[1]), pk2(vT[2], vT[3])};
                }
#undef MF
                if (lanev < 16) {
                    float X[16];
                    const int tcolp = (lanev >> 2) * 8 + (lanev & 3);
#pragma unroll
                    for (int tcol = 0; tcol < 16; ++tcol) {
                        float acc = (lanev == tcol) ? 1.0f : 0.0f;
#pragma unroll
                        for (int i = 0; i < tcol; ++i) acc += X[i] * nb[i * 16 + tcol];
                        X[tcol] = acc;
                        gim[tcol * 32 + tcolp] = f2bf(acc);
                    }
                }
            }
        }
        {
            u32x4 Lq[4][2];
#pragma unroll
            for (int qk = 0; qk < 4; ++qk) {
                const bf16_t* p = proj + (size_t)t * INW + 1792 + (qk & 1) * 512 + (hp * 2 + (qk >> 1)) * 64 + fq * 16;
                Lq[qk][0] = *(const u32x4*)p; Lq[qk][1] = *(const u32x4*)(p + 8);
            }
#pragma unroll
            for (int qk = 0; qk < 4; ++qk) {
                const float* gn = (qk & 1) ? kgn : qgn;
                bf16_t* p = proj + (size_t)t * INW + 1792 + (qk & 1) * 512 + (hp * 2 + (qk >> 1)) * 64 + fq * 16;
                const u32x4 wa = Lq[qk][0], wb = Lq[qk][1];
                float x[16];
#pragma unroll
                for (int j = 0; j < 4; ++j) { x[2 * j] = lo16(wa[j]); x[2 * j + 1] = hi16(wa[j]); x[8 + 2 * j] = lo16(wb[j]); x[9 + 2 * j] = hi16(wb[j]); }
                float ssq = 0.f;
#pragma unroll
                for (int j = 0; j < 16; ++j) ssq += x[j] * x[j];
                ssq += __shfl_xor(ssq, 16); ssq += __shfl_xor(ssq, 32);
                const float rinv = rsqrtf(ssq * (1.0f / 64.0f) + 1e-6f);
                const float qsc = (qk & 1) ? rinv : rinv * 0.18033688011112042f;
#pragma unroll
                for (int j = 0; j < 16; ++j) x[j] = x[j] * qsc * gn[fq * 16 + j];
                u32x4 oa, ob;
#pragma unroll
                for (int j = 0; j < 4; ++j) { oa[j] = pk2(x[2 * j], x[2 * j + 1]); ob[j] = pk2(x[8 + 2 * j], x[9 + 2 * j]); }
                *(u32x4*)p = oa; *(u32x4*)(p + 8) = ob;
            }
        }
    }
    __syncthreads();
}

__device__ __forceinline__ void pb2_chunks(const PA a, int l, LAS unsigned char* lds) {
    const int tid = otid(), wave = tid >> 6, lane = tid & 63, fr = lane & 15, fq = lane >> 4;
    LAS bf16_t* sA = (LAS bf16_t*)(lds + wave * 11520);
    LAS bf16_t* sR = sA + 1152; LAS bf16_t* sB = sR + 1152; LAS bf16_t* sK = sB + 1152; LAS bf16_t* sX = sK + 1152;
    LAS float* nb = (LAS float*)(lds + 8 * 11520) + wave * 256;
    bf16_t* SR = WSP(bf16_t, WS_SR); bf16_t* SK = WSP(bf16_t, WS_SK); bf16_t* SV = WSP(bf16_t, WS_SV);
    bf16_t* SA = WSP(bf16_t, WS_SA); bf16_t* SB = WSP(bf16_t, WS_SB); const bf16_t* SWD = WSP(const bf16_t, WS_SWD);
    const float* rkp = INP(12) + l * 512;
    for (int cid = oblk() * 8 + wave; cid < NCHUNK; cid += ogrid() * 8) {
        const int b = cid >> 10, h = (cid >> 7) & 7, c = cid & 127;
        const size_t tok0 = (size_t)b * SEQ + c * 16;
        const size_t e0 = tok0 * 512 + h * 64 + lane;
        const float rkv = rkp[h * 64 + lane];
        const int posl = (lane & 32) | (((lane & 15) >> 2) << 3) | (((lane >> 4) & 1) << 2) | (lane & 3);
        float P = 1.0f;
        unsigned bt2[8], kt2[8], vt2[8];
#pragma unroll
        for (int hf = 0; hf < 2; ++hf) {
            bf16_t r16[8], k16[8], a16[8], b16[8], v16[8]; float w32[8];
#pragma unroll
            for (int t8 = 0; t8 < 8; ++t8) { const size_t e = e0 + (size_t)(hf * 8 + t8) * 512; r16[t8] = SR[e]; k16[t8] = SK[e]; a16[t8] = SA[e]; b16[t8] = SB[e]; v16[t8] = SV[e]; w32[t8] = __builtin_amdgcn_exp2f(-bf2f(SWD[e])); }
#pragma unroll
            for (int t8 = 0; t8 < 8; ++t8) {
                const int t = hf * 8 + t8;
                const float rr = bf2f(r16[t8]), kk = bf2f(k16[t8]), aa = bf2f(a16[t8]), bb = bf2f(b16[t8]);
                const float Pm = P; P *= w32[t8]; const float ip = 1.0f / P;
                const unsigned ar = pk2(aa * Pm, rr * P), bk = pk2(bb * ip, kk * ip);
                const bf16_t at = (bf16_t)(ar & 0xffffu), rt = (bf16_t)(ar >> 16), btv = (bf16_t)(bk & 0xffffu), ktv = (bf16_t)(bk >> 16);
                { const size_t es = tok0 * 512 + (size_t)t * 512 + h * 64 + (posl ^ ((t & 7) << 3)); SA[es] = at; SR[es] = rt; }
                sA[t * 72 + lane] = at; sR[t * 72 + lane] = rt; sB[t * 72 + lane] = btv; sK[t * 72 + lane] = ktv;
                sX[t * 72 + lane] = (bf16_t)(pk2(rr * kk * rkv, 0.f) & 0xffffu);
                if (t & 1) { bt2[t >> 1] |= (unsigned)btv << 16; kt2[t >> 1] |= (unsigned)ktv << 16; vt2[t >> 1] |= (unsigned)v16[t8] << 16; }
                else       { bt2[t >> 1] = btv; kt2[t >> 1] = ktv; vt2[t >> 1] = v16[t8]; }
            }
        }
        WSP(float, WS_PCK)[(size_t)cid * 64 + lane] = P;
        {
            u32x4* pb_ = (u32x4*)(WSP(bf16_t, WS_BTT) + (size_t)cid * 2048 + lane * 32);
            u32x4* pv_ = (u32x4*)(WSP(bf16_t, WS_VST) + (size_t)cid * 1024 + lane * 16);
#pragma unroll
            for (int q = 0; q < 4; ++q) pb_[q] = (u32x4){bt2[2 * q], bt2[2 * q + 1], kt2[2 * q], kt2[2 * q + 1]};
            pv_[0] = (u32x4){vt2[0], vt2[1], vt2[2], vt2[3]}; pv_[1] = (u32x4){vt2[4], vt2[5], vt2[6], vt2[7]};
        }
        bf16x8 fA[2], fR[2], fB[2], fK[2], fX[2];
#pragma unroll
        for (int s_ = 0; s_ < 2; ++s_) {
            fA[s_] = *(const LAS bf16x8*)(sA + fr * 72 + 32 * s_ + 8 * fq); fR[s_] = *(const LAS bf16x8*)(sR + fr * 72 + 32 * s_ + 8 * fq);
            fB[s_] = *(const LAS bf16x8*)(sB + fr * 72 + 32 * s_ + 8 * fq); fK[s_] = *(const LAS bf16x8*)(sK + fr * 72 + 32 * s_ + 8 * fq);
            fX[s_] = *(const LAS bf16x8*)(sX + fr * 72 + 32 * s_ + 8 * fq);
        }
        const f32x4 z4 = {0.f, 0.f, 0.f, 0.f};
        const bf16x8 ones = {0x3f80, 0x3f80, 0x3f80, 0x3f80, 0x3f80, 0x3f80, 0x3f80, 0x3f80};
        const f32x4 nka = __builtin_amdgcn_mfma_f32_16x16x32_bf16(fA[1], fK[1], __builtin_amdgcn_mfma_f32_16x16x32_bf16(fA[0], fK[0], z4, 0, 0, 0), 0, 0, 0);
        const f32x4 nbr = __builtin_amdgcn_mfma_f32_16x16x32_bf16(fR[1], fB[1], __builtin_amdgcn_mfma_f32_16x16x32_bf16(fR[0], fB[0], z4, 0, 0, 0), 0, 0, 0);
        const f32x4 nkr = __builtin_amdgcn_mfma_f32_16x16x32_bf16(fR[1], fK[1], __builtin_amdgcn_mfma_f32_16x16x32_bf16(fR[0], fK[0], z4, 0, 0, 0), 0, 0, 0);
        const f32x4 nba = __builtin_amdgcn_mfma_f32_16x16x32_bf16(fB[1], fA[1], __builtin_amdgcn_mfma_f32_16x16x32_bf16(fB[0], fA[0], z4, 0, 0, 0), 0, 0, 0);
        const f32x4 bsm = __builtin_amdgcn_mfma_f32_16x16x32_bf16(fX[1], ones, __builtin_amdgcn_mfma_f32_16x16x32_bf16(fX[0], ones, z4, 0, 0, 0), 0, 0, 0);
        bf16_t* gim = WSP(bf16_t, WS_NKA) + (size_t)cid * 1024;
        const int ncol = (fr >> 2) * 8 + (fr & 3);
#pragma unroll
        for (int j = 0; j < 4; ++j) {
            const int row = 4 * fq + j;
            gim[row * 32 + ncol + 4] = f2bf(fr < row ? nka[j] : 0.f);
            gim[512 + row * 32 + ncol] = f2bf(fr <= row ? nbr[j] : 0.f);
            gim[512 + row * 32 + ncol + 4] = f2bf(fr <= row ? nkr[j] : 0.f);
            nb[row * 16 + fr] = (row < fr) ? nba[j] : 0.f;
            if (fr == 0) WSP(float, WS_BS)[(tok0 + row) * 8 + h] = bsm[j];
        }
        if (lane < 16) {
            float X[16];
            bf16_t* gtm = WSP(bf16_t, WS_NKA) + (size_t)cid * 1024; const int tcolp = (lane >> 2) * 8 + (lane & 3);
#pragma unroll
            for (int tcol = 0; tcol < 16; ++tcol) {
                float acc = (lane == tcol) ? 1.0f : 0.0f;
#pragma unroll
                for (int i = 0; i < tcol; ++i) acc += X[i] * nb[i * 16 + tcol];
                X[tcol] = acc;
                gtm[tcol * 32 + tcolp] = f2bf(acc);
            }
        }
    }
    __syncthreads();
}

__device__ __forceinline__ void scan_item(const PA a, int l, int bh, LAS unsigned char* lds) {
    const int tid = otid(), wave = __builtin_amdgcn_readfirstlane(tid >> 6), lane = tid & 63, fr = lane & 15, fq = lane >> 4;
    const int b = __builtin_amdgcn_readfirstlane(bh >> 3), h = __builtin_amdgcn_readfirstlane(bh & 7);
    constexpr int SLOT = 15104, NS = 8, DPF = 6;
    constexpr int OA = 0, OR_ = 2048, OBK = 4096, OVT = 8192, ON = 10240, OPC = 12288, OBS = 12544, OSG = 13056;
    constexpr int YBO = NS * SLOT;
    const size_t tokb = (size_t)b * SEQ;
    const int cid0 = (b * 8 + h) * 128;
    const unsigned char* gA = (const unsigned char*)WSP(const bf16_t, WS_SA); const unsigned char* gR = (const unsigned char*)WSP(const bf16_t, WS_SR);
    const unsigned char* gG = (const unsigned char*)WSP(const bf16_t, WS_SG);
    const unsigned char* gBK = (const unsigned char*)WSP(const bf16_t, WS_BTT);
    const unsigned char* gVT = (const unsigned char*)WSP(const bf16_t, WS_VST); const unsigned char* gN = (const unsigned char*)WSP(const bf16_t, WS_NKA);
    const unsigned char* gPC = (const unsigned char*)WSP(const float, WS_PCK); const unsigned char* gBS = (const unsigned char*)WSP(const float, WS_BS);
#define DMA16(gp, ldsoff) __builtin_amdgcn_global_load_lds((const unsigned*)(gp), (LAS unsigned*)(lds + (ldsoff)), 16, 0, 0)
    const unsigned rowoff0 = (unsigned)(((lane >> 3) * 512 + (lane & 7) * 8) * 2), rowoff1 = rowoff0 + 8u * 512u * 2u;
#define DMA_CHUNK(c_) do { const int cid_ = cid0 + (c_); const int so_ = ((c_) % NS) * SLOT; \
        const size_t rb_ = ((tokb + (size_t)(c_) * 16) * 512 + h * 64) * 2; \
        if (wave == 4) { \
            DMA16(gA + rb_ + rowoff0, so_ + OA); DMA16(gA + rb_ + rowoff1, so_ + OA + 1024); DMA16(gR + rb_ + rowoff0, so_ + OR_); DMA16(gR + rb_ + rowoff1, so_ + OR_ + 1024); \
            DMA16(gBK + (size_t)cid_ * 4096 + lane * 16, so_ + OBK); DMA16(gBK + (size_t)cid_ * 4096 + 1024 + lane * 16, so_ + OBK + 1024); \
            DMA16(gBK + (size_t)cid_ * 4096 + 2048 + lane * 16, so_ + OBK + 2048); DMA16(gBK + (size_t)cid_ * 4096 + 3072 + lane * 16, so_ + OBK + 3072); \
            if (lane < 16) DMA16(gPC + (size_t)cid_ * 256 + lane * 16, so_ + OPC); \
        } else { \
            DMA16(gVT + (size_t)cid_ * 2048 + lane * 16, so_ + OVT); DMA16(gVT + (size_t)cid_ * 2048 + 1024 + lane * 16, so_ + OVT + 1024); \
            DMA16(gN + (size_t)cid_ * 2048 + lane * 16, so_ + ON); DMA16(gN + (size_t)cid_ * 2048 + 1024 + lane * 16, so_ + ON + 1024); \
            DMA16(gG + rb_ + rowoff0, so_ + OSG); DMA16(gG + rb_ + rowoff1, so_ + OSG + 1024); \
            if (lane < 32) DMA16(gBS + (tokb + (size_t)(c_) * 16) * 32 + lane * 16, so_ + OBS); \
            if (lane < 1) DMA16(gPC + (size_t)cid_ * 256, so_ + OPC); if (lane < 1) DMA16(gPC + (size_t)cid_ * 256, so_ + OPC); \
        } } while (0)
#define MF(a_, b_, c_) __builtin_amdgcn_mfma_f32_16x16x32_bf16((a_), (b_), (c_), 0, 0, 0)
#define LDF(off_) (*(const LAS bf16x8*)(sl + (off_)))
    const int swz = fr & 7;
    const int aoff0 = fr * 128 + ((fq) ^ swz) * 16, aoff1 = fr * 128 + ((4 + fq) ^ swz) * 16;
    const int noff = fr * 64 + fq * 16, voff = ((wave & 3) * 16 + fr) * 32 + 8 * fq;
    const float lw = INP(13)[l * 512 + h * 64 + lane], lb = INP(14)[l * 512 + h * 64 + lane];
    bf16_t* YC = WSP(bf16_t, WS_YCAT);
#define SCAN_EPI(cp_) do { const int cp = (cp_); \
        const unsigned slb = (unsigned)(unsigned long long)(lds + (cp % NS) * SLOT), ybb = (unsigned)(unsigned long long)(lds + YBO + (cp & 1) * 4352); \
          \
        f32x4 y0, y1, y2, y3; { const unsigned ya = ybb + fr * 272 + fq * 32; \
            asm volatile("ds_read_b128 %0, %4\n\tds_read_b128 %1, %4 offset:16\n\tds_read_b128 %2, %4 offset:128\n\tds_read_b128 %3, %4 offset:144\n\ts_waitcnt lgkmcnt(0)" \
                         : "=&v"(y0), "=&v"(y1), "=&v"(y2), "=&v"(y3) : "v"(ya) : "memory"); } \
        u32x4 f0, f1, g0, g1; \
        f0.x = pk2(y0[0], y0[1]); f0.y = pk2(y0[2], y0[3]); f0.z = pk2(y1[0], y1[1]); f0.w = pk2(y1[2], y1[3]); f1.x = pk2(y2[0], y2[1]); f1.y = pk2(y2[2], y2[3]); f1.z = pk2(y3[0], y3[1]); f1.w = pk2(y3[2], y3[3]); \
        g0.x = pk2(y0[0] * y0[0], y0[1] * y0[1]); g0.y = pk2(y0[2] * y0[2], y0[3] * y0[3]); g0.z = pk2(y1[0] * y1[0], y1[1] * y1[1]); g0.w = pk2(y1[2] * y1[2], y1[3] * y1[3]); \
        g1.x = pk2(y2[0] * y2[0], y2[1] * y2[1]); g1.y = pk2(y2[2] * y2[2], y2[3] * y2[3]); g1.z = pk2(y3[0] * y3[0], y3[1] * y3[1]); g1.w = pk2(y3[2] * y3[2], y3[3] * y3[3]); \
        const bf16x8 ones = {0x3f80, 0x3f80, 0x3f80, 0x3f80, 0x3f80, 0x3f80, 0x3f80, 0x3f80}; const f32x4 z4 = {0.f, 0.f, 0.f, 0.f}; \
        const f32x4 ssum = MF(__builtin_bit_cast(bf16x8, f1), ones, MF(__builtin_bit_cast(bf16x8, f0), ones, z4));        \
        const f32x4 sqsm = MF(__builtin_bit_cast(bf16x8, g1), ones, MF(__builtin_bit_cast(bf16x8, g0), ones, z4)); \
          \
        f32x4 rs4, mr4; \
        _Pragma("unroll") for (int j = 0; j < 4; ++j) { const float mean = ssum[j] * (1.0f / 64.0f); const float var = fmaxf(sqsm[j] * (1.0f / 64.0f) - mean * mean, 0.f); \
            rs4[j] = rsqrtf(var + 64e-5f); mr4[j] = -mean * rs4[j]; } \
        float eY[8], eB[8]; unsigned eV[8], eG[8]; \
        _Pragma("unroll") for (int i = 0; i < 8; ++i) { const int t = (wave - 6) * 8 + i; \
            const unsigned ay_ = ybb + (t * 68 + lane) * 4, ab_ = slb + OBS + t * 32 + h * 4, av_ = slb + OVT + lane * 32 + t * 2, ag_ = slb + OSG + t * 128 + lane * 2; \
            asm volatile("ds_read_b32 %0, %4\n\tds_read_b32 %1, %5\n\tds_read_u16 %2, %6\n\tds_read_u16 %3, %7" \
                         : "=&v"(eY[i]), "=&v"(eB[i]), "=&v"(eV[i]), "=&v"(eG[i]) : "v"(ay_), "v"(ab_), "v"(av_), "v"(ag_) : "memory"); } \
        asm volatile("s_waitcnt lgkmcnt(0)" ::: "memory"); \
        bf16_t* yrow = YC + (tokb + (size_t)cp * 16 + (wave - 6) * 8) * 1024 + h * 64;       \
        _Pragma("unroll") for (int i = 0; i < 8; ++i) { \
            asm volatile("" : "+v"(eY[i]), "+v"(eB[i]), "+v"(eV[i]), "+v"(eG[i])); \
            const int sl_ = ((wave - 6) * 2 + (i >> 2)) * 16; \
            const float rstd = __int_as_float(__builtin_amdgcn_readlane(__float_as_int(rs4[i & 3]), sl_)); \
            const float nmr = __int_as_float(__builtin_amdgcn_readlane(__float_as_int(mr4[i & 3]), sl_)); \
            const float vv = __uint_as_float(eV[i] << 16), g = __uint_as_float(eG[i] << 16); \
            const float o_ = (eY[i] * (rstd * lw) + (nmr * lw + lb) + eB[i] * vv) * g; \
            *(bf16_t*)((char*)(yrow + (size_t)i * 1024) + (unsigned)(lane * 2)) = (bf16_t)(pk2(o_, 0.f) & 0xffffu); } } while (0)
    f32x4 S[4];
#pragma unroll
    for (int kt = 0; kt < 4; ++kt) S[kt] = (f32x4){0.f, 0.f, 0.f, 0.f};
    __syncthreads();
    if (wave == 4 || wave == 5) {
#pragma unroll 1
        for (int c = 0; c < DPF; ++c) DMA_CHUNK(c);
        asm volatile("s_waitcnt vmcnt(0)" ::: "memory");
    }
    __syncthreads();
#pragma unroll 1
    for (int c = 0; c < 128; ++c) {
        if (wave < 4) {
            const LAS unsigned char* sl = lds + (c % NS) * SLOT;
            u32x4 s0w, s1w; s0w.x = pk2(S[0][0], S[0][1]); s0w.y = pk2(S[0][2], S[0][3]); s0w.z = pk2(S[1][0], S[1][1]); s0w.w = pk2(S[1][2], S[1][3]);
            s1w.x = pk2(S[2][0], S[2][1]); s1w.y = pk2(S[2][2], S[2][3]); s1w.z = pk2(S[3][0], S[3][1]); s1w.w = pk2(S[3][2], S[3][3]);
            const bf16x8 Sf0 = __builtin_bit_cast(bf16x8, s0w), Sf1 = __builtin_bit_cast(bf16x8, s1w);
            const u32x2 vm = *(const LAS u32x2*)(sl + OVT + voff);
            const bf16x8 TN = LDF(ON + noff), BN = LDF(ON + 1024 + noff);
            const f32x4 z4 = {0.f, 0.f, 0.f, 0.f};
            const bf16x8 ZV = __builtin_bit_cast(bf16x8, (u32x4){0u, 0u, vm.x, vm.y});
            f32x4 Wt = MF(LDF(OA + aoff0), Sf0, z4); Wt = MF(LDF(OA + aoff1), Sf1, Wt); Wt = MF(TN, ZV, Wt);
            const bf16x8 WZ = __builtin_bit_cast(bf16x8, (u32x4){pk2(Wt[0], Wt[1]), pk2(Wt[2], Wt[3]), 0u, 0u});
            const f32x4 Ut = MF(TN, WZ, z4);
            const bf16x8 UV = __builtin_bit_cast(bf16x8, (u32x4){pk2(Ut[0], Ut[1]), pk2(Ut[2], Ut[3]), vm.x, vm.y});
            f32x4 Yt = MF(LDF(OR_ + aoff0), Sf0, z4); Yt = MF(LDF(OR_ + aoff1), Sf1, Yt); Yt = MF(BN, UV, Yt);
#pragma unroll
            for (int kt = 0; kt < 4; ++kt) {
                const f32x4 pc = *(const LAS f32x4*)(sl + OPC + (kt * 16 + 4 * fq) * 4);
                S[kt] = MF(LDF(OBK + kt * 1024 + noff), UV, S[kt]) * pc;
            }
            LAS float* yb = (LAS float*)(lds + YBO + (c & 1) * 4352) + (wave & 3) * 16 + fr;
#pragma unroll
            for (int j = 0; j < 4; ++j) yb[(4 * fq + j) * 68] = Yt[j];
            asm volatile("s_waitcnt lgkmcnt(0)" ::: "memory");
        } else if (wave < 6) {
            if (c + DPF < 128) DMA_CHUNK(c + DPF);
            if (c >= DPF && c + DPF < 128) asm volatile("s_waitcnt vmcnt(45)" ::: "memory"); else asm volatile("s_waitcnt vmcnt(0)" ::: "memory");
        } else if (c > 0) {
            SCAN_EPI(c - 1);
        }
        asm volatile("" ::: "memory"); __builtin_amdgcn_s_barrier(); asm volatile("" ::: "memory");
    }
    if (wave >= 6) { SCAN_EPI(127); }
    asm volatile("s_waitcnt vmcnt(0)" ::: "memory");
    __syncthreads();
#undef SCAN_EPI
#undef DMA16
#undef DMA_CHUNK
#undef MF
#undef LDF
}

__device__ __forceinline__ void attn_item(const PA a, int l, int it, LAS unsigned char* lds) {
    const int tid = otid(), h = __builtin_amdgcn_readfirstlane(tid >> 6), lane = tid & 63, fr = lane & 15, fq = lane >> 4;
    const int b = it >> 5, c = it & 31;
    LAS float* s_bias = (LAS float*)(lds + LDS_MISC + 1024);
    LAS float* s_part = s_bias + 8 * 320;
    LAS float* tb = (LAS float*)lds + h * 1600;
    __syncthreads();
    for (int e = lane; e < 1600; e += 64) { const int r = e / 400, y = e - r * 400; int idx = 383 - (y + r); idx = idx > 319 ? 319 : (idx < 0 ? 0 : idx); tb[e] = s_bias[h * 320 + idx]; }
    const bf16_t* proj = WSP(const bf16_t, WS_PROJ);
    const bf16_t* VT = WSP(const bf16_t, WS_VT) + (size_t)(b * 8 + h) * 64 * 2048;
    const size_t tq0 = (size_t)b * SEQ + c * 64;
    bf16x8 qf[4][2];
#pragma unroll
    for (int nt = 0; nt < 4; ++nt)
#pragma unroll
        for (int ks = 0; ks < 2; ++ks) qf[nt][ks] = *(const bf16x8*)(proj + (tq0 + nt * 16 + fr) * INW + 1792 + h * 64 + 32 * ks + 8 * fq);
    f32x4 o[5][4];
#pragma unroll
    for (int dt = 0; dt < 5; ++dt)
#pragma unroll
        for (int nt = 0; nt < 4; ++nt) o[dt][nt] = (f32x4){0.f, 0.f, 0.f, 0.f};
    const int kc0 = c - 8 > 0 ? c - 8 : 0;
    const int nsteps = (c - kc0 + 1) * 2;
    const bf16x8 ones = {0x3f80, 0x3f80, 0x3f80, 0x3f80, 0x3f80, 0x3f80, 0x3f80, 0x3f80};
    const int rr = (4 - (fr & 3)) & 3;
    const unsigned tbl = (unsigned)(unsigned long long)(tb + rr * 400) + (unsigned)((320 - fr + 4 * fq - rr - 48) * 4);
    const bf16_t* kbase = proj + ((size_t)b * SEQ + kc0 * 64) * INW + 2304 + h * 64;
    const unsigned koff = (unsigned)((fr * INW + 8 * fq) * 2), voffb = (unsigned)((fr * 2048 + 8 * fq) * 2);
    const bf16_t* vbase = VT + kc0 * 64;
    bf16x8 kfA[2][2], kfB[2][2]; u32x4 vfA[4], vfB[4];
#define ATT_LOAD(KF, VF, st) do { unsigned ko_ = koff, vo_ = voffb; asm volatile("" : "+v"(ko_), "+v"(vo_)); \
        const char* kp_ = (const char*)(kbase + (size_t)(st) * 32 * INW); const char* vp_ = (const char*)(vbase + (st) * 32); \
        _Pragma("unroll") for (int mt = 0; mt < 2; ++mt) _Pragma("unroll") for (int ks = 0; ks < 2; ++ks) \
            KF[mt][ks] = *(const bf16x8*)(kp_ + (size_t)(mt * 16 * INW + 32 * ks) * 2 + ko_); \
        _Pragma("unroll") for (int dt = 0; dt < 4; ++dt) VF[dt] = *(const u32x4*)(vp_ + (size_t)(dt * 16 * 2048) * 2 + vo_); } while (0)
#define MF(a_, b_, c_) __builtin_amdgcn_mfma_f32_16x16x32_bf16((a_), (b_), (c_), 0, 0, 0)
#define ATT_STEP(KF, VF, st) do { \
        f32x4 sacc[2][4]; const f32x4 z4 = {0.f, 0.f, 0.f, 0.f}; \
        _Pragma("unroll") for (int mt = 0; mt < 2; ++mt) _Pragma("unroll") for (int nt = 0; nt < 4; ++nt) sacc[mt][nt] = MF(KF[mt][1], qf[nt][1], MF(KF[mt][0], qf[nt][0], z4)); \
        const int dk = c - (kc0 + ((st) >> 1)), half = (st) & 1; \
        if (dk >= 5) { const float bc = s_bias[h * 320 + 319]; \
            _Pragma("unroll") for (int mt = 0; mt < 2; ++mt) _Pragma("unroll") for (int nt = 0; nt < 4; ++nt) sacc[mt][nt] += bc; \
        } else { \
            const unsigned ta = tbl + (unsigned)((32 * half - 64 * dk + 256) * 4); f32x4 bv[5]; \
            _Pragma("unroll") for (int dd = 0; dd < 5; ++dd) bv[dd] = *(const LAS f32x4*)(unsigned long long)(ta - 1024u + (unsigned)((3 - (dd - 1)) * 64)); \
            _Pragma("unroll") for (int mt = 0; mt < 2; ++mt) _Pragma("unroll") for (int nt = 0; nt < 4; ++nt) sacc[mt][nt] += bv[nt - mt + 1]; } \
        bf16x8 pf[4]; \
        _Pragma("unroll") for (int nt = 0; nt < 4; ++nt) { \
            u32x4 w; w.x = pk2(__builtin_amdgcn_exp2f(sacc[0][nt][0]), __builtin_amdgcn_exp2f(sacc[0][nt][1])); w.y = pk2(__builtin_amdgcn_exp2f(sacc[0][nt][2]), __builtin_amdgcn_exp2f(sacc[0][nt][3])); \
            w.z = pk2(__builtin_amdgcn_exp2f(sacc[1][nt][0]), __builtin_amdgcn_exp2f(sacc[1][nt][1])); w.w = pk2(__builtin_amdgcn_exp2f(sacc[1][nt][2]), __builtin_amdgcn_exp2f(sacc[1][nt][3])); \
            pf[nt] = __builtin_bit_cast(bf16x8, w); } \
        _Pragma("unroll") for (int nt = 0; nt < 4; ++nt) { \
            _Pragma("unroll") for (int dt = 0; dt < 4; ++dt) o[dt][nt] = MF(__builtin_bit_cast(bf16x8, VF[dt]), pf[nt], o[dt][nt]); \
            o[4][nt] = MF(ones, pf[nt], o[4][nt]); } } while (0)
    ATT_LOAD(kfA, vfA, 0);
    __syncthreads();
#pragma unroll 1
    for (int st = 0; st < nsteps; st += 2) {
        ATT_LOAD(kfB, vfB, st + 1);
        ATT_STEP(kfA, vfA, st);
        if (st + 2 < nsteps) ATT_LOAD(kfA, vfA, st + 2);
        ATT_STEP(kfB, vfB, st + 1);
    }
#undef ATT_LOAD
#undef ATT_STEP
#undef MF
#pragma unroll
    for (int nt = 0; nt < 4; ++nt) {
        const float inv = 1.0f / o[4][nt][0];
        float sq = 0.f;
#pragma unroll
        for (int dt = 0; dt < 4; ++dt) { o[dt][nt] *= inv; sq += (o[dt][nt][0] * o[dt][nt][0] + o[dt][nt][1] * o[dt][nt][1]) + (o[dt][nt][2] * o[dt][nt][2] + o[dt][nt][3] * o[dt][nt][3]); }
        sq += __shfl_xor(sq, 16); sq += __shfl_xor(sq, 32);
        if (fq == 0) s_part[h * 64 + nt * 16 + fr] = sq;
    }
    __syncthreads();
#pragma unroll
    for (int nt = 0; nt < 4; ++nt) {
        float tot = 0.f;
#pragma unroll
        for (int hh = 0; hh < 8; ++hh) tot += s_part[hh * 64 + nt * 16 + fr];
        const float rinv = rsqrtf(tot * (1.0f / 512.0f) + 1e-6f);
        bf16_t* yp = WSP(bf16_t, WS_YCAT) + (tq0 + nt * 16 + fr) * 1024 + 512 + h * 64 + 4 * fq;
#pragma unroll
        for (int dt = 0; dt < 4; ++dt) { u32x2 w; w.x = pk2(o[dt][nt][0] * rinv, o[dt][nt][1] * rinv); w.y = pk2(o[dt][nt][2] * rinv, o[dt][nt][3] * rinv); *(u32x2*)(yp + dt * 16) = w; }
    }
    __syncthreads();
}

__device__ __forceinline__ void pc_mixer(const PA a, int l, LAS unsigned char* lds) {
    const int tid = otid();
    LAS float* s_bias = (LAS float*)(lds + LDS_MISC + 1024);
    volatile LAS int* s_item = (volatile LAS int*)(lds + LDS_MISC + 64);
    for (int i = tid; i < 8 * 320; i += 512) s_bias[i] = INP(20)[l * 8 * 320 + i] * 1.4426950408889634f;
    unsigned* qhead = WSP(unsigned, WS_CTL) + CW_QUEUE + l * 64;
    for (;;) {
        __syncthreads();
        if (tid == 0) *s_item = (int)__hip_atomic_fetch_add(qhead, 1u, __ATOMIC_RELAXED, __HIP_MEMORY_SCOPE_AGENT);
        __syncthreads();
        const int item = __builtin_amdgcn_readfirstlane(*s_item);
        if (item >= 128 + 512 + MOE_CONV_ITEMS) break;
        if (item < 128) scan_item(a, l, item, lds);
        else if (item < 128 + 512) attn_item(a, l, item - 128, lds);
        else moe_convert_item(a, l, lds, item - 640);
    }
}

__device__ __forceinline__ void pe2_xattn(const PA a, int l, LAS unsigned char* lds) {
    const int tid = otid(), wave = tid >> 6, lane = tid & 63, fr = lane & 15, fq = lane >> 4;
    LAS bf16_t* sK = (LAS bf16_t*)lds;
    LAS bf16_t* sV = (LAS bf16_t*)(lds + 69632);
    const bf16_t* QX = WSP(const bf16_t, WS_QX); bf16_t* OX = WSP(bf16_t, WS_OX);
    const bf16_t* KV = WSP(const bf16_t, WS_KV) + (size_t)l * MROWS * 1024;
    const bf16_t* VTX = WSP(const bf16_t, WS_VTX) + (size_t)l * MROWS * 512;
    const float* qgn = INP(28) + l * 128;
    for (int it = oblk(); it < 256; it += ogrid()) {
        const int b = it >> 4, h = (it >> 2) & 3, qr = it & 3;
        __syncthreads();
#pragma unroll
        for (int i = 0; i < 8; ++i) {
            const int p = tid + i * 512, r = p >> 4, c8 = (p & 15) * 8;
            *(LAS u32x4*)(sK + r * 136 + c8) = *(const u32x4*)(KV + (size_t)(b * 256 + r) * 1024 + h * 128 + c8);
            const int d = p >> 5, m8 = (p & 31) * 8;
            *(LAS u32x4*)(sV + d * 264 + m8) = *(const u32x4*)(VTX + ((size_t)(b * 4 + h) * 128 + d) * 256 + m8);
        }
        __syncthreads();
#pragma unroll 1
        for (int iter = 0; iter < 2; ++iter) {
            const size_t q0 = (size_t)b * SEQ + qr * 512 + iter * 256 + wave * 32;
            bf16x8 qf[2][4];
#pragma unroll
            for (int nt = 0; nt < 2; ++nt) {
                const bf16_t* qp = QX + (q0 + nt * 16 + fr) * 512 + h * 128 + 8 * fq;
                u32x4 w[4]; float ssq = 0.f;
#pragma unroll
                for (int ks = 0; ks < 4; ++ks) { w[ks] = *(const u32x4*)(qp + 32 * ks);
#pragma unroll
                    for (int j = 0; j < 4; ++j) { const float x0 = lo16(w[ks][j]), x1 = hi16(w[ks][j]); ssq += x0 * x0 + x1 * x1; } }
                ssq += __shfl_xor(ssq, 16); ssq += __shfl_xor(ssq, 32);
                const float sc = rsqrtf(ssq * (1.0f / 128.0f) + 1e-6f) * 0.12751743f;
#pragma unroll
                for (int ks = 0; ks < 4; ++ks) {
                    const f32x4 g0 = *(const f32x4*)(qgn + 32 * ks + 8 * fq), g1 = *(const f32x4*)(qgn + 32 * ks + 8 * fq + 4);
                    u32x4 ow;
                    ow.x = pk2(lo16(w[ks][0]) * sc * g0[0], hi16(w[ks][0]) * sc * g0[1]); ow.y = pk2(lo16(w[ks][1]) * sc * g0[2], hi16(w[ks][1]) * sc * g0[3]);
                    ow.z = pk2(lo16(w[ks][2]) * sc * g1[0], hi16(w[ks][2]) * sc * g1[1]); ow.w = pk2(lo16(w[ks][3]) * sc * g1[2], hi16(w[ks][3]) * sc * g1[3]);
                    qf[nt][ks] = __builtin_bit_cast(bf16x8, ow);
                }
            }
            f32x4 o[8][2];
#pragma unroll
            for (int dt = 0; dt < 8; ++dt) { o[dt][0] = (f32x4){0.f, 0.f, 0.f, 0.f}; o[dt][1] = (f32x4){0.f, 0.f, 0.f, 0.f}; }
            float lsum[2] = {0.f, 0.f};
#pragma unroll 2
            for (int st = 0; st < 8; ++st) {
                const int k0 = st * 32;
                f32x4 sacc[2][2];
#pragma unroll
                for (int mt = 0; mt < 2; ++mt) {
                    sacc[mt][0] = (f32x4){0.f, 0.f, 0.f, 0.f}; sacc[mt][1] = (f32x4){0.f, 0.f, 0.f, 0.f};
#pragma unroll
                    for (int ks = 0; ks < 4; ++ks) {
                        const bf16x8 kfr = *(const LAS bf16x8*)(sK + (k0 + mt * 16 + fr) * 136 + 32 * ks + 8 * fq);
                        sacc[mt][0] = __builtin_amdgcn_mfma_f32_16x16x32_bf16(kfr, qf[0][ks], sacc[mt][0], 0, 0, 0);
                        sacc[mt][1] = __builtin_amdgcn_mfma_f32_16x16x32_bf16(kfr, qf[1][ks], sacc[mt][1], 0, 0, 0);
                    }
                }
                bf16x8 pf[2];
#pragma unroll
                for (int nt = 0; nt < 2; ++nt) {
                    float p[8];
#pragma unroll
                    for (int j = 0; j < 4; ++j) { p[j] = __builtin_amdgcn_exp2f(fminf(sacc[0][nt][j], 80.f)); p[4 + j] = __builtin_amdgcn_exp2f(fminf(sacc[1][nt][j], 80.f)); }
                    lsum[nt] += ((p[0] + p[1]) + (p[2] + p[3])) + ((p[4] + p[5]) + (p[6] + p[7]));
                    u32x4 w; w.x = pk2(p[0], p[1]); w.y = pk2(p[2], p[3]); w.z = pk2(p[4], p[5]); w.w = pk2(p[6], p[7]);
                    pf[nt] = __builtin_bit_cast(bf16x8, w);
                }
#pragma unroll
                for (int dt = 0; dt < 8; ++dt) {
                    const LAS bf16_t* vp = sV + (dt * 16 + fr) * 264 + k0 + 4 * fq;
                    const u32x2 v0 = *(const LAS u32x2*)vp, v1 = *(const LAS u32x2*)(vp + 16);
                    u32x4 w; w.x = v0.x; w.y = v0.y; w.z = v1.x; w.w = v1.y;
                    const bf16x8 vfr = __builtin_bit_cast(bf16x8, w);
                    o[dt][0] = __builtin_amdgcn_mfma_f32_16x16x32_bf16(vfr, pf[0], o[dt][0], 0, 0, 0);
                    o[dt][1] = __builtin_amdgcn_mfma_f32_16x16x32_bf16(vfr, pf[1], o[dt][1], 0, 0, 0);
                }
            }
#pragma unroll
            for (int nt = 0; nt < 2; ++nt) {
                float ls = lsum[nt]; ls += __shfl_xor(ls, 16); ls += __shfl_xor(ls, 32);
                const float inv = 1.0f / ls;
                bf16_t* op = OX + (q0 + nt * 16 + fr) * 512 + h * 128 + 4 * fq;
#pragma unroll
                for (int dt = 0; dt < 8; ++dt) { u32x2 w; w.x = pk2(o[dt][nt][0] * inv, o[dt][nt][1] * inv); w.y = pk2(o[dt][nt][2] * inv, o[dt][nt][3] * inv); *(u32x2*)(op + dt * 16) = w; }
            }
        }
    }
    __syncthreads();
}

__device__ __forceinline__ void pf_router(const PA a, int l, LAS unsigned char* lds) {
    const int tid = otid(), wave = tid >> 6, lane = tid & 63, fr = lane & 15, fq = lane >> 4;
    LAS int* s_cnt = (LAS int*)lds;
    LAS int* s_base = s_cnt + 32;
    LAS int* s_e = s_base + 32;
    LAS int* s_rk = s_e + 256;
    LAS float* s_w = (LAS float*)(s_rk + 256);
    const float* X = a.out; const float* SS = WSP(const float, WS_SS);
    const bf16_t* wrh = WSP(const bf16_t, WS_WRH) + (size_t)l * 48 * 1024; const bf16_t* wrl = WSP(const bf16_t, WS_WRL) + (size_t)l * 48 * 1024;
    const float* bg = INP(32) + l * 4; const float* br = INP(34) + l * 32;
    int* EID = WSP(int, WS_EID); float* EW = WSP(float, WS_EW); int* ERK = WSP(int, WS_ERK);
    unsigned* cnt = WSP(unsigned, WS_CTL) + CW_CNT + l * 32;
    for (int tile = oblk(); tile < T / 128; tile += ogrid()) {
        __syncthreads();
        if (tid < 32) s_cnt[tid] = 0;
        __syncthreads();
        const int t = tile * 128 + wave * 16 + fr;
        f32x4 acc[3];
#pragma unroll
        for (int mt = 0; mt < 3; ++mt) acc[mt] = (f32x4){0.f, 0.f, 0.f, 0.f};
        const float* xr = X + (size_t)t * 1024 + 8 * fq;
#pragma unroll 8
        for (int s_ = 0; s_ < 32; ++s_) {
            const f32x4 x0 = *(const f32x4*)(xr + 32 * s_), x1 = *(const f32x4*)(xr + 32 * s_ + 4);
            u32x4 hw; hw.x = pk2(x0[0], x0[1]); hw.y = pk2(x0[2], x0[3]); hw.z = pk2(x1[0], x1[1]); hw.w = pk2(x1[2], x1[3]);
            u32x4 lw; lw.x = pk2(x0[0] - lo16(hw.x), x0[1] - hi16(hw.x)); lw.y = pk2(x0[2] - lo16(hw.y), x0[3] - hi16(hw.y));
            lw.z = pk2(x1[0] - lo16(hw.z), x1[1] - hi16(hw.z)); lw.w = pk2(x1[2] - lo16(hw.w), x1[3] - hi16(hw.w));
            const bf16x8 xh = __builtin_bit_cast(bf16x8, hw), xl = __builtin_bit_cast(bf16x8, lw);
#pragma unroll
            for (int mt = 0; mt < 3; ++mt) {
                const bf16x8 wh = *(const bf16x8*)(wrh + (size_t)(mt * 16 + fr) * 1024 + 32 * s_ + 8 * fq);
                const bf16x8 wl = *(const bf16x8*)(wrl + (size_t)(mt * 16 + fr) * 1024 + 32 * s_ + 8 * fq);
                acc[mt] = __builtin_amdgcn_mfma_f32_16x16x32_bf16(wh, xh, acc[mt], 0, 0, 0);
                acc[mt] = __builtin_amdgcn_mfma_f32_16x16x32_bf16(wh, xl, acc[mt], 0, 0, 0);
                acc[mt] = __builtin_amdgcn_mfma_f32_16x16x32_bf16(wl, xh, acc[mt], 0, 0, 0);
            }
        }
        const f32x4* sp = (const f32x4*)(SS + (size_t)t * 16);
        const f32x4 s0 = sp[0], s1 = sp[1], s2 = sp[2], s3 = sp[3];
        const float tot = ((s0[0] + s0[1]) + (s0[2] + s0[3])) + ((s1[0] + s1[1]) + (s1[2] + s1[3])) + ((s2[0] + s2[1]) + (s2[2] + s2[3])) + ((s3[0] + s3[1]) + (s3[2] + s3[3]));
        const float rinv = rsqrtf(tot * (1.0f / 1024.0f) + 1e-6f);
        float lg[4], lr[8];
#pragma unroll
        for (int j = 0; j < 4; ++j) { lg[j] = acc[0][j] * rinv + bg[j]; lr[j] = acc[1][j] * rinv + br[fq * 8 + j]; lr[4 + j] = acc[2][j] * rinv + br[fq * 8 + 4 + j]; }
        float g0 = lg[0]; int gt = 0;
#pragma unroll
        for (int j = 1; j < 4; ++j) { if (lg[j] > g0) { g0 = lg[j]; gt = j; } }
        if (fq == gt) {
            float gs = 0.f;
#pragma unroll
            for (int j = 0; j < 4; ++j) gs += __expf(lg[j] - g0);
            const float ggate = 1.0f / gs;
            float l1 = -1e30f, l2 = -1e30f; int j1 = 0, j2 = 0;
#pragma unroll
            for (int j = 0; j < 8; ++j) { const float v = lr[j];
                if (v > l1) { l2 = l1; j2 = j1; l1 = v; j1 = j; } else if (v > l2) { l2 = v; j2 = j; } }
            const float e2 = __expf(l2 - l1);
            const float p1 = 1.0f / (1.0f + e2), p2 = e2 / (1.0f + e2);
            const int e1i = gt * 8 + j1, e2i = gt * 8 + j2;
            const int r1 = atomicAdd((int*)(s_cnt + e1i), 1), r2 = atomicAdd((int*)(s_cnt + e2i), 1);
            const int sl = (wave * 16 + fr) * 2;
            s_e[sl] = e1i; s_e[sl + 1] = e2i; s_rk[sl] = r1; s_rk[sl + 1] = r2; s_w[sl] = ggate * p1; s_w[sl + 1] = ggate * p2;
        }
        __syncthreads();
        if (tid < 32) s_base[tid] = (int)__hip_atomic_fetch_add(cnt + tid, (unsigned)s_cnt[tid], __ATOMIC_RELAXED, __HIP_MEMORY_SCOPE_AGENT);
        __syncthreads();
        if (tid < 256) { const int e = s_e[tid]; const size_t o = (size_t)tile * 256 + tid; EID[o] = e; EW[o] = s_w[tid]; ERK[o] = s_base[e] + s_rk[tid]; }
    }
    __syncthreads();
}

__device__ __forceinline__ void pg_gather(const PA a, int l, LAS unsigned char* lds) {
    const int tid = otid(), wave = tid >> 6, lane = tid & 63;
    LAS int* s_ps = (LAS int*)lds;
    const unsigned* cnt = WSP(const unsigned, WS_CTL) + CW_CNT + l * 32;
    int* SSLOT = WSP(int, WS_SSLOT); float* SW = WSP(float, WS_SW); int* MTE = WSP(int, WS_MTE);
    bf16_t* XS = WSP(bf16_t, WS_XS); const bf16_t* XB = WSP(const bf16_t, WS_XB);
    const float* SS = WSP(const float, WS_SS);
    const int* EID = WSP(const int, WS_EID); const float* EW = WSP(const float, WS_EW); const int* ERK = WSP(const int, WS_ERK);
    __syncthreads();
    if (tid == 0) {
        int acc = 0;
        for (int e = 0; e < 32; ++e) { s_ps[e] = acc; const int c = (int)__hip_atomic_load(cnt + e, __ATOMIC_RELAXED, __HIP_MEMORY_SCOPE_AGENT); acc += ((c + 255) >> 8) << 8; }
        s_ps[32] = acc;
    }
    __syncthreads();
    if (oblk() == 0) {
        if (tid < 32) { const int m0 = s_ps[tid] >> 8, m1 = s_ps[tid + 1] >> 8; for (int mt = m0; mt < m1; ++mt) MTE[mt] = tid; }
        if (tid == 0) MTE[511] = s_ps[32] >> 8;
        if (tid < 33) MTE[400 + tid] = s_ps[tid] >> 8;
    }
    int* STOK = WSP(int, WS_STOK); float* SRINV = WSP(float, WS_SRINV);
    for (int e = oblk(); e < 32; e += ogrid()) {
        const int c = (int)__hip_atomic_load(cnt + e, __ATOMIC_RELAXED, __HIP_MEMORY_SCOPE_AGENT);
        const int r0 = s_ps[e] + c, r1 = s_ps[e + 1];
        for (int r = r0 + tid; r < r1; r += 512) { SSLOT[r] = -1; SW[r] = 0.f; STOK[r] = 0; SRINV[r] = 0.f; }
    }
    for (int as = oblk() * 512 + tid; as < 2 * T; as += ogrid() * 512) {
        const int t = as >> 1;
        const int dest = s_ps[EID[as]] + ERK[as];
        const f32x4* sp = (const f32x4*)(SS + (size_t)t * 16);
        const f32x4 s0 = sp[0], s1 = sp[1], s2 = sp[2], s3 = sp[3];
        const float tot = ((s0[0] + s0[1]) + (s0[2] + s0[3])) + ((s1[0] + s1[1]) + (s1[2] + s1[3])) + ((s2[0] + s2[1]) + (s2[2] + s2[3])) + ((s3[0] + s3[1]) + (s3[2] + s3[3]));
        SSLOT[dest] = as; SW[dest] = EW[as]; STOK[dest] = t; SRINV[dest] = rsqrtf(tot * (1.0f / 1024.0f) + 1e-6f);
    }
}

__device__ __forceinline__ void pj_finalize(const PA a) {
    const int wave = otid() >> 6, lane = otid() & 63;
    float* X = a.out; bf16_t* XB = WSP(bf16_t, WS_XB); float* SS = WSP(float, WS_SS);
    const bf16_t* Y = WSP(const bf16_t, WS_Y);
    for (int t = oblk() * 8 + wave; t < T; t += ogrid() * 8) {
        float sq = 0.f;
#pragma unroll
        for (int i = 0; i < 4; ++i) {
            const int c = i * 256 + lane * 4;
            f32x4 v = *(const f32x4*)(X + (size_t)t * 1024 + c);
            const u32x2 y0 = *(const u32x2*)(Y + (size_t)(2 * t) * 1024 + c), y1 = *(const u32x2*)(Y + (size_t)(2 * t + 1) * 1024 + c);
            v[0] += lo16(y0.x) + lo16(y1.x); v[1] += hi16(y0.x) + hi16(y1.x); v[2] += lo16(y0.y) + lo16(y1.y); v[3] += hi16(y0.y) + hi16(y1.y);
            *(f32x4*)(X + (size_t)t * 1024 + c) = v;
            u32x2 w; w.x = pk2(v[0], v[1]); w.y = pk2(v[2], v[3]);
            *(u32x2*)(XB + (size_t)t * 1024 + c) = w;
            sq += (v[0] * v[0] + v[1] * v[1]) + (v[2] * v[2] + v[3] * v[3]);
        }
        sq = wsum(sq);
        if (lane < 16) SS[(size_t)t * 16 + lane] = (lane == 0) ? sq : 0.f;
    }
}

#define SITE static __device__ __forceinline__ void
#define OPAQUE() do { a.out = (float*)ldsin(lds, 38); a.ws = (unsigned char*)ldsin(lds, 39); } while (0)
__device__ __forceinline__ int opq(int v) { asm volatile("" : "+s"(v)); return v; }
SITE site_p0(PA a, LAS unsigned char* lds) { OPAQUE(); p0_prologue(a, lds); }
SITE site_kv(PA a, LAS unsigned char* lds) { OPAQUE();
    pg8::Gemm g{WSP(const bf16_t, WS_MEMB), WSP(const bf16_t, WS_WKV), 1024, (size_t)1024 * 1024, nullptr};
    pg8::KvOrder S{opq((int)gridDim.x), opq((int)blockIdx.x)};
    pg8::EpiScale E{WSP(bf16_t, WS_KV), 1024, WSP(const float, WS_MEMSS), MROWS - 1};
    pg8::gemm_phase<pg8::EpiScale, pg8::KvOrder>(lds, g, S, E);
}
SITE site_knorm(PA a, LAS unsigned char* lds) { OPAQUE(); p2_knorm(a, lds); }
SITE site_inproj(PA a, int l, LAS unsigned char* lds) { OPAQUE();
    pg8::Gemm g{WSP(const bf16_t, WS_XB), WSP(const bf16_t, WS_WIN) + (size_t)l * INW * 1024, 1024, 0, nullptr};
    pg8::StaticOrder S; S.init(T, INW, opq((int)gridDim.x), opq((int)blockIdx.x));
    pg8::EpiProj E{WSP(bf16_t, WS_PROJ), WSP(bf16_t, WS_VT), WSP(const float, WS_SS)};
    pg8::gemm_phase<pg8::EpiProj, pg8::StaticOrder>(lds, g, S, E);
}
SITE site_prep(PA a, int l, LAS unsigned char* lds) { OPAQUE();
    pb_prep(a, l, lds);
}
SITE site_chunks(PA a, int l, LAS unsigned char* lds) { OPAQUE(); pb2_chunks(a, l, lds); }
SITE site_mixer(PA a, int l, LAS unsigned char* lds) { OPAQUE(); pc_mixer(a, l, lds); }
SITE site_outproj(PA a, int l, LAS unsigned char* lds) { OPAQUE();
    pg8::Gemm g{WSP(const bf16_t, WS_YCAT), WSP(const bf16_t, WS_WOUT) + (size_t)l * 1024 * 1024, 1024, 0, nullptr};
    pg8::StaticOrder S; S.init(T, 1024, opq((int)gridDim.x), opq((int)blockIdx.x));
    pg8::EpiRes E{a.out, WSP(bf16_t, WS_XB), WSP(float, WS_SS)};
    pg8::gemm_phase<pg8::EpiRes, pg8::StaticOrder>(lds, g, S, E);
}
SITE site_xq(PA a, int l, LAS unsigned char* lds) { OPAQUE();
    pg8::Gemm g{WSP(const bf16_t, WS_XB), WSP(const bf16_t, WS_WQ) + (size_t)l * 512 * 1024, 1024, 0, nullptr};
    pg8::StaticOrder S; S.init(T, 512, opq((int)gridDim.x), opq((int)blockIdx.x));
    pg8::EpiScale E{WSP(bf16_t, WS_QX), 512, WSP(const float, WS_SS), T - 1};
    pg8::gemm_phase<pg8::EpiScale, pg8::StaticOrder>(lds, g, S, E);
}
SITE site_xattn(PA a, int l, LAS unsigned char* lds) { OPAQUE(); pe2_xattn(a, l, lds); }
SITE site_xo(PA a, int l, LAS unsigned char* lds) { OPAQUE();
    pg8::Gemm g{WSP(const bf16_t, WS_OX), WSP(const bf16_t, WS_WO) + (size_t)l * 1024 * 512, 512, 0, nullptr};
    pg8::StaticOrder S; S.init(T, 1024, opq((int)gridDim.x), opq((int)blockIdx.x));
    pg8::EpiRes E{a.out, WSP(bf16_t, WS_XB), WSP(float, WS_SS)};
    pg8::gemm_phase<pg8::EpiRes, pg8::StaticOrder>(lds, g, S, E);
}
SITE site_router(PA a, int l, LAS unsigned char* lds) { OPAQUE(); pf_router(a, l, lds); }
SITE site_gather(PA a, int l, LAS unsigned char* lds) { OPAQUE(); pg_gather(a, l, lds); }
SITE site_gu(PA a, LAS unsigned char* lds) { OPAQUE();
    pg8::Gemm g{WSP(const bf16_t, WS_XB), WSP(const bf16_t, WS_WGU), 1024, (size_t)1024 * 1024, WSP(const int, WS_STOK)};
    pg8::MoeOrder S{WSP(const int, WS_MTE), opq((int)gridDim.x), opq((int)blockIdx.x)};
    pg8::EpiGU E{WSP(bf16_t, WS_HB), WSP(const float, WS_SRINV)};
    pg8::gemm_phase<pg8::EpiGU, pg8::MoeOrder, true, true>(lds, g, S, E);
}
SITE site_down(PA a, LAS unsigned char* lds) { OPAQUE();
    pg8::Gemm g{WSP(const bf16_t, WS_HB), WSP(const bf16_t, WS_WD), 512, (size_t)1024 * 512, nullptr};
    pg8::MoeOrder S{WSP(const int, WS_MTE), opq((int)gridDim.x), opq((int)blockIdx.x)};
    pg8::EpiDown E{WSP(bf16_t, WS_Y), WSP(const int, WS_SSLOT), WSP(const float, WS_SW)};
    pg8::gemm_phase<pg8::EpiDown, pg8::MoeOrder>(lds, g, S, E);
}
SITE site_final(PA a, LAS unsigned char* lds) { OPAQUE(); pj_finalize(a); }

__global__ void __launch_bounds__(512, 2) mk_fwd(Args args) {
    extern __shared__ __attribute__((aligned(16))) unsigned char lds_raw[];
    LAS unsigned char* lds = (LAS unsigned char*)lds_raw;
    const int tid = threadIdx.x;
    const int lo = args.ph_lo, hi = args.ph_hi;
    PA a; a.out = args.out; a.ws = args.ws;
    if (tid < 16) ((LAS unsigned*)(lds + LDS_MISC))[tid] = 0u;
    if (tid == 64) {
        LAS unsigned long long* tab = (LAS unsigned long long*)(lds + LDS_INTAB);
#pragma unroll
        for (int i = 0; i < 38; ++i) tab[i] = (unsigned long long)args.in[i];
        tab[38] = (unsigned long long)args.out; tab[39] = (unsigned long long)args.ws;
    }
    __syncthreads();
    XcdBarrier bar; bar.bar = WSP(unsigned, WS_CTL) + CW_BAR; bar.x = 0; bar.st = nullptr;
    if (!MK_PER_PHASE) bar = xcd_barrier_post(WSP(unsigned, WS_CTL) + CW_BAR, (volatile LAS unsigned*)(lds + LDS_MISC));
#define IN(k) (lo <= (k) && (k) < hi)
#define GRID_BAR() do { if (!MK_PER_PHASE) xcd_barrier(bar); } while (0)
#ifdef PROBE_MASK
    unsigned long long pr_acc = 0ull, pr_t0 = 0ull; const unsigned long long pr_start = wall_clock64();
#define PR0() do { pr_t0 = wall_clock64(); } while (0)
#define PR1(p) do { if ((PROBE_MASK >> (p)) & 1) pr_acc += wall_clock64() - pr_t0; } while (0)
#else
#define PR0() do { } while (0)
#define PR1(p) do { } while (0)
#endif
    PR0(); if (IN(0)) { site_p0(a, lds); GRID_BAR(); } PR1(12);
    PR0(); if (IN(1)) { site_kv(a, lds); GRID_BAR(); } PR1(13);
    PR0(); if (IN(2)) { site_knorm(a, lds); GRID_BAR(); } PR1(14);
    for (int l = 0; l < NL; ++l) {
        const int pb = 3 + 12 * l;
        PR0(); if (IN(pb + 0)) { site_inproj(a, l, lds); GRID_BAR(); } PR1(0);
        PR0(); if (IN(pb + 1)) { site_prep(a, l, lds); GRID_BAR(); } PR1(1);
        PR0(); if (IN(pb + 2)) { site_mixer(a, l, lds); GRID_BAR(); } PR1(2);
        PR0(); if (IN(pb + 3)) { site_outproj(a, l, lds); GRID_BAR(); } PR1(3);
        PR0(); if (IN(pb + 4)) { site_xq(a, l, lds); GRID_BAR(); } PR1(4);
        PR0(); if (IN(pb + 5)) { site_xattn(a, l, lds); GRID_BAR(); } PR1(5);
        PR0(); if (IN(pb + 6)) { site_xo(a, l, lds); GRID_BAR(); } PR1(6);
        PR0(); if (IN(pb + 7)) { site_router(a, l, lds); GRID_BAR(); } PR1(7);
        PR0(); if (IN(pb + 8)) { site_gather(a, l, lds); GRID_BAR(); } PR1(8);
        PR0(); if (IN(pb + 9)) { site_gu(a, lds); GRID_BAR(); } PR1(9);
        PR0(); if (IN(pb + 10)) { site_down(a, lds); GRID_BAR(); } PR1(10);
#ifdef PROBE_MASK
        PR0(); if (IN(pb + 11)) { site_final(a, lds); GRID_BAR(); } PR1(11);
#else
        if (IN(pb + 11)) { site_final(a, lds); if (l + 1 < NL) GRID_BAR(); }
#endif
    }
#ifdef PROBE_MASK
    {
        unsigned long long* pw = (unsigned long long*)(WSP(unsigned, WS_CTL) + 8192);
        if (blockIdx.x == 0 && tid == 0) __hip_atomic_store(pw, pr_acc, __ATOMIC_RELAXED, __HIP_MEMORY_SCOPE_AGENT);
        GRID_BAR();
        const unsigned long long tgt = 1600000ull + __hip_atomic_load(pw, __ATOMIC_RELAXED, __HIP_MEMORY_SCOPE_AGENT) * (unsigned long long)PROBE_MULT;
        while (wall_clock64() - pr_start < tgt) __builtin_amdgcn_s_sleep(16);
    }
#endif
#undef IN
#undef GRID_BAR
}

extern "C" void kernel_launch(void* const* d_in, const int* in_sizes, int n_in, void* d_out, int out_size, void* d_ws, size_t ws_size, hipStream_t stream) {
    static int grid = 0;
    if (grid == 0) {
        if (n_in != 38 || out_size != T * D || ws_size < WS_END) { fprintf(stderr, "kernel_launch: unexpected shapes (n_in %d out %d ws %zu need %zu)\n", n_in, out_size, ws_size, (size_t)WS_END); grid = -1; return; }
        int dev = 0, cus = 0, per_cu = 0;
        if (hipGetDevice(&dev) != hipSuccess || hipDeviceGetAttribute(&cus, hipDeviceAttributeMultiprocessorCount, dev) != hipSuccess) { grid = -1; return; }
        if (hipFuncSetAttribute((const void*)mk_fwd, hipFuncAttributeMaxDynamicSharedMemorySize, LDS_BYTES) != hipSuccess) { fprintf(stderr, "kernel_launch: hipFuncSetAttribute failed\n"); grid = -1; return; }
        if (hipOccupancyMaxActiveBlocksPerMultiprocessor(&per_cu, (const void*)mk_fwd, 512, LDS_BYTES) != hipSuccess || per_cu < 1) { fprintf(stderr, "kernel_launch: occupancy query says %d\n", per_cu); }
        (void)hipGetLastError();
        grid = cus;
    }
    if (grid < 0) return;
    (void)hipMemsetAsync((char*)d_ws + WS_CTL, 0, CTL_BYTES, stream);
    Args a{};
    for (int i = 0; i < 38; ++i) a.in[i] = (const float*)d_in[i];
    a.out = (float*)d_out; a.ws = (unsigned char*)d_ws;
#if MK_PER_PHASE
    for (int p = 0; p < NPH; ++p) { a.ph_lo = p; a.ph_hi = p + 1; hipLaunchKernelGGL(mk_fwd, dim3(grid), dim3(512), LDS_BYTES, stream, a); }
#else
    a.ph_lo = 0; a.ph_hi = NPH;
    hipLaunchKernelGGL(mk_fwd, dim3(grid), dim3(512), LDS_BYTES, stream, a);
#endif
}
```

```cpp
#include <hip/hip_runtime.h>
#include <cstdio>
#include <cstdint>

#ifndef MK_PER_PHASE
#define MK_PER_PHASE 0
#endif

#define LAS __attribute__((address_space(3)))
typedef unsigned short bf16_t;
typedef short bf16x8 __attribute__((ext_vector_type(8)));
typedef float f32x4 __attribute__((ext_vector_type(4)));
typedef unsigned u32x4 __attribute__((ext_vector_type(4)));
typedef unsigned u32x2 __attribute__((ext_vector_type(2)));

constexpr int T = 32768, D = 1024, SEQ = 2048, NL = 4;
constexpr int INW = 3328;
constexpr int MROWS = 4096;
constexpr int MAXROWS = 73728, MAXMT = 288;
constexpr int NPH = 3 + 12 * NL;

constexpr size_t WS_CTL   = 0;
constexpr size_t CTL_BYTES = 65536;
constexpr size_t WS_WIN   = WS_CTL + CTL_BYTES;
constexpr size_t WS_WOUT  = WS_WIN  + (size_t)4 * 3328 * 1024 * 2;
constexpr size_t WS_WQ    = WS_WOUT + (size_t)4 * 1024 * 1024 * 2;
constexpr size_t WS_WKV   = WS_WQ   + (size_t)4 * 512 * 1024 * 2;
constexpr size_t WS_WO    = WS_WKV  + (size_t)4 * 1024 * 1024 * 2;
constexpr size_t WS_WGU   = WS_WO   + (size_t)4 * 1024 * 512 * 2;
constexpr size_t WS_WD    = WS_WGU  + (size_t)32 * 1024 * 1024 * 2;
constexpr size_t WS_KV    = WS_WD   + (size_t)32 * 1024 * 512 * 2;
constexpr size_t WS_MEMB  = WS_KV   + (size_t)4 * 4096 * 1024 * 2;
constexpr size_t WS_MEMSS = WS_MEMB + (size_t)4096 * 1024 * 2;
constexpr size_t WS_VTX   = WS_MEMSS + (size_t)4096 * 16 * 4;
constexpr size_t WS_WRH   = WS_VTX  + (size_t)4 * 4096 * 512 * 2;
constexpr size_t WS_WRL   = WS_WRH  + (size_t)4 * 48 * 1024 * 2;
constexpr size_t WS_PBI   = WS_WRL  + (size_t)4 * 48 * 1024 * 2;
constexpr int PBI_BYTES = 122880;
constexpr size_t WS_XB    = WS_PBI  + (size_t)16 * PBI_BYTES;
constexpr size_t WS_SS    = WS_XB   + (size_t)T * 1024 * 2;
constexpr size_t WS_VF    = WS_SS   + (size_t)T * 16 * 4;
constexpr size_t WS_EID   = WS_VF   + (size_t)T * 512 * 2;
constexpr size_t WS_EW    = WS_EID  + (size_t)T * 2 * 4;
constexpr size_t WS_ERK   = WS_EW   + (size_t)T * 2 * 4;
constexpr size_t WS_SSLOT = WS_ERK  + (size_t)T * 2 * 4;
constexpr size_t WS_SW    = WS_SSLOT + (size_t)MAXROWS * 4;
constexpr size_t WS_MTE   = WS_SW   + (size_t)MAXROWS * 4;
constexpr size_t WS_STOK  = WS_MTE  + 2048;
constexpr size_t WS_SRINV = WS_STOK + (size_t)MAXROWS * 4;
constexpr size_t WS_U     = WS_SRINV + (size_t)MAXROWS * 4;
constexpr size_t WS_PROJ  = WS_U;
constexpr size_t WS_SR    = WS_PROJ + (size_t)T * 3328 * 2;
constexpr size_t WS_SK    = WS_SR   + (size_t)T * 512 * 2;
constexpr size_t WS_SV    = WS_SK   + (size_t)T * 512 * 2;
constexpr size_t WS_SA    = WS_SV   + (size_t)T * 512 * 2;
constexpr size_t WS_SB    = WS_SA   + (size_t)T * 512 * 2;
constexpr size_t WS_SG    = WS_SB   + (size_t)T * 512 * 2;
constexpr size_t WS_SWD   = WS_SG   + (size_t)T * 512 * 2;
constexpr size_t WS_YCAT  = WS_SWD  + (size_t)T * 512 * 4;
constexpr size_t WS_VT    = WS_YCAT + (size_t)T * 1024 * 2;
constexpr int NCHUNK = 16 * 8 * 128;
constexpr size_t WS_BTT   = WS_VT   + (size_t)T * 512 * 2;
constexpr size_t WS_KTT   = WS_BTT  + (size_t)NCHUNK * 2048;
constexpr size_t WS_VST   = WS_KTT  + (size_t)NCHUNK * 2048;
constexpr size_t WS_NKA   = WS_VST  + (size_t)NCHUNK * 2048;
constexpr size_t WS_NBR   = WS_NKA  + (size_t)NCHUNK * 512;
constexpr size_t WS_NKR   = WS_NBR  + (size_t)NCHUNK * 512;
constexpr size_t WS_TMT   = WS_NKR  + (size_t)NCHUNK * 512;
constexpr size_t WS_PCK   = WS_TMT  + (size_t)NCHUNK * 512;
constexpr size_t WS_BS    = WS_PCK  + (size_t)NCHUNK * 256;
constexpr size_t WS_UEND1 = WS_BS   + (size_t)T * 8 * 4;
constexpr size_t WS_QX    = WS_U;
constexpr size_t WS_OX    = WS_QX   + (size_t)T * 512 * 2;
constexpr size_t WS_XS    = WS_U;
constexpr size_t WS_HB    = WS_XS   + (size_t)MAXROWS * 1024 * 2;
constexpr size_t WS_Y     = WS_HB   + (size_t)MAXROWS * 512 * 2;
constexpr size_t WS_UEND2 = WS_Y    + (size_t)2 * T * 1024 * 2;
constexpr size_t WS_END   = WS_UEND1 > WS_UEND2 ? WS_UEND1 : WS_UEND2;

constexpr int CW_BAR = 0;
constexpr int CW_CNT = 4096;
constexpr int CW_QUEUE = 4096 + 256;

constexpr int LDS_MISC = 139264;
constexpr int LDS_BYTES = LDS_MISC + 16384;

struct Args { const float* in[38]; float* out; unsigned char* ws; int ph_lo, ph_hi; };
struct PA { float* out; unsigned char* ws; };

__device__ __forceinline__ float bf2f(bf16_t b) { return __uint_as_float(((unsigned)b) << 16); }
__device__ __forceinline__ bf16_t f2bf(float f) { unsigned u = __float_as_uint(f); u += 0x7FFFu + ((u >> 16) & 1u); return (bf16_t)(u >> 16); }
typedef __bf16 bf16v2 __attribute__((ext_vector_type(2)));
typedef float f32x2 __attribute__((ext_vector_type(2)));
__device__ __forceinline__ unsigned pk2(float lo, float hi) { f32x2 v = {lo, hi}; bf16v2 b = __builtin_convertvector(v, bf16v2); return __builtin_bit_cast(unsigned, b); }
__device__ __forceinline__ float lo16(unsigned u) { return __uint_as_float(u << 16); }
__device__ __forceinline__ float hi16(unsigned u) { return __uint_as_float(u & 0xffff0000u); }
__device__ __forceinline__ float wsum(float v) {
#pragma unroll
    for (int o = 32; o; o >>= 1) v += __shfl_xor(v, o);
    return v;
}
__device__ __forceinline__ float sigmoidf_(float x) { return 1.0f / (1.0f + __expf(-x)); }

#define XB_TMO      128
#define XB_XCNT(j)  (256  + 64 * (j))
#define XB_XSUB(j)  (1280 + 64 * (j))
#define XB_XGEN(j)  (2304 + 64 * (j))
#define XB_TOP      3328
#define XB_TOPGEN   3392
#define XCD_BAR_WORDS 3456
#define XB_SPIN_CAP (1u << 22)

__device__ __forceinline__ unsigned xb_ld(unsigned* p)              { return __hip_atomic_load(p, __ATOMIC_RELAXED, __HIP_MEMORY_SCOPE_AGENT); }
__device__ __forceinline__ unsigned xb_add(unsigned* p, unsigned v) { return __hip_atomic_fetch_add(p, v, __ATOMIC_RELAXED, __HIP_MEMORY_SCOPE_AGENT); }
__device__ __forceinline__ unsigned xb_xcc_id() { return (unsigned)__builtin_amdgcn_s_getreg((3 << 11) | 20) & 0xFu; }
#define XB_SPIN(cond, bar) do { unsigned _sp = 0; while (cond) { __builtin_amdgcn_s_sleep(1); \
    if ((++_sp & 255u) == 0u) { if (xb_ld(&(bar)[XB_TMO])) break; if (_sp > XB_SPIN_CAP) { atomicAdd(&(bar)[XB_TMO], 1u); break; } } } } while (0)

struct XcdBarrier { unsigned* bar; unsigned x; volatile LAS unsigned* st; };

__device__ __forceinline__ XcdBarrier xcd_barrier_post(unsigned* bar, volatile LAS unsigned* st) {
    XcdBarrier b; b.bar = bar; b.x = xb_xcc_id(); b.st = st;
    if (threadIdx.x == 0) (void)xb_add(&bar[XB_XCNT(b.x)], 1u);
    return b;
}
__device__ __forceinline__ void xcd_barrier_complete(unsigned* bar, unsigned x, unsigned& nloc, unsigned& nx) {
    const unsigned G = gridDim.x * gridDim.y * gridDim.z;
    unsigned sum, cnt, mine, sp = 0u;
    for (;;) {
        sum = 0u; cnt = 0u; mine = 0u;
#pragma unroll
        for (unsigned j = 0; j < 16; ++j) { const unsigned c = xb_ld(&bar[XB_XCNT(j)]); sum += c; cnt += (c > 0u) ? 1u : 0u; mine = (j == x) ? c : mine; }
        if (sum == G) break;
        __builtin_amdgcn_s_sleep(1);
        if ((++sp & 255u) == 0u) { if (xb_ld(&bar[XB_TMO])) break; if (sp > XB_SPIN_CAP) { atomicAdd(&bar[XB_TMO], 1u); break; } }
    }
    nloc = mine > 0u ? mine : 1u; nx = cnt > 0u ? cnt : 1u;
}
__device__ __forceinline__ void xcd_barrier(const XcdBarrier& b) {
    asm volatile("s_waitcnt vmcnt(0)" ::: "memory");
    __syncthreads();
    if (threadIdx.x == 0) {
        unsigned* bar = b.bar;
        __builtin_amdgcn_s_waitcnt(0);
        unsigned nloc = b.st[0], nx = b.st[1];
        if (nloc == 0u) { xcd_barrier_complete(bar, b.x, nloc, nx); b.st[0] = nloc; b.st[1] = nx; }
        const unsigned old = xb_add(&bar[XB_XSUB(b.x)], 1u);
        const unsigned gen = old / nloc;
        if (old + 1u == (gen + 1u) * nloc) {
            __builtin_amdgcn_fence(__ATOMIC_RELEASE, "agent");
            asm volatile("s_waitcnt vmcnt(0)" ::: "memory");
            const unsigned og = xb_add(&bar[XB_TOP], 1u);
            const unsigned tg = og / nx;
            if (og + 1u == (tg + 1u) * nx) xb_add(&bar[XB_TOPGEN], 1u);
            else XB_SPIN(xb_ld(&bar[XB_TOPGEN]) == tg, bar);
            __builtin_amdgcn_fence(__ATOMIC_ACQUIRE, "agent");
            xb_add(&bar[XB_XGEN(b.x)], 1u);
            asm volatile("s_waitcnt vmcnt(0)" ::: "memory");
        } else {
            XB_SPIN(xb_ld(&bar[XB_XGEN(b.x)]) == gen, bar);
            __builtin_amdgcn_fence(__ATOMIC_ACQUIRE, "agent");
            asm volatile("s_waitcnt vmcnt(0)" ::: "memory");
        }
    }
    __syncthreads();
}

namespace pg8 {
constexpr int BM = 256, BK = 64, HALF = 128, HTB = HALF * BK * 2, STAGE_BYTES = 8 * HTB, NXCD = 8, WGM = 8;
__host__ __device__ __forceinline__ int lds_byte(int r, int c) { const int st = (r >> 4) * 2 + (c >> 5), rr = r & 15, cc = c & 31, ob = rr * 64 + cc * 2; return st * 1024 + (ob ^ (((ob >> 9) & 1) << 5)); }
__host__ __device__ __forceinline__ void stage_rc(int b, int& R, int& C) { const int st = b / 1024, sb = b % 1024, swz = sb ^ (((sb >> 9) & 1) << 5); R = (st >> 1) * 16 + swz / 64; C = (st & 1) * 32 + (swz % 64) / 2; }
__host__ __device__ __forceinline__ int perm32(int rho) { const int n = rho >> 4, i = rho & 15; return 8 * (i >> 2) + 4 * n + (i & 3); }

struct Unit { int pm, pn, pa, z; };
struct Gemm { const bf16_t* A; const bf16_t* Bt; int K; size_t bz_stride; const int* rowidx; };

struct StaticOrder {
    int nM, nN, nwg, G, c;
    __device__ void init(int M, int N, int G_, int c_) { nM = M / BM; nN = N / BM; nwg = nM * nN; G = G_; c = c_; }
    __device__ bool next(int i, Unit& u) const {
        const long L = (long)i * G + c; if (L >= nwg) return false;
        int wgid = (int)L; { const int q = nwg / NXCD, r = nwg % NXCD, xcd = wgid % NXCD, off = wgid / NXCD; wgid = (xcd < r ? xcd * (q + 1) : r * (q + 1) + (xcd - r) * q) + off; }
        const int nig = WGM * nN, gid = wgid / nig, fm = gid * WGM, gsz = (nM - fm) < WGM ? (nM - fm) : WGM;
        u.pm = fm + ((wgid % nig) % gsz); u.pn = (wgid % nig) / gsz; u.pa = u.pm; u.z = 0; return true;
    }
};
struct KvOrder {
    int G, c;
    __device__ bool next(int i, Unit& u) const {
        const int L = i * G + c; if (L >= 256) return false;
        u.z = L >> 6; const int r = L & 63; u.pa = r >> 2; u.pn = r & 3; u.pm = u.z * 16 + u.pa; return true;
    }
};
struct MoeOrder {
    const int* mte; int G, c;
    __device__ bool next(int i, Unit& u) const {
        if ((G & 7) != 0) {
            const int nunits = mte[511] * 4;
            const int L = i * G + c; if (L >= nunits) return false;
            u.pm = L >> 2; u.pa = u.pm; u.pn = L & 3; u.z = mte[u.pm]; return true;
        }
        const int x = c & 7; int q = i * (G >> 3) + (c >> 3);
#pragma unroll
        for (int k = 0; k < 4; ++k) {
            const int e = x + 8 * k; const int m0 = mte[400 + e], m1 = mte[401 + e]; const int n = (m1 - m0) * 4;
            if (q < n) { u.pm = m0 + (q >> 2); u.pa = u.pm; u.pn = q & 3; u.z = e; return true; }
            q -= n;
        }
        return false;
    }
};

template <class Epi, class Sched, bool ALIGN_EPI = true, bool GATHER = false>
__device__ __forceinline__ void gemm_phase(LAS unsigned char* lds, const Gemm g, const Sched& S, const Epi& E) {
    int tid_ = threadIdx.x; asm volatile("" : "+v"(tid_));
    const int tid = tid_, wid = __builtin_amdgcn_readfirstlane(tid >> 6), lane = tid & 63, wr = wid >> 2, wc = wid & 3, fr = lane & 15, fq = lane >> 4;
    const int K = g.K, nt = K / BK;
    unsigned voffA[2], voffB[2], gcol[2]; int grow[2];
#pragma unroll
    for (int i = 0; i < 2; ++i) { int R, C; stage_rc(tid * 16 + i * 8192, R, C); const int Rb = ((R & ~31) + perm32(R & 31));
        voffA[i] = (unsigned)(R * K + C) * 2u; voffB[i] = (unsigned)(Rb * K + C) * 2u; grow[i] = R; gcol[i] = (unsigned)C * 2u; }
    const size_t kstep = (size_t)(BK * 2);
    const size_t hstep = (size_t)HALF * K * 2;
    const size_t tstep = 2 * hstep;
    const unsigned ldsw = (unsigned)wid * 1024u;
    const int aoff = lds_byte(wr * 64 + fr, fq * 8), boff = lds_byte(wc * 32 + fr, fq * 8);
#define PG8_SA(b, h) (((b) * 2 + (h)) * HTB)
#define PG8_SB(b, h) ((4 + (b) * 2 + (h)) * HTB)
#define PG8_STAGE(bufoff, gbase, voff) do { _Pragma("unroll") for (int _i = 0; _i < 2; ++_i) \
        __builtin_amdgcn_global_load_lds((const unsigned*)((const char*)(gbase) + (voff)[_i]), (LAS unsigned*)(lds + (bufoff) + ldsw + _i * 8192), 16, 0, 0); } while (0)
#define PG8_LDA(dst, b, h) do { _Pragma("unroll") for (int m = 0; m < 4; ++m) _Pragma("unroll") for (int k = 0; k < 2; ++k) dst[m][k] = *(const LAS bf16x8*)(lds + PG8_SA(b, h) + aoff + m * 2048 + k * 1024); } while (0)
#define PG8_LDB(dst, b, h) do { _Pragma("unroll") for (int n = 0; n < 2; ++n) _Pragma("unroll") for (int k = 0; k < 2; ++k) dst[n][k] = *(const LAS bf16x8*)(lds + PG8_SB(b, h) + boff + n * 2048 + k * 1024); } while (0)
#define PG8_MMA(ai, bj, At, Bt) do { __builtin_amdgcn_s_setprio(1); _Pragma("unroll") for (int m = 0; m < 4; ++m) _Pragma("unroll") for (int n = 0; n < 2; ++n) _Pragma("unroll") for (int k = 0; k < 2; ++k) \
        acc[ai][bj][m][n] = __builtin_amdgcn_mfma_f32_16x16x32_bf16(Bt[n][k], At[m][k], acc[ai][bj][m][n], 0, 0, 0); __builtin_amdgcn_s_setprio(0); } while (0)
#define PG8_WAIT_V(n) asm volatile("s_waitcnt vmcnt(" #n ")" ::: "memory")
#define PG8_WAIT_L(n) asm volatile("s_waitcnt lgkmcnt(" #n ")" ::: "memory")
#define PG8_BAR __builtin_amdgcn_s_barrier()
#define PG8_SCHED __builtin_amdgcn_sched_barrier(0)
#define PG8_APTR(u) ((const char*)g.A + (size_t)(u).pa * tstep)
#define PG8_BPTR(u) ((const char*)g.Bt + ((size_t)(u).z * g.bz_stride) * 2 + (size_t)(u).pn * tstep)
    Unit cur, nxt; int ui = 0;
    if (!S.next(0, cur)) return;
    f32x4 acc[2][2][4][2];
#pragma unroll
    for (int a = 0; a < 2; ++a)
#pragma unroll
        for (int b = 0; b < 2; ++b)
#pragma unroll
            for (int m = 0; m < 4; ++m)
#pragma unroll
                for (int n = 0; n < 2; ++n) acc[a][b][m][n] = (f32x4){0.f, 0.f, 0.f, 0.f};
    bf16x8 At[4][2], B0[2][2], B1[2][2];
    const char* cA = GATHER ? (const char*)g.A : PG8_APTR(cur); const char* cB = PG8_BPTR(cur);
    unsigned gcu[2][2] = {{0u, 0u}, {0u, 0u}}, gnx[2][2] = {{0u, 0u}, {0u, 0u}};
#define PG8_GOFF(dst, u) do { _Pragma("unroll") for (int h_ = 0; h_ < 2; ++h_) _Pragma("unroll") for (int i_ = 0; i_ < 2; ++i_) \
        dst[h_][i_] = (unsigned)g.rowidx[(u).pa * 256 + h_ * 128 + grow[i_]] * (unsigned)(K * 2) + gcol[i_]; } while (0)
    if constexpr (GATHER) PG8_GOFF(gcu, cur);
#define PG8_STAGE_A(bufoff, h_, nonGatherPtr, gatherBase, GO) do { if constexpr (GATHER) { PG8_STAGE(bufoff, gatherBase, GO[h_]); } else { PG8_STAGE(bufoff, nonGatherPtr, voffA); } } while (0)
    PG8_STAGE(PG8_SB(0, 0), cB, voffB); PG8_STAGE(PG8_SB(0, 1), cB + hstep, voffB); PG8_STAGE_A(PG8_SA(0, 0), 0, cA, cA, gcu); PG8_STAGE_A(PG8_SA(0, 1), 1, cA + hstep, cA, gcu);
    if (wr == 1) PG8_BAR;
    PG8_WAIT_V(2); PG8_BAR;
    PG8_STAGE(PG8_SB(1, 0), cB + kstep, voffB); PG8_STAGE_A(PG8_SA(1, 0), 0, cA + kstep, cA + kstep, gcu); PG8_STAGE(PG8_SB(1, 1), cB + hstep + kstep, voffB);
    PG8_WAIT_V(6); PG8_BAR;
    for (;;) {
        const bool has_next = S.next(ui + 1, nxt);
        const char* nA = GATHER ? cA : (has_next ? PG8_APTR(nxt) : cA); const char* nB = has_next ? PG8_BPTR(nxt) : cB;
        if constexpr (GATHER) { if (has_next) PG8_GOFF(gnx, nxt); else { _Pragma("unroll") for (int h_ = 0; h_ < 2; ++h_) _Pragma("unroll") for (int i_ = 0; i_ < 2; ++i_) gnx[h_][i_] = gcu[h_][i_]; } }
        for (int t = 0; t < nt; t += 2) {
            const bool last = (t == nt - 2);
            const char* a1 = cA + (size_t)(t + 1) * kstep;
            const char* a2 = last ? nA : cA + (size_t)(t + 2) * kstep; const char* b2 = last ? nB : cB + (size_t)(t + 2) * kstep;
            const char* a3 = a2 + kstep; const char* b3 = b2 + kstep;
            unsigned gse[2][2];
            _Pragma("unroll") for (int h_ = 0; h_ < 2; ++h_) _Pragma("unroll") for (int i_ = 0; i_ < 2; ++i_) gse[h_][i_] = last ? gnx[h_][i_] : gcu[h_][i_];
            PG8_LDB(B0, 0, 0); PG8_LDB(B1, 0, 1); PG8_SCHED; PG8_LDA(At, 0, 0); PG8_STAGE_A(PG8_SA(1, 1), 1, a1 + hstep, a1, gcu);
            PG8_WAIT_V(8); PG8_WAIT_L(0); PG8_BAR; PG8_MMA(0, 0, At, B0); PG8_MMA(0, 1, At, B1); PG8_BAR; PG8_SCHED;
            PG8_LDA(At, 0, 1); PG8_STAGE(PG8_SB(0, 0), b2, voffB); PG8_STAGE(PG8_SB(0, 1), b2 + hstep, voffB); PG8_STAGE_A(PG8_SA(0, 0), 0, a2, a2, gse);
            PG8_WAIT_V(8); PG8_WAIT_L(0); PG8_BAR; PG8_MMA(1, 0, At, B0); PG8_MMA(1, 1, At, B1); PG8_BAR; PG8_SCHED;
            PG8_LDB(B0, 1, 0); PG8_LDB(B1, 1, 1); PG8_SCHED; PG8_LDA(At, 1, 0); PG8_STAGE_A(PG8_SA(0, 1), 1, a2 + hstep, a2, gse);
            PG8_WAIT_V(8); PG8_WAIT_L(0); PG8_BAR; PG8_MMA(0, 0, At, B0); PG8_MMA(0, 1, At, B1); PG8_BAR; PG8_SCHED;
            PG8_LDA(At, 1, 1); PG8_STAGE(PG8_SB(1, 0), b3, voffB); PG8_STAGE(PG8_SB(1, 1), b3 + hstep, voffB); PG8_STAGE_A(PG8_SA(1, 0), 0, a3, a3, gse);
            PG8_WAIT_V(8); PG8_WAIT_L(0); PG8_BAR; PG8_MMA(1, 0, At, B0); PG8_MMA(1, 1, At, B1); PG8_BAR; PG8_SCHED;
        }
        if constexpr (ALIGN_EPI) { if (wr == 0) PG8_BAR; }
        E(acc, cur, wr, wc, fr, fq);
        if (!has_next) break;
#pragma unroll
        for (int a = 0; a < 2; ++a)
#pragma unroll
            for (int b = 0; b < 2; ++b)
#pragma unroll
                for (int m = 0; m < 4; ++m)
#pragma unroll
                    for (int n = 0; n < 2; ++n) acc[a][b][m][n] = (f32x4){0.f, 0.f, 0.f, 0.f};
        cur = nxt; cA = nA; cB = nB; ++ui;
        if constexpr (GATHER) { _Pragma("unroll") for (int h_ = 0; h_ < 2; ++h_) _Pragma("unroll") for (int i_ = 0; i_ < 2; ++i_) gcu[h_][i_] = gnx[h_][i_]; }
        if constexpr (ALIGN_EPI) { if (wr == 1) PG8_BAR; }
    }
    PG8_WAIT_V(0);
    if constexpr (!ALIGN_EPI) { if (wr == 0) PG8_BAR; }
    PG8_BAR;
#undef PG8_SA
#undef PG8_SB
#undef PG8_STAGE
#undef PG8_LDA
#undef PG8_LDB
#undef PG8_MMA
#undef PG8_WAIT_V
#undef PG8_WAIT_L
#undef PG8_BAR
#undef PG8_SCHED
#undef PG8_APTR
#undef PG8_BPTR
#undef PG8_GOFF
#undef PG8_STAGE_A
}

typedef const f32x4 (&AccRef)[2][2][4][2];

struct EpiScale {
    bf16_t* O; int ldc; const float* ss; int ssmask;
    __device__ __forceinline__ void operator()(AccRef acc, const Unit& u, int wr, int wc, int fr, int fq) const {
#pragma unroll
        for (int ai = 0; ai < 2; ++ai)
#pragma unroll
            for (int m = 0; m < 4; ++m) {
                const int row = u.pm * 256 + ai * 128 + wr * 64 + m * 16 + fr;
                const f32x4* sp = (const f32x4*)(ss + (size_t)(row & ssmask) * 16);
                const f32x4 s0 = sp[0], s1 = sp[1], s2 = sp[2], s3 = sp[3];
                const float tot = ((s0[0] + s0[1]) + (s0[2] + s0[3])) + ((s1[0] + s1[1]) + (s1[2] + s1[3])) + ((s2[0] + s2[1]) + (s2[2] + s2[3])) + ((s3[0] + s3[1]) + (s3[2] + s3[3]));
                const float rinv = rsqrtf(tot * (1.0f / 1024.0f) + 1e-6f);
#pragma unroll
                for (int bj = 0; bj < 2; ++bj) {
                    const int col = u.pn * 256 + bj * 128 + wc * 32 + 8 * fq;
                    const f32x4 v0 = acc[ai][bj][m][0] * rinv, v1 = acc[ai][bj][m][1] * rinv;
                    u32x4 w; w.x = pk2(v0[0], v0[1]); w.y = pk2(v0[2], v0[3]); w.z = pk2(v1[0], v1[1]); w.w = pk2(v1[2], v1[3]);
                    *(u32x4*)(O + (size_t)row * ldc + col) = w;
                }
            }
    }
};
struct EpiProj {
    bf16_t* O; bf16_t* VT; const float* ss;
    __device__ __forceinline__ void operator()(AccRef acc, const Unit& u, int wr, int wc, int fr, int fq) const {
#pragma unroll
        for (int ai = 0; ai < 2; ++ai)
#pragma unroll
            for (int m = 0; m < 4; ++m) {
                const int row = u.pm * 256 + ai * 128 + wr * 64 + m * 16 + fr;
                const f32x4* sp = (const f32x4*)(ss + (size_t)row * 16);
                const f32x4 s0 = sp[0], s1 = sp[1], s2 = sp[2], s3 = sp[3];
                const float tot = ((s0[0] + s0[1]) + (s0[2] + s0[3])) + ((s1[0] + s1[1]) + (s1[2] + s1[3])) + ((s2[0] + s2[1]) + (s2[2] + s2[3])) + ((s3[0] + s3[1]) + (s3[2] + s3[3]));
                const float rinv = rsqrtf(tot * (1.0f / 1024.0f) + 1e-6f);
#pragma unroll
                for (int bj = 0; bj < 2; ++bj) {
                    const int col = u.pn * 256 + bj * 128 + wc * 32 + 8 * fq;
                    const f32x4 v0 = acc[ai][bj][m][0] * rinv, v1 = acc[ai][bj][m][1] * rinv;
                    u32x4 w; w.x = pk2(v0[0], v0[1]); w.y = pk2(v0[2], v0[3]); w.z = pk2(v1[0], v1[1]); w.w = pk2(v1[2], v1[3]);
                    if (u.pn < 11) *(u32x4*)(O + (size_t)row * INW + col) = w;
                    else {
                        const int cv = col - 2816;
                        const int sq_ = row & 2047;
                        const int sp_ = (sq_ & ~31) | (((sq_ >> 2) & 3) << 3) | (((sq_ >> 4) & 1) << 2) | (sq_ & 3);
                        bf16_t* vp = VT + ((size_t)((row >> 11) * 8 + (cv >> 6)) * 64 + (cv & 63)) * 2048 + sp_;
#pragma unroll
                        for (int e = 0; e < 4; ++e) { vp[(size_t)(2 * e) * 2048] = (bf16_t)(w[e] & 0xffffu); vp[(size_t)(2 * e + 1) * 2048] = (bf16_t)(w[e] >> 16); }
                    }
                }
            }
    }
};
struct EpiRes {
    bf16_t* XB; float* SS;
    __device__ __forceinline__ void operator()(AccRef acc, const Unit& u, int wr, int wc, int fr, int fq) const {
#pragma unroll
        for (int ai = 0; ai < 2; ++ai)
#pragma unroll
            for (int m = 0; m < 4; ++m) {
                const int row = u.pm * 256 + ai * 128 + wr * 64 + m * 16 + fr;
                float sq = 0.f;
#pragma unroll
                for (int bj = 0; bj < 2; ++bj) {
                    const int col = u.pn * 256 + bj * 128 + wc * 32 + 8 * fq;
                    u32x4* xp = (u32x4*)(XB + (size_t)row * 1024 + col);
                    const u32x4 xw = *xp;
                    f32x4 x0 = {lo16(xw.x), hi16(xw.x), lo16(xw.y), hi16(xw.y)}, x1 = {lo16(xw.z), hi16(xw.z), lo16(xw.w), hi16(xw.w)};
                    x0 += acc[ai][bj][m][0]; x1 += acc[ai][bj][m][1];
                    u32x4 w; w.x = pk2(x0[0], x0[1]); w.y = pk2(x0[2], x0[3]); w.z = pk2(x1[0], x1[1]); w.w = pk2(x1[2], x1[3]);
                    *xp = w;
                    x0 = (f32x4){lo16(w.x), hi16(w.x), lo16(w.y), hi16(w.y)}; x1 = (f32x4){lo16(w.z), hi16(w.z), lo16(w.w), hi16(w.w)};
                    sq += (x0[0] * x0[0] + x0[1] * x0[1]) + (x0[2] * x0[2] + x0[3] * x0[3]) + (x1[0] * x1[0] + x1[1] * x1[1]) + (x1[2] * x1[2] + x1[3] * x1[3]);
                }
                sq += __shfl_xor(sq, 16); sq += __shfl_xor(sq, 32);
                if (fq == 0) SS[(size_t)row * 16 + u.pn * 4 + wc] = sq;
            }
    }
};
struct EpiGU {
    bf16_t* H; const float* rinv;
    __device__ __forceinline__ void operator()(AccRef acc, const Unit& u, int wr, int wc, int fr, int fq) const {
#pragma unroll
        for (int ai = 0; ai < 2; ++ai)
#pragma unroll
            for (int m = 0; m < 4; ++m) {
                const int row = u.pm * 256 + ai * 128 + wr * 64 + m * 16 + fr;
                const float rs = rinv[row];
                float h[8];
#pragma unroll
                for (int n = 0; n < 2; ++n)
#pragma unroll
                    for (int j = 0; j < 4; ++j) { const float gt = acc[ai][0][m][n][j] * rs, up = acc[ai][1][m][n][j] * rs; h[n * 4 + j] = gt * __builtin_amdgcn_rcpf(1.0f + __expf(-gt)) * up; }
                u32x4 w; w.x = pk2(h[0], h[1]); w.y = pk2(h[2], h[3]); w.z = pk2(h[4], h[5]); w.w = pk2(h[6], h[7]);
                *(u32x4*)(H + (size_t)row * 512 + u.pn * 128 + wc * 32 + 8 * fq) = w;
            }
    }
};
struct EpiDown {
    bf16_t* Y; const int* slot; const float* sw;
    __device__ __forceinline__ void operator()(AccRef acc, const Unit& u, int wr, int wc, int fr, int fq) const {
#pragma unroll
        for (int ai = 0; ai < 2; ++ai)
#pragma unroll
            for (int m = 0; m < 4; ++m) {
                const int row = u.pm * 256 + ai * 128 + wr * 64 + m * 16 + fr;
                const int s = slot[row]; const float wgt = sw[row];
                if (s >= 0) {
#pragma unroll
                    for (int bj = 0; bj < 2; ++bj) {
                        const int col = u.pn * 256 + bj * 128 + wc * 32 + 8 * fq;
                        const f32x4 v0 = acc[ai][bj][m][0] * wgt, v1 = acc[ai][bj][m][1] * wgt;
                        u32x4 w; w.x = pk2(v0[0], v0[1]); w.y = pk2(v0[2], v0[3]); w.z = pk2(v1[0], v1[1]); w.w = pk2(v1[2], v1[3]);
                        *(u32x4*)(Y + (size_t)s * 1024 + col) = w;
                    }
                }
            }
    }
};
}

#define WSP(type, off) ((type*)(a.ws + (off)))
__device__ __forceinline__ int oblk() { int t = blockIdx.x; asm volatile("" : "+s"(t)); return t; }
__device__ __forceinline__ int ogrid() { int t = gridDim.x; asm volatile("" : "+s"(t)); return t; }
__device__ __forceinline__ int otid() { int t = threadIdx.x; asm volatile("" : "+v"(t)); return t; }
constexpr int LDS_INTAB = LDS_MISC + 14336;
__device__ __forceinline__ const float* ldsin(LAS unsigned char* lds, int i) {
    const unsigned long long p = ((const LAS unsigned long long*)(lds + LDS_INTAB))[i];
    const unsigned lo = __builtin_amdgcn_readfirstlane((unsigned)p), hi = __builtin_amdgcn_readfirstlane((unsigned)(p >> 32));
    return (const float*)(__attribute__((address_space(1))) const float*)(((unsigned long long)hi << 32) | lo);
}
#define INP(i) ldsin(lds, (i))

template <int MAP>
__device__ __forceinline__ void conv_slab(const float* __restrict__ src, int N, int Kper, bf16_t* __restrict__ dst, size_t estride,
                                          const float* __restrict__ gain, int goff, LAS float* tile, int slab) {
    const int tid = otid();
    const int nsn = N >> 8;
    const int kt = slab / nsn, ns = slab - kt * nsn, k0 = kt * 64, n0 = ns * 256;
    const int e = k0 / Kper, kl0 = k0 - e * Kper;
    f32x4 v[8];
#pragma unroll
    for (int i = 0; i < 8; ++i) { const int idx = tid + i * 512, kk = idx >> 6, n4 = (idx & 63) * 4; v[i] = *(const f32x4*)(src + (size_t)(k0 + kk) * N + n0 + n4); }
#pragma unroll
    for (int i = 0; i < 8; ++i) {
        const int idx = tid + i * 512, kk = idx >> 6, n4 = (idx & 63) * 4;
        float gsc = 1.0f;
        if (gain != nullptr && kl0 + kk >= goff) gsc = gain[kl0 + kk - goff];
        LAS float* tp = tile + kk * 257 + n4;
        tp[0] = v[i][0] * gsc; tp[1] = v[i][1] * gsc; tp[2] = v[i][2] * gsc; tp[3] = v[i][3] * gsc;
    }
    __syncthreads();
#pragma unroll
    for (int i = 0; i < 4; ++i) {
        const int p = tid + i * 512, nn = p >> 3, kg = p & 7;
        float x[8];
#pragma unroll
        for (int j = 0; j < 8; ++j) x[j] = tile[(kg * 8 + j) * 257 + nn];
        const int n = n0 + nn;
        const int nr = (MAP == 0) ? n : ((n >> 7) * 256 + (n & 127) + (MAP == 2 ? 128 : 0));
        u32x4 w; w.x = pk2(x[0], x[1]); w.y = pk2(x[2], x[3]); w.z = pk2(x[4], x[5]); w.w = pk2(x[6], x[7]);
        *(u32x4*)(dst + (size_t)e * estride + (size_t)nr * Kper + kl0 + kg * 8) = w;
    }
    __syncthreads();
}
template <int MAP>
__device__ __forceinline__ void conv_T(const float* __restrict__ src, int Ktot, int N, int Kper, bf16_t* __restrict__ dst, size_t estride,
                                       const float* __restrict__ gain, int goff, LAS float* tile) {
    const int nslab = (Ktot >> 6) * (N >> 8);
    for (int sl = oblk(); sl < nslab; sl += ogrid()) conv_slab<MAP>(src, N, Kper, dst, estride, gain, goff, tile, sl);
}
constexpr int MOE_CONV_ITEMS = 3 * 128;
__device__ __forceinline__ void moe_convert_item(const PA a, int l, LAS unsigned char* lds, int item) {
    LAS float* tile = (LAS float*)lds;
    const int which = item >> 7, s0 = (item & 127) * 8;
    const float* gn = INP(30) + l * 1024;
    for (int sl = s0; sl < s0 + 8; ++sl) {
        if (which == 0)      conv_slab<1>(INP(35) + (size_t)l * 32 * 1024 * 512, 512, 1024, WSP(bf16_t, WS_WGU), (size_t)1024 * 1024, gn, 0, tile, sl);
        else if (which == 1) conv_slab<2>(INP(36) + (size_t)l * 32 * 1024 * 512, 512, 1024, WSP(bf16_t, WS_WGU), (size_t)1024 * 1024, gn, 0, tile, sl);
        else                 conv_slab<0>(INP(37) + (size_t)l * 32 * 512 * 1024, 1024, 512, WSP(bf16_t, WS_WD), (size_t)1024 * 512, nullptr, 0, tile, sl);
    }
}

__device__ __forceinline__ void rows_convert(const float* __restrict__ src, float* __restrict__ dstf, bf16_t* __restrict__ dstb, float* __restrict__ ss, int nrows) {
    const int wave = otid() >> 6, lane = otid() & 63;
    for (int r = oblk() * 8 + wave; r < nrows; r += ogrid() * 8) {
        float sq = 0.f;
#pragma unroll
        for (int i = 0; i < 4; ++i) {
            const int c = i * 256 + lane * 4;
            const f32x4 v = *(const f32x4*)(src + (size_t)r * 1024 + c);
            if (dstf) *(f32x4*)(dstf + (size_t)r * 1024 + c) = v;
            u32x2 w; w.x = pk2(v[0], v[1]); w.y = pk2(v[2], v[3]);
            *(u32x2*)(dstb + (size_t)r * 1024 + c) = w;
            sq += (v[0] * v[0] + v[1] * v[1]) + (v[2] * v[2] + v[3] * v[3]);
        }
        sq = wsum(sq);
        if (lane < 16) ss[(size_t)r * 16 + lane] = (lane == 0) ? sq : 0.f;
    }
}

__device__ __forceinline__ void p0_prologue(const PA a, LAS unsigned char* lds) {
    LAS float* tile = (LAS float*)lds;
    for (int l = 0; l < NL; ++l) {
        conv_T<0>(INP(3) + (size_t)l * 1024 * INW, 1024, INW, 1024, WSP(bf16_t, WS_WIN) + (size_t)l * INW * 1024, 0, INP(2) + l * 1024, 0, tile);
        conv_T<0>(INP(22) + (size_t)l * 1024 * 1024, 1024, 1024, 1024, WSP(bf16_t, WS_WOUT) + (size_t)l * 1024 * 1024, 0, INP(21) + l * 512, 512, tile);
        conv_T<0>(INP(25) + (size_t)l * 1024 * 512, 1024, 512, 1024, WSP(bf16_t, WS_WQ) + (size_t)l * 512 * 1024, 0, INP(23) + l * 1024, 0, tile);
        conv_T<0>(INP(26) + (size_t)l * 1024 * 1024, 1024, 1024, 1024, WSP(bf16_t, WS_WKV) + (size_t)l * 1024 * 1024, 0, INP(24) + l * 1024, 0, tile);
        conv_T<0>(INP(27) + (size_t)l * 512 * 1024, 512, 1024, 512, WSP(bf16_t, WS_WO) + (size_t)l * 1024 * 512, 0, nullptr, 0, tile);
    }
    {
        bf16_t* wrh = WSP(bf16_t, WS_WRH); bf16_t* wrl = WSP(bf16_t, WS_WRL);
        for (int idx = oblk() * 512 + otid(); idx < NL * 48 * 1024; idx += ogrid() * 512) {
            const int k = idx & 1023, r = (idx >> 10) % 48, l = idx / (48 * 1024);
            float w;
            if (r < 16) w = INP(31)[((size_t)l * 1024 + k) * 4 + (r & 3)];
            else { const int ri = ((r >> 2) & 3) * 8 + ((r >> 4) - 1) * 4 + (r & 3); w = INP(33)[((size_t)l * 1024 + k) * 32 + ri]; }
            w *= INP(30)[l * 1024 + k];
            const bf16_t hi = f2bf(w);
            wrh[idx] = hi; wrl[idx] = f2bf(w - bf2f(hi));
        }
    }
    {
        const int gt = oblk() * 512 + otid(), gs = ogrid() * 512;
        for (int e = gt; e < 16 * 8192; e += gs) { const int im = e >> 13, idx = e & 8191, ch = idx & 127, k = idx >> 7, l = im >> 2, chb = (im & 3) * 128;
            bf16_t* ib = (bf16_t*)(a.ws + WS_PBI + (size_t)im * PBI_BYTES);
            ib[ch * 72 + k] = f2bf(INP(6)[(size_t)l * 64 * 512 + k * 512 + chb + ch]); ib[9216 + ch * 72 + k] = f2bf(INP(8)[(size_t)l * 64 * 512 + k * 512 + chb + ch]); }
        for (int e = gt; e < 16 * 16384; e += gs) { const int im = e >> 14, idx = e & 16383, ch = idx & 127, k = idx >> 7, l = im >> 2, chb = (im & 3) * 128;
            bf16_t* ib = (bf16_t*)(a.ws + WS_PBI + (size_t)im * PBI_BYTES);
            ib[18432 + ch * 136 + k] = f2bf(INP(9)[(size_t)l * 128 * 512 + k * 512 + chb + ch]); }
        for (int e = gt; e < 16 * 4096; e += gs) { const int im = e >> 12, idx = e & 4095, ch = idx & 127, k = idx >> 7, l = im >> 2, chb = (im & 3) * 128;
            bf16_t* ib = (bf16_t*)(a.ws + WS_PBI + (size_t)im * PBI_BYTES);
            ib[35840 + ch * 40 + k] = l > 0 ? f2bf(INP(17)[(size_t)(l - 1) * 32 * 512 + k * 512 + chb + ch]) : (bf16_t)0; }
        for (int e = gt; e < 16 * 16384; e += gs) { const int im = e >> 14, idx = e & 16383, n = idx & 31, k = idx >> 5, l = im >> 2;
            bf16_t* ib = (bf16_t*)(a.ws + WS_PBI + (size_t)im * PBI_BYTES);
            ib[40960 + n * 520 + k] = l > 0 ? f2bf(INP(16)[(size_t)(l - 1) * 512 * 32 + k * 32 + n]) : (bf16_t)0; }
        for (int e = gt; e < 16 * 1920; e += gs) { const int im = e / 1920, idx = e - im * 1920, l = im >> 2, chb = (im & 3) * 128;
            float* fb = (float*)(a.ws + WS_PBI + (size_t)im * PBI_BYTES + 115200);
            float v;
            if (idx < 1152) { const int arr = idx >> 7, cc = chb + (idx & 127);
                v = arr == 0 ? INP(4)[l * 1792 + cc] : arr == 1 ? INP(4)[l * 1792 + 512 + cc] : arr == 2 ? INP(4)[l * 1792 + 1024 + cc] : arr == 3 ? INP(5)[l * 512 + cc]
                  : arr == 4 ? INP(7)[l * 512 + cc] : arr == 5 ? INP(10)[l * 512 + cc] : arr == 6 ? INP(11)[l * 512 + cc] : arr == 7 ? (l > 0 ? INP(15)[(l - 1) * 512 + cc] : 0.f) : INP(12)[l * 512 + cc]; }
            else v = INP(4)[l * 1792 + 1024 + (idx - 1152)];
            fb[idx] = v; }
    }
    rows_convert(INP(0), nullptr, WSP(bf16_t, WS_XB), WSP(float, WS_SS), T);
    rows_convert(INP(1), nullptr, WSP(bf16_t, WS_MEMB), WSP(float, WS_MEMSS), MROWS);
}

__device__ __forceinline__ void p2_knorm(const PA a, LAS unsigned char* lds) {
    const int wave = otid() >> 6, lane = otid() & 63;
    bf16_t* kv = WSP(bf16_t, WS_KV);
    for (int it = oblk() * 8 + wave; it < NL * MROWS * 4; it += ogrid() * 8) {
        const int h = it & 3, row = (it >> 2) & (MROWS - 1), l = it >> 14;
        unsigned* p = (unsigned*)(kv + ((size_t)l * MROWS + row) * 1024 + h * 128 + lane * 2);
        const unsigned w = *p; const float x0 = lo16(w), x1 = hi16(w);
        const float ssq = wsum(x0 * x0 + x1 * x1);
        const float rinv = rsqrtf(ssq * (1.0f / 128.0f) + 1e-6f);
        const float* gk = INP(29) + l * 128 + lane * 2;
        *p = pk2(x0 * rinv * gk[0], x1 * rinv * gk[1]);
    }
    bf16_t* vtx = WSP(bf16_t, WS_VTX);
    const int tid = otid();
    for (int it = oblk(); it < NL * 16 * 4; it += ogrid()) {
        const int h = it & 3, b = (it >> 2) & 15, l = it >> 6;
        const bf16_t* src = kv + ((size_t)l * MROWS + b * 256) * 1024 + 512 + h * 128;
        bf16_t* dst = vtx + (size_t)it * 128 * 256;
#pragma unroll 1
        for (int i = 0; i < 8; ++i) {
            const int p = tid + i * 512, d = p & 127, m8 = (p >> 7) * 8;
            unsigned short x[8];
#pragma unroll
            for (int j = 0; j < 8; ++j) x[j] = src[(size_t)(m8 + j) * 1024 + d];
            u32x4 w; w.x = x[0] | ((unsigned)x[1] << 16); w.y = x[2] | ((unsigned)x[3] << 16); w.z = x[4] | ((unsigned)x[5] << 16); w.w = x[6] | ((unsigned)x[7] << 16);
            *(u32x4*)(dst + (size_t)d * 256 + m8) = w;
        }
    }
}

__device__ __forceinline__ float fast_tanh(float x) { return 1.0f - 2.0f * __builtin_amdgcn_rcpf(1.0f + __expf(2.0f * x)); }
__device__ __forceinline__ float fast_sigmoid(float x) { return __builtin_amdgcn_rcpf(1.0f + __expf(-x)); }
template <int MODE>
__device__ __forceinline__ bf16x8 mixfrag(const bf16_t* pu, const bf16_t* pp, float hpf, unsigned mub, int colc, int col) {
    const u32x4 u = *(const u32x4*)(pu + col), p = *(const u32x4*)(pp + col);
    const f32x4 m0 = *(const LAS f32x4*)(unsigned long long)(mub + (unsigned)colc * 4u), m1 = *(const LAS f32x4*)(unsigned long long)(mub + (unsigned)colc * 4u + 16u);
    float x[8];
#pragma unroll
    for (int j = 0; j < 4; ++j) {
        const float u0 = lo16(u[j]), u1 = hi16(u[j]), p0 = lo16(p[j]) * hpf, p1 = hi16(p[j]) * hpf;
        const float ma = (j < 2) ? m0[2 * j] : m1[2 * j - 4], mb = (j < 2) ? m0[2 * j + 1] : m1[2 * j - 3];
        x[2 * j] = u0 + ma * (p0 - u0); x[2 * j + 1] = u1 + mb * (p1 - u1);
    }
#pragma unroll
    for (int j = 0; j < 8; ++j) { if (MODE == 1) x[j] = fast_tanh(x[j]); if (MODE == 2) x[j] = fast_sigmoid(x[j]); }
    u32x4 w; w.x = pk2(x[0], x[1]); w.y = pk2(x[2], x[3]); w.z = pk2(x[4], x[5]); w.w = pk2(x[6], x[7]);
    return __builtin_bit_cast(bf16x8, w);
}
__device__ __forceinline__ void pb_prep(const PA a, int l, LAS unsigned char* lds) {
    const int tid = otid(), wave = __builtin_amdgcn_readfirstlane(tid >> 6), lane0 = tid & 63, fr0 = lane0 & 15, fq0 = lane0 >> 4;
    const int G = ogrid(), blk = oblk();
    LAS bf16_t* s_w2 = (LAS bf16_t*)lds;
    LAS bf16_t* s_a2 = (LAS bf16_t*)(lds + 18432);
    LAS bf16_t* s_g2 = (LAS bf16_t*)(lds + 36864);
    LAS bf16_t* s_v2 = (LAS bf16_t*)(lds + 71680);
    LAS bf16_t* s_v1 = (LAS bf16_t*)(lds + 81920);
    LAS float* s_par = (LAS float*)(lds + 115200);
    LAS float* s_mux = s_par + 1152;
    bf16_t* proj = WSP(bf16_t, WS_PROJ);
    const float* mu = INP(4) + l * 1792;
    const float* w0 = INP(5) + l * 512;  const float* w2 = INP(6) + (size_t)l * 64 * 512;
    const float* a0 = INP(7) + l * 512;  const float* a2 = INP(8) + (size_t)l * 64 * 512;
    const float* g2 = INP(9) + (size_t)l * 128 * 512;
    const float* kkw = INP(10) + l * 512; const float* kaw = INP(11) + l * 512;
    const int lv = l > 0 ? l - 1 : 0;
    const float* v0 = INP(15) + lv * 512; const float* v1 = INP(16) + (size_t)lv * 512 * 32; const float* v2 = INP(17) + (size_t)lv * 32 * 512;
    const float* qgn = INP(18) + l * 64; const float* kgn = INP(19) + l * 64;
    bf16_t* SR = WSP(bf16_t, WS_SR); bf16_t* SK = WSP(bf16_t, WS_SK); bf16_t* SV = WSP(bf16_t, WS_SV);
    bf16_t* SA = WSP(bf16_t, WS_SA); bf16_t* SB = WSP(bf16_t, WS_SB); bf16_t* SG = WSP(bf16_t, WS_SG);
    bf16_t* SWD = WSP(bf16_t, WS_SWD); bf16_t* VF = WSP(bf16_t, WS_VF);
    int cur_hp = -1;
    for (int item = blk; item < 4 * (T / 128); item += G) {
        const int hp = item & 3, tt = item >> 2;
        if (hp != cur_hp) {
            __syncthreads();
            const unsigned char* img = a.ws + WS_PBI + (size_t)(l * 4 + hp) * PBI_BYTES;
            for (int p = tid; p < PBI_BYTES / 16; p += 512) *(LAS u32x4*)(lds + p * 16) = *(const u32x4*)(img + (size_t)p * 16);
            __syncthreads();
            cur_hp = hp;
        }
        const int lane = otid() & 63, fr = lane & 15, fq = lane >> 4;
        const int t = tt * 128 + wave * 16 + fr;
        const bool hpv = (t & (SEQ - 1)) != 0;
        const bf16_t* pu = proj + (size_t)t * INW;
        const bf16_t* pp = hpv ? pu - INW : pu;
        const float hpf = hpv ? 1.0f : 0.0f;
        unsigned mub = (unsigned)(unsigned long long)s_mux - 4096u + (unsigned)(fq * 32); asm volatile("" : "+v"(mub));
        bf16x8 fwl[2], fal[2], fgl[4], ft32;
#pragma unroll
        for (int s = 0; s < 2; ++s) { fwl[s] = mixfrag<1>(pu, pp, hpf, mub, 1536 + 32 * s, 1536 + 32 * s + 8 * fq); fal[s] = mixfrag<0>(pu, pp, hpf, mub, 1600 + 32 * s, 1600 + 32 * s + 8 * fq); }
#pragma unroll
        for (int s = 0; s < 4; ++s) fgl[s] = mixfrag<2>(pu, pp, hpf, mub, 1664 + 32 * s, 1664 + 32 * s + 8 * fq);
        {
#pragma unroll
            for (int n8 = 0; n8 < 8; ++n8) {
                f32x4 ag = {0.f, 0.f, 0.f, 0.f};
#pragma unroll
                for (int s = 0; s < 4; ++s) ag = __builtin_amdgcn_mfma_f32_16x16x32_bf16(*(const LAS bf16x8*)(s_g2 + (n8 * 16 + fr) * 136 + 32 * s + 8 * fq), fgl[s], ag, 0, 0, 0);
                u32x2 w; w.x = pk2(ag[0], ag[1]); w.y = pk2(ag[2], ag[3]); *(u32x2*)(SG + (size_t)t * 512 + hp * 128 + n8 * 16 + 4 * fq) = w;
            }
        }
        ft32 = fwl[0];
        if (l > 0) {
            f32x4 c0 = {0.f, 0.f, 0.f, 0.f}, c1 = {0.f, 0.f, 0.f, 0.f};
#pragma unroll 8
            for (int s = 0; s < 16; ++s) {
                const bf16x8 xf = mixfrag<0>(pu, pp, hpf, mub, 1024 + 32 * s, 1024 + 32 * s + 8 * fq);
                const bf16x8 wa = *(const LAS bf16x8*)(s_v1 + fr * 520 + 32 * s + 8 * fq), wb = *(const LAS bf16x8*)(s_v1 + (16 + fr) * 520 + 32 * s + 8 * fq);
                c0 = __builtin_amdgcn_mfma_f32_16x16x32_bf16(wa, xf, c0, 0, 0, 0);
                c1 = __builtin_amdgcn_mfma_f32_16x16x32_bf16(wb, xf, c1, 0, 0, 0);
            }
            u32x4 w; w.x = pk2(c0[0], c0[1]); w.y = pk2(c0[2], c0[3]); w.z = pk2(c1[0], c1[1]); w.w = pk2(c1[2], c1[3]);
            ft32 = __builtin_bit_cast(bf16x8, w);
        }
#pragma unroll 1
        for (int hh = 0; hh < 2; ++hh) {
            u32x2 kkp[4], avp[4], dcp[4];
            u32x2 xrp[4], kmp[4], xvp[4];
            float kss = 0.f, bsum = 0.f;
            u32x2 Lur[4], Lpr[4], Luk[4], Lpk[4], Luv[4], Lpv[4], Lvf[4];
#pragma unroll
            for (int nt = 0; nt < 4; ++nt) {
                if ((nt & 1) == 0) {
#pragma unroll
                    for (int n2 = nt; n2 < nt + 2; ++n2) {
                        const int c4 = hp * 128 + hh * 64 + n2 * 16 + 4 * fq;
                        Lur[n2] = *(const u32x2*)(pu + c4); Lpr[n2] = *(const u32x2*)(pp + c4);
                        Luk[n2] = *(const u32x2*)(pu + 512 + c4); Lpk[n2] = *(const u32x2*)(pp + 512 + c4);
                        Luv[n2] = *(const u32x2*)(pu + 1024 + c4); Lpv[n2] = *(const u32x2*)(pp + 1024 + c4);
                        Lvf[n2] = (l > 0) ? *(const u32x2*)(VF + (size_t)t * 512 + c4) : (u32x2){0u, 0u};
                    }
                    __builtin_amdgcn_sched_barrier(0);
                }
                const int lc = hh * 64 + nt * 16, ch4 = hp * 128 + lc + 4 * fq;
                f32x4 aw = {0.f, 0.f, 0.f, 0.f}, aa = aw, az = aw;
#pragma unroll
                for (int s = 0; s < 2; ++s) {
                    aw = __builtin_amdgcn_mfma_f32_16x16x32_bf16(*(const LAS bf16x8*)(s_w2 + (lc + fr) * 72 + 32 * s + 8 * fq), fwl[s], aw, 0, 0, 0);
                    aa = __builtin_amdgcn_mfma_f32_16x16x32_bf16(*(const LAS bf16x8*)(s_a2 + (lc + fr) * 72 + 32 * s + 8 * fq), fal[s], aa, 0, 0, 0);
                }
                if (l > 0) {
                    const u32x2 q0 = *(const LAS u32x2*)(s_v2 + (lc + fr) * 40 + 4 * fq), q1 = *(const LAS u32x2*)(s_v2 + (lc + fr) * 40 + 16 + 4 * fq);
                    u32x4 w; w.x = q0.x; w.y = q0.y; w.z = q1.x; w.w = q1.y;
                    az = __builtin_amdgcn_mfma_f32_16x16x32_bf16(__builtin_bit_cast(bf16x8, w), ft32, az, 0, 0, 0);
                }
                const u32x2 ur = Lur[nt], pr = Lpr[nt], uk = Luk[nt], pk = Lpk[nt], uv = Luv[nt], pv = Lpv[nt];
                const int pc4 = lc + 4 * fq;
                const f32x4 mr = *(const LAS f32x4*)(s_par + pc4), mk = *(const LAS f32x4*)(s_par + 128 + pc4), mv = *(const LAS f32x4*)(s_par + 256 + pc4);
                const f32x4 w0v = *(const LAS f32x4*)(s_par + 384 + pc4), a0v = *(const LAS f32x4*)(s_par + 512 + pc4), kkwv = *(const LAS f32x4*)(s_par + 640 + pc4), kawv = *(const LAS f32x4*)(s_par + 768 + pc4);
                float xr[4], xk[4], xv[4];
                { const float u0 = lo16(ur.x), u1 = hi16(ur.x), u2 = lo16(ur.y), u3 = hi16(ur.y);
                  xr[0] = u0 + mr[0] * (lo16(pr.x) * hpf - u0); xr[1] = u1 + mr[1] * (hi16(pr.x) * hpf - u1); xr[2] = u2 + mr[2] * (lo16(pr.y) * hpf - u2); xr[3] = u3 + mr[3] * (hi16(pr.y) * hpf - u3); }
                { const float u0 = lo16(uk.x), u1 = hi16(uk.x), u2 = lo16(uk.y), u3 = hi16(uk.y);
                  xk[0] = u0 + mk[0] * (lo16(pk.x) * hpf - u0); xk[1] = u1 + mk[1] * (hi16(pk.x) * hpf - u1); xk[2] = u2 + mk[2] * (lo16(pk.y) * hpf - u2); xk[3] = u3 + mk[3] * (hi16(pk.y) * hpf - u3); }
                { const float u0 = lo16(uv.x), u1 = hi16(uv.x), u2 = lo16(uv.y), u3 = hi16(uv.y);
                  xv[0] = u0 + mv[0] * (lo16(pv.x) * hpf - u0); xv[1] = u1 + mv[1] * (hi16(pv.x) * hpf - u1); xv[2] = u2 + mv[2] * (lo16(pv.y) * hpf - u2); xv[3] = u3 + mv[3] * (hi16(pv.y) * hpf - u3); }
                const size_t o = (size_t)t * 512 + ch4;
                if (l > 0) {
                    const f32x4 v0v = *(const LAS f32x4*)(s_par + 896 + pc4);
                    const u32x2 vfw = Lvf[nt];
                    const float vf0 = lo16(vfw.x), vf1 = hi16(vfw.x), vf2 = lo16(vfw.y), vf3 = hi16(vfw.y);
                    xv[0] += (vf0 - xv[0]) * fast_sigmoid(v0v[0] + az[0]); xv[1] += (vf1 - xv[1]) * fast_sigmoid(v0v[1] + az[1]);
                    xv[2] += (vf2 - xv[2]) * fast_sigmoid(v0v[2] + az[2]); xv[3] += (vf3 - xv[3]) * fast_sigmoid(v0v[3] + az[3]);
                } else {
                    u32x2 w; w.x = pk2(xv[0], xv[1]); w.y = pk2(xv[2], xv[3]); *(u32x2*)(VF + o) = w;
                }
                const f32x4 rkv = *(const LAS f32x4*)(s_par + 1024 + pc4);
                float kmod[4], dcj[4], kkj[4], avj[4];
#pragma unroll
                for (int j = 0; j < 4; ++j) {
                    dcj[j] = 0.8750387749f * fast_sigmoid(w0v[j] + aw[j]);
                    avj[j] = fast_sigmoid(a0v[j] + aa[j]);
                    kkj[j] = xk[j] * kkwv[j];
                    kss += kkj[j] * kkj[j];
                    kmod[j] = xk[j] * (1.0f + (avj[j] - 1.0f) * kawv[j]);
                }
                dcp[nt].x = pk2(dcj[0], dcj[1]); dcp[nt].y = pk2(dcj[2], dcj[3]);
                kkp[nt].x = pk2(kkj[0], kkj[1]); kkp[nt].y = pk2(kkj[2], kkj[3]); avp[nt].x = pk2(avj[0], avj[1]); avp[nt].y = pk2(avj[2], avj[3]);
                xrp[nt].x = pk2(xr[0], xr[1]); xrp[nt].y = pk2(xr[2], xr[3]); kmp[nt].x = pk2(kmod[0], kmod[1]); kmp[nt].y = pk2(kmod[2], kmod[3]);
                xvp[nt].x = pk2(xv[0], xv[1]); xvp[nt].y = pk2(xv[2], xv[3]);
                bsum += lo16(xrp[nt].x) * lo16(kmp[nt].x) * rkv[0] + hi16(xrp[nt].x) * hi16(kmp[nt].x) * rkv[1] + lo16(xrp[nt].y) * lo16(kmp[nt].y) * rkv[2] + hi16(xrp[nt].y) * hi16(kmp[nt].y) * rkv[3];
            }
            kss += __shfl_xor(kss, 16); kss += __shfl_xor(kss, 32);
            bsum += __shfl_xor(bsum, 16); bsum += __shfl_xor(bsum, 32);
            const float rn = rsqrtf(fmaxf(kss, 1e-24f));
            const int t0w = tt * 128 + wave * 16, hd = hp * 2 + hh;
            const int cid = ((t0w >> 11) * 8 + hd) * 128 + ((t0w & (SEQ - 1)) >> 4);
            if (fq == 0) WSP(float, WS_BS)[(size_t)t * 8 + hd] = bsum;
            bf16x8 fA[2], fR[2], fB[2], fK[2], fV[2];
#define DPP1(x, ctrl) __int_as_float(__builtin_amdgcn_update_dpp(0x3f800000, __float_as_int(x), (ctrl), 0xF, 0xF, false))
#pragma unroll
            for (int nt = 0; nt < 4; ++nt) {
                float P[4], at[4], rt[4], bt[4], kt[4];
                const float xr4[4] = {lo16(xrp[nt].x), hi16(xrp[nt].x), lo16(xrp[nt].y), hi16(xrp[nt].y)};
                const float km4[4] = {lo16(kmp[nt].x), hi16(kmp[nt].x), lo16(kmp[nt].y), hi16(kmp[nt].y)};
                const float dc4[4] = {lo16(dcp[nt].x), hi16(dcp[nt].x), lo16(dcp[nt].y), hi16(dcp[nt].y)};
                const float kk4[4] = {lo16(kkp[nt].x), hi16(kkp[nt].x), lo16(kkp[nt].y), hi16(kkp[nt].y)};
                const float av4[4] = {lo16(avp[nt].x), hi16(avp[nt].x), lo16(avp[nt].y), hi16(avp[nt].y)};
#pragma unroll
                for (int j = 0; j < 4; ++j) {
                    float p = __builtin_amdgcn_exp2f(-dc4[j]);
                    p *= DPP1(p, 0x111); p *= DPP1(p, 0x112); p *= DPP1(p, 0x114); p *= DPP1(p, 0x118);
                    const float pm = DPP1(p, 0x111);
                    const float ip = 1.0f / p;
                    const float kn = kk4[j] * rn;
                    P[j] = p; at[j] = -kn * pm; rt[j] = xr4[j] * p; bt[j] = kn * av4[j] * ip; kt[j] = km4[j] * ip;
                }
                u32x2 wa, wr_, wb, wk;
                wa.x = pk2(at[0], at[1]); wa.y = pk2(at[2], at[3]); wr_.x = pk2(rt[0], rt[1]); wr_.y = pk2(rt[2], rt[3]);
                wb.x = pk2(bt[0], bt[1]); wb.y = pk2(bt[2], bt[3]); wk.x = pk2(kt[0], kt[1]); wk.y = pk2(kt[2], kt[3]);
                if (fr == 15) *(f32x4*)(WSP(float, WS_PCK) + (size_t)cid * 64 + nt * 16 + 4 * fq) = (f32x4){P[0], P[1], P[2], P[3]};
                u32x4 w;
                if ((nt & 1) == 0) { w = (u32x4){wa.x, wa.y, 0u, 0u}; fA[nt >> 1] = __builtin_bit_cast(bf16x8, w); w = (u32x4){wr_.x, wr_.y, 0u, 0u}; fR[nt >> 1] = __builtin_bit_cast(bf16x8, w);
                                     w = (u32x4){wb.x, wb.y, 0u, 0u}; fB[nt >> 1] = __builtin_bit_cast(bf16x8, w); w = (u32x4){wk.x, wk.y, 0u, 0u}; fK[nt >> 1] = __builtin_bit_cast(bf16x8, w);
                                     w = (u32x4){xvp[nt].x, xvp[nt].y, 0u, 0u}; fV[nt >> 1] = __builtin_bit_cast(bf16x8, w); }
                else { w = __builtin_bit_cast(u32x4, fA[nt >> 1]); w.z = wa.x; w.w = wa.y; fA[nt >> 1] = __builtin_bit_cast(bf16x8, w);
                       w = __builtin_bit_cast(u32x4, fR[nt >> 1]); w.z = wr_.x; w.w = wr_.y; fR[nt >> 1] = __builtin_bit_cast(bf16x8, w);
                       w = __builtin_bit_cast(u32x4, fB[nt >> 1]); w.z = wb.x; w.w = wb.y; fB[nt >> 1] = __builtin_bit_cast(bf16x8, w);
                       w = __builtin_bit_cast(u32x4, fK[nt >> 1]); w.z = wk.x; w.w = wk.y; fK[nt >> 1] = __builtin_bit_cast(bf16x8, w);
                       w = __builtin_bit_cast(u32x4, fV[nt >> 1]); w.z = xvp[nt].x; w.w = xvp[nt].y; fV[nt >> 1] = __builtin_bit_cast(bf16x8, w); }
            }
#undef DPP1
            {
                int frv = fr, fqv = fq, lanev = lane; asm volatile("" : "+v"(frv), "+v"(fqv), "+v"(lanev));
                const unsigned rowo = (unsigned)(frv * 1024);
                char* ua = (char*)(SA + ((size_t)t0w * 512 + hd * 64)); char* ur = (char*)(SR + ((size_t)t0w * 512 + hd * 64));
#pragma unroll
                for (int s_ = 0; s_ < 2; ++s_) { const unsigned co = rowo + (unsigned)((((4 * s_ + fqv) ^ (frv & 7))) * 16);
                    *(u32x4*)(ua + co) = __builtin_bit_cast(u32x4, fA[s_]); *(u32x4*)(ur + co) = __builtin_bit_cast(u32x4, fR[s_]); }
                const f32x4 z4 = {0.f, 0.f, 0.f, 0.f};
#define MF(a_, b_, c_) __builtin_amdgcn_mfma_f32_16x16x32_bf16((a_), (b_), (c_), 0, 0, 0)
                const f32x4 nka = MF(fA[1], fK[1], MF(fA[0], fK[0], z4));
                const f32x4 nbr = MF(fR[1], fB[1], MF(fR[0], fB[0], z4));
                const f32x4 nkr = MF(fR[1], fK[1], MF(fR[0], fK[0], z4));
                const f32x4 nba = MF(fB[1], fA[1], MF(fB[0], fA[0], z4));
                unsigned nbu = (unsigned)(unsigned long long)((LAS float*)(lds + PBI_BYTES) + wave * 256); asm volatile("" : "+v"(nbu));
                LAS float* nb = (LAS float*)(unsigned long long)nbu;
                bf16_t* gim = WSP(bf16_t, WS_NKA) + (size_t)cid * 1024;
                const int ncol = (frv >> 2) * 8 + (frv & 3);
#pragma unroll
                for (int j = 0; j < 4; ++j) {
                    const int row = 4 * fqv + j;
                    gim[row * 32 + ncol + 4] = f2bf(frv < row ? nka[j] : 0.f);
                    gim[512 + row * 32 + ncol] = f2bf(frv <= row ? nbr[j] : 0.f);
                    gim[512 + row * 32 + ncol + 4] = f2bf(frv <= row ? nkr[j] : 0.f);
                    nb[row * 16 + frv] = (row < frv) ? nba[j] : 0.f;
                }
                const unsigned idv = (fqv == (frv >> 2)) ? (0x3f80u << (16 * (frv & 1))) : 0u;
                u32x4 idA = {0u, 0u, 0u, 0u}, idB = {0u, 0u, 0u, 0u};
                if ((frv & 3) < 2) { idA.x = idv; idB.z = idv; } else { idA.y = idv; idB.w = idv; }
                char* ubk = (char*)(WSP(bf16_t, WS_BTT) + (size_t)cid * 2048); char* uvs = (char*)(WSP(bf16_t, WS_VST) + (size_t)cid * 1024);
                const unsigned bko = (unsigned)(frv * 64 + fqv * 16), vso = (unsigned)(frv * 32 + fqv * 8);
#pragma unroll
                for (int n_ = 0; n_ < 4; ++n_) {
                    const bf16x8 idf = __builtin_bit_cast(bf16x8, (n_ & 1) ? idB : idA);
                    const f32x4 bT = MF(fB[n_ >> 1], idf, z4), kT = MF(fK[n_ >> 1], idf, z4), vT = MF(fV[n_ >> 1], idf, z4);
                    *(u32x4*)(ubk + n_ * 1024 + bko) = (u32x4){pk2(bT[0], bT[1]), pk2(bT[2], bT[3]), pk2(kT[0], kT[1]), pk2(kT[2], kT[3])};
                    *(u32x2*)(uvs + n_ * 512 + vso) = (u32x2){pk2(vT[0], vT[1]), pk2(vT[2], vT[3])};
                }
#undef MF
                if (lanev < 16) {
                    float X[16];
                    const int tcolp = (lanev >> 2) * 8 + (lanev & 3);
#pragma unroll
                    for (int tcol = 0; tcol < 16; ++tcol) {
                        float acc = (lanev == tcol) ? 1.0f : 0.0f;
#pragma unroll
                        for (int i = 0; i < tcol; ++i) acc += X[i] * nb[i * 16 + tcol];
                        X[tcol] = acc;
                        gim[tcol * 32 + tcolp] = f2bf(acc);
                    }
                }
            }
        }
        {
            u32x4 Lq[4][2];
#pragma unroll
            for (int qk = 0; qk < 4; ++qk) {
                const bf16_t* p = proj + (size_t)t * INW + 1792 + (qk & 1) * 512 + (hp * 2 + (qk >> 1)) * 64 + fq * 16;
                Lq[qk][0] = *(const u32x4*)p; Lq[qk][1] = *(const u32x4*)(p + 8);
            }
#pragma unroll
            for (int qk = 0; qk < 4; ++qk) {
                const float* gn = (qk & 1) ? kgn : qgn;
                bf16_t* p = proj + (size_t)t * INW + 1792 + (qk & 1) * 512 + (hp * 2 + (qk >> 1)) * 64 + fq * 16;
                const u32x4 wa = Lq[qk][0], wb = Lq[qk][1];
                float x[16];
#pragma unroll
                for (int j = 0; j < 4; ++j) { x[2 * j] = lo16(wa[j]); x[2 * j + 1] = hi16(wa[j]); x[8 + 2 * j] = lo16(wb[j]); x[9 + 2 * j] = hi16(wb[j]); }
                float ssq = 0.f;
#pragma unroll
                for (int j = 0; j < 16; ++j) ssq += x[j] * x[j];
                ssq += __shfl_xor(ssq, 16); ssq += __shfl_xor(ssq, 32);
                const float rinv = rsqrtf(ssq * (1.0f / 64.0f) + 1e-6f);
                const float qsc = (qk & 1) ? rinv : rinv * 0.18033688011112042f;
#pragma unroll
                for (int j = 0; j < 16; ++j) x[j] = x[j] * qsc * gn[fq * 16 + j];
                u32x4 oa, ob;
#pragma unroll
                for (int j = 0; j < 4; ++j) { oa[j] = pk2(x[2 * j], x[2 * j + 1]); ob[j] = pk2(x[8 + 2 * j], x[9 + 2 * j]); }
                *(u32x4*)p = oa; *(u32x4*)(p + 8) = ob;
            }
        }
    }
    __syncthreads();
}

__device__ __forceinline__ void pb2_chunks(const PA a, int l, LAS unsigned char* lds) {
    const int tid = otid(), wave = tid >> 6, lane = tid & 63, fr = lane & 15, fq = lane >> 4;
    LAS bf16_t* sA = (LAS bf16_t*)(lds + wave * 11520);
    LAS bf16_t* sR = sA + 1152; LAS bf16_t* sB = sR + 1152; LAS bf16_t* sK = sB + 1152; LAS bf16_t* sX = sK + 1152;
    LAS float* nb = (LAS float*)(lds + 8 * 11520) + wave * 256;
    bf16_t* SR = WSP(bf16_t, WS_SR); bf16_t* SK = WSP(bf16_t, WS_SK); bf16_t* SV = WSP(bf16_t, WS_SV);
    bf16_t* SA = WSP(bf16_t, WS_SA); bf16_t* SB = WSP(bf16_t, WS_SB); const bf16_t* SWD = WSP(const bf16_t, WS_SWD);
    const float* rkp = INP(12) + l * 512;
    for (int cid = oblk() * 8 + wave; cid < NCHUNK; cid += ogrid() * 8) {
        const int b = cid >> 10, h = (cid >> 7) & 7, c = cid & 127;
        const size_t tok0 = (size_t)b * SEQ + c * 16;
        const size_t e0 = tok0 * 512 + h * 64 + lane;
        const float rkv = rkp[h * 64 + lane];
        const int posl = (lane & 32) | (((lane & 15) >> 2) << 3) | (((lane >> 4) & 1) << 2) | (lane & 3);
        float P = 1.0f;
        unsigned bt2[8], kt2[8], vt2[8];
#pragma unroll
        for (int hf = 0; hf < 2; ++hf) {
            bf16_t r16[8], k16[8], a16[8], b16[8], v16[8]; float w32[8];
#pragma unroll
            for (int t8 = 0; t8 < 8; ++t8) { const size_t e = e0 + (size_t)(hf * 8 + t8) * 512; r16[t8] = SR[e]; k16[t8] = SK[e]; a16[t8] = SA[e]; b16[t8] = SB[e]; v16[t8] = SV[e]; w32[t8] = __builtin_amdgcn_exp2f(-bf2f(SWD[e])); }
#pragma unroll
            for (int t8 = 0; t8 < 8; ++t8) {
                const int t = hf * 8 + t8;
                const float rr = bf2f(r16[t8]), kk = bf2f(k16[t8]), aa = bf2f(a16[t8]), bb = bf2f(b16[t8]);
                const float Pm = P; P *= w32[t8]; const float ip = 1.0f / P;
                const unsigned ar = pk2(aa * Pm, rr * P), bk = pk2(bb * ip, kk * ip);
                const bf16_t at = (bf16_t)(ar & 0xffffu), rt = (bf16_t)(ar >> 16), btv = (bf16_t)(bk & 0xffffu), ktv = (bf16_t)(bk >> 16);
                { const size_t es = tok0 * 512 + (size_t)t * 512 + h * 64 + (posl ^ ((t & 7) << 3)); SA[es] = at; SR[es] = rt; }
                sA[t * 72 + lane] = at; sR[t * 72 + lane] = rt; sB[t * 72 + lane] = btv; sK[t * 72 + lane] = ktv;
                sX[t * 72 + lane] = (bf16_t)(pk2(rr * kk * rkv, 0.f) & 0xffffu);
                if (t & 1) { bt2[t >> 1] |= (unsigned)btv << 16; kt2[t >> 1] |= (unsigned)ktv << 16; vt2[t >> 1] |= (unsigned)v16[t8] << 16; }
                else       { bt2[t >> 1] = btv; kt2[t >> 1] = ktv; vt2[t >> 1] = v16[t8]; }
            }
        }
        WSP(float, WS_PCK)[(size_t)cid * 64 + lane] = P;
        {
            u32x4* pb_ = (u32x4*)(WSP(bf16_t, WS_BTT) + (size_t)cid * 2048 + lane * 32);
            u32x4* pv_ = (u32x4*)(WSP(bf16_t, WS_VST) + (size_t)cid * 1024 + lane * 16);
#pragma unroll
            for (int q = 0; q < 4; ++q) pb_[q] = (u32x4){bt2[2 * q], bt2[2 * q + 1], kt2[2 * q], kt2[2 * q + 1]};
            pv_[0] = (u32x4){vt2[0], vt2[1], vt2[2], vt2[3]}; pv_[1] = (u32x4){vt2[4], vt2[5], vt2[6], vt2[7]};
        }
        bf16x8 fA[2], fR[2], fB[2], fK[2], fX[2];
#pragma unroll
        for (int s_ = 0; s_ < 2; ++s_) {
            fA[s_] = *(const LAS bf16x8*)(sA + fr * 72 + 32 * s_ + 8 * fq); fR[s_] = *(const LAS bf16x8*)(sR + fr * 72 + 32 * s_ + 8 * fq);
            fB[s_] = *(const LAS bf16x8*)(sB + fr * 72 + 32 * s_ + 8 * fq); fK[s_] = *(const LAS bf16x8*)(sK + fr * 72 + 32 * s_ + 8 * fq);
            fX[s_] = *(const LAS bf16x8*)(sX + fr * 72 + 32 * s_ + 8 * fq);
        }
        const f32x4 z4 = {0.f, 0.f, 0.f, 0.f};
        const bf16x8 ones = {0x3f80, 0x3f80, 0x3f80, 0x3f80, 0x3f80, 0x3f80, 0x3f80, 0x3f80};
        const f32x4 nka = __builtin_amdgcn_mfma_f32_16x16x32_bf16(fA[1], fK[1], __builtin_amdgcn_mfma_f32_16x16x32_bf16(fA[0], fK[0], z4, 0, 0, 0), 0, 0, 0);
        const f32x4 nbr = __builtin_amdgcn_mfma_f32_16x16x32_bf16(fR[1], fB[1], __builtin_amdgcn_mfma_f32_16x16x32_bf16(fR[0], fB[0], z4, 0, 0, 0), 0, 0, 0);
        const f32x4 nkr = __builtin_amdgcn_mfma_f32_16x16x32_bf16(fR[1], fK[1], __builtin_amdgcn_mfma_f32_16x16x32_bf16(fR[0], fK[0], z4, 0, 0, 0), 0, 0, 0);
        const f32x4 nba = __builtin_amdgcn_mfma_f32_16x16x32_bf16(fB[1], fA[1], __builtin_amdgcn_mfma_f32_16x16x32_bf16(fB[0], fA[0], z4, 0, 0, 0), 0, 0, 0);
        const f32x4 bsm = __builtin_amdgcn_mfma_f32_16x16x32_bf16(fX[1], ones, __builtin_amdgcn_mfma_f32_16x16x32_bf16(fX[0], ones, z4, 0, 0, 0), 0, 0, 0);
        bf16_t* gim = WSP(bf16_t, WS_NKA) + (size_t)cid * 1024;
        const int ncol = (fr >> 2) * 8 + (fr & 3);
#pragma unroll
        for (int j = 0; j < 4; ++j) {
            const int row = 4 * fq + j;
            gim[row * 32 + ncol + 4] = f2bf(fr < row ? nka[j] : 0.f);
            gim[512 + row * 32 + ncol] = f2bf(fr <= row ? nbr[j] : 0.f);
            gim[512 + row * 32 + ncol + 4] = f2bf(fr <= row ? nkr[j] : 0.f);
            nb[row * 16 + fr] = (row < fr) ? nba[j] : 0.f;
            if (fr == 0) WSP(float, WS_BS)[(tok0 + row) * 8 + h] = bsm[j];
        }
        if (lane < 16) {
            float X[16];
            bf16_t* gtm = WSP(bf16_t, WS_NKA) + (size_t)cid * 1024; const int tcolp = (lane >> 2) * 8 + (lane & 3);
#pragma unroll
            for (int tcol = 0; tcol < 16; ++tcol) {
                float acc = (lane == tcol) ? 1.0f : 0.0f;
#pragma unroll
                for (int i = 0; i < tcol; ++i) acc += X[i] * nb[i * 16 + tcol];
                X[tcol] = acc;
                gtm[tcol * 32 + tcolp] = f2bf(acc);
            }
        }
    }
    __syncthreads();
}

__device__ __forceinline__ void scan_item(const PA a, int l, int bh, LAS unsigned char* lds) {
    const int tid = otid(), wave = __builtin_amdgcn_readfirstlane(tid >> 6), lane = tid & 63, fr = lane & 15, fq = lane >> 4;
    const int b = __builtin_amdgcn_readfirstlane(bh >> 3), h = __builtin_amdgcn_readfirstlane(bh & 7);
    constexpr int SLOT = 15104, NS = 8, DPF = 6;
    constexpr int OA = 0, OR_ = 2048, OBK = 4096, OVT = 8192, ON = 10240, OPC = 12288, OBS = 12544, OSG = 13056;
    constexpr int YBO = NS * SLOT;
    const size_t tokb = (size_t)b * SEQ;
    const int cid0 = (b * 8 + h) * 128;
    const unsigned char* gA = (const unsigned char*)WSP(const bf16_t, WS_SA); const unsigned char* gR = (const unsigned char*)WSP(const bf16_t, WS_SR);
    const unsigned char* gG = (const unsigned char*)WSP(const bf16_t, WS_SG);
    const unsigned char* gBK = (const unsigned char*)WSP(const bf16_t, WS_BTT);
    const unsigned char* gVT = (const unsigned char*)WSP(const bf16_t, WS_VST); const unsigned char* gN = (const unsigned char*)WSP(const bf16_t, WS_NKA);
    const unsigned char* gPC = (const unsigned char*)WSP(const float, WS_PCK); const unsigned char* gBS = (const unsigned char*)WSP(const float, WS_BS);
#define DMA16(gp, ldsoff) __builtin_amdgcn_global_load_lds((const unsigned*)(gp), (LAS unsigned*)(lds + (ldsoff)), 16, 0, 0)
    const unsigned rowoff0 = (unsigned)(((lane >> 3) * 512 + (lane & 7) * 8) * 2), rowoff1 = rowoff0 + 8u * 512u * 2u;
#define DMA_CHUNK(c_) do { const int cid_ = cid0 + (c_); const int so_ = ((c_) % NS) * SLOT; \
        const size_t rb_ = ((tokb + (size_t)(c_) * 16) * 512 + h * 64) * 2; \
        if (wave == 4) { \
            DMA16(gA + rb_ + rowoff0, so_ + OA); DMA16(gA + rb_ + rowoff1, so_ + OA + 1024); DMA16(gR + rb_ + rowoff0, so_ + OR_); DMA16(gR + rb_ + rowoff1, so_ + OR_ + 1024); \
            DMA16(gBK + (size_t)cid_ * 4096 + lane * 16, so_ + OBK); DMA16(gBK + (size_t)cid_ * 4096 + 1024 + lane * 16, so_ + OBK + 1024); \
            DMA16(gBK + (size_t)cid_ * 4096 + 2048 + lane * 16, so_ + OBK + 2048); DMA16(gBK + (size_t)cid_ * 4096 + 3072 + lane * 16, so_ + OBK + 3072); \
            if (lane < 16) DMA16(gPC + (size_t)cid_ * 256 + lane * 16, so_ + OPC); \
        } else { \
            DMA16(gVT + (size_t)cid_ * 2048 + lane * 16, so_ + OVT); DMA16(gVT + (size_t)cid_ * 2048 + 1024 + lane * 16, so_ + OVT + 1024); \
            DMA16(gN + (size_t)cid_ * 2048 + lane * 16, so_ + ON); DMA16(gN + (size_t)cid_ * 2048 + 1024 + lane * 16, so_ + ON + 1024); \
            DMA16(gG + rb_ + rowoff0, so_ + OSG); DMA16(gG + rb_ + rowoff1, so_ + OSG + 1024); \
            if (lane < 32) DMA16(gBS + (tokb + (size_t)(c_) * 16) * 32 + lane * 16, so_ + OBS); \
            if (lane < 1) DMA16(gPC + (size_t)cid_ * 256, so_ + OPC); if (lane < 1) DMA16(gPC + (size_t)cid_ * 256, so_ + OPC); \
        } } while (0)
#define MF(a_, b_, c_) __builtin_amdgcn_mfma_f32_16x16x32_bf16((a_), (b_), (c_), 0, 0, 0)
#define LDF(off_) (*(const LAS bf16x8*)(sl + (off_)))
    const int swz = fr & 7;
    const int aoff0 = fr * 128 + ((fq) ^ swz) * 16, aoff1 = fr * 128 + ((4 + fq) ^ swz) * 16;
    const int noff = fr * 64 + fq * 16, voff = ((wave & 3) * 16 + fr) * 32 + 8 * fq;
    const float lw = INP(13)[l * 512 + h * 64 + lane], lb = INP(14)[l * 512 + h * 64 + lane];
    bf16_t* YC = WSP(bf16_t, WS_YCAT);
#define SCAN_EPI(cp_) do { const int cp = (cp_); \
        const unsigned slb = (unsigned)(unsigned long long)(lds + (cp % NS) * SLOT), ybb = (unsigned)(unsigned long long)(lds + YBO + (cp & 1) * 4352); \
          \
        f32x4 y0, y1, y2, y3; { const unsigned ya = ybb + fr * 272 + fq * 32; \
            asm volatile("ds_read_b128 %0, %4\n\tds_read_b128 %1, %4 offset:16\n\tds_read_b128 %2, %4 offset:128\n\tds_read_b128 %3, %4 offset:144\n\ts_waitcnt lgkmcnt(0)" \
                         : "=&v"(y0), "=&v"(y1), "=&v"(y2), "=&v"(y3) : "v"(ya) : "memory"); } \
        u32x4 f0, f1, g0, g1; \
        f0.x = pk2(y0[0], y0[1]); f0.y = pk2(y0[2], y0[3]); f0.z = pk2(y1[0], y1[1]); f0.w = pk2(y1[2], y1[3]); f1.x = pk2(y2[0], y2[1]); f1.y = pk2(y2[2], y2[3]); f1.z = pk2(y3[0], y3[1]); f1.w = pk2(y3[2], y3[3]); \
        g0.x = pk2(y0[0] * y0[0], y0[1] * y0[1]); g0.y = pk2(y0[2] * y0[2], y0[3] * y0[3]); g0.z = pk2(y1[0] * y1[0], y1[1] * y1[1]); g0.w = pk2(y1[2] * y1[2], y1[3] * y1[3]); \
        g1.x = pk2(y2[0] * y2[0], y2[1] * y2[1]); g1.y = pk2(y2[2] * y2[2], y2[3] * y2[3]); g1.z = pk2(y3[0] * y3[0], y3[1] * y3[1]); g1.w = pk2(y3[2] * y3[2], y3[3] * y3[3]); \
        const bf16x8 ones = {0x3f80, 0x3f80, 0x3f80, 0x3f80, 0x3f80, 0x3f80, 0x3f80, 0x3f80}; const f32x4 z4 = {0.f, 0.f, 0.f, 0.f}; \
        const f32x4 ssum = MF(__builtin_bit_cast(bf16x8, f1), ones, MF(__builtin_bit_cast(bf16x8, f0), ones, z4));        \
        const f32x4 sqsm = MF(__builtin_bit_cast(bf16x8, g1), ones, MF(__builtin_bit_cast(bf16x8, g0), ones, z4)); \
          \
        f32x4 rs4, mr4; \
        _Pragma("unroll") for (int j = 0; j < 4; ++j) { const float mean = ssum[j] * (1.0f / 64.0f); const float var = fmaxf(sqsm[j] * (1.0f / 64.0f) - mean * mean, 0.f); \
            rs4[j] = rsqrtf(var + 64e-5f); mr4[j] = -mean * rs4[j]; } \
        float eY[8], eB[8]; unsigned eV[8], eG[8]; \
        _Pragma("unroll") for (int i = 0; i < 8; ++i) { const int t = (wave - 6) * 8 + i; \
            const unsigned ay_ = ybb + (t * 68 + lane) * 4, ab_ = slb + OBS + t * 32 + h * 4, av_ = slb + OVT + lane * 32 + t * 2, ag_ = slb + OSG + t * 128 + lane * 2; \
            asm volatile("ds_read_b32 %0, %4\n\tds_read_b32 %1, %5\n\tds_read_u16 %2, %6\n\tds_read_u16 %3, %7" \
                         : "=&v"(eY[i]), "=&v"(eB[i]), "=&v"(eV[i]), "=&v"(eG[i]) : "v"(ay_), "v"(ab_), "v"(av_), "v"(ag_) : "memory"); } \
        asm volatile("s_waitcnt lgkmcnt(0)" ::: "memory"); \
        bf16_t* yrow = YC + (tokb + (size_t)cp * 16 + (wave - 6) * 8) * 1024 + h * 64;       \
        _Pragma("unroll") for (int i = 0; i < 8; ++i) { \
            asm volatile("" : "+v"(eY[i]), "+v"(eB[i]), "+v"(eV[i]), "+v"(eG[i])); \
            const int sl_ = ((wave - 6) * 2 + (i >> 2)) * 16; \
            const float rstd = __int_as_float(__builtin_amdgcn_readlane(__float_as_int(rs4[i & 3]), sl_)); \
            const float nmr = __int_as_float(__builtin_amdgcn_readlane(__float_as_int(mr4[i & 3]), sl_)); \
            const float vv = __uint_as_float(eV[i] << 16), g = __uint_as_float(eG[i] << 16); \
            const float o_ = (eY[i] * (rstd * lw) + (nmr * lw + lb) + eB[i] * vv) * g; \
            *(bf16_t*)((char*)(yrow + (size_t)i * 1024) + (unsigned)(lane * 2)) = (bf16_t)(pk2(o_, 0.f) & 0xffffu); } } while (0)
    f32x4 S[4];
#pragma unroll
    for (int kt = 0; kt < 4; ++kt) S[kt] = (f32x4){0.f, 0.f, 0.f, 0.f};
    __syncthreads();
    if (wave == 4 || wave == 5) {
#pragma unroll 1
        for (int c = 0; c < DPF; ++c) DMA_CHUNK(c);
        asm volatile("s_waitcnt vmcnt(0)" ::: "memory");
    }
    __syncthreads();
#pragma unroll 1
    for (int c = 0; c < 128; ++c) {
        if (wave < 4) {
            const LAS unsigned char* sl = lds + (c % NS) * SLOT;
            u32x4 s0w, s1w; s0w.x = pk2(S[0][0], S[0][1]); s0w.y = pk2(S[0][2], S[0][3]); s0w.z = pk2(S[1][0], S[1][1]); s0w.w = pk2(S[1][2], S[1][3]);
            s1w.x = pk2(S[2][0], S[2][1]); s1w.y = pk2(S[2][2], S[2][3]); s1w.z = pk2(S[3][0], S[3][1]); s1w.w = pk2(S[3][2], S[3][3]);
            const bf16x8 Sf0 = __builtin_bit_cast(bf16x8, s0w), Sf1 = __builtin_bit_cast(bf16x8, s1w);
            const u32x2 vm = *(const LAS u32x2*)(sl + OVT + voff);
            const bf16x8 TN = LDF(ON + noff), BN = LDF(ON + 1024 + noff);
            const f32x4 z4 = {0.f, 0.f, 0.f, 0.f};
            const bf16x8 ZV = __builtin_bit_cast(bf16x8, (u32x4){0u, 0u, vm.x, vm.y});
            f32x4 Wt = MF(LDF(OA + aoff0), Sf0, z4); Wt = MF(LDF(OA + aoff1), Sf1, Wt); Wt = MF(TN, ZV, Wt);
            const bf16x8 WZ = __builtin_bit_cast(bf16x8, (u32x4){pk2(Wt[0], Wt[1]), pk2(Wt[2], Wt[3]), 0u, 0u});
            const f32x4 Ut = MF(TN, WZ, z4);
            const bf16x8 UV = __builtin_bit_cast(bf16x8, (u32x4){pk2(Ut[0], Ut[1]), pk2(Ut[2], Ut[3]), vm.x, vm.y});
            f32x4 Yt = MF(LDF(OR_ + aoff0), Sf0, z4); Yt = MF(LDF(OR_ + aoff1), Sf1, Yt); Yt = MF(BN, UV, Yt);
#pragma unroll
            for (int kt = 0; kt < 4; ++kt) {
                const f32x4 pc = *(const LAS f32x4*)(sl + OPC + (kt * 16 + 4 * fq) * 4);
                S[kt] = MF(LDF(OBK + kt * 1024 + noff), UV, S[kt]) * pc;
            }
            LAS float* yb = (LAS float*)(lds + YBO + (c & 1) * 4352) + (wave & 3) * 16 + fr;
#pragma unroll
            for (int j = 0; j < 4; ++j) yb[(4 * fq + j) * 68] = Yt[j];
            asm volatile("s_waitcnt lgkmcnt(0)" ::: "memory");
        } else if (wave < 6) {
            if (c + DPF < 128) DMA_CHUNK(c + DPF);
            if (c >= DPF && c + DPF < 128) asm volatile("s_waitcnt vmcnt(45)" ::: "memory"); else asm volatile("s_waitcnt vmcnt(0)" ::: "memory");
        } else if (c > 0) {
            SCAN_EPI(c - 1);
        }
        asm volatile("" ::: "memory"); __builtin_amdgcn_s_barrier(); asm volatile("" ::: "memory");
    }
    if (wave >= 6) { SCAN_EPI(127); }
    asm volatile("s_waitcnt vmcnt(0)" ::: "memory");
    __syncthreads();
#undef SCAN_EPI
#undef DMA16
#undef DMA_CHUNK
#undef MF
#undef LDF
}

__device__ __forceinline__ void attn_item(const PA a, int l, int it, LAS unsigned char* lds) {
    const int tid = otid(), h = __builtin_amdgcn_readfirstlane(tid >> 6), lane = tid & 63, fr = lane & 15, fq = lane >> 4;
    const int b = it >> 5, c = it & 31;
    LAS float* s_bias = (LAS float*)(lds + LDS_MISC + 1024);
    LAS float* s_part = s_bias + 8 * 320;
    LAS float* tb = (LAS float*)lds + h * 1600;
    __syncthreads();
    for (int e = lane; e < 1600; e += 64) { const int r = e / 400, y = e - r * 400; int idx = 383 - (y + r); idx = idx > 319 ? 319 : (idx < 0 ? 0 : idx); tb[e] = s_bias[h * 320 + idx]; }
    const bf16_t* proj = WSP(const bf16_t, WS_PROJ);
    const bf16_t* VT = WSP(const bf16_t, WS_VT) + (size_t)(b * 8 + h) * 64 * 2048;
    const size_t tq0 = (size_t)b * SEQ + c * 64;
    bf16x8 qf[4][2];
#pragma unroll
    for (int nt = 0; nt < 4; ++nt)
#pragma unroll
        for (int ks = 0; ks < 2; ++ks) qf[nt][ks] = *(const bf16x8*)(proj + (tq0 + nt * 16 + fr) * INW + 1792 + h * 64 + 32 * ks + 8 * fq);
    f32x4 o[5][4];
#pragma unroll
    for (int dt = 0; dt < 5; ++dt)
#pragma unroll
        for (int nt = 0; nt < 4; ++nt) o[dt][nt] = (f32x4){0.f, 0.f, 0.f, 0.f};
    const int kc0 = c - 8 > 0 ? c - 8 : 0;
    const int nsteps = (c - kc0 + 1) * 2;
    const bf16x8 ones = {0x3f80, 0x3f80, 0x3f80, 0x3f80, 0x3f80, 0x3f80, 0x3f80, 0x3f80};
    const int rr = (4 - (fr & 3)) & 3;
    const unsigned tbl = (unsigned)(unsigned long long)(tb + rr * 400) + (unsigned)((320 - fr + 4 * fq - rr - 48) * 4);
    const bf16_t* kbase = proj + ((size_t)b * SEQ + kc0 * 64) * INW + 2304 + h * 64;
    const unsigned koff = (unsigned)((fr * INW + 8 * fq) * 2), voffb = (unsigned)((fr * 2048 + 8 * fq) * 2);
    const bf16_t* vbase = VT + kc0 * 64;
    bf16x8 kfA[2][2], kfB[2][2]; u32x4 vfA[4], vfB[4];
#define ATT_LOAD(KF, VF, st) do { unsigned ko_ = koff, vo_ = voffb; asm volatile("" : "+v"(ko_), "+v"(vo_)); \
        const char* kp_ = (const char*)(kbase + (size_t)(st) * 32 * INW); const char* vp_ = (const char*)(vbase + (st) * 32); \
        _Pragma("unroll") for (int mt = 0; mt < 2; ++mt) _Pragma("unroll") for (int ks = 0; ks < 2; ++ks) \
            KF[mt][ks] = *(const bf16x8*)(kp_ + (size_t)(mt * 16 * INW + 32 * ks) * 2 + ko_); \
        _Pragma("unroll") for (int dt = 0; dt < 4; ++dt) VF[dt] = *(const u32x4*)(vp_ + (size_t)(dt * 16 * 2048) * 2 + vo_); } while (0)
#define MF(a_, b_, c_) __builtin_amdgcn_mfma_f32_16x16x32_bf16((a_), (b_), (c_), 0, 0, 0)
#define ATT_STEP(KF, VF, st) do { \
        f32x4 sacc[2][4]; const f32x4 z4 = {0.f, 0.f, 0.f, 0.f}; \
        _Pragma("unroll") for (int mt = 0; mt < 2; ++mt) _Pragma("unroll") for (int nt = 0; nt < 4; ++nt) sacc[mt][nt] = MF(KF[mt][1], qf[nt][1], MF(KF[mt][0], qf[nt][0], z4)); \
        const int dk = c - (kc0 + ((st) >> 1)), half = (st) & 1; \
        if (dk >= 5) { const float bc = s_bias[h * 320 + 319]; \
            _Pragma("unroll") for (int mt = 0; mt < 2; ++mt) _Pragma("unroll") for (int nt = 0; nt < 4; ++nt) sacc[mt][nt] += bc; \
        } else { \
            const unsigned ta = tbl + (unsigned)((32 * half - 64 * dk + 256) * 4); f32x4 bv[5]; \
            _Pragma("unroll") for (int dd = 0; dd < 5; ++dd) bv[dd] = *(const LAS f32x4*)(unsigned long long)(ta - 1024u + (unsigned)((3 - (dd - 1)) * 64)); \
            _Pragma("unroll") for (int mt = 0; mt < 2; ++mt) _Pragma("unroll") for (int nt = 0; nt < 4; ++nt) sacc[mt][nt] += bv[nt - mt + 1]; } \
        bf16x8 pf[4]; \
        _Pragma("unroll") for (int nt = 0; nt < 4; ++nt) { \
            u32x4 w; w.x = pk2(__builtin_amdgcn_exp2f(sacc[0][nt][0]), __builtin_amdgcn_exp2f(sacc[0][nt][1])); w.y = pk2(__builtin_amdgcn_exp2f(sacc[0][nt][2]), __builtin_amdgcn_exp2f(sacc[0][nt][3])); \
            w.z = pk2(__builtin_amdgcn_exp2f(sacc[1][nt][0]), __builtin_amdgcn_exp2f(sacc[1][nt][1])); w.w = pk2(__builtin_amdgcn_exp2f(sacc[1][nt][2]), __builtin_amdgcn_exp2f(sacc[1][nt][3])); \
            pf[nt] = __builtin_bit_cast(bf16x8, w); } \
        _Pragma("unroll") for (int nt = 0; nt < 4; ++nt) { \
            _Pragma("unroll") for (int dt = 0; dt < 4; ++dt) o[dt][nt] = MF(__builtin_bit_cast(bf16x8, VF[dt]), pf[nt], o[dt][nt]); \
            o[4][nt] = MF(ones, pf[nt], o[4][nt]); } } while (0)
    ATT_LOAD(kfA, vfA, 0);
    __syncthreads();
#pragma unroll 1
    for (int st = 0; st < nsteps; st += 2) {
        ATT_LOAD(kfB, vfB, st + 1);
        ATT_STEP(kfA, vfA, st);
        if (st + 2 < nsteps) ATT_LOAD(kfA, vfA, st + 2);
        ATT_STEP(kfB, vfB, st + 1);
    }
#undef ATT_LOAD
#undef ATT_STEP
#undef MF
#pragma unroll
    for (int nt = 0; nt < 4; ++nt) {
        const float inv = 1.0f / o[4][nt][0];
        float sq = 0.f;
#pragma unroll
        for (int dt = 0; dt < 4; ++dt) { o[dt][nt] *= inv; sq += (o[dt][nt][0] * o[dt][nt][0] + o[dt][nt][1] * o[dt][nt][1]) + (o[dt][nt][2] * o[dt][nt][2] + o[dt][nt][3] * o[dt][nt][3]); }
        sq += __shfl_xor(sq, 16); sq += __shfl_xor(sq, 32);
        if (fq == 0) s_part[h * 64 + nt * 16 + fr] = sq;
    }
    __syncthreads();
#pragma unroll
    for (int nt = 0; nt < 4; ++nt) {
        float tot = 0.f;
#pragma unroll
        for (int hh = 0; hh < 8; ++hh) tot += s_part[hh * 64 + nt * 16 + fr];
        const float rinv = rsqrtf(tot * (1.0f / 512.0f) + 1e-6f);
        bf16_t* yp = WSP(bf16_t, WS_YCAT) + (tq0 + nt * 16 + fr) * 1024 + 512 + h * 64 + 4 * fq;
#pragma unroll
        for (int dt = 0; dt < 4; ++dt) { u32x2 w; w.x = pk2(o[dt][nt][0] * rinv, o[dt][nt][1] * rinv); w.y = pk2(o[dt][nt][2] * rinv, o[dt][nt][3] * rinv); *(u32x2*)(yp + dt * 16) = w; }
    }
    __syncthreads();
}

__device__ __forceinline__ void pc_mixer(const PA a, int l, LAS unsigned char* lds) {
    const int tid = otid();
    LAS float* s_bias = (LAS float*)(lds + LDS_MISC + 1024);
    volatile LAS int* s_item = (volatile LAS int*)(lds + LDS_MISC + 64);
    for (int i = tid; i < 8 * 320; i += 512) s_bias[i] = INP(20)[l * 8 * 320 + i] * 1.4426950408889634f;
    unsigned* qhead = WSP(unsigned, WS_CTL) + CW_QUEUE + l * 64;
    for (;;) {
        __syncthreads();
        if (tid == 0) *s_item = (int)__hip_atomic_fetch_add(qhead, 1u, __ATOMIC_RELAXED, __HIP_MEMORY_SCOPE_AGENT);
        __syncthreads();
        const int item = __builtin_amdgcn_readfirstlane(*s_item);
        if (item >= 128 + 512 + MOE_CONV_ITEMS) break;
        if (item < 128) scan_item(a, l, item, lds);
        else if (item < 128 + 512) attn_item(a, l, item - 128, lds);
        else moe_convert_item(a, l, lds, item - 640);
    }
}

__device__ __forceinline__ void pe2_xattn(const PA a, int l, LAS unsigned char* lds) {
    const int tid = otid(), wave = tid >> 6, lane = tid & 63, fr = lane & 15, fq = lane >> 4;
    LAS bf16_t* sK = (LAS bf16_t*)lds;
    LAS bf16_t* sV = (LAS bf16_t*)(lds + 69632);
    const bf16_t* QX = WSP(const bf16_t, WS_QX); bf16_t* OX = WSP(bf16_t, WS_OX);
    const bf16_t* KV = WSP(const bf16_t, WS_KV) + (size_t)l * MROWS * 1024;
    const bf16_t* VTX = WSP(const bf16_t, WS_VTX) + (size_t)l * MROWS * 512;
    const float* qgn = INP(28) + l * 128;
    for (int it = oblk(); it < 256; it += ogrid()) {
        const int b = it >> 4, h = (it >> 2) & 3, qr = it & 3;
        __syncthreads();
#pragma unroll
        for (int i = 0; i < 8; ++i) {
            const int p = tid + i * 512, r = p >> 4, c8 = (p & 15) * 8;
            *(LAS u32x4*)(sK + r * 136 + c8) = *(const u32x4*)(KV + (size_t)(b * 256 + r) * 1024 + h * 128 + c8);
            const int d = p >> 5, m8 = (p & 31) * 8;
            *(LAS u32x4*)(sV + d * 264 + m8) = *(const u32x4*)(VTX + ((size_t)(b * 4 + h) * 128 + d) * 256 + m8);
        }
        __syncthreads();
#pragma unroll 1
        for (int iter = 0; iter < 2; ++iter) {
            const size_t q0 = (size_t)b * SEQ + qr * 512 + iter * 256 + wave * 32;
            bf16x8 qf[2][4];
#pragma unroll
            for (int nt = 0; nt < 2; ++nt) {
                const bf16_t* qp = QX + (q0 + nt * 16 + fr) * 512 + h * 128 + 8 * fq;
                u32x4 w[4]; float ssq = 0.f;
#pragma unroll
                for (int ks = 0; ks < 4; ++ks) { w[ks] = *(const u32x4*)(qp + 32 * ks);
#pragma unroll
                    for (int j = 0; j < 4; ++j) { const float x0 = lo16(w[ks][j]), x1 = hi16(w[ks][j]); ssq += x0 * x0 + x1 * x1; } }
                ssq += __shfl_xor(ssq, 16); ssq += __shfl_xor(ssq, 32);
                const float sc = rsqrtf(ssq * (1.0f / 128.0f) + 1e-6f) * 0.12751743f;
#pragma unroll
                for (int ks = 0; ks < 4; ++ks) {
                    const f32x4 g0 = *(const f32x4*)(qgn + 32 * ks + 8 * fq), g1 = *(const f32x4*)(qgn + 32 * ks + 8 * fq + 4);
                    u32x4 ow;
                    ow.x = pk2(lo16(w[ks][0]) * sc * g0[0], hi16(w[ks][0]) * sc * g0[1]); ow.y = pk2(lo16(w[ks][1]) * sc * g0[2], hi16(w[ks][1]) * sc * g0[3]);
                    ow.z = pk2(lo16(w[ks][2]) * sc * g1[0], hi16(w[ks][2]) * sc * g1[1]); ow.w = pk2(lo16(w[ks][3]) * sc * g1[2], hi16(w[ks][3]) * sc * g1[3]);
                    qf[nt][ks] = __builtin_bit_cast(bf16x8, ow);
                }
            }
            f32x4 o[8][2];
#pragma unroll
            for (int dt = 0; dt < 8; ++dt) { o[dt][0] = (f32x4){0.f, 0.f, 0.f, 0.f}; o[dt][1] = (f32x4){0.f, 0.f, 0.f, 0.f}; }
            float lsum[2] = {0.f, 0.f};
#pragma unroll 2
            for (int st = 0; st < 8; ++st) {
                const int k0 = st * 32;
                f32x4 sacc[2][2];
#pragma unroll
                for (int mt = 0; mt < 2; ++mt) {
                    sacc[mt][0] = (f32x4){0.f, 0.f, 0.f, 0.f}; sacc[mt][1] = (f32x4){0.f, 0.f, 0.f, 0.f};
#pragma unroll
                    for (int ks = 0; ks < 4; ++ks) {
                        const bf16x8 kfr = *(const LAS bf16x8*)(sK + (k0 + mt * 16 + fr) * 136 + 32 * ks + 8 * fq);
                        sacc[mt][0] = __builtin_amdgcn_mfma_f32_16x16x32_bf16(kfr, qf[0][ks], sacc[mt][0], 0, 0, 0);
                        sacc[mt][1] = __builtin_amdgcn_mfma_f32_16x16x32_bf16(kfr, qf[1][ks], sacc[mt][1], 0, 0, 0);
                    }
                }
                bf16x8 pf[2];
#pragma unroll
                for (int nt = 0; nt < 2; ++nt) {
                    float p[8];
#pragma unroll
                    for (int j = 0; j < 4; ++j) { p[j] = __builtin_amdgcn_exp2f(fminf(sacc[0][nt][j], 80.f)); p[4 + j] = __builtin_amdgcn_exp2f(fminf(sacc[1][nt][j], 80.f)); }
                    lsum[nt] += ((p[0] + p[1]) + (p[2] + p[3])) + ((p[4] + p[5]) + (p[6] + p[7]));
                    u32x4 w; w.x = pk2(p[0], p[1]); w.y = pk2(p[2], p[3]); w.z = pk2(p[4], p[5]); w.w = pk2(p[6], p[7]);
                    pf[nt] = __builtin_bit_cast(bf16x8, w);
                }
#pragma unroll
                for (int dt = 0; dt < 8; ++dt) {
                    const LAS bf16_t* vp = sV + (dt * 16 + fr) * 264 + k0 + 4 * fq;
                    const u32x2 v0 = *(const LAS u32x2*)vp, v1 = *(const LAS u32x2*)(vp + 16);
                    u32x4 w; w.x = v0.x; w.y = v0.y; w.z = v1.x; w.w = v1.y;
                    const bf16x8 vfr = __builtin_bit_cast(bf16x8, w);
                    o[dt][0] = __builtin_amdgcn_mfma_f32_16x16x32_bf16(vfr, pf[0], o[dt][0], 0, 0, 0);
                    o[dt][1] = __builtin_amdgcn_mfma_f32_16x16x32_bf16(vfr, pf[1], o[dt][1], 0, 0, 0);
                }
            }
#pragma unroll
            for (int nt = 0; nt < 2; ++nt) {
                float ls = lsum[nt]; ls += __shfl_xor(ls, 16); ls += __shfl_xor(ls, 32);
                const float inv = 1.0f / ls;
                bf16_t* op = OX + (q0 + nt * 16 + fr) * 512 + h * 128 + 4 * fq;
#pragma unroll
                for (int dt = 0; dt < 8; ++dt) { u32x2 w; w.x = pk2(o[dt][nt][0] * inv, o[dt][nt][1] * inv); w.y = pk2(o[dt][nt][2] * inv, o[dt][nt][3] * inv); *(u32x2*)(op + dt * 16) = w; }
            }
        }
    }
    __syncthreads();
}

__device__ __forceinline__ void pf_router(const PA a, int l, LAS unsigned char* lds) {
    const int tid = otid(), wave = tid >> 6, lane = tid & 63, fr = lane & 15, fq = lane >> 4;
    LAS int* s_cnt = (LAS int*)lds;
    LAS int* s_base = s_cnt + 32;
    LAS int* s_e = s_base + 32;
    LAS int* s_rk = s_e + 256;
    LAS float* s_w = (LAS float*)(s_rk + 256);
    const bf16_t* X = WSP(const bf16_t, WS_XB); const float* SS = WSP(const float, WS_SS);
    const bf16_t* wrh = WSP(const bf16_t, WS_WRH) + (size_t)l * 48 * 1024; const bf16_t* wrl = WSP(const bf16_t, WS_WRL) + (size_t)l * 48 * 1024;
    const float* bg = INP(32) + l * 4; const float* br = INP(34) + l * 32;
    int* EID = WSP(int, WS_EID); float* EW = WSP(float, WS_EW); int* ERK = WSP(int, WS_ERK);
    unsigned* cnt = WSP(unsigned, WS_CTL) + CW_CNT + l * 32;
    for (int tile = oblk(); tile < T / 128; tile += ogrid()) {
        __syncthreads();
        if (tid < 32) s_cnt[tid] = 0;
        __syncthreads();
        const int t = tile * 128 + wave * 16 + fr;
        f32x4 acc[3];
#pragma unroll
        for (int mt = 0; mt < 3; ++mt) acc[mt] = (f32x4){0.f, 0.f, 0.f, 0.f};
        const bf16_t* xr = X + (size_t)t * 1024 + 8 * fq;
        u32x4 wst[6];
#define RT_LOAD(sl_) do { _Pragma("unroll") for (int i = 0; i < 6; ++i) { const int p = tid + i * 512, arr = p / 1536, pr = p - arr * 1536, r = pr >> 5, q = pr & 31; \
            wst[i] = *(const u32x4*)((arr ? wrl : wrh) + (size_t)r * 1024 + (sl_) * 256 + q * 8); } } while (0)
#define RT_STORE(buf_) do { _Pragma("unroll") for (int i = 0; i < 6; ++i) { const int p = tid + i * 512, arr = p / 1536, pr = p - arr * 1536, r = pr >> 5, q = pr & 31; \
            *(LAS u32x4*)(lds + 4096 + (buf_) * 50688 + arr * 25344 + r * 528 + q * 16) = wst[i]; } } while (0)
        RT_LOAD(0); RT_STORE(0);
        __syncthreads();
#pragma unroll 1
        for (int sl = 0; sl < 4; ++sl) {
            if (sl < 3) RT_LOAD(sl + 1);
            const LAS unsigned char* wb_ = lds + 4096 + (sl & 1) * 50688;
#pragma unroll
            for (int s8 = 0; s8 < 8; ++s8) {
                const int s_ = sl * 8 + s8;
                const bf16x8 xh = *(const bf16x8*)(xr + 32 * s_);
#pragma unroll
                for (int mt = 0; mt < 3; ++mt) {
                    const bf16x8 wh = *(const LAS bf16x8*)(wb_ + (mt * 16 + fr) * 528 + (32 * s8 + 8 * fq) * 2);
                    const bf16x8 wl = *(const LAS bf16x8*)(wb_ + 25344 + (mt * 16 + fr) * 528 + (32 * s8 + 8 * fq) * 2);
                    acc[mt] = __builtin_amdgcn_mfma_f32_16x16x32_bf16(wh, xh, acc[mt], 0, 0, 0);
                    acc[mt] = __builtin_amdgcn_mfma_f32_16x16x32_bf16(wl, xh, acc[mt], 0, 0, 0);
                }
            }
            if (sl < 3) { RT_STORE((sl + 1) & 1); __syncthreads(); }
        }
#undef RT_LOAD
#undef RT_STORE
        const f32x4* sp = (const f32x4*)(SS + (size_t)t * 16);
        const f32x4 s0 = sp[0], s1 = sp[1], s2 = sp[2], s3 = sp[3];
        const float tot = ((s0[0] + s0[1]) + (s0[2] + s0[3])) + ((s1[0] + s1[1]) + (s1[2] + s1[3])) + ((s2[0] + s2[1]) + (s2[2] + s2[3])) + ((s3[0] + s3[1]) + (s3[2] + s3[3]));
        const float rinv = rsqrtf(tot * (1.0f / 1024.0f) + 1e-6f);
        float lg[4], lr[8];
#pragma unroll
        for (int j = 0; j < 4; ++j) { lg[j] = acc[0][j] * rinv + bg[j]; lr[j] = acc[1][j] * rinv + br[fq * 8 + j]; lr[4 + j] = acc[2][j] * rinv + br[fq * 8 + 4 + j]; }
        float g0 = lg[0]; int gt = 0;
#pragma unroll
        for (int j = 1; j < 4; ++j) { if (lg[j] > g0) { g0 = lg[j]; gt = j; } }
        if (fq == gt) {
            float gs = 0.f;
#pragma unroll
            for (int j = 0; j < 4; ++j) gs += __expf(lg[j] - g0);
            const float ggate = 1.0f / gs;
            float l1 = -1e30f, l2 = -1e30f; int j1 = 0, j2 = 0;
#pragma unroll
            for (int j = 0; j < 8; ++j) { const float v = lr[j];
                if (v > l1) { l2 = l1; j2 = j1; l1 = v; j1 = j; } else if (v > l2) { l2 = v; j2 = j; } }
            const float e2 = __expf(l2 - l1);
            const float p1 = 1.0f / (1.0f + e2), p2 = e2 / (1.0f + e2);
            const int e1i = gt * 8 + j1, e2i = gt * 8 + j2;
            const int r1 = atomicAdd((int*)(s_cnt + e1i), 1), r2 = atomicAdd((int*)(s_cnt + e2i), 1);
            const int sl = (wave * 16 + fr) * 2;
            s_e[sl] = e1i; s_e[sl + 1] = e2i; s_rk[sl] = r1; s_rk[sl + 1] = r2; s_w[sl] = ggate * p1; s_w[sl + 1] = ggate * p2;
        }
        __syncthreads();
        if (tid < 32) s_base[tid] = (int)__hip_atomic_fetch_add(cnt + tid, (unsigned)s_cnt[tid], __ATOMIC_RELAXED, __HIP_MEMORY_SCOPE_AGENT);
        __syncthreads();
        if (tid < 256) { const int e = s_e[tid]; const size_t o = (size_t)tile * 256 + tid; EID[o] = e; EW[o] = s_w[tid]; ERK[o] = s_base[e] + s_rk[tid]; }
    }
    __syncthreads();
}

__device__ __forceinline__ void pg_gather(const PA a, int l, LAS unsigned char* lds) {
    const int tid = otid(), wave = tid >> 6, lane = tid & 63;
    LAS int* s_ps = (LAS int*)lds;
    const unsigned* cnt = WSP(const unsigned, WS_CTL) + CW_CNT + l * 32;
    int* SSLOT = WSP(int, WS_SSLOT); float* SW = WSP(float, WS_SW); int* MTE = WSP(int, WS_MTE);
    bf16_t* XS = WSP(bf16_t, WS_XS); const bf16_t* XB = WSP(const bf16_t, WS_XB);
    const float* SS = WSP(const float, WS_SS);
    const int* EID = WSP(const int, WS_EID); const float* EW = WSP(const float, WS_EW); const int* ERK = WSP(const int, WS_ERK);
    __syncthreads();
    if (tid == 0) {
        int acc = 0;
        for (int e = 0; e < 32; ++e) { s_ps[e] = acc; const int c = (int)__hip_atomic_load(cnt + e, __ATOMIC_RELAXED, __HIP_MEMORY_SCOPE_AGENT); acc += ((c + 255) >> 8) << 8; }
        s_ps[32] = acc;
    }
    __syncthreads();
    if (oblk() == 0) {
        if (tid < 32) { const int m0 = s_ps[tid] >> 8, m1 = s_ps[tid + 1] >> 8; for (int mt = m0; mt < m1; ++mt) MTE[mt] = tid; }
        if (tid == 0) MTE[511] = s_ps[32] >> 8;
        if (tid < 33) MTE[400 + tid] = s_ps[tid] >> 8;
    }
    int* STOK = WSP(int, WS_STOK); float* SRINV = WSP(float, WS_SRINV);
    for (int e = oblk(); e < 32; e += ogrid()) {
        const int c = (int)__hip_atomic_load(cnt + e, __ATOMIC_RELAXED, __HIP_MEMORY_SCOPE_AGENT);
        const int r0 = s_ps[e] + c, r1 = s_ps[e + 1];
        for (int r = r0 + tid; r < r1; r += 512) { SSLOT[r] = -1; SW[r] = 0.f; STOK[r] = 0; SRINV[r] = 0.f; }
    }
    for (int as = oblk() * 512 + tid; as < 2 * T; as += ogrid() * 512) {
        const int t = as >> 1;
        const int dest = s_ps[EID[as]] + ERK[as];
        const f32x4* sp = (const f32x4*)(SS + (size_t)t * 16);
        const f32x4 s0 = sp[0], s1 = sp[1], s2 = sp[2], s3 = sp[3];
        const float tot = ((s0[0] + s0[1]) + (s0[2] + s0[3])) + ((s1[0] + s1[1]) + (s1[2] + s1[3])) + ((s2[0] + s2[1]) + (s2[2] + s2[3])) + ((s3[0] + s3[1]) + (s3[2] + s3[3]));
        SSLOT[dest] = as; SW[dest] = EW[as]; STOK[dest] = t; SRINV[dest] = rsqrtf(tot * (1.0f / 1024.0f) + 1e-6f);
    }
}

__device__ __forceinline__ void pj_finalize(const PA a, bool last) {
    const int wave = otid() >> 6, lane = otid() & 63;
    float* OUT = a.out; bf16_t* XB = WSP(bf16_t, WS_XB); float* SS = WSP(float, WS_SS);
    const bf16_t* Y = WSP(const bf16_t, WS_Y);
    for (int t = oblk() * 8 + wave; t < T; t += ogrid() * 8) {
        float sq = 0.f;
#pragma unroll
        for (int i = 0; i < 2; ++i) {
            const int c = i * 512 + lane * 8;
            const u32x4 xw = *(const u32x4*)(XB + (size_t)t * 1024 + c);
            const u32x4 y0 = *(const u32x4*)(Y + (size_t)(2 * t) * 1024 + c), y1 = *(const u32x4*)(Y + (size_t)(2 * t + 1) * 1024 + c);
            float v[8];
#pragma unroll
            for (int j = 0; j < 4; ++j) { v[2 * j] = lo16(xw[j]) + (lo16(y0[j]) + lo16(y1[j])); v[2 * j + 1] = hi16(xw[j]) + (hi16(y0[j]) + hi16(y1[j])); }
            if (last) { *(f32x4*)(OUT + (size_t)t * 1024 + c) = (f32x4){v[0], v[1], v[2], v[3]}; *(f32x4*)(OUT + (size_t)t * 1024 + c + 4) = (f32x4){v[4], v[5], v[6], v[7]}; }
            else {
                u32x4 w; w.x = pk2(v[0], v[1]); w.y = pk2(v[2], v[3]); w.z = pk2(v[4], v[5]); w.w = pk2(v[6], v[7]);
                *(u32x4*)(XB + (size_t)t * 1024 + c) = w;
#pragma unroll
                for (int j = 0; j < 4; ++j) { const float a0 = lo16(w[j]), a1 = hi16(w[j]); sq += a0 * a0 + a1 * a1; }
            }
        }
        if (!last) { sq = wsum(sq); if (lane < 16) SS[(size_t)t * 16 + lane] = (lane == 0) ? sq : 0.f; }
    }
}

#define SITE static __device__ __forceinline__ void
#define OPAQUE() do { a.out = (float*)ldsin(lds, 38); a.ws = (unsigned char*)ldsin(lds, 39); } while (0)
__device__ __forceinline__ int opq(int v) { asm volatile("" : "+s"(v)); return v; }
SITE site_p0(PA a, LAS unsigned char* lds) { OPAQUE(); p0_prologue(a, lds); }
SITE site_kv(PA a, LAS unsigned char* lds) { OPAQUE();
    pg8::Gemm g{WSP(const bf16_t, WS_MEMB), WSP(const bf16_t, WS_WKV), 1024, (size_t)1024 * 1024, nullptr};
    pg8::KvOrder S{opq((int)gridDim.x), opq((int)blockIdx.x)};
    pg8::EpiScale E{WSP(bf16_t, WS_KV), 1024, WSP(const float, WS_MEMSS), MROWS - 1};
    pg8::gemm_phase<pg8::EpiScale, pg8::KvOrder>(lds, g, S, E);
}
SITE site_knorm(PA a, LAS unsigned char* lds) { OPAQUE(); p2_knorm(a, lds); }
SITE site_inproj(PA a, int l, LAS unsigned char* lds) { OPAQUE();
    pg8::Gemm g{WSP(const bf16_t, WS_XB), WSP(const bf16_t, WS_WIN) + (size_t)l * INW * 1024, 1024, 0, nullptr};
    pg8::StaticOrder S; S.init(T, INW, opq((int)gridDim.x), opq((int)blockIdx.x));
    pg8::EpiProj E{WSP(bf16_t, WS_PROJ), WSP(bf16_t, WS_VT), WSP(const float, WS_SS)};
    pg8::gemm_phase<pg8::EpiProj, pg8::StaticOrder>(lds, g, S, E);
}
SITE site_prep(PA a, int l, LAS unsigned char* lds) { OPAQUE();
    pb_prep(a, l, lds);
}
SITE site_chunks(PA a, int l, LAS unsigned char* lds) { OPAQUE(); pb2_chunks(a, l, lds); }
SITE site_mixer(PA a, int l, LAS unsigned char* lds) { OPAQUE(); pc_mixer(a, l, lds); }
SITE site_outproj(PA a, int l, LAS unsigned char* lds) { OPAQUE();
    pg8::Gemm g{WSP(const bf16_t, WS_YCAT), WSP(const bf16_t, WS_WOUT) + (size_t)l * 1024 * 1024, 1024, 0, nullptr};
    pg8::StaticOrder S; S.init(T, 1024, opq((int)gridDim.x), opq((int)blockIdx.x));
    pg8::EpiRes E{WSP(bf16_t, WS_XB), WSP(float, WS_SS)};
    pg8::gemm_phase<pg8::EpiRes, pg8::StaticOrder>(lds, g, S, E);
}
SITE site_xq(PA a, int l, LAS unsigned char* lds) { OPAQUE();
    pg8::Gemm g{WSP(const bf16_t, WS_XB), WSP(const bf16_t, WS_WQ) + (size_t)l * 512 * 1024, 1024, 0, nullptr};
    pg8::StaticOrder S; S.init(T, 512, opq((int)gridDim.x), opq((int)blockIdx.x));
    pg8::EpiScale E{WSP(bf16_t, WS_QX), 512, WSP(const float, WS_SS), T - 1};
    pg8::gemm_phase<pg8::EpiScale, pg8::StaticOrder>(lds, g, S, E);
}
SITE site_xattn(PA a, int l, LAS unsigned char* lds) { OPAQUE(); pe2_xattn(a, l, lds); }
SITE site_xo(PA a, int l, LAS unsigned char* lds) { OPAQUE();
    pg8::Gemm g{WSP(const bf16_t, WS_OX), WSP(const bf16_t, WS_WO) + (size_t)l * 1024 * 512, 512, 0, nullptr};
    pg8::StaticOrder S; S.init(T, 1024, opq((int)gridDim.x), opq((int)blockIdx.x));
    pg8::EpiRes E{WSP(bf16_t, WS_XB), WSP(float, WS_SS)};
    pg8::gemm_phase<pg8::EpiRes, pg8::StaticOrder>(lds, g, S, E);
}
SITE site_router(PA a, int l, LAS unsigned char* lds) { OPAQUE(); pf_router(a, l, lds); }
SITE site_gather(PA a, int l, LAS unsigned char* lds) { OPAQUE(); pg_gather(a, l, lds); }
SITE site_gu(PA a, LAS unsigned char* lds) { OPAQUE();
    pg8::Gemm g{WSP(const bf16_t, WS_XB), WSP(const bf16_t, WS_WGU), 1024, (size_t)1024 * 1024, WSP(const int, WS_STOK)};
    pg8::MoeOrder S{WSP(const int, WS_MTE), opq((int)gridDim.x), opq((int)blockIdx.x)};
    pg8::EpiGU E{WSP(bf16_t, WS_HB), WSP(const float, WS_SRINV)};
    pg8::gemm_phase<pg8::EpiGU, pg8::MoeOrder, true, true>(lds, g, S, E);
}
SITE site_down(PA a, LAS unsigned char* lds) { OPAQUE();
    pg8::Gemm g{WSP(const bf16_t, WS_HB), WSP(const bf16_t, WS_WD), 512, (size_t)1024 * 512, nullptr};
    pg8::MoeOrder S{WSP(const int, WS_MTE), opq((int)gridDim.x), opq((int)blockIdx.x)};
    pg8::EpiDown E{WSP(bf16_t, WS_Y), WSP(const int, WS_SSLOT), WSP(const float, WS_SW)};
    pg8::gemm_phase<pg8::EpiDown, pg8::MoeOrder>(lds, g, S, E);
}
SITE site_final(PA a, int l, LAS unsigned char* lds) { OPAQUE(); pj_finalize(a, l == NL - 1); }

__global__ void __launch_bounds__(512, 2) mk_fwd(Args args) {
    extern __shared__ __attribute__((aligned(16))) unsigned char lds_raw[];
    LAS unsigned char* lds = (LAS unsigned char*)lds_raw;
    const int tid = threadIdx.x;
    const int lo = args.ph_lo, hi = args.ph_hi;
    PA a; a.out = args.out; a.ws = args.ws;
    if (tid < 16) ((LAS unsigned*)(lds + LDS_MISC))[tid] = 0u;
    if (tid == 64) {
        LAS unsigned long long* tab = (LAS unsigned long long*)(lds + LDS_INTAB);
#pragma unroll
        for (int i = 0; i < 38; ++i) tab[i] = (unsigned long long)args.in[i];
        tab[38] = (unsigned long long)args.out; tab[39] = (unsigned long long)args.ws;
    }
    __syncthreads();
    XcdBarrier bar; bar.bar = WSP(unsigned, WS_CTL) + CW_BAR; bar.x = 0; bar.st = nullptr;
    if (!MK_PER_PHASE) bar = xcd_barrier_post(WSP(unsigned, WS_CTL) + CW_BAR, (volatile LAS unsigned*)(lds + LDS_MISC));
#define IN(k) (lo <= (k) && (k) < hi)
#define GRID_BAR() do { if (!MK_PER_PHASE) xcd_barrier(bar); } while (0)
#ifdef PROBE_MASK
    unsigned long long pr_acc = 0ull, pr_t0 = 0ull; const unsigned long long pr_start = wall_clock64();
#define PR0() do { pr_t0 = wall_clock64(); } while (0)
#define PR1(p) do { if ((PROBE_MASK >> (p)) & 1) pr_acc += wall_clock64() - pr_t0; } while (0)
#else
#define PR0() do { } while (0)
#define PR1(p) do { } while (0)
#endif
    PR0(); if (IN(0)) { site_p0(a, lds); GRID_BAR(); } PR1(12);
    PR0(); if (IN(1)) { site_kv(a, lds); GRID_BAR(); } PR1(13);
    PR0(); if (IN(2)) { site_knorm(a, lds); GRID_BAR(); } PR1(14);
    for (int l = 0; l < NL; ++l) {
        const int pb = 3 + 12 * l;
        PR0(); if (IN(pb + 0)) { site_inproj(a, l, lds); GRID_BAR(); } PR1(0);
        PR0(); if (IN(pb + 1)) { site_prep(a, l, lds); GRID_BAR(); } PR1(1);
        PR0(); if (IN(pb + 2)) { site_mixer(a, l, lds); GRID_BAR(); } PR1(2);
        PR0(); if (IN(pb + 3)) { site_outproj(a, l, lds); GRID_BAR(); } PR1(3);
        PR0(); if (IN(pb + 4)) { site_xq(a, l, lds); GRID_BAR(); } PR1(4);
        PR0(); if (IN(pb + 5)) { site_xattn(a, l, lds); GRID_BAR(); } PR1(5);
        PR0(); if (IN(pb + 6)) { site_xo(a, l, lds); GRID_BAR(); } PR1(6);
        PR0(); if (IN(pb + 7)) { site_router(a, l, lds); GRID_BAR(); } PR1(7);
        PR0(); if (IN(pb + 8)) { site_gather(a, l, lds); GRID_BAR(); } PR1(8);
        PR0(); if (IN(pb + 9)) { site_gu(a, lds); GRID_BAR(); } PR1(9);
        PR0(); if (IN(pb + 10)) { site_down(a, lds); GRID_BAR(); } PR1(10);
#ifdef PROBE_MASK
        PR0(); if (IN(pb + 11)) { site_final(a, l, lds); GRID_BAR(); } PR1(11);
#else
        if (IN(pb + 11)) { site_final(a, l, lds); if (l + 1 < NL) GRID_BAR(); }
#endif
    }
#ifdef PROBE_MASK
    {
        unsigned long long* pw = (unsigned long long*)(WSP(unsigned, WS_CTL) + 8192);
        if (blockIdx.x == 0 && tid == 0) __hip_atomic_store(pw, pr_acc, __ATOMIC_RELAXED, __HIP_MEMORY_SCOPE_AGENT);
        GRID_BAR();
        const unsigned long long tgt = 1600000ull + __hip_atomic_load(pw, __ATOMIC_RELAXED, __HIP_MEMORY_SCOPE_AGENT) * (unsigned long long)PROBE_MULT;
        while (wall_clock64() - pr_start < tgt) __builtin_amdgcn_s_sleep(16);
    }
#endif
#undef IN
#undef GRID_BAR
}

extern "C" void kernel_launch(void* const* d_in, const int* in_sizes, int n_in, void* d_out, int out_size, void* d_ws, size_t ws_size, hipStream_t stream) {
    static int grid = 0;
    if (grid == 0) {
        if (n_in != 38 || out_size != T * D || ws_size < WS_END) { fprintf(stderr, "kernel_launch: unexpected shapes (n_in %d out %d ws %zu need %zu)\n", n_in, out_size, ws_size, (size_t)WS_END); grid = -1; return; }
        int dev = 0, cus = 0, per_cu = 0;
        if (hipGetDevice(&dev) != hipSuccess || hipDeviceGetAttribute(&cus, hipDeviceAttributeMultiprocessorCount, dev) != hipSuccess) { grid = -1; return; }
        if (hipFuncSetAttribute((const void*)mk_fwd, hipFuncAttributeMaxDynamicSharedMemorySize, LDS_BYTES) != hipSuccess) { fprintf(stderr, "kernel_launch: hipFuncSetAttribute failed\n"); grid = -1; return; }
        if (hipOccupancyMaxActiveBlocksPerMultiprocessor(&per_cu, (const void*)mk_fwd, 512, LDS_BYTES) != hipSuccess || per_cu < 1) { fprintf(stderr, "kernel_launch: occupancy query says %d\n", per_cu); }
        (void)hipGetLastError();
        grid = cus;
    }
    if (grid < 0) return;
    (void)hipMemsetAsync((char*)d_ws + WS_CTL, 0, CTL_BYTES, stream);
    Args a{};
    for (int i = 0; i < 38; ++i) a.in[i] = (const float*)d_in[i];
    a.out = (float*)d_out; a.ws = (unsigned char*)d_ws;
#if MK_PER_PHASE
    for (int p = 0; p < NPH; ++p) { a.ph_lo = p; a.ph_hi = p + 1; hipLaunchKernelGGL(mk_fwd, dim3(grid), dim3(512), LDS_BYTES, stream, a); }
#else
    a.ph_lo = 0; a.ph_hi = NPH;
    hipLaunchKernelGGL(mk_fwd, dim3(grid), dim3(512), LDS_BYTES, stream, a);
#endif
}
```

```cpp
#include <hip/hip_runtime.h>
#include <cstdio>
#include <cstdint>

#ifndef MK_PER_PHASE
#define MK_PER_PHASE 0
#endif

#define LAS __attribute__((address_space(3)))
typedef unsigned short bf16_t;
typedef short bf16x8 __attribute__((ext_vector_type(8)));
typedef float f32x4 __attribute__((ext_vector_type(4)));
typedef unsigned u32x4 __attribute__((ext_vector_type(4)));
typedef unsigned u32x2 __attribute__((ext_vector_type(2)));

constexpr int T = 32768, D = 1024, SEQ = 2048, NL = 4;
constexpr int INW = 3328;
constexpr int MROWS = 4096;
constexpr int MAXROWS = 73728, MAXMT = 288;
constexpr int NPH = 3 + 12 * NL;

constexpr size_t WS_CTL   = 0;
constexpr size_t CTL_BYTES = 65536;
constexpr size_t WS_WIN   = WS_CTL + CTL_BYTES;
constexpr size_t WS_WOUT  = WS_WIN  + (size_t)4 * 3328 * 1024 * 2;
constexpr size_t WS_WQ    = WS_WOUT + (size_t)4 * 1024 * 1024 * 2;
constexpr size_t WS_WKV   = WS_WQ   + (size_t)4 * 512 * 1024 * 2;
constexpr size_t WS_WO    = WS_WKV  + (size_t)4 * 1024 * 1024 * 2;
constexpr size_t WS_WGU   = WS_WO   + (size_t)4 * 1024 * 512 * 2;
constexpr size_t WS_WD    = WS_WGU  + (size_t)32 * 1024 * 1024 * 2;
constexpr size_t WS_KV    = WS_WD   + (size_t)32 * 1024 * 512 * 2;
constexpr size_t WS_MEMB  = WS_KV   + (size_t)4 * 4096 * 1024 * 2;
constexpr size_t WS_MEMSS = WS_MEMB + (size_t)4096 * 1024 * 2;
constexpr size_t WS_VTX   = WS_MEMSS + (size_t)4096 * 16 * 4;
constexpr size_t WS_WRH   = WS_VTX  + (size_t)4 * 4096 * 512 * 2;
constexpr size_t WS_WRL   = WS_WRH  + (size_t)4 * 48 * 1024 * 2;
constexpr size_t WS_PBI   = WS_WRL  + (size_t)4 * 48 * 1024 * 2;
constexpr int PBI_BYTES = 122880;
constexpr size_t WS_XB    = WS_PBI  + (size_t)16 * PBI_BYTES;
constexpr size_t WS_SS    = WS_XB   + (size_t)T * 1024 * 2;
constexpr size_t WS_VF    = WS_SS   + (size_t)T * 16 * 4;
constexpr size_t WS_EID   = WS_VF   + (size_t)T * 512 * 2;
constexpr size_t WS_EW    = WS_EID  + (size_t)T * 2 * 4;
constexpr size_t WS_ERK   = WS_EW   + (size_t)T * 2 * 4;
constexpr size_t WS_SSLOT = WS_ERK  + (size_t)T * 2 * 4;
constexpr size_t WS_SW    = WS_SSLOT + (size_t)MAXROWS * 4;
constexpr size_t WS_MTE   = WS_SW   + (size_t)MAXROWS * 4;
constexpr size_t WS_STOK  = WS_MTE  + 2048;
constexpr size_t WS_SRINV = WS_STOK + (size_t)MAXROWS * 4;
constexpr size_t WS_U     = WS_SRINV + (size_t)MAXROWS * 4;
constexpr size_t WS_PROJ  = WS_U;
constexpr size_t WS_SR    = WS_PROJ + (size_t)T * 3328 * 2;
constexpr size_t WS_SK    = WS_SR   + (size_t)T * 512 * 2;
constexpr size_t WS_SV    = WS_SK   + (size_t)T * 512 * 2;
constexpr size_t WS_SA    = WS_SV   + (size_t)T * 512 * 2;
constexpr size_t WS_SB    = WS_SA   + (size_t)T * 512 * 2;
constexpr size_t WS_SG    = WS_SB   + (size_t)T * 512 * 2;
constexpr size_t WS_SWD   = WS_SG   + (size_t)T * 512 * 2;
constexpr size_t WS_YCAT  = WS_SWD  + (size_t)T * 512 * 4;
constexpr size_t WS_VT    = WS_YCAT + (size_t)T * 1024 * 2;
constexpr int NCHUNK = 16 * 8 * 128;
constexpr size_t WS_BTT   = WS_VT   + (size_t)T * 512 * 2;
constexpr size_t WS_KTT   = WS_BTT  + (size_t)NCHUNK * 2048;
constexpr size_t WS_VST   = WS_KTT  + (size_t)NCHUNK * 2048;
constexpr size_t WS_NKA   = WS_VST  + (size_t)NCHUNK * 2048;
constexpr size_t WS_NBR   = WS_NKA  + (size_t)NCHUNK * 512;
constexpr size_t WS_NKR   = WS_NBR  + (size_t)NCHUNK * 512;
constexpr size_t WS_TMT   = WS_NKR  + (size_t)NCHUNK * 512;
constexpr size_t WS_PCK   = WS_TMT  + (size_t)NCHUNK * 512;
constexpr size_t WS_BS    = WS_PCK  + (size_t)NCHUNK * 256;
constexpr size_t WS_UEND1 = WS_BS   + (size_t)T * 8 * 4;
constexpr size_t WS_QX    = WS_U;
constexpr size_t WS_OX    = WS_QX   + (size_t)T * 512 * 2;
constexpr size_t WS_XS    = WS_U;
constexpr size_t WS_HB    = WS_XS   + (size_t)MAXROWS * 1024 * 2;
constexpr size_t WS_Y     = WS_HB   + (size_t)MAXROWS * 512 * 2;
constexpr size_t WS_UEND2 = WS_Y    + (size_t)2 * T * 1024 * 2;
constexpr size_t WS_END   = WS_UEND1 > WS_UEND2 ? WS_UEND1 : WS_UEND2;

constexpr int CW_BAR = 0;
constexpr int CW_CNT = 4096;
constexpr int CW_QUEUE = 4096 + 256;

constexpr int LDS_MISC = 139264;
constexpr int LDS_BYTES = LDS_MISC + 16384;

struct Args { const float* in[38]; float* out; unsigned char* ws; int ph_lo, ph_hi; };
struct PA { float* out; unsigned char* ws; };

__device__ __forceinline__ float bf2f(bf16_t b) { return __uint_as_float(((unsigned)b) << 16); }
__device__ __forceinline__ bf16_t f2bf(float f) { unsigned u = __float_as_uint(f); u += 0x7FFFu + ((u >> 16) & 1u); return (bf16_t)(u >> 16); }
typedef __bf16 bf16v2 __attribute__((ext_vector_type(2)));
typedef float f32x2 __attribute__((ext_vector_type(2)));
__device__ __forceinline__ unsigned pk2(float lo, float hi) { f32x2 v = {lo, hi}; bf16v2 b = __builtin_convertvector(v, bf16v2); return __builtin_bit_cast(unsigned, b); }
__device__ __forceinline__ float lo16(unsigned u) { return __uint_as_float(u << 16); }
__device__ __forceinline__ float hi16(unsigned u) { return __uint_as_float(u & 0xffff0000u); }
__device__ __forceinline__ float wsum(float v) {
#pragma unroll
    for (int o = 32; o; o >>= 1) v += __shfl_xor(v, o);
    return v;
}
__device__ __forceinline__ float sigmoidf_(float x) { return 1.0f / (1.0f + __expf(-x)); }

#define XB_TMO      128
#define XB_XCNT(j)  (256  + 64 * (j))
#define XB_XSUB(j)  (1280 + 64 * (j))
#define XB_XGEN(j)  (2304 + 64 * (j))
#define XB_TOP      3328
#define XB_TOPGEN   3392
#define XCD_BAR_WORDS 3456
#define XB_SPIN_CAP (1u << 22)

__device__ __forceinline__ unsigned xb_ld(unsigned* p)              { return __hip_atomic_load(p, __ATOMIC_RELAXED, __HIP_MEMORY_SCOPE_AGENT); }
__device__ __forceinline__ unsigned xb_add(unsigned* p, unsigned v) { return __hip_atomic_fetch_add(p, v, __ATOMIC_RELAXED, __HIP_MEMORY_SCOPE_AGENT); }
__device__ __forceinline__ unsigned xb_xcc_id() { return (unsigned)__builtin_amdgcn_s_getreg((3 << 11) | 20) & 0xFu; }
#define XB_SPIN(cond, bar) do { unsigned _sp = 0; while (cond) { __builtin_amdgcn_s_sleep(1); \
    if ((++_sp & 255u) == 0u) { if (xb_ld(&(bar)[XB_TMO])) break; if (_sp > XB_SPIN_CAP) { atomicAdd(&(bar)[XB_TMO], 1u); break; } } } } while (0)

struct XcdBarrier { unsigned* bar; unsigned x; volatile LAS unsigned* st; };

__device__ __forceinline__ XcdBarrier xcd_barrier_post(unsigned* bar, volatile LAS unsigned* st) {
    XcdBarrier b; b.bar = bar; b.x = xb_xcc_id(); b.st = st;
    if (threadIdx.x == 0) (void)xb_add(&bar[XB_XCNT(b.x)], 1u);
    return b;
}
__device__ __forceinline__ void xcd_barrier_complete(unsigned* bar, unsigned x, unsigned& nloc, unsigned& nx) {
    const unsigned G = gridDim.x * gridDim.y * gridDim.z;
    unsigned sum, cnt, mine, sp = 0u;
    for (;;) {
        sum = 0u; cnt = 0u; mine = 0u;
#pragma unroll
        for (unsigned j = 0; j < 16; ++j) { const unsigned c = xb_ld(&bar[XB_XCNT(j)]); sum += c; cnt += (c > 0u) ? 1u : 0u; mine = (j == x) ? c : mine; }
        if (sum == G) break;
        __builtin_amdgcn_s_sleep(1);
        if ((++sp & 255u) == 0u) { if (xb_ld(&bar[XB_TMO])) break; if (sp > XB_SPIN_CAP) { atomicAdd(&bar[XB_TMO], 1u); break; } }
    }
    nloc = mine > 0u ? mine : 1u; nx = cnt > 0u ? cnt : 1u;
}
__device__ __forceinline__ void xcd_barrier(const XcdBarrier& b) {
    asm volatile("s_waitcnt vmcnt(0)" ::: "memory");
    __syncthreads();
    if (threadIdx.x == 0) {
        unsigned* bar = b.bar;
        __builtin_amdgcn_s_waitcnt(0);
        unsigned nloc = b.st[0], nx = b.st[1];
        if (nloc == 0u) { xcd_barrier_complete(bar, b.x, nloc, nx); b.st[0] = nloc; b.st[1] = nx; }
        const unsigned old = xb_add(&bar[XB_XSUB(b.x)], 1u);
        const unsigned gen = old / nloc;
        if (old + 1u == (gen + 1u) * nloc) {
            __builtin_amdgcn_fence(__ATOMIC_RELEASE, "agent");
            asm volatile("s_waitcnt vmcnt(0)" ::: "memory");
            const unsigned og = xb_add(&bar[XB_TOP], 1u);
            const unsigned tg = og / nx;
            if (og + 1u == (tg + 1u) * nx) xb_add(&bar[XB_TOPGEN], 1u);
            else XB_SPIN(xb_ld(&bar[XB_TOPGEN]) == tg, bar);
            __builtin_amdgcn_fence(__ATOMIC_ACQUIRE, "agent");
            xb_add(&bar[XB_XGEN(b.x)], 1u);
            asm volatile("s_waitcnt vmcnt(0)" ::: "memory");
        } else {
            XB_SPIN(xb_ld(&bar[XB_XGEN(b.x)]) == gen, bar);
            __builtin_amdgcn_fence(__ATOMIC_ACQUIRE, "agent");
            asm volatile("s_waitcnt vmcnt(0)" ::: "memory");
        }
    }
    __syncthreads();
}

namespace pg8 {
constexpr int BM = 256, BK = 64, HALF = 128, HTB = HALF * BK * 2, STAGE_BYTES = 8 * HTB, NXCD = 8, WGM = 8;
__host__ __device__ __forceinline__ int lds_byte(int r, int c) { const int st = (r >> 4) * 2 + (c >> 5), rr = r & 15, cc = c & 31, ob = rr * 64 + cc * 2; return st * 1024 + (ob ^ (((ob >> 9) & 1) << 5)); }
__host__ __device__ __forceinline__ void stage_rc(int b, int& R, int& C) { const int st = b / 1024, sb = b % 1024, swz = sb ^ (((sb >> 9) & 1) << 5); R = (st >> 1) * 16 + swz / 64; C = (st & 1) * 32 + (swz % 64) / 2; }
__host__ __device__ __forceinline__ int perm32(int rho) { const int n = rho >> 4, i = rho & 15; return 8 * (i >> 2) + 4 * n + (i & 3); }

struct Unit { int pm, pn, pa, z; };
struct Gemm { const bf16_t* A; const bf16_t* Bt; int K; size_t bz_stride; const int* rowidx; };

struct StaticOrder {
    int nM, nN, nwg, G, c;
    __device__ void init(int M, int N, int G_, int c_) { nM = M / BM; nN = N / BM; nwg = nM * nN; G = G_; c = c_; }
    __device__ bool next(int i, Unit& u) const {
        const long L = (long)i * G + c; if (L >= nwg) return false;
        int wgid = (int)L; { const int q = nwg / NXCD, r = nwg % NXCD, xcd = wgid % NXCD, off = wgid / NXCD; wgid = (xcd < r ? xcd * (q + 1) : r * (q + 1) + (xcd - r) * q) + off; }
        const int nig = WGM * nN, gid = wgid / nig, fm = gid * WGM, gsz = (nM - fm) < WGM ? (nM - fm) : WGM;
        u.pm = fm + ((wgid % nig) % gsz); u.pn = (wgid % nig) / gsz; u.pa = u.pm; u.z = 0; return true;
    }
};
struct KvOrder {
    int G, c;
    __device__ bool next(int i, Unit& u) const {
        const int L = i * G + c; if (L >= 256) return false;
        u.z = L >> 6; const int r = L & 63; u.pa = r >> 2; u.pn = r & 3; u.pm = u.z * 16 + u.pa; return true;
    }
};
struct MoeOrder {
    const int* mte; int G, c;
    __device__ bool next(int i, Unit& u) const {
        if ((G & 7) != 0) {
            const int nunits = mte[511] * 4;
            const int L = i * G + c; if (L >= nunits) return false;
            u.pm = L >> 2; u.pa = u.pm; u.pn = L & 3; u.z = mte[u.pm]; return true;
        }
        const int x = c & 7; int q = i * (G >> 3) + (c >> 3);
#pragma unroll
        for (int k = 0; k < 4; ++k) {
            const int e = x + 8 * k; const int m0 = mte[400 + e], m1 = mte[401 + e]; const int n = (m1 - m0) * 4;
            if (q < n) { u.pm = m0 + (q >> 2); u.pa = u.pm; u.pn = q & 3; u.z = e; return true; }
            q -= n;
        }
        return false;
    }
};

template <class Epi, class Sched, bool ALIGN_EPI = true, bool GATHER = false>
__device__ __forceinline__ void gemm_phase(LAS unsigned char* lds, const Gemm g, const Sched& S, const Epi& E) {
    int tid_ = threadIdx.x; asm volatile("" : "+v"(tid_));
    const int tid = tid_, wid = __builtin_amdgcn_readfirstlane(tid >> 6), lane = tid & 63, wr = wid >> 2, wc = wid & 3, fr = lane & 15, fq = lane >> 4;
    const int K = g.K, nt = K / BK;
    unsigned voffA[2], voffB[2], gcol[2]; int grow[2];
#pragma unroll
    for (int i = 0; i < 2; ++i) { int R, C; stage_rc(tid * 16 + i * 8192, R, C); const int Rb = ((R & ~31) + perm32(R & 31));
        voffA[i] = (unsigned)(R * K + C) * 2u; voffB[i] = (unsigned)(Rb * K + C) * 2u; grow[i] = R; gcol[i] = (unsigned)C * 2u; }
    const size_t kstep = (size_t)(BK * 2);
    const size_t hstep = (size_t)HALF * K * 2;
    const size_t tstep = 2 * hstep;
    const unsigned ldsw = (unsigned)wid * 1024u;
    const int aoff = lds_byte(wr * 64 + fr, fq * 8), boff = lds_byte(wc * 32 + fr, fq * 8);
#define PG8_SA(b, h) (((b) * 2 + (h)) * HTB)
#define PG8_SB(b, h) ((4 + (b) * 2 + (h)) * HTB)
#define PG8_STAGE(bufoff, gbase, voff) do { _Pragma("unroll") for (int _i = 0; _i < 2; ++_i) \
        __builtin_amdgcn_global_load_lds((const unsigned*)((const char*)(gbase) + (voff)[_i]), (LAS unsigned*)(lds + (bufoff) + ldsw + _i * 8192), 16, 0, 0); } while (0)
#define PG8_LDA(dst, b, h) do { _Pragma("unroll") for (int m = 0; m < 4; ++m) _Pragma("unroll") for (int k = 0; k < 2; ++k) dst[m][k] = *(const LAS bf16x8*)(lds + PG8_SA(b, h) + aoff + m * 2048 + k * 1024); } while (0)
#define PG8_LDB(dst, b, h) do { _Pragma("unroll") for (int n = 0; n < 2; ++n) _Pragma("unroll") for (int k = 0; k < 2; ++k) dst[n][k] = *(const LAS bf16x8*)(lds + PG8_SB(b, h) + boff + n * 2048 + k * 1024); } while (0)
#define PG8_MMA(ai, bj, At, Bt) do { __builtin_amdgcn_s_setprio(1); _Pragma("unroll") for (int m = 0; m < 4; ++m) _Pragma("unroll") for (int n = 0; n < 2; ++n) _Pragma("unroll") for (int k = 0; k < 2; ++k) \
        acc[ai][bj][m][n] = __builtin_amdgcn_mfma_f32_16x16x32_bf16(Bt[n][k], At[m][k], acc[ai][bj][m][n], 0, 0, 0); __builtin_amdgcn_s_setprio(0); } while (0)
#define PG8_WAIT_V(n) asm volatile("s_waitcnt vmcnt(" #n ")" ::: "memory")
#define PG8_WAIT_L(n) asm volatile("s_waitcnt lgkmcnt(" #n ")" ::: "memory")
#define PG8_BAR __builtin_amdgcn_s_barrier()
#define PG8_SCHED __builtin_amdgcn_sched_barrier(0)
#define PG8_APTR(u) ((const char*)g.A + (size_t)(u).pa * tstep)
#define PG8_BPTR(u) ((const char*)g.Bt + ((size_t)(u).z * g.bz_stride) * 2 + (size_t)(u).pn * tstep)
    Unit cur, nxt; int ui = 0;
    if (!S.next(0, cur)) return;
    f32x4 acc[2][2][4][2];
#pragma unroll
    for (int a = 0; a < 2; ++a)
#pragma unroll
        for (int b = 0; b < 2; ++b)
#pragma unroll
            for (int m = 0; m < 4; ++m)
#pragma unroll
                for (int n = 0; n < 2; ++n) acc[a][b][m][n] = (f32x4){0.f, 0.f, 0.f, 0.f};
    bf16x8 At[4][2], B0[2][2], B1[2][2];
    const char* cA = GATHER ? (const char*)g.A : PG8_APTR(cur); const char* cB = PG8_BPTR(cur);
    unsigned gcu[2][2] = {{0u, 0u}, {0u, 0u}}, gnx[2][2] = {{0u, 0u}, {0u, 0u}};
#define PG8_GOFF(dst, u) do { _Pragma("unroll") for (int h_ = 0; h_ < 2; ++h_) _Pragma("unroll") for (int i_ = 0; i_ < 2; ++i_) \
        dst[h_][i_] = (unsigned)g.rowidx[(u).pa * 256 + h_ * 128 + grow[i_]] * (unsigned)(K * 2) + gcol[i_]; } while (0)
    if constexpr (GATHER) PG8_GOFF(gcu, cur);
#define PG8_STAGE_A(bufoff, h_, nonGatherPtr, gatherBase, GO) do { if constexpr (GATHER) { PG8_STAGE(bufoff, gatherBase, GO[h_]); } else { PG8_STAGE(bufoff, nonGatherPtr, voffA); } } while (0)
    PG8_STAGE(PG8_SB(0, 0), cB, voffB); PG8_STAGE(PG8_SB(0, 1), cB + hstep, voffB); PG8_STAGE_A(PG8_SA(0, 0), 0, cA, cA, gcu); PG8_STAGE_A(PG8_SA(0, 1), 1, cA + hstep, cA, gcu);
    if (wr == 1) PG8_BAR;
    PG8_WAIT_V(2); PG8_BAR;
    PG8_STAGE(PG8_SB(1, 0), cB + kstep, voffB); PG8_STAGE_A(PG8_SA(1, 0), 0, cA + kstep, cA + kstep, gcu); PG8_STAGE(PG8_SB(1, 1), cB + hstep + kstep, voffB);
    PG8_WAIT_V(6); PG8_BAR;
    for (;;) {
        const bool has_next = S.next(ui + 1, nxt);
        const char* nA = GATHER ? cA : (has_next ? PG8_APTR(nxt) : cA); const char* nB = has_next ? PG8_BPTR(nxt) : cB;
        if constexpr (GATHER) { if (has_next) PG8_GOFF(gnx, nxt); else { _Pragma("unroll") for (int h_ = 0; h_ < 2; ++h_) _Pragma("unroll") for (int i_ = 0; i_ < 2; ++i_) gnx[h_][i_] = gcu[h_][i_]; } }
        for (int t = 0; t < nt; t += 2) {
            const bool last = (t == nt - 2);
            const char* a1 = cA + (size_t)(t + 1) * kstep;
            const char* a2 = last ? nA : cA + (size_t)(t + 2) * kstep; const char* b2 = last ? nB : cB + (size_t)(t + 2) * kstep;
            const char* a3 = a2 + kstep; const char* b3 = b2 + kstep;
            unsigned gse[2][2];
            _Pragma("unroll") for (int h_ = 0; h_ < 2; ++h_) _Pragma("unroll") for (int i_ = 0; i_ < 2; ++i_) gse[h_][i_] = last ? gnx[h_][i_] : gcu[h_][i_];
            PG8_LDB(B0, 0, 0); PG8_LDB(B1, 0, 1); PG8_SCHED; PG8_LDA(At, 0, 0); PG8_STAGE_A(PG8_SA(1, 1), 1, a1 + hstep, a1, gcu);
            PG8_WAIT_V(8); PG8_WAIT_L(0); PG8_BAR; PG8_MMA(0, 0, At, B0); PG8_MMA(0, 1, At, B1); PG8_BAR; PG8_SCHED;
            PG8_LDA(At, 0, 1); PG8_STAGE(PG8_SB(0, 0), b2, voffB); PG8_STAGE(PG8_SB(0, 1), b2 + hstep, voffB); PG8_STAGE_A(PG8_SA(0, 0), 0, a2, a2, gse);
            PG8_WAIT_V(8); PG8_WAIT_L(0); PG8_BAR; PG8_MMA(1, 0, At, B0); PG8_MMA(1, 1, At, B1); PG8_BAR; PG8_SCHED;
            PG8_LDB(B0, 1, 0); PG8_LDB(B1, 1, 1); PG8_SCHED; PG8_LDA(At, 1, 0); PG8_STAGE_A(PG8_SA(0, 1), 1, a2 + hstep, a2, gse);
            PG8_WAIT_V(8); PG8_WAIT_L(0); PG8_BAR; PG8_MMA(0, 0, At, B0); PG8_MMA(0, 1, At, B1); PG8_BAR; PG8_SCHED;
            PG8_LDA(At, 1, 1); PG8_STAGE(PG8_SB(1, 0), b3, voffB); PG8_STAGE(PG8_SB(1, 1), b3 + hstep, voffB); PG8_STAGE_A(PG8_SA(1, 0), 0, a3, a3, gse);
            PG8_WAIT_V(8); PG8_WAIT_L(0); PG8_BAR; PG8_MMA(1, 0, At, B0); PG8_MMA(1, 1, At, B1); PG8_BAR; PG8_SCHED;
        }
        if constexpr (ALIGN_EPI) { if (wr == 0) PG8_BAR; }
        E(acc, cur, wr, wc, fr, fq);
        if (!has_next) break;
#pragma unroll
        for (int a = 0; a < 2; ++a)
#pragma unroll
            for (int b = 0; b < 2; ++b)
#pragma unroll
                for (int m = 0; m < 4; ++m)
#pragma unroll
                    for (int n = 0; n < 2; ++n) acc[a][b][m][n] = (f32x4){0.f, 0.f, 0.f, 0.f};
        cur = nxt; cA = nA; cB = nB; ++ui;
        if constexpr (GATHER) { _Pragma("unroll") for (int h_ = 0; h_ < 2; ++h_) _Pragma("unroll") for (int i_ = 0; i_ < 2; ++i_) gcu[h_][i_] = gnx[h_][i_]; }
        if constexpr (ALIGN_EPI) { if (wr == 1) PG8_BAR; }
    }
    PG8_WAIT_V(0);
    if constexpr (!ALIGN_EPI) { if (wr == 0) PG8_BAR; }
    PG8_BAR;
#undef PG8_SA
#undef PG8_SB
#undef PG8_STAGE
#undef PG8_LDA
#undef PG8_LDB
#undef PG8_MMA
#undef PG8_WAIT_V
#undef PG8_WAIT_L
#undef PG8_BAR
#undef PG8_SCHED
#undef PG8_APTR
#undef PG8_BPTR
#undef PG8_GOFF
#undef PG8_STAGE_A
}

typedef const f32x4 (&AccRef)[2][2][4][2];

__device__ __forceinline__ float ss_part(const float* ss, size_t row, int fq) { const f32x4 s = *(const f32x4*)(ss + row * 16 + 4 * fq); return (s[0] + s[1]) + (s[2] + s[3]); }
__device__ __forceinline__ float ss_tot(float p) { p += __shfl_xor(p, 16); p += __shfl_xor(p, 32); return p; }
#define EPI_FENCE8(v) asm volatile("s_waitcnt vmcnt(0)" : "+v"((v)[0][0]), "+v"((v)[0][1]), "+v"((v)[0][2]), "+v"((v)[0][3]), "+v"((v)[1][0]), "+v"((v)[1][1]), "+v"((v)[1][2]), "+v"((v)[1][3]) :: "memory")
struct EpiScale {
    bf16_t* O; int ldc; const float* ss; int ssmask;
    __device__ __forceinline__ void operator()(AccRef acc, const Unit& u, int wr, int wc, int fr, int fq) const {
        float rv[2][4];
#pragma unroll
        for (int ai = 0; ai < 2; ++ai)
#pragma unroll
            for (int m = 0; m < 4; ++m) rv[ai][m] = ss_part(ss, (size_t)((u.pm * 256 + ai * 128 + wr * 64 + m * 16 + fr) & ssmask), fq);
#pragma unroll
        for (int ai = 0; ai < 2; ++ai)
#pragma unroll
            for (int m = 0; m < 4; ++m) rv[ai][m] = rsqrtf(ss_tot(rv[ai][m]) * (1.0f / 1024.0f) + 1e-6f);
        EPI_FENCE8(rv);
#pragma unroll
        for (int ai = 0; ai < 2; ++ai)
#pragma unroll
            for (int m = 0; m < 4; ++m) {
                const int row = u.pm * 256 + ai * 128 + wr * 64 + m * 16 + fr;
                const float rinv = rv[ai][m];
#pragma unroll
                for (int bj = 0; bj < 2; ++bj) {
                    const int col = u.pn * 256 + bj * 128 + wc * 32 + 8 * fq;
                    const f32x4 v0 = acc[ai][bj][m][0] * rinv, v1 = acc[ai][bj][m][1] * rinv;
                    u32x4 w; w.x = pk2(v0[0], v0[1]); w.y = pk2(v0[2], v0[3]); w.z = pk2(v1[0], v1[1]); w.w = pk2(v1[2], v1[3]);
                    *(u32x4*)(O + (size_t)row * ldc + col) = w;
                }
            }
    }
};
struct EpiProj {
    bf16_t* O; bf16_t* VT; const float* ss; const float* qg; const float* kg;
    __device__ __forceinline__ void operator()(AccRef acc, const Unit& u, int wr, int wc, int fr, int fq) const {
        float rv[2][4];
#pragma unroll
        for (int ai = 0; ai < 2; ++ai)
#pragma unroll
            for (int m = 0; m < 4; ++m) rv[ai][m] = ss_part(ss, (size_t)(u.pm * 256 + ai * 128 + wr * 64 + m * 16 + fr), fq);
        if (u.pn >= 7 && u.pn <= 10) {
            const bool isk = u.pn >= 9; const float* gp = isk ? kg : qg;
            const int head = ((u.pn - 7) & 1) * 4 + wc;
            f32x4 g00 = *(const f32x4*)(gp + 8 * fq), g01 = *(const f32x4*)(gp + 8 * fq + 4), g10 = *(const f32x4*)(gp + 32 + 8 * fq), g11 = *(const f32x4*)(gp + 32 + 8 * fq + 4);
            const float qsc = isk ? 1.0f : 0.18033688011112042f;
#pragma unroll
            for (int ai = 0; ai < 2; ++ai)
#pragma unroll
                for (int m = 0; m < 4; ++m) rv[ai][m] = ss_tot(rv[ai][m]) * (1.0f / 1024.0f) + 1e-6f;
            EPI_FENCE8(rv);
            asm volatile("" : "+v"(g00), "+v"(g01), "+v"(g10), "+v"(g11));
#pragma unroll
            for (int ai = 0; ai < 2; ++ai)
#pragma unroll
                for (int m = 0; m < 4; ++m) {
                    const int row = u.pm * 256 + ai * 128 + wr * 64 + m * 16 + fr;
                    const f32x4 a0 = acc[ai][0][m][0], a1 = acc[ai][0][m][1], b0 = acc[ai][1][m][0], b1 = acc[ai][1][m][1];
                    float sq = ((a0[0] * a0[0] + a0[1] * a0[1]) + (a0[2] * a0[2] + a0[3] * a0[3])) + ((a1[0] * a1[0] + a1[1] * a1[1]) + (a1[2] * a1[2] + a1[3] * a1[3]))
                             + ((b0[0] * b0[0] + b0[1] * b0[1]) + (b0[2] * b0[2] + b0[3] * b0[3])) + ((b1[0] * b1[0] + b1[1] * b1[1]) + (b1[2] * b1[2] + b1[3] * b1[3]));
                    sq += __shfl_xor(sq, 16); sq += __shfl_xor(sq, 32);
                    const float sc = rsqrtf(sq * (1.0f / 64.0f) + 1e-6f * rv[ai][m]) * qsc;
                    bf16_t* op = O + (size_t)row * INW + 1792 + (isk ? 512 : 0) + head * 64 + 8 * fq;
                    u32x4 w;
                    w.x = pk2(a0[0] * sc * g00[0], a0[1] * sc * g00[1]); w.y = pk2(a0[2] * sc * g00[2], a0[3] * sc * g00[3]); w.z = pk2(a1[0] * sc * g01[0], a1[1] * sc * g01[1]); w.w = pk2(a1[2] * sc * g01[2], a1[3] * sc * g01[3]);
                    *(u32x4*)op = w;
                    w.x = pk2(b0[0] * sc * g10[0], b0[1] * sc * g10[1]); w.y = pk2(b0[2] * sc * g10[2], b0[3] * sc * g10[3]); w.z = pk2(b1[0] * sc * g11[0], b1[1] * sc * g11[1]); w.w = pk2(b1[2] * sc * g11[2], b1[3] * sc * g11[3]);
                    *(u32x4*)(op + 32) = w;
                }
            return;
        }
#pragma unroll
        for (int ai = 0; ai < 2; ++ai)
#pragma unroll
            for (int m = 0; m < 4; ++m) rv[ai][m] = rsqrtf(ss_tot(rv[ai][m]) * (1.0f / 1024.0f) + 1e-6f);
        EPI_FENCE8(rv);
#pragma unroll
        for (int ai = 0; ai < 2; ++ai)
#pragma unroll
            for (int m = 0; m < 4; ++m) {
                const int row = u.pm * 256 + ai * 128 + wr * 64 + m * 16 + fr;
                const float rinv = rv[ai][m];
#pragma unroll
                for (int bj = 0; bj < 2; ++bj) {
                    const int col = u.pn * 256 + bj * 128 + wc * 32 + 8 * fq;
                    const f32x4 v0 = acc[ai][bj][m][0] * rinv, v1 = acc[ai][bj][m][1] * rinv;
                    u32x4 w; w.x = pk2(v0[0], v0[1]); w.y = pk2(v0[2], v0[3]); w.z = pk2(v1[0], v1[1]); w.w = pk2(v1[2], v1[3]);
                    if (u.pn < 11) *(u32x4*)(O + (size_t)row * INW + col) = w;
                    else {
                        const int cv = col - 2816;
                        const int sq_ = row & 2047;
                        const int sp_ = (sq_ & ~31) | (((sq_ >> 2) & 3) << 3) | (((sq_ >> 4) & 1) << 2) | (sq_ & 3);
                        bf16_t* vp = VT + ((size_t)((row >> 11) * 8 + (cv >> 6)) * 64 + (cv & 63)) * 2048 + sp_;
#pragma unroll
                        for (int e = 0; e < 4; ++e) { vp[(size_t)(2 * e) * 2048] = (bf16_t)(w[e] & 0xffffu); vp[(size_t)(2 * e + 1) * 2048] = (bf16_t)(w[e] >> 16); }
                    }
                }
            }
    }
};
struct EpiRes {
    bf16_t* XB; float* SS;
    __device__ __forceinline__ void operator()(AccRef acc, const Unit& u, int wr, int wc, int fr, int fq) const {
        u32x4 xin[2][2][4];
#pragma unroll
        for (int ai = 0; ai < 2; ++ai)
#pragma unroll
            for (int m = 0; m < 4; ++m)
#pragma unroll
                for (int bj = 0; bj < 2; ++bj)
                    xin[bj][ai][m] = *(const u32x4*)(XB + (size_t)(u.pm * 256 + ai * 128 + wr * 64 + m * 16 + fr) * 1024 + u.pn * 256 + bj * 128 + wc * 32 + 8 * fq);
        EPI_FENCE8(xin[0]);
        asm volatile("" : "+v"(xin[1][0][0]), "+v"(xin[1][0][1]), "+v"(xin[1][0][2]), "+v"(xin[1][0][3]), "+v"(xin[1][1][0]), "+v"(xin[1][1][1]), "+v"(xin[1][1][2]), "+v"(xin[1][1][3]));
#pragma unroll
        for (int ai = 0; ai < 2; ++ai)
#pragma unroll
            for (int m = 0; m < 4; ++m) {
                const int row = u.pm * 256 + ai * 128 + wr * 64 + m * 16 + fr;
                float sq = 0.f;
#pragma unroll
                for (int bj = 0; bj < 2; ++bj) {
                    const int col = u.pn * 256 + bj * 128 + wc * 32 + 8 * fq;
                    u32x4* xp = (u32x4*)(XB + (size_t)row * 1024 + col);
                    const u32x4 xw = xin[bj][ai][m];
                    f32x4 x0 = {lo16(xw.x), hi16(xw.x), lo16(xw.y), hi16(xw.y)}, x1 = {lo16(xw.z), hi16(xw.z), lo16(xw.w), hi16(xw.w)};
                    x0 += acc[ai][bj][m][0]; x1 += acc[ai][bj][m][1];
                    u32x4 w; w.x = pk2(x0[0], x0[1]); w.y = pk2(x0[2], x0[3]); w.z = pk2(x1[0], x1[1]); w.w = pk2(x1[2], x1[3]);
                    *xp = w;
                    x0 = (f32x4){lo16(w.x), hi16(w.x), lo16(w.y), hi16(w.y)}; x1 = (f32x4){lo16(w.z), hi16(w.z), lo16(w.w), hi16(w.w)};
                    sq += (x0[0] * x0[0] + x0[1] * x0[1]) + (x0[2] * x0[2] + x0[3] * x0[3]) + (x1[0] * x1[0] + x1[1] * x1[1]) + (x1[2] * x1[2] + x1[3] * x1[3]);
                }
                sq += __shfl_xor(sq, 16); sq += __shfl_xor(sq, 32);
                if (fq == 0) SS[(size_t)row * 16 + u.pn * 4 + wc] = sq;
            }
    }
};
struct EpiGU {
    bf16_t* H; const float* rinv;
    __device__ __forceinline__ void operator()(AccRef acc, const Unit& u, int wr, int wc, int fr, int fq) const {
        float rv[2][4];
#pragma unroll
        for (int ai = 0; ai < 2; ++ai)
#pragma unroll
            for (int m = 0; m < 4; ++m) rv[ai][m] = rinv[u.pm * 256 + ai * 128 + wr * 64 + m * 16 + fr];
        EPI_FENCE8(rv);
#pragma unroll
        for (int ai = 0; ai < 2; ++ai)
#pragma unroll
            for (int m = 0; m < 4; ++m) {
                const int row = u.pm * 256 + ai * 128 + wr * 64 + m * 16 + fr;
                const float rs = rv[ai][m];
                float h[8];
#pragma unroll
                for (int n = 0; n < 2; ++n)
#pragma unroll
                    for (int j = 0; j < 4; ++j) { const float gt = acc[ai][0][m][n][j] * rs, up = acc[ai][1][m][n][j] * rs; h[n * 4 + j] = gt * __builtin_amdgcn_rcpf(1.0f + __expf(-gt)) * up; }
                u32x4 w; w.x = pk2(h[0], h[1]); w.y = pk2(h[2], h[3]); w.z = pk2(h[4], h[5]); w.w = pk2(h[6], h[7]);
                *(u32x4*)(H + (size_t)row * 512 + u.pn * 128 + wc * 32 + 8 * fq) = w;
            }
    }
};
struct EpiDown {
    bf16_t* Y; const int* slot; const float* sw;
    __device__ __forceinline__ void operator()(AccRef acc, const Unit& u, int wr, int wc, int fr, int fq) const {
        int sl[2][4]; float wv[2][4];
#pragma unroll
        for (int ai = 0; ai < 2; ++ai)
#pragma unroll
            for (int m = 0; m < 4; ++m) { const int row = u.pm * 256 + ai * 128 + wr * 64 + m * 16 + fr; sl[ai][m] = slot[row]; wv[ai][m] = sw[row]; }
        EPI_FENCE8(sl);
        asm volatile("" : "+v"(wv[0][0]), "+v"(wv[0][1]), "+v"(wv[0][2]), "+v"(wv[0][3]), "+v"(wv[1][0]), "+v"(wv[1][1]), "+v"(wv[1][2]), "+v"(wv[1][3]));
#pragma unroll
        for (int ai = 0; ai < 2; ++ai)
#pragma unroll
            for (int m = 0; m < 4; ++m) {
                const int s = sl[ai][m]; const float wgt = wv[ai][m];
                if (s >= 0) {
#pragma unroll
                    for (int bj = 0; bj < 2; ++bj) {
                        const int col = u.pn * 256 + bj * 128 + wc * 32 + 8 * fq;
                        const f32x4 v0 = acc[ai][bj][m][0] * wgt, v1 = acc[ai][bj][m][1] * wgt;
                        u32x4 w; w.x = pk2(v0[0], v0[1]); w.y = pk2(v0[2], v0[3]); w.z = pk2(v1[0], v1[1]); w.w = pk2(v1[2], v1[3]);
                        *(u32x4*)(Y + (size_t)s * 1024 + col) = w;
                    }
                }
            }
    }
};
}

#define WSP(type, off) ((type*)(a.ws + (off)))
__device__ __forceinline__ int oblk() { int t = blockIdx.x; asm volatile("" : "+s"(t)); return t; }
__device__ __forceinline__ int ogrid() { int t = gridDim.x; asm volatile("" : "+s"(t)); return t; }
__device__ __forceinline__ int otid() { int t = threadIdx.x; asm volatile("" : "+v"(t)); return t; }
constexpr int LDS_INTAB = LDS_MISC + 14336;
__device__ __forceinline__ const float* ldsin(LAS unsigned char* lds, int i) {
    const unsigned long long p = ((const LAS unsigned long long*)(lds + LDS_INTAB))[i];
    const unsigned lo = __builtin_amdgcn_readfirstlane((unsigned)p), hi = __builtin_amdgcn_readfirstlane((unsigned)(p >> 32));
    return (const float*)(__attribute__((address_space(1))) const float*)(((unsigned long long)hi << 32) | lo);
}
#define INP(i) ldsin(lds, (i))

template <int MAP>
__device__ __forceinline__ void conv_slab(const float* __restrict__ src, int N, int Kper, bf16_t* __restrict__ dst, size_t estride,
                                          const float* __restrict__ gain, int goff, LAS float* tile, int slab) {
    const int tid = otid();
    const int nsn = N >> 8;
    const int kt = slab / nsn, ns = slab - kt * nsn, k0 = kt * 64, n0 = ns * 256;
    const int e = k0 / Kper, kl0 = k0 - e * Kper;
    f32x4 v[8];
#pragma unroll
    for (int i = 0; i < 8; ++i) { const int idx = tid + i * 512, kk = idx >> 6, n4 = (idx & 63) * 4; v[i] = *(const f32x4*)(src + (size_t)(k0 + kk) * N + n0 + n4); }
#pragma unroll
    for (int i = 0; i < 8; ++i) {
        const int idx = tid + i * 512, kk = idx >> 6, n4 = (idx & 63) * 4;
        float gsc = 1.0f;
        if (gain != nullptr && kl0 + kk >= goff) gsc = gain[kl0 + kk - goff];
        LAS float* tp = tile + kk * 257 + n4;
        tp[0] = v[i][0] * gsc; tp[1] = v[i][1] * gsc; tp[2] = v[i][2] * gsc; tp[3] = v[i][3] * gsc;
    }
    __syncthreads();
#pragma unroll
    for (int i = 0; i < 4; ++i) {
        const int p = tid + i * 512, nn = p >> 3, kg = p & 7;
        float x[8];
#pragma unroll
        for (int j = 0; j < 8; ++j) x[j] = tile[(kg * 8 + j) * 257 + nn];
        const int n = n0 + nn;
        int nr;
        if (MAP == 0) nr = n;
        else if (MAP == 3) { const int pn_ = n >> 8, wi = n & 255;
            nr = (pn_ >= 7 && pn_ <= 10) ? pn_ * 256 + ((wi & 63) >> 5) * 128 + (wi >> 6) * 32 + (wi & 31) : n; }
        else nr = (n >> 7) * 256 + (n & 127) + (MAP == 2 ? 128 : 0);
        u32x4 w; w.x = pk2(x[0], x[1]); w.y = pk2(x[2], x[3]); w.z = pk2(x[4], x[5]); w.w = pk2(x[6], x[7]);
        *(u32x4*)(dst + (size_t)e * estride + (size_t)nr * Kper + kl0 + kg * 8) = w;
    }
    __syncthreads();
}
template <int MAP>
__device__ __forceinline__ void conv_T(const float* __restrict__ src, int Ktot, int N, int Kper, bf16_t* __restrict__ dst, size_t estride,
                                       const float* __restrict__ gain, int goff, LAS float* tile) {
    const int nslab = (Ktot >> 6) * (N >> 8);
    for (int sl = oblk(); sl < nslab; sl += ogrid()) conv_slab<MAP>(src, N, Kper, dst, estride, gain, goff, tile, sl);
}
constexpr int MOE_CONV_ITEMS = 3 * 128;
__device__ __forceinline__ void moe_convert_item(const PA a, int l, LAS unsigned char* lds, int item) {
    LAS float* tile = (LAS float*)lds;
    const int which = item >> 7, s0 = (item & 127) * 8;
    const float* gn = INP(30) + l * 1024;
    for (int sl = s0; sl < s0 + 8; ++sl) {
        if (which == 0)      conv_slab<1>(INP(35) + (size_t)l * 32 * 1024 * 512, 512, 1024, WSP(bf16_t, WS_WGU), (size_t)1024 * 1024, gn, 0, tile, sl);
        else if (which == 1) conv_slab<2>(INP(36) + (size_t)l * 32 * 1024 * 512, 512, 1024, WSP(bf16_t, WS_WGU), (size_t)1024 * 1024, gn, 0, tile, sl);
        else                 conv_slab<0>(INP(37) + (size_t)l * 32 * 512 * 1024, 1024, 512, WSP(bf16_t, WS_WD), (size_t)1024 * 512, nullptr, 0, tile, sl);
    }
}

__device__ __forceinline__ void rows_convert(const float* __restrict__ src, float* __restrict__ dstf, bf16_t* __restrict__ dstb, float* __restrict__ ss, int nrows) {
    const int wave = otid() >> 6, lane = otid() & 63;
    for (int r = oblk() * 8 + wave; r < nrows; r += ogrid() * 8) {
        float sq = 0.f;
#pragma unroll
        for (int i = 0; i < 4; ++i) {
            const int c = i * 256 + lane * 4;
            const f32x4 v = *(const f32x4*)(src + (size_t)r * 1024 + c);
            if (dstf) *(f32x4*)(dstf + (size_t)r * 1024 + c) = v;
            u32x2 w; w.x = pk2(v[0], v[1]); w.y = pk2(v[2], v[3]);
            *(u32x2*)(dstb + (size_t)r * 1024 + c) = w;
            sq += (v[0] * v[0] + v[1] * v[1]) + (v[2] * v[2] + v[3] * v[3]);
        }
        sq = wsum(sq);
        if (lane < 16) ss[(size_t)r * 16 + lane] = (lane == 0) ? sq : 0.f;
    }
}

__device__ __forceinline__ void p0_prologue(const PA a, LAS unsigned char* lds) {
    LAS float* tile = (LAS float*)lds;
    for (int l = 0; l < NL; ++l) {
        conv_T<3>(INP(3) + (size_t)l * 1024 * INW, 1024, INW, 1024, WSP(bf16_t, WS_WIN) + (size_t)l * INW * 1024, 0, INP(2) + l * 1024, 0, tile);
        conv_T<0>(INP(22) + (size_t)l * 1024 * 1024, 1024, 1024, 1024, WSP(bf16_t, WS_WOUT) + (size_t)l * 1024 * 1024, 0, INP(21) + l * 512, 512, tile);
        conv_T<0>(INP(25) + (size_t)l * 1024 * 512, 1024, 512, 1024, WSP(bf16_t, WS_WQ) + (size_t)l * 512 * 1024, 0, INP(23) + l * 1024, 0, tile);
        conv_T<0>(INP(26) + (size_t)l * 1024 * 1024, 1024, 1024, 1024, WSP(bf16_t, WS_WKV) + (size_t)l * 1024 * 1024, 0, INP(24) + l * 1024, 0, tile);
        conv_T<0>(INP(27) + (size_t)l * 512 * 1024, 512, 1024, 512, WSP(bf16_t, WS_WO) + (size_t)l * 1024 * 512, 0, nullptr, 0, tile);
    }
    {
        bf16_t* wrh = WSP(bf16_t, WS_WRH); bf16_t* wrl = WSP(bf16_t, WS_WRL);
        for (int idx = oblk() * 512 + otid(); idx < NL * 48 * 1024; idx += ogrid() * 512) {
            const int k = idx & 1023, r = (idx >> 10) % 48, l = idx / (48 * 1024);
            float w;
            if (r < 16) w = INP(31)[((size_t)l * 1024 + k) * 4 + (r & 3)];
            else { const int ri = ((r >> 2) & 3) * 8 + ((r >> 4) - 1) * 4 + (r & 3); w = INP(33)[((size_t)l * 1024 + k) * 32 + ri]; }
            w *= INP(30)[l * 1024 + k];
            const bf16_t hi = f2bf(w);
            wrh[idx] = hi; wrl[idx] = f2bf(w - bf2f(hi));
        }
    }
    {
        const int gt = oblk() * 512 + otid(), gs = ogrid() * 512;
        for (int e = gt; e < 16 * 8192; e += gs) { const int im = e >> 13, idx = e & 8191, ch = idx & 127, k = idx >> 7, l = im >> 2, chb = (im & 3) * 128;
            bf16_t* ib = (bf16_t*)(a.ws + WS_PBI + (size_t)im * PBI_BYTES);
            ib[ch * 72 + k] = f2bf(INP(6)[(size_t)l * 64 * 512 + k * 512 + chb + ch]); ib[9216 + ch * 72 + k] = f2bf(INP(8)[(size_t)l * 64 * 512 + k * 512 + chb + ch]); }
        for (int e = gt; e < 16 * 16384; e += gs) { const int im = e >> 14, idx = e & 16383, ch = idx & 127, k = idx >> 7, l = im >> 2, chb = (im & 3) * 128;
            bf16_t* ib = (bf16_t*)(a.ws + WS_PBI + (size_t)im * PBI_BYTES);
            ib[18432 + ch * 136 + k] = f2bf(INP(9)[(size_t)l * 128 * 512 + k * 512 + chb + ch]); }
        for (int e = gt; e < 16 * 4096; e += gs) { const int im = e >> 12, idx = e & 4095, ch = idx & 127, k = idx >> 7, l = im >> 2, chb = (im & 3) * 128;
            bf16_t* ib = (bf16_t*)(a.ws + WS_PBI + (size_t)im * PBI_BYTES);
            ib[35840 + ch * 40 + k] = l > 0 ? f2bf(INP(17)[(size_t)(l - 1) * 32 * 512 + k * 512 + chb + ch]) : (bf16_t)0; }
        for (int e = gt; e < 16 * 16384; e += gs) { const int im = e >> 14, idx = e & 16383, n = idx & 31, k = idx >> 5, l = im >> 2;
            bf16_t* ib = (bf16_t*)(a.ws + WS_PBI + (size_t)im * PBI_BYTES);
            ib[40960 + n * 520 + k] = l > 0 ? f2bf(INP(16)[(size_t)(l - 1) * 512 * 32 + k * 32 + n]) : (bf16_t)0; }
        for (int e = gt; e < 16 * 1920; e += gs) { const int im = e / 1920, idx = e - im * 1920, l = im >> 2, chb = (im & 3) * 128;
            float* fb = (float*)(a.ws + WS_PBI + (size_t)im * PBI_BYTES + 115200);
            float v;
            if (idx < 1152) { const int arr = idx >> 7, cc = chb + (idx & 127);
                v = arr == 0 ? INP(4)[l * 1792 + cc] : arr == 1 ? INP(4)[l * 1792 + 512 + cc] : arr == 2 ? INP(4)[l * 1792 + 1024 + cc] : arr == 3 ? INP(5)[l * 512 + cc]
                  : arr == 4 ? INP(7)[l * 512 + cc] : arr == 5 ? INP(10)[l * 512 + cc] : arr == 6 ? INP(11)[l * 512 + cc] : arr == 7 ? (l > 0 ? INP(15)[(l - 1) * 512 + cc] : 0.f) : INP(12)[l * 512 + cc]; }
            else v = INP(4)[l * 1792 + 1024 + (idx - 1152)];
            fb[idx] = v; }
    }
    rows_convert(INP(0), nullptr, WSP(bf16_t, WS_XB), WSP(float, WS_SS), T);
    rows_convert(INP(1), nullptr, WSP(bf16_t, WS_MEMB), WSP(float, WS_MEMSS), MROWS);
}

__device__ __forceinline__ void p2_knorm(const PA a, LAS unsigned char* lds) {
    const int wave = otid() >> 6, lane = otid() & 63;
    bf16_t* kv = WSP(bf16_t, WS_KV);
    for (int it = oblk() * 8 + wave; it < NL * MROWS * 4; it += ogrid() * 8) {
        const int h = it & 3, row = (it >> 2) & (MROWS - 1), l = it >> 14;
        unsigned* p = (unsigned*)(kv + ((size_t)l * MROWS + row) * 1024 + h * 128 + lane * 2);
        const unsigned w = *p; const float x0 = lo16(w), x1 = hi16(w);
        const float ssq = wsum(x0 * x0 + x1 * x1);
        const float rinv = rsqrtf(ssq * (1.0f / 128.0f) + 1e-6f);
        const float* gk = INP(29) + l * 128 + lane * 2;
        *p = pk2(x0 * rinv * gk[0], x1 * rinv * gk[1]);
    }
    bf16_t* vtx = WSP(bf16_t, WS_VTX);
    const int tid = otid();
    for (int it = oblk(); it < NL * 16 * 4; it += ogrid()) {
        const int h = it & 3, b = (it >> 2) & 15, l = it >> 6;
        const bf16_t* src = kv + ((size_t)l * MROWS + b * 256) * 1024 + 512 + h * 128;
        bf16_t* dst = vtx + (size_t)it * 128 * 256;
#pragma unroll 1
        for (int i = 0; i < 8; ++i) {
            const int p = tid + i * 512, d = p & 127, m8 = (p >> 7) * 8;
            unsigned short x[8];
#pragma unroll
            for (int j = 0; j < 8; ++j) x[j] = src[(size_t)(m8 + j) * 1024 + d];
            u32x4 w; w.x = x[0] | ((unsigned)x[1] << 16); w.y = x[2] | ((unsigned)x[3] << 16); w.z = x[4] | ((unsigned)x[5] << 16); w.w = x[6] | ((unsigned)x[7] << 16);
            *(u32x4*)(dst + (size_t)d * 256 + m8) = w;
        }
    }
}

__device__ __forceinline__ float fast_tanh(float x) { return 1.0f - 2.0f * __builtin_amdgcn_rcpf(1.0f + __expf(2.0f * x)); }
__device__ __forceinline__ float fast_sigmoid(float x) { return __builtin_amdgcn_rcpf(1.0f + __expf(-x)); }
template <int MODE>
__device__ __forceinline__ bf16x8 mixfrag(const bf16_t* pu, const bf16_t* pp, float hpf, unsigned mub, int colc, int col) {
    const u32x4 u = *(const u32x4*)(pu + col), p = *(const u32x4*)(pp + col);
    const f32x4 m0 = *(const LAS f32x4*)(unsigned long long)(mub + (unsigned)colc * 4u), m1 = *(const LAS f32x4*)(unsigned long long)(mub + (unsigned)colc * 4u + 16u);
    float x[8];
#pragma unroll
    for (int j = 0; j < 4; ++j) {
        const float u0 = lo16(u[j]), u1 = hi16(u[j]), p0 = lo16(p[j]) * hpf, p1 = hi16(p[j]) * hpf;
        const float ma = (j < 2) ? m0[2 * j] : m1[2 * j - 4], mb = (j < 2) ? m0[2 * j + 1] : m1[2 * j - 3];
        x[2 * j] = u0 + ma * (p0 - u0); x[2 * j + 1] = u1 + mb * (p1 - u1);
    }
#pragma unroll
    for (int j = 0; j < 8; ++j) { if (MODE == 1) x[j] = fast_tanh(x[j]); if (MODE == 2) x[j] = fast_sigmoid(x[j]); }
    u32x4 w; w.x = pk2(x[0], x[1]); w.y = pk2(x[2], x[3]); w.z = pk2(x[4], x[5]); w.w = pk2(x[6], x[7]);
    return __builtin_bit_cast(bf16x8, w);
}
__device__ __forceinline__ void pb_prep(const PA a, int l, LAS unsigned char* lds) {
    const int tid = otid(), wave = __builtin_amdgcn_readfirstlane(tid >> 6), lane0 = tid & 63, fr0 = lane0 & 15, fq0 = lane0 >> 4;
    const int G = ogrid(), blk = oblk();
    LAS bf16_t* s_w2 = (LAS bf16_t*)lds;
    LAS bf16_t* s_a2 = (LAS bf16_t*)(lds + 18432);
    LAS bf16_t* s_g2 = (LAS bf16_t*)(lds + 36864);
    LAS bf16_t* s_v2 = (LAS bf16_t*)(lds + 71680);
    LAS bf16_t* s_v1 = (LAS bf16_t*)(lds + 81920);
    LAS float* s_par = (LAS float*)(lds + 115200);
    LAS float* s_mux = s_par + 1152;
    bf16_t* proj = WSP(bf16_t, WS_PROJ);
    const float* mu = INP(4) + l * 1792;
    const float* w0 = INP(5) + l * 512;  const float* w2 = INP(6) + (size_t)l * 64 * 512;
    const float* a0 = INP(7) + l * 512;  const float* a2 = INP(8) + (size_t)l * 64 * 512;
    const float* g2 = INP(9) + (size_t)l * 128 * 512;
    const float* kkw = INP(10) + l * 512; const float* kaw = INP(11) + l * 512;
    const int lv = l > 0 ? l - 1 : 0;
    const float* v0 = INP(15) + lv * 512; const float* v1 = INP(16) + (size_t)lv * 512 * 32; const float* v2 = INP(17) + (size_t)lv * 32 * 512;
    const float* qgn = INP(18) + l * 64; const float* kgn = INP(19) + l * 64;
    bf16_t* SR = WSP(bf16_t, WS_SR); bf16_t* SK = WSP(bf16_t, WS_SK); bf16_t* SV = WSP(bf16_t, WS_SV);
    bf16_t* SA = WSP(bf16_t, WS_SA); bf16_t* SB = WSP(bf16_t, WS_SB); bf16_t* SG = WSP(bf16_t, WS_SG);
    bf16_t* SWD = WSP(bf16_t, WS_SWD); bf16_t* VF = WSP(bf16_t, WS_VF);
    int cur_hp = -1;
    for (int item = blk; item < 4 * (T / 128); item += G) {
        const int hp = item & 3, tt = item >> 2;
        if (hp != cur_hp) {
            __syncthreads();
            const unsigned char* img = a.ws + WS_PBI + (size_t)(l * 4 + hp) * PBI_BYTES;
            for (int p = tid; p < PBI_BYTES / 16; p += 512) *(LAS u32x4*)(lds + p * 16) = *(const u32x4*)(img + (size_t)p * 16);
            __syncthreads();
            cur_hp = hp;
        }
        const int lane = otid() & 63, fr = lane & 15, fq = lane >> 4;
        const int t = tt * 128 + wave * 16 + fr;
        const bool hpv = (t & (SEQ - 1)) != 0;
        const bf16_t* pu = proj + (size_t)t * INW;
        const bf16_t* pp = hpv ? pu - INW : pu;
        const float hpf = hpv ? 1.0f : 0.0f;
        unsigned mub = (unsigned)(unsigned long long)s_mux - 4096u + (unsigned)(fq * 32); asm volatile("" : "+v"(mub));
        bf16x8 fwl[2], fal[2], fgl[4], ft32;
#pragma unroll
        for (int s = 0; s < 2; ++s) { fwl[s] = mixfrag<1>(pu, pp, hpf, mub, 1536 + 32 * s, 1536 + 32 * s + 8 * fq); fal[s] = mixfrag<0>(pu, pp, hpf, mub, 1600 + 32 * s, 1600 + 32 * s + 8 * fq); }
#pragma unroll
        for (int s = 0; s < 4; ++s) fgl[s] = mixfrag<2>(pu, pp, hpf, mub, 1664 + 32 * s, 1664 + 32 * s + 8 * fq);
        {
#pragma unroll
            for (int n8 = 0; n8 < 8; ++n8) {
                f32x4 ag = {0.f, 0.f, 0.f, 0.f};
#pragma unroll
                for (int s = 0; s < 4; ++s) ag = __builtin_amdgcn_mfma_f32_16x16x32_bf16(*(const LAS bf16x8*)(s_g2 + (n8 * 16 + fr) * 136 + 32 * s + 8 * fq), fgl[s], ag, 0, 0, 0);
                u32x2 w; w.x = pk2(ag[0], ag[1]); w.y = pk2(ag[2], ag[3]); *(u32x2*)(SG + (size_t)t * 512 + hp * 128 + n8 * 16 + 4 * fq) = w;
            }
        }
        ft32 = fwl[0];
        if (l > 0) {
            f32x4 c0 = {0.f, 0.f, 0.f, 0.f}, c1 = {0.f, 0.f, 0.f, 0.f};
#pragma unroll 8
            for (int s = 0; s < 16; ++s) {
                const bf16x8 xf = mixfrag<0>(pu, pp, hpf, mub, 1024 + 32 * s, 1024 + 32 * s + 8 * fq);
                const bf16x8 wa = *(const LAS bf16x8*)(s_v1 + fr * 520 + 32 * s + 8 * fq), wb = *(const LAS bf16x8*)(s_v1 + (16 + fr) * 520 + 32 * s + 8 * fq);
                c0 = __builtin_amdgcn_mfma_f32_16x16x32_bf16(wa, xf, c0, 0, 0, 0);
                c1 = __builtin_amdgcn_mfma_f32_16x16x32_bf16(wb, xf, c1, 0, 0, 0);
            }
            u32x4 w; w.x = pk2(c0[0], c0[1]); w.y = pk2(c0[2], c0[3]); w.z = pk2(c1[0], c1[1]); w.w = pk2(c1[2], c1[3]);
            ft32 = __builtin_bit_cast(bf16x8, w);
        }
#pragma unroll 1
        for (int hh = 0; hh < 2; ++hh) {
            float atu[4][4], btu[4][4];
            u32x2 hR[4], hK[4], hV[4];
            float kss = 0.f, bsum = 0.f;
            const int t0w = tt * 128 + wave * 16, hd = hp * 2 + hh;
            const int cid = ((t0w >> 11) * 8 + hd) * 128 + ((t0w & (SEQ - 1)) >> 4);
#define DPP1(x, ctrl) __int_as_float(__builtin_amdgcn_update_dpp(0x3f800000, __float_as_int(x), (ctrl), 0xF, 0xF, false))
            u32x2 Lur[4], Lpr[4], Luk[4], Lpk[4], Luv[4], Lpv[4], Lvf[4];
#pragma unroll
            for (int nt = 0; nt < 4; ++nt) {
                if ((nt & 1) == 0) {
#pragma unroll
                    for (int n2 = nt; n2 < nt + 2; ++n2) {
                        const int c4 = hp * 128 + hh * 64 + n2 * 16 + 4 * fq;
                        Lur[n2] = *(const u32x2*)(pu + c4); Lpr[n2] = *(const u32x2*)(pp + c4);
                        Luk[n2] = *(const u32x2*)(pu + 512 + c4); Lpk[n2] = *(const u32x2*)(pp + 512 + c4);
                        Luv[n2] = *(const u32x2*)(pu + 1024 + c4); Lpv[n2] = *(const u32x2*)(pp + 1024 + c4);
                        Lvf[n2] = (l > 0) ? *(const u32x2*)(VF + (size_t)t * 512 + c4) : (u32x2){0u, 0u};
                    }
                    __builtin_amdgcn_sched_barrier(0);
                }
                const int lc = hh * 64 + nt * 16, ch4 = hp * 128 + lc + 4 * fq;
                f32x4 aw = {0.f, 0.f, 0.f, 0.f}, aa = aw, az = aw;
#pragma unroll
                for (int s = 0; s < 2; ++s) {
                    aw = __builtin_amdgcn_mfma_f32_16x16x32_bf16(*(const LAS bf16x8*)(s_w2 + (lc + fr) * 72 + 32 * s + 8 * fq), fwl[s], aw, 0, 0, 0);
                    aa = __builtin_amdgcn_mfma_f32_16x16x32_bf16(*(const LAS bf16x8*)(s_a2 + (lc + fr) * 72 + 32 * s + 8 * fq), fal[s], aa, 0, 0, 0);
                }
                if (l > 0) {
                    const u32x2 q0 = *(const LAS u32x2*)(s_v2 + (lc + fr) * 40 + 4 * fq), q1 = *(const LAS u32x2*)(s_v2 + (lc + fr) * 40 + 16 + 4 * fq);
                    u32x4 w; w.x = q0.x; w.y = q0.y; w.z = q1.x; w.w = q1.y;
                    az = __builtin_amdgcn_mfma_f32_16x16x32_bf16(__builtin_bit_cast(bf16x8, w), ft32, az, 0, 0, 0);
                }
                const u32x2 ur = Lur[nt], pr = Lpr[nt], uk = Luk[nt], pk = Lpk[nt], uv = Luv[nt], pv = Lpv[nt];
                const int pc4 = lc + 4 * fq;
                const f32x4 mr = *(const LAS f32x4*)(s_par + pc4), mk = *(const LAS f32x4*)(s_par + 128 + pc4), mv = *(const LAS f32x4*)(s_par + 256 + pc4);
                const f32x4 w0v = *(const LAS f32x4*)(s_par + 384 + pc4), a0v = *(const LAS f32x4*)(s_par + 512 + pc4), kkwv = *(const LAS f32x4*)(s_par + 640 + pc4), kawv = *(const LAS f32x4*)(s_par + 768 + pc4);
                float xr[4], xk[4], xv[4];
                { const float u0 = lo16(ur.x), u1 = hi16(ur.x), u2 = lo16(ur.y), u3 = hi16(ur.y);
                  xr[0] = u0 + mr[0] * (lo16(pr.x) * hpf - u0); xr[1] = u1 + mr[1] * (hi16(pr.x) * hpf - u1); xr[2] = u2 + mr[2] * (lo16(pr.y) * hpf - u2); xr[3] = u3 + mr[3] * (hi16(pr.y) * hpf - u3); }
                { const float u0 = lo16(uk.x), u1 = hi16(uk.x), u2 = lo16(uk.y), u3 = hi16(uk.y);
                  xk[0] = u0 + mk[0] * (lo16(pk.x) * hpf - u0); xk[1] = u1 + mk[1] * (hi16(pk.x) * hpf - u1); xk[2] = u2 + mk[2] * (lo16(pk.y) * hpf - u2); xk[3] = u3 + mk[3] * (hi16(pk.y) * hpf - u3); }
                { const float u0 = lo16(uv.x), u1 = hi16(uv.x), u2 = lo16(uv.y), u3 = hi16(uv.y);
                  xv[0] = u0 + mv[0] * (lo16(pv.x) * hpf - u0); xv[1] = u1 + mv[1] * (hi16(pv.x) * hpf - u1); xv[2] = u2 + mv[2] * (lo16(pv.y) * hpf - u2); xv[3] = u3 + mv[3] * (hi16(pv.y) * hpf - u3); }
                const size_t o = (size_t)t * 512 + ch4;
                if (l > 0) {
                    const f32x4 v0v = *(const LAS f32x4*)(s_par + 896 + pc4);
                    const u32x2 vfw = Lvf[nt];
                    const float vf0 = lo16(vfw.x), vf1 = hi16(vfw.x), vf2 = lo16(vfw.y), vf3 = hi16(vfw.y);
                    xv[0] += (vf0 - xv[0]) * fast_sigmoid(v0v[0] + az[0]); xv[1] += (vf1 - xv[1]) * fast_sigmoid(v0v[1] + az[1]);
                    xv[2] += (vf2 - xv[2]) * fast_sigmoid(v0v[2] + az[2]); xv[3] += (vf3 - xv[3]) * fast_sigmoid(v0v[3] + az[3]);
                } else {
                    u32x2 w; w.x = pk2(xv[0], xv[1]); w.y = pk2(xv[2], xv[3]); *(u32x2*)(VF + o) = w;
                }
                const f32x4 rkv = *(const LAS f32x4*)(s_par + 1024 + pc4);
                float P[4], rt[4], kt[4];
#pragma unroll
                for (int j = 0; j < 4; ++j) {
                    const float dcl = 0.8750387749f * fast_sigmoid(w0v[j] + aw[j]);
                    const float av = fast_sigmoid(a0v[j] + aa[j]);
                    const float kk = xk[j] * kkwv[j];
                    const float kmod = xk[j] * (1.0f + (av - 1.0f) * kawv[j]);
                    kss += kk * kk; bsum += xr[j] * kmod * rkv[j];
                    float p = __builtin_amdgcn_exp2f(-dcl);
                    p *= DPP1(p, 0x111); p *= DPP1(p, 0x112); p *= DPP1(p, 0x114); p *= DPP1(p, 0x118);
                    const float pm = DPP1(p, 0x111);
                    const float ip = __builtin_amdgcn_rcpf(p);
                    P[j] = p; rt[j] = xr[j] * p; kt[j] = kmod * ip; atu[nt][j] = -kk * pm; btu[nt][j] = kk * av * ip;
                }
                hR[nt].x = pk2(rt[0], rt[1]); hR[nt].y = pk2(rt[2], rt[3]); hK[nt].x = pk2(kt[0], kt[1]); hK[nt].y = pk2(kt[2], kt[3]);
                hV[nt].x = pk2(xv[0], xv[1]); hV[nt].y = pk2(xv[2], xv[3]);
                if (fr == 15) *(f32x4*)(WSP(float, WS_PCK) + (size_t)cid * 64 + nt * 16 + 4 * fq) = (f32x4){P[0], P[1], P[2], P[3]};
            }
            kss += __shfl_xor(kss, 16); kss += __shfl_xor(kss, 32);
            bsum += __shfl_xor(bsum, 16); bsum += __shfl_xor(bsum, 32);
            const float rn = rsqrtf(fmaxf(kss, 1e-24f));
            if (fq == 0) WSP(float, WS_BS)[(size_t)t * 8 + hd] = bsum;
            bf16x8 fA[2], fR[2], fB[2], fK[2], fV[2];
#pragma unroll
            for (int s_ = 0; s_ < 2; ++s_) {
                u32x4 w;
                w.x = pk2(atu[2 * s_][0] * rn, atu[2 * s_][1] * rn); w.y = pk2(atu[2 * s_][2] * rn, atu[2 * s_][3] * rn); w.z = pk2(atu[2 * s_ + 1][0] * rn, atu[2 * s_ + 1][1] * rn); w.w = pk2(atu[2 * s_ + 1][2] * rn, atu[2 * s_ + 1][3] * rn);
                fA[s_] = __builtin_bit_cast(bf16x8, w);
                w.x = pk2(btu[2 * s_][0] * rn, btu[2 * s_][1] * rn); w.y = pk2(btu[2 * s_][2] * rn, btu[2 * s_][3] * rn); w.z = pk2(btu[2 * s_ + 1][0] * rn, btu[2 * s_ + 1][1] * rn); w.w = pk2(btu[2 * s_ + 1][2] * rn, btu[2 * s_ + 1][3] * rn);
                fB[s_] = __builtin_bit_cast(bf16x8, w);
                fR[s_] = __builtin_bit_cast(bf16x8, (u32x4){hR[2 * s_].x, hR[2 * s_].y, hR[2 * s_ + 1].x, hR[2 * s_ + 1].y});
                fK[s_] = __builtin_bit_cast(bf16x8, (u32x4){hK[2 * s_].x, hK[2 * s_].y, hK[2 * s_ + 1].x, hK[2 * s_ + 1].y});
                fV[s_] = __builtin_bit_cast(bf16x8, (u32x4){hV[2 * s_].x, hV[2 * s_].y, hV[2 * s_ + 1].x, hV[2 * s_ + 1].y});
            }
#undef DPP1
            {
                int frv = fr, fqv = fq, lanev = lane; asm volatile("" : "+v"(frv), "+v"(fqv), "+v"(lanev));
                const unsigned rowo = (unsigned)(frv * 1024);
                char* ua = (char*)(SA + ((size_t)t0w * 512 + hd * 64)); char* ur = (char*)(SR + ((size_t)t0w * 512 + hd * 64));
#pragma unroll
                for (int s_ = 0; s_ < 2; ++s_) { const unsigned co = rowo + (unsigned)((((4 * s_ + fqv) ^ (frv & 7))) * 16);
                    *(u32x4*)(ua + co) = __builtin_bit_cast(u32x4, fA[s_]); *(u32x4*)(ur + co) = __builtin_bit_cast(u32x4, fR[s_]); }
                const f32x4 z4 = {0.f, 0.f, 0.f, 0.f};
#define MF(a_, b_, c_) __builtin_amdgcn_mfma_f32_16x16x32_bf16((a_), (b_), (c_), 0, 0, 0)
                const f32x4 nka = MF(fA[1], fK[1], MF(fA[0], fK[0], z4));
                const f32x4 nbr = MF(fR[1], fB[1], MF(fR[0], fB[0], z4));
                const f32x4 nkr = MF(fR[1], fK[1], MF(fR[0], fK[0], z4));
                const f32x4 nba = MF(fB[1], fA[1], MF(fB[0], fA[0], z4));
                unsigned nbu = (unsigned)(unsigned long long)((LAS float*)(lds + PBI_BYTES) + wave * 256); asm volatile("" : "+v"(nbu));
                LAS float* nb = (LAS float*)(unsigned long long)nbu;
                bf16_t* gim = WSP(bf16_t, WS_NKA) + (size_t)cid * 1024;
                const int ncol = (frv >> 2) * 8 + (frv & 3);
#pragma unroll
                for (int j = 0; j < 4; ++j) {
                    const int row = 4 * fqv + j;
                    gim[row * 32 + ncol + 4] = f2bf(frv < row ? nka[j] : 0.f);
                    gim[512 + row * 32 + ncol] = f2bf(frv <= row ? nbr[j] : 0.f);
                    gim[512 + row * 32 + ncol + 4] = f2bf(frv <= row ? nkr[j] : 0.f);
                    nb[row * 16 + frv] = (row < frv) ? nba[j] : 0.f;
                }
                const unsigned idv = (fqv == (frv >> 2)) ? (0x3f80u << (16 * (frv & 1))) : 0u;
                u32x4 idA = {0u, 0u, 0u, 0u}, idB = {0u, 0u, 0u, 0u};
                if ((frv & 3) < 2) { idA.x = idv; idB.z = idv; } else { idA.y = idv; idB.w = idv; }
                char* ubk = (char*)(WSP(bf16_t, WS_BTT) + (size_t)cid * 2048); char* uvs = (char*)(WSP(bf16_t, WS_VST) + (size_t)cid * 1024);
                const unsigned bko = (unsigned)(frv * 64 + fqv * 16), vso = (unsigned)(frv * 32 + fqv * 8);
#pragma unroll
                for (int n_ = 0; n_ < 4; ++n_) {
                    const bf16x8 idf = __builtin_bit_cast(bf16x8, (n_ & 1) ? idB : idA);
                    const f32x4 bT = MF(fB[n_ >> 1], idf, z4), kT = MF(fK[n_ >> 1], idf, z4), vT = MF(fV[n_ >> 1], idf, z4);
                    *(u32x4*)(ubk + n_ * 1024 + bko) = (u32x4){pk2(bT[0], bT[1]), pk2(bT[2], bT[3]), pk2(kT[0], kT[1]), pk2(kT[2], kT[3])};
                    *(u32x2*)(uvs + n_ * 512 + vso) = (u32x2){pk2(vT[0], vT[1]), pk2(vT[2], vT[3])};
                }
#undef MF
                if (lanev < 16) {
                    float X[16];
                    const int tcolp = (lanev >> 2) * 8 + (lanev & 3);
#pragma unroll
                    for (int tcol = 0; tcol < 16; ++tcol) {
                        float acc = (lanev == tcol) ? 1.0f : 0.0f;
#pragma unroll
                        for (int i = 0; i < tcol; ++i) acc += X[i] * nb[i * 16 + tcol];
                        X[tcol] = acc;
                        gim[tcol * 32 + tcolp] = f2bf(acc);
                    }
                }
            }
        }
    }
    __syncthreads();
}

__device__ __forceinline__ void pb2_chunks(const PA a, int l, LAS unsigned char* lds) {
    const int tid = otid(), wave = tid >> 6, lane = tid & 63, fr = lane & 15, fq = lane >> 4;
    LAS bf16_t* sA = (LAS bf16_t*)(lds + wave * 11520);
    LAS bf16_t* sR = sA + 1152; LAS bf16_t* sB = sR + 1152; LAS bf16_t* sK = sB + 1152; LAS bf16_t* sX = sK + 1152;
    LAS float* nb = (LAS float*)(lds + 8 * 11520) + wave * 256;
    bf16_t* SR = WSP(bf16_t, WS_SR); bf16_t* SK = WSP(bf16_t, WS_SK); bf16_t* SV = WSP(bf16_t, WS_SV);
    bf16_t* SA = WSP(bf16_t, WS_SA); bf16_t* SB = WSP(bf16_t, WS_SB); const bf16_t* SWD = WSP(const bf16_t, WS_SWD);
    const float* rkp = INP(12) + l * 512;
    for (int cid = oblk() * 8 + wave; cid < NCHUNK; cid += ogrid() * 8) {
        const int b = cid >> 10, h = (cid >> 7) & 7, c = cid & 127;
        const size_t tok0 = (size_t)b * SEQ + c * 16;
        const size_t e0 = tok0 * 512 + h * 64 + lane;
        const float rkv = rkp[h * 64 + lane];
        const int posl = (lane & 32) | (((lane & 15) >> 2) << 3) | (((lane >> 4) & 1) << 2) | (lane & 3);
        float P = 1.0f;
        unsigned bt2[8], kt2[8], vt2[8];
#pragma unroll
        for (int hf = 0; hf < 2; ++hf) {
            bf16_t r16[8], k16[8], a16[8], b16[8], v16[8]; float w32[8];
#pragma unroll
            for (int t8 = 0; t8 < 8; ++t8) { const size_t e = e0 + (size_t)(hf * 8 + t8) * 512; r16[t8] = SR[e]; k16[t8] = SK[e]; a16[t8] = SA[e]; b16[t8] = SB[e]; v16[t8] = SV[e]; w32[t8] = __builtin_amdgcn_exp2f(-bf2f(SWD[e])); }
#pragma unroll
            for (int t8 = 0; t8 < 8; ++t8) {
                const int t = hf * 8 + t8;
                const float rr = bf2f(r16[t8]), kk = bf2f(k16[t8]), aa = bf2f(a16[t8]), bb = bf2f(b16[t8]);
                const float Pm = P; P *= w32[t8]; const float ip = 1.0f / P;
                const unsigned ar = pk2(aa * Pm, rr * P), bk = pk2(bb * ip, kk * ip);
                const bf16_t at = (bf16_t)(ar & 0xffffu), rt = (bf16_t)(ar >> 16), btv = (bf16_t)(bk & 0xffffu), ktv = (bf16_t)(bk >> 16);
                { const size_t es = tok0 * 512 + (size_t)t * 512 + h * 64 + (posl ^ ((t & 7) << 3)); SA[es] = at; SR[es] = rt; }
                sA[t * 72 + lane] = at; sR[t * 72 + lane] = rt; sB[t * 72 + lane] = btv; sK[t * 72 + lane] = ktv;
                sX[t * 72 + lane] = (bf16_t)(pk2(rr * kk * rkv, 0.f) & 0xffffu);
                if (t & 1) { bt2[t >> 1] |= (unsigned)btv << 16; kt2[t >> 1] |= (unsigned)ktv << 16; vt2[t >> 1] |= (unsigned)v16[t8] << 16; }
                else       { bt2[t >> 1] = btv; kt2[t >> 1] = ktv; vt2[t >> 1] = v16[t8]; }
            }
        }
        WSP(float, WS_PCK)[(size_t)cid * 64 + lane] = P;
        {
            u32x4* pb_ = (u32x4*)(WSP(bf16_t, WS_BTT) + (size_t)cid * 2048 + lane * 32);
            u32x4* pv_ = (u32x4*)(WSP(bf16_t, WS_VST) + (size_t)cid * 1024 + lane * 16);
#pragma unroll
            for (int q = 0; q < 4; ++q) pb_[q] = (u32x4){bt2[2 * q], bt2[2 * q + 1], kt2[2 * q], kt2[2 * q + 1]};
            pv_[0] = (u32x4){vt2[0], vt2[1], vt2[2], vt2[3]}; pv_[1] = (u32x4){vt2[4], vt2[5], vt2[6], vt2[7]};
        }
        bf16x8 fA[2], fR[2], fB[2], fK[2], fX[2];
#pragma unroll
        for (int s_ = 0; s_ < 2; ++s_) {
            fA[s_] = *(const LAS bf16x8*)(sA + fr * 72 + 32 * s_ + 8 * fq); fR[s_] = *(const LAS bf16x8*)(sR + fr * 72 + 32 * s_ + 8 * fq);
            fB[s_] = *(const LAS bf16x8*)(sB + fr * 72 + 32 * s_ + 8 * fq); fK[s_] = *(const LAS bf16x8*)(sK + fr * 72 + 32 * s_ + 8 * fq);
            fX[s_] = *(const LAS bf16x8*)(sX + fr * 72 + 32 * s_ + 8 * fq);
        }
        const f32x4 z4 = {0.f, 0.f, 0.f, 0.f};
        const bf16x8 ones = {0x3f80, 0x3f80, 0x3f80, 0x3f80, 0x3f80, 0x3f80, 0x3f80, 0x3f80};
        const f32x4 nka = __builtin_amdgcn_mfma_f32_16x16x32_bf16(fA[1], fK[1], __builtin_amdgcn_mfma_f32_16x16x32_bf16(fA[0], fK[0], z4, 0, 0, 0), 0, 0, 0);
        const f32x4 nbr = __builtin_amdgcn_mfma_f32_16x16x32_bf16(fR[1], fB[1], __builtin_amdgcn_mfma_f32_16x16x32_bf16(fR[0], fB[0], z4, 0, 0, 0), 0, 0, 0);
        const f32x4 nkr = __builtin_amdgcn_mfma_f32_16x16x32_bf16(fR[1], fK[1], __builtin_amdgcn_mfma_f32_16x16x32_bf16(fR[0], fK[0], z4, 0, 0, 0), 0, 0, 0);
        const f32x4 nba = __builtin_amdgcn_mfma_f32_16x16x32_bf16(fB[1], fA[1], __builtin_amdgcn_mfma_f32_16x16x32_bf16(fB[0], fA[0], z4, 0, 0, 0), 0, 0, 0);
        const f32x4 bsm = __builtin_amdgcn_mfma_f32_16x16x32_bf16(fX[1], ones, __builtin_amdgcn_mfma_f32_16x16x32_bf16(fX[0], ones, z4, 0, 0, 0), 0, 0, 0);
        bf16_t* gim = WSP(bf16_t, WS_NKA) + (size_t)cid * 1024;
        const int ncol = (fr >> 2) * 8 + (fr & 3);
#pragma unroll
        for (int j = 0; j < 4; ++j) {
            const int row = 4 * fq + j;
            gim[row * 32 + ncol + 4] = f2bf(fr < row ? nka[j] : 0.f);
            gim[512 + row * 32 + ncol] = f2bf(fr <= row ? nbr[j] : 0.f);
            gim[512 + row * 32 + ncol + 4] = f2bf(fr <= row ? nkr[j] : 0.f);
            nb[row * 16 + fr] = (row < fr) ? nba[j] : 0.f;
            if (fr == 0) WSP(float, WS_BS)[(tok0 + row) * 8 + h] = bsm[j];
        }
        if (lane < 16) {
            float X[16];
            bf16_t* gtm = WSP(bf16_t, WS_NKA) + (size_t)cid * 1024; const int tcolp = (lane >> 2) * 8 + (lane & 3);
#pragma unroll
            for (int tcol = 0; tcol < 16; ++tcol) {
                float acc = (lane == tcol) ? 1.0f : 0.0f;
#pragma unroll
                for (int i = 0; i < tcol; ++i) acc += X[i] * nb[i * 16 + tcol];
                X[tcol] = acc;
                gtm[tcol * 32 + tcolp] = f2bf(acc);
            }
        }
    }
    __syncthreads();
}

__device__ __forceinline__ void scan_item(const PA a, int l, int bh, LAS unsigned char* lds) {
    const int tid = otid(), wave = __builtin_amdgcn_readfirstlane(tid >> 6), lane = tid & 63, fr = lane & 15, fq = lane >> 4;
    const int b = __builtin_amdgcn_readfirstlane(bh >> 3), h = __builtin_amdgcn_readfirstlane(bh & 7);
    constexpr int SLOT = 15104, NS = 8, DPF = 6;
    constexpr int OA = 0, OR_ = 2048, OBK = 4096, OVT = 8192, ON = 10240, OPC = 12288, OBS = 12544, OSG = 13056;
    constexpr int YBO = NS * SLOT;
    const size_t tokb = (size_t)b * SEQ;
    const int cid0 = (b * 8 + h) * 128;
    const unsigned char* gA = (const unsigned char*)WSP(const bf16_t, WS_SA); const unsigned char* gR = (const unsigned char*)WSP(const bf16_t, WS_SR);
    const unsigned char* gG = (const unsigned char*)WSP(const bf16_t, WS_SG);
    const unsigned char* gBK = (const unsigned char*)WSP(const bf16_t, WS_BTT);
    const unsigned char* gVT = (const unsigned char*)WSP(const bf16_t, WS_VST); const unsigned char* gN = (const unsigned char*)WSP(const bf16_t, WS_NKA);
    const unsigned char* gPC = (const unsigned char*)WSP(const float, WS_PCK); const unsigned char* gBS = (const unsigned char*)WSP(const float, WS_BS);
#define DMA16(gp, ldsoff) __builtin_amdgcn_global_load_lds((const unsigned*)(gp), (LAS unsigned*)(lds + (ldsoff)), 16, 0, 0)
    const unsigned rowoff0 = (unsigned)(((lane >> 3) * 512 + (lane & 7) * 8) * 2), rowoff1 = rowoff0 + 8u * 512u * 2u;
#define DMA_CHUNK(c_) do { const int cid_ = cid0 + (c_); const int so_ = ((c_) % NS) * SLOT; \
        const size_t rb_ = ((tokb + (size_t)(c_) * 16) * 512 + h * 64) * 2; \
        if (wave == 4) { \
            DMA16(gA + rb_ + rowoff0, so_ + OA); DMA16(gA + rb_ + rowoff1, so_ + OA + 1024); DMA16(gR + rb_ + rowoff0, so_ + OR_); DMA16(gR + rb_ + rowoff1, so_ + OR_ + 1024); \
            DMA16(gBK + (size_t)cid_ * 4096 + lane * 16, so_ + OBK); DMA16(gBK + (size_t)cid_ * 4096 + 1024 + lane * 16, so_ + OBK + 1024); \
            DMA16(gBK + (size_t)cid_ * 4096 + 2048 + lane * 16, so_ + OBK + 2048); DMA16(gBK + (size_t)cid_ * 4096 + 3072 + lane * 16, so_ + OBK + 3072); \
            if (lane < 16) DMA16(gPC + (size_t)cid_ * 256 + lane * 16, so_ + OPC); \
        } else { \
            DMA16(gVT + (size_t)cid_ * 2048 + lane * 16, so_ + OVT); DMA16(gVT + (size_t)cid_ * 2048 + 1024 + lane * 16, so_ + OVT + 1024); \
            DMA16(gN + (size_t)cid_ * 2048 + lane * 16, so_ + ON); DMA16(gN + (size_t)cid_ * 2048 + 1024 + lane * 16, so_ + ON + 1024); \
            DMA16(gG + rb_ + rowoff0, so_ + OSG); DMA16(gG + rb_ + rowoff1, so_ + OSG + 1024); \
            if (lane < 32) DMA16(gBS + (tokb + (size_t)(c_) * 16) * 32 + lane * 16, so_ + OBS); \
            if (lane < 1) DMA16(gPC + (size_t)cid_ * 256, so_ + OPC); if (lane < 1) DMA16(gPC + (size_t)cid_ * 256, so_ + OPC); \
        } } while (0)
#define MF(a_, b_, c_) __builtin_amdgcn_mfma_f32_16x16x32_bf16((a_), (b_), (c_), 0, 0, 0)
#define LDF(off_) (*(const LAS bf16x8*)(sl + (off_)))
    const int swz = fr & 7;
    const int aoff0 = fr * 128 + ((fq) ^ swz) * 16, aoff1 = fr * 128 + ((4 + fq) ^ swz) * 16;
    const int noff = fr * 64 + fq * 16, voff = ((wave & 3) * 16 + fr) * 32 + 8 * fq;
    const float lw = INP(13)[l * 512 + h * 64 + lane], lb = INP(14)[l * 512 + h * 64 + lane];
    bf16_t* YC = WSP(bf16_t, WS_YCAT);
#define SCAN_EPI(cp_) do { const int cp = (cp_); \
        const unsigned slb = (unsigned)(unsigned long long)(lds + (cp % NS) * SLOT), ybb = (unsigned)(unsigned long long)(lds + YBO + (cp & 1) * 4352); \
          \
        f32x4 y0, y1, y2, y3; { const unsigned ya = ybb + fr * 272 + fq * 32; \
            asm volatile("ds_read_b128 %0, %4\n\tds_read_b128 %1, %4 offset:16\n\tds_read_b128 %2, %4 offset:128\n\tds_read_b128 %3, %4 offset:144\n\ts_waitcnt lgkmcnt(0)" \
                         : "=&v"(y0), "=&v"(y1), "=&v"(y2), "=&v"(y3) : "v"(ya) : "memory"); } \
        u32x4 f0, f1, g0, g1; \
        f0.x = pk2(y0[0], y0[1]); f0.y = pk2(y0[2], y0[3]); f0.z = pk2(y1[0], y1[1]); f0.w = pk2(y1[2], y1[3]); f1.x = pk2(y2[0], y2[1]); f1.y = pk2(y2[2], y2[3]); f1.z = pk2(y3[0], y3[1]); f1.w = pk2(y3[2], y3[3]); \
        g0.x = pk2(y0[0] * y0[0], y0[1] * y0[1]); g0.y = pk2(y0[2] * y0[2], y0[3] * y0[3]); g0.z = pk2(y1[0] * y1[0], y1[1] * y1[1]); g0.w = pk2(y1[2] * y1[2], y1[3] * y1[3]); \
        g1.x = pk2(y2[0] * y2[0], y2[1] * y2[1]); g1.y = pk2(y2[2] * y2[2], y2[3] * y2[3]); g1.z = pk2(y3[0] * y3[0], y3[1] * y3[1]); g1.w = pk2(y3[2] * y3[2], y3[3] * y3[3]); \
        const bf16x8 ones = {0x3f80, 0x3f80, 0x3f80, 0x3f80, 0x3f80, 0x3f80, 0x3f80, 0x3f80}; const f32x4 z4 = {0.f, 0.f, 0.f, 0.f}; \
        const f32x4 ssum = MF(__builtin_bit_cast(bf16x8, f1), ones, MF(__builtin_bit_cast(bf16x8, f0), ones, z4));        \
        const f32x4 sqsm = MF(__builtin_bit_cast(bf16x8, g1), ones, MF(__builtin_bit_cast(bf16x8, g0), ones, z4)); \
          \
        f32x4 rs4, mr4; \
        _Pragma("unroll") for (int j = 0; j < 4; ++j) { const float mean = ssum[j] * (1.0f / 64.0f); const float var = fmaxf(sqsm[j] * (1.0f / 64.0f) - mean * mean, 0.f); \
            rs4[j] = rsqrtf(var + 64e-5f); mr4[j] = -mean * rs4[j]; } \
        float eY[8], eB[8]; unsigned eV[8], eG[8]; \
        _Pragma("unroll") for (int i = 0; i < 8; ++i) { const int t = (wave - 6) * 8 + i; \
            const unsigned ay_ = ybb + (t * 68 + lane) * 4, ab_ = slb + OBS + t * 32 + h * 4, av_ = slb + OVT + lane * 32 + t * 2, ag_ = slb + OSG + t * 128 + lane * 2; \
            asm volatile("ds_read_b32 %0, %4\n\tds_read_b32 %1, %5\n\tds_read_u16 %2, %6\n\tds_read_u16 %3, %7" \
                         : "=&v"(eY[i]), "=&v"(eB[i]), "=&v"(eV[i]), "=&v"(eG[i]) : "v"(ay_), "v"(ab_), "v"(av_), "v"(ag_) : "memory"); } \
        asm volatile("s_waitcnt lgkmcnt(0)" ::: "memory"); \
        bf16_t* yrow = YC + (tokb + (size_t)cp * 16 + (wave - 6) * 8) * 1024 + h * 64;       \
        _Pragma("unroll") for (int i = 0; i < 8; ++i) { \
            asm volatile("" : "+v"(eY[i]), "+v"(eB[i]), "+v"(eV[i]), "+v"(eG[i])); \
            const int sl_ = ((wave - 6) * 2 + (i >> 2)) * 16; \
            const float rstd = __int_as_float(__builtin_amdgcn_readlane(__float_as_int(rs4[i & 3]), sl_)); \
            const float nmr = __int_as_float(__builtin_amdgcn_readlane(__float_as_int(mr4[i & 3]), sl_)); \
            const float vv = __uint_as_float(eV[i] << 16), g = __uint_as_float(eG[i] << 16); \
            const float o_ = (eY[i] * (rstd * lw) + (nmr * lw + lb) + eB[i] * vv) * g; \
            *(bf16_t*)((char*)(yrow + (size_t)i * 1024) + (unsigned)(lane * 2)) = (bf16_t)(pk2(o_, 0.f) & 0xffffu); } } while (0)
    f32x4 S[4];
#pragma unroll
    for (int kt = 0; kt < 4; ++kt) S[kt] = (f32x4){0.f, 0.f, 0.f, 0.f};
    __syncthreads();
    if (wave == 4 || wave == 5) {
#pragma unroll 1
        for (int c = 0; c < DPF; ++c) DMA_CHUNK(c);
        asm volatile("s_waitcnt vmcnt(0)" ::: "memory");
    }
    __syncthreads();
#pragma unroll 1
    for (int c = 0; c < 128; ++c) {
        if (wave < 4) {
            const LAS unsigned char* sl = lds + (c % NS) * SLOT;
            u32x4 s0w, s1w; s0w.x = pk2(S[0][0], S[0][1]); s0w.y = pk2(S[0][2], S[0][3]); s0w.z = pk2(S[1][0], S[1][1]); s0w.w = pk2(S[1][2], S[1][3]);
            s1w.x = pk2(S[2][0], S[2][1]); s1w.y = pk2(S[2][2], S[2][3]); s1w.z = pk2(S[3][0], S[3][1]); s1w.w = pk2(S[3][2], S[3][3]);
            const bf16x8 Sf0 = __builtin_bit_cast(bf16x8, s0w), Sf1 = __builtin_bit_cast(bf16x8, s1w);
            const u32x2 vm = *(const LAS u32x2*)(sl + OVT + voff);
            const bf16x8 TN = LDF(ON + noff), BN = LDF(ON + 1024 + noff);
            const f32x4 z4 = {0.f, 0.f, 0.f, 0.f};
            const bf16x8 ZV = __builtin_bit_cast(bf16x8, (u32x4){0u, 0u, vm.x, vm.y});
            f32x4 Wt = MF(LDF(OA + aoff0), Sf0, z4); Wt = MF(LDF(OA + aoff1), Sf1, Wt); Wt = MF(TN, ZV, Wt);
            const bf16x8 WZ = __builtin_bit_cast(bf16x8, (u32x4){pk2(Wt[0], Wt[1]), pk2(Wt[2], Wt[3]), 0u, 0u});
            const f32x4 Ut = MF(TN, WZ, z4);
            const bf16x8 UV = __builtin_bit_cast(bf16x8, (u32x4){pk2(Ut[0], Ut[1]), pk2(Ut[2], Ut[3]), vm.x, vm.y});
            f32x4 Yt = MF(LDF(OR_ + aoff0), Sf0, z4); Yt = MF(LDF(OR_ + aoff1), Sf1, Yt); Yt = MF(BN, UV, Yt);
#pragma unroll
            for (int kt = 0; kt < 4; ++kt) {
                const f32x4 pc = *(const LAS f32x4*)(sl + OPC + (kt * 16 + 4 * fq) * 4);
                S[kt] = MF(LDF(OBK + kt * 1024 + noff), UV, S[kt]) * pc;
            }
            LAS float* yb = (LAS float*)(lds + YBO + (c & 1) * 4352) + (wave & 3) * 16 + fr;
#pragma unroll
            for (int j = 0; j < 4; ++j) yb[(4 * fq + j) * 68] = Yt[j];
            asm volatile("s_waitcnt lgkmcnt(0)" ::: "memory");
        } else if (wave < 6) {
            if (c + DPF < 128) DMA_CHUNK(c + DPF);
            if (c >= DPF && c + DPF < 128) asm volatile("s_waitcnt vmcnt(45)" ::: "memory"); else asm volatile("s_waitcnt vmcnt(0)" ::: "memory");
        } else if (c > 0) {
            SCAN_EPI(c - 1);
        }
        asm volatile("" ::: "memory"); __builtin_amdgcn_s_barrier(); asm volatile("" ::: "memory");
    }
    if (wave >= 6) { SCAN_EPI(127); }
    asm volatile("s_waitcnt vmcnt(0)" ::: "memory");
    __syncthreads();
#undef SCAN_EPI
#undef DMA16
#undef DMA_CHUNK
#undef MF
#undef LDF
}

__device__ __forceinline__ void attn_item(const PA a, int l, int it, LAS unsigned char* lds) {
    const int tid = otid(), h = __builtin_amdgcn_readfirstlane(tid >> 6), lane = tid & 63, fr = lane & 15, fq = lane >> 4;
    const int b = it >> 5, c = it & 31;
    LAS float* s_bias = (LAS float*)(lds + LDS_MISC + 1024);
    LAS float* s_part = s_bias + 8 * 320;
    LAS float* tb = (LAS float*)lds + h * 1600;
    __syncthreads();
    for (int e = lane; e < 1600; e += 64) { const int r = e / 400, y = e - r * 400; int idx = 383 - (y + r); idx = idx > 319 ? 319 : (idx < 0 ? 0 : idx); tb[e] = s_bias[h * 320 + idx]; }
    const bf16_t* proj = WSP(const bf16_t, WS_PROJ);
    const bf16_t* VT = WSP(const bf16_t, WS_VT) + (size_t)(b * 8 + h) * 64 * 2048;
    const size_t tq0 = (size_t)b * SEQ + c * 64;
    bf16x8 qf[4][2];
#pragma unroll
    for (int nt = 0; nt < 4; ++nt)
#pragma unroll
        for (int ks = 0; ks < 2; ++ks) qf[nt][ks] = *(const bf16x8*)(proj + (tq0 + nt * 16 + fr) * INW + 1792 + h * 64 + 32 * ks + 8 * fq);
    f32x4 o[5][4];
#pragma unroll
    for (int dt = 0; dt < 5; ++dt)
#pragma unroll
        for (int nt = 0; nt < 4; ++nt) o[dt][nt] = (f32x4){0.f, 0.f, 0.f, 0.f};
    const int kc0 = c - 8 > 0 ? c - 8 : 0;
    const int nsteps = (c - kc0 + 1) * 2;
    const bf16x8 ones = {0x3f80, 0x3f80, 0x3f80, 0x3f80, 0x3f80, 0x3f80, 0x3f80, 0x3f80};
    const int rr = (4 - (fr & 3)) & 3;
    const unsigned tbl = (unsigned)(unsigned long long)(tb + rr * 400) + (unsigned)((320 - fr + 4 * fq - rr - 48) * 4);
    const bf16_t* kbase = proj + ((size_t)b * SEQ + kc0 * 64) * INW + 2304 + h * 64;
    const unsigned koff = (unsigned)((fr * INW + 8 * fq) * 2), voffb = (unsigned)((fr * 2048 + 8 * fq) * 2);
    const bf16_t* vbase = VT + kc0 * 64;
    bf16x8 kfA[2][2], kfB[2][2]; u32x4 vfA[4], vfB[4];
#define ATT_LOAD(KF, VF, st) do { unsigned ko_ = koff, vo_ = voffb; asm volatile("" : "+v"(ko_), "+v"(vo_)); \
        const char* kp_ = (const char*)(kbase + (size_t)(st) * 32 * INW); const char* vp_ = (const char*)(vbase + (st) * 32); \
        _Pragma("unroll") for (int mt = 0; mt < 2; ++mt) _Pragma("unroll") for (int ks = 0; ks < 2; ++ks) \
            KF[mt][ks] = *(const bf16x8*)(kp_ + (size_t)(mt * 16 * INW + 32 * ks) * 2 + ko_); \
        _Pragma("unroll") for (int dt = 0; dt < 4; ++dt) VF[dt] = *(const u32x4*)(vp_ + (size_t)(dt * 16 * 2048) * 2 + vo_); } while (0)
#define MF(a_, b_, c_) __builtin_amdgcn_mfma_f32_16x16x32_bf16((a_), (b_), (c_), 0, 0, 0)
#define ATT_STEP(KF, VF, st) do { \
        f32x4 sacc[2][4]; const f32x4 z4 = {0.f, 0.f, 0.f, 0.f}; \
        _Pragma("unroll") for (int mt = 0; mt < 2; ++mt) _Pragma("unroll") for (int nt = 0; nt < 4; ++nt) sacc[mt][nt] = MF(KF[mt][1], qf[nt][1], MF(KF[mt][0], qf[nt][0], z4)); \
        const int dk = c - (kc0 + ((st) >> 1)), half = (st) & 1; \
        if (dk >= 5) { const float bc = s_bias[h * 320 + 319]; \
            _Pragma("unroll") for (int mt = 0; mt < 2; ++mt) _Pragma("unroll") for (int nt = 0; nt < 4; ++nt) sacc[mt][nt] += bc; \
        } else { \
            const unsigned ta = tbl + (unsigned)((32 * half - 64 * dk + 256) * 4); f32x4 bv[5]; \
            _Pragma("unroll") for (int dd = 0; dd < 5; ++dd) bv[dd] = *(const LAS f32x4*)(unsigned long long)(ta - 1024u + (unsigned)((3 - (dd - 1)) * 64)); \
            _Pragma("unroll") for (int mt = 0; mt < 2; ++mt) _Pragma("unroll") for (int nt = 0; nt < 4; ++nt) sacc[mt][nt] += bv[nt - mt + 1]; } \
        bf16x8 pf[4]; \
        _Pragma("unroll") for (int nt = 0; nt < 4; ++nt) { \
            u32x4 w; w.x = pk2(__builtin_amdgcn_exp2f(sacc[0][nt][0]), __builtin_amdgcn_exp2f(sacc[0][nt][1])); w.y = pk2(__builtin_amdgcn_exp2f(sacc[0][nt][2]), __builtin_amdgcn_exp2f(sacc[0][nt][3])); \
            w.z = pk2(__builtin_amdgcn_exp2f(sacc[1][nt][0]), __builtin_amdgcn_exp2f(sacc[1][nt][1])); w.w = pk2(__builtin_amdgcn_exp2f(sacc[1][nt][2]), __builtin_amdgcn_exp2f(sacc[1][nt][3])); \
            pf[nt] = __builtin_bit_cast(bf16x8, w); } \
        _Pragma("unroll") for (int nt = 0; nt < 4; ++nt) { \
            _Pragma("unroll") for (int dt = 0; dt < 4; ++dt) o[dt][nt] = MF(__builtin_bit_cast(bf16x8, VF[dt]), pf[nt], o[dt][nt]); \
            o[4][nt] = MF(ones, pf[nt], o[4][nt]); } } while (0)
    ATT_LOAD(kfA, vfA, 0);
    __syncthreads();
#pragma unroll 1
    for (int st = 0; st < nsteps; st += 2) {
        ATT_LOAD(kfB, vfB, st + 1);
        ATT_STEP(kfA, vfA, st);
        if (st + 2 < nsteps) ATT_LOAD(kfA, vfA, st + 2);
        ATT_STEP(kfB, vfB, st + 1);
    }
#undef ATT_LOAD
#undef ATT_STEP
#undef MF
#pragma unroll
    for (int nt = 0; nt < 4; ++nt) {
        const float inv = 1.0f / o[4][nt][0];
        float sq = 0.f;
#pragma unroll
        for (int dt = 0; dt < 4; ++dt) { o[dt][nt] *= inv; sq += (o[dt][nt][0] * o[dt][nt][0] + o[dt][nt][1] * o[dt][nt][1]) + (o[dt][nt][2] * o[dt][nt][2] + o[dt][nt][3] * o[dt][nt][3]); }
        sq += __shfl_xor(sq, 16); sq += __shfl_xor(sq, 32);
        if (fq == 0) s_part[h * 64 + nt * 16 + fr] = sq;
    }
    __syncthreads();
#pragma unroll
    for (int nt = 0; nt < 4; ++nt) {
        float tot = 0.f;
#pragma unroll
        for (int hh = 0; hh < 8; ++hh) tot += s_part[hh * 64 + nt * 16 + fr];
        const float rinv = rsqrtf(tot * (1.0f / 512.0f) + 1e-6f);
        bf16_t* yp = WSP(bf16_t, WS_YCAT) + (tq0 + nt * 16 + fr) * 1024 + 512 + h * 64 + 4 * fq;
#pragma unroll
        for (int dt = 0; dt < 4; ++dt) { u32x2 w; w.x = pk2(o[dt][nt][0] * rinv, o[dt][nt][1] * rinv); w.y = pk2(o[dt][nt][2] * rinv, o[dt][nt][3] * rinv); *(u32x2*)(yp + dt * 16) = w; }
    }
    __syncthreads();
}

__device__ __forceinline__ void pc_mixer(const PA a, int l, LAS unsigned char* lds) {
    const int tid = otid();
    LAS float* s_bias = (LAS float*)(lds + LDS_MISC + 1024);
    volatile LAS int* s_item = (volatile LAS int*)(lds + LDS_MISC + 64);
    for (int i = tid; i < 8 * 320; i += 512) s_bias[i] = INP(20)[l * 8 * 320 + i] * 1.4426950408889634f;
    unsigned* qhead = WSP(unsigned, WS_CTL) + CW_QUEUE + l * 64;
    for (;;) {
        __syncthreads();
        if (tid == 0) *s_item = (int)__hip_atomic_fetch_add(qhead, 1u, __ATOMIC_RELAXED, __HIP_MEMORY_SCOPE_AGENT);
        __syncthreads();
        const int item = __builtin_amdgcn_readfirstlane(*s_item);
        if (item >= 128 + 512 + MOE_CONV_ITEMS) break;
        if (item < 128) scan_item(a, l, item, lds);
        else if (item < 128 + 512) attn_item(a, l, item - 128, lds);
        else moe_convert_item(a, l, lds, item - 640);
    }
}

__device__ __forceinline__ void pe2_xattn(const PA a, int l, LAS unsigned char* lds) {
    const int tid = otid(), wave = tid >> 6, lane = tid & 63, fr = lane & 15, fq = lane >> 4;
    LAS bf16_t* sK = (LAS bf16_t*)lds;
    LAS bf16_t* sV = (LAS bf16_t*)(lds + 69632);
    const bf16_t* QX = WSP(const bf16_t, WS_QX); bf16_t* OX = WSP(bf16_t, WS_OX);
    const bf16_t* KV = WSP(const bf16_t, WS_KV) + (size_t)l * MROWS * 1024;
    const bf16_t* VTX = WSP(const bf16_t, WS_VTX) + (size_t)l * MROWS * 512;
    const float* qgn = INP(28) + l * 128;
    for (int it = oblk(); it < 256; it += ogrid()) {
        const int b = it >> 4, h = (it >> 2) & 3, qr = it & 3;
        __syncthreads();
#pragma unroll
        for (int i = 0; i < 8; ++i) {
            const int p = tid + i * 512, r = p >> 4, c8 = (p & 15) * 8;
            *(LAS u32x4*)(sK + r * 136 + c8) = *(const u32x4*)(KV + (size_t)(b * 256 + r) * 1024 + h * 128 + c8);
            const int d = p >> 5, m8 = (p & 31) * 8;
            *(LAS u32x4*)(sV + d * 264 + m8) = *(const u32x4*)(VTX + ((size_t)(b * 4 + h) * 128 + d) * 256 + m8);
        }
        __syncthreads();
#pragma unroll 1
        for (int iter = 0; iter < 2; ++iter) {
            const size_t q0 = (size_t)b * SEQ + qr * 512 + iter * 256 + wave * 32;
            bf16x8 qf[2][4];
#pragma unroll
            for (int nt = 0; nt < 2; ++nt) {
                const bf16_t* qp = QX + (q0 + nt * 16 + fr) * 512 + h * 128 + 8 * fq;
                u32x4 w[4]; float ssq = 0.f;
#pragma unroll
                for (int ks = 0; ks < 4; ++ks) { w[ks] = *(const u32x4*)(qp + 32 * ks);
#pragma unroll
                    for (int j = 0; j < 4; ++j) { const float x0 = lo16(w[ks][j]), x1 = hi16(w[ks][j]); ssq += x0 * x0 + x1 * x1; } }
                ssq += __shfl_xor(ssq, 16); ssq += __shfl_xor(ssq, 32);
                const float sc = rsqrtf(ssq * (1.0f / 128.0f) + 1e-6f) * 0.12751743f;
#pragma unroll
                for (int ks = 0; ks < 4; ++ks) {
                    const f32x4 g0 = *(const f32x4*)(qgn + 32 * ks + 8 * fq), g1 = *(const f32x4*)(qgn + 32 * ks + 8 * fq + 4);
                    u32x4 ow;
                    ow.x = pk2(lo16(w[ks][0]) * sc * g0[0], hi16(w[ks][0]) * sc * g0[1]); ow.y = pk2(lo16(w[ks][1]) * sc * g0[2], hi16(w[ks][1]) * sc * g0[3]);
                    ow.z = pk2(lo16(w[ks][2]) * sc * g1[0], hi16(w[ks][2]) * sc * g1[1]); ow.w = pk2(lo16(w[ks][3]) * sc * g1[2], hi16(w[ks][3]) * sc * g1[3]);
                    qf[nt][ks] = __builtin_bit_cast(bf16x8, ow);
                }
            }
            f32x4 o[8][2];
#pragma unroll
            for (int dt = 0; dt < 8; ++dt) { o[dt][0] = (f32x4){0.f, 0.f, 0.f, 0.f}; o[dt][1] = (f32x4){0.f, 0.f, 0.f, 0.f}; }
            float lsum[2] = {0.f, 0.f};
#pragma unroll 2
            for (int st = 0; st < 8; ++st) {
                const int k0 = st * 32;
                f32x4 sacc[2][2];
#pragma unroll
                for (int mt = 0; mt < 2; ++mt) {
                    sacc[mt][0] = (f32x4){0.f, 0.f, 0.f, 0.f}; sacc[mt][1] = (f32x4){0.f, 0.f, 0.f, 0.f};
#pragma unroll
                    for (int ks = 0; ks < 4; ++ks) {
                        const bf16x8 kfr = *(const LAS bf16x8*)(sK + (k0 + mt * 16 + fr) * 136 + 32 * ks + 8 * fq);
                        sacc[mt][0] = __builtin_amdgcn_mfma_f32_16x16x32_bf16(kfr, qf[0][ks], sacc[mt][0], 0, 0, 0);
                        sacc[mt][1] = __builtin_amdgcn_mfma_f32_16x16x32_bf16(kfr, qf[1][ks], sacc[mt][1], 0, 0, 0);
                    }
                }
                bf16x8 pf[2];
#pragma unroll
                for (int nt = 0; nt < 2; ++nt) {
                    float p[8];
#pragma unroll
                    for (int j = 0; j < 4; ++j) { p[j] = __builtin_amdgcn_exp2f(fminf(sacc[0][nt][j], 80.f)); p[4 + j] = __builtin_amdgcn_exp2f(fminf(sacc[1][nt][j], 80.f)); }
                    lsum[nt] += ((p[0] + p[1]) + (p[2] + p[3])) + ((p[4] + p[5]) + (p[6] + p[7]));
                    u32x4 w; w.x = pk2(p[0], p[1]); w.y = pk2(p[2], p[3]); w.z = pk2(p[4], p[5]); w.w = pk2(p[6], p[7]);
                    pf[nt] = __builtin_bit_cast(bf16x8, w);
                }
#pragma unroll
                for (int dt = 0; dt < 8; ++dt) {
                    const LAS bf16_t* vp = sV + (dt * 16 + fr) * 264 + k0 + 4 * fq;
                    const u32x2 v0 = *(const LAS u32x2*)vp, v1 = *(const LAS u32x2*)(vp + 16);
                    u32x4 w; w.x = v0.x; w.y = v0.y; w.z = v1.x; w.w = v1.y;
                    const bf16x8 vfr = __builtin_bit_cast(bf16x8, w);
                    o[dt][0] = __builtin_amdgcn_mfma_f32_16x16x32_bf16(vfr, pf[0], o[dt][0], 0, 0, 0);
                    o[dt][1] = __builtin_amdgcn_mfma_f32_16x16x32_bf16(vfr, pf[1], o[dt][1], 0, 0, 0);
                }
            }
#pragma unroll
            for (int nt = 0; nt < 2; ++nt) {
                float ls = lsum[nt]; ls += __shfl_xor(ls, 16); ls += __shfl_xor(ls, 32);
                const float inv = 1.0f / ls;
                bf16_t* op = OX + (q0 + nt * 16 + fr) * 512 + h * 128 + 4 * fq;
#pragma unroll
                for (int dt = 0; dt < 8; ++dt) { u32x2 w; w.x = pk2(o[dt][nt][0] * inv, o[dt][nt][1] * inv); w.y = pk2(o[dt][nt][2] * inv, o[dt][nt][3] * inv); *(u32x2*)(op + dt * 16) = w; }
            }
        }
    }
    __syncthreads();
}

__device__ __forceinline__ void pf_router(const PA a, int l, LAS unsigned char* lds) {
    const int tid = otid(), wave = tid >> 6, lane = tid & 63, fr = lane & 15, fq = lane >> 4;
    LAS int* s_cnt = (LAS int*)lds;
    LAS int* s_base = s_cnt + 32;
    LAS int* s_e = s_base + 32;
    LAS int* s_rk = s_e + 256;
    LAS float* s_w = (LAS float*)(s_rk + 256);
    const bf16_t* X = WSP(const bf16_t, WS_XB); const float* SS = WSP(const float, WS_SS);
    const bf16_t* wrh = WSP(const bf16_t, WS_WRH) + (size_t)l * 48 * 1024; const bf16_t* wrl = WSP(const bf16_t, WS_WRL) + (size_t)l * 48 * 1024;
    const float* bg = INP(32) + l * 4; const float* br = INP(34) + l * 32;
    int* EID = WSP(int, WS_EID); float* EW = WSP(float, WS_EW); int* ERK = WSP(int, WS_ERK);
    unsigned* cnt = WSP(unsigned, WS_CTL) + CW_CNT + l * 32;
    for (int tile = oblk(); tile < T / 128; tile += ogrid()) {
        __syncthreads();
        if (tid < 32) s_cnt[tid] = 0;
        __syncthreads();
        const int t = tile * 128 + wave * 16 + fr;
        f32x4 acc[3];
#pragma unroll
        for (int mt = 0; mt < 3; ++mt) acc[mt] = (f32x4){0.f, 0.f, 0.f, 0.f};
        const bf16_t* xr = X + (size_t)t * 1024 + 8 * fq;
        u32x4 wst[6];
#define RT_LOAD(sl_) do { _Pragma("unroll") for (int i = 0; i < 6; ++i) { const int p = tid + i * 512, arr = p / 1536, pr = p - arr * 1536, r = pr >> 5, q = pr & 31; \
            wst[i] = *(const u32x4*)((arr ? wrl : wrh) + (size_t)r * 1024 + (sl_) * 256 + q * 8); } } while (0)
#define RT_STORE(buf_) do { _Pragma("unroll") for (int i = 0; i < 6; ++i) { const int p = tid + i * 512, arr = p / 1536, pr = p - arr * 1536, r = pr >> 5, q = pr & 31; \
            *(LAS u32x4*)(lds + 4096 + (buf_) * 50688 + arr * 25344 + r * 528 + q * 16) = wst[i]; } } while (0)
        RT_LOAD(0); RT_STORE(0);
        __syncthreads();
#pragma unroll 1
        for (int sl = 0; sl < 4; ++sl) {
            if (sl < 3) RT_LOAD(sl + 1);
            const LAS unsigned char* wb_ = lds + 4096 + (sl & 1) * 50688;
#pragma unroll
            for (int s8 = 0; s8 < 8; ++s8) {
                const int s_ = sl * 8 + s8;
                const bf16x8 xh = *(const bf16x8*)(xr + 32 * s_);
#pragma unroll
                for (int mt = 0; mt < 3; ++mt) {
                    const bf16x8 wh = *(const LAS bf16x8*)(wb_ + (mt * 16 + fr) * 528 + (32 * s8 + 8 * fq) * 2);
                    const bf16x8 wl = *(const LAS bf16x8*)(wb_ + 25344 + (mt * 16 + fr) * 528 + (32 * s8 + 8 * fq) * 2);
                    acc[mt] = __builtin_amdgcn_mfma_f32_16x16x32_bf16(wh, xh, acc[mt], 0, 0, 0);
                    acc[mt] = __builtin_amdgcn_mfma_f32_16x16x32_bf16(wl, xh, acc[mt], 0, 0, 0);
                }
            }
            if (sl < 3) { RT_STORE((sl + 1) & 1); __syncthreads(); }
        }
#undef RT_LOAD
#undef RT_STORE
        const f32x4* sp = (const f32x4*)(SS + (size_t)t * 16);
        const f32x4 s0 = sp[0], s1 = sp[1], s2 = sp[2], s3 = sp[3];
        const float tot = ((s0[0] + s0[1]) + (s0[2] + s0[3])) + ((s1[0] + s1[1]) + (s1[2] + s1[3])) + ((s2[0] + s2[1]) + (s2[2] + s2[3])) + ((s3[0] + s3[1]) + (s3[2] + s3[3]));
        const float rinv = rsqrtf(tot * (1.0f / 1024.0f) + 1e-6f);
        float lg[4], lr[8];
#pragma unroll
        for (int j = 0; j < 4; ++j) { lg[j] = acc[0][j] * rinv + bg[j]; lr[j] = acc[1][j] * rinv + br[fq * 8 + j]; lr[4 + j] = acc[2][j] * rinv + br[fq * 8 + 4 + j]; }
        float g0 = lg[0]; int gt = 0;
#pragma unroll
        for (int j = 1; j < 4; ++j) { if (lg[j] > g0) { g0 = lg[j]; gt = j; } }
        if (fq == gt) {
            float gs = 0.f;
#pragma unroll
            for (int j = 0; j < 4; ++j) gs += __expf(lg[j] - g0);
            const float ggate = 1.0f / gs;
            float l1 = -1e30f, l2 = -1e30f; int j1 = 0, j2 = 0;
#pragma unroll
            for (int j = 0; j < 8; ++j) { const float v = lr[j];
                if (v > l1) { l2 = l1; j2 = j1; l1 = v; j1 = j; } else if (v > l2) { l2 = v; j2 = j; } }
            const float e2 = __expf(l2 - l1);
            const float p1 = 1.0f / (1.0f + e2), p2 = e2 / (1.0f + e2);
            const int e1i = gt * 8 + j1, e2i = gt * 8 + j2;
            const int r1 = atomicAdd((int*)(s_cnt + e1i), 1), r2 = atomicAdd((int*)(s_cnt + e2i), 1);
            const int sl = (wave * 16 + fr) * 2;
            s_e[sl] = e1i; s_e[sl + 1] = e2i; s_rk[sl] = r1; s_rk[sl + 1] = r2; s_w[sl] = ggate * p1; s_w[sl + 1] = ggate * p2;
        }
        __syncthreads();
        if (tid < 32) s_base[tid] = (int)__hip_atomic_fetch_add(cnt + tid, (unsigned)s_cnt[tid], __ATOMIC_RELAXED, __HIP_MEMORY_SCOPE_AGENT);
        __syncthreads();
        if (tid < 256) { const int e = s_e[tid]; const size_t o = (size_t)tile * 256 + tid; EID[o] = e; EW[o] = s_w[tid]; ERK[o] = s_base[e] + s_rk[tid]; }
    }
    __syncthreads();
}

__device__ __forceinline__ void pg_gather(const PA a, int l, LAS unsigned char* lds) {
    const int tid = otid(), wave = tid >> 6, lane = tid & 63;
    LAS int* s_ps = (LAS int*)lds;
    const unsigned* cnt = WSP(const unsigned, WS_CTL) + CW_CNT + l * 32;
    int* SSLOT = WSP(int, WS_SSLOT); float* SW = WSP(float, WS_SW); int* MTE = WSP(int, WS_MTE);
    bf16_t* XS = WSP(bf16_t, WS_XS); const bf16_t* XB = WSP(const bf16_t, WS_XB);
    const float* SS = WSP(const float, WS_SS);
    const int* EID = WSP(const int, WS_EID); const float* EW = WSP(const float, WS_EW); const int* ERK = WSP(const int, WS_ERK);
    __syncthreads();
    if (tid == 0) {
        int acc = 0;
        for (int e = 0; e < 32; ++e) { s_ps[e] = acc; const int c = (int)__hip_atomic_load(cnt + e, __ATOMIC_RELAXED, __HIP_MEMORY_SCOPE_AGENT); acc += ((c + 255) >> 8) << 8; }
        s_ps[32] = acc;
    }
    __syncthreads();
    if (oblk() == 0) {
        if (tid < 32) { const int m0 = s_ps[tid] >> 8, m1 = s_ps[tid + 1] >> 8; for (int mt = m0; mt < m1; ++mt) MTE[mt] = tid; }
        if (tid == 0) MTE[511] = s_ps[32] >> 8;
        if (tid < 33) MTE[400 + tid] = s_ps[tid] >> 8;
    }
    int* STOK = WSP(int, WS_STOK); float* SRINV = WSP(float, WS_SRINV);
    for (int e = oblk(); e < 32; e += ogrid()) {
        const int c = (int)__hip_atomic_load(cnt + e, __ATOMIC_RELAXED, __HIP_MEMORY_SCOPE_AGENT);
        const int r0 = s_ps[e] + c, r1 = s_ps[e + 1];
        for (int r = r0 + tid; r < r1; r += 512) { SSLOT[r] = -1; SW[r] = 0.f; STOK[r] = 0; SRINV[r] = 0.f; }
    }
    for (int as = oblk() * 512 + tid; as < 2 * T; as += ogrid() * 512) {
        const int t = as >> 1;
        const int dest = s_ps[EID[as]] + ERK[as];
        const f32x4* sp = (const f32x4*)(SS + (size_t)t * 16);
        const f32x4 s0 = sp[0], s1 = sp[1], s2 = sp[2], s3 = sp[3];
        const float tot = ((s0[0] + s0[1]) + (s0[2] + s0[3])) + ((s1[0] + s1[1]) + (s1[2] + s1[3])) + ((s2[0] + s2[1]) + (s2[2] + s2[3])) + ((s3[0] + s3[1]) + (s3[2] + s3[3]));
        SSLOT[dest] = as; SW[dest] = EW[as]; STOK[dest] = t; SRINV[dest] = rsqrtf(tot * (1.0f / 1024.0f) + 1e-6f);
    }
}

__device__ __forceinline__ void pj_finalize(const PA a, bool last) {
    const int wave = otid() >> 6, lane = otid() & 63;
    float* OUT = a.out; bf16_t* XB = WSP(bf16_t, WS_XB); float* SS = WSP(float, WS_SS);
    const bf16_t* Y = WSP(const bf16_t, WS_Y);
    for (int t = oblk() * 8 + wave; t < T; t += ogrid() * 8) {
        float sq = 0.f;
#pragma unroll
        for (int i = 0; i < 2; ++i) {
            const int c = i * 512 + lane * 8;
            const u32x4 xw = *(const u32x4*)(XB + (size_t)t * 1024 + c);
            const u32x4 y0 = *(const u32x4*)(Y + (size_t)(2 * t) * 1024 + c), y1 = *(const u32x4*)(Y + (size_t)(2 * t + 1) * 1024 + c);
            float v[8];
#pragma unroll
            for (int j = 0; j < 4; ++j) { v[2 * j] = lo16(xw[j]) + (lo16(y0[j]) + lo16(y1[j])); v[2 * j + 1] = hi16(xw[j]) + (hi16(y0[j]) + hi16(y1[j])); }
            if (last) { *(f32x4*)(OUT + (size_t)t * 1024 + c) = (f32x4){v[0], v[1], v[2], v[3]}; *(f32x4*)(OUT + (size_t)t * 1024 + c + 4) = (f32x4){v[4], v[5], v[6], v[7]}; }
            else {
                u32x4 w; w.x = pk2(v[0], v[1]); w.y = pk2(v[2], v[3]); w.z = pk2(v[4], v[5]); w.w = pk2(v[6], v[7]);
                *(u32x4*)(XB + (size_t)t * 1024 + c) = w;
#pragma unroll
                for (int j = 0; j < 4; ++j) { const float a0 = lo16(w[j]), a1 = hi16(w[j]); sq += a0 * a0 + a1 * a1; }
            }
        }
        if (!last) { sq = wsum(sq); if (lane < 16) SS[(size_t)t * 16 + lane] = (lane == 0) ? sq : 0.f; }
    }
}

#define SITE static __device__ __forceinline__ void
#define OPAQUE() do { a.out = (float*)ldsin(lds, 38); a.ws = (unsigned char*)ldsin(lds, 39); } while (0)
__device__ __forceinline__ int opq(int v) { asm volatile("" : "+s"(v)); return v; }
SITE site_p0(PA a, LAS unsigned char* lds) { OPAQUE(); p0_prologue(a, lds); }
SITE site_kv(PA a, LAS unsigned char* lds) { OPAQUE();
    pg8::Gemm g{WSP(const bf16_t, WS_MEMB), WSP(const bf16_t, WS_WKV), 1024, (size_t)1024 * 1024, nullptr};
    pg8::KvOrder S{opq((int)gridDim.x), opq((int)blockIdx.x)};
    pg8::EpiScale E{WSP(bf16_t, WS_KV), 1024, WSP(const float, WS_MEMSS), MROWS - 1};
    pg8::gemm_phase<pg8::EpiScale, pg8::KvOrder>(lds, g, S, E);
}
SITE site_knorm(PA a, LAS unsigned char* lds) { OPAQUE(); p2_knorm(a, lds); }
SITE site_inproj(PA a, int l, LAS unsigned char* lds) { OPAQUE();
    pg8::Gemm g{WSP(const bf16_t, WS_XB), WSP(const bf16_t, WS_WIN) + (size_t)l * INW * 1024, 1024, 0, nullptr};
    pg8::StaticOrder S; S.init(T, INW, opq((int)gridDim.x), opq((int)blockIdx.x));
    pg8::EpiProj E{WSP(bf16_t, WS_PROJ), WSP(bf16_t, WS_VT), WSP(const float, WS_SS), INP(18) + l * 64, INP(19) + l * 64};
    pg8::gemm_phase<pg8::EpiProj, pg8::StaticOrder>(lds, g, S, E);
}
SITE site_prep(PA a, int l, LAS unsigned char* lds) { OPAQUE();
    pb_prep(a, l, lds);
}
SITE site_chunks(PA a, int l, LAS unsigned char* lds) { OPAQUE(); pb2_chunks(a, l, lds); }
SITE site_mixer(PA a, int l, LAS unsigned char* lds) { OPAQUE(); pc_mixer(a, l, lds); }
SITE site_outproj(PA a, int l, LAS unsigned char* lds) { OPAQUE();
    pg8::Gemm g{WSP(const bf16_t, WS_YCAT), WSP(const bf16_t, WS_WOUT) + (size_t)l * 1024 * 1024, 1024, 0, nullptr};
    pg8::StaticOrder S; S.init(T, 1024, opq((int)gridDim.x), opq((int)blockIdx.x));
    pg8::EpiRes E{WSP(bf16_t, WS_XB), WSP(float, WS_SS)};
    pg8::gemm_phase<pg8::EpiRes, pg8::StaticOrder>(lds, g, S, E);
}
SITE site_xq(PA a, int l, LAS unsigned char* lds) { OPAQUE();
    pg8::Gemm g{WSP(const bf16_t, WS_XB), WSP(const bf16_t, WS_WQ) + (size_t)l * 512 * 1024, 1024, 0, nullptr};
    pg8::StaticOrder S; S.init(T, 512, opq((int)gridDim.x), opq((int)blockIdx.x));
    pg8::EpiScale E{WSP(bf16_t, WS_QX), 512, WSP(const float, WS_SS), T - 1};
    pg8::gemm_phase<pg8::EpiScale, pg8::StaticOrder>(lds, g, S, E);
}
SITE site_xattn(PA a, int l, LAS unsigned char* lds) { OPAQUE(); pe2_xattn(a, l, lds); }
SITE site_xo(PA a, int l, LAS unsigned char* lds) { OPAQUE();
    pg8::Gemm g{WSP(const bf16_t, WS_OX), WSP(const bf16_t, WS_WO) + (size_t)l * 1024 * 512, 512, 0, nullptr};
    pg8::StaticOrder S; S.init(T, 1024, opq((int)gridDim.x), opq((int)blockIdx.x));
    pg8::EpiRes E{WSP(bf16_t, WS_XB), WSP(float, WS_SS)};
    pg8::gemm_phase<pg8::EpiRes, pg8::StaticOrder>(lds, g, S, E);
}
SITE site_router(PA a, int l, LAS unsigned char* lds) { OPAQUE(); pf_router(a, l, lds); }
SITE site_gather(PA a, int l, LAS unsigned char* lds) { OPAQUE(); pg_gather(a, l, lds); }
SITE site_gu(PA a, LAS unsigned char* lds) { OPAQUE();
    pg8::Gemm g{WSP(const bf16_t, WS_XB), WSP(const bf16_t, WS_WGU), 1024, (size_t)1024 * 1024, WSP(const int, WS_STOK)};
    pg8::MoeOrder S{WSP(const int, WS_MTE), opq((int)gridDim.x), opq((int)blockIdx.x)};
    pg8::EpiGU E{WSP(bf16_t, WS_HB), WSP(const float, WS_SRINV)};
    pg8::gemm_phase<pg8::EpiGU, pg8::MoeOrder, true, true>(lds, g, S, E);
}
SITE site_down(PA a, LAS unsigned char* lds) { OPAQUE();
    pg8::Gemm g{WSP(const bf16_t, WS_HB), WSP(const bf16_t, WS_WD), 512, (size_t)1024 * 512, nullptr};
    pg8::MoeOrder S{WSP(const int, WS_MTE), opq((int)gridDim.x), opq((int)blockIdx.x)};
    pg8::EpiDown E{WSP(bf16_t, WS_Y), WSP(const int, WS_SSLOT), WSP(const float, WS_SW)};
    pg8::gemm_phase<pg8::EpiDown, pg8::MoeOrder>(lds, g, S, E);
}
SITE site_final(PA a, int l, LAS unsigned char* lds) { OPAQUE(); pj_finalize(a, l == NL - 1); }

__global__ void __launch_bounds__(512, 2) mk_fwd(Args args) {
    extern __shared__ __attribute__((aligned(16))) unsigned char lds_raw[];
    LAS unsigned char* lds = (LAS unsigned char*)lds_raw;
    const int tid = threadIdx.x;
    const int lo = args.ph_lo, hi = args.ph_hi;
    PA a; a.out = args.out; a.ws = args.ws;
    if (tid < 16) ((LAS unsigned*)(lds + LDS_MISC))[tid] = 0u;
    if (tid == 64) {
        LAS unsigned long long* tab = (LAS unsigned long long*)(lds + LDS_INTAB);
#pragma unroll
        for (int i = 0; i < 38; ++i) tab[i] = (unsigned long long)args.in[i];
        tab[38] = (unsigned long long)args.out; tab[39] = (unsigned long long)args.ws;
    }
    __syncthreads();
    XcdBarrier bar; bar.bar = WSP(unsigned, WS_CTL) + CW_BAR; bar.x = 0; bar.st = nullptr;
    if (!MK_PER_PHASE) bar = xcd_barrier_post(WSP(unsigned, WS_CTL) + CW_BAR, (volatile LAS unsigned*)(lds + LDS_MISC));
#define IN(k) (lo <= (k) && (k) < hi)
#define GRID_BAR() do { if (!MK_PER_PHASE) xcd_barrier(bar); } while (0)
#ifdef PROBE_MASK
    unsigned long long pr_acc = 0ull, pr_t0 = 0ull; const unsigned long long pr_start = wall_clock64();
#define PR0() do { pr_t0 = wall_clock64(); } while (0)
#define PR1(p) do { if ((PROBE_MASK >> (p)) & 1) pr_acc += wall_clock64() - pr_t0; } while (0)
#else
#define PR0() do { } while (0)
#define PR1(p) do { } while (0)
#endif
    PR0(); if (IN(0)) { site_p0(a, lds); GRID_BAR(); } PR1(12);
    PR0(); if (IN(1)) { site_kv(a, lds); GRID_BAR(); } PR1(13);
    PR0(); if (IN(2)) { site_knorm(a, lds); GRID_BAR(); } PR1(14);
    for (int l = 0; l < NL; ++l) {
        const int pb = 3 + 12 * l;
        PR0(); if (IN(pb + 0)) { site_inproj(a, l, lds); GRID_BAR(); } PR1(0);
        PR0(); if (IN(pb + 1)) { site_prep(a, l, lds); GRID_BAR(); } PR1(1);
        PR0(); if (IN(pb + 2)) { site_mixer(a, l, lds); GRID_BAR(); } PR1(2);
        PR0(); if (IN(pb + 3)) { site_outproj(a, l, lds); GRID_BAR(); } PR1(3);
        PR0(); if (IN(pb + 4)) { site_xq(a, l, lds); GRID_BAR(); } PR1(4);
        PR0(); if (IN(pb + 5)) { site_xattn(a, l, lds); GRID_BAR(); } PR1(5);
        PR0(); if (IN(pb + 6)) { site_xo(a, l, lds); GRID_BAR(); } PR1(6);
        PR0(); if (IN(pb + 7)) { site_router(a, l, lds); GRID_BAR(); } PR1(7);
        PR0(); if (IN(pb + 8)) { site_gather(a, l, lds); GRID_BAR(); } PR1(8);
        PR0(); if (IN(pb + 9)) { site_gu(a, lds); GRID_BAR(); } PR1(9);
        PR0(); if (IN(pb + 10)) { site_down(a, lds); GRID_BAR(); } PR1(10);
#ifdef PROBE_MASK
        PR0(); if (IN(pb + 11)) { site_final(a, l, lds); GRID_BAR(); } PR1(11);
#else
        if (IN(pb + 11)) { site_final(a, l, lds); if (l + 1 < NL) GRID_BAR(); }
#endif
    }
#ifdef PROBE_MASK
    {
        unsigned long long* pw = (unsigned long long*)(WSP(unsigned, WS_CTL) + 8192);
        if (blockIdx.x == 0 && tid == 0) __hip_atomic_store(pw, pr_acc, __ATOMIC_RELAXED, __HIP_MEMORY_SCOPE_AGENT);
        GRID_BAR();
        const unsigned long long tgt = 1600000ull + __hip_atomic_load(pw, __ATOMIC_RELAXED, __HIP_MEMORY_SCOPE_AGENT) * (unsigned long long)PROBE_MULT;
        while (wall_clock64() - pr_start < tgt) __builtin_amdgcn_s_sleep(16);
    }
#endif
#undef IN
#undef GRID_BAR
}

extern "C" void kernel_launch(void* const* d_in, const int* in_sizes, int n_in, void* d_out, int out_size, void* d_ws, size_t ws_size, hipStream_t stream) {
    static int grid = 0;
    if (grid == 0) {
        if (n_in != 38 || out_size != T * D || ws_size < WS_END) { fprintf(stderr, "kernel_launch: unexpected shapes (n_in %d out %d ws %zu need %zu)\n", n_in, out_size, ws_size, (size_t)WS_END); grid = -1; return; }
        int dev = 0, cus = 0, per_cu = 0;
        if (hipGetDevice(&dev) != hipSuccess || hipDeviceGetAttribute(&cus, hipDeviceAttributeMultiprocessorCount, dev) != hipSuccess) { grid = -1; return; }
        if (hipFuncSetAttribute((const void*)mk_fwd, hipFuncAttributeMaxDynamicSharedMemorySize, LDS_BYTES) != hipSuccess) { fprintf(stderr, "kernel_launch: hipFuncSetAttribute failed\n"); grid = -1; return; }
        if (hipOccupancyMaxActiveBlocksPerMultiprocessor(&per_cu, (const void*)mk_fwd, 512, LDS_BYTES) != hipSuccess || per_cu < 1) { fprintf(stderr, "kernel_launch: occupancy query says %d\n", per_cu); }
        (void)hipGetLastError();
        grid = cus;
    }
    if (grid < 0) return;
    (void)hipMemsetAsync((char*)d_ws + WS_CTL, 0, CTL_BYTES, stream);
    Args a{};
    for (int i = 0; i < 38; ++i) a.in[i] = (const float*)d_in[i];
    a.out = (float*)d_out; a.ws = (unsigned char*)d_ws;
#if MK_PER_PHASE
    for (int p = 0; p < NPH; ++p) { a.ph_lo = p; a.ph_hi = p + 1; hipLaunchKernelGGL(mk_fwd, dim3(grid), dim3(512), LDS_BYTES, stream, a); }
#else
    a.ph_lo = 0; a.ph_hi = NPH;
    hipLaunchKernelGGL(mk_fwd, dim3(grid), dim3(512), LDS_BYTES, stream, a);
#endif
}
```

```cpp
#include <hip/hip_runtime.h>
#include <cstdio>
#include <cstdint>

#ifndef MK_PER_PHASE
#define MK_PER_PHASE 0
#endif

#define LAS __attribute__((address_space(3)))
typedef unsigned short bf16_t;
typedef short bf16x8 __attribute__((ext_vector_type(8)));
typedef float f32x4 __attribute__((ext_vector_type(4)));
typedef unsigned u32x4 __attribute__((ext_vector_type(4)));
typedef unsigned u32x2 __attribute__((ext_vector_type(2)));

constexpr int T = 32768, D = 1024, SEQ = 2048, NL = 4;
constexpr int INW = 3328;
constexpr int MROWS = 4096;
constexpr int MAXROWS = 73728, MAXMT = 288;
constexpr int NPH = 3 + 12 * NL;

constexpr size_t WS_CTL   = 0;
constexpr size_t CTL_BYTES = 65536;
constexpr size_t WS_WIN   = WS_CTL + CTL_BYTES;
constexpr size_t WS_WOUT  = WS_WIN  + (size_t)4 * 3328 * 1024 * 2;
constexpr size_t WS_WQ    = WS_WOUT + (size_t)4 * 1024 * 1024 * 2;
constexpr size_t WS_WKV   = WS_WQ   + (size_t)4 * 512 * 1024 * 2;
constexpr size_t WS_WO    = WS_WKV  + (size_t)4 * 1024 * 1024 * 2;
constexpr size_t WS_WGU   = WS_WO   + (size_t)4 * 1024 * 512 * 2;
constexpr size_t WS_WD    = WS_WGU  + (size_t)32 * 1024 * 1024 * 2;
constexpr size_t WS_KV    = WS_WD   + (size_t)32 * 1024 * 512 * 2;
constexpr size_t WS_MEMB  = WS_KV   + (size_t)4 * 4096 * 1024 * 2;
constexpr size_t WS_MEMSS = WS_MEMB + (size_t)4096 * 1024 * 2;
constexpr size_t WS_VTX   = WS_MEMSS + (size_t)4096 * 16 * 4;
constexpr size_t WS_WRH   = WS_VTX  + (size_t)4 * 4096 * 512 * 2;
constexpr size_t WS_WRL   = WS_WRH  + (size_t)4 * 48 * 1024 * 2;
constexpr size_t WS_PBI   = WS_WRL  + (size_t)4 * 48 * 1024 * 2;
constexpr int PBI_BYTES = 122880;
constexpr size_t WS_XB    = WS_PBI  + (size_t)16 * PBI_BYTES;
constexpr size_t WS_SS    = WS_XB   + (size_t)T * 1024 * 2;
constexpr size_t WS_VF    = WS_SS   + (size_t)T * 16 * 4;
constexpr size_t WS_EID   = WS_VF   + (size_t)T * 512 * 2;
constexpr size_t WS_EW    = WS_EID  + (size_t)T * 2 * 4;
constexpr size_t WS_ERK   = WS_EW   + (size_t)T * 2 * 4;
constexpr size_t WS_SSLOT = WS_ERK  + (size_t)T * 2 * 4;
constexpr size_t WS_SW    = WS_SSLOT + (size_t)MAXROWS * 4;
constexpr size_t WS_MTE   = WS_SW   + (size_t)MAXROWS * 4;
constexpr size_t WS_STOK  = WS_MTE  + 2048;
constexpr size_t WS_SRINV = WS_STOK + (size_t)MAXROWS * 4;
constexpr size_t WS_U     = WS_SRINV + (size_t)MAXROWS * 4;
constexpr size_t WS_PROJ  = WS_U;
constexpr size_t WS_SR    = WS_PROJ + (size_t)T * 3328 * 2;
constexpr size_t WS_SK    = WS_SR   + (size_t)T * 512 * 2;
constexpr size_t WS_SV    = WS_SK   + (size_t)T * 512 * 2;
constexpr size_t WS_SA    = WS_SV   + (size_t)T * 512 * 2;
constexpr size_t WS_SB    = WS_SA   + (size_t)T * 512 * 2;
constexpr size_t WS_SG    = WS_SB   + (size_t)T * 512 * 2;
constexpr size_t WS_SWD   = WS_SG   + (size_t)T * 512 * 2;
constexpr size_t WS_YCAT  = WS_SWD  + (size_t)T * 512 * 4;
constexpr size_t WS_VT    = WS_YCAT + (size_t)T * 1024 * 2;
constexpr int NCHUNK = 16 * 8 * 128;
constexpr size_t WS_BTT   = WS_VT   + (size_t)T * 512 * 2;
constexpr size_t WS_KTT   = WS_BTT  + (size_t)NCHUNK * 2048;
constexpr size_t WS_VST   = WS_KTT  + (size_t)NCHUNK * 2048;
constexpr size_t WS_NKA   = WS_VST  + (size_t)NCHUNK * 2048;
constexpr size_t WS_NBR   = WS_NKA  + (size_t)NCHUNK * 512;
constexpr size_t WS_NKR   = WS_NBR  + (size_t)NCHUNK * 512;
constexpr size_t WS_TMT   = WS_NKR  + (size_t)NCHUNK * 512;
constexpr size_t WS_PCK   = WS_TMT  + (size_t)NCHUNK * 512;
constexpr size_t WS_BS    = WS_PCK  + (size_t)NCHUNK * 256;
constexpr size_t WS_KFR   = WS_SK;
constexpr size_t WS_UEND1 = WS_BS   + (size_t)T * 8 * 4;
constexpr size_t WS_QX    = WS_U;
constexpr size_t WS_OX    = WS_QX   + (size_t)T * 512 * 2;
constexpr size_t WS_XS    = WS_U;
constexpr size_t WS_HB    = WS_XS   + (size_t)MAXROWS * 1024 * 2;
constexpr size_t WS_Y     = WS_HB   + (size_t)MAXROWS * 512 * 2;
constexpr size_t WS_UEND2 = WS_Y    + (size_t)2 * T * 1024 * 2;
constexpr size_t WS_END   = WS_UEND1 > WS_UEND2 ? WS_UEND1 : WS_UEND2;

constexpr int CW_BAR = 0;
constexpr int CW_CNT = 4096;
constexpr int CW_QUEUE = 4096 + 256;

constexpr int LDS_MISC = 139264;
constexpr int LDS_BYTES = LDS_MISC + 16384;

struct Args { const float* in[38]; float* out; unsigned char* ws; int ph_lo, ph_hi; };
struct PA { float* out; unsigned char* ws; };

__device__ __forceinline__ float bf2f(bf16_t b) { return __uint_as_float(((unsigned)b) << 16); }
__device__ __forceinline__ bf16_t f2bf(float f) { unsigned u = __float_as_uint(f); u += 0x7FFFu + ((u >> 16) & 1u); return (bf16_t)(u >> 16); }
typedef __bf16 bf16v2 __attribute__((ext_vector_type(2)));
typedef float f32x2 __attribute__((ext_vector_type(2)));
__device__ __forceinline__ unsigned pk2(float lo, float hi) { f32x2 v = {lo, hi}; bf16v2 b = __builtin_convertvector(v, bf16v2); return __builtin_bit_cast(unsigned, b); }
__device__ __forceinline__ float lo16(unsigned u) { return __uint_as_float(u << 16); }
__device__ __forceinline__ float hi16(unsigned u) { return __uint_as_float(u & 0xffff0000u); }
__device__ __forceinline__ float wsum(float v) {
#pragma unroll
    for (int o = 32; o; o >>= 1) v += __shfl_xor(v, o);
    return v;
}
__device__ __forceinline__ float sigmoidf_(float x) { return 1.0f / (1.0f + __expf(-x)); }

#define XB_TMO      128
#define XB_XCNT(j)  (256  + 64 * (j))
#define XB_XSUB(j)  (1280 + 64 * (j))
#define XB_XGEN(j)  (2304 + 64 * (j))
#define XB_TOP      3328
#define XB_TOPGEN   3392
#define XCD_BAR_WORDS 3456
#define XB_SPIN_CAP (1u << 22)

__device__ __forceinline__ unsigned xb_ld(unsigned* p)              { return __hip_atomic_load(p, __ATOMIC_RELAXED, __HIP_MEMORY_SCOPE_AGENT); }
__device__ __forceinline__ unsigned xb_add(unsigned* p, unsigned v) { return __hip_atomic_fetch_add(p, v, __ATOMIC_RELAXED, __HIP_MEMORY_SCOPE_AGENT); }
__device__ __forceinline__ unsigned xb_xcc_id() { return (unsigned)__builtin_amdgcn_s_getreg((3 << 11) | 20) & 0xFu; }
#define XB_SPIN(cond, bar) do { unsigned _sp = 0; while (cond) { __builtin_amdgcn_s_sleep(1); \
    if ((++_sp & 255u) == 0u) { if (xb_ld(&(bar)[XB_TMO])) break; if (_sp > XB_SPIN_CAP) { atomicAdd(&(bar)[XB_TMO], 1u); break; } } } } while (0)

struct XcdBarrier { unsigned* bar; unsigned x; volatile LAS unsigned* st; };

__device__ __forceinline__ XcdBarrier xcd_barrier_post(unsigned* bar, volatile LAS unsigned* st) {
    XcdBarrier b; b.bar = bar; b.x = xb_xcc_id(); b.st = st;
    if (threadIdx.x == 0) (void)xb_add(&bar[XB_XCNT(b.x)], 1u);
    return b;
}
__device__ __forceinline__ void xcd_barrier_complete(unsigned* bar, unsigned x, unsigned& nloc, unsigned& nx) {
    const unsigned G = gridDim.x * gridDim.y * gridDim.z;
    unsigned sum, cnt, mine, sp = 0u;
    for (;;) {
        sum = 0u; cnt = 0u; mine = 0u;
#pragma unroll
        for (unsigned j = 0; j < 16; ++j) { const unsigned c = xb_ld(&bar[XB_XCNT(j)]); sum += c; cnt += (c > 0u) ? 1u : 0u; mine = (j == x) ? c : mine; }
        if (sum == G) break;
        __builtin_amdgcn_s_sleep(1);
        if ((++sp & 255u) == 0u) { if (xb_ld(&bar[XB_TMO])) break; if (sp > XB_SPIN_CAP) { atomicAdd(&bar[XB_TMO], 1u); break; } }
    }
    nloc = mine > 0u ? mine : 1u; nx = cnt > 0u ? cnt : 1u;
}
__device__ __forceinline__ void xcd_barrier(const XcdBarrier& b) {
    asm volatile("s_waitcnt vmcnt(0)" ::: "memory");
    __syncthreads();
    if (threadIdx.x == 0) {
        unsigned* bar = b.bar;
        __builtin_amdgcn_s_waitcnt(0);
        unsigned nloc = b.st[0], nx = b.st[1];
        if (nloc == 0u) { xcd_barrier_complete(bar, b.x, nloc, nx); b.st[0] = nloc; b.st[1] = nx; }
        const unsigned old = xb_add(&bar[XB_XSUB(b.x)], 1u);
        const unsigned gen = old / nloc;
        if (old + 1u == (gen + 1u) * nloc) {
            __builtin_amdgcn_fence(__ATOMIC_RELEASE, "agent");
            asm volatile("s_waitcnt vmcnt(0)" ::: "memory");
            const unsigned og = xb_add(&bar[XB_TOP], 1u);
            const unsigned tg = og / nx;
            if (og + 1u == (tg + 1u) * nx) xb_add(&bar[XB_TOPGEN], 1u);
            else XB_SPIN(xb_ld(&bar[XB_TOPGEN]) == tg, bar);
            __builtin_amdgcn_fence(__ATOMIC_ACQUIRE, "agent");
            xb_add(&bar[XB_XGEN(b.x)], 1u);
            asm volatile("s_waitcnt vmcnt(0)" ::: "memory");
        } else {
            XB_SPIN(xb_ld(&bar[XB_XGEN(b.x)]) == gen, bar);
            __builtin_amdgcn_fence(__ATOMIC_ACQUIRE, "agent");
            asm volatile("s_waitcnt vmcnt(0)" ::: "memory");
        }
    }
    __syncthreads();
}

namespace pg8 {
constexpr int BM = 256, BK = 64, HALF = 128, HTB = HALF * BK * 2, STAGE_BYTES = 8 * HTB, NXCD = 8, WGM = 8;
__host__ __device__ __forceinline__ int lds_byte(int r, int c) { const int st = (r >> 4) * 2 + (c >> 5), rr = r & 15, cc = c & 31, ob = rr * 64 + cc * 2; return st * 1024 + (ob ^ (((ob >> 9) & 1) << 5)); }
__host__ __device__ __forceinline__ void stage_rc(int b, int& R, int& C) { const int st = b / 1024, sb = b % 1024, swz = sb ^ (((sb >> 9) & 1) << 5); R = (st >> 1) * 16 + swz / 64; C = (st & 1) * 32 + (swz % 64) / 2; }
__host__ __device__ __forceinline__ int perm32(int rho) { const int n = rho >> 4, i = rho & 15; return 8 * (i >> 2) + 4 * n + (i & 3); }

struct Unit { int pm, pn, pa, z; };
struct Gemm { const bf16_t* A; const bf16_t* Bt; int K; size_t bz_stride; const int* rowidx; };

struct StaticOrder {
    int nM, nN, nwg, G, c;
    __device__ void init(int M, int N, int G_, int c_) { nM = M / BM; nN = N / BM; nwg = nM * nN; G = G_; c = c_; }
    __device__ bool next(int i, Unit& u) const {
        const long L = (long)i * G + c; if (L >= nwg) return false;
        int wgid = (int)L; { const int q = nwg / NXCD, r = nwg % NXCD, xcd = wgid % NXCD, off = wgid / NXCD; wgid = (xcd < r ? xcd * (q + 1) : r * (q + 1) + (xcd - r) * q) + off; }
        const int nig = WGM * nN, gid = wgid / nig, fm = gid * WGM, gsz = (nM - fm) < WGM ? (nM - fm) : WGM;
        u.pm = fm + ((wgid % nig) % gsz); u.pn = (wgid % nig) / gsz; u.pa = u.pm; u.z = 0; return true;
    }
};
struct KvOrder {
    int G, c;
    __device__ bool next(int i, Unit& u) const {
        const int L = i * G + c; if (L >= 256) return false;
        u.z = L >> 6; const int r = L & 63; u.pa = r >> 2; u.pn = r & 3; u.pm = u.z * 16 + u.pa; return true;
    }
};
struct MoeOrder {
    const int* mte; int G, c;
    int b0[4], b1[4];
    __device__ void init() {
        const int x = c & 7;
#pragma unroll
        for (int k = 0; k < 4; ++k) { b0[k] = mte[400 + x + 8 * k]; b1[k] = mte[401 + x + 8 * k]; }
#pragma unroll
        for (int k = 0; k < 4; ++k) { b0[k] = __builtin_amdgcn_readfirstlane(b0[k]); b1[k] = __builtin_amdgcn_readfirstlane(b1[k]); }
    }
    __device__ bool next(int i, Unit& u) const {
        if ((G & 7) != 0) {
            const int nunits = mte[511] * 4;
            const int L = i * G + c; if (L >= nunits) return false;
            u.pm = L >> 2; u.pa = u.pm; u.pn = L & 3; u.z = mte[u.pm]; return true;
        }
        const int x = c & 7; int q = i * (G >> 3) + (c >> 3);
#pragma unroll
        for (int k = 0; k < 4; ++k) {
            const int e = x + 8 * k; const int m0 = b0[k], m1 = b1[k]; const int n = (m1 - m0) * 4;
            if (q < n) { u.pm = m0 + (q >> 2); u.pa = u.pm; u.pn = q & 3; u.z = e; return true; }
            q -= n;
        }
        return false;
    }
};

template <class Epi, class Sched, bool ALIGN_EPI = true, bool GATHER = false>
__device__ __forceinline__ void gemm_phase(LAS unsigned char* lds, const Gemm g, const Sched& S, const Epi& E) {
    int tid_ = threadIdx.x; asm volatile("" : "+v"(tid_));
    const int tid = tid_, wid = __builtin_amdgcn_readfirstlane(tid >> 6), lane = tid & 63, wr = wid >> 2, wc = wid & 3, fr = lane & 15, fq = lane >> 4;
    const int K = g.K, nt = K / BK;
    unsigned voffA[2], voffB[2], gcol[2]; int grow[2];
#pragma unroll
    for (int i = 0; i < 2; ++i) { int R, C; stage_rc(tid * 16 + i * 8192, R, C); const int Rb = ((R & ~31) + perm32(R & 31));
        voffA[i] = (unsigned)(R * K + C) * 2u; voffB[i] = (unsigned)(Rb * K + C) * 2u; grow[i] = R; gcol[i] = (unsigned)C * 2u; }
    const size_t kstep = (size_t)(BK * 2);
    const size_t hstep = (size_t)HALF * K * 2;
    const size_t tstep = 2 * hstep;
    const unsigned ldsw = (unsigned)wid * 1024u;
    const int aoff = lds_byte(wr * 64 + fr, fq * 8), boff = lds_byte(wc * 32 + fr, fq * 8);
#define PG8_SA(b, h) (((b) * 2 + (h)) * HTB)
#define PG8_SB(b, h) ((4 + (b) * 2 + (h)) * HTB)
#define PG8_STAGE(bufoff, gbase, voff) do { _Pragma("unroll") for (int _i = 0; _i < 2; ++_i) \
        __builtin_amdgcn_global_load_lds((const unsigned*)((const char*)(gbase) + (voff)[_i]), (LAS unsigned*)(lds + (bufoff) + ldsw + _i * 8192), 16, 0, 0); } while (0)
#define PG8_LDA(dst, b, h) do { _Pragma("unroll") for (int m = 0; m < 4; ++m) _Pragma("unroll") for (int k = 0; k < 2; ++k) dst[m][k] = *(const LAS bf16x8*)(lds + PG8_SA(b, h) + aoff + m * 2048 + k * 1024); } while (0)
#define PG8_LDB(dst, b, h) do { _Pragma("unroll") for (int n = 0; n < 2; ++n) _Pragma("unroll") for (int k = 0; k < 2; ++k) dst[n][k] = *(const LAS bf16x8*)(lds + PG8_SB(b, h) + boff + n * 2048 + k * 1024); } while (0)
#define PG8_MMA(ai, bj, At, Bt) do { __builtin_amdgcn_s_setprio(1); _Pragma("unroll") for (int m = 0; m < 4; ++m) _Pragma("unroll") for (int n = 0; n < 2; ++n) _Pragma("unroll") for (int k = 0; k < 2; ++k) \
        acc[ai][bj][m][n] = __builtin_amdgcn_mfma_f32_16x16x32_bf16(Bt[n][k], At[m][k], acc[ai][bj][m][n], 0, 0, 0); __builtin_amdgcn_s_setprio(0); } while (0)
#define PG8_WAIT_V(n) asm volatile("s_waitcnt vmcnt(" #n ")" ::: "memory")
#define PG8_WAIT_L(n) asm volatile("s_waitcnt lgkmcnt(" #n ")" ::: "memory")
#define PG8_BAR __builtin_amdgcn_s_barrier()
#define PG8_SCHED __builtin_amdgcn_sched_barrier(0)
#define PG8_APTR(u) ((const char*)g.A + (size_t)(u).pa * tstep)
#define PG8_BPTR(u) ((const char*)g.Bt + ((size_t)(u).z * g.bz_stride) * 2 + (size_t)(u).pn * tstep)
    Unit cur, nxt; int ui = 0;
    if (!S.next(0, cur)) return;
    f32x4 acc[2][2][4][2];
#pragma unroll
    for (int a = 0; a < 2; ++a)
#pragma unroll
        for (int b = 0; b < 2; ++b)
#pragma unroll
            for (int m = 0; m < 4; ++m)
#pragma unroll
                for (int n = 0; n < 2; ++n) acc[a][b][m][n] = (f32x4){0.f, 0.f, 0.f, 0.f};
    bf16x8 At[4][2], B0[2][2], B1[2][2];
    const char* cA = GATHER ? (const char*)g.A : PG8_APTR(cur); const char* cB = PG8_BPTR(cur);
    unsigned gcu[2][2] = {{0u, 0u}, {0u, 0u}}, gnx[2][2] = {{0u, 0u}, {0u, 0u}};
#define PG8_GOFF(dst, u) do { _Pragma("unroll") for (int h_ = 0; h_ < 2; ++h_) _Pragma("unroll") for (int i_ = 0; i_ < 2; ++i_) \
        dst[h_][i_] = (unsigned)g.rowidx[(u).pa * 256 + h_ * 128 + grow[i_]] * (unsigned)(K * 2) + gcol[i_]; } while (0)
    if constexpr (GATHER) PG8_GOFF(gcu, cur);
#define PG8_STAGE_A(bufoff, h_, nonGatherPtr, gatherBase, GO) do { if constexpr (GATHER) { PG8_STAGE(bufoff, gatherBase, GO[h_]); } else { PG8_STAGE(bufoff, nonGatherPtr, voffA); } } while (0)
    PG8_STAGE(PG8_SB(0, 0), cB, voffB); PG8_STAGE(PG8_SB(0, 1), cB + hstep, voffB); PG8_STAGE_A(PG8_SA(0, 0), 0, cA, cA, gcu); PG8_STAGE_A(PG8_SA(0, 1), 1, cA + hstep, cA, gcu);
    if (wr == 1) PG8_BAR;
    PG8_WAIT_V(2); PG8_BAR;
    PG8_STAGE(PG8_SB(1, 0), cB + kstep, voffB); PG8_STAGE_A(PG8_SA(1, 0), 0, cA + kstep, cA + kstep, gcu); PG8_STAGE(PG8_SB(1, 1), cB + hstep + kstep, voffB);
    PG8_WAIT_V(6); PG8_BAR;
    for (;;) {
        const bool has_next = S.next(ui + 1, nxt);
        const char* nA = GATHER ? cA : (has_next ? PG8_APTR(nxt) : cA); const char* nB = has_next ? PG8_BPTR(nxt) : cB;
        if constexpr (GATHER) { if (has_next) PG8_GOFF(gnx, nxt); else { _Pragma("unroll") for (int h_ = 0; h_ < 2; ++h_) _Pragma("unroll") for (int i_ = 0; i_ < 2; ++i_) gnx[h_][i_] = gcu[h_][i_]; } }
        for (int t = 0; t < nt; t += 2) {
            const bool last = (t == nt - 2);
            const char* a1 = cA + (size_t)(t + 1) * kstep;
            const char* a2 = last ? nA : cA + (size_t)(t + 2) * kstep; const char* b2 = last ? nB : cB + (size_t)(t + 2) * kstep;
            const char* a3 = a2 + kstep; const char* b3 = b2 + kstep;
            unsigned gse[2][2];
            _Pragma("unroll") for (int h_ = 0; h_ < 2; ++h_) _Pragma("unroll") for (int i_ = 0; i_ < 2; ++i_) gse[h_][i_] = last ? gnx[h_][i_] : gcu[h_][i_];
            PG8_LDB(B0, 0, 0); PG8_LDB(B1, 0, 1); PG8_SCHED; PG8_LDA(At, 0, 0); PG8_STAGE_A(PG8_SA(1, 1), 1, a1 + hstep, a1, gcu);
            PG8_WAIT_V(8); PG8_WAIT_L(0); PG8_BAR; PG8_MMA(0, 0, At, B0); PG8_MMA(0, 1, At, B1); PG8_BAR; PG8_SCHED;
            PG8_LDA(At, 0, 1); PG8_STAGE(PG8_SB(0, 0), b2, voffB); PG8_STAGE(PG8_SB(0, 1), b2 + hstep, voffB); PG8_STAGE_A(PG8_SA(0, 0), 0, a2, a2, gse);
            PG8_WAIT_V(8); PG8_WAIT_L(0); PG8_BAR; PG8_MMA(1, 0, At, B0); PG8_MMA(1, 1, At, B1); PG8_BAR; PG8_SCHED;
            PG8_LDB(B0, 1, 0); PG8_LDB(B1, 1, 1); PG8_SCHED; PG8_LDA(At, 1, 0); PG8_STAGE_A(PG8_SA(0, 1), 1, a2 + hstep, a2, gse);
            PG8_WAIT_V(8); PG8_WAIT_L(0); PG8_BAR; PG8_MMA(0, 0, At, B0); PG8_MMA(0, 1, At, B1); PG8_BAR; PG8_SCHED;
            PG8_LDA(At, 1, 1); PG8_STAGE(PG8_SB(1, 0), b3, voffB); PG8_STAGE(PG8_SB(1, 1), b3 + hstep, voffB); PG8_STAGE_A(PG8_SA(1, 0), 0, a3, a3, gse);
            PG8_WAIT_V(8); PG8_WAIT_L(0); PG8_BAR; PG8_MMA(1, 0, At, B0); PG8_MMA(1, 1, At, B1); PG8_BAR; PG8_SCHED;
        }
        if constexpr (ALIGN_EPI) { if (wr == 0) PG8_BAR; }
        E(acc, cur, wr, wc, fr, fq);
        if (!has_next) break;
#pragma unroll
        for (int a = 0; a < 2; ++a)
#pragma unroll
            for (int b = 0; b < 2; ++b)
#pragma unroll
                for (int m = 0; m < 4; ++m)
#pragma unroll
                    for (int n = 0; n < 2; ++n) acc[a][b][m][n] = (f32x4){0.f, 0.f, 0.f, 0.f};
        cur = nxt; cA = nA; cB = nB; ++ui;
        if constexpr (GATHER) { _Pragma("unroll") for (int h_ = 0; h_ < 2; ++h_) _Pragma("unroll") for (int i_ = 0; i_ < 2; ++i_) gcu[h_][i_] = gnx[h_][i_]; }
        if constexpr (ALIGN_EPI) { if (wr == 1) PG8_BAR; }
    }
    PG8_WAIT_V(0);
    if constexpr (!ALIGN_EPI) { if (wr == 0) PG8_BAR; }
    PG8_BAR;
#undef PG8_SA
#undef PG8_SB
#undef PG8_STAGE
#undef PG8_LDA
#undef PG8_LDB
#undef PG8_MMA
#undef PG8_WAIT_V
#undef PG8_WAIT_L
#undef PG8_BAR
#undef PG8_SCHED
#undef PG8_APTR
#undef PG8_BPTR
#undef PG8_GOFF
#undef PG8_STAGE_A
}

typedef const f32x4 (&AccRef)[2][2][4][2];

__device__ __forceinline__ f32x4 ss_part(const float* ss, size_t row, int fq) { return *(const f32x4*)(ss + row * 16 + 4 * fq); }
__device__ __forceinline__ float ss_tot(f32x4 s) { float p = (s[0] + s[1]) + (s[2] + s[3]); p += __shfl_xor(p, 16); p += __shfl_xor(p, 32); return p; }
#define EPI_FENCE8(v) asm volatile("s_waitcnt vmcnt(0)" : "+v"((v)[0][0]), "+v"((v)[0][1]), "+v"((v)[0][2]), "+v"((v)[0][3]), "+v"((v)[1][0]), "+v"((v)[1][1]), "+v"((v)[1][2]), "+v"((v)[1][3]) :: "memory")
struct EpiScale {
    bf16_t* O; int ldc; const float* ss; int ssmask;
    __device__ __forceinline__ void operator()(AccRef acc, const Unit& u, int wr, int wc, int fr, int fq) const {
        f32x4 sv[2][4]; float rv[2][4];
#pragma unroll
        for (int ai = 0; ai < 2; ++ai)
#pragma unroll
            for (int m = 0; m < 4; ++m) sv[ai][m] = ss_part(ss, (size_t)((u.pm * 256 + ai * 128 + wr * 64 + m * 16 + fr) & ssmask), fq);
        EPI_FENCE8(sv);
#pragma unroll
        for (int ai = 0; ai < 2; ++ai)
#pragma unroll
            for (int m = 0; m < 4; ++m) rv[ai][m] = rsqrtf(ss_tot(sv[ai][m]) * (1.0f / 1024.0f) + 1e-6f);
#pragma unroll
        for (int ai = 0; ai < 2; ++ai)
#pragma unroll
            for (int m = 0; m < 4; ++m) {
                const int row = u.pm * 256 + ai * 128 + wr * 64 + m * 16 + fr;
                const float rinv = rv[ai][m];
#pragma unroll
                for (int bj = 0; bj < 2; ++bj) {
                    const int col = u.pn * 256 + bj * 128 + wc * 32 + 8 * fq;
                    const f32x4 v0 = acc[ai][bj][m][0] * rinv, v1 = acc[ai][bj][m][1] * rinv;
                    u32x4 w; w.x = pk2(v0[0], v0[1]); w.y = pk2(v0[2], v0[3]); w.z = pk2(v1[0], v1[1]); w.w = pk2(v1[2], v1[3]);
                    *(u32x4*)(O + (size_t)row * ldc + col) = w;
                }
            }
    }
};
struct EpiProj {
    bf16_t* O; bf16_t* VT; bf16_t* KF; const float* ss; const float* qg; const float* kg;
    __device__ __forceinline__ void operator()(AccRef acc, const Unit& u, int wr, int wc, int fr, int fq) const {
        f32x4 sv[2][4]; float rv[2][4];
#pragma unroll
        for (int ai = 0; ai < 2; ++ai)
#pragma unroll
            for (int m = 0; m < 4; ++m) sv[ai][m] = ss_part(ss, (size_t)(u.pm * 256 + ai * 128 + wr * 64 + m * 16 + fr), fq);
        if (u.pn >= 7 && u.pn <= 10) {
            const bool isk = u.pn >= 9; const float* gp = isk ? kg : qg;
            const int head = ((u.pn - 7) & 1) * 4 + wc;
            f32x4 g00 = *(const f32x4*)(gp + 8 * fq), g01 = *(const f32x4*)(gp + 8 * fq + 4), g10 = *(const f32x4*)(gp + 32 + 8 * fq), g11 = *(const f32x4*)(gp + 32 + 8 * fq + 4);
            const float qsc = isk ? 1.0f : 0.18033688011112042f;
#pragma unroll
            for (int ai = 0; ai < 2; ++ai)
#pragma unroll
                for (int m = 0; m < 4; ++m) rv[ai][m] = 0.f;
            EPI_FENCE8(sv);
            asm volatile("" : "+v"(g00), "+v"(g01), "+v"(g10), "+v"(g11));
#pragma unroll
            for (int ai = 0; ai < 2; ++ai)
#pragma unroll
                for (int m = 0; m < 4; ++m) rv[ai][m] = ss_tot(sv[ai][m]) * (1.0f / 1024.0f) + 1e-6f;
#pragma unroll
            for (int ai = 0; ai < 2; ++ai)
#pragma unroll
                for (int m = 0; m < 4; ++m) {
                    const int row = u.pm * 256 + ai * 128 + wr * 64 + m * 16 + fr;
                    const f32x4 a0 = acc[ai][0][m][0], a1 = acc[ai][0][m][1], b0 = acc[ai][1][m][0], b1 = acc[ai][1][m][1];
                    float sq = ((a0[0] * a0[0] + a0[1] * a0[1]) + (a0[2] * a0[2] + a0[3] * a0[3])) + ((a1[0] * a1[0] + a1[1] * a1[1]) + (a1[2] * a1[2] + a1[3] * a1[3]))
                             + ((b0[0] * b0[0] + b0[1] * b0[1]) + (b0[2] * b0[2] + b0[3] * b0[3])) + ((b1[0] * b1[0] + b1[1] * b1[1]) + (b1[2] * b1[2] + b1[3] * b1[3]));
                    sq += __shfl_xor(sq, 16); sq += __shfl_xor(sq, 32);
                    const float sc = rsqrtf(sq * (1.0f / 64.0f) + 1e-6f * rv[ai][m]) * qsc;
                    bf16_t* op = isk ? KF + ((((size_t)(row >> 11) * 8 + head) * 128 + ((row & 2047) >> 4)) * 2) * 512 + (fq * 16 + fr) * 8
                                     : O + (size_t)row * INW + 1792 + head * 64 + 8 * fq;
                    const int op2 = isk ? 512 : 32;
                    u32x4 w;
                    w.x = pk2(a0[0] * sc * g00[0], a0[1] * sc * g00[1]); w.y = pk2(a0[2] * sc * g00[2], a0[3] * sc * g00[3]); w.z = pk2(a1[0] * sc * g01[0], a1[1] * sc * g01[1]); w.w = pk2(a1[2] * sc * g01[2], a1[3] * sc * g01[3]);
                    *(u32x4*)op = w;
                    w.x = pk2(b0[0] * sc * g10[0], b0[1] * sc * g10[1]); w.y = pk2(b0[2] * sc * g10[2], b0[3] * sc * g10[3]); w.z = pk2(b1[0] * sc * g11[0], b1[1] * sc * g11[1]); w.w = pk2(b1[2] * sc * g11[2], b1[3] * sc * g11[3]);
                    *(u32x4*)(op + op2) = w;
                }
            return;
        }
#pragma unroll
        for (int ai = 0; ai < 2; ++ai)
#pragma unroll
            for (int m = 0; m < 4; ++m) rv[ai][m] = 0.f;
        EPI_FENCE8(sv);
#pragma unroll
        for (int ai = 0; ai < 2; ++ai)
#pragma unroll
            for (int m = 0; m < 4; ++m) rv[ai][m] = rsqrtf(ss_tot(sv[ai][m]) * (1.0f / 1024.0f) + 1e-6f);
#pragma unroll
        for (int ai = 0; ai < 2; ++ai)
#pragma unroll
            for (int m = 0; m < 4; ++m) {
                const int row = u.pm * 256 + ai * 128 + wr * 64 + m * 16 + fr;
                const float rinv = rv[ai][m];
#pragma unroll
                for (int bj = 0; bj < 2; ++bj) {
                    const int col = u.pn * 256 + bj * 128 + wc * 32 + 8 * fq;
                    const f32x4 v0 = acc[ai][bj][m][0] * rinv, v1 = acc[ai][bj][m][1] * rinv;
                    u32x4 w; w.x = pk2(v0[0], v0[1]); w.y = pk2(v0[2], v0[3]); w.z = pk2(v1[0], v1[1]); w.w = pk2(v1[2], v1[3]);
                    if (u.pn < 11) *(u32x4*)(O + (size_t)row * INW + col) = w;
                    else {
                        const int cv = col - 2816;
                        const int sq_ = row & 2047, kk = sq_ & 31;
                        bf16_t* vp = VT + ((((size_t)((row >> 11) * 8 + (cv >> 6)) * 64 + (sq_ >> 5)) * 4 + ((cv & 63) >> 4)) * 64 + ((kk & 15) >> 2) * 16 + (cv & 15)) * 8 + ((kk >> 4) & 1) * 4 + (kk & 3);
#pragma unroll
                        for (int e = 0; e < 4; ++e) { vp[(2 * e) * 8] = (bf16_t)(w[e] & 0xffffu); vp[(2 * e + 1) * 8] = (bf16_t)(w[e] >> 16); }
                    }
                }
            }
    }
};
struct EpiRes {
    bf16_t* XB; float* SS;
    __device__ __forceinline__ void operator()(AccRef acc, const Unit& u, int wr, int wc, int fr, int fq) const {
        u32x4 xin[2][2][4];
#pragma unroll
        for (int ai = 0; ai < 2; ++ai)
#pragma unroll
            for (int m = 0; m < 4; ++m)
#pragma unroll
                for (int bj = 0; bj < 2; ++bj)
                    xin[bj][ai][m] = *(const u32x4*)(XB + (size_t)(u.pm * 256 + ai * 128 + wr * 64 + m * 16 + fr) * 1024 + u.pn * 256 + bj * 128 + wc * 32 + 8 * fq);
        EPI_FENCE8(xin[0]);
        asm volatile("" : "+v"(xin[1][0][0]), "+v"(xin[1][0][1]), "+v"(xin[1][0][2]), "+v"(xin[1][0][3]), "+v"(xin[1][1][0]), "+v"(xin[1][1][1]), "+v"(xin[1][1][2]), "+v"(xin[1][1][3]));
#pragma unroll
        for (int ai = 0; ai < 2; ++ai)
#pragma unroll
            for (int m = 0; m < 4; ++m) {
                const int row = u.pm * 256 + ai * 128 + wr * 64 + m * 16 + fr;
                float sq = 0.f;
#pragma unroll
                for (int bj = 0; bj < 2; ++bj) {
                    const int col = u.pn * 256 + bj * 128 + wc * 32 + 8 * fq;
                    u32x4* xp = (u32x4*)(XB + (size_t)row * 1024 + col);
                    const u32x4 xw = xin[bj][ai][m];
                    f32x4 x0 = {lo16(xw.x), hi16(xw.x), lo16(xw.y), hi16(xw.y)}, x1 = {lo16(xw.z), hi16(xw.z), lo16(xw.w), hi16(xw.w)};
                    x0 += acc[ai][bj][m][0]; x1 += acc[ai][bj][m][1];
                    u32x4 w; w.x = pk2(x0[0], x0[1]); w.y = pk2(x0[2], x0[3]); w.z = pk2(x1[0], x1[1]); w.w = pk2(x1[2], x1[3]);
                    *xp = w;
                    x0 = (f32x4){lo16(w.x), hi16(w.x), lo16(w.y), hi16(w.y)}; x1 = (f32x4){lo16(w.z), hi16(w.z), lo16(w.w), hi16(w.w)};
                    sq += (x0[0] * x0[0] + x0[1] * x0[1]) + (x0[2] * x0[2] + x0[3] * x0[3]) + (x1[0] * x1[0] + x1[1] * x1[1]) + (x1[2] * x1[2] + x1[3] * x1[3]);
                }
                sq += __shfl_xor(sq, 16); sq += __shfl_xor(sq, 32);
                if (fq == 0) SS[(size_t)row * 16 + u.pn * 4 + wc] = sq;
            }
    }
};
struct EpiGU {
    bf16_t* H; const float* rinv;
    __device__ __forceinline__ void operator()(AccRef acc, const Unit& u, int wr, int wc, int fr, int fq) const {
        float rv[2][4];
#pragma unroll
        for (int ai = 0; ai < 2; ++ai)
#pragma unroll
            for (int m = 0; m < 4; ++m) rv[ai][m] = rinv[u.pm * 256 + ai * 128 + wr * 64 + m * 16 + fr];
        EPI_FENCE8(rv);
#pragma unroll
        for (int ai = 0; ai < 2; ++ai)
#pragma unroll
            for (int m = 0; m < 4; ++m) {
                const int row = u.pm * 256 + ai * 128 + wr * 64 + m * 16 + fr;
                const float rs = rv[ai][m];
                float h[8];
#pragma unroll
                for (int n = 0; n < 2; ++n)
#pragma unroll
                    for (int j = 0; j < 4; ++j) { const float gt = acc[ai][0][m][n][j] * rs, up = acc[ai][1][m][n][j] * rs; h[n * 4 + j] = gt * __builtin_amdgcn_rcpf(1.0f + __expf(-gt)) * up; }
                u32x4 w; w.x = pk2(h[0], h[1]); w.y = pk2(h[2], h[3]); w.z = pk2(h[4], h[5]); w.w = pk2(h[6], h[7]);
                *(u32x4*)(H + (size_t)row * 512 + u.pn * 128 + wc * 32 + 8 * fq) = w;
            }
    }
};
struct EpiDown {
    bf16_t* Y; const int* slot; const float* sw;
    __device__ __forceinline__ void operator()(AccRef acc, const Unit& u, int wr, int wc, int fr, int fq) const {
        int sl[2][4]; float wv[2][4];
#pragma unroll
        for (int ai = 0; ai < 2; ++ai)
#pragma unroll
            for (int m = 0; m < 4; ++m) { const int row = u.pm * 256 + ai * 128 + wr * 64 + m * 16 + fr; sl[ai][m] = slot[row]; wv[ai][m] = sw[row]; }
        EPI_FENCE8(sl);
        asm volatile("" : "+v"(wv[0][0]), "+v"(wv[0][1]), "+v"(wv[0][2]), "+v"(wv[0][3]), "+v"(wv[1][0]), "+v"(wv[1][1]), "+v"(wv[1][2]), "+v"(wv[1][3]));
#pragma unroll
        for (int ai = 0; ai < 2; ++ai)
#pragma unroll
            for (int m = 0; m < 4; ++m) {
                const int s = sl[ai][m]; const float wgt = wv[ai][m];
                if (s >= 0) {
#pragma unroll
                    for (int bj = 0; bj < 2; ++bj) {
                        const int col = u.pn * 256 + bj * 128 + wc * 32 + 8 * fq;
                        const f32x4 v0 = acc[ai][bj][m][0] * wgt, v1 = acc[ai][bj][m][1] * wgt;
                        u32x4 w; w.x = pk2(v0[0], v0[1]); w.y = pk2(v0[2], v0[3]); w.z = pk2(v1[0], v1[1]); w.w = pk2(v1[2], v1[3]);
                        *(u32x4*)(Y + (size_t)s * 1024 + col) = w;
                    }
                }
            }
    }
};
}

#define WSP(type, off) ((type*)(a.ws + (off)))
__device__ __forceinline__ int oblk() { int t = blockIdx.x; asm volatile("" : "+s"(t)); return t; }
__device__ __forceinline__ int ogrid() { int t = gridDim.x; asm volatile("" : "+s"(t)); return t; }
__device__ __forceinline__ int otid() { int t = threadIdx.x; asm volatile("" : "+v"(t)); return t; }
constexpr int LDS_INTAB = LDS_MISC + 14336;
__device__ __forceinline__ const float* ldsin(LAS unsigned char* lds, int i) {
    const unsigned long long p = ((const LAS unsigned long long*)(lds + LDS_INTAB))[i];
    const unsigned lo = __builtin_amdgcn_readfirstlane((unsigned)p), hi = __builtin_amdgcn_readfirstlane((unsigned)(p >> 32));
    return (const float*)(__attribute__((address_space(1))) const float*)(((unsigned long long)hi << 32) | lo);
}
#define INP(i) ldsin(lds, (i))

template <int MAP>
__device__ __forceinline__ void conv_slab(const float* __restrict__ src, int N, int Kper, bf16_t* __restrict__ dst, size_t estride,
                                          const float* __restrict__ gain, int goff, LAS float* tile, int slab) {
    const int tid = otid();
    const int nsn = N >> 8;
    const int kt = slab / nsn, ns = slab - kt * nsn, k0 = kt * 64, n0 = ns * 256;
    const int e = k0 / Kper, kl0 = k0 - e * Kper;
    f32x4 v[8]; float gs[8];
#pragma unroll
    for (int i = 0; i < 8; ++i) { const int idx = tid + i * 512, kk = idx >> 6, n4 = (idx & 63) * 4; v[i] = *(const f32x4*)(src + (size_t)(k0 + kk) * N + n0 + n4);
        const int gi = kl0 + kk - goff; gs[i] = (gain != nullptr) ? gain[gi < 0 ? 0 : gi] : 1.0f; }
    asm volatile("" : "+v"(gs[0]), "+v"(gs[1]), "+v"(gs[2]), "+v"(gs[3]), "+v"(gs[4]), "+v"(gs[5]), "+v"(gs[6]), "+v"(gs[7]));
#pragma unroll
    for (int i = 0; i < 8; ++i) {
        const int idx = tid + i * 512, kk = idx >> 6, n4 = (idx & 63) * 4;
        const float gsc = (kl0 + kk >= goff) ? gs[i] : 1.0f;
        LAS float* tp = tile + kk * 257 + n4;
        tp[0] = v[i][0] * gsc; tp[1] = v[i][1] * gsc; tp[2] = v[i][2] * gsc; tp[3] = v[i][3] * gsc;
    }
    __syncthreads();
#pragma unroll
    for (int i = 0; i < 4; ++i) {
        const int p = tid + i * 512, nn = p >> 3, kg = p & 7;
        float x[8];
#pragma unroll
        for (int j = 0; j < 8; ++j) x[j] = tile[(kg * 8 + j) * 257 + nn];
        const int n = n0 + nn;
        int nr;
        if (MAP == 0) nr = n;
        else if (MAP == 3) { const int pn_ = n >> 8, wi = n & 255;
            nr = (pn_ >= 7 && pn_ <= 10) ? pn_ * 256 + ((wi & 63) >> 5) * 128 + (wi >> 6) * 32 + (wi & 31) : n; }
        else nr = (n >> 7) * 256 + (n & 127) + (MAP == 2 ? 128 : 0);
        u32x4 w; w.x = pk2(x[0], x[1]); w.y = pk2(x[2], x[3]); w.z = pk2(x[4], x[5]); w.w = pk2(x[6], x[7]);
        *(u32x4*)(dst + (size_t)e * estride + (size_t)nr * Kper + kl0 + kg * 8) = w;
    }
    __syncthreads();
}
template <int MAP>
__device__ __forceinline__ void conv_T(const float* __restrict__ src, int Ktot, int N, int Kper, bf16_t* __restrict__ dst, size_t estride,
                                       const float* __restrict__ gain, int goff, LAS float* tile) {
    const int nslab = (Ktot >> 6) * (N >> 8);
    for (int sl = oblk(); sl < nslab; sl += ogrid()) conv_slab<MAP>(src, N, Kper, dst, estride, gain, goff, tile, sl);
}
constexpr int MOE_CONV_ITEMS = 3 * 256;
__device__ __forceinline__ void moe_convert_item(const PA a, int l, LAS unsigned char* lds, int item) {
    LAS float* tile = (LAS float*)lds;
    const int which = item >> 8, s0 = (item & 255) * 4;
    const float* gn = INP(30) + l * 1024;
    for (int sl = s0; sl < s0 + 4; ++sl) {
        if (which == 0)      conv_slab<1>(INP(35) + (size_t)l * 32 * 1024 * 512, 512, 1024, WSP(bf16_t, WS_WGU), (size_t)1024 * 1024, gn, 0, tile, sl);
        else if (which == 1) conv_slab<2>(INP(36) + (size_t)l * 32 * 1024 * 512, 512, 1024, WSP(bf16_t, WS_WGU), (size_t)1024 * 1024, gn, 0, tile, sl);
        else                 conv_slab<0>(INP(37) + (size_t)l * 32 * 512 * 1024, 1024, 512, WSP(bf16_t, WS_WD), (size_t)1024 * 512, nullptr, 0, tile, sl);
    }
}

__device__ __forceinline__ void rows_convert(const float* __restrict__ src, float* __restrict__ dstf, bf16_t* __restrict__ dstb, float* __restrict__ ss, int nrows) {
    const int wave = otid() >> 6, lane = otid() & 63;
    for (int r = oblk() * 8 + wave; r < nrows; r += ogrid() * 8) {
        float sq = 0.f;
        f32x4 vv[4];
#pragma unroll
        for (int i = 0; i < 4; ++i) vv[i] = *(const f32x4*)(src + (size_t)r * 1024 + i * 256 + lane * 4);
        asm volatile("" : "+v"(vv[0]), "+v"(vv[1]), "+v"(vv[2]), "+v"(vv[3]));
#pragma unroll
        for (int i = 0; i < 4; ++i) {
            const int c = i * 256 + lane * 4;
            const f32x4 v = vv[i];
            if (dstf) *(f32x4*)(dstf + (size_t)r * 1024 + c) = v;
            u32x2 w; w.x = pk2(v[0], v[1]); w.y = pk2(v[2], v[3]);
            *(u32x2*)(dstb + (size_t)r * 1024 + c) = w;
            sq += (v[0] * v[0] + v[1] * v[1]) + (v[2] * v[2] + v[3] * v[3]);
        }
        sq = wsum(sq);
        if (lane < 16) ss[(size_t)r * 16 + lane] = (lane == 0) ? sq : 0.f;
    }
}

__device__ __forceinline__ void p0_prologue(const PA a, LAS unsigned char* lds) {
    LAS float* tile = (LAS float*)lds;
    for (int l = 0; l < NL; ++l) {
        conv_T<3>(INP(3) + (size_t)l * 1024 * INW, 1024, INW, 1024, WSP(bf16_t, WS_WIN) + (size_t)l * INW * 1024, 0, INP(2) + l * 1024, 0, tile);
        conv_T<0>(INP(22) + (size_t)l * 1024 * 1024, 1024, 1024, 1024, WSP(bf16_t, WS_WOUT) + (size_t)l * 1024 * 1024, 0, INP(21) + l * 512, 512, tile);
        conv_T<0>(INP(25) + (size_t)l * 1024 * 512, 1024, 512, 1024, WSP(bf16_t, WS_WQ) + (size_t)l * 512 * 1024, 0, INP(23) + l * 1024, 0, tile);
        conv_T<0>(INP(26) + (size_t)l * 1024 * 1024, 1024, 1024, 1024, WSP(bf16_t, WS_WKV) + (size_t)l * 1024 * 1024, 0, INP(24) + l * 1024, 0, tile);
        conv_T<0>(INP(27) + (size_t)l * 512 * 1024, 512, 1024, 512, WSP(bf16_t, WS_WO) + (size_t)l * 1024 * 512, 0, nullptr, 0, tile);
    }
    {
        bf16_t* wrh = WSP(bf16_t, WS_WRH); bf16_t* wrl = WSP(bf16_t, WS_WRL);
        for (int idx = oblk() * 512 + otid(); idx < NL * 48 * 1024; idx += ogrid() * 512) {
            const int k = idx & 1023, r = (idx >> 10) % 48, l = idx / (48 * 1024);
            float w;
            if (r < 16) w = INP(31)[((size_t)l * 1024 + k) * 4 + (r & 3)];
            else { const int ri = ((r >> 2) & 3) * 8 + ((r >> 4) - 1) * 4 + (r & 3); w = INP(33)[((size_t)l * 1024 + k) * 32 + ri]; }
            w *= INP(30)[l * 1024 + k];
            const bf16_t hi = f2bf(w);
            wrh[idx] = hi; wrl[idx] = f2bf(w - bf2f(hi));
        }
    }
    {
        const int gt = oblk() * 512 + otid(), gs = ogrid() * 512;
        for (int e = gt; e < 16 * 8192; e += gs) { const int im = e >> 13, idx = e & 8191, ch = idx & 127, k = idx >> 7, l = im >> 2, chb = (im & 3) * 128;
            bf16_t* ib = (bf16_t*)(a.ws + WS_PBI + (size_t)im * PBI_BYTES);
            ib[ch * 72 + k] = f2bf(INP(6)[(size_t)l * 64 * 512 + k * 512 + chb + ch]); ib[9216 + ch * 72 + k] = f2bf(INP(8)[(size_t)l * 64 * 512 + k * 512 + chb + ch]); }
        for (int e = gt; e < 16 * 16384; e += gs) { const int im = e >> 14, idx = e & 16383, ch = idx & 127, k = idx >> 7, l = im >> 2, chb = (im & 3) * 128;
            bf16_t* ib = (bf16_t*)(a.ws + WS_PBI + (size_t)im * PBI_BYTES);
            ib[18432 + ch * 136 + k] = f2bf(INP(9)[(size_t)l * 128 * 512 + k * 512 + chb + ch]); }
        for (int e = gt; e < 16 * 4096; e += gs) { const int im = e >> 12, idx = e & 4095, ch = idx & 127, k = idx >> 7, l = im >> 2, chb = (im & 3) * 128;
            bf16_t* ib = (bf16_t*)(a.ws + WS_PBI + (size_t)im * PBI_BYTES);
            ib[35840 + ch * 40 + k] = l > 0 ? f2bf(INP(17)[(size_t)(l - 1) * 32 * 512 + k * 512 + chb + ch]) : (bf16_t)0; }
        for (int e = gt; e < 16 * 16384; e += gs) { const int im = e >> 14, idx = e & 16383, n = idx & 31, k = idx >> 5, l = im >> 2;
            bf16_t* ib = (bf16_t*)(a.ws + WS_PBI + (size_t)im * PBI_BYTES);
            ib[40960 + n * 520 + k] = l > 0 ? f2bf(INP(16)[(size_t)(l - 1) * 512 * 32 + k * 32 + n]) : (bf16_t)0; }
        for (int e = gt; e < 16 * 1920; e += gs) { const int im = e / 1920, idx = e - im * 1920, l = im >> 2, chb = (im & 3) * 128;
            float* fb = (float*)(a.ws + WS_PBI + (size_t)im * PBI_BYTES + 115200);
            float v;
            if (idx < 1152) { const int arr = idx >> 7, cc = chb + (idx & 127);
                v = arr == 0 ? INP(4)[l * 1792 + cc] : arr == 1 ? INP(4)[l * 1792 + 512 + cc] : arr == 2 ? INP(4)[l * 1792 + 1024 + cc] : arr == 3 ? INP(5)[l * 512 + cc]
                  : arr == 4 ? INP(7)[l * 512 + cc] : arr == 5 ? INP(10)[l * 512 + cc] : arr == 6 ? INP(11)[l * 512 + cc] : arr == 7 ? (l > 0 ? INP(15)[(l - 1) * 512 + cc] : 0.f) : INP(12)[l * 512 + cc]; }
            else v = INP(4)[l * 1792 + 1024 + (idx - 1152)];
            fb[idx] = v; }
    }
    rows_convert(INP(0), nullptr, WSP(bf16_t, WS_XB), WSP(float, WS_SS), T);
    rows_convert(INP(1), nullptr, WSP(bf16_t, WS_MEMB), WSP(float, WS_MEMSS), MROWS);
}

__device__ __forceinline__ void p2_knorm(const PA a, LAS unsigned char* lds) {
    const int wave = otid() >> 6, lane = otid() & 63;
    bf16_t* kv = WSP(bf16_t, WS_KV);
    for (int it = oblk() * 8 + wave; it < NL * MROWS * 4; it += ogrid() * 8) {
        const int h = it & 3, row = (it >> 2) & (MROWS - 1), l = it >> 14;
        unsigned* p = (unsigned*)(kv + ((size_t)l * MROWS + row) * 1024 + h * 128 + lane * 2);
        const unsigned w = *p; const float x0 = lo16(w), x1 = hi16(w);
        const float ssq = wsum(x0 * x0 + x1 * x1);
        const float rinv = rsqrtf(ssq * (1.0f / 128.0f) + 1e-6f);
        const float* gk = INP(29) + l * 128 + lane * 2;
        *p = pk2(x0 * rinv * gk[0], x1 * rinv * gk[1]);
    }
    bf16_t* vtx = WSP(bf16_t, WS_VTX);
    const int tid = otid();
    for (int it = oblk(); it < NL * 16 * 4; it += ogrid()) {
        const int h = it & 3, b = (it >> 2) & 15, l = it >> 6;
        const bf16_t* src = kv + ((size_t)l * MROWS + b * 256) * 1024 + 512 + h * 128;
        bf16_t* dst = vtx + (size_t)it * 128 * 256;
#pragma unroll 1
        for (int i = 0; i < 8; ++i) {
            const int p = tid + i * 512, d = p & 127, m8 = (p >> 7) * 8;
            unsigned short x[8];
#pragma unroll
            for (int j = 0; j < 8; ++j) x[j] = src[(size_t)(m8 + j) * 1024 + d];
            u32x4 w; w.x = x[0] | ((unsigned)x[1] << 16); w.y = x[2] | ((unsigned)x[3] << 16); w.z = x[4] | ((unsigned)x[5] << 16); w.w = x[6] | ((unsigned)x[7] << 16);
            *(u32x4*)(dst + (size_t)d * 256 + m8) = w;
        }
    }
}

__device__ __forceinline__ float fast_tanh(float x) { return 1.0f - 2.0f * __builtin_amdgcn_rcpf(1.0f + __expf(2.0f * x)); }
__device__ __forceinline__ float fast_sigmoid(float x) { return __builtin_amdgcn_rcpf(1.0f + __expf(-x)); }
template <int MODE>
__device__ __forceinline__ bf16x8 mixfrag(const bf16_t* pu, const bf16_t* pp, float hpf, unsigned mub, int colc, int col) {
    const u32x4 u = *(const u32x4*)(pu + col), p = *(const u32x4*)(pp + col);
    const f32x4 m0 = *(const LAS f32x4*)(unsigned long long)(mub + (unsigned)colc * 4u), m1 = *(const LAS f32x4*)(unsigned long long)(mub + (unsigned)colc * 4u + 16u);
    float x[8];
#pragma unroll
    for (int j = 0; j < 4; ++j) {
        const float u0 = lo16(u[j]), u1 = hi16(u[j]), p0 = lo16(p[j]) * hpf, p1 = hi16(p[j]) * hpf;
        const float ma = (j < 2) ? m0[2 * j] : m1[2 * j - 4], mb = (j < 2) ? m0[2 * j + 1] : m1[2 * j - 3];
        x[2 * j] = u0 + ma * (p0 - u0); x[2 * j + 1] = u1 + mb * (p1 - u1);
    }
#pragma unroll
    for (int j = 0; j < 8; ++j) { if (MODE == 1) x[j] = fast_tanh(x[j]); if (MODE == 2) x[j] = fast_sigmoid(x[j]); }
    u32x4 w; w.x = pk2(x[0], x[1]); w.y = pk2(x[2], x[3]); w.z = pk2(x[4], x[5]); w.w = pk2(x[6], x[7]);
    return __builtin_bit_cast(bf16x8, w);
}
__device__ __forceinline__ void pb_prep(const PA a, int l, LAS unsigned char* lds) {
    const int tid = otid(), wave = __builtin_amdgcn_readfirstlane(tid >> 6), lane0 = tid & 63, fr0 = lane0 & 15, fq0 = lane0 >> 4;
    const int G = ogrid(), blk = oblk();
    LAS bf16_t* s_w2 = (LAS bf16_t*)lds;
    LAS bf16_t* s_a2 = (LAS bf16_t*)(lds + 18432);
    LAS bf16_t* s_g2 = (LAS bf16_t*)(lds + 36864);
    LAS bf16_t* s_v2 = (LAS bf16_t*)(lds + 71680);
    LAS bf16_t* s_v1 = (LAS bf16_t*)(lds + 81920);
    LAS float* s_par = (LAS float*)(lds + 115200);
    LAS float* s_mux = s_par + 1152;
    bf16_t* proj = WSP(bf16_t, WS_PROJ);
    const float* mu = INP(4) + l * 1792;
    const float* w0 = INP(5) + l * 512;  const float* w2 = INP(6) + (size_t)l * 64 * 512;
    const float* a0 = INP(7) + l * 512;  const float* a2 = INP(8) + (size_t)l * 64 * 512;
    const float* g2 = INP(9) + (size_t)l * 128 * 512;
    const float* kkw = INP(10) + l * 512; const float* kaw = INP(11) + l * 512;
    const int lv = l > 0 ? l - 1 : 0;
    const float* v0 = INP(15) + lv * 512; const float* v1 = INP(16) + (size_t)lv * 512 * 32; const float* v2 = INP(17) + (size_t)lv * 32 * 512;
    const float* qgn = INP(18) + l * 64; const float* kgn = INP(19) + l * 64;
    bf16_t* SR = WSP(bf16_t, WS_SR); bf16_t* SK = WSP(bf16_t, WS_SK); bf16_t* SV = WSP(bf16_t, WS_SV);
    bf16_t* SA = WSP(bf16_t, WS_SA); bf16_t* SB = WSP(bf16_t, WS_SB); bf16_t* SG = WSP(bf16_t, WS_SG);
    bf16_t* SWD = WSP(bf16_t, WS_SWD); bf16_t* VF = WSP(bf16_t, WS_VF);
    int cur_hp = -1;
    for (int item = blk; item < 4 * (T / 128); item += G) {
        const int hp = item & 3, tt = item >> 2;
        if (hp != cur_hp) {
            __syncthreads();
            const unsigned char* img = a.ws + WS_PBI + (size_t)(l * 4 + hp) * PBI_BYTES;
            for (int p = tid; p < PBI_BYTES / 16; p += 512) *(LAS u32x4*)(lds + p * 16) = *(const u32x4*)(img + (size_t)p * 16);
            __syncthreads();
            cur_hp = hp;
        }
        const int lane = otid() & 63, fr = lane & 15, fq = lane >> 4;
        const int t = tt * 128 + wave * 16 + fr;
        const bool hpv = (t & (SEQ - 1)) != 0;
        const bf16_t* pu = proj + (size_t)t * INW;
        const bf16_t* pp = hpv ? pu - INW : pu;
        const float hpf = hpv ? 1.0f : 0.0f;
        unsigned mub = (unsigned)(unsigned long long)s_mux - 4096u + (unsigned)(fq * 32); asm volatile("" : "+v"(mub));
        bf16x8 fwl[2], fal[2], fgl[4], ft32;
#pragma unroll
        for (int s = 0; s < 2; ++s) { fwl[s] = mixfrag<1>(pu, pp, hpf, mub, 1536 + 32 * s, 1536 + 32 * s + 8 * fq); fal[s] = mixfrag<0>(pu, pp, hpf, mub, 1600 + 32 * s, 1600 + 32 * s + 8 * fq); }
#pragma unroll
        for (int s = 0; s < 4; ++s) fgl[s] = mixfrag<2>(pu, pp, hpf, mub, 1664 + 32 * s, 1664 + 32 * s + 8 * fq);
        {
#pragma unroll
            for (int n8 = 0; n8 < 8; ++n8) {
                f32x4 ag = {0.f, 0.f, 0.f, 0.f};
#pragma unroll
                for (int s = 0; s < 4; ++s) ag = __builtin_amdgcn_mfma_f32_16x16x32_bf16(*(const LAS bf16x8*)(s_g2 + (n8 * 16 + fr) * 136 + 32 * s + 8 * fq), fgl[s], ag, 0, 0, 0);
                u32x2 w; w.x = pk2(ag[0], ag[1]); w.y = pk2(ag[2], ag[3]); *(u32x2*)(SG + (size_t)t * 512 + hp * 128 + n8 * 16 + 4 * fq) = w;
            }
        }
        ft32 = fwl[0];
        if (l > 0) {
            f32x4 c0 = {0.f, 0.f, 0.f, 0.f}, c1 = {0.f, 0.f, 0.f, 0.f};
#pragma unroll 8
            for (int s = 0; s < 16; ++s) {
                const bf16x8 xf = mixfrag<0>(pu, pp, hpf, mub, 1024 + 32 * s, 1024 + 32 * s + 8 * fq);
                const bf16x8 wa = *(const LAS bf16x8*)(s_v1 + fr * 520 + 32 * s + 8 * fq), wb = *(const LAS bf16x8*)(s_v1 + (16 + fr) * 520 + 32 * s + 8 * fq);
                c0 = __builtin_amdgcn_mfma_f32_16x16x32_bf16(wa, xf, c0, 0, 0, 0);
                c1 = __builtin_amdgcn_mfma_f32_16x16x32_bf16(wb, xf, c1, 0, 0, 0);
            }
            u32x4 w; w.x = pk2(c0[0], c0[1]); w.y = pk2(c0[2], c0[3]); w.z = pk2(c1[0], c1[1]); w.w = pk2(c1[2], c1[3]);
            ft32 = __builtin_bit_cast(bf16x8, w);
        }
#pragma unroll 1
        for (int hh = 0; hh < 2; ++hh) {
            float atu[4][4], btu[4][4];
            u32x2 hR[4], hK[4], hV[4];
            float kss = 0.f, bsum = 0.f;
            const int t0w = tt * 128 + wave * 16, hd = hp * 2 + hh;
            const int cid = ((t0w >> 11) * 8 + hd) * 128 + ((t0w & (SEQ - 1)) >> 4);
#define DPP1(x, ctrl) __int_as_float(__builtin_amdgcn_update_dpp(0x3f800000, __float_as_int(x), (ctrl), 0xF, 0xF, false))
            u32x2 Lur[4], Lpr[4], Luk[4], Lpk[4], Luv[4], Lpv[4], Lvf[4];
#pragma unroll
            for (int nt = 0; nt < 4; ++nt) {
                if ((nt & 1) == 0) {
#pragma unroll
                    for (int n2 = nt; n2 < nt + 2; ++n2) {
                        const int c4 = hp * 128 + hh * 64 + n2 * 16 + 4 * fq;
                        Lur[n2] = *(const u32x2*)(pu + c4); Lpr[n2] = *(const u32x2*)(pp + c4);
                        Luk[n2] = *(const u32x2*)(pu + 512 + c4); Lpk[n2] = *(const u32x2*)(pp + 512 + c4);
                        Luv[n2] = *(const u32x2*)(pu + 1024 + c4); Lpv[n2] = *(const u32x2*)(pp + 1024 + c4);
                        Lvf[n2] = (l > 0) ? *(const u32x2*)(VF + (size_t)t * 512 + c4) : (u32x2){0u, 0u};
                    }
                    __builtin_amdgcn_sched_barrier(0);
                }
                const int lc = hh * 64 + nt * 16, ch4 = hp * 128 + lc + 4 * fq;
                f32x4 aw = {0.f, 0.f, 0.f, 0.f}, aa = aw, az = aw;
#pragma unroll
                for (int s = 0; s < 2; ++s) {
                    aw = __builtin_amdgcn_mfma_f32_16x16x32_bf16(*(const LAS bf16x8*)(s_w2 + (lc + fr) * 72 + 32 * s + 8 * fq), fwl[s], aw, 0, 0, 0);
                    aa = __builtin_amdgcn_mfma_f32_16x16x32_bf16(*(const LAS bf16x8*)(s_a2 + (lc + fr) * 72 + 32 * s + 8 * fq), fal[s], aa, 0, 0, 0);
                }
                if (l > 0) {
                    const u32x2 q0 = *(const LAS u32x2*)(s_v2 + (lc + fr) * 40 + 4 * fq), q1 = *(const LAS u32x2*)(s_v2 + (lc + fr) * 40 + 16 + 4 * fq);
                    u32x4 w; w.x = q0.x; w.y = q0.y; w.z = q1.x; w.w = q1.y;
                    az = __builtin_amdgcn_mfma_f32_16x16x32_bf16(__builtin_bit_cast(bf16x8, w), ft32, az, 0, 0, 0);
                }
                const u32x2 ur = Lur[nt], pr = Lpr[nt], uk = Luk[nt], pk = Lpk[nt], uv = Luv[nt], pv = Lpv[nt];
                const int pc4 = lc + 4 * fq;
                const f32x4 mr = *(const LAS f32x4*)(s_par + pc4), mk = *(const LAS f32x4*)(s_par + 128 + pc4), mv = *(const LAS f32x4*)(s_par + 256 + pc4);
                const f32x4 w0v = *(const LAS f32x4*)(s_par + 384 + pc4), a0v = *(const LAS f32x4*)(s_par + 512 + pc4), kkwv = *(const LAS f32x4*)(s_par + 640 + pc4), kawv = *(const LAS f32x4*)(s_par + 768 + pc4);
                float xr[4], xk[4], xv[4];
                { const float u0 = lo16(ur.x), u1 = hi16(ur.x), u2 = lo16(ur.y), u3 = hi16(ur.y);
                  xr[0] = u0 + mr[0] * (lo16(pr.x) * hpf - u0); xr[1] = u1 + mr[1] * (hi16(pr.x) * hpf - u1); xr[2] = u2 + mr[2] * (lo16(pr.y) * hpf - u2); xr[3] = u3 + mr[3] * (hi16(pr.y) * hpf - u3); }
                { const float u0 = lo16(uk.x), u1 = hi16(uk.x), u2 = lo16(uk.y), u3 = hi16(uk.y);
                  xk[0] = u0 + mk[0] * (lo16(pk.x) * hpf - u0); xk[1] = u1 + mk[1] * (hi16(pk.x) * hpf - u1); xk[2] = u2 + mk[2] * (lo16(pk.y) * hpf - u2); xk[3] = u3 + mk[3] * (hi16(pk.y) * hpf - u3); }
                { const float u0 = lo16(uv.x), u1 = hi16(uv.x), u2 = lo16(uv.y), u3 = hi16(uv.y);
                  xv[0] = u0 + mv[0] * (lo16(pv.x) * hpf - u0); xv[1] = u1 + mv[1] * (hi16(pv.x) * hpf - u1); xv[2] = u2 + mv[2] * (lo16(pv.y) * hpf - u2); xv[3] = u3 + mv[3] * (hi16(pv.y) * hpf - u3); }
                const size_t o = (size_t)t * 512 + ch4;
                if (l > 0) {
                    const f32x4 v0v = *(const LAS f32x4*)(s_par + 896 + pc4);
                    const u32x2 vfw = Lvf[nt];
                    const float vf0 = lo16(vfw.x), vf1 = hi16(vfw.x), vf2 = lo16(vfw.y), vf3 = hi16(vfw.y);
                    xv[0] += (vf0 - xv[0]) * fast_sigmoid(v0v[0] + az[0]); xv[1] += (vf1 - xv[1]) * fast_sigmoid(v0v[1] + az[1]);
                    xv[2] += (vf2 - xv[2]) * fast_sigmoid(v0v[2] + az[2]); xv[3] += (vf3 - xv[3]) * fast_sigmoid(v0v[3] + az[3]);
                } else {
                    u32x2 w; w.x = pk2(xv[0], xv[1]); w.y = pk2(xv[2], xv[3]); *(u32x2*)(VF + o) = w;
                }
                const f32x4 rkv = *(const LAS f32x4*)(s_par + 1024 + pc4);
                float P[4], rt[4], kt[4];
#pragma unroll
                for (int j = 0; j < 4; ++j) {
                    const float dcl = 0.8750387749f * fast_sigmoid(w0v[j] + aw[j]);
                    const float av = fast_sigmoid(a0v[j] + aa[j]);
                    const float kk = xk[j] * kkwv[j];
                    const float kmod = xk[j] * (1.0f + (av - 1.0f) * kawv[j]);
                    kss += kk * kk; bsum += xr[j] * kmod * rkv[j];
                    float p = __builtin_amdgcn_exp2f(-dcl);
                    p *= DPP1(p, 0x111); p *= DPP1(p, 0x112); p *= DPP1(p, 0x114); p *= DPP1(p, 0x118);
                    const float pm = DPP1(p, 0x111);
                    const float ip = __builtin_amdgcn_rcpf(p);
                    P[j] = p; rt[j] = xr[j] * p; kt[j] = kmod * ip; atu[nt][j] = -kk * pm; btu[nt][j] = kk * av * ip;
                }
                hR[nt].x = pk2(rt[0], rt[1]); hR[nt].y = pk2(rt[2], rt[3]); hK[nt].x = pk2(kt[0], kt[1]); hK[nt].y = pk2(kt[2], kt[3]);
                hV[nt].x = pk2(xv[0], xv[1]); hV[nt].y = pk2(xv[2], xv[3]);
                if (fr == 15) *(f32x4*)(WSP(float, WS_PCK) + (size_t)cid * 64 + nt * 16 + 4 * fq) = (f32x4){P[0], P[1], P[2], P[3]};
            }
            kss += __shfl_xor(kss, 16); kss += __shfl_xor(kss, 32);
            bsum += __shfl_xor(bsum, 16); bsum += __shfl_xor(bsum, 32);
            const float rn = rsqrtf(fmaxf(kss, 1e-24f));
            if (fq == 0) WSP(float, WS_BS)[(size_t)t * 8 + hd] = bsum;
            bf16x8 fA[2], fR[2], fB[2], fK[2], fV[2];
#pragma unroll
            for (int s_ = 0; s_ < 2; ++s_) {
                u32x4 w;
                w.x = pk2(atu[2 * s_][0] * rn, atu[2 * s_][1] * rn); w.y = pk2(atu[2 * s_][2] * rn, atu[2 * s_][3] * rn); w.z = pk2(atu[2 * s_ + 1][0] * rn, atu[2 * s_ + 1][1] * rn); w.w = pk2(atu[2 * s_ + 1][2] * rn, atu[2 * s_ + 1][3] * rn);
                fA[s_] = __builtin_bit_cast(bf16x8, w);
                w.x = pk2(btu[2 * s_][0] * rn, btu[2 * s_][1] * rn); w.y = pk2(btu[2 * s_][2] * rn, btu[2 * s_][3] * rn); w.z = pk2(btu[2 * s_ + 1][0] * rn, btu[2 * s_ + 1][1] * rn); w.w = pk2(btu[2 * s_ + 1][2] * rn, btu[2 * s_ + 1][3] * rn);
                fB[s_] = __builtin_bit_cast(bf16x8, w);
                fR[s_] = __builtin_bit_cast(bf16x8, (u32x4){hR[2 * s_].x, hR[2 * s_].y, hR[2 * s_ + 1].x, hR[2 * s_ + 1].y});
                fK[s_] = __builtin_bit_cast(bf16x8, (u32x4){hK[2 * s_].x, hK[2 * s_].y, hK[2 * s_ + 1].x, hK[2 * s_ + 1].y});
                fV[s_] = __builtin_bit_cast(bf16x8, (u32x4){hV[2 * s_].x, hV[2 * s_].y, hV[2 * s_ + 1].x, hV[2 * s_ + 1].y});
            }
#undef DPP1
            {
                int frv = fr, fqv = fq, lanev = lane; asm volatile("" : "+v"(frv), "+v"(fqv), "+v"(lanev));
                const unsigned rowo = (unsigned)(frv * 1024);
                char* ua = (char*)(SA + ((size_t)t0w * 512 + hd * 64)); char* ur = (char*)(SR + ((size_t)t0w * 512 + hd * 64));
#pragma unroll
                for (int s_ = 0; s_ < 2; ++s_) { const unsigned co = rowo + (unsigned)((((4 * s_ + fqv) ^ (frv & 7))) * 16);
                    *(u32x4*)(ua + co) = __builtin_bit_cast(u32x4, fA[s_]); *(u32x4*)(ur + co) = __builtin_bit_cast(u32x4, fR[s_]); }
                const f32x4 z4 = {0.f, 0.f, 0.f, 0.f};
#define MF(a_, b_, c_) __builtin_amdgcn_mfma_f32_16x16x32_bf16((a_), (b_), (c_), 0, 0, 0)
                const f32x4 nka = MF(fA[1], fK[1], MF(fA[0], fK[0], z4));
                const f32x4 nbr = MF(fR[1], fB[1], MF(fR[0], fB[0], z4));
                const f32x4 nkr = MF(fR[1], fK[1], MF(fR[0], fK[0], z4));
                const f32x4 nba = MF(fB[1], fA[1], MF(fB[0], fA[0], z4));
                unsigned nbu = (unsigned)(unsigned long long)((LAS float*)(lds + PBI_BYTES) + wave * 256); asm volatile("" : "+v"(nbu));
                LAS float* nb = (LAS float*)(unsigned long long)nbu;
                bf16_t* gim = WSP(bf16_t, WS_NKA) + (size_t)cid * 1024;
                const int ncol = (frv >> 2) * 8 + (frv & 3);
#pragma unroll
                for (int j = 0; j < 4; ++j) {
                    const int row = 4 * fqv + j;
                    gim[row * 32 + ncol + 4] = f2bf(frv < row ? nka[j] : 0.f);
                    gim[512 + row * 32 + ncol] = f2bf(frv <= row ? nbr[j] : 0.f);
                    gim[512 + row * 32 + ncol + 4] = f2bf(frv <= row ? nkr[j] : 0.f);
                    nb[row * 16 + frv] = (row < frv) ? nba[j] : 0.f;
                }
                const unsigned idv = (fqv == (frv >> 2)) ? (0x3f80u << (16 * (frv & 1))) : 0u;
                u32x4 idA = {0u, 0u, 0u, 0u}, idB = {0u, 0u, 0u, 0u};
                if ((frv & 3) < 2) { idA.x = idv; idB.z = idv; } else { idA.y = idv; idB.w = idv; }
                char* ubk = (char*)(WSP(bf16_t, WS_BTT) + (size_t)cid * 2048); char* uvs = (char*)(WSP(bf16_t, WS_VST) + (size_t)cid * 1024);
                const unsigned bko = (unsigned)(frv * 64 + fqv * 16), vso = (unsigned)(frv * 32 + fqv * 8);
#pragma unroll
                for (int n_ = 0; n_ < 4; ++n_) {
                    const bf16x8 idf = __builtin_bit_cast(bf16x8, (n_ & 1) ? idB : idA);
                    const f32x4 bT = MF(fB[n_ >> 1], idf, z4), kT = MF(fK[n_ >> 1], idf, z4), vT = MF(fV[n_ >> 1], idf, z4);
                    *(u32x4*)(ubk + n_ * 1024 + bko) = (u32x4){pk2(bT[0], bT[1]), pk2(bT[2], bT[3]), pk2(kT[0], kT[1]), pk2(kT[2], kT[3])};
                    *(u32x2*)(uvs + n_ * 512 + vso) = (u32x2){pk2(vT[0], vT[1]), pk2(vT[2], vT[3])};
                }
#undef MF
                if (lanev < 16) {
                    float X[16];
                    const int tcolp = (lanev >> 2) * 8 + (lanev & 3);
#pragma unroll
                    for (int tcol = 0; tcol < 16; ++tcol) {
                        float acc = (lanev == tcol) ? 1.0f : 0.0f;
#pragma unroll
                        for (int i = 0; i < tcol; ++i) acc += X[i] * nb[i * 16 + tcol];
                        X[tcol] = acc;
                        gim[tcol * 32 + tcolp] = f2bf(acc);
                    }
                }
            }
        }
    }
    __syncthreads();
}

__device__ __forceinline__ void pb2_chunks(const PA a, int l, LAS unsigned char* lds) {
    const int tid = otid(), wave = tid >> 6, lane = tid & 63, fr = lane & 15, fq = lane >> 4;
    LAS bf16_t* sA = (LAS bf16_t*)(lds + wave * 11520);
    LAS bf16_t* sR = sA + 1152; LAS bf16_t* sB = sR + 1152; LAS bf16_t* sK = sB + 1152; LAS bf16_t* sX = sK + 1152;
    LAS float* nb = (LAS float*)(lds + 8 * 11520) + wave * 256;
    bf16_t* SR = WSP(bf16_t, WS_SR); bf16_t* SK = WSP(bf16_t, WS_SK); bf16_t* SV = WSP(bf16_t, WS_SV);
    bf16_t* SA = WSP(bf16_t, WS_SA); bf16_t* SB = WSP(bf16_t, WS_SB); const bf16_t* SWD = WSP(const bf16_t, WS_SWD);
    const float* rkp = INP(12) + l * 512;
    for (int cid = oblk() * 8 + wave; cid < NCHUNK; cid += ogrid() * 8) {
        const int b = cid >> 10, h = (cid >> 7) & 7, c = cid & 127;
        const size_t tok0 = (size_t)b * SEQ + c * 16;
        const size_t e0 = tok0 * 512 + h * 64 + lane;
        const float rkv = rkp[h * 64 + lane];
        const int posl = (lane & 32) | (((lane & 15) >> 2) << 3) | (((lane >> 4) & 1) << 2) | (lane & 3);
        float P = 1.0f;
        unsigned bt2[8], kt2[8], vt2[8];
#pragma unroll
        for (int hf = 0; hf < 2; ++hf) {
            bf16_t r16[8], k16[8], a16[8], b16[8], v16[8]; float w32[8];
#pragma unroll
            for (int t8 = 0; t8 < 8; ++t8) { const size_t e = e0 + (size_t)(hf * 8 + t8) * 512; r16[t8] = SR[e]; k16[t8] = SK[e]; a16[t8] = SA[e]; b16[t8] = SB[e]; v16[t8] = SV[e]; w32[t8] = __builtin_amdgcn_exp2f(-bf2f(SWD[e])); }
#pragma unroll
            for (int t8 = 0; t8 < 8; ++t8) {
                const int t = hf * 8 + t8;
                const float rr = bf2f(r16[t8]), kk = bf2f(k16[t8]), aa = bf2f(a16[t8]), bb = bf2f(b16[t8]);
                const float Pm = P; P *= w32[t8]; const float ip = 1.0f / P;
                const unsigned ar = pk2(aa * Pm, rr * P), bk = pk2(bb * ip, kk * ip);
                const bf16_t at = (bf16_t)(ar & 0xffffu), rt = (bf16_t)(ar >> 16), btv = (bf16_t)(bk & 0xffffu), ktv = (bf16_t)(bk >> 16);
                { const size_t es = tok0 * 512 + (size_t)t * 512 + h * 64 + (posl ^ ((t & 7) << 3)); SA[es] = at; SR[es] = rt; }
                sA[t * 72 + lane] = at; sR[t * 72 + lane] = rt; sB[t * 72 + lane] = btv; sK[t * 72 + lane] = ktv;
                sX[t * 72 + lane] = (bf16_t)(pk2(rr * kk * rkv, 0.f) & 0xffffu);
                if (t & 1) { bt2[t >> 1] |= (unsigned)btv << 16; kt2[t >> 1] |= (unsigned)ktv << 16; vt2[t >> 1] |= (unsigned)v16[t8] << 16; }
                else       { bt2[t >> 1] = btv; kt2[t >> 1] = ktv; vt2[t >> 1] = v16[t8]; }
            }
        }
        WSP(float, WS_PCK)[(size_t)cid * 64 + lane] = P;
        {
            u32x4* pb_ = (u32x4*)(WSP(bf16_t, WS_BTT) + (size_t)cid * 2048 + lane * 32);
            u32x4* pv_ = (u32x4*)(WSP(bf16_t, WS_VST) + (size_t)cid * 1024 + lane * 16);
#pragma unroll
            for (int q = 0; q < 4; ++q) pb_[q] = (u32x4){bt2[2 * q], bt2[2 * q + 1], kt2[2 * q], kt2[2 * q + 1]};
            pv_[0] = (u32x4){vt2[0], vt2[1], vt2[2], vt2[3]}; pv_[1] = (u32x4){vt2[4], vt2[5], vt2[6], vt2[7]};
        }
        bf16x8 fA[2], fR[2], fB[2], fK[2], fX[2];
#pragma unroll
        for (int s_ = 0; s_ < 2; ++s_) {
            fA[s_] = *(const LAS bf16x8*)(sA + fr * 72 + 32 * s_ + 8 * fq); fR[s_] = *(const LAS bf16x8*)(sR + fr * 72 + 32 * s_ + 8 * fq);
            fB[s_] = *(const LAS bf16x8*)(sB + fr * 72 + 32 * s_ + 8 * fq); fK[s_] = *(const LAS bf16x8*)(sK + fr * 72 + 32 * s_ + 8 * fq);
            fX[s_] = *(const LAS bf16x8*)(sX + fr * 72 + 32 * s_ + 8 * fq);
        }
        const f32x4 z4 = {0.f, 0.f, 0.f, 0.f};
        const bf16x8 ones = {0x3f80, 0x3f80, 0x3f80, 0x3f80, 0x3f80, 0x3f80, 0x3f80, 0x3f80};
        const f32x4 nka = __builtin_amdgcn_mfma_f32_16x16x32_bf16(fA[1], fK[1], __builtin_amdgcn_mfma_f32_16x16x32_bf16(fA[0], fK[0], z4, 0, 0, 0), 0, 0, 0);
        const f32x4 nbr = __builtin_amdgcn_mfma_f32_16x16x32_bf16(fR[1], fB[1], __builtin_amdgcn_mfma_f32_16x16x32_bf16(fR[0], fB[0], z4, 0, 0, 0), 0, 0, 0);
        const f32x4 nkr = __builtin_amdgcn_mfma_f32_16x16x32_bf16(fR[1], fK[1], __builtin_amdgcn_mfma_f32_16x16x32_bf16(fR[0], fK[0], z4, 0, 0, 0), 0, 0, 0);
        const f32x4 nba = __builtin_amdgcn_mfma_f32_16x16x32_bf16(fB[1], fA[1], __builtin_amdgcn_mfma_f32_16x16x32_bf16(fB[0], fA[0], z4, 0, 0, 0), 0, 0, 0);
        const f32x4 bsm = __builtin_amdgcn_mfma_f32_16x16x32_bf16(fX[1], ones, __builtin_amdgcn_mfma_f32_16x16x32_bf16(fX[0], ones, z4, 0, 0, 0), 0, 0, 0);
        bf16_t* gim = WSP(bf16_t, WS_NKA) + (size_t)cid * 1024;
        const int ncol = (fr >> 2) * 8 + (fr & 3);
#pragma unroll
        for (int j = 0; j < 4; ++j) {
            const int row = 4 * fq + j;
            gim[row * 32 + ncol + 4] = f2bf(fr < row ? nka[j] : 0.f);
            gim[512 + row * 32 + ncol] = f2bf(fr <= row ? nbr[j] : 0.f);
            gim[512 + row * 32 + ncol + 4] = f2bf(fr <= row ? nkr[j] : 0.f);
            nb[row * 16 + fr] = (row < fr) ? nba[j] : 0.f;
            if (fr == 0) WSP(float, WS_BS)[(tok0 + row) * 8 + h] = bsm[j];
        }
        if (lane < 16) {
            float X[16];
            bf16_t* gtm = WSP(bf16_t, WS_NKA) + (size_t)cid * 1024; const int tcolp = (lane >> 2) * 8 + (lane & 3);
#pragma unroll
            for (int tcol = 0; tcol < 16; ++tcol) {
                float acc = (lane == tcol) ? 1.0f : 0.0f;
#pragma unroll
                for (int i = 0; i < tcol; ++i) acc += X[i] * nb[i * 16 + tcol];
                X[tcol] = acc;
                gtm[tcol * 32 + tcolp] = f2bf(acc);
            }
        }
    }
    __syncthreads();
}

__device__ __forceinline__ void scan_item(const PA a, int l, int bh, LAS unsigned char* lds) {
    const int tid = otid(), wave = __builtin_amdgcn_readfirstlane(tid >> 6), lane = tid & 63, fr = lane & 15, fq = lane >> 4;
    const int b = __builtin_amdgcn_readfirstlane(bh >> 3), h = __builtin_amdgcn_readfirstlane(bh & 7);
    constexpr int SLOT = 15104, NS = 8, DPF = 6;
    constexpr int OA = 0, OR_ = 2048, OBK = 4096, OVT = 8192, ON = 10240, OPC = 12288, OBS = 12544, OSG = 13056;
    constexpr int YBO = NS * SLOT;
    const size_t tokb = (size_t)b * SEQ;
    const int cid0 = (b * 8 + h) * 128;
    const unsigned char* gA = (const unsigned char*)WSP(const bf16_t, WS_SA); const unsigned char* gR = (const unsigned char*)WSP(const bf16_t, WS_SR);
    const unsigned char* gG = (const unsigned char*)WSP(const bf16_t, WS_SG);
    const unsigned char* gBK = (const unsigned char*)WSP(const bf16_t, WS_BTT);
    const unsigned char* gVT = (const unsigned char*)WSP(const bf16_t, WS_VST); const unsigned char* gN = (const unsigned char*)WSP(const bf16_t, WS_NKA);
    const unsigned char* gPC = (const unsigned char*)WSP(const float, WS_PCK); const unsigned char* gBS = (const unsigned char*)WSP(const float, WS_BS);
#define DMA16(gp, ldsoff) __builtin_amdgcn_global_load_lds((const unsigned*)(gp), (LAS unsigned*)(lds + (ldsoff)), 16, 0, 0)
    const unsigned rowoff0 = (unsigned)(((lane >> 3) * 512 + (lane & 7) * 8) * 2), rowoff1 = rowoff0 + 8u * 512u * 2u;
#define DMA_CHUNK(c_) do { const int cid_ = cid0 + (c_); const int so_ = ((c_) % NS) * SLOT; \
        const size_t rb_ = ((tokb + (size_t)(c_) * 16) * 512 + h * 64) * 2; \
        if (wave == 4) { \
            DMA16(gA + rb_ + rowoff0, so_ + OA); DMA16(gA + rb_ + rowoff1, so_ + OA + 1024); DMA16(gR + rb_ + rowoff0, so_ + OR_); DMA16(gR + rb_ + rowoff1, so_ + OR_ + 1024); \
            DMA16(gBK + (size_t)cid_ * 4096 + lane * 16, so_ + OBK); DMA16(gBK + (size_t)cid_ * 4096 + 1024 + lane * 16, so_ + OBK + 1024); \
            DMA16(gBK + (size_t)cid_ * 4096 + 2048 + lane * 16, so_ + OBK + 2048); DMA16(gBK + (size_t)cid_ * 4096 + 3072 + lane * 16, so_ + OBK + 3072); \
            if (lane < 16) DMA16(gPC + (size_t)cid_ * 256 + lane * 16, so_ + OPC); \
        } else { \
            DMA16(gVT + (size_t)cid_ * 2048 + lane * 16, so_ + OVT); DMA16(gVT + (size_t)cid_ * 2048 + 1024 + lane * 16, so_ + OVT + 1024); \
            DMA16(gN + (size_t)cid_ * 2048 + lane * 16, so_ + ON); DMA16(gN + (size_t)cid_ * 2048 + 1024 + lane * 16, so_ + ON + 1024); \
            DMA16(gG + rb_ + rowoff0, so_ + OSG); DMA16(gG + rb_ + rowoff1, so_ + OSG + 1024); \
            if (lane < 32) DMA16(gBS + (tokb + (size_t)(c_) * 16) * 32 + lane * 16, so_ + OBS); \
            if (lane < 1) DMA16(gPC + (size_t)cid_ * 256, so_ + OPC); if (lane < 1) DMA16(gPC + (size_t)cid_ * 256, so_ + OPC); \
        } } while (0)
#define MF(a_, b_, c_) __builtin_amdgcn_mfma_f32_16x16x32_bf16((a_), (b_), (c_), 0, 0, 0)
#define LDF(off_) (*(const LAS bf16x8*)(sl + (off_)))
    const int swz = fr & 7;
    const int aoff0 = fr * 128 + ((fq) ^ swz) * 16, aoff1 = fr * 128 + ((4 + fq) ^ swz) * 16;
    const int noff = fr * 64 + fq * 16, voff = ((wave & 3) * 16 + fr) * 32 + 8 * fq;
    const float lw = INP(13)[l * 512 + h * 64 + lane], lb = INP(14)[l * 512 + h * 64 + lane];
    bf16_t* YC = WSP(bf16_t, WS_YCAT);
#define SCAN_EPI(cp_) do { const int cp = (cp_); \
        const unsigned slb = (unsigned)(unsigned long long)(lds + (cp % NS) * SLOT), ybb = (unsigned)(unsigned long long)(lds + YBO + (cp & 1) * 4352); \
          \
        f32x4 y0, y1, y2, y3; { const unsigned ya = ybb + fr * 272 + fq * 32; \
            asm volatile("ds_read_b128 %0, %4\n\tds_read_b128 %1, %4 offset:16\n\tds_read_b128 %2, %4 offset:128\n\tds_read_b128 %3, %4 offset:144\n\ts_waitcnt lgkmcnt(0)" \
                         : "=&v"(y0), "=&v"(y1), "=&v"(y2), "=&v"(y3) : "v"(ya) : "memory"); } \
        u32x4 f0, f1, g0, g1; \
        f0.x = pk2(y0[0], y0[1]); f0.y = pk2(y0[2], y0[3]); f0.z = pk2(y1[0], y1[1]); f0.w = pk2(y1[2], y1[3]); f1.x = pk2(y2[0], y2[1]); f1.y = pk2(y2[2], y2[3]); f1.z = pk2(y3[0], y3[1]); f1.w = pk2(y3[2], y3[3]); \
        g0.x = pk2(y0[0] * y0[0], y0[1] * y0[1]); g0.y = pk2(y0[2] * y0[2], y0[3] * y0[3]); g0.z = pk2(y1[0] * y1[0], y1[1] * y1[1]); g0.w = pk2(y1[2] * y1[2], y1[3] * y1[3]); \
        g1.x = pk2(y2[0] * y2[0], y2[1] * y2[1]); g1.y = pk2(y2[2] * y2[2], y2[3] * y2[3]); g1.z = pk2(y3[0] * y3[0], y3[1] * y3[1]); g1.w = pk2(y3[2] * y3[2], y3[3] * y3[3]); \
        const bf16x8 ones = {0x3f80, 0x3f80, 0x3f80, 0x3f80, 0x3f80, 0x3f80, 0x3f80, 0x3f80}; const f32x4 z4 = {0.f, 0.f, 0.f, 0.f}; \
        const f32x4 ssum = MF(__builtin_bit_cast(bf16x8, f1), ones, MF(__builtin_bit_cast(bf16x8, f0), ones, z4));        \
        const f32x4 sqsm = MF(__builtin_bit_cast(bf16x8, g1), ones, MF(__builtin_bit_cast(bf16x8, g0), ones, z4)); \
          \
        f32x4 rs4, mr4; \
        _Pragma("unroll") for (int j = 0; j < 4; ++j) { const float mean = ssum[j] * (1.0f / 64.0f); const float var = fmaxf(sqsm[j] * (1.0f / 64.0f) - mean * mean, 0.f); \
            rs4[j] = rsqrtf(var + 64e-5f); mr4[j] = -mean * rs4[j]; } \
        float eY[8], eB[8]; unsigned eV[8], eG[8]; \
        _Pragma("unroll") for (int i = 0; i < 8; ++i) { const int t = (wave - 6) * 8 + i; \
            const unsigned ay_ = ybb + (t * 68 + lane) * 4, ab_ = slb + OBS + t * 32 + h * 4, av_ = slb + OVT + lane * 32 + t * 2, ag_ = slb + OSG + t * 128 + lane * 2; \
            asm volatile("ds_read_b32 %0, %4\n\tds_read_b32 %1, %5\n\tds_read_u16 %2, %6\n\tds_read_u16 %3, %7" \
                         : "=&v"(eY[i]), "=&v"(eB[i]), "=&v"(eV[i]), "=&v"(eG[i]) : "v"(ay_), "v"(ab_), "v"(av_), "v"(ag_) : "memory"); } \
        asm volatile("s_waitcnt lgkmcnt(0)" ::: "memory"); \
        bf16_t* yrow = YC + (tokb + (size_t)cp * 16 + (wave - 6) * 8) * 1024 + h * 64;       \
        _Pragma("unroll") for (int i = 0; i < 8; ++i) { \
            asm volatile("" : "+v"(eY[i]), "+v"(eB[i]), "+v"(eV[i]), "+v"(eG[i])); \
            const int sl_ = ((wave - 6) * 2 + (i >> 2)) * 16; \
            const float rstd = __int_as_float(__builtin_amdgcn_readlane(__float_as_int(rs4[i & 3]), sl_)); \
            const float nmr = __int_as_float(__builtin_amdgcn_readlane(__float_as_int(mr4[i & 3]), sl_)); \
            const float vv = __uint_as_float(eV[i] << 16), g = __uint_as_float(eG[i] << 16); \
            const float o_ = (eY[i] * (rstd * lw) + (nmr * lw + lb) + eB[i] * vv) * g; \
            *(bf16_t*)((char*)(yrow + (size_t)i * 1024) + (unsigned)(lane * 2)) = (bf16_t)(pk2(o_, 0.f) & 0xffffu); } } while (0)
    f32x4 S[4];
#pragma unroll
    for (int kt = 0; kt < 4; ++kt) S[kt] = (f32x4){0.f, 0.f, 0.f, 0.f};
    __syncthreads();
    if (wave == 4 || wave == 5) {
#pragma unroll 1
        for (int c = 0; c < DPF; ++c) DMA_CHUNK(c);
        asm volatile("s_waitcnt vmcnt(0)" ::: "memory");
    }
    __syncthreads();
#pragma unroll 1
    for (int c = 0; c < 128; ++c) {
        if (wave < 4) {
            const LAS unsigned char* sl = lds + (c % NS) * SLOT;
            u32x4 s0w, s1w; s0w.x = pk2(S[0][0], S[0][1]); s0w.y = pk2(S[0][2], S[0][3]); s0w.z = pk2(S[1][0], S[1][1]); s0w.w = pk2(S[1][2], S[1][3]);
            s1w.x = pk2(S[2][0], S[2][1]); s1w.y = pk2(S[2][2], S[2][3]); s1w.z = pk2(S[3][0], S[3][1]); s1w.w = pk2(S[3][2], S[3][3]);
            const bf16x8 Sf0 = __builtin_bit_cast(bf16x8, s0w), Sf1 = __builtin_bit_cast(bf16x8, s1w);
            const u32x2 vm = *(const LAS u32x2*)(sl + OVT + voff);
            const bf16x8 TN = LDF(ON + noff), BN = LDF(ON + 1024 + noff);
            const f32x4 z4 = {0.f, 0.f, 0.f, 0.f};
            const bf16x8 ZV = __builtin_bit_cast(bf16x8, (u32x4){0u, 0u, vm.x, vm.y});
            f32x4 Wt = MF(LDF(OA + aoff0), Sf0, z4); Wt = MF(LDF(OA + aoff1), Sf1, Wt); Wt = MF(TN, ZV, Wt);
            const bf16x8 WZ = __builtin_bit_cast(bf16x8, (u32x4){pk2(Wt[0], Wt[1]), pk2(Wt[2], Wt[3]), 0u, 0u});
            const f32x4 Ut = MF(TN, WZ, z4);
            const bf16x8 UV = __builtin_bit_cast(bf16x8, (u32x4){pk2(Ut[0], Ut[1]), pk2(Ut[2], Ut[3]), vm.x, vm.y});
            f32x4 Yt = MF(LDF(OR_ + aoff0), Sf0, z4); Yt = MF(LDF(OR_ + aoff1), Sf1, Yt); Yt = MF(BN, UV, Yt);
#pragma unroll
            for (int kt = 0; kt < 4; ++kt) {
                const f32x4 pc = *(const LAS f32x4*)(sl + OPC + (kt * 16 + 4 * fq) * 4);
                S[kt] = MF(LDF(OBK + kt * 1024 + noff), UV, S[kt]) * pc;
            }
            LAS float* yb = (LAS float*)(lds + YBO + (c & 1) * 4352) + (wave & 3) * 16 + fr;
#pragma unroll
            for (int j = 0; j < 4; ++j) yb[(4 * fq + j) * 68] = Yt[j];
            asm volatile("s_waitcnt lgkmcnt(0)" ::: "memory");
        } else if (wave < 6) {
            if (c + DPF < 128) DMA_CHUNK(c + DPF);
            if (c >= DPF && c + DPF < 128) asm volatile("s_waitcnt vmcnt(45)" ::: "memory"); else asm volatile("s_waitcnt vmcnt(0)" ::: "memory");
        } else if (c > 0) {
            SCAN_EPI(c - 1);
        }
        asm volatile("" ::: "memory"); __builtin_amdgcn_s_barrier(); asm volatile("" ::: "memory");
    }
    if (wave >= 6) { SCAN_EPI(127); }
    asm volatile("s_waitcnt vmcnt(0)" ::: "memory");
    __syncthreads();
#undef SCAN_EPI
#undef DMA16
#undef DMA_CHUNK
#undef MF
#undef LDF
}

__device__ __forceinline__ void attn_item(const PA a, int l, int it, LAS unsigned char* lds) {
    const int tid = otid(), h = __builtin_amdgcn_readfirstlane(tid >> 6), lane = tid & 63, fr = lane & 15, fq = lane >> 4;
    const int b = it >> 5, c = it & 31;
    LAS float* s_bias = (LAS float*)(lds + LDS_MISC + 1024);
    LAS float* s_part = s_bias + 8 * 320;
    LAS float* tb = (LAS float*)lds + h * 1600;
    __syncthreads();
    for (int e = lane; e < 1600; e += 64) { const int r = e / 400, y = e - r * 400; int idx = 383 - (y + r); idx = idx > 319 ? 319 : (idx < 0 ? 0 : idx); tb[e] = s_bias[h * 320 + idx]; }
    const bf16_t* proj = WSP(const bf16_t, WS_PROJ);
    const bf16_t* VT = WSP(const bf16_t, WS_VT) + (size_t)(b * 8 + h) * 64 * 2048;
    const size_t tq0 = (size_t)b * SEQ + c * 64;
    bf16x8 qf[4][2];
#pragma unroll
    for (int nt = 0; nt < 4; ++nt)
#pragma unroll
        for (int ks = 0; ks < 2; ++ks) qf[nt][ks] = *(const bf16x8*)(proj + (tq0 + nt * 16 + fr) * INW + 1792 + h * 64 + 32 * ks + 8 * fq);
    f32x4 o[5][4];
#pragma unroll
    for (int dt = 0; dt < 5; ++dt)
#pragma unroll
        for (int nt = 0; nt < 4; ++nt) o[dt][nt] = (f32x4){0.f, 0.f, 0.f, 0.f};
    const int kc0 = c - 8 > 0 ? c - 8 : 0;
    const int nsteps = (c - kc0 + 1) * 2;
    const bf16x8 ones = {0x3f80, 0x3f80, 0x3f80, 0x3f80, 0x3f80, 0x3f80, 0x3f80, 0x3f80};
    const int rr = (4 - (fr & 3)) & 3;
    const unsigned tbl = (unsigned)(unsigned long long)(tb + rr * 400) + (unsigned)((320 - fr + 4 * fq - rr - 48) * 4);
    const char* kbase = (const char*)(WSP(const bf16_t, WS_KFR) + ((size_t)(b * 8 + h) * 128 + kc0 * 4) * 1024);
    const char* vbase = (const char*)(VT + (size_t)kc0 * 2 * 2048);
    const unsigned loff = (unsigned)(lane * 16);
    bf16x8 kfA[2][2], kfB[2][2]; u32x4 vfA[4], vfB[4];
#define ATT_LOAD(KF, VF, st) do { unsigned lo_ = loff; asm volatile("" : "+v"(lo_)); \
        const char* kp_ = kbase + (size_t)(st) * 4096; const char* vp_ = vbase + (size_t)(st) * 4096; \
        _Pragma("unroll") for (int mt = 0; mt < 2; ++mt) _Pragma("unroll") for (int ks = 0; ks < 2; ++ks) \
            KF[mt][ks] = *(const bf16x8*)(kp_ + (mt * 2 + ks) * 1024 + lo_); \
        _Pragma("unroll") for (int dt = 0; dt < 4; ++dt) VF[dt] = *(const u32x4*)(vp_ + dt * 1024 + lo_); } while (0)
#define MF(a_, b_, c_) __builtin_amdgcn_mfma_f32_16x16x32_bf16((a_), (b_), (c_), 0, 0, 0)
#define ATT_STEP(KF, VF, st) do { \
        f32x4 sacc[2][4]; const f32x4 z4 = {0.f, 0.f, 0.f, 0.f}; \
        _Pragma("unroll") for (int mt = 0; mt < 2; ++mt) _Pragma("unroll") for (int nt = 0; nt < 4; ++nt) sacc[mt][nt] = MF(KF[mt][1], qf[nt][1], MF(KF[mt][0], qf[nt][0], z4)); \
        const int dk = c - (kc0 + ((st) >> 1)), half = (st) & 1; \
        if (dk >= 5) { const float bc = s_bias[h * 320 + 319]; \
            _Pragma("unroll") for (int mt = 0; mt < 2; ++mt) _Pragma("unroll") for (int nt = 0; nt < 4; ++nt) sacc[mt][nt] += bc; \
        } else { \
            const unsigned ta = tbl + (unsigned)((32 * half - 64 * dk + 256) * 4); f32x4 bv[5]; \
            _Pragma("unroll") for (int dd = 0; dd < 5; ++dd) bv[dd] = *(const LAS f32x4*)(unsigned long long)(ta - 1024u + (unsigned)((3 - (dd - 1)) * 64)); \
            _Pragma("unroll") for (int mt = 0; mt < 2; ++mt) _Pragma("unroll") for (int nt = 0; nt < 4; ++nt) sacc[mt][nt] += bv[nt - mt + 1]; } \
        bf16x8 pf[4]; \
        _Pragma("unroll") for (int nt = 0; nt < 4; ++nt) { \
            u32x4 w; w.x = pk2(__builtin_amdgcn_exp2f(sacc[0][nt][0]), __builtin_amdgcn_exp2f(sacc[0][nt][1])); w.y = pk2(__builtin_amdgcn_exp2f(sacc[0][nt][2]), __builtin_amdgcn_exp2f(sacc[0][nt][3])); \
            w.z = pk2(__builtin_amdgcn_exp2f(sacc[1][nt][0]), __builtin_amdgcn_exp2f(sacc[1][nt][1])); w.w = pk2(__builtin_amdgcn_exp2f(sacc[1][nt][2]), __builtin_amdgcn_exp2f(sacc[1][nt][3])); \
            pf[nt] = __builtin_bit_cast(bf16x8, w); } \
        _Pragma("unroll") for (int nt = 0; nt < 4; ++nt) { \
            _Pragma("unroll") for (int dt = 0; dt < 4; ++dt) o[dt][nt] = MF(__builtin_bit_cast(bf16x8, VF[dt]), pf[nt], o[dt][nt]); \
            o[4][nt] = MF(ones, pf[nt], o[4][nt]); } } while (0)
    ATT_LOAD(kfA, vfA, 0);
    __syncthreads();
#pragma unroll 1
    for (int st = 0; st < nsteps; st += 2) {
        ATT_LOAD(kfB, vfB, st + 1);
        ATT_STEP(kfA, vfA, st);
        if (st + 2 < nsteps) ATT_LOAD(kfA, vfA, st + 2);
        ATT_STEP(kfB, vfB, st + 1);
    }
#undef ATT_LOAD
#undef ATT_STEP
#undef MF
#pragma unroll
    for (int nt = 0; nt < 4; ++nt) {
        const float inv = 1.0f / o[4][nt][0];
        float sq = 0.f;
#pragma unroll
        for (int dt = 0; dt < 4; ++dt) { o[dt][nt] *= inv; sq += (o[dt][nt][0] * o[dt][nt][0] + o[dt][nt][1] * o[dt][nt][1]) + (o[dt][nt][2] * o[dt][nt][2] + o[dt][nt][3] * o[dt][nt][3]); }
        sq += __shfl_xor(sq, 16); sq += __shfl_xor(sq, 32);
        if (fq == 0) s_part[h * 64 + nt * 16 + fr] = sq;
    }
    __syncthreads();
#pragma unroll
    for (int nt = 0; nt < 4; ++nt) {
        float tot = 0.f;
#pragma unroll
        for (int hh = 0; hh < 8; ++hh) tot += s_part[hh * 64 + nt * 16 + fr];
        const float rinv = rsqrtf(tot * (1.0f / 512.0f) + 1e-6f);
        bf16_t* yp = WSP(bf16_t, WS_YCAT) + (tq0 + nt * 16 + fr) * 1024 + 512 + h * 64 + 4 * fq;
#pragma unroll
        for (int dt = 0; dt < 4; ++dt) { u32x2 w; w.x = pk2(o[dt][nt][0] * rinv, o[dt][nt][1] * rinv); w.y = pk2(o[dt][nt][2] * rinv, o[dt][nt][3] * rinv); *(u32x2*)(yp + dt * 16) = w; }
    }
    __syncthreads();
}

__device__ __forceinline__ void pc_mixer(const PA a, int l, LAS unsigned char* lds) {
    const int tid = otid();
    LAS float* s_bias = (LAS float*)(lds + LDS_MISC + 1024);
    volatile LAS int* s_item = (volatile LAS int*)(lds + LDS_MISC + 64);
    for (int i = tid; i < 8 * 320; i += 512) s_bias[i] = INP(20)[l * 8 * 320 + i] * 1.4426950408889634f;
    unsigned* qhead = WSP(unsigned, WS_CTL) + CW_QUEUE + l * 64;
    for (;;) {
        __syncthreads();
        if (tid == 0) *s_item = (int)__hip_atomic_fetch_add(qhead, 1u, __ATOMIC_RELAXED, __HIP_MEMORY_SCOPE_AGENT);
        __syncthreads();
        const int item = __builtin_amdgcn_readfirstlane(*s_item);
        if (item >= 128 + 512 + MOE_CONV_ITEMS) break;
        if (item < 128) scan_item(a, l, item, lds);
        else if (item < 128 + 512) attn_item(a, l, item - 128, lds);
        else moe_convert_item(a, l, lds, item - 640);
    }
}

__device__ __forceinline__ void pe2_xattn(const PA a, int l, LAS unsigned char* lds) {
    const int tid = otid(), wave = tid >> 6, lane = tid & 63, fr = lane & 15, fq = lane >> 4;
    LAS bf16_t* sK = (LAS bf16_t*)lds;
    LAS bf16_t* sV = (LAS bf16_t*)(lds + 69632);
    const bf16_t* QX = WSP(const bf16_t, WS_QX); bf16_t* OX = WSP(bf16_t, WS_OX);
    const bf16_t* KV = WSP(const bf16_t, WS_KV) + (size_t)l * MROWS * 1024;
    const bf16_t* VTX = WSP(const bf16_t, WS_VTX) + (size_t)l * MROWS * 512;
    const float* qgn = INP(28) + l * 128;
    for (int it = oblk(); it < 256; it += ogrid()) {
        const int b = it >> 4, h = (it >> 2) & 3, qr = it & 3;
        __syncthreads();
        {
            u32x4 tk[8], tv[8];
#pragma unroll
            for (int i = 0; i < 8; ++i) {
                const int p = tid + i * 512, r = p >> 4, c8 = (p & 15) * 8, d = p >> 5, m8 = (p & 31) * 8;
                tk[i] = *(const u32x4*)(KV + (size_t)(b * 256 + r) * 1024 + h * 128 + c8);
                tv[i] = *(const u32x4*)(VTX + ((size_t)(b * 4 + h) * 128 + d) * 256 + m8);
            }
            asm volatile("" : "+v"(tk[0]), "+v"(tk[1]), "+v"(tk[2]), "+v"(tk[3]), "+v"(tk[4]), "+v"(tk[5]), "+v"(tk[6]), "+v"(tk[7]));
            asm volatile("" : "+v"(tv[0]), "+v"(tv[1]), "+v"(tv[2]), "+v"(tv[3]), "+v"(tv[4]), "+v"(tv[5]), "+v"(tv[6]), "+v"(tv[7]));
#pragma unroll
            for (int i = 0; i < 8; ++i) {
                const int p = tid + i * 512, r = p >> 4, c8 = (p & 15) * 8, d = p >> 5, m8 = (p & 31) * 8;
                *(LAS u32x4*)(sK + r * 136 + c8) = tk[i];
                *(LAS u32x4*)(sV + d * 264 + m8) = tv[i];
            }
        }
        __syncthreads();
#pragma unroll 1
        for (int iter = 0; iter < 2; ++iter) {
            const size_t q0 = (size_t)b * SEQ + qr * 512 + iter * 256 + wave * 32;
            bf16x8 qf[2][4];
#pragma unroll
            for (int nt = 0; nt < 2; ++nt) {
                const bf16_t* qp = QX + (q0 + nt * 16 + fr) * 512 + h * 128 + 8 * fq;
                u32x4 w[4]; float ssq = 0.f;
#pragma unroll
                for (int ks = 0; ks < 4; ++ks) { w[ks] = *(const u32x4*)(qp + 32 * ks);
#pragma unroll
                    for (int j = 0; j < 4; ++j) { const float x0 = lo16(w[ks][j]), x1 = hi16(w[ks][j]); ssq += x0 * x0 + x1 * x1; } }
                ssq += __shfl_xor(ssq, 16); ssq += __shfl_xor(ssq, 32);
                const float sc = rsqrtf(ssq * (1.0f / 128.0f) + 1e-6f) * 0.12751743f;
#pragma unroll
                for (int ks = 0; ks < 4; ++ks) {
                    const f32x4 g0 = *(const f32x4*)(qgn + 32 * ks + 8 * fq), g1 = *(const f32x4*)(qgn + 32 * ks + 8 * fq + 4);
                    u32x4 ow;
                    ow.x = pk2(lo16(w[ks][0]) * sc * g0[0], hi16(w[ks][0]) * sc * g0[1]); ow.y = pk2(lo16(w[ks][1]) * sc * g0[2], hi16(w[ks][1]) * sc * g0[3]);
                    ow.z = pk2(lo16(w[ks][2]) * sc * g1[0], hi16(w[ks][2]) * sc * g1[1]); ow.w = pk2(lo16(w[ks][3]) * sc * g1[2], hi16(w[ks][3]) * sc * g1[3]);
                    qf[nt][ks] = __builtin_bit_cast(bf16x8, ow);
                }
            }
            f32x4 o[8][2];
#pragma unroll
            for (int dt = 0; dt < 8; ++dt) { o[dt][0] = (f32x4){0.f, 0.f, 0.f, 0.f}; o[dt][1] = (f32x4){0.f, 0.f, 0.f, 0.f}; }
            float lsum[2] = {0.f, 0.f};
#pragma unroll 2
            for (int st = 0; st < 8; ++st) {
                const int k0 = st * 32;
                f32x4 sacc[2][2];
#pragma unroll
                for (int mt = 0; mt < 2; ++mt) {
                    sacc[mt][0] = (f32x4){0.f, 0.f, 0.f, 0.f}; sacc[mt][1] = (f32x4){0.f, 0.f, 0.f, 0.f};
#pragma unroll
                    for (int ks = 0; ks < 4; ++ks) {
                        const bf16x8 kfr = *(const LAS bf16x8*)(sK + (k0 + mt * 16 + fr) * 136 + 32 * ks + 8 * fq);
                        sacc[mt][0] = __builtin_amdgcn_mfma_f32_16x16x32_bf16(kfr, qf[0][ks], sacc[mt][0], 0, 0, 0);
                        sacc[mt][1] = __builtin_amdgcn_mfma_f32_16x16x32_bf16(kfr, qf[1][ks], sacc[mt][1], 0, 0, 0);
                    }
                }
                bf16x8 pf[2];
#pragma unroll
                for (int nt = 0; nt < 2; ++nt) {
                    float p[8];
#pragma unroll
                    for (int j = 0; j < 4; ++j) { p[j] = __builtin_amdgcn_exp2f(fminf(sacc[0][nt][j], 80.f)); p[4 + j] = __builtin_amdgcn_exp2f(fminf(sacc[1][nt][j], 80.f)); }
                    lsum[nt] += ((p[0] + p[1]) + (p[2] + p[3])) + ((p[4] + p[5]) + (p[6] + p[7]));
                    u32x4 w; w.x = pk2(p[0], p[1]); w.y = pk2(p[2], p[3]); w.z = pk2(p[4], p[5]); w.w = pk2(p[6], p[7]);
                    pf[nt] = __builtin_bit_cast(bf16x8, w);
                }
#pragma unroll
                for (int dt = 0; dt < 8; ++dt) {
                    const LAS bf16_t* vp = sV + (dt * 16 + fr) * 264 + k0 + 4 * fq;
                    const u32x2 v0 = *(const LAS u32x2*)vp, v1 = *(const LAS u32x2*)(vp + 16);
                    u32x4 w; w.x = v0.x; w.y = v0.y; w.z = v1.x; w.w = v1.y;
                    const bf16x8 vfr = __builtin_bit_cast(bf16x8, w);
                    o[dt][0] = __builtin_amdgcn_mfma_f32_16x16x32_bf16(vfr, pf[0], o[dt][0], 0, 0, 0);
                    o[dt][1] = __builtin_amdgcn_mfma_f32_16x16x32_bf16(vfr, pf[1], o[dt][1], 0, 0, 0);
                }
            }
#pragma unroll
            for (int nt = 0; nt < 2; ++nt) {
                float ls = lsum[nt]; ls += __shfl_xor(ls, 16); ls += __shfl_xor(ls, 32);
                const float inv = 1.0f / ls;
                bf16_t* op = OX + (q0 + nt * 16 + fr) * 512 + h * 128 + 4 * fq;
#pragma unroll
                for (int dt = 0; dt < 8; ++dt) { u32x2 w; w.x = pk2(o[dt][nt][0] * inv, o[dt][nt][1] * inv); w.y = pk2(o[dt][nt][2] * inv, o[dt][nt][3] * inv); *(u32x2*)(op + dt * 16) = w; }
            }
        }
    }
    __syncthreads();
}

__device__ __forceinline__ void pf_router(const PA a, int l, LAS unsigned char* lds) {
    const int tid = otid(), wave = tid >> 6, lane = tid & 63, fr = lane & 15, fq = lane >> 4;
    LAS int* s_cnt = (LAS int*)lds;
    LAS int* s_base = s_cnt + 32;
    LAS int* s_e = s_base + 32;
    LAS int* s_rk = s_e + 256;
    LAS float* s_w = (LAS float*)(s_rk + 256);
    const bf16_t* X = WSP(const bf16_t, WS_XB); const float* SS = WSP(const float, WS_SS);
    const bf16_t* wrh = WSP(const bf16_t, WS_WRH) + (size_t)l * 48 * 1024; const bf16_t* wrl = WSP(const bf16_t, WS_WRL) + (size_t)l * 48 * 1024;
    const float* bg = INP(32) + l * 4; const float* br = INP(34) + l * 32;
    int* EID = WSP(int, WS_EID); float* EW = WSP(float, WS_EW); int* ERK = WSP(int, WS_ERK);
    unsigned* cnt = WSP(unsigned, WS_CTL) + CW_CNT + l * 32;
    for (int tile = oblk(); tile < T / 128; tile += ogrid()) {
        __syncthreads();
        if (tid < 32) s_cnt[tid] = 0;
        __syncthreads();
        const int t = tile * 128 + wave * 16 + fr;
        f32x4 acc[3];
#pragma unroll
        for (int mt = 0; mt < 3; ++mt) acc[mt] = (f32x4){0.f, 0.f, 0.f, 0.f};
        const bf16_t* xr = X + (size_t)t * 1024 + 8 * fq;
        u32x4 wst[6];
#define RT_LOAD(sl_) do { _Pragma("unroll") for (int i = 0; i < 6; ++i) { const int p = tid + i * 512, arr = p / 1536, pr = p - arr * 1536, r = pr >> 5, q = pr & 31; \
            wst[i] = *(const u32x4*)((arr ? wrl : wrh) + (size_t)r * 1024 + (sl_) * 256 + q * 8); } } while (0)
#define RT_STORE(buf_) do { _Pragma("unroll") for (int i = 0; i < 6; ++i) { const int p = tid + i * 512, arr = p / 1536, pr = p - arr * 1536, r = pr >> 5, q = pr & 31; \
            *(LAS u32x4*)(lds + 4096 + (buf_) * 50688 + arr * 25344 + r * 528 + q * 16) = wst[i]; } } while (0)
        RT_LOAD(0); RT_STORE(0);
        __syncthreads();
#pragma unroll 1
        for (int sl = 0; sl < 4; ++sl) {
            if (sl < 3) RT_LOAD(sl + 1);
            const LAS unsigned char* wb_ = lds + 4096 + (sl & 1) * 50688;
#pragma unroll
            for (int s8 = 0; s8 < 8; ++s8) {
                const int s_ = sl * 8 + s8;
                const bf16x8 xh = *(const bf16x8*)(xr + 32 * s_);
#pragma unroll
                for (int mt = 0; mt < 3; ++mt) {
                    const bf16x8 wh = *(const LAS bf16x8*)(wb_ + (mt * 16 + fr) * 528 + (32 * s8 + 8 * fq) * 2);
                    const bf16x8 wl = *(const LAS bf16x8*)(wb_ + 25344 + (mt * 16 + fr) * 528 + (32 * s8 + 8 * fq) * 2);
                    acc[mt] = __builtin_amdgcn_mfma_f32_16x16x32_bf16(wh, xh, acc[mt], 0, 0, 0);
                    acc[mt] = __builtin_amdgcn_mfma_f32_16x16x32_bf16(wl, xh, acc[mt], 0, 0, 0);
                }
            }
            if (sl < 3) { RT_STORE((sl + 1) & 1); __syncthreads(); }
        }
#undef RT_LOAD
#undef RT_STORE
        const f32x4* sp = (const f32x4*)(SS + (size_t)t * 16);
        const f32x4 s0 = sp[0], s1 = sp[1], s2 = sp[2], s3 = sp[3];
        const float tot = ((s0[0] + s0[1]) + (s0[2] + s0[3])) + ((s1[0] + s1[1]) + (s1[2] + s1[3])) + ((s2[0] + s2[1]) + (s2[2] + s2[3])) + ((s3[0] + s3[1]) + (s3[2] + s3[3]));
        const float rinv = rsqrtf(tot * (1.0f / 1024.0f) + 1e-6f);
        float lg[4], lr[8];
#pragma unroll
        for (int j = 0; j < 4; ++j) { lg[j] = acc[0][j] * rinv + bg[j]; lr[j] = acc[1][j] * rinv + br[fq * 8 + j]; lr[4 + j] = acc[2][j] * rinv + br[fq * 8 + 4 + j]; }
        float g0 = lg[0]; int gt = 0;
#pragma unroll
        for (int j = 1; j < 4; ++j) { if (lg[j] > g0) { g0 = lg[j]; gt = j; } }
        if (fq == gt) {
            float gs = 0.f;
#pragma unroll
            for (int j = 0; j < 4; ++j) gs += __expf(lg[j] - g0);
            const float ggate = 1.0f / gs;
            float l1 = -1e30f, l2 = -1e30f; int j1 = 0, j2 = 0;
#pragma unroll
            for (int j = 0; j < 8; ++j) { const float v = lr[j];
                if (v > l1) { l2 = l1; j2 = j1; l1 = v; j1 = j; } else if (v > l2) { l2 = v; j2 = j; } }
            const float e2 = __expf(l2 - l1);
            const float p1 = 1.0f / (1.0f + e2), p2 = e2 / (1.0f + e2);
            const int e1i = gt * 8 + j1, e2i = gt * 8 + j2;
            const int r1 = atomicAdd((int*)(s_cnt + e1i), 1), r2 = atomicAdd((int*)(s_cnt + e2i), 1);
            const int sl = (wave * 16 + fr) * 2;
            s_e[sl] = e1i; s_e[sl + 1] = e2i; s_rk[sl] = r1; s_rk[sl + 1] = r2; s_w[sl] = ggate * p1; s_w[sl + 1] = ggate * p2;
        }
        __syncthreads();
        if (tid < 32) s_base[tid] = (int)__hip_atomic_fetch_add(cnt + tid, (unsigned)s_cnt[tid], __ATOMIC_RELAXED, __HIP_MEMORY_SCOPE_AGENT);
        __syncthreads();
        if (tid < 256) { const int e = s_e[tid]; const size_t o = (size_t)tile * 256 + tid; EID[o] = e; EW[o] = s_w[tid]; ERK[o] = s_base[e] + s_rk[tid]; }
    }
    __syncthreads();
}

__device__ __forceinline__ void pg_gather(const PA a, int l, LAS unsigned char* lds) {
    const int tid = otid(), wave = tid >> 6, lane = tid & 63;
    LAS int* s_ps = (LAS int*)lds;
    const unsigned* cnt = WSP(const unsigned, WS_CTL) + CW_CNT + l * 32;
    int* SSLOT = WSP(int, WS_SSLOT); float* SW = WSP(float, WS_SW); int* MTE = WSP(int, WS_MTE);
    bf16_t* XS = WSP(bf16_t, WS_XS); const bf16_t* XB = WSP(const bf16_t, WS_XB);
    const float* SS = WSP(const float, WS_SS);
    const int* EID = WSP(const int, WS_EID); const float* EW = WSP(const float, WS_EW); const int* ERK = WSP(const int, WS_ERK);
    __syncthreads();
    if (tid == 0) {
        int acc = 0;
        for (int e = 0; e < 32; ++e) { s_ps[e] = acc; const int c = (int)__hip_atomic_load(cnt + e, __ATOMIC_RELAXED, __HIP_MEMORY_SCOPE_AGENT); acc += ((c + 255) >> 8) << 8; }
        s_ps[32] = acc;
    }
    __syncthreads();
    if (oblk() == 0) {
        if (tid < 32) { const int m0 = s_ps[tid] >> 8, m1 = s_ps[tid + 1] >> 8; for (int mt = m0; mt < m1; ++mt) MTE[mt] = tid; }
        if (tid == 0) MTE[511] = s_ps[32] >> 8;
        if (tid < 33) MTE[400 + tid] = s_ps[tid] >> 8;
    }
    int* STOK = WSP(int, WS_STOK); float* SRINV = WSP(float, WS_SRINV);
    for (int e = oblk(); e < 32; e += ogrid()) {
        const int c = (int)__hip_atomic_load(cnt + e, __ATOMIC_RELAXED, __HIP_MEMORY_SCOPE_AGENT);
        const int r0 = s_ps[e] + c, r1 = s_ps[e + 1];
        for (int r = r0 + tid; r < r1; r += 512) { SSLOT[r] = -1; SW[r] = 0.f; STOK[r] = 0; SRINV[r] = 0.f; }
    }
    for (int as = oblk() * 512 + tid; as < 2 * T; as += ogrid() * 512) {
        const int t = as >> 1;
        const int dest = s_ps[EID[as]] + ERK[as];
        const f32x4* sp = (const f32x4*)(SS + (size_t)t * 16);
        const f32x4 s0 = sp[0], s1 = sp[1], s2 = sp[2], s3 = sp[3];
        const float tot = ((s0[0] + s0[1]) + (s0[2] + s0[3])) + ((s1[0] + s1[1]) + (s1[2] + s1[3])) + ((s2[0] + s2[1]) + (s2[2] + s2[3])) + ((s3[0] + s3[1]) + (s3[2] + s3[3]));
        SSLOT[dest] = as; SW[dest] = EW[as]; STOK[dest] = t; SRINV[dest] = rsqrtf(tot * (1.0f / 1024.0f) + 1e-6f);
    }
}

__device__ __forceinline__ void pj_finalize(const PA a, bool last) {
    const int wave = otid() >> 6, lane = otid() & 63;
    float* OUT = a.out; bf16_t* XB = WSP(bf16_t, WS_XB); float* SS = WSP(float, WS_SS);
    const bf16_t* Y = WSP(const bf16_t, WS_Y);
    for (int t = oblk() * 8 + wave; t < T; t += ogrid() * 8) {
        float sq = 0.f;
#pragma unroll
        for (int i = 0; i < 2; ++i) {
            const int c = i * 512 + lane * 8;
            const u32x4 xw = *(const u32x4*)(XB + (size_t)t * 1024 + c);
            const u32x4 y0 = *(const u32x4*)(Y + (size_t)(2 * t) * 1024 + c), y1 = *(const u32x4*)(Y + (size_t)(2 * t + 1) * 1024 + c);
            float v[8];
#pragma unroll
            for (int j = 0; j < 4; ++j) { v[2 * j] = lo16(xw[j]) + (lo16(y0[j]) + lo16(y1[j])); v[2 * j + 1] = hi16(xw[j]) + (hi16(y0[j]) + hi16(y1[j])); }
            if (last) { *(f32x4*)(OUT + (size_t)t * 1024 + c) = (f32x4){v[0], v[1], v[2], v[3]}; *(f32x4*)(OUT + (size_t)t * 1024 + c + 4) = (f32x4){v[4], v[5], v[6], v[7]}; }
            else {
                u32x4 w; w.x = pk2(v[0], v[1]); w.y = pk2(v[2], v[3]); w.z = pk2(v[4], v[5]); w.w = pk2(v[6], v[7]);
                *(u32x4*)(XB + (size_t)t * 1024 + c) = w;
#pragma unroll
                for (int j = 0; j < 4; ++j) { const float a0 = lo16(w[j]), a1 = hi16(w[j]); sq += a0 * a0 + a1 * a1; }
            }
        }
        if (!last) { sq = wsum(sq); if (lane < 16) SS[(size_t)t * 16 + lane] = (lane == 0) ? sq : 0.f; }
    }
}

#define SITE static __device__ __forceinline__ void
#define OPAQUE() do { a.out = (float*)ldsin(lds, 38); a.ws = (unsigned char*)ldsin(lds, 39); } while (0)
__device__ __forceinline__ int opq(int v) { asm volatile("" : "+s"(v)); return v; }
SITE site_p0(PA a, LAS unsigned char* lds) { OPAQUE(); p0_prologue(a, lds); }
SITE site_kv(PA a, LAS unsigned char* lds) { OPAQUE();
    pg8::Gemm g{WSP(const bf16_t, WS_MEMB), WSP(const bf16_t, WS_WKV), 1024, (size_t)1024 * 1024, nullptr};
    pg8::KvOrder S{opq((int)gridDim.x), opq((int)blockIdx.x)};
    pg8::EpiScale E{WSP(bf16_t, WS_KV), 1024, WSP(const float, WS_MEMSS), MROWS - 1};
    pg8::gemm_phase<pg8::EpiScale, pg8::KvOrder>(lds, g, S, E);
}
SITE site_knorm(PA a, LAS unsigned char* lds) { OPAQUE(); p2_knorm(a, lds); }
SITE site_inproj(PA a, int l, LAS unsigned char* lds) { OPAQUE();
    pg8::Gemm g{WSP(const bf16_t, WS_XB), WSP(const bf16_t, WS_WIN) + (size_t)l * INW * 1024, 1024, 0, nullptr};
    pg8::StaticOrder S; S.init(T, INW, opq((int)gridDim.x), opq((int)blockIdx.x));
    pg8::EpiProj E{WSP(bf16_t, WS_PROJ), WSP(bf16_t, WS_VT), WSP(bf16_t, WS_KFR), WSP(const float, WS_SS), INP(18) + l * 64, INP(19) + l * 64};
    pg8::gemm_phase<pg8::EpiProj, pg8::StaticOrder>(lds, g, S, E);
}
SITE site_prep(PA a, int l, LAS unsigned char* lds) { OPAQUE();
    pb_prep(a, l, lds);
}
SITE site_chunks(PA a, int l, LAS unsigned char* lds) { OPAQUE(); pb2_chunks(a, l, lds); }
SITE site_mixer(PA a, int l, LAS unsigned char* lds) { OPAQUE(); pc_mixer(a, l, lds); }
SITE site_outproj(PA a, int l, LAS unsigned char* lds) { OPAQUE();
    pg8::Gemm g{WSP(const bf16_t, WS_YCAT), WSP(const bf16_t, WS_WOUT) + (size_t)l * 1024 * 1024, 1024, 0, nullptr};
    pg8::StaticOrder S; S.init(T, 1024, opq((int)gridDim.x), opq((int)blockIdx.x));
    pg8::EpiRes E{WSP(bf16_t, WS_XB), WSP(float, WS_SS)};
    pg8::gemm_phase<pg8::EpiRes, pg8::StaticOrder>(lds, g, S, E);
}
SITE site_xq(PA a, int l, LAS unsigned char* lds) { OPAQUE();
    pg8::Gemm g{WSP(const bf16_t, WS_XB), WSP(const bf16_t, WS_WQ) + (size_t)l * 512 * 1024, 1024, 0, nullptr};
    pg8::StaticOrder S; S.init(T, 512, opq((int)gridDim.x), opq((int)blockIdx.x));
    pg8::EpiScale E{WSP(bf16_t, WS_QX), 512, WSP(const float, WS_SS), T - 1};
    pg8::gemm_phase<pg8::EpiScale, pg8::StaticOrder>(lds, g, S, E);
}
SITE site_xattn(PA a, int l, LAS unsigned char* lds) { OPAQUE(); pe2_xattn(a, l, lds); }
SITE site_xo(PA a, int l, LAS unsigned char* lds) { OPAQUE();
    pg8::Gemm g{WSP(const bf16_t, WS_OX), WSP(const bf16_t, WS_WO) + (size_t)l * 1024 * 512, 512, 0, nullptr};
    pg8::StaticOrder S; S.init(T, 1024, opq((int)gridDim.x), opq((int)blockIdx.x));
    pg8::EpiRes E{WSP(bf16_t, WS_XB), WSP(float, WS_SS)};
    pg8::gemm_phase<pg8::EpiRes, pg8::StaticOrder>(lds, g, S, E);
}
SITE site_router(PA a, int l, LAS unsigned char* lds) { OPAQUE(); pf_router(a, l, lds); }
SITE site_gather(PA a, int l, LAS unsigned char* lds) { OPAQUE(); pg_gather(a, l, lds); }
SITE site_gu(PA a, LAS unsigned char* lds) { OPAQUE();
    pg8::Gemm g{WSP(const bf16_t, WS_XB), WSP(const bf16_t, WS_WGU), 1024, (size_t)1024 * 1024, WSP(const int, WS_STOK)};
    pg8::MoeOrder S; S.mte = WSP(const int, WS_MTE); S.G = opq((int)gridDim.x); S.c = opq((int)blockIdx.x); S.init();
    pg8::EpiGU E{WSP(bf16_t, WS_HB), WSP(const float, WS_SRINV)};
    pg8::gemm_phase<pg8::EpiGU, pg8::MoeOrder, true, true>(lds, g, S, E);
}
SITE site_down(PA a, LAS unsigned char* lds) { OPAQUE();
    pg8::Gemm g{WSP(const bf16_t, WS_HB), WSP(const bf16_t, WS_WD), 512, (size_t)1024 * 512, nullptr};
    pg8::MoeOrder S; S.mte = WSP(const int, WS_MTE); S.G = opq((int)gridDim.x); S.c = opq((int)blockIdx.x); S.init();
    pg8::EpiDown E{WSP(bf16_t, WS_Y), WSP(const int, WS_SSLOT), WSP(const float, WS_SW)};
    pg8::gemm_phase<pg8::EpiDown, pg8::MoeOrder>(lds, g, S, E);
}
SITE site_final(PA a, int l, LAS unsigned char* lds) { OPAQUE(); pj_finalize(a, l == NL - 1); }

__global__ void __launch_bounds__(512, 2) mk_fwd(Args args) {
    extern __shared__ __attribute__((aligned(16))) unsigned char lds_raw[];
    LAS unsigned char* lds = (LAS unsigned char*)lds_raw;
    const int tid = threadIdx.x;
    const int lo = args.ph_lo, hi = args.ph_hi;
    PA a; a.out = args.out; a.ws = args.ws;
    if (tid < 16) ((LAS unsigned*)(lds + LDS_MISC))[tid] = 0u;
    if (tid == 64) {
        LAS unsigned long long* tab = (LAS unsigned long long*)(lds + LDS_INTAB);
#pragma unroll
        for (int i = 0; i < 38; ++i) tab[i] = (unsigned long long)args.in[i];
        tab[38] = (unsigned long long)args.out; tab[39] = (unsigned long long)args.ws;
    }
    __syncthreads();
    XcdBarrier bar; bar.bar = WSP(unsigned, WS_CTL) + CW_BAR; bar.x = 0; bar.st = nullptr;
    if (!MK_PER_PHASE) bar = xcd_barrier_post(WSP(unsigned, WS_CTL) + CW_BAR, (volatile LAS unsigned*)(lds + LDS_MISC));
#define IN(k) (lo <= (k) && (k) < hi)
#define GRID_BAR() do { if (!MK_PER_PHASE) xcd_barrier(bar); } while (0)
#ifdef PROBE_MASK
    unsigned long long pr_acc = 0ull, pr_t0 = 0ull; const unsigned long long pr_start = wall_clock64();
#define PR0() do { pr_t0 = wall_clock64(); } while (0)
#define PR1(p) do { if ((PROBE_MASK >> (p)) & 1) pr_acc += wall_clock64() - pr_t0; } while (0)
#else
#define PR0() do { } while (0)
#define PR1(p) do { } while (0)
#endif
    PR0(); if (IN(0)) { site_p0(a, lds); GRID_BAR(); } PR1(12);
    PR0(); if (IN(1)) { site_kv(a, lds); GRID_BAR(); } PR1(13);
    PR0(); if (IN(2)) { site_knorm(a, lds); GRID_BAR(); } PR1(14);
    for (int l = 0; l < NL; ++l) {
        const int pb = 3 + 12 * l;
        PR0(); if (IN(pb + 0)) { site_inproj(a, l, lds); GRID_BAR(); } PR1(0);
        PR0(); if (IN(pb + 1)) { site_prep(a, l, lds); GRID_BAR(); } PR1(1);
        PR0(); if (IN(pb + 2)) { site_mixer(a, l, lds); GRID_BAR(); } PR1(2);
        PR0(); if (IN(pb + 3)) { site_outproj(a, l, lds); GRID_BAR(); } PR1(3);
        PR0(); if (IN(pb + 4)) { site_xq(a, l, lds); GRID_BAR(); } PR1(4);
        PR0(); if (IN(pb + 5)) { site_xattn(a, l, lds); GRID_BAR(); } PR1(5);
        PR0(); if (IN(pb + 6)) { site_xo(a, l, lds); GRID_BAR(); } PR1(6);
        PR0(); if (IN(pb + 7)) { site_router(a, l, lds); GRID_BAR(); } PR1(7);
        PR0(); if (IN(pb + 8)) { site_gather(a, l, lds); GRID_BAR(); } PR1(8);
        PR0(); if (IN(pb + 9)) { site_gu(a, lds); GRID_BAR(); } PR1(9);
        PR0(); if (IN(pb + 10)) { site_down(a, lds); GRID_BAR(); } PR1(10);
#ifdef PROBE_MASK
        PR0(); if (IN(pb + 11)) { site_final(a, l, lds); GRID_BAR(); } PR1(11);
#else
        if (IN(pb + 11)) { site_final(a, l, lds); if (l + 1 < NL) GRID_BAR(); }
#endif
    }
#ifdef PROBE_MASK
    {
        unsigned long long* pw = (unsigned long long*)(WSP(unsigned, WS_CTL) + 8192);
        if (blockIdx.x == 0 && tid == 0) __hip_atomic_store(pw, pr_acc, __ATOMIC_RELAXED, __HIP_MEMORY_SCOPE_AGENT);
        GRID_BAR();
        const unsigned long long tgt = 1600000ull + __hip_atomic_load(pw, __ATOMIC_RELAXED, __HIP_MEMORY_SCOPE_AGENT) * (unsigned long long)PROBE_MULT;
        while (wall_clock64() - pr_start < tgt) __builtin_amdgcn_s_sleep(16);
    }
#endif
#undef IN
#undef GRID_BAR
}

extern "C" void kernel_launch(void* const* d_in, const int* in_sizes, int n_in, void* d_out, int out_size, void* d_ws, size_t ws_size, hipStream_t stream) {
    static int grid = 0;
    if (grid == 0) {
        if (n_in != 38 || out_size != T * D || ws_size < WS_END) { fprintf(stderr, "kernel_launch: unexpected shapes (n_in %d out %d ws %zu need %zu)\n", n_in, out_size, ws_size, (size_t)WS_END); grid = -1; return; }
        int dev = 0, cus = 0, per_cu = 0;
        if (hipGetDevice(&dev) != hipSuccess || hipDeviceGetAttribute(&cus, hipDeviceAttributeMultiprocessorCount, dev) != hipSuccess) { grid = -1; return; }
        if (hipFuncSetAttribute((const void*)mk_fwd, hipFuncAttributeMaxDynamicSharedMemorySize, LDS_BYTES) != hipSuccess) { fprintf(stderr, "kernel_launch: hipFuncSetAttribute failed\n"); grid = -1; return; }
        if (hipOccupancyMaxActiveBlocksPerMultiprocessor(&per_cu, (const void*)mk_fwd, 512, LDS_BYTES) != hipSuccess || per_cu < 1) { fprintf(stderr, "kernel_launch: occupancy query says %d\n", per_cu); }
        (void)hipGetLastError();
        grid = cus;
    }
    if (grid < 0) return;
    (void)hipMemsetAsync((char*)d_ws + WS_CTL, 0, CTL_BYTES, stream);
    Args a{};
    for (int i = 0; i < 38; ++i) a.in[i] = (const float*)d_in[i];
    a.out = (float*)d_out; a.ws = (unsigned char*)d_ws;
#if MK_PER_PHASE
    for (int p = 0; p < NPH; ++p) { a.ph_lo = p; a.ph_hi = p + 1; hipLaunchKernelGGL(mk_fwd, dim3(grid), dim3(512), LDS_BYTES, stream, a); }
#else
    a.ph_lo = 0; a.ph_hi = NPH;
    hipLaunchKernelGGL(mk_fwd, dim3(grid), dim3(512), LDS_BYTES, stream, a);
#endif
}
```

```cpp
#include <hip/hip_runtime.h>
#include <cstdio>
#include <cstdint>

#ifndef MK_PER_PHASE
#define MK_PER_PHASE 0
#endif

#define LAS __attribute__((address_space(3)))
typedef unsigned short bf16_t;
typedef short bf16x8 __attribute__((ext_vector_type(8)));
typedef float f32x4 __attribute__((ext_vector_type(4)));
typedef unsigned u32x4 __attribute__((ext_vector_type(4)));
typedef unsigned u32x2 __attribute__((ext_vector_type(2)));

constexpr int T = 32768, D = 1024, SEQ = 2048, NL = 4;
constexpr int INW = 3328;
constexpr int MROWS = 4096;
constexpr int MAXROWS = 73728, MAXMT = 288;
constexpr int NPH = 3 + 12 * NL;

constexpr size_t WS_CTL   = 0;
constexpr size_t CTL_BYTES = 65536;
constexpr size_t WS_WIN   = WS_CTL + CTL_BYTES;
constexpr size_t WS_WOUT  = WS_WIN  + (size_t)4 * 3328 * 1024 * 2;
constexpr size_t WS_WQ    = WS_WOUT + (size_t)4 * 1024 * 1024 * 2;
constexpr size_t WS_WKV   = WS_WQ   + (size_t)4 * 512 * 1024 * 2;
constexpr size_t WS_WO    = WS_WKV  + (size_t)4 * 1024 * 1024 * 2;
constexpr size_t WS_WGU   = WS_WO   + (size_t)4 * 1024 * 512 * 2;
constexpr size_t WS_WD    = WS_WGU  + (size_t)32 * 1024 * 1024 * 2;
constexpr size_t WS_KV    = WS_WD   + (size_t)32 * 1024 * 512 * 2;
constexpr size_t WS_MEMB  = WS_KV   + (size_t)4 * 4096 * 1024 * 2;
constexpr size_t WS_MEMSS = WS_MEMB + (size_t)4096 * 1024 * 2;
constexpr size_t WS_VTX   = WS_MEMSS + (size_t)4096 * 16 * 4;
constexpr size_t WS_WRH   = WS_VTX  + (size_t)4 * 4096 * 512 * 2;
constexpr size_t WS_WRL   = WS_WRH  + (size_t)4 * 48 * 1024 * 2;
constexpr size_t WS_PBI   = WS_WRL  + (size_t)4 * 48 * 1024 * 2;
constexpr int PBI_BYTES = 122880;
constexpr size_t WS_XB    = WS_PBI  + (size_t)16 * PBI_BYTES;
constexpr size_t WS_SS    = WS_XB   + (size_t)T * 1024 * 2;
constexpr size_t WS_VF    = WS_SS   + (size_t)T * 16 * 4;
constexpr size_t WS_EID   = WS_VF   + (size_t)T * 512 * 2;
constexpr size_t WS_EW    = WS_EID  + (size_t)T * 2 * 4;
constexpr size_t WS_ERK   = WS_EW   + (size_t)T * 2 * 4;
constexpr size_t WS_SSLOT = WS_ERK  + (size_t)T * 2 * 4;
constexpr size_t WS_SW    = WS_SSLOT + (size_t)MAXROWS * 4;
constexpr size_t WS_MTE   = WS_SW   + (size_t)MAXROWS * 4;
constexpr size_t WS_STOK  = WS_MTE  + 2048;
constexpr size_t WS_SRINV = WS_STOK + (size_t)MAXROWS * 4;
constexpr size_t WS_U     = WS_SRINV + (size_t)MAXROWS * 4;
constexpr size_t WS_PROJ  = WS_U;
constexpr size_t WS_SR    = WS_PROJ + (size_t)T * 3328 * 2;
constexpr size_t WS_SK    = WS_SR   + (size_t)T * 512 * 2;
constexpr size_t WS_SV    = WS_SK   + (size_t)T * 512 * 2;
constexpr size_t WS_SA    = WS_SV   + (size_t)T * 512 * 2;
constexpr size_t WS_SB    = WS_SA   + (size_t)T * 512 * 2;
constexpr size_t WS_SG    = WS_SB   + (size_t)T * 512 * 2;
constexpr size_t WS_SWD   = WS_SG   + (size_t)T * 512 * 2;
constexpr size_t WS_YCAT  = WS_SWD  + (size_t)T * 512 * 4;
constexpr size_t WS_VT    = WS_YCAT + (size_t)T * 1024 * 2;
constexpr int NCHUNK = 16 * 8 * 128;
constexpr size_t WS_BTT   = WS_VT   + (size_t)T * 512 * 2;
constexpr size_t WS_KTT   = WS_BTT  + (size_t)NCHUNK * 2048;
constexpr size_t WS_VST   = WS_KTT  + (size_t)NCHUNK * 2048;
constexpr size_t WS_NKA   = WS_VST  + (size_t)NCHUNK * 2048;
constexpr size_t WS_NBR   = WS_NKA  + (size_t)NCHUNK * 512;
constexpr size_t WS_NKR   = WS_NBR  + (size_t)NCHUNK * 512;
constexpr size_t WS_TMT   = WS_NKR  + (size_t)NCHUNK * 512;
constexpr size_t WS_PCK   = WS_TMT  + (size_t)NCHUNK * 512;
constexpr size_t WS_BS    = WS_PCK  + (size_t)NCHUNK * 256;
constexpr size_t WS_KFR   = WS_SK;
constexpr size_t WS_LH    = WS_SV;
constexpr size_t WS_UEND1 = WS_BS   + (size_t)T * 8 * 4;
constexpr size_t WS_QX    = WS_U;
constexpr size_t WS_OX    = WS_QX   + (size_t)T * 512 * 2;
constexpr size_t WS_XS    = WS_U;
constexpr size_t WS_HB    = WS_XS   + (size_t)MAXROWS * 1024 * 2;
constexpr size_t WS_Y     = WS_HB   + (size_t)MAXROWS * 512 * 2;
constexpr size_t WS_UEND2 = WS_Y    + (size_t)2 * T * 1024 * 2;
constexpr size_t WS_END   = WS_UEND1 > WS_UEND2 ? WS_UEND1 : WS_UEND2;

constexpr int CW_BAR = 0;
constexpr int CW_CNT = 4096;
constexpr int CW_QUEUE = 4096 + 256;

constexpr int LDS_MISC = 139264;
constexpr int LDS_BYTES = LDS_MISC + 16384;

struct Args { const float* in[38]; float* out; unsigned char* ws; int ph_lo, ph_hi; };
struct PA { float* out; unsigned char* ws; };

__device__ __forceinline__ float bf2f(bf16_t b) { return __uint_as_float(((unsigned)b) << 16); }
__device__ __forceinline__ bf16_t f2bf(float f) { unsigned u = __float_as_uint(f); u += 0x7FFFu + ((u >> 16) & 1u); return (bf16_t)(u >> 16); }
typedef __bf16 bf16v2 __attribute__((ext_vector_type(2)));
typedef float f32x2 __attribute__((ext_vector_type(2)));
__device__ __forceinline__ unsigned pk2(float lo, float hi) { f32x2 v = {lo, hi}; bf16v2 b = __builtin_convertvector(v, bf16v2); return __builtin_bit_cast(unsigned, b); }
__device__ __forceinline__ float lo16(unsigned u) { return __uint_as_float(u << 16); }
__device__ __forceinline__ float hi16(unsigned u) { return __uint_as_float(u & 0xffff0000u); }
__device__ __forceinline__ float wsum(float v) {
#pragma unroll
    for (int o = 32; o; o >>= 1) v += __shfl_xor(v, o);
    return v;
}
__device__ __forceinline__ float sigmoidf_(float x) { return 1.0f / (1.0f + __expf(-x)); }

#define XB_TMO      128
#define XB_XCNT(j)  (256  + 64 * (j))
#define XB_XSUB(j)  (1280 + 64 * (j))
#define XB_XGEN(j)  (2304 + 64 * (j))
#define XB_TOP      3328
#define XB_TOPGEN   3392
#define XCD_BAR_WORDS 3456
#define XB_SPIN_CAP (1u << 22)

__device__ __forceinline__ unsigned xb_ld(unsigned* p)              { return __hip_atomic_load(p, __ATOMIC_RELAXED, __HIP_MEMORY_SCOPE_AGENT); }
__device__ __forceinline__ unsigned xb_add(unsigned* p, unsigned v) { return __hip_atomic_fetch_add(p, v, __ATOMIC_RELAXED, __HIP_MEMORY_SCOPE_AGENT); }
__device__ __forceinline__ unsigned xb_xcc_id() { return (unsigned)__builtin_amdgcn_s_getreg((3 << 11) | 20) & 0xFu; }
#define XB_SPIN(cond, bar) do { unsigned _sp = 0; while (cond) { __builtin_amdgcn_s_sleep(1); \
    if ((++_sp & 255u) == 0u) { if (xb_ld(&(bar)[XB_TMO])) break; if (_sp > XB_SPIN_CAP) { atomicAdd(&(bar)[XB_TMO], 1u); break; } } } } while (0)

struct XcdBarrier { unsigned* bar; unsigned x; volatile LAS unsigned* st; };

__device__ __forceinline__ XcdBarrier xcd_barrier_post(unsigned* bar, volatile LAS unsigned* st) {
    XcdBarrier b; b.bar = bar; b.x = xb_xcc_id(); b.st = st;
    if (threadIdx.x == 0) (void)xb_add(&bar[XB_XCNT(b.x)], 1u);
    return b;
}
__device__ __forceinline__ void xcd_barrier_complete(unsigned* bar, unsigned x, unsigned& nloc, unsigned& nx) {
    const unsigned G = gridDim.x * gridDim.y * gridDim.z;
    unsigned sum, cnt, mine, sp = 0u;
    for (;;) {
        sum = 0u; cnt = 0u; mine = 0u;
#pragma unroll
        for (unsigned j = 0; j < 16; ++j) { const unsigned c = xb_ld(&bar[XB_XCNT(j)]); sum += c; cnt += (c > 0u) ? 1u : 0u; mine = (j == x) ? c : mine; }
        if (sum == G) break;
        __builtin_amdgcn_s_sleep(1);
        if ((++sp & 255u) == 0u) { if (xb_ld(&bar[XB_TMO])) break; if (sp > XB_SPIN_CAP) { atomicAdd(&bar[XB_TMO], 1u); break; } }
    }
    nloc = mine > 0u ? mine : 1u; nx = cnt > 0u ? cnt : 1u;
}
__device__ __forceinline__ void xcd_barrier(const XcdBarrier& b) {
    asm volatile("s_waitcnt vmcnt(0)" ::: "memory");
    __syncthreads();
    if (threadIdx.x == 0) {
        unsigned* bar = b.bar;
        __builtin_amdgcn_s_waitcnt(0);
        unsigned nloc = b.st[0], nx = b.st[1];
        if (nloc == 0u) { xcd_barrier_complete(bar, b.x, nloc, nx); b.st[0] = nloc; b.st[1] = nx; }
        const unsigned old = xb_add(&bar[XB_XSUB(b.x)], 1u);
        const unsigned gen = old / nloc;
        if (old + 1u == (gen + 1u) * nloc) {
            __builtin_amdgcn_fence(__ATOMIC_RELEASE, "agent");
            asm volatile("s_waitcnt vmcnt(0)" ::: "memory");
            const unsigned og = xb_add(&bar[XB_TOP], 1u);
            const unsigned tg = og / nx;
            if (og + 1u == (tg + 1u) * nx) xb_add(&bar[XB_TOPGEN], 1u);
            else XB_SPIN(xb_ld(&bar[XB_TOPGEN]) == tg, bar);
            __builtin_amdgcn_fence(__ATOMIC_ACQUIRE, "agent");
            xb_add(&bar[XB_XGEN(b.x)], 1u);
            asm volatile("s_waitcnt vmcnt(0)" ::: "memory");
        } else {
            XB_SPIN(xb_ld(&bar[XB_XGEN(b.x)]) == gen, bar);
            __builtin_amdgcn_fence(__ATOMIC_ACQUIRE, "agent");
            asm volatile("s_waitcnt vmcnt(0)" ::: "memory");
        }
    }
    __syncthreads();
}

namespace pg8 {
constexpr int BM = 256, BK = 64, HALF = 128, HTB = HALF * BK * 2, STAGE_BYTES = 8 * HTB, NXCD = 8, WGM = 8;
__host__ __device__ __forceinline__ int lds_byte(int r, int c) { const int st = (r >> 4) * 2 + (c >> 5), rr = r & 15, cc = c & 31, ob = rr * 64 + cc * 2; return st * 1024 + (ob ^ (((ob >> 9) & 1) << 5)); }
__host__ __device__ __forceinline__ void stage_rc(int b, int& R, int& C) { const int st = b / 1024, sb = b % 1024, swz = sb ^ (((sb >> 9) & 1) << 5); R = (st >> 1) * 16 + swz / 64; C = (st & 1) * 32 + (swz % 64) / 2; }
__host__ __device__ __forceinline__ int perm32(int rho) { const int n = rho >> 4, i = rho & 15; return 8 * (i >> 2) + 4 * n + (i & 3); }

struct Unit { int pm, pn, pa, z; };
struct Gemm { const bf16_t* A; const bf16_t* Bt; int K; size_t bz_stride; const int* rowidx; };

struct StaticOrder {
    int nM, nN, nwg, G, c;
    __device__ void init(int M, int N, int G_, int c_) { nM = M / BM; nN = N / BM; nwg = nM * nN; G = G_; c = c_; }
    __device__ bool next(int i, Unit& u) const {
        const long L = (long)i * G + c; if (L >= nwg) return false;
        int wgid = (int)L; { const int q = nwg / NXCD, r = nwg % NXCD, xcd = wgid % NXCD, off = wgid / NXCD; wgid = (xcd < r ? xcd * (q + 1) : r * (q + 1) + (xcd - r) * q) + off; }
        const int nig = WGM * nN, gid = wgid / nig, fm = gid * WGM, gsz = (nM - fm) < WGM ? (nM - fm) : WGM;
        u.pm = fm + ((wgid % nig) % gsz); u.pn = (wgid % nig) / gsz; u.pa = u.pm; u.z = 0; return true;
    }
};
struct KvOrder {
    int G, c;
    __device__ bool next(int i, Unit& u) const {
        const int L = i * G + c; if (L >= 256) return false;
        u.z = L >> 6; const int r = L & 63; u.pa = r >> 2; u.pn = r & 3; u.pm = u.z * 16 + u.pa; return true;
    }
};
struct MoeOrder {
    const int* mte; int G, c;
    int b0[4], b1[4];
    __device__ void init() {
        const int x = c & 7;
#pragma unroll
        for (int k = 0; k < 4; ++k) { b0[k] = mte[400 + x + 8 * k]; b1[k] = mte[401 + x + 8 * k]; }
#pragma unroll
        for (int k = 0; k < 4; ++k) { b0[k] = __builtin_amdgcn_readfirstlane(b0[k]); b1[k] = __builtin_amdgcn_readfirstlane(b1[k]); }
    }
    __device__ bool next(int i, Unit& u) const {
        if ((G & 7) != 0) {
            const int nunits = mte[511] * 4;
            const int L = i * G + c; if (L >= nunits) return false;
            u.pm = L >> 2; u.pa = u.pm; u.pn = L & 3; u.z = mte[u.pm]; return true;
        }
        const int x = c & 7; int q = i * (G >> 3) + (c >> 3);
#pragma unroll
        for (int k = 0; k < 4; ++k) {
            const int e = x + 8 * k; const int m0 = b0[k], m1 = b1[k]; const int n = (m1 - m0) * 4;
            if (q < n) { u.pm = m0 + (q >> 2); u.pa = u.pm; u.pn = q & 3; u.z = e; return true; }
            q -= n;
        }
        return false;
    }
};

template <class Epi, class Sched, bool ALIGN_EPI = true, bool GATHER = false>
__device__ __forceinline__ void gemm_phase(LAS unsigned char* lds, const Gemm g, const Sched& S, const Epi& E) {
    int tid_ = threadIdx.x; asm volatile("" : "+v"(tid_));
    const int tid = tid_, wid = __builtin_amdgcn_readfirstlane(tid >> 6), lane = tid & 63, wr = wid >> 2, wc = wid & 3, fr = lane & 15, fq = lane >> 4;
    const int K = g.K, nt = K / BK;
    unsigned voffA[2], voffB[2], gcol[2]; int grow[2];
#pragma unroll
    for (int i = 0; i < 2; ++i) { int R, C; stage_rc(tid * 16 + i * 8192, R, C); const int Rb = ((R & ~31) + perm32(R & 31));
        voffA[i] = (unsigned)(R * K + C) * 2u; voffB[i] = (unsigned)(Rb * K + C) * 2u; grow[i] = R; gcol[i] = (unsigned)C * 2u; }
    const size_t kstep = (size_t)(BK * 2);
    const size_t hstep = (size_t)HALF * K * 2;
    const size_t tstep = 2 * hstep;
    const unsigned ldsw = (unsigned)wid * 1024u;
    const int aoff = lds_byte(wr * 64 + fr, fq * 8), boff = lds_byte(wc * 32 + fr, fq * 8);
#define PG8_SA(b, h) (((b) * 2 + (h)) * HTB)
#define PG8_SB(b, h) ((4 + (b) * 2 + (h)) * HTB)
#define PG8_STAGE(bufoff, gbase, voff) do { _Pragma("unroll") for (int _i = 0; _i < 2; ++_i) \
        __builtin_amdgcn_global_load_lds((const unsigned*)((const char*)(gbase) + (voff)[_i]), (LAS unsigned*)(lds + (bufoff) + ldsw + _i * 8192), 16, 0, 0); } while (0)
#define PG8_LDA(dst, b, h) do { _Pragma("unroll") for (int m = 0; m < 4; ++m) _Pragma("unroll") for (int k = 0; k < 2; ++k) dst[m][k] = *(const LAS bf16x8*)(lds + PG8_SA(b, h) + aoff + m * 2048 + k * 1024); } while (0)
#define PG8_LDB(dst, b, h) do { _Pragma("unroll") for (int n = 0; n < 2; ++n) _Pragma("unroll") for (int k = 0; k < 2; ++k) dst[n][k] = *(const LAS bf16x8*)(lds + PG8_SB(b, h) + boff + n * 2048 + k * 1024); } while (0)
#define PG8_MMA(ai, bj, At, Bt) do { __builtin_amdgcn_s_setprio(1); _Pragma("unroll") for (int m = 0; m < 4; ++m) _Pragma("unroll") for (int n = 0; n < 2; ++n) _Pragma("unroll") for (int k = 0; k < 2; ++k) \
        acc[ai][bj][m][n] = __builtin_amdgcn_mfma_f32_16x16x32_bf16(Bt[n][k], At[m][k], acc[ai][bj][m][n], 0, 0, 0); __builtin_amdgcn_s_setprio(0); } while (0)
#define PG8_WAIT_V(n) asm volatile("s_waitcnt vmcnt(" #n ")" ::: "memory")
#define PG8_WAIT_L(n) asm volatile("s_waitcnt lgkmcnt(" #n ")" ::: "memory")
#define PG8_BAR __builtin_amdgcn_s_barrier()
#define PG8_SCHED __builtin_amdgcn_sched_barrier(0)
#define PG8_APTR(u) ((const char*)g.A + (size_t)(u).pa * tstep)
#define PG8_BPTR(u) ((const char*)g.Bt + ((size_t)(u).z * g.bz_stride) * 2 + (size_t)(u).pn * tstep)
    Unit cur, nxt; int ui = 0;
    if (!S.next(0, cur)) return;
    f32x4 acc[2][2][4][2];
#pragma unroll
    for (int a = 0; a < 2; ++a)
#pragma unroll
        for (int b = 0; b < 2; ++b)
#pragma unroll
            for (int m = 0; m < 4; ++m)
#pragma unroll
                for (int n = 0; n < 2; ++n) acc[a][b][m][n] = (f32x4){0.f, 0.f, 0.f, 0.f};
    bf16x8 At[4][2], B0[2][2], B1[2][2];
    const char* cA = GATHER ? (const char*)g.A : PG8_APTR(cur); const char* cB = PG8_BPTR(cur);
    unsigned gcu[2][2] = {{0u, 0u}, {0u, 0u}}, gnx[2][2] = {{0u, 0u}, {0u, 0u}};
#define PG8_GOFF(dst, u) do { _Pragma("unroll") for (int h_ = 0; h_ < 2; ++h_) _Pragma("unroll") for (int i_ = 0; i_ < 2; ++i_) \
        dst[h_][i_] = (unsigned)g.rowidx[(u).pa * 256 + h_ * 128 + grow[i_]] * (unsigned)(K * 2) + gcol[i_]; } while (0)
    if constexpr (GATHER) PG8_GOFF(gcu, cur);
#define PG8_STAGE_A(bufoff, h_, nonGatherPtr, gatherBase, GO) do { if constexpr (GATHER) { PG8_STAGE(bufoff, gatherBase, GO[h_]); } else { PG8_STAGE(bufoff, nonGatherPtr, voffA); } } while (0)
    PG8_STAGE(PG8_SB(0, 0), cB, voffB); PG8_STAGE(PG8_SB(0, 1), cB + hstep, voffB); PG8_STAGE_A(PG8_SA(0, 0), 0, cA, cA, gcu); PG8_STAGE_A(PG8_SA(0, 1), 1, cA + hstep, cA, gcu);
    if (wr == 1) PG8_BAR;
    PG8_WAIT_V(2); PG8_BAR;
    PG8_STAGE(PG8_SB(1, 0), cB + kstep, voffB); PG8_STAGE_A(PG8_SA(1, 0), 0, cA + kstep, cA + kstep, gcu); PG8_STAGE(PG8_SB(1, 1), cB + hstep + kstep, voffB);
    PG8_WAIT_V(6); PG8_BAR;
    for (;;) {
        const bool has_next = S.next(ui + 1, nxt);
        const char* nA = GATHER ? cA : (has_next ? PG8_APTR(nxt) : cA); const char* nB = has_next ? PG8_BPTR(nxt) : cB;
        if constexpr (GATHER) { if (has_next) PG8_GOFF(gnx, nxt); else { _Pragma("unroll") for (int h_ = 0; h_ < 2; ++h_) _Pragma("unroll") for (int i_ = 0; i_ < 2; ++i_) gnx[h_][i_] = gcu[h_][i_]; } }
        for (int t = 0; t < nt; t += 2) {
            const bool last = (t == nt - 2);
            const char* a1 = cA + (size_t)(t + 1) * kstep;
            const char* a2 = last ? nA : cA + (size_t)(t + 2) * kstep; const char* b2 = last ? nB : cB + (size_t)(t + 2) * kstep;
            const char* a3 = a2 + kstep; const char* b3 = b2 + kstep;
            unsigned gse[2][2];
            _Pragma("unroll") for (int h_ = 0; h_ < 2; ++h_) _Pragma("unroll") for (int i_ = 0; i_ < 2; ++i_) gse[h_][i_] = last ? gnx[h_][i_] : gcu[h_][i_];
            PG8_LDB(B0, 0, 0); PG8_LDB(B1, 0, 1); PG8_SCHED; PG8_LDA(At, 0, 0); PG8_STAGE_A(PG8_SA(1, 1), 1, a1 + hstep, a1, gcu);
            PG8_WAIT_V(8); PG8_WAIT_L(0); PG8_BAR; PG8_MMA(0, 0, At, B0); PG8_MMA(0, 1, At, B1); PG8_BAR; PG8_SCHED;
            PG8_LDA(At, 0, 1); PG8_STAGE(PG8_SB(0, 0), b2, voffB); PG8_STAGE(PG8_SB(0, 1), b2 + hstep, voffB); PG8_STAGE_A(PG8_SA(0, 0), 0, a2, a2, gse);
            PG8_WAIT_V(8); PG8_WAIT_L(0); PG8_BAR; PG8_MMA(1, 0, At, B0); PG8_MMA(1, 1, At, B1); PG8_BAR; PG8_SCHED;
            PG8_LDB(B0, 1, 0); PG8_LDB(B1, 1, 1); PG8_SCHED; PG8_LDA(At, 1, 0); PG8_STAGE_A(PG8_SA(0, 1), 1, a2 + hstep, a2, gse);
            PG8_WAIT_V(8); PG8_WAIT_L(0); PG8_BAR; PG8_MMA(0, 0, At, B0); PG8_MMA(0, 1, At, B1); PG8_BAR; PG8_SCHED;
            PG8_LDA(At, 1, 1); PG8_STAGE(PG8_SB(1, 0), b3, voffB); PG8_STAGE(PG8_SB(1, 1), b3 + hstep, voffB); PG8_STAGE_A(PG8_SA(1, 0), 0, a3, a3, gse);
            PG8_WAIT_V(8); PG8_WAIT_L(0); PG8_BAR; PG8_MMA(1, 0, At, B0); PG8_MMA(1, 1, At, B1); PG8_BAR; PG8_SCHED;
        }
        if constexpr (ALIGN_EPI) { if (wr == 0) PG8_BAR; }
        E(acc, cur, wr, wc, fr, fq);
        if (!has_next) break;
#pragma unroll
        for (int a = 0; a < 2; ++a)
#pragma unroll
            for (int b = 0; b < 2; ++b)
#pragma unroll
                for (int m = 0; m < 4; ++m)
#pragma unroll
                    for (int n = 0; n < 2; ++n) acc[a][b][m][n] = (f32x4){0.f, 0.f, 0.f, 0.f};
        cur = nxt; cA = nA; cB = nB; ++ui;
        if constexpr (GATHER) { _Pragma("unroll") for (int h_ = 0; h_ < 2; ++h_) _Pragma("unroll") for (int i_ = 0; i_ < 2; ++i_) gcu[h_][i_] = gnx[h_][i_]; }
        if constexpr (ALIGN_EPI) { if (wr == 1) PG8_BAR; }
    }
    PG8_WAIT_V(0);
    if constexpr (!ALIGN_EPI) { if (wr == 0) PG8_BAR; }
    PG8_BAR;
#undef PG8_SA
#undef PG8_SB
#undef PG8_STAGE
#undef PG8_LDA
#undef PG8_LDB
#undef PG8_MMA
#undef PG8_WAIT_V
#undef PG8_WAIT_L
#undef PG8_BAR
#undef PG8_SCHED
#undef PG8_APTR
#undef PG8_BPTR
#undef PG8_GOFF
#undef PG8_STAGE_A
}

typedef const f32x4 (&AccRef)[2][2][4][2];

__device__ __forceinline__ f32x4 ss_part(const float* ss, size_t row, int fq) { return *(const f32x4*)(ss + row * 16 + 4 * fq); }
__device__ __forceinline__ float ss_tot(f32x4 s) { float p = (s[0] + s[1]) + (s[2] + s[3]); p += __shfl_xor(p, 16); p += __shfl_xor(p, 32); return p; }
#define EPI_FENCE8(v) asm volatile("s_waitcnt vmcnt(0)" : "+v"((v)[0][0]), "+v"((v)[0][1]), "+v"((v)[0][2]), "+v"((v)[0][3]), "+v"((v)[1][0]), "+v"((v)[1][1]), "+v"((v)[1][2]), "+v"((v)[1][3]) :: "memory")
struct EpiScale {
    bf16_t* O; int ldc; const float* ss; int ssmask;
    __device__ __forceinline__ void operator()(AccRef acc, const Unit& u, int wr, int wc, int fr, int fq) const {
        f32x4 sv[2][4]; float rv[2][4];
#pragma unroll
        for (int ai = 0; ai < 2; ++ai)
#pragma unroll
            for (int m = 0; m < 4; ++m) sv[ai][m] = ss_part(ss, (size_t)((u.pm * 256 + ai * 128 + wr * 64 + m * 16 + fr) & ssmask), fq);
        EPI_FENCE8(sv);
#pragma unroll
        for (int ai = 0; ai < 2; ++ai)
#pragma unroll
            for (int m = 0; m < 4; ++m) rv[ai][m] = rsqrtf(ss_tot(sv[ai][m]) * (1.0f / 1024.0f) + 1e-6f);
#pragma unroll
        for (int ai = 0; ai < 2; ++ai)
#pragma unroll
            for (int m = 0; m < 4; ++m) {
                const int row = u.pm * 256 + ai * 128 + wr * 64 + m * 16 + fr;
                const float rinv = rv[ai][m];
#pragma unroll
                for (int bj = 0; bj < 2; ++bj) {
                    const int col = u.pn * 256 + bj * 128 + wc * 32 + 8 * fq;
                    const f32x4 v0 = acc[ai][bj][m][0] * rinv, v1 = acc[ai][bj][m][1] * rinv;
                    u32x4 w; w.x = pk2(v0[0], v0[1]); w.y = pk2(v0[2], v0[3]); w.z = pk2(v1[0], v1[1]); w.w = pk2(v1[2], v1[3]);
                    *(u32x4*)(O + (size_t)row * ldc + col) = w;
                }
            }
    }
};
struct EpiProj {
    bf16_t* O; bf16_t* VT; bf16_t* KF; const float* ss; const float* qg; const float* kg;
    __device__ __forceinline__ void operator()(AccRef acc, const Unit& u, int wr, int wc, int fr, int fq) const {
        f32x4 sv[2][4]; float rv[2][4];
#pragma unroll
        for (int ai = 0; ai < 2; ++ai)
#pragma unroll
            for (int m = 0; m < 4; ++m) sv[ai][m] = ss_part(ss, (size_t)(u.pm * 256 + ai * 128 + wr * 64 + m * 16 + fr), fq);
        if (u.pn >= 7 && u.pn <= 10) {
            const bool isk = u.pn >= 9; const float* gp = isk ? kg : qg;
            const int head = ((u.pn - 7) & 1) * 4 + wc;
            f32x4 g00 = *(const f32x4*)(gp + 8 * fq), g01 = *(const f32x4*)(gp + 8 * fq + 4), g10 = *(const f32x4*)(gp + 32 + 8 * fq), g11 = *(const f32x4*)(gp + 32 + 8 * fq + 4);
            const float qsc = isk ? 1.0f : 0.18033688011112042f;
#pragma unroll
            for (int ai = 0; ai < 2; ++ai)
#pragma unroll
                for (int m = 0; m < 4; ++m) rv[ai][m] = 0.f;
            EPI_FENCE8(sv);
            asm volatile("" : "+v"(g00), "+v"(g01), "+v"(g10), "+v"(g11));
#pragma unroll
            for (int ai = 0; ai < 2; ++ai)
#pragma unroll
                for (int m = 0; m < 4; ++m) rv[ai][m] = ss_tot(sv[ai][m]) * (1.0f / 1024.0f) + 1e-6f;
#pragma unroll
            for (int ai = 0; ai < 2; ++ai)
#pragma unroll
                for (int m = 0; m < 4; ++m) {
                    const int row = u.pm * 256 + ai * 128 + wr * 64 + m * 16 + fr;
                    const f32x4 a0 = acc[ai][0][m][0], a1 = acc[ai][0][m][1], b0 = acc[ai][1][m][0], b1 = acc[ai][1][m][1];
                    float sq = ((a0[0] * a0[0] + a0[1] * a0[1]) + (a0[2] * a0[2] + a0[3] * a0[3])) + ((a1[0] * a1[0] + a1[1] * a1[1]) + (a1[2] * a1[2] + a1[3] * a1[3]))
                             + ((b0[0] * b0[0] + b0[1] * b0[1]) + (b0[2] * b0[2] + b0[3] * b0[3])) + ((b1[0] * b1[0] + b1[1] * b1[1]) + (b1[2] * b1[2] + b1[3] * b1[3]));
                    sq += __shfl_xor(sq, 16); sq += __shfl_xor(sq, 32);
                    const float sc = rsqrtf(sq * (1.0f / 64.0f) + 1e-6f * rv[ai][m]) * qsc;
                    bf16_t* op = isk ? KF + ((((size_t)(row >> 11) * 8 + head) * 128 + ((row & 2047) >> 4)) * 2) * 512 + (fq * 16 + fr) * 8
                                     : O + (size_t)row * INW + 1792 + head * 64 + 8 * fq;
                    const int op2 = isk ? 512 : 32;
                    u32x4 w;
                    w.x = pk2(a0[0] * sc * g00[0], a0[1] * sc * g00[1]); w.y = pk2(a0[2] * sc * g00[2], a0[3] * sc * g00[3]); w.z = pk2(a1[0] * sc * g01[0], a1[1] * sc * g01[1]); w.w = pk2(a1[2] * sc * g01[2], a1[3] * sc * g01[3]);
                    *(u32x4*)op = w;
                    w.x = pk2(b0[0] * sc * g10[0], b0[1] * sc * g10[1]); w.y = pk2(b0[2] * sc * g10[2], b0[3] * sc * g10[3]); w.z = pk2(b1[0] * sc * g11[0], b1[1] * sc * g11[1]); w.w = pk2(b1[2] * sc * g11[2], b1[3] * sc * g11[3]);
                    *(u32x4*)(op + op2) = w;
                }
            return;
        }
#pragma unroll
        for (int ai = 0; ai < 2; ++ai)
#pragma unroll
            for (int m = 0; m < 4; ++m) rv[ai][m] = 0.f;
        EPI_FENCE8(sv);
#pragma unroll
        for (int ai = 0; ai < 2; ++ai)
#pragma unroll
            for (int m = 0; m < 4; ++m) rv[ai][m] = rsqrtf(ss_tot(sv[ai][m]) * (1.0f / 1024.0f) + 1e-6f);
#pragma unroll
        for (int ai = 0; ai < 2; ++ai)
#pragma unroll
            for (int m = 0; m < 4; ++m) {
                const int row = u.pm * 256 + ai * 128 + wr * 64 + m * 16 + fr;
                const float rinv = rv[ai][m];
#pragma unroll
                for (int bj = 0; bj < 2; ++bj) {
                    const int col = u.pn * 256 + bj * 128 + wc * 32 + 8 * fq;
                    const f32x4 v0 = acc[ai][bj][m][0] * rinv, v1 = acc[ai][bj][m][1] * rinv;
                    u32x4 w; w.x = pk2(v0[0], v0[1]); w.y = pk2(v0[2], v0[3]); w.z = pk2(v1[0], v1[1]); w.w = pk2(v1[2], v1[3]);
                    if (u.pn < 11) *(u32x4*)(O + (size_t)row * INW + col) = w;
                    else {
                        const int cv = col - 2816;
                        const int sq_ = row & 2047, kk = sq_ & 31;
                        bf16_t* vp = VT + ((((size_t)((row >> 11) * 8 + (cv >> 6)) * 64 + (sq_ >> 5)) * 4 + ((cv & 63) >> 4)) * 64 + ((kk & 15) >> 2) * 16 + (cv & 15)) * 8 + ((kk >> 4) & 1) * 4 + (kk & 3);
#pragma unroll
                        for (int e = 0; e < 4; ++e) { vp[(2 * e) * 8] = (bf16_t)(w[e] & 0xffffu); vp[(2 * e + 1) * 8] = (bf16_t)(w[e] >> 16); }
                    }
                }
            }
    }
};
struct EpiRes {
    bf16_t* XB; float* SS;
    __device__ __forceinline__ void operator()(AccRef acc, const Unit& u, int wr, int wc, int fr, int fq) const {
        u32x4 xin[2][2][4];
#pragma unroll
        for (int ai = 0; ai < 2; ++ai)
#pragma unroll
            for (int m = 0; m < 4; ++m)
#pragma unroll
                for (int bj = 0; bj < 2; ++bj)
                    xin[bj][ai][m] = *(const u32x4*)(XB + (size_t)(u.pm * 256 + ai * 128 + wr * 64 + m * 16 + fr) * 1024 + u.pn * 256 + bj * 128 + wc * 32 + 8 * fq);
        EPI_FENCE8(xin[0]);
        asm volatile("" : "+v"(xin[1][0][0]), "+v"(xin[1][0][1]), "+v"(xin[1][0][2]), "+v"(xin[1][0][3]), "+v"(xin[1][1][0]), "+v"(xin[1][1][1]), "+v"(xin[1][1][2]), "+v"(xin[1][1][3]));
#pragma unroll
        for (int ai = 0; ai < 2; ++ai)
#pragma unroll
            for (int m = 0; m < 4; ++m) {
                const int row = u.pm * 256 + ai * 128 + wr * 64 + m * 16 + fr;
                float sq = 0.f;
#pragma unroll
                for (int bj = 0; bj < 2; ++bj) {
                    const int col = u.pn * 256 + bj * 128 + wc * 32 + 8 * fq;
                    u32x4* xp = (u32x4*)(XB + (size_t)row * 1024 + col);
                    const u32x4 xw = xin[bj][ai][m];
                    f32x4 x0 = {lo16(xw.x), hi16(xw.x), lo16(xw.y), hi16(xw.y)}, x1 = {lo16(xw.z), hi16(xw.z), lo16(xw.w), hi16(xw.w)};
                    x0 += acc[ai][bj][m][0]; x1 += acc[ai][bj][m][1];
                    u32x4 w; w.x = pk2(x0[0], x0[1]); w.y = pk2(x0[2], x0[3]); w.z = pk2(x1[0], x1[1]); w.w = pk2(x1[2], x1[3]);
                    *xp = w;
                    x0 = (f32x4){lo16(w.x), hi16(w.x), lo16(w.y), hi16(w.y)}; x1 = (f32x4){lo16(w.z), hi16(w.z), lo16(w.w), hi16(w.w)};
                    sq += (x0[0] * x0[0] + x0[1] * x0[1]) + (x0[2] * x0[2] + x0[3] * x0[3]) + (x1[0] * x1[0] + x1[1] * x1[1]) + (x1[2] * x1[2] + x1[3] * x1[3]);
                }
                sq += __shfl_xor(sq, 16); sq += __shfl_xor(sq, 32);
                if (fq == 0) SS[(size_t)row * 16 + u.pn * 4 + wc] = sq;
            }
    }
};
struct EpiGU {
    bf16_t* H; const float* rinv;
    __device__ __forceinline__ void operator()(AccRef acc, const Unit& u, int wr, int wc, int fr, int fq) const {
        float rv[2][4];
#pragma unroll
        for (int ai = 0; ai < 2; ++ai)
#pragma unroll
            for (int m = 0; m < 4; ++m) rv[ai][m] = rinv[u.pm * 256 + ai * 128 + wr * 64 + m * 16 + fr];
        EPI_FENCE8(rv);
#pragma unroll
        for (int ai = 0; ai < 2; ++ai)
#pragma unroll
            for (int m = 0; m < 4; ++m) {
                const int row = u.pm * 256 + ai * 128 + wr * 64 + m * 16 + fr;
                const float rs = rv[ai][m];
                float h[8];
#pragma unroll
                for (int n = 0; n < 2; ++n)
#pragma unroll
                    for (int j = 0; j < 4; ++j) { const float gt = acc[ai][0][m][n][j] * rs, up = acc[ai][1][m][n][j] * rs; h[n * 4 + j] = gt * __builtin_amdgcn_rcpf(1.0f + __expf(-gt)) * up; }
                u32x4 w; w.x = pk2(h[0], h[1]); w.y = pk2(h[2], h[3]); w.z = pk2(h[4], h[5]); w.w = pk2(h[6], h[7]);
                *(u32x4*)(H + (size_t)row * 512 + u.pn * 128 + wc * 32 + 8 * fq) = w;
            }
    }
};
struct EpiDown {
    bf16_t* Y; const int* slot; const float* sw;
    __device__ __forceinline__ void operator()(AccRef acc, const Unit& u, int wr, int wc, int fr, int fq) const {
        int sl[2][4]; float wv[2][4];
#pragma unroll
        for (int ai = 0; ai < 2; ++ai)
#pragma unroll
            for (int m = 0; m < 4; ++m) { const int row = u.pm * 256 + ai * 128 + wr * 64 + m * 16 + fr; sl[ai][m] = slot[row]; wv[ai][m] = sw[row]; }
        EPI_FENCE8(sl);
        asm volatile("" : "+v"(wv[0][0]), "+v"(wv[0][1]), "+v"(wv[0][2]), "+v"(wv[0][3]), "+v"(wv[1][0]), "+v"(wv[1][1]), "+v"(wv[1][2]), "+v"(wv[1][3]));
#pragma unroll
        for (int ai = 0; ai < 2; ++ai)
#pragma unroll
            for (int m = 0; m < 4; ++m) {
                const int s = sl[ai][m]; const float wgt = wv[ai][m];
                if (s >= 0) {
#pragma unroll
                    for (int bj = 0; bj < 2; ++bj) {
                        const int col = u.pn * 256 + bj * 128 + wc * 32 + 8 * fq;
                        const f32x4 v0 = acc[ai][bj][m][0] * wgt, v1 = acc[ai][bj][m][1] * wgt;
                        u32x4 w; w.x = pk2(v0[0], v0[1]); w.y = pk2(v0[2], v0[3]); w.z = pk2(v1[0], v1[1]); w.w = pk2(v1[2], v1[3]);
                        *(u32x4*)(Y + (size_t)s * 1024 + col) = w;
                    }
                }
            }
    }
};
}

#define WSP(type, off) ((type*)(a.ws + (off)))
__device__ __forceinline__ int oblk() { int t = blockIdx.x; asm volatile("" : "+s"(t)); return t; }
__device__ __forceinline__ int ogrid() { int t = gridDim.x; asm volatile("" : "+s"(t)); return t; }
__device__ __forceinline__ int otid() { int t = threadIdx.x; asm volatile("" : "+v"(t)); return t; }
constexpr int LDS_INTAB = LDS_MISC + 14336;
__device__ __forceinline__ const float* ldsin(LAS unsigned char* lds, int i) {
    const unsigned long long p = ((const LAS unsigned long long*)(lds + LDS_INTAB))[i];
    const unsigned lo = __builtin_amdgcn_readfirstlane((unsigned)p), hi = __builtin_amdgcn_readfirstlane((unsigned)(p >> 32));
    return (const float*)(__attribute__((address_space(1))) const float*)(((unsigned long long)hi << 32) | lo);
}
#define INP(i) ldsin(lds, (i))

template <int MAP>
__device__ __forceinline__ void conv_slab(const float* __restrict__ src, int N, int Kper, bf16_t* __restrict__ dst, size_t estride,
                                          const float* __restrict__ gain, int goff, LAS float* tile, int slab) {
    const int tid = otid();
    const int nsn = N >> 8;
    const int kt = slab / nsn, ns = slab - kt * nsn, k0 = kt * 64, n0 = ns * 256;
    const int e = k0 / Kper, kl0 = k0 - e * Kper;
    f32x4 v[8]; float gs[8];
#pragma unroll
    for (int i = 0; i < 8; ++i) { const int idx = tid + i * 512, kk = idx >> 6, n4 = (idx & 63) * 4; v[i] = *(const f32x4*)(src + (size_t)(k0 + kk) * N + n0 + n4);
        const int gi = kl0 + kk - goff; gs[i] = (gain != nullptr) ? gain[gi < 0 ? 0 : gi] : 1.0f; }
    asm volatile("" : "+v"(gs[0]), "+v"(gs[1]), "+v"(gs[2]), "+v"(gs[3]), "+v"(gs[4]), "+v"(gs[5]), "+v"(gs[6]), "+v"(gs[7]));
#pragma unroll
    for (int i = 0; i < 8; ++i) {
        const int idx = tid + i * 512, kk = idx >> 6, n4 = (idx & 63) * 4;
        const float gsc = (kl0 + kk >= goff) ? gs[i] : 1.0f;
        LAS float* tp = tile + kk * 257 + n4;
        tp[0] = v[i][0] * gsc; tp[1] = v[i][1] * gsc; tp[2] = v[i][2] * gsc; tp[3] = v[i][3] * gsc;
    }
    __syncthreads();
#pragma unroll
    for (int i = 0; i < 4; ++i) {
        const int p = tid + i * 512, nn = p >> 3, kg = p & 7;
        float x[8];
#pragma unroll
        for (int j = 0; j < 8; ++j) x[j] = tile[(kg * 8 + j) * 257 + nn];
        const int n = n0 + nn;
        int nr;
        if (MAP == 0) nr = n;
        else if (MAP == 3) { const int pn_ = n >> 8, wi = n & 255;
            nr = (pn_ >= 7 && pn_ <= 10) ? pn_ * 256 + ((wi & 63) >> 5) * 128 + (wi >> 6) * 32 + (wi & 31) : n; }
        else nr = (n >> 7) * 256 + (n & 127) + (MAP == 2 ? 128 : 0);
        u32x4 w; w.x = pk2(x[0], x[1]); w.y = pk2(x[2], x[3]); w.z = pk2(x[4], x[5]); w.w = pk2(x[6], x[7]);
        *(u32x4*)(dst + (size_t)e * estride + (size_t)nr * Kper + kl0 + kg * 8) = w;
    }
    __syncthreads();
}
template <int MAP>
__device__ __forceinline__ void conv_T(const float* __restrict__ src, int Ktot, int N, int Kper, bf16_t* __restrict__ dst, size_t estride,
                                       const float* __restrict__ gain, int goff, LAS float* tile) {
    const int nslab = (Ktot >> 6) * (N >> 8);
    for (int sl = oblk(); sl < nslab; sl += ogrid()) conv_slab<MAP>(src, N, Kper, dst, estride, gain, goff, tile, sl);
}
constexpr int MOE_CONV_ITEMS = 3 * 256;
__device__ __forceinline__ void moe_convert_item(const PA a, int l, LAS unsigned char* lds, int item) {
    LAS float* tile = (LAS float*)lds;
    const int which = item >> 8, s0 = (item & 255) * 4;
    const float* gn = INP(30) + l * 1024;
    for (int sl = s0; sl < s0 + 4; ++sl) {
        if (which == 0)      conv_slab<1>(INP(35) + (size_t)l * 32 * 1024 * 512, 512, 1024, WSP(bf16_t, WS_WGU), (size_t)1024 * 1024, gn, 0, tile, sl);
        else if (which == 1) conv_slab<2>(INP(36) + (size_t)l * 32 * 1024 * 512, 512, 1024, WSP(bf16_t, WS_WGU), (size_t)1024 * 1024, gn, 0, tile, sl);
        else                 conv_slab<0>(INP(37) + (size_t)l * 32 * 512 * 1024, 1024, 512, WSP(bf16_t, WS_WD), (size_t)1024 * 512, nullptr, 0, tile, sl);
    }
}

__device__ __forceinline__ void rows_convert(const float* __restrict__ src, float* __restrict__ dstf, bf16_t* __restrict__ dstb, float* __restrict__ ss, int nrows) {
    const int wave = otid() >> 6, lane = otid() & 63;
    for (int r = oblk() * 8 + wave; r < nrows; r += ogrid() * 8) {
        float sq = 0.f;
        f32x4 vv[4];
#pragma unroll
        for (int i = 0; i < 4; ++i) vv[i] = *(const f32x4*)(src + (size_t)r * 1024 + i * 256 + lane * 4);
        asm volatile("" : "+v"(vv[0]), "+v"(vv[1]), "+v"(vv[2]), "+v"(vv[3]));
#pragma unroll
        for (int i = 0; i < 4; ++i) {
            const int c = i * 256 + lane * 4;
            const f32x4 v = vv[i];
            if (dstf) *(f32x4*)(dstf + (size_t)r * 1024 + c) = v;
            u32x2 w; w.x = pk2(v[0], v[1]); w.y = pk2(v[2], v[3]);
            *(u32x2*)(dstb + (size_t)r * 1024 + c) = w;
            sq += (v[0] * v[0] + v[1] * v[1]) + (v[2] * v[2] + v[3] * v[3]);
        }
        sq = wsum(sq);
        if (lane < 16) ss[(size_t)r * 16 + lane] = (lane == 0) ? sq : 0.f;
    }
}

__device__ __forceinline__ void p0_prologue(const PA a, LAS unsigned char* lds) {
    LAS float* tile = (LAS float*)lds;
    for (int l = 0; l < NL; ++l) {
        conv_T<3>(INP(3) + (size_t)l * 1024 * INW, 1024, INW, 1024, WSP(bf16_t, WS_WIN) + (size_t)l * INW * 1024, 0, INP(2) + l * 1024, 0, tile);
        conv_T<0>(INP(22) + (size_t)l * 1024 * 1024, 1024, 1024, 1024, WSP(bf16_t, WS_WOUT) + (size_t)l * 1024 * 1024, 0, INP(21) + l * 512, 512, tile);
        conv_T<0>(INP(25) + (size_t)l * 1024 * 512, 1024, 512, 1024, WSP(bf16_t, WS_WQ) + (size_t)l * 512 * 1024, 0, INP(23) + l * 1024, 0, tile);
        conv_T<0>(INP(26) + (size_t)l * 1024 * 1024, 1024, 1024, 1024, WSP(bf16_t, WS_WKV) + (size_t)l * 1024 * 1024, 0, INP(24) + l * 1024, 0, tile);
        conv_T<0>(INP(27) + (size_t)l * 512 * 1024, 512, 1024, 512, WSP(bf16_t, WS_WO) + (size_t)l * 1024 * 512, 0, nullptr, 0, tile);
    }
    {
        bf16_t* wrh = WSP(bf16_t, WS_WRH); bf16_t* wrl = WSP(bf16_t, WS_WRL);
        for (int idx = oblk() * 512 + otid(); idx < NL * 48 * 1024; idx += ogrid() * 512) {
            const int k = idx & 1023, r = (idx >> 10) % 48, l = idx / (48 * 1024);
            float w;
            if (r < 16) w = INP(31)[((size_t)l * 1024 + k) * 4 + (r & 3)];
            else { const int ri = ((r >> 2) & 3) * 8 + ((r >> 4) - 1) * 4 + (r & 3); w = INP(33)[((size_t)l * 1024 + k) * 32 + ri]; }
            w *= INP(30)[l * 1024 + k];
            const bf16_t hi = f2bf(w);
            wrh[idx] = hi; wrl[idx] = f2bf(w - bf2f(hi));
        }
    }
    {
        const int gt = oblk() * 512 + otid(), gs = ogrid() * 512;
        for (int e = gt; e < 16 * 8192; e += gs) { const int im = e >> 13, idx = e & 8191, ch = idx & 127, k = idx >> 7, l = im >> 2, chb = (im & 3) * 128;
            bf16_t* ib = (bf16_t*)(a.ws + WS_PBI + (size_t)im * PBI_BYTES);
            ib[ch * 72 + k] = f2bf(INP(6)[(size_t)l * 64 * 512 + k * 512 + chb + ch]); ib[9216 + ch * 72 + k] = f2bf(INP(8)[(size_t)l * 64 * 512 + k * 512 + chb + ch]); }
        for (int e = gt; e < 16 * 16384; e += gs) { const int im = e >> 14, idx = e & 16383, ch = idx & 127, k = idx >> 7, l = im >> 2, chb = (im & 3) * 128;
            bf16_t* ib = (bf16_t*)(a.ws + WS_PBI + (size_t)im * PBI_BYTES);
            ib[18432 + ch * 136 + k] = f2bf(INP(9)[(size_t)l * 128 * 512 + k * 512 + chb + ch]); }
        for (int e = gt; e < 16 * 4096; e += gs) { const int im = e >> 12, idx = e & 4095, ch = idx & 127, k = idx >> 7, l = im >> 2, chb = (im & 3) * 128;
            bf16_t* ib = (bf16_t*)(a.ws + WS_PBI + (size_t)im * PBI_BYTES);
            ib[35840 + ch * 40 + k] = l > 0 ? f2bf(INP(17)[(size_t)(l - 1) * 32 * 512 + k * 512 + chb + ch]) : (bf16_t)0; }
        for (int e = gt; e < 16 * 16384; e += gs) { const int im = e >> 14, idx = e & 16383, n = idx & 31, k = idx >> 5, l = im >> 2;
            bf16_t* ib = (bf16_t*)(a.ws + WS_PBI + (size_t)im * PBI_BYTES);
            ib[40960 + n * 520 + k] = l > 0 ? f2bf(INP(16)[(size_t)(l - 1) * 512 * 32 + k * 32 + n]) : (bf16_t)0; }
        for (int e = gt; e < 16 * 1920; e += gs) { const int im = e / 1920, idx = e - im * 1920, l = im >> 2, chb = (im & 3) * 128;
            float* fb = (float*)(a.ws + WS_PBI + (size_t)im * PBI_BYTES + 115200);
            float v;
            if (idx < 1152) { const int arr = idx >> 7, cc = chb + (idx & 127);
                v = arr == 0 ? INP(4)[l * 1792 + cc] : arr == 1 ? INP(4)[l * 1792 + 512 + cc] : arr == 2 ? INP(4)[l * 1792 + 1024 + cc] : arr == 3 ? INP(5)[l * 512 + cc]
                  : arr == 4 ? INP(7)[l * 512 + cc] : arr == 5 ? INP(10)[l * 512 + cc] : arr == 6 ? INP(11)[l * 512 + cc] : arr == 7 ? (l > 0 ? INP(15)[(l - 1) * 512 + cc] : 0.f) : INP(12)[l * 512 + cc]; }
            else v = INP(4)[l * 1792 + 1024 + (idx - 1152)];
            fb[idx] = v; }
    }
    rows_convert(INP(0), nullptr, WSP(bf16_t, WS_XB), WSP(float, WS_SS), T);
    rows_convert(INP(1), nullptr, WSP(bf16_t, WS_MEMB), WSP(float, WS_MEMSS), MROWS);
}

__device__ __forceinline__ void p2_knorm(const PA a, LAS unsigned char* lds) {
    const int wave = otid() >> 6, lane = otid() & 63;
    bf16_t* kv = WSP(bf16_t, WS_KV);
    for (int it = oblk() * 8 + wave; it < NL * MROWS * 4; it += ogrid() * 8) {
        const int h = it & 3, row = (it >> 2) & (MROWS - 1), l = it >> 14;
        unsigned* p = (unsigned*)(kv + ((size_t)l * MROWS + row) * 1024 + h * 128 + lane * 2);
        const unsigned w = *p; const float x0 = lo16(w), x1 = hi16(w);
        const float ssq = wsum(x0 * x0 + x1 * x1);
        const float rinv = rsqrtf(ssq * (1.0f / 128.0f) + 1e-6f);
        const float* gk = INP(29) + l * 128 + lane * 2;
        *p = pk2(x0 * rinv * gk[0], x1 * rinv * gk[1]);
    }
    bf16_t* vtx = WSP(bf16_t, WS_VTX);
    const int tid = otid();
    for (int it = oblk(); it < NL * 16 * 4; it += ogrid()) {
        const int h = it & 3, b = (it >> 2) & 15, l = it >> 6;
        const bf16_t* src = kv + ((size_t)l * MROWS + b * 256) * 1024 + 512 + h * 128;
        bf16_t* dst = vtx + (size_t)it * 128 * 256;
#pragma unroll 1
        for (int i = 0; i < 8; ++i) {
            const int p = tid + i * 512, d = p & 127, m8 = (p >> 7) * 8;
            unsigned short x[8];
#pragma unroll
            for (int j = 0; j < 8; ++j) x[j] = src[(size_t)(m8 + j) * 1024 + d];
            u32x4 w; w.x = x[0] | ((unsigned)x[1] << 16); w.y = x[2] | ((unsigned)x[3] << 16); w.z = x[4] | ((unsigned)x[5] << 16); w.w = x[6] | ((unsigned)x[7] << 16);
            *(u32x4*)(dst + (size_t)d * 256 + m8) = w;
        }
    }
}

__device__ __forceinline__ float fast_tanh(float x) { return 1.0f - 2.0f * __builtin_amdgcn_rcpf(1.0f + __expf(2.0f * x)); }
__device__ __forceinline__ float fast_sigmoid(float x) { return __builtin_amdgcn_rcpf(1.0f + __expf(-x)); }
template <int MODE>
__device__ __forceinline__ bf16x8 mixfrag(const bf16_t* pu, const bf16_t* pp, float hpf, unsigned mub, int colc, int col) {
    const u32x4 u = *(const u32x4*)(pu + col), p = *(const u32x4*)(pp + col);
    const f32x4 m0 = *(const LAS f32x4*)(unsigned long long)(mub + (unsigned)colc * 4u), m1 = *(const LAS f32x4*)(unsigned long long)(mub + (unsigned)colc * 4u + 16u);
    float x[8];
#pragma unroll
    for (int j = 0; j < 4; ++j) {
        const float u0 = lo16(u[j]), u1 = hi16(u[j]), p0 = lo16(p[j]) * hpf, p1 = hi16(p[j]) * hpf;
        const float ma = (j < 2) ? m0[2 * j] : m1[2 * j - 4], mb = (j < 2) ? m0[2 * j + 1] : m1[2 * j - 3];
        x[2 * j] = u0 + ma * (p0 - u0); x[2 * j + 1] = u1 + mb * (p1 - u1);
    }
#pragma unroll
    for (int j = 0; j < 8; ++j) { if (MODE == 1) x[j] = fast_tanh(x[j]); if (MODE == 2) x[j] = fast_sigmoid(x[j]); }
    u32x4 w; w.x = pk2(x[0], x[1]); w.y = pk2(x[2], x[3]); w.z = pk2(x[4], x[5]); w.w = pk2(x[6], x[7]);
    return __builtin_bit_cast(bf16x8, w);
}
__device__ __forceinline__ void pb_prep(const PA a, int l, LAS unsigned char* lds, XcdBarrier& bar) {
    const int tid = otid(), wave = __builtin_amdgcn_readfirstlane(tid >> 6), lane0 = tid & 63, fr0 = lane0 & 15, fq0 = lane0 >> 4;
    const int G = ogrid(), blk = oblk();
    LAS bf16_t* s_w2 = (LAS bf16_t*)lds;
    LAS bf16_t* s_a2 = (LAS bf16_t*)(lds + 18432);
    LAS bf16_t* s_g2 = (LAS bf16_t*)(lds + 36864);
    LAS bf16_t* s_v2 = (LAS bf16_t*)(lds + 71680);
    LAS bf16_t* s_v1 = (LAS bf16_t*)(lds + 81920);
    LAS float* s_par = (LAS float*)(lds + 115200);
    LAS float* s_mux = s_par + 1152;
    bf16_t* proj = WSP(bf16_t, WS_PROJ);
    const float* mu = INP(4) + l * 1792;
    const float* w0 = INP(5) + l * 512;  const float* w2 = INP(6) + (size_t)l * 64 * 512;
    const float* a0 = INP(7) + l * 512;  const float* a2 = INP(8) + (size_t)l * 64 * 512;
    const float* g2 = INP(9) + (size_t)l * 128 * 512;
    const float* kkw = INP(10) + l * 512; const float* kaw = INP(11) + l * 512;
    const int lv = l > 0 ? l - 1 : 0;
    const float* v0 = INP(15) + lv * 512; const float* v1 = INP(16) + (size_t)lv * 512 * 32; const float* v2 = INP(17) + (size_t)lv * 32 * 512;
    const float* qgn = INP(18) + l * 64; const float* kgn = INP(19) + l * 64;
    bf16_t* SR = WSP(bf16_t, WS_SR); bf16_t* SK = WSP(bf16_t, WS_SK); bf16_t* SV = WSP(bf16_t, WS_SV);
    bf16_t* SA = WSP(bf16_t, WS_SA); bf16_t* SB = WSP(bf16_t, WS_SB); bf16_t* SG = WSP(bf16_t, WS_SG);
    bf16_t* SWD = WSP(bf16_t, WS_SWD); bf16_t* VF = WSP(bf16_t, WS_VF);
    int cur_hp = blk & 3;
    {
        const unsigned char* img = a.ws + WS_PBI + (size_t)(l * 4 + cur_hp) * PBI_BYTES;
        for (int p = tid; p < PBI_BYTES / 16; p += 512) *(LAS u32x4*)(lds + p * 16) = *(const u32x4*)(img + (size_t)p * 16);
        __syncthreads();
    }
    u32x4* LH = WSP(u32x4, WS_LH);
    for (int tt = blk; tt < T / 128; tt += G) {
        const int lane = otid() & 63, fr = lane & 15, fq = lane >> 4;
        const int t = tt * 128 + wave * 16 + fr;
        const bool hpv = (t & (SEQ - 1)) != 0;
        const bf16_t* pu = proj + (size_t)t * INW;
        const bf16_t* pp = hpv ? pu - INW : pu;
        const float hpf = hpv ? 1.0f : 0.0f;
        unsigned mub = (unsigned)(unsigned long long)s_mux - 4096u + (unsigned)(fq * 32); asm volatile("" : "+v"(mub));
        u32x4* dst = LH + ((size_t)(tt * 8 + wave) * 9) * 64 + lane;
#pragma unroll
        for (int s = 0; s < 2; ++s) { dst[s * 64] = __builtin_bit_cast(u32x4, mixfrag<1>(pu, pp, hpf, mub, 1536 + 32 * s, 1536 + 32 * s + 8 * fq)); dst[(2 + s) * 64] = __builtin_bit_cast(u32x4, mixfrag<0>(pu, pp, hpf, mub, 1600 + 32 * s, 1600 + 32 * s + 8 * fq)); }
#pragma unroll
        for (int s = 0; s < 4; ++s) dst[(4 + s) * 64] = __builtin_bit_cast(u32x4, mixfrag<2>(pu, pp, hpf, mub, 1664 + 32 * s, 1664 + 32 * s + 8 * fq));
        if (l > 0) {
            f32x4 c0 = {0.f, 0.f, 0.f, 0.f}, c1 = {0.f, 0.f, 0.f, 0.f};
#pragma unroll 8
            for (int s = 0; s < 16; ++s) {
                const bf16x8 xf = mixfrag<0>(pu, pp, hpf, mub, 1024 + 32 * s, 1024 + 32 * s + 8 * fq);
                const bf16x8 wa = *(const LAS bf16x8*)(s_v1 + fr * 520 + 32 * s + 8 * fq), wb = *(const LAS bf16x8*)(s_v1 + (16 + fr) * 520 + 32 * s + 8 * fq);
                c0 = __builtin_amdgcn_mfma_f32_16x16x32_bf16(wa, xf, c0, 0, 0, 0);
                c1 = __builtin_amdgcn_mfma_f32_16x16x32_bf16(wb, xf, c1, 0, 0, 0);
            }
            u32x4 w; w.x = pk2(c0[0], c0[1]); w.y = pk2(c0[2], c0[3]); w.z = pk2(c1[0], c1[1]); w.w = pk2(c1[2], c1[3]);
            dst[8 * 64] = w;
        }
    }
    if (!MK_PER_PHASE) xcd_barrier(bar);
    for (int item = blk; item < 4 * (T / 128); item += G) {
        const int hp = item & 3, tt = item >> 2;
        if (hp != cur_hp) {
            __syncthreads();
            const unsigned char* img = a.ws + WS_PBI + (size_t)(l * 4 + hp) * PBI_BYTES;
            for (int p = tid; p < PBI_BYTES / 16; p += 512) *(LAS u32x4*)(lds + p * 16) = *(const u32x4*)(img + (size_t)p * 16);
            __syncthreads();
            cur_hp = hp;
        }
        const int lane = otid() & 63, fr = lane & 15, fq = lane >> 4;
        const int t = tt * 128 + wave * 16 + fr;
        const bool hpv = (t & (SEQ - 1)) != 0;
        const bf16_t* pu = proj + (size_t)t * INW;
        const bf16_t* pp = hpv ? pu - INW : pu;
        const float hpf = hpv ? 1.0f : 0.0f;
        bf16x8 fwl[2], fal[2], fgl[4], ft32;
        {
            const u32x4* lh = LH + ((size_t)(tt * 8 + wave) * 9) * 64 + lane;
#pragma unroll
            for (int s = 0; s < 2; ++s) { fwl[s] = __builtin_bit_cast(bf16x8, lh[s * 64]); fal[s] = __builtin_bit_cast(bf16x8, lh[(2 + s) * 64]); }
#pragma unroll
            for (int s = 0; s < 4; ++s) fgl[s] = __builtin_bit_cast(bf16x8, lh[(4 + s) * 64]);
            ft32 = (l > 0) ? __builtin_bit_cast(bf16x8, lh[8 * 64]) : fwl[0];
        }
        {
#pragma unroll
            for (int n8 = 0; n8 < 8; ++n8) {
                f32x4 ag = {0.f, 0.f, 0.f, 0.f};
#pragma unroll
                for (int s = 0; s < 4; ++s) ag = __builtin_amdgcn_mfma_f32_16x16x32_bf16(*(const LAS bf16x8*)(s_g2 + (n8 * 16 + fr) * 136 + 32 * s + 8 * fq), fgl[s], ag, 0, 0, 0);
                u32x2 w; w.x = pk2(ag[0], ag[1]); w.y = pk2(ag[2], ag[3]); *(u32x2*)(SG + (size_t)t * 512 + hp * 128 + n8 * 16 + 4 * fq) = w;
            }
        }
#pragma unroll 1
        for (int hh = 0; hh < 2; ++hh) {
            float atu[4][4], btu[4][4];
            u32x2 hR[4], hK[4], hV[4];
            float kss = 0.f, bsum = 0.f;
            const int t0w = tt * 128 + wave * 16, hd = hp * 2 + hh;
            const int cid = ((t0w >> 11) * 8 + hd) * 128 + ((t0w & (SEQ - 1)) >> 4);
#define DPP1(x, ctrl) __int_as_float(__builtin_amdgcn_update_dpp(0x3f800000, __float_as_int(x), (ctrl), 0xF, 0xF, false))
            u32x2 Lur[4], Lpr[4], Luk[4], Lpk[4], Luv[4], Lpv[4], Lvf[4];
#pragma unroll
            for (int nt = 0; nt < 4; ++nt) {
                if ((nt & 1) == 0) {
#pragma unroll
                    for (int n2 = nt; n2 < nt + 2; ++n2) {
                        const int c4 = hp * 128 + hh * 64 + n2 * 16 + 4 * fq;
                        Lur[n2] = *(const u32x2*)(pu + c4); Lpr[n2] = *(const u32x2*)(pp + c4);
                        Luk[n2] = *(const u32x2*)(pu + 512 + c4); Lpk[n2] = *(const u32x2*)(pp + 512 + c4);
                        Luv[n2] = *(const u32x2*)(pu + 1024 + c4); Lpv[n2] = *(const u32x2*)(pp + 1024 + c4);
                        Lvf[n2] = (l > 0) ? *(const u32x2*)(VF + (size_t)t * 512 + c4) : (u32x2){0u, 0u};
                    }
                    __builtin_amdgcn_sched_barrier(0);
                }
                const int lc = hh * 64 + nt * 16, ch4 = hp * 128 + lc + 4 * fq;
                f32x4 aw = {0.f, 0.f, 0.f, 0.f}, aa = aw, az = aw;
#pragma unroll
                for (int s = 0; s < 2; ++s) {
                    aw = __builtin_amdgcn_mfma_f32_16x16x32_bf16(*(const LAS bf16x8*)(s_w2 + (lc + fr) * 72 + 32 * s + 8 * fq), fwl[s], aw, 0, 0, 0);
                    aa = __builtin_amdgcn_mfma_f32_16x16x32_bf16(*(const LAS bf16x8*)(s_a2 + (lc + fr) * 72 + 32 * s + 8 * fq), fal[s], aa, 0, 0, 0);
                }
                if (l > 0) {
                    const u32x2 q0 = *(const LAS u32x2*)(s_v2 + (lc + fr) * 40 + 4 * fq), q1 = *(const LAS u32x2*)(s_v2 + (lc + fr) * 40 + 16 + 4 * fq);
                    u32x4 w; w.x = q0.x; w.y = q0.y; w.z = q1.x; w.w = q1.y;
                    az = __builtin_amdgcn_mfma_f32_16x16x32_bf16(__builtin_bit_cast(bf16x8, w), ft32, az, 0, 0, 0);
                }
                const u32x2 ur = Lur[nt], pr = Lpr[nt], uk = Luk[nt], pk = Lpk[nt], uv = Luv[nt], pv = Lpv[nt];
                const int pc4 = lc + 4 * fq;
                const f32x4 mr = *(const LAS f32x4*)(s_par + pc4), mk = *(const LAS f32x4*)(s_par + 128 + pc4), mv = *(const LAS f32x4*)(s_par + 256 + pc4);
                const f32x4 w0v = *(const LAS f32x4*)(s_par + 384 + pc4), a0v = *(const LAS f32x4*)(s_par + 512 + pc4), kkwv = *(const LAS f32x4*)(s_par + 640 + pc4), kawv = *(const LAS f32x4*)(s_par + 768 + pc4);
                float xr[4], xk[4], xv[4];
                { const float u0 = lo16(ur.x), u1 = hi16(ur.x), u2 = lo16(ur.y), u3 = hi16(ur.y);
                  xr[0] = u0 + mr[0] * (lo16(pr.x) * hpf - u0); xr[1] = u1 + mr[1] * (hi16(pr.x) * hpf - u1); xr[2] = u2 + mr[2] * (lo16(pr.y) * hpf - u2); xr[3] = u3 + mr[3] * (hi16(pr.y) * hpf - u3); }
                { const float u0 = lo16(uk.x), u1 = hi16(uk.x), u2 = lo16(uk.y), u3 = hi16(uk.y);
                  xk[0] = u0 + mk[0] * (lo16(pk.x) * hpf - u0); xk[1] = u1 + mk[1] * (hi16(pk.x) * hpf - u1); xk[2] = u2 + mk[2] * (lo16(pk.y) * hpf - u2); xk[3] = u3 + mk[3] * (hi16(pk.y) * hpf - u3); }
                { const float u0 = lo16(uv.x), u1 = hi16(uv.x), u2 = lo16(uv.y), u3 = hi16(uv.y);
                  xv[0] = u0 + mv[0] * (lo16(pv.x) * hpf - u0); xv[1] = u1 + mv[1] * (hi16(pv.x) * hpf - u1); xv[2] = u2 + mv[2] * (lo16(pv.y) * hpf - u2); xv[3] = u3 + mv[3] * (hi16(pv.y) * hpf - u3); }
                const size_t o = (size_t)t * 512 + ch4;
                if (l > 0) {
                    const f32x4 v0v = *(const LAS f32x4*)(s_par + 896 + pc4);
                    const u32x2 vfw = Lvf[nt];
                    const float vf0 = lo16(vfw.x), vf1 = hi16(vfw.x), vf2 = lo16(vfw.y), vf3 = hi16(vfw.y);
                    xv[0] += (vf0 - xv[0]) * fast_sigmoid(v0v[0] + az[0]); xv[1] += (vf1 - xv[1]) * fast_sigmoid(v0v[1] + az[1]);
                    xv[2] += (vf2 - xv[2]) * fast_sigmoid(v0v[2] + az[2]); xv[3] += (vf3 - xv[3]) * fast_sigmoid(v0v[3] + az[3]);
                } else {
                    u32x2 w; w.x = pk2(xv[0], xv[1]); w.y = pk2(xv[2], xv[3]); *(u32x2*)(VF + o) = w;
                }
                const f32x4 rkv = *(const LAS f32x4*)(s_par + 1024 + pc4);
                float P[4], rt[4], kt[4];
#pragma unroll
                for (int j = 0; j < 4; ++j) {
                    const float dcl = 0.8750387749f * fast_sigmoid(w0v[j] + aw[j]);
                    const float av = fast_sigmoid(a0v[j] + aa[j]);
                    const float kk = xk[j] * kkwv[j];
                    const float kmod = xk[j] * (1.0f + (av - 1.0f) * kawv[j]);
                    kss += kk * kk; bsum += xr[j] * kmod * rkv[j];
                    float p = __builtin_amdgcn_exp2f(-dcl);
                    p *= DPP1(p, 0x111); p *= DPP1(p, 0x112); p *= DPP1(p, 0x114); p *= DPP1(p, 0x118);
                    const float pm = DPP1(p, 0x111);
                    const float ip = __builtin_amdgcn_rcpf(p);
                    P[j] = p; rt[j] = xr[j] * p; kt[j] = kmod * ip; atu[nt][j] = -kk * pm; btu[nt][j] = kk * av * ip;
                }
                hR[nt].x = pk2(rt[0], rt[1]); hR[nt].y = pk2(rt[2], rt[3]); hK[nt].x = pk2(kt[0], kt[1]); hK[nt].y = pk2(kt[2], kt[3]);
                hV[nt].x = pk2(xv[0], xv[1]); hV[nt].y = pk2(xv[2], xv[3]);
                if (fr == 15) *(f32x4*)(WSP(float, WS_PCK) + (size_t)cid * 64 + nt * 16 + 4 * fq) = (f32x4){P[0], P[1], P[2], P[3]};
            }
            kss += __shfl_xor(kss, 16); kss += __shfl_xor(kss, 32);
            bsum += __shfl_xor(bsum, 16); bsum += __shfl_xor(bsum, 32);
            const float rn = rsqrtf(fmaxf(kss, 1e-24f));
            if (fq == 0) WSP(float, WS_BS)[(size_t)t * 8 + hd] = bsum;
            bf16x8 fA[2], fR[2], fB[2], fK[2], fV[2];
#pragma unroll
            for (int s_ = 0; s_ < 2; ++s_) {
                u32x4 w;
                w.x = pk2(atu[2 * s_][0] * rn, atu[2 * s_][1] * rn); w.y = pk2(atu[2 * s_][2] * rn, atu[2 * s_][3] * rn); w.z = pk2(atu[2 * s_ + 1][0] * rn, atu[2 * s_ + 1][1] * rn); w.w = pk2(atu[2 * s_ + 1][2] * rn, atu[2 * s_ + 1][3] * rn);
                fA[s_] = __builtin_bit_cast(bf16x8, w);
                w.x = pk2(btu[2 * s_][0] * rn, btu[2 * s_][1] * rn); w.y = pk2(btu[2 * s_][2] * rn, btu[2 * s_][3] * rn); w.z = pk2(btu[2 * s_ + 1][0] * rn, btu[2 * s_ + 1][1] * rn); w.w = pk2(btu[2 * s_ + 1][2] * rn, btu[2 * s_ + 1][3] * rn);
                fB[s_] = __builtin_bit_cast(bf16x8, w);
                fR[s_] = __builtin_bit_cast(bf16x8, (u32x4){hR[2 * s_].x, hR[2 * s_].y, hR[2 * s_ + 1].x, hR[2 * s_ + 1].y});
                fK[s_] = __builtin_bit_cast(bf16x8, (u32x4){hK[2 * s_].x, hK[2 * s_].y, hK[2 * s_ + 1].x, hK[2 * s_ + 1].y});
                fV[s_] = __builtin_bit_cast(bf16x8, (u32x4){hV[2 * s_].x, hV[2 * s_].y, hV[2 * s_ + 1].x, hV[2 * s_ + 1].y});
            }
#undef DPP1
            {
                int frv = fr, fqv = fq, lanev = lane; asm volatile("" : "+v"(frv), "+v"(fqv), "+v"(lanev));
                const unsigned rowo = (unsigned)(frv * 1024);
                char* ua = (char*)(SA + ((size_t)t0w * 512 + hd * 64)); char* ur = (char*)(SR + ((size_t)t0w * 512 + hd * 64));
#pragma unroll
                for (int s_ = 0; s_ < 2; ++s_) { const unsigned co = rowo + (unsigned)((((4 * s_ + fqv) ^ (frv & 7))) * 16);
                    *(u32x4*)(ua + co) = __builtin_bit_cast(u32x4, fA[s_]); *(u32x4*)(ur + co) = __builtin_bit_cast(u32x4, fR[s_]); }
                const f32x4 z4 = {0.f, 0.f, 0.f, 0.f};
#define MF(a_, b_, c_) __builtin_amdgcn_mfma_f32_16x16x32_bf16((a_), (b_), (c_), 0, 0, 0)
                const f32x4 nka = MF(fA[1], fK[1], MF(fA[0], fK[0], z4));
                const f32x4 nbr = MF(fR[1], fB[1], MF(fR[0], fB[0], z4));
                const f32x4 nkr = MF(fR[1], fK[1], MF(fR[0], fK[0], z4));
                const f32x4 nba = MF(fB[1], fA[1], MF(fB[0], fA[0], z4));
                unsigned nbu = (unsigned)(unsigned long long)((LAS float*)(lds + PBI_BYTES) + wave * 256); asm volatile("" : "+v"(nbu));
                LAS float* nb = (LAS float*)(unsigned long long)nbu;
                bf16_t* gim = WSP(bf16_t, WS_NKA) + (size_t)cid * 1024;
                const int ncol = (frv >> 2) * 8 + (frv & 3);
#pragma unroll
                for (int j = 0; j < 4; ++j) {
                    const int row = 4 * fqv + j;
                    gim[row * 32 + ncol + 4] = f2bf(frv < row ? nka[j] : 0.f);
                    gim[512 + row * 32 + ncol] = f2bf(frv <= row ? nbr[j] : 0.f);
                    gim[512 + row * 32 + ncol + 4] = f2bf(frv <= row ? nkr[j] : 0.f);
                    nb[row * 16 + frv] = (row < frv) ? nba[j] : 0.f;
                }
                const unsigned idv = (fqv == (frv >> 2)) ? (0x3f80u << (16 * (frv & 1))) : 0u;
                u32x4 idA = {0u, 0u, 0u, 0u}, idB = {0u, 0u, 0u, 0u};
                if ((frv & 3) < 2) { idA.x = idv; idB.z = idv; } else { idA.y = idv; idB.w = idv; }
                char* ubk = (char*)(WSP(bf16_t, WS_BTT) + (size_t)cid * 2048); char* uvs = (char*)(WSP(bf16_t, WS_VST) + (size_t)cid * 1024);
                const unsigned bko = (unsigned)(frv * 64 + fqv * 16), vso = (unsigned)(frv * 32 + fqv * 8);
#pragma unroll
                for (int n_ = 0; n_ < 4; ++n_) {
                    const bf16x8 idf = __builtin_bit_cast(bf16x8, (n_ & 1) ? idB : idA);
                    const f32x4 bT = MF(fB[n_ >> 1], idf, z4), kT = MF(fK[n_ >> 1], idf, z4), vT = MF(fV[n_ >> 1], idf, z4);
                    *(u32x4*)(ubk + n_ * 1024 + bko) = (u32x4){pk2(bT[0], bT[1]), pk2(bT[2], bT[3]), pk2(kT[0], kT[1]), pk2(kT[2], kT[3])};
                    *(u32x2*)(uvs + n_ * 512 + vso) = (u32x2){pk2(vT[0], vT[1]), pk2(vT[2], vT[3])};
                }
#undef MF
                if (lanev < 16) {
                    float X[16];
                    const int tcolp = (lanev >> 2) * 8 + (lanev & 3);
#pragma unroll
                    for (int tcol = 0; tcol < 16; ++tcol) {
                        float acc = (lanev == tcol) ? 1.0f : 0.0f;
#pragma unroll
                        for (int i = 0; i < tcol; ++i) acc += X[i] * nb[i * 16 + tcol];
                        X[tcol] = acc;
                        gim[tcol * 32 + tcolp] = f2bf(acc);
                    }
                }
            }
        }
    }
    __syncthreads();
}

__device__ __forceinline__ void pb2_chunks(const PA a, int l, LAS unsigned char* lds) {
    const int tid = otid(), wave = tid >> 6, lane = tid & 63, fr = lane & 15, fq = lane >> 4;
    LAS bf16_t* sA = (LAS bf16_t*)(lds + wave * 11520);
    LAS bf16_t* sR = sA + 1152; LAS bf16_t* sB = sR + 1152; LAS bf16_t* sK = sB + 1152; LAS bf16_t* sX = sK + 1152;
    LAS float* nb = (LAS float*)(lds + 8 * 11520) + wave * 256;
    bf16_t* SR = WSP(bf16_t, WS_SR); bf16_t* SK = WSP(bf16_t, WS_SK); bf16_t* SV = WSP(bf16_t, WS_SV);
    bf16_t* SA = WSP(bf16_t, WS_SA); bf16_t* SB = WSP(bf16_t, WS_SB); const bf16_t* SWD = WSP(const bf16_t, WS_SWD);
    const float* rkp = INP(12) + l * 512;
    for (int cid = oblk() * 8 + wave; cid < NCHUNK; cid += ogrid() * 8) {
        const int b = cid >> 10, h = (cid >> 7) & 7, c = cid & 127;
        const size_t tok0 = (size_t)b * SEQ + c * 16;
        const size_t e0 = tok0 * 512 + h * 64 + lane;
        const float rkv = rkp[h * 64 + lane];
        const int posl = (lane & 32) | (((lane & 15) >> 2) << 3) | (((lane >> 4) & 1) << 2) | (lane & 3);
        float P = 1.0f;
        unsigned bt2[8], kt2[8], vt2[8];
#pragma unroll
        for (int hf = 0; hf < 2; ++hf) {
            bf16_t r16[8], k16[8], a16[8], b16[8], v16[8]; float w32[8];
#pragma unroll
            for (int t8 = 0; t8 < 8; ++t8) { const size_t e = e0 + (size_t)(hf * 8 + t8) * 512; r16[t8] = SR[e]; k16[t8] = SK[e]; a16[t8] = SA[e]; b16[t8] = SB[e]; v16[t8] = SV[e]; w32[t8] = __builtin_amdgcn_exp2f(-bf2f(SWD[e])); }
#pragma unroll
            for (int t8 = 0; t8 < 8; ++t8) {
                const int t = hf * 8 + t8;
                const float rr = bf2f(r16[t8]), kk = bf2f(k16[t8]), aa = bf2f(a16[t8]), bb = bf2f(b16[t8]);
                const float Pm = P; P *= w32[t8]; const float ip = 1.0f / P;
                const unsigned ar = pk2(aa * Pm, rr * P), bk = pk2(bb * ip, kk * ip);
                const bf16_t at = (bf16_t)(ar & 0xffffu), rt = (bf16_t)(ar >> 16), btv = (bf16_t)(bk & 0xffffu), ktv = (bf16_t)(bk >> 16);
                { const size_t es = tok0 * 512 + (size_t)t * 512 + h * 64 + (posl ^ ((t & 7) << 3)); SA[es] = at; SR[es] = rt; }
                sA[t * 72 + lane] = at; sR[t * 72 + lane] = rt; sB[t * 72 + lane] = btv; sK[t * 72 + lane] = ktv;
                sX[t * 72 + lane] = (bf16_t)(pk2(rr * kk * rkv, 0.f) & 0xffffu);
                if (t & 1) { bt2[t >> 1] |= (unsigned)btv << 16; kt2[t >> 1] |= (unsigned)ktv << 16; vt2[t >> 1] |= (unsigned)v16[t8] << 16; }
                else       { bt2[t >> 1] = btv; kt2[t >> 1] = ktv; vt2[t >> 1] = v16[t8]; }
            }
        }
        WSP(float, WS_PCK)[(size_t)cid * 64 + lane] = P;
        {
            u32x4* pb_ = (u32x4*)(WSP(bf16_t, WS_BTT) + (size_t)cid * 2048 + lane * 32);
            u32x4* pv_ = (u32x4*)(WSP(bf16_t, WS_VST) + (size_t)cid * 1024 + lane * 16);
#pragma unroll
            for (int q = 0; q < 4; ++q) pb_[q] = (u32x4){bt2[2 * q], bt2[2 * q + 1], kt2[2 * q], kt2[2 * q + 1]};
            pv_[0] = (u32x4){vt2[0], vt2[1], vt2[2], vt2[3]}; pv_[1] = (u32x4){vt2[4], vt2[5], vt2[6], vt2[7]};
        }
        bf16x8 fA[2], fR[2], fB[2], fK[2], fX[2];
#pragma unroll
        for (int s_ = 0; s_ < 2; ++s_) {
            fA[s_] = *(const LAS bf16x8*)(sA + fr * 72 + 32 * s_ + 8 * fq); fR[s_] = *(const LAS bf16x8*)(sR + fr * 72 + 32 * s_ + 8 * fq);
            fB[s_] = *(const LAS bf16x8*)(sB + fr * 72 + 32 * s_ + 8 * fq); fK[s_] = *(const LAS bf16x8*)(sK + fr * 72 + 32 * s_ + 8 * fq);
            fX[s_] = *(const LAS bf16x8*)(sX + fr * 72 + 32 * s_ + 8 * fq);
        }
        const f32x4 z4 = {0.f, 0.f, 0.f, 0.f};
        const bf16x8 ones = {0x3f80, 0x3f80, 0x3f80, 0x3f80, 0x3f80, 0x3f80, 0x3f80, 0x3f80};
        const f32x4 nka = __builtin_amdgcn_mfma_f32_16x16x32_bf16(fA[1], fK[1], __builtin_amdgcn_mfma_f32_16x16x32_bf16(fA[0], fK[0], z4, 0, 0, 0), 0, 0, 0);
        const f32x4 nbr = __builtin_amdgcn_mfma_f32_16x16x32_bf16(fR[1], fB[1], __builtin_amdgcn_mfma_f32_16x16x32_bf16(fR[0], fB[0], z4, 0, 0, 0), 0, 0, 0);
        const f32x4 nkr = __builtin_amdgcn_mfma_f32_16x16x32_bf16(fR[1], fK[1], __builtin_amdgcn_mfma_f32_16x16x32_bf16(fR[0], fK[0], z4, 0, 0, 0), 0, 0, 0);
        const f32x4 nba = __builtin_amdgcn_mfma_f32_16x16x32_bf16(fB[1], fA[1], __builtin_amdgcn_mfma_f32_16x16x32_bf16(fB[0], fA[0], z4, 0, 0, 0), 0, 0, 0);
        const f32x4 bsm = __builtin_amdgcn_mfma_f32_16x16x32_bf16(fX[1], ones, __builtin_amdgcn_mfma_f32_16x16x32_bf16(fX[0], ones, z4, 0, 0, 0), 0, 0, 0);
        bf16_t* gim = WSP(bf16_t, WS_NKA) + (size_t)cid * 1024;
        const int ncol = (fr >> 2) * 8 + (fr & 3);
#pragma unroll
        for (int j = 0; j < 4; ++j) {
            const int row = 4 * fq + j;
            gim[row * 32 + ncol + 4] = f2bf(fr < row ? nka[j] : 0.f);
            gim[512 + row * 32 + ncol] = f2bf(fr <= row ? nbr[j] : 0.f);
            gim[512 + row * 32 + ncol + 4] = f2bf(fr <= row ? nkr[j] : 0.f);
            nb[row * 16 + fr] = (row < fr) ? nba[j] : 0.f;
            if (fr == 0) WSP(float, WS_BS)[(tok0 + row) * 8 + h] = bsm[j];
        }
        if (lane < 16) {
            float X[16];
            bf16_t* gtm = WSP(bf16_t, WS_NKA) + (size_t)cid * 1024; const int tcolp = (lane >> 2) * 8 + (lane & 3);
#pragma unroll
            for (int tcol = 0; tcol < 16; ++tcol) {
                float acc = (lane == tcol) ? 1.0f : 0.0f;
#pragma unroll
                for (int i = 0; i < tcol; ++i) acc += X[i] * nb[i * 16 + tcol];
                X[tcol] = acc;
                gtm[tcol * 32 + tcolp] = f2bf(acc);
            }
        }
    }
    __syncthreads();
}

__device__ __forceinline__ void scan_item(const PA a, int l, int bh, LAS unsigned char* lds) {
    const int tid = otid(), wave = __builtin_amdgcn_readfirstlane(tid >> 6), lane = tid & 63, fr = lane & 15, fq = lane >> 4;
    const int b = __builtin_amdgcn_readfirstlane(bh >> 3), h = __builtin_amdgcn_readfirstlane(bh & 7);
    constexpr int SLOT = 15104, NS = 8, DPF = 6;
    constexpr int OA = 0, OR_ = 2048, OBK = 4096, OVT = 8192, ON = 10240, OPC = 12288, OBS = 12544, OSG = 13056;
    constexpr int YBO = NS * SLOT;
    const size_t tokb = (size_t)b * SEQ;
    const int cid0 = (b * 8 + h) * 128;
    const unsigned char* gA = (const unsigned char*)WSP(const bf16_t, WS_SA); const unsigned char* gR = (const unsigned char*)WSP(const bf16_t, WS_SR);
    const unsigned char* gG = (const unsigned char*)WSP(const bf16_t, WS_SG);
    const unsigned char* gBK = (const unsigned char*)WSP(const bf16_t, WS_BTT);
    const unsigned char* gVT = (const unsigned char*)WSP(const bf16_t, WS_VST); const unsigned char* gN = (const unsigned char*)WSP(const bf16_t, WS_NKA);
    const unsigned char* gPC = (const unsigned char*)WSP(const float, WS_PCK); const unsigned char* gBS = (const unsigned char*)WSP(const float, WS_BS);
#define DMA16(gp, ldsoff) __builtin_amdgcn_global_load_lds((const unsigned*)(gp), (LAS unsigned*)(lds + (ldsoff)), 16, 0, 0)
    const unsigned rowoff0 = (unsigned)(((lane >> 3) * 512 + (lane & 7) * 8) * 2), rowoff1 = rowoff0 + 8u * 512u * 2u;
#define DMA_CHUNK(c_) do { const int cid_ = cid0 + (c_); const int so_ = ((c_) % NS) * SLOT; \
        const size_t rb_ = ((tokb + (size_t)(c_) * 16) * 512 + h * 64) * 2; \
        if (wave == 4) { \
            DMA16(gA + rb_ + rowoff0, so_ + OA); DMA16(gA + rb_ + rowoff1, so_ + OA + 1024); DMA16(gR + rb_ + rowoff0, so_ + OR_); DMA16(gR + rb_ + rowoff1, so_ + OR_ + 1024); \
            DMA16(gBK + (size_t)cid_ * 4096 + lane * 16, so_ + OBK); DMA16(gBK + (size_t)cid_ * 4096 + 1024 + lane * 16, so_ + OBK + 1024); \
            DMA16(gBK + (size_t)cid_ * 4096 + 2048 + lane * 16, so_ + OBK + 2048); DMA16(gBK + (size_t)cid_ * 4096 + 3072 + lane * 16, so_ + OBK + 3072); \
            if (lane < 16) DMA16(gPC + (size_t)cid_ * 256 + lane * 16, so_ + OPC); \
        } else { \
            DMA16(gVT + (size_t)cid_ * 2048 + lane * 16, so_ + OVT); DMA16(gVT + (size_t)cid_ * 2048 + 1024 + lane * 16, so_ + OVT + 1024); \
            DMA16(gN + (size_t)cid_ * 2048 + lane * 16, so_ + ON); DMA16(gN + (size_t)cid_ * 2048 + 1024 + lane * 16, so_ + ON + 1024); \
            DMA16(gG + rb_ + rowoff0, so_ + OSG); DMA16(gG + rb_ + rowoff1, so_ + OSG + 1024); \
            if (lane < 32) DMA16(gBS + (tokb + (size_t)(c_) * 16) * 32 + lane * 16, so_ + OBS); \
            if (lane < 1) DMA16(gPC + (size_t)cid_ * 256, so_ + OPC); if (lane < 1) DMA16(gPC + (size_t)cid_ * 256, so_ + OPC); \
        } } while (0)
#define MF(a_, b_, c_) __builtin_amdgcn_mfma_f32_16x16x32_bf16((a_), (b_), (c_), 0, 0, 0)
#define LDF(off_) (*(const LAS bf16x8*)(sl + (off_)))
    const int swz = fr & 7;
    const int aoff0 = fr * 128 + ((fq) ^ swz) * 16, aoff1 = fr * 128 + ((4 + fq) ^ swz) * 16;
    const int noff = fr * 64 + fq * 16, voff = ((wave & 3) * 16 + fr) * 32 + 8 * fq;
    const float lw = INP(13)[l * 512 + h * 64 + lane], lb = INP(14)[l * 512 + h * 64 + lane];
    bf16_t* YC = WSP(bf16_t, WS_YCAT);
#define SCAN_EPI(cp_) do { const int cp = (cp_); \
        const unsigned slb = (unsigned)(unsigned long long)(lds + (cp % NS) * SLOT), ybb = (unsigned)(unsigned long long)(lds + YBO + (cp & 1) * 4352); \
          \
        f32x4 y0, y1, y2, y3; { const unsigned ya = ybb + fr * 272 + fq * 32; \
            asm volatile("ds_read_b128 %0, %4\n\tds_read_b128 %1, %4 offset:16\n\tds_read_b128 %2, %4 offset:128\n\tds_read_b128 %3, %4 offset:144\n\ts_waitcnt lgkmcnt(0)" \
                         : "=&v"(y0), "=&v"(y1), "=&v"(y2), "=&v"(y3) : "v"(ya) : "memory"); } \
        u32x4 f0, f1, g0, g1; \
        f0.x = pk2(y0[0], y0[1]); f0.y = pk2(y0[2], y0[3]); f0.z = pk2(y1[0], y1[1]); f0.w = pk2(y1[2], y1[3]); f1.x = pk2(y2[0], y2[1]); f1.y = pk2(y2[2], y2[3]); f1.z = pk2(y3[0], y3[1]); f1.w = pk2(y3[2], y3[3]); \
        g0.x = pk2(y0[0] * y0[0], y0[1] * y0[1]); g0.y = pk2(y0[2] * y0[2], y0[3] * y0[3]); g0.z = pk2(y1[0] * y1[0], y1[1] * y1[1]); g0.w = pk2(y1[2] * y1[2], y1[3] * y1[3]); \
        g1.x = pk2(y2[0] * y2[0], y2[1] * y2[1]); g1.y = pk2(y2[2] * y2[2], y2[3] * y2[3]); g1.z = pk2(y3[0] * y3[0], y3[1] * y3[1]); g1.w = pk2(y3[2] * y3[2], y3[3] * y3[3]); \
        const bf16x8 ones = {0x3f80, 0x3f80, 0x3f80, 0x3f80, 0x3f80, 0x3f80, 0x3f80, 0x3f80}; const f32x4 z4 = {0.f, 0.f, 0.f, 0.f}; \
        const f32x4 ssum = MF(__builtin_bit_cast(bf16x8, f1), ones, MF(__builtin_bit_cast(bf16x8, f0), ones, z4));        \
        const f32x4 sqsm = MF(__builtin_bit_cast(bf16x8, g1), ones, MF(__builtin_bit_cast(bf16x8, g0), ones, z4)); \
          \
        f32x4 rs4, mr4; \
        _Pragma("unroll") for (int j = 0; j < 4; ++j) { const float mean = ssum[j] * (1.0f / 64.0f); const float var = fmaxf(sqsm[j] * (1.0f / 64.0f) - mean * mean, 0.f); \
            rs4[j] = rsqrtf(var + 64e-5f); mr4[j] = -mean * rs4[j]; } \
        float eY[8], eB[8]; unsigned eV[8], eG[8]; \
        _Pragma("unroll") for (int i = 0; i < 8; ++i) { const int t = (wave - 6) * 8 + i; \
            const unsigned ay_ = ybb + (t * 68 + lane) * 4, ab_ = slb + OBS + t * 32 + h * 4, av_ = slb + OVT + lane * 32 + t * 2, ag_ = slb + OSG + t * 128 + lane * 2; \
            asm volatile("ds_read_b32 %0, %4\n\tds_read_b32 %1, %5\n\tds_read_u16 %2, %6\n\tds_read_u16 %3, %7" \
                         : "=&v"(eY[i]), "=&v"(eB[i]), "=&v"(eV[i]), "=&v"(eG[i]) : "v"(ay_), "v"(ab_), "v"(av_), "v"(ag_) : "memory"); } \
        asm volatile("s_waitcnt lgkmcnt(0)" ::: "memory"); \
        bf16_t* yrow = YC + (tokb + (size_t)cp * 16 + (wave - 6) * 8) * 1024 + h * 64;       \
        _Pragma("unroll") for (int i = 0; i < 8; ++i) { \
            asm volatile("" : "+v"(eY[i]), "+v"(eB[i]), "+v"(eV[i]), "+v"(eG[i])); \
            const int sl_ = ((wave - 6) * 2 + (i >> 2)) * 16; \
            const float rstd = __int_as_float(__builtin_amdgcn_readlane(__float_as_int(rs4[i & 3]), sl_)); \
            const float nmr = __int_as_float(__builtin_amdgcn_readlane(__float_as_int(mr4[i & 3]), sl_)); \
            const float vv = __uint_as_float(eV[i] << 16), g = __uint_as_float(eG[i] << 16); \
            const float o_ = (eY[i] * (rstd * lw) + (nmr * lw + lb) + eB[i] * vv) * g; \
            *(bf16_t*)((char*)(yrow + (size_t)i * 1024) + (unsigned)(lane * 2)) = (bf16_t)(pk2(o_, 0.f) & 0xffffu); } } while (0)
    f32x4 S[4];
#pragma unroll
    for (int kt = 0; kt < 4; ++kt) S[kt] = (f32x4){0.f, 0.f, 0.f, 0.f};
    __syncthreads();
    if (wave == 4 || wave == 5) {
#pragma unroll 1
        for (int c = 0; c < DPF; ++c) DMA_CHUNK(c);
        asm volatile("s_waitcnt vmcnt(0)" ::: "memory");
    }
    __syncthreads();
#pragma unroll 1
    for (int c = 0; c < 128; ++c) {
        if (wave < 4) {
            const LAS unsigned char* sl = lds + (c % NS) * SLOT;
            u32x4 s0w, s1w; s0w.x = pk2(S[0][0], S[0][1]); s0w.y = pk2(S[0][2], S[0][3]); s0w.z = pk2(S[1][0], S[1][1]); s0w.w = pk2(S[1][2], S[1][3]);
            s1w.x = pk2(S[2][0], S[2][1]); s1w.y = pk2(S[2][2], S[2][3]); s1w.z = pk2(S[3][0], S[3][1]); s1w.w = pk2(S[3][2], S[3][3]);
            const bf16x8 Sf0 = __builtin_bit_cast(bf16x8, s0w), Sf1 = __builtin_bit_cast(bf16x8, s1w);
            const u32x2 vm = *(const LAS u32x2*)(sl + OVT + voff);
            const bf16x8 TN = LDF(ON + noff), BN = LDF(ON + 1024 + noff);
            const f32x4 z4 = {0.f, 0.f, 0.f, 0.f};
            const bf16x8 ZV = __builtin_bit_cast(bf16x8, (u32x4){0u, 0u, vm.x, vm.y});
            f32x4 Wt = MF(LDF(OA + aoff0), Sf0, z4); Wt = MF(LDF(OA + aoff1), Sf1, Wt); Wt = MF(TN, ZV, Wt);
            const bf16x8 WZ = __builtin_bit_cast(bf16x8, (u32x4){pk2(Wt[0], Wt[1]), pk2(Wt[2], Wt[3]), 0u, 0u});
            const f32x4 Ut = MF(TN, WZ, z4);
            const bf16x8 UV = __builtin_bit_cast(bf16x8, (u32x4){pk2(Ut[0], Ut[1]), pk2(Ut[2], Ut[3]), vm.x, vm.y});
            f32x4 Yt = MF(LDF(OR_ + aoff0), Sf0, z4); Yt = MF(LDF(OR_ + aoff1), Sf1, Yt); Yt = MF(BN, UV, Yt);
#pragma unroll
            for (int kt = 0; kt < 4; ++kt) {
                const f32x4 pc = *(const LAS f32x4*)(sl + OPC + (kt * 16 + 4 * fq) * 4);
                S[kt] = MF(LDF(OBK + kt * 1024 + noff), UV, S[kt]) * pc;
            }
            LAS float* yb = (LAS float*)(lds + YBO + (c & 1) * 4352) + (wave & 3) * 16 + fr;
#pragma unroll
            for (int j = 0; j < 4; ++j) yb[(4 * fq + j) * 68] = Yt[j];
            asm volatile("s_waitcnt lgkmcnt(0)" ::: "memory");
        } else if (wave < 6) {
            if (c + DPF < 128) DMA_CHUNK(c + DPF);
            if (c >= DPF && c + DPF < 128) asm volatile("s_waitcnt vmcnt(45)" ::: "memory"); else asm volatile("s_waitcnt vmcnt(0)" ::: "memory");
        } else if (c > 0) {
            SCAN_EPI(c - 1);
        }
        asm volatile("" ::: "memory"); __builtin_amdgcn_s_barrier(); asm volatile("" ::: "memory");
    }
    if (wave >= 6) { SCAN_EPI(127); }
    asm volatile("s_waitcnt vmcnt(0)" ::: "memory");
    __syncthreads();
#undef SCAN_EPI
#undef DMA16
#undef DMA_CHUNK
#undef MF
#undef LDF
}

__device__ __forceinline__ void attn_item(const PA a, int l, int it, LAS unsigned char* lds) {
    const int tid = otid(), h = __builtin_amdgcn_readfirstlane(tid >> 6), lane = tid & 63, fr = lane & 15, fq = lane >> 4;
    const int b = it >> 5, c = it & 31;
    LAS float* s_bias = (LAS float*)(lds + LDS_MISC + 1024);
    LAS float* s_part = s_bias + 8 * 320;
    LAS float* tb = (LAS float*)lds + h * 1600;
    __syncthreads();
    for (int e = lane; e < 1600; e += 64) { const int r = e / 400, y = e - r * 400; int idx = 383 - (y + r); idx = idx > 319 ? 319 : (idx < 0 ? 0 : idx); tb[e] = s_bias[h * 320 + idx]; }
    const bf16_t* proj = WSP(const bf16_t, WS_PROJ);
    const bf16_t* VT = WSP(const bf16_t, WS_VT) + (size_t)(b * 8 + h) * 64 * 2048;
    const size_t tq0 = (size_t)b * SEQ + c * 64;
    bf16x8 qf[4][2];
#pragma unroll
    for (int nt = 0; nt < 4; ++nt)
#pragma unroll
        for (int ks = 0; ks < 2; ++ks) qf[nt][ks] = *(const bf16x8*)(proj + (tq0 + nt * 16 + fr) * INW + 1792 + h * 64 + 32 * ks + 8 * fq);
    f32x4 o[5][4];
#pragma unroll
    for (int dt = 0; dt < 5; ++dt)
#pragma unroll
        for (int nt = 0; nt < 4; ++nt) o[dt][nt] = (f32x4){0.f, 0.f, 0.f, 0.f};
    const int kc0 = c - 8 > 0 ? c - 8 : 0;
    const int nsteps = (c - kc0 + 1) * 2;
    const bf16x8 ones = {0x3f80, 0x3f80, 0x3f80, 0x3f80, 0x3f80, 0x3f80, 0x3f80, 0x3f80};
    const int rr = (4 - (fr & 3)) & 3;
    const unsigned tbl = (unsigned)(unsigned long long)(tb + rr * 400) + (unsigned)((320 - fr + 4 * fq - rr - 48) * 4);
    const char* kbase = (const char*)(WSP(const bf16_t, WS_KFR) + ((size_t)(b * 8 + h) * 128 + kc0 * 4) * 1024);
    const char* vbase = (const char*)(VT + (size_t)kc0 * 2 * 2048);
    const unsigned loff = (unsigned)(lane * 16);
    bf16x8 kfA[2][2], kfB[2][2]; u32x4 vfA[4], vfB[4];
#define ATT_LOAD(KF, VF, st) do { unsigned lo_ = loff; asm volatile("" : "+v"(lo_)); \
        const char* kp_ = kbase + (size_t)(st) * 4096; const char* vp_ = vbase + (size_t)(st) * 4096; \
        _Pragma("unroll") for (int mt = 0; mt < 2; ++mt) _Pragma("unroll") for (int ks = 0; ks < 2; ++ks) \
            KF[mt][ks] = *(const bf16x8*)(kp_ + (mt * 2 + ks) * 1024 + lo_); \
        _Pragma("unroll") for (int dt = 0; dt < 4; ++dt) VF[dt] = *(const u32x4*)(vp_ + dt * 1024 + lo_); } while (0)
#define MF(a_, b_, c_) __builtin_amdgcn_mfma_f32_16x16x32_bf16((a_), (b_), (c_), 0, 0, 0)
#define ATT_STEP(KF, VF, st) do { \
        f32x4 sacc[2][4]; const f32x4 z4 = {0.f, 0.f, 0.f, 0.f}; \
        _Pragma("unroll") for (int mt = 0; mt < 2; ++mt) _Pragma("unroll") for (int nt = 0; nt < 4; ++nt) sacc[mt][nt] = MF(KF[mt][1], qf[nt][1], MF(KF[mt][0], qf[nt][0], z4)); \
        const int dk = c - (kc0 + ((st) >> 1)), half = (st) & 1; \
        if (dk >= 5) { const float bc = s_bias[h * 320 + 319]; \
            _Pragma("unroll") for (int mt = 0; mt < 2; ++mt) _Pragma("unroll") for (int nt = 0; nt < 4; ++nt) sacc[mt][nt] += bc; \
        } else { \
            const unsigned ta = tbl + (unsigned)((32 * half - 64 * dk + 256) * 4); f32x4 bv[5]; \
            _Pragma("unroll") for (int dd = 0; dd < 5; ++dd) bv[dd] = *(const LAS f32x4*)(unsigned long long)(ta - 1024u + (unsigned)((3 - (dd - 1)) * 64)); \
            _Pragma("unroll") for (int mt = 0; mt < 2; ++mt) _Pragma("unroll") for (int nt = 0; nt < 4; ++nt) sacc[mt][nt] += bv[nt - mt + 1]; } \
        bf16x8 pf[4]; \
        _Pragma("unroll") for (int nt = 0; nt < 4; ++nt) { \
            u32x4 w; w.x = pk2(__builtin_amdgcn_exp2f(sacc[0][nt][0]), __builtin_amdgcn_exp2f(sacc[0][nt][1])); w.y = pk2(__builtin_amdgcn_exp2f(sacc[0][nt][2]), __builtin_amdgcn_exp2f(sacc[0][nt][3])); \
            w.z = pk2(__builtin_amdgcn_exp2f(sacc[1][nt][0]), __builtin_amdgcn_exp2f(sacc[1][nt][1])); w.w = pk2(__builtin_amdgcn_exp2f(sacc[1][nt][2]), __builtin_amdgcn_exp2f(sacc[1][nt][3])); \
            pf[nt] = __builtin_bit_cast(bf16x8, w); } \
        _Pragma("unroll") for (int nt = 0; nt < 4; ++nt) { \
            _Pragma("unroll") for (int dt = 0; dt < 4; ++dt) o[dt][nt] = MF(__builtin_bit_cast(bf16x8, VF[dt]), pf[nt], o[dt][nt]); \
            o[4][nt] = MF(ones, pf[nt], o[4][nt]); } } while (0)
    ATT_LOAD(kfA, vfA, 0);
    __syncthreads();
#pragma unroll 1
    for (int st = 0; st < nsteps; st += 2) {
        ATT_LOAD(kfB, vfB, st + 1);
        ATT_STEP(kfA, vfA, st);
        if (st + 2 < nsteps) ATT_LOAD(kfA, vfA, st + 2);
        ATT_STEP(kfB, vfB, st + 1);
    }
#undef ATT_LOAD
#undef ATT_STEP
#undef MF
#pragma unroll
    for (int nt = 0; nt < 4; ++nt) {
        const float inv = 1.0f / o[4][nt][0];
        float sq = 0.f;
#pragma unroll
        for (int dt = 0; dt < 4; ++dt) { o[dt][nt] *= inv; sq += (o[dt][nt][0] * o[dt][nt][0] + o[dt][nt][1] * o[dt][nt][1]) + (o[dt][nt][2] * o[dt][nt][2] + o[dt][nt][3] * o[dt][nt][3]); }
        sq += __shfl_xor(sq, 16); sq += __shfl_xor(sq, 32);
        if (fq == 0) s_part[h * 64 + nt * 16 + fr] = sq;
    }
    __syncthreads();
#pragma unroll
    for (int nt = 0; nt < 4; ++nt) {
        float tot = 0.f;
#pragma unroll
        for (int hh = 0; hh < 8; ++hh) tot += s_part[hh * 64 + nt * 16 + fr];
        const float rinv = rsqrtf(tot * (1.0f / 512.0f) + 1e-6f);
        bf16_t* yp = WSP(bf16_t, WS_YCAT) + (tq0 + nt * 16 + fr) * 1024 + 512 + h * 64 + 4 * fq;
#pragma unroll
        for (int dt = 0; dt < 4; ++dt) { u32x2 w; w.x = pk2(o[dt][nt][0] * rinv, o[dt][nt][1] * rinv); w.y = pk2(o[dt][nt][2] * rinv, o[dt][nt][3] * rinv); *(u32x2*)(yp + dt * 16) = w; }
    }
    __syncthreads();
}

__device__ __forceinline__ void pc_mixer(const PA a, int l, LAS unsigned char* lds) {
    const int tid = otid();
    LAS float* s_bias = (LAS float*)(lds + LDS_MISC + 1024);
    volatile LAS int* s_item = (volatile LAS int*)(lds + LDS_MISC + 64);
    for (int i = tid; i < 8 * 320; i += 512) s_bias[i] = INP(20)[l * 8 * 320 + i] * 1.4426950408889634f;
    unsigned* qhead = WSP(unsigned, WS_CTL) + CW_QUEUE + l * 64;
    for (;;) {
        __syncthreads();
        if (tid == 0) *s_item = (int)__hip_atomic_fetch_add(qhead, 1u, __ATOMIC_RELAXED, __HIP_MEMORY_SCOPE_AGENT);
        __syncthreads();
        const int item = __builtin_amdgcn_readfirstlane(*s_item);
        if (item >= 128 + 512 + MOE_CONV_ITEMS) break;
        if (item < 128) scan_item(a, l, item, lds);
        else if (item < 128 + 512) attn_item(a, l, item - 128, lds);
        else moe_convert_item(a, l, lds, item - 640);
    }
}

__device__ __forceinline__ void pe2_xattn(const PA a, int l, LAS unsigned char* lds) {
    const int tid = otid(), wave = tid >> 6, lane = tid & 63, fr = lane & 15, fq = lane >> 4;
    LAS bf16_t* sK = (LAS bf16_t*)lds;
    LAS bf16_t* sV = (LAS bf16_t*)(lds + 69632);
    const bf16_t* QX = WSP(const bf16_t, WS_QX); bf16_t* OX = WSP(bf16_t, WS_OX);
    const bf16_t* KV = WSP(const bf16_t, WS_KV) + (size_t)l * MROWS * 1024;
    const bf16_t* VTX = WSP(const bf16_t, WS_VTX) + (size_t)l * MROWS * 512;
    const float* qgn = INP(28) + l * 128;
    for (int it = oblk(); it < 256; it += ogrid()) {
        const int b = it >> 4, h = (it >> 2) & 3, qr = it & 3;
        __syncthreads();
        {
            u32x4 tk[8], tv[8];
#pragma unroll
            for (int i = 0; i < 8; ++i) {
                const int p = tid + i * 512, r = p >> 4, c8 = (p & 15) * 8, d = p >> 5, m8 = (p & 31) * 8;
                tk[i] = *(const u32x4*)(KV + (size_t)(b * 256 + r) * 1024 + h * 128 + c8);
                tv[i] = *(const u32x4*)(VTX + ((size_t)(b * 4 + h) * 128 + d) * 256 + m8);
            }
            asm volatile("" : "+v"(tk[0]), "+v"(tk[1]), "+v"(tk[2]), "+v"(tk[3]), "+v"(tk[4]), "+v"(tk[5]), "+v"(tk[6]), "+v"(tk[7]));
            asm volatile("" : "+v"(tv[0]), "+v"(tv[1]), "+v"(tv[2]), "+v"(tv[3]), "+v"(tv[4]), "+v"(tv[5]), "+v"(tv[6]), "+v"(tv[7]));
#pragma unroll
            for (int i = 0; i < 8; ++i) {
                const int p = tid + i * 512, r = p >> 4, c8 = (p & 15) * 8, d = p >> 5, m8 = (p & 31) * 8;
                *(LAS u32x4*)(sK + r * 136 + c8) = tk[i];
                *(LAS u32x4*)(sV + d * 264 + m8) = tv[i];
            }
        }
        __syncthreads();
#pragma unroll 1
        for (int iter = 0; iter < 2; ++iter) {
            const size_t q0 = (size_t)b * SEQ + qr * 512 + iter * 256 + wave * 32;
            bf16x8 qf[2][4];
#pragma unroll
            for (int nt = 0; nt < 2; ++nt) {
                const bf16_t* qp = QX + (q0 + nt * 16 + fr) * 512 + h * 128 + 8 * fq;
                u32x4 w[4]; float ssq = 0.f;
#pragma unroll
                for (int ks = 0; ks < 4; ++ks) { w[ks] = *(const u32x4*)(qp + 32 * ks);
#pragma unroll
                    for (int j = 0; j < 4; ++j) { const float x0 = lo16(w[ks][j]), x1 = hi16(w[ks][j]); ssq += x0 * x0 + x1 * x1; } }
                ssq += __shfl_xor(ssq, 16); ssq += __shfl_xor(ssq, 32);
                const float sc = rsqrtf(ssq * (1.0f / 128.0f) + 1e-6f) * 0.12751743f;
#pragma unroll
                for (int ks = 0; ks < 4; ++ks) {
                    const f32x4 g0 = *(const f32x4*)(qgn + 32 * ks + 8 * fq), g1 = *(const f32x4*)(qgn + 32 * ks + 8 * fq + 4);
                    u32x4 ow;
                    ow.x = pk2(lo16(w[ks][0]) * sc * g0[0], hi16(w[ks][0]) * sc * g0[1]); ow.y = pk2(lo16(w[ks][1]) * sc * g0[2], hi16(w[ks][1]) * sc * g0[3]);
                    ow.z = pk2(lo16(w[ks][2]) * sc * g1[0], hi16(w[ks][2]) * sc * g1[1]); ow.w = pk2(lo16(w[ks][3]) * sc * g1[2], hi16(w[ks][3]) * sc * g1[3]);
                    qf[nt][ks] = __builtin_bit_cast(bf16x8, ow);
                }
            }
            f32x4 o[8][2];
#pragma unroll
            for (int dt = 0; dt < 8; ++dt) { o[dt][0] = (f32x4){0.f, 0.f, 0.f, 0.f}; o[dt][1] = (f32x4){0.f, 0.f, 0.f, 0.f}; }
            float lsum[2] = {0.f, 0.f};
#pragma unroll 2
            for (int st = 0; st < 8; ++st) {
                const int k0 = st * 32;
                f32x4 sacc[2][2];
#pragma unroll
                for (int mt = 0; mt < 2; ++mt) {
                    sacc[mt][0] = (f32x4){0.f, 0.f, 0.f, 0.f}; sacc[mt][1] = (f32x4){0.f, 0.f, 0.f, 0.f};
#pragma unroll
                    for (int ks = 0; ks < 4; ++ks) {
                        const bf16x8 kfr = *(const LAS bf16x8*)(sK + (k0 + mt * 16 + fr) * 136 + 32 * ks + 8 * fq);
                        sacc[mt][0] = __builtin_amdgcn_mfma_f32_16x16x32_bf16(kfr, qf[0][ks], sacc[mt][0], 0, 0, 0);
                        sacc[mt][1] = __builtin_amdgcn_mfma_f32_16x16x32_bf16(kfr, qf[1][ks], sacc[mt][1], 0, 0, 0);
                    }
                }
                bf16x8 pf[2];
#pragma unroll
                for (int nt = 0; nt < 2; ++nt) {
                    float p[8];
#pragma unroll
                    for (int j = 0; j < 4; ++j) { p[j] = __builtin_amdgcn_exp2f(fminf(sacc[0][nt][j], 80.f)); p[4 + j] = __builtin_amdgcn_exp2f(fminf(sacc[1][nt][j], 80.f)); }
                    lsum[nt] += ((p[0] + p[1]) + (p[2] + p[3])) + ((p[4] + p[5]) + (p[6] + p[7]));
                    u32x4 w; w.x = pk2(p[0], p[1]); w.y = pk2(p[2], p[3]); w.z = pk2(p[4], p[5]); w.w = pk2(p[6], p[7]);
                    pf[nt] = __builtin_bit_cast(bf16x8, w);
                }
#pragma unroll
                for (int dt = 0; dt < 8; ++dt) {
                    const LAS bf16_t* vp = sV + (dt * 16 + fr) * 264 + k0 + 4 * fq;
                    const u32x2 v0 = *(const LAS u32x2*)vp, v1 = *(const LAS u32x2*)(vp + 16);
                    u32x4 w; w.x = v0.x; w.y = v0.y; w.z = v1.x; w.w = v1.y;
                    const bf16x8 vfr = __builtin_bit_cast(bf16x8, w);
                    o[dt][0] = __builtin_amdgcn_mfma_f32_16x16x32_bf16(vfr, pf[0], o[dt][0], 0, 0, 0);
                    o[dt][1] = __builtin_amdgcn_mfma_f32_16x16x32_bf16(vfr, pf[1], o[dt][1], 0, 0, 0);
                }
            }
#pragma unroll
            for (int nt = 0; nt < 2; ++nt) {
                float ls = lsum[nt]; ls += __shfl_xor(ls, 16); ls += __shfl_xor(ls, 32);
                const float inv = 1.0f / ls;
                bf16_t* op = OX + (q0 + nt * 16 + fr) * 512 + h * 128 + 4 * fq;
#pragma unroll
                for (int dt = 0; dt < 8; ++dt) { u32x2 w; w.x = pk2(o[dt][nt][0] * inv, o[dt][nt][1] * inv); w.y = pk2(o[dt][nt][2] * inv, o[dt][nt][3] * inv); *(u32x2*)(op + dt * 16) = w; }
            }
        }
    }
    __syncthreads();
}

__device__ __forceinline__ void pf_router(const PA a, int l, LAS unsigned char* lds) {
    const int tid = otid(), wave = tid >> 6, lane = tid & 63, fr = lane & 15, fq = lane >> 4;
    LAS int* s_cnt = (LAS int*)lds;
    LAS int* s_base = s_cnt + 32;
    LAS int* s_e = s_base + 32;
    LAS int* s_rk = s_e + 256;
    LAS float* s_w = (LAS float*)(s_rk + 256);
    const bf16_t* X = WSP(const bf16_t, WS_XB); const float* SS = WSP(const float, WS_SS);
    const bf16_t* wrh = WSP(const bf16_t, WS_WRH) + (size_t)l * 48 * 1024; const bf16_t* wrl = WSP(const bf16_t, WS_WRL) + (size_t)l * 48 * 1024;
    const float* bg = INP(32) + l * 4; const float* br = INP(34) + l * 32;
    int* EID = WSP(int, WS_EID); float* EW = WSP(float, WS_EW); int* ERK = WSP(int, WS_ERK);
    unsigned* cnt = WSP(unsigned, WS_CTL) + CW_CNT + l * 32;
    for (int tile = oblk(); tile < T / 128; tile += ogrid()) {
        __syncthreads();
        if (tid < 32) s_cnt[tid] = 0;
        __syncthreads();
        const int t = tile * 128 + wave * 16 + fr;
        f32x4 acc[3];
#pragma unroll
        for (int mt = 0; mt < 3; ++mt) acc[mt] = (f32x4){0.f, 0.f, 0.f, 0.f};
        const bf16_t* xr = X + (size_t)t * 1024 + 8 * fq;
        u32x4 wst[6];
#define RT_LOAD(sl_) do { _Pragma("unroll") for (int i = 0; i < 6; ++i) { const int p = tid + i * 512, arr = p / 1536, pr = p - arr * 1536, r = pr >> 5, q = pr & 31; \
            wst[i] = *(const u32x4*)((arr ? wrl : wrh) + (size_t)r * 1024 + (sl_) * 256 + q * 8); } } while (0)
#define RT_STORE(buf_) do { _Pragma("unroll") for (int i = 0; i < 6; ++i) { const int p = tid + i * 512, arr = p / 1536, pr = p - arr * 1536, r = pr >> 5, q = pr & 31; \
            *(LAS u32x4*)(lds + 4096 + (buf_) * 50688 + arr * 25344 + r * 528 + q * 16) = wst[i]; } } while (0)
        RT_LOAD(0); RT_STORE(0);
        __syncthreads();
#pragma unroll 1
        for (int sl = 0; sl < 4; ++sl) {
            if (sl < 3) RT_LOAD(sl + 1);
            const LAS unsigned char* wb_ = lds + 4096 + (sl & 1) * 50688;
#pragma unroll
            for (int s8 = 0; s8 < 8; ++s8) {
                const int s_ = sl * 8 + s8;
                const bf16x8 xh = *(const bf16x8*)(xr + 32 * s_);
#pragma unroll
                for (int mt = 0; mt < 3; ++mt) {
                    const bf16x8 wh = *(const LAS bf16x8*)(wb_ + (mt * 16 + fr) * 528 + (32 * s8 + 8 * fq) * 2);
                    const bf16x8 wl = *(const LAS bf16x8*)(wb_ + 25344 + (mt * 16 + fr) * 528 + (32 * s8 + 8 * fq) * 2);
                    acc[mt] = __builtin_amdgcn_mfma_f32_16x16x32_bf16(wh, xh, acc[mt], 0, 0, 0);
                    acc[mt] = __builtin_amdgcn_mfma_f32_16x16x32_bf16(wl, xh, acc[mt], 0, 0, 0);
                }
            }
            if (sl < 3) { RT_STORE((sl + 1) & 1); __syncthreads(); }
        }
#undef RT_LOAD
#undef RT_STORE
        const f32x4* sp = (const f32x4*)(SS + (size_t)t * 16);
        const f32x4 s0 = sp[0], s1 = sp[1], s2 = sp[2], s3 = sp[3];
        const float tot = ((s0[0] + s0[1]) + (s0[2] + s0[3])) + ((s1[0] + s1[1]) + (s1[2] + s1[3])) + ((s2[0] + s2[1]) + (s2[2] + s2[3])) + ((s3[0] + s3[1]) + (s3[2] + s3[3]));
        const float rinv = rsqrtf(tot * (1.0f / 1024.0f) + 1e-6f);
        float lg[4], lr[8];
#pragma unroll
        for (int j = 0; j < 4; ++j) { lg[j] = acc[0][j] * rinv + bg[j]; lr[j] = acc[1][j] * rinv + br[fq * 8 + j]; lr[4 + j] = acc[2][j] * rinv + br[fq * 8 + 4 + j]; }
        float g0 = lg[0]; int gt = 0;
#pragma unroll
        for (int j = 1; j < 4; ++j) { if (lg[j] > g0) { g0 = lg[j]; gt = j; } }
        if (fq == gt) {
            float gs = 0.f;
#pragma unroll
            for (int j = 0; j < 4; ++j) gs += __expf(lg[j] - g0);
            const float ggate = 1.0f / gs;
            float l1 = -1e30f, l2 = -1e30f; int j1 = 0, j2 = 0;
#pragma unroll
            for (int j = 0; j < 8; ++j) { const float v = lr[j];
                if (v > l1) { l2 = l1; j2 = j1; l1 = v; j1 = j; } else if (v > l2) { l2 = v; j2 = j; } }
            const float e2 = __expf(l2 - l1);
            const float p1 = 1.0f / (1.0f + e2), p2 = e2 / (1.0f + e2);
            const int e1i = gt * 8 + j1, e2i = gt * 8 + j2;
            const int r1 = atomicAdd((int*)(s_cnt + e1i), 1), r2 = atomicAdd((int*)(s_cnt + e2i), 1);
            const int sl = (wave * 16 + fr) * 2;
            s_e[sl] = e1i; s_e[sl + 1] = e2i; s_rk[sl] = r1; s_rk[sl + 1] = r2; s_w[sl] = ggate * p1; s_w[sl + 1] = ggate * p2;
        }
        __syncthreads();
        if (tid < 32) s_base[tid] = (int)__hip_atomic_fetch_add(cnt + tid, (unsigned)s_cnt[tid], __ATOMIC_RELAXED, __HIP_MEMORY_SCOPE_AGENT);
        __syncthreads();
        if (tid < 256) { const int e = s_e[tid]; const size_t o = (size_t)tile * 256 + tid; EID[o] = e; EW[o] = s_w[tid]; ERK[o] = s_base[e] + s_rk[tid]; }
    }
    __syncthreads();
}

__device__ __forceinline__ void pg_gather(const PA a, int l, LAS unsigned char* lds) {
    const int tid = otid(), wave = tid >> 6, lane = tid & 63;
    LAS int* s_ps = (LAS int*)lds;
    const unsigned* cnt = WSP(const unsigned, WS_CTL) + CW_CNT + l * 32;
    int* SSLOT = WSP(int, WS_SSLOT); float* SW = WSP(float, WS_SW); int* MTE = WSP(int, WS_MTE);
    bf16_t* XS = WSP(bf16_t, WS_XS); const bf16_t* XB = WSP(const bf16_t, WS_XB);
    const float* SS = WSP(const float, WS_SS);
    const int* EID = WSP(const int, WS_EID); const float* EW = WSP(const float, WS_EW); const int* ERK = WSP(const int, WS_ERK);
    __syncthreads();
    if (tid == 0) {
        int acc = 0;
        for (int e = 0; e < 32; ++e) { s_ps[e] = acc; const int c = (int)__hip_atomic_load(cnt + e, __ATOMIC_RELAXED, __HIP_MEMORY_SCOPE_AGENT); acc += ((c + 255) >> 8) << 8; }
        s_ps[32] = acc;
    }
    __syncthreads();
    if (oblk() == 0) {
        if (tid < 32) { const int m0 = s_ps[tid] >> 8, m1 = s_ps[tid + 1] >> 8; for (int mt = m0; mt < m1; ++mt) MTE[mt] = tid; }
        if (tid == 0) MTE[511] = s_ps[32] >> 8;
        if (tid < 33) MTE[400 + tid] = s_ps[tid] >> 8;
    }
    int* STOK = WSP(int, WS_STOK); float* SRINV = WSP(float, WS_SRINV);
    for (int e = oblk(); e < 32; e += ogrid()) {
        const int c = (int)__hip_atomic_load(cnt + e, __ATOMIC_RELAXED, __HIP_MEMORY_SCOPE_AGENT);
        const int r0 = s_ps[e] + c, r1 = s_ps[e + 1];
        for (int r = r0 + tid; r < r1; r += 512) { SSLOT[r] = -1; SW[r] = 0.f; STOK[r] = 0; SRINV[r] = 0.f; }
    }
    for (int as = oblk() * 512 + tid; as < 2 * T; as += ogrid() * 512) {
        const int t = as >> 1;
        const int dest = s_ps[EID[as]] + ERK[as];
        const f32x4* sp = (const f32x4*)(SS + (size_t)t * 16);
        const f32x4 s0 = sp[0], s1 = sp[1], s2 = sp[2], s3 = sp[3];
        const float tot = ((s0[0] + s0[1]) + (s0[2] + s0[3])) + ((s1[0] + s1[1]) + (s1[2] + s1[3])) + ((s2[0] + s2[1]) + (s2[2] + s2[3])) + ((s3[0] + s3[1]) + (s3[2] + s3[3]));
        SSLOT[dest] = as; SW[dest] = EW[as]; STOK[dest] = t; SRINV[dest] = rsqrtf(tot * (1.0f / 1024.0f) + 1e-6f);
    }
}

__device__ __forceinline__ void pj_finalize(const PA a, bool last) {
    const int wave = otid() >> 6, lane = otid() & 63;
    float* OUT = a.out; bf16_t* XB = WSP(bf16_t, WS_XB); float* SS = WSP(float, WS_SS);
    const bf16_t* Y = WSP(const bf16_t, WS_Y);
    for (int t = oblk() * 8 + wave; t < T; t += ogrid() * 8) {
        float sq = 0.f;
#pragma unroll
        for (int i = 0; i < 2; ++i) {
            const int c = i * 512 + lane * 8;
            const u32x4 xw = *(const u32x4*)(XB + (size_t)t * 1024 + c);
            const u32x4 y0 = *(const u32x4*)(Y + (size_t)(2 * t) * 1024 + c), y1 = *(const u32x4*)(Y + (size_t)(2 * t + 1) * 1024 + c);
            float v[8];
#pragma unroll
            for (int j = 0; j < 4; ++j) { v[2 * j] = lo16(xw[j]) + (lo16(y0[j]) + lo16(y1[j])); v[2 * j + 1] = hi16(xw[j]) + (hi16(y0[j]) + hi16(y1[j])); }
            if (last) { *(f32x4*)(OUT + (size_t)t * 1024 + c) = (f32x4){v[0], v[1], v[2], v[3]}; *(f32x4*)(OUT + (size_t)t * 1024 + c + 4) = (f32x4){v[4], v[5], v[6], v[7]}; }
            else {
                u32x4 w; w.x = pk2(v[0], v[1]); w.y = pk2(v[2], v[3]); w.z = pk2(v[4], v[5]); w.w = pk2(v[6], v[7]);
                *(u32x4*)(XB + (size_t)t * 1024 + c) = w;
#pragma unroll
                for (int j = 0; j < 4; ++j) { const float a0 = lo16(w[j]), a1 = hi16(w[j]); sq += a0 * a0 + a1 * a1; }
            }
        }
        if (!last) { sq = wsum(sq); if (lane < 16) SS[(size_t)t * 16 + lane] = (lane == 0) ? sq : 0.f; }
    }
}

#define SITE static __device__ __forceinline__ void
#define OPAQUE() do { a.out = (float*)ldsin(lds, 38); a.ws = (unsigned char*)ldsin(lds, 39); } while (0)
__device__ __forceinline__ int opq(int v) { asm volatile("" : "+s"(v)); return v; }
SITE site_p0(PA a, LAS unsigned char* lds) { OPAQUE(); p0_prologue(a, lds); }
SITE site_kv(PA a, LAS unsigned char* lds) { OPAQUE();
    pg8::Gemm g{WSP(const bf16_t, WS_MEMB), WSP(const bf16_t, WS_WKV), 1024, (size_t)1024 * 1024, nullptr};
    pg8::KvOrder S{opq((int)gridDim.x), opq((int)blockIdx.x)};
    pg8::EpiScale E{WSP(bf16_t, WS_KV), 1024, WSP(const float, WS_MEMSS), MROWS - 1};
    pg8::gemm_phase<pg8::EpiScale, pg8::KvOrder>(lds, g, S, E);
}
SITE site_knorm(PA a, LAS unsigned char* lds) { OPAQUE(); p2_knorm(a, lds); }
SITE site_inproj(PA a, int l, LAS unsigned char* lds) { OPAQUE();
    pg8::Gemm g{WSP(const bf16_t, WS_XB), WSP(const bf16_t, WS_WIN) + (size_t)l * INW * 1024, 1024, 0, nullptr};
    pg8::StaticOrder S; S.init(T, INW, opq((int)gridDim.x), opq((int)blockIdx.x));
    pg8::EpiProj E{WSP(bf16_t, WS_PROJ), WSP(bf16_t, WS_VT), WSP(bf16_t, WS_KFR), WSP(const float, WS_SS), INP(18) + l * 64, INP(19) + l * 64};
    pg8::gemm_phase<pg8::EpiProj, pg8::StaticOrder>(lds, g, S, E);
}
SITE site_prep(PA a, int l, LAS unsigned char* lds, XcdBarrier& bar) { OPAQUE();
    pb_prep(a, l, lds, bar);
}
SITE site_chunks(PA a, int l, LAS unsigned char* lds) { OPAQUE(); pb2_chunks(a, l, lds); }
SITE site_mixer(PA a, int l, LAS unsigned char* lds) { OPAQUE(); pc_mixer(a, l, lds); }
SITE site_outproj(PA a, int l, LAS unsigned char* lds) { OPAQUE();
    pg8::Gemm g{WSP(const bf16_t, WS_YCAT), WSP(const bf16_t, WS_WOUT) + (size_t)l * 1024 * 1024, 1024, 0, nullptr};
    pg8::StaticOrder S; S.init(T, 1024, opq((int)gridDim.x), opq((int)blockIdx.x));
    pg8::EpiRes E{WSP(bf16_t, WS_XB), WSP(float, WS_SS)};
    pg8::gemm_phase<pg8::EpiRes, pg8::StaticOrder>(lds, g, S, E);
}
SITE site_xq(PA a, int l, LAS unsigned char* lds) { OPAQUE();
    pg8::Gemm g{WSP(const bf16_t, WS_XB), WSP(const bf16_t, WS_WQ) + (size_t)l * 512 * 1024, 1024, 0, nullptr};
    pg8::StaticOrder S; S.init(T, 512, opq((int)gridDim.x), opq((int)blockIdx.x));
    pg8::EpiScale E{WSP(bf16_t, WS_QX), 512, WSP(const float, WS_SS), T - 1};
    pg8::gemm_phase<pg8::EpiScale, pg8::StaticOrder>(lds, g, S, E);
}
SITE site_xattn(PA a, int l, LAS unsigned char* lds) { OPAQUE(); pe2_xattn(a, l, lds); }
SITE site_xo(PA a, int l, LAS unsigned char* lds) { OPAQUE();
    pg8::Gemm g{WSP(const bf16_t, WS_OX), WSP(const bf16_t, WS_WO) + (size_t)l * 1024 * 512, 512, 0, nullptr};
    pg8::StaticOrder S; S.init(T, 1024, opq((int)gridDim.x), opq((int)blockIdx.x));
    pg8::EpiRes E{WSP(bf16_t, WS_XB), WSP(float, WS_SS)};
    pg8::gemm_phase<pg8::EpiRes, pg8::StaticOrder>(lds, g, S, E);
}
SITE site_router(PA a, int l, LAS unsigned char* lds) { OPAQUE(); pf_router(a, l, lds); }
SITE site_gather(PA a, int l, LAS unsigned char* lds) { OPAQUE(); pg_gather(a, l, lds); }
SITE site_gu(PA a, LAS unsigned char* lds) { OPAQUE();
    pg8::Gemm g{WSP(const bf16_t, WS_XB), WSP(const bf16_t, WS_WGU), 1024, (size_t)1024 * 1024, WSP(const int, WS_STOK)};
    pg8::MoeOrder S; S.mte = WSP(const int, WS_MTE); S.G = opq((int)gridDim.x); S.c = opq((int)blockIdx.x); S.init();
    pg8::EpiGU E{WSP(bf16_t, WS_HB), WSP(const float, WS_SRINV)};
    pg8::gemm_phase<pg8::EpiGU, pg8::MoeOrder, true, true>(lds, g, S, E);
}
SITE site_down(PA a, LAS unsigned char* lds) { OPAQUE();
    pg8::Gemm g{WSP(const bf16_t, WS_HB), WSP(const bf16_t, WS_WD), 512, (size_t)1024 * 512, nullptr};
    pg8::MoeOrder S; S.mte = WSP(const int, WS_MTE); S.G = opq((int)gridDim.x); S.c = opq((int)blockIdx.x); S.init();
    pg8::EpiDown E{WSP(bf16_t, WS_Y), WSP(const int, WS_SSLOT), WSP(const float, WS_SW)};
    pg8::gemm_phase<pg8::EpiDown, pg8::MoeOrder>(lds, g, S, E);
}
SITE site_final(PA a, int l, LAS unsigned char* lds) { OPAQUE(); pj_finalize(a, l == NL - 1); }

__global__ void __launch_bounds__(512, 2) mk_fwd(Args args) {
    extern __shared__ __attribute__((aligned(16))) unsigned char lds_raw[];
    LAS unsigned char* lds = (LAS unsigned char*)lds_raw;
    const int tid = threadIdx.x;
    const int lo = args.ph_lo, hi = args.ph_hi;
    PA a; a.out = args.out; a.ws = args.ws;
    if (tid < 16) ((LAS unsigned*)(lds + LDS_MISC))[tid] = 0u;
    if (tid == 64) {
        LAS unsigned long long* tab = (LAS unsigned long long*)(lds + LDS_INTAB);
#pragma unroll
        for (int i = 0; i < 38; ++i) tab[i] = (unsigned long long)args.in[i];
        tab[38] = (unsigned long long)args.out; tab[39] = (unsigned long long)args.ws;
    }
    __syncthreads();
    XcdBarrier bar; bar.bar = WSP(unsigned, WS_CTL) + CW_BAR; bar.x = 0; bar.st = nullptr;
    if (!MK_PER_PHASE) bar = xcd_barrier_post(WSP(unsigned, WS_CTL) + CW_BAR, (volatile LAS unsigned*)(lds + LDS_MISC));
#define IN(k) (lo <= (k) && (k) < hi)
#define GRID_BAR() do { if (!MK_PER_PHASE) xcd_barrier(bar); } while (0)
#ifdef PROBE_MASK
    unsigned long long pr_acc = 0ull, pr_t0 = 0ull; const unsigned long long pr_start = wall_clock64();
#define PR0() do { pr_t0 = wall_clock64(); } while (0)
#define PR1(p) do { if ((PROBE_MASK >> (p)) & 1) pr_acc += wall_clock64() - pr_t0; } while (0)
#else
#define PR0() do { } while (0)
#define PR1(p) do { } while (0)
#endif
    PR0(); if (IN(0)) { site_p0(a, lds); GRID_BAR(); } PR1(12);
    PR0(); if (IN(1)) { site_kv(a, lds); GRID_BAR(); } PR1(13);
    PR0(); if (IN(2)) { site_knorm(a, lds); GRID_BAR(); } PR1(14);
    for (int l = 0; l < NL; ++l) {
        const int pb = 3 + 12 * l;
        PR0(); if (IN(pb + 0)) { site_inproj(a, l, lds); GRID_BAR(); } PR1(0);
        PR0(); if (IN(pb + 1)) { site_prep(a, l, lds, bar); GRID_BAR(); } PR1(1);
        PR0(); if (IN(pb + 2)) { site_mixer(a, l, lds); GRID_BAR(); } PR1(2);
        PR0(); if (IN(pb + 3)) { site_outproj(a, l, lds); GRID_BAR(); } PR1(3);
        PR0(); if (IN(pb + 4)) { site_xq(a, l, lds); GRID_BAR(); } PR1(4);
        PR0(); if (IN(pb + 5)) { site_xattn(a, l, lds); GRID_BAR(); } PR1(5);
        PR0(); if (IN(pb + 6)) { site_xo(a, l, lds); GRID_BAR(); } PR1(6);
        PR0(); if (IN(pb + 7)) { site_router(a, l, lds); GRID_BAR(); } PR1(7);
        PR0(); if (IN(pb + 8)) { site_gather(a, l, lds); GRID_BAR(); } PR1(8);
        PR0(); if (IN(pb + 9)) { site_gu(a, lds); GRID_BAR(); } PR1(9);
        PR0(); if (IN(pb + 10)) { site_down(a, lds); GRID_BAR(); } PR1(10);
#ifdef PROBE_MASK
        PR0(); if (IN(pb + 11)) { site_final(a, l, lds); GRID_BAR(); } PR1(11);
#else
        if (IN(pb + 11)) { site_final(a, l, lds); if (l + 1 < NL) GRID_BAR(); }
#endif
    }
#ifdef PROBE_MASK
    {
        unsigned long long* pw = (unsigned long long*)(WSP(unsigned, WS_CTL) + 8192);
        if (blockIdx.x == 0 && tid == 0) __hip_atomic_store(pw, pr_acc, __ATOMIC_RELAXED, __HIP_MEMORY_SCOPE_AGENT);
        GRID_BAR();
        const unsigned long long tgt = 1600000ull + __hip_atomic_load(pw, __ATOMIC_RELAXED, __HIP_MEMORY_SCOPE_AGENT) * (unsigned long long)PROBE_MULT;
        while (wall_clock64() - pr_start < tgt) __builtin_amdgcn_s_sleep(16);
    }
#endif
#undef IN
#undef GRID_BAR
}

extern "C" void kernel_launch(void* const* d_in, const int* in_sizes, int n_in, void* d_out, int out_size, void* d_ws, size_t ws_size, hipStream_t stream) {
    static int grid = 0;
    if (grid == 0) {
        if (n_in != 38 || out_size != T * D || ws_size < WS_END) { fprintf(stderr, "kernel_launch: unexpected shapes (n_in %d out %d ws %zu need %zu)\n", n_in, out_size, ws_size, (size_t)WS_END); grid = -1; return; }
        int dev = 0, cus = 0, per_cu = 0;
        if (hipGetDevice(&dev) != hipSuccess || hipDeviceGetAttribute(&cus, hipDeviceAttributeMultiprocessorCount, dev) != hipSuccess) { grid = -1; return; }
        if (hipFuncSetAttribute((const void*)mk_fwd, hipFuncAttributeMaxDynamicSharedMemorySize, LDS_BYTES) != hipSuccess) { fprintf(stderr, "kernel_launch: hipFuncSetAttribute failed\n"); grid = -1; return; }
        if (hipOccupancyMaxActiveBlocksPerMultiprocessor(&per_cu, (const void*)mk_fwd, 512, LDS_BYTES) != hipSuccess || per_cu < 1) { fprintf(stderr, "kernel_launch: occupancy query says %d\n", per_cu); }
        (void)hipGetLastError();
        grid = cus;
    }
    if (grid < 0) return;
    (void)hipMemsetAsync((char*)d_ws + WS_CTL, 0, CTL_BYTES, stream);
    Args a{};
    for (int i = 0; i < 38; ++i) a.in[i] = (const float*)d_in[i];
    a.out = (float*)d_out; a.ws = (unsigned char*)d_ws;
#if MK_PER_PHASE
    for (int p = 0; p < NPH; ++p) { a.ph_lo = p; a.ph_hi = p + 1; hipLaunchKernelGGL(mk_fwd, dim3(grid), dim3(512), LDS_BYTES, stream, a); }
#else
    a.ph_lo = 0; a.ph_hi = NPH;
    hipLaunchKernelGGL(mk_fwd, dim3(grid), dim3(512), LDS_BYTES, stream, a);
#endif
}
```

```cpp
#include <hip/hip_runtime.h>
#include <cstdio>
#include <cstdint>

#ifndef MK_PER_PHASE
#define MK_PER_PHASE 0
#endif

#define LAS __attribute__((address_space(3)))
typedef unsigned short bf16_t;
typedef short bf16x8 __attribute__((ext_vector_type(8)));
typedef float f32x4 __attribute__((ext_vector_type(4)));
typedef unsigned u32x4 __attribute__((ext_vector_type(4)));
typedef unsigned u32x2 __attribute__((ext_vector_type(2)));

constexpr int T = 32768, D = 1024, SEQ = 2048, NL = 4;
constexpr int INW = 3328;
constexpr int MROWS = 4096;
constexpr int MAXROWS = 73728, MAXMT = 288;
constexpr int NPH = 3 + 12 * NL;

constexpr size_t WS_CTL   = 0;
constexpr size_t CTL_BYTES = 65536;
constexpr size_t WS_WIN   = WS_CTL + CTL_BYTES;
constexpr size_t WS_WOUT  = WS_WIN  + (size_t)4 * 3328 * 1024 * 2;
constexpr size_t WS_WQ    = WS_WOUT + (size_t)4 * 1024 * 1024 * 2;
constexpr size_t WS_WKV   = WS_WQ   + (size_t)4 * 512 * 1024 * 2;
constexpr size_t WS_WO    = WS_WKV  + (size_t)4 * 1024 * 1024 * 2;
constexpr size_t WS_WGU   = WS_WO   + (size_t)4 * 1024 * 512 * 2;
constexpr size_t WS_WD    = WS_WGU  + (size_t)32 * 1024 * 1024 * 2;
constexpr size_t WS_KV    = WS_WD   + (size_t)32 * 1024 * 512 * 2;
constexpr size_t WS_MEMB  = WS_KV   + (size_t)4 * 4096 * 1024 * 2;
constexpr size_t WS_MEMSS = WS_MEMB + (size_t)4096 * 1024 * 2;
constexpr size_t WS_VTX   = WS_MEMSS + (size_t)4096 * 16 * 4;
constexpr size_t WS_WRH   = WS_VTX  + (size_t)4 * 4096 * 512 * 2;
constexpr size_t WS_WRL   = WS_WRH  + (size_t)4 * 48 * 1024 * 2;
constexpr size_t WS_PBI   = WS_WRL  + (size_t)4 * 48 * 1024 * 2;
constexpr int PBI_BYTES = 122880;
constexpr size_t WS_XB    = WS_PBI  + (size_t)16 * PBI_BYTES;
constexpr size_t WS_SS    = WS_XB   + (size_t)T * 1024 * 2;
constexpr size_t WS_VF    = WS_SS   + (size_t)T * 16 * 4;
constexpr size_t WS_EID   = WS_VF   + (size_t)T * 512 * 2;
constexpr size_t WS_EW    = WS_EID  + (size_t)T * 2 * 4;
constexpr size_t WS_ERK   = WS_EW   + (size_t)T * 2 * 4;
constexpr size_t WS_SSLOT = WS_ERK  + (size_t)T * 2 * 4;
constexpr size_t WS_SW    = WS_SSLOT + (size_t)MAXROWS * 4;
constexpr size_t WS_MTE   = WS_SW   + (size_t)MAXROWS * 4;
constexpr size_t WS_STOK  = WS_MTE  + 2048;
constexpr size_t WS_SRINV = WS_STOK + (size_t)MAXROWS * 4;
constexpr size_t WS_U     = WS_SRINV + (size_t)MAXROWS * 4;
constexpr size_t WS_PROJ  = WS_U;
constexpr size_t WS_SR    = WS_PROJ + (size_t)T * 3328 * 2;
constexpr size_t WS_SK    = WS_SR   + (size_t)T * 512 * 2;
constexpr size_t WS_SV    = WS_SK   + (size_t)T * 512 * 2;
constexpr size_t WS_SA    = WS_SV   + (size_t)T * 512 * 2;
constexpr size_t WS_SB    = WS_SA   + (size_t)T * 512 * 2;
constexpr size_t WS_SG    = WS_SB   + (size_t)T * 512 * 2;
constexpr size_t WS_SWD   = WS_SG   + (size_t)T * 512 * 2;
constexpr size_t WS_YCAT  = WS_SWD  + (size_t)T * 512 * 4;
constexpr size_t WS_VT    = WS_YCAT + (size_t)T * 1024 * 2;
constexpr int NCHUNK = 16 * 8 * 128;
constexpr size_t WS_BTT   = WS_VT   + (size_t)T * 512 * 2;
constexpr size_t WS_KTT   = WS_BTT  + (size_t)NCHUNK * 2048;
constexpr size_t WS_VST   = WS_KTT  + (size_t)NCHUNK * 2048;
constexpr size_t WS_NKA   = WS_VST  + (size_t)NCHUNK * 2048;
constexpr size_t WS_NBR   = WS_NKA  + (size_t)NCHUNK * 512;
constexpr size_t WS_NKR   = WS_NBR  + (size_t)NCHUNK * 512;
constexpr size_t WS_TMT   = WS_NKR  + (size_t)NCHUNK * 512;
constexpr size_t WS_PCK   = WS_TMT  + (size_t)NCHUNK * 512;
constexpr size_t WS_BS    = WS_PCK  + (size_t)NCHUNK * 256;
constexpr size_t WS_KFR   = WS_SK;
constexpr size_t WS_LH    = WS_SV;
constexpr size_t WS_UEND1 = WS_BS   + (size_t)T * 8 * 4;
constexpr size_t WS_QX    = WS_U;
constexpr size_t WS_OX    = WS_QX   + (size_t)T * 512 * 2;
constexpr size_t WS_XS    = WS_U;
constexpr size_t WS_HB    = WS_XS   + (size_t)MAXROWS * 1024 * 2;
constexpr size_t WS_Y     = WS_HB   + (size_t)MAXROWS * 512 * 2;
constexpr size_t WS_UEND2 = WS_Y    + (size_t)2 * T * 1024 * 2;
constexpr size_t WS_END   = WS_UEND1 > WS_UEND2 ? WS_UEND1 : WS_UEND2;

constexpr int CW_BAR = 0;
constexpr int CW_CNT = 4096;
constexpr int CW_QUEUE = 4096 + 256;

constexpr int LDS_MISC = 139264;
constexpr int LDS_BYTES = LDS_MISC + 16384;

struct Args { const float* in[38]; float* out; unsigned char* ws; int ph_lo, ph_hi; };
struct PA { float* out; unsigned char* ws; };

__device__ __forceinline__ float bf2f(bf16_t b) { return __uint_as_float(((unsigned)b) << 16); }
__device__ __forceinline__ bf16_t f2bf(float f) { unsigned u = __float_as_uint(f); u += 0x7FFFu + ((u >> 16) & 1u); return (bf16_t)(u >> 16); }
typedef __bf16 bf16v2 __attribute__((ext_vector_type(2)));
typedef float f32x2 __attribute__((ext_vector_type(2)));
__device__ __forceinline__ unsigned pk2(float lo, float hi) { f32x2 v = {lo, hi}; bf16v2 b = __builtin_convertvector(v, bf16v2); return __builtin_bit_cast(unsigned, b); }
__device__ __forceinline__ float lo16(unsigned u) { return __uint_as_float(u << 16); }
__device__ __forceinline__ float hi16(unsigned u) { return __uint_as_float(u & 0xffff0000u); }
__device__ __forceinline__ float wsum(float v) {
#pragma unroll
    for (int o = 32; o; o >>= 1) v += __shfl_xor(v, o);
    return v;
}
__device__ __forceinline__ float sigmoidf_(float x) { return 1.0f / (1.0f + __expf(-x)); }

#define XB_TMO      128
#define XB_XCNT(j)  (256  + 64 * (j))
#define XB_XSUB(j)  (1280 + 64 * (j))
#define XB_XGEN(j)  (2304 + 64 * (j))
#define XB_TOP      3328
#define XB_TOPGEN   3392
#define XCD_BAR_WORDS 3456
#define XB_SPIN_CAP (1u << 22)

__device__ __forceinline__ unsigned xb_ld(unsigned* p)              { return __hip_atomic_load(p, __ATOMIC_RELAXED, __HIP_MEMORY_SCOPE_AGENT); }
__device__ __forceinline__ unsigned xb_add(unsigned* p, unsigned v) { return __hip_atomic_fetch_add(p, v, __ATOMIC_RELAXED, __HIP_MEMORY_SCOPE_AGENT); }
__device__ __forceinline__ unsigned xb_xcc_id() { return (unsigned)__builtin_amdgcn_s_getreg((3 << 11) | 20) & 0xFu; }
#define XB_SPIN(cond, bar) do { unsigned _sp = 0; while (cond) { __builtin_amdgcn_s_sleep(1); \
    if ((++_sp & 255u) == 0u) { if (xb_ld(&(bar)[XB_TMO])) break; if (_sp > XB_SPIN_CAP) { atomicAdd(&(bar)[XB_TMO], 1u); break; } } } } while (0)

struct XcdBarrier { unsigned* bar; unsigned x; volatile LAS unsigned* st; };

__device__ __forceinline__ XcdBarrier xcd_barrier_post(unsigned* bar, volatile LAS unsigned* st) {
    XcdBarrier b; b.bar = bar; b.x = xb_xcc_id(); b.st = st;
    if (threadIdx.x == 0) (void)xb_add(&bar[XB_XCNT(b.x)], 1u);
    return b;
}
__device__ __forceinline__ void xcd_barrier_complete(unsigned* bar, unsigned x, unsigned& nloc, unsigned& nx) {
    const unsigned G = gridDim.x * gridDim.y * gridDim.z;
    unsigned sum, cnt, mine, sp = 0u;
    for (;;) {
        sum = 0u; cnt = 0u; mine = 0u;
#pragma unroll
        for (unsigned j = 0; j < 16; ++j) { const unsigned c = xb_ld(&bar[XB_XCNT(j)]); sum += c; cnt += (c > 0u) ? 1u : 0u; mine = (j == x) ? c : mine; }
        if (sum == G) break;
        __builtin_amdgcn_s_sleep(1);
        if ((++sp & 255u) == 0u) { if (xb_ld(&bar[XB_TMO])) break; if (sp > XB_SPIN_CAP) { atomicAdd(&bar[XB_TMO], 1u); break; } }
    }
    nloc = mine > 0u ? mine : 1u; nx = cnt > 0u ? cnt : 1u;
}
__device__ __forceinline__ void xcd_barrier(const XcdBarrier& b) {
    asm volatile("s_waitcnt vmcnt(0)" ::: "memory");
    __syncthreads();
    if (threadIdx.x == 0) {
        unsigned* bar = b.bar;
        __builtin_amdgcn_s_waitcnt(0);
        unsigned nloc = b.st[0], nx = b.st[1];
        if (nloc == 0u) { xcd_barrier_complete(bar, b.x, nloc, nx); b.st[0] = nloc; b.st[1] = nx; }
        const unsigned old = xb_add(&bar[XB_XSUB(b.x)], 1u);
        const unsigned gen = old / nloc;
        if (old + 1u == (gen + 1u) * nloc) {
            __builtin_amdgcn_fence(__ATOMIC_RELEASE, "agent");
            asm volatile("s_waitcnt vmcnt(0)" ::: "memory");
            const unsigned og = xb_add(&bar[XB_TOP], 1u);
            const unsigned tg = og / nx;
            if (og + 1u == (tg + 1u) * nx) xb_add(&bar[XB_TOPGEN], 1u);
            else XB_SPIN(xb_ld(&bar[XB_TOPGEN]) == tg, bar);
            __builtin_amdgcn_fence(__ATOMIC_ACQUIRE, "agent");
            xb_add(&bar[XB_XGEN(b.x)], 1u);
            asm volatile("s_waitcnt vmcnt(0)" ::: "memory");
        } else {
            XB_SPIN(xb_ld(&bar[XB_XGEN(b.x)]) == gen, bar);
            __builtin_amdgcn_fence(__ATOMIC_ACQUIRE, "agent");
            asm volatile("s_waitcnt vmcnt(0)" ::: "memory");
        }
    }
    __syncthreads();
}

namespace pg8 {
constexpr int BM = 256, BK = 64, HALF = 128, HTB = HALF * BK * 2, STAGE_BYTES = 8 * HTB, NXCD = 8, WGM = 8;
__host__ __device__ __forceinline__ int lds_byte(int r, int c) { const int st = (r >> 4) * 2 + (c >> 5), rr = r & 15, cc = c & 31, ob = rr * 64 + cc * 2; return st * 1024 + (ob ^ (((ob >> 9) & 1) << 5)); }
__host__ __device__ __forceinline__ void stage_rc(int b, int& R, int& C) { const int st = b / 1024, sb = b % 1024, swz = sb ^ (((sb >> 9) & 1) << 5); R = (st >> 1) * 16 + swz / 64; C = (st & 1) * 32 + (swz % 64) / 2; }
__host__ __device__ __forceinline__ int perm32(int rho) { const int n = rho >> 4, i = rho & 15; return 8 * (i >> 2) + 4 * n + (i & 3); }

struct Unit { int pm, pn, pa, z; };
struct Gemm { const bf16_t* A; const bf16_t* Bt; int K; size_t bz_stride; const int* rowidx; };

struct StaticOrder {
    int nM, nN, nwg, G, c;
    __device__ void init(int M, int N, int G_, int c_) { nM = M / BM; nN = N / BM; nwg = nM * nN; G = G_; c = c_; }
    __device__ bool next(int i, Unit& u) const {
        const long L = (long)i * G + c; if (L >= nwg) return false;
        int wgid = (int)L; { const int q = nwg / NXCD, r = nwg % NXCD, xcd = wgid % NXCD, off = wgid / NXCD; wgid = (xcd < r ? xcd * (q + 1) : r * (q + 1) + (xcd - r) * q) + off; }
        const int nig = WGM * nN, gid = wgid / nig, fm = gid * WGM, gsz = (nM - fm) < WGM ? (nM - fm) : WGM;
        u.pm = fm + ((wgid % nig) % gsz); u.pn = (wgid % nig) / gsz; u.pa = u.pm; u.z = 0; return true;
    }
};
struct KvOrder {
    int G, c;
    __device__ bool next(int i, Unit& u) const {
        const int L = i * G + c; if (L >= 256) return false;
        u.z = L >> 6; const int r = L & 63; u.pa = r >> 2; u.pn = r & 3; u.pm = u.z * 16 + u.pa; return true;
    }
};
struct MoeOrder {
    const int* mte; int G, c;
    int b0[4], b1[4];
    __device__ void init() {
        const int x = c & 7;
#pragma unroll
        for (int k = 0; k < 4; ++k) { b0[k] = mte[400 + x + 8 * k]; b1[k] = mte[401 + x + 8 * k]; }
#pragma unroll
        for (int k = 0; k < 4; ++k) { b0[k] = __builtin_amdgcn_readfirstlane(b0[k]); b1[k] = __builtin_amdgcn_readfirstlane(b1[k]); }
    }
    __device__ bool next(int i, Unit& u) const {
        if ((G & 7) != 0) {
            const int nunits = mte[511] * 4;
            const int L = i * G + c; if (L >= nunits) return false;
            u.pm = L >> 2; u.pa = u.pm; u.pn = L & 3; u.z = mte[u.pm]; return true;
        }
        const int x = c & 7; int q = i * (G >> 3) + (c >> 3);
#pragma unroll
        for (int k = 0; k < 4; ++k) {
            const int e = x + 8 * k; const int m0 = b0[k], m1 = b1[k]; const int n = (m1 - m0) * 4;
            if (q < n) { u.pm = m0 + (q >> 2); u.pa = u.pm; u.pn = q & 3; u.z = e; return true; }
            q -= n;
        }
        return false;
    }
};

template <class Epi, class Sched, bool ALIGN_EPI = true, bool GATHER = false>
__device__ __forceinline__ void gemm_phase(LAS unsigned char* lds, const Gemm g, const Sched& S, const Epi& E) {
    int tid_ = threadIdx.x; asm volatile("" : "+v"(tid_));
    const int tid = tid_, wid = __builtin_amdgcn_readfirstlane(tid >> 6), lane = tid & 63, wr = wid >> 2, wc = wid & 3, fr = lane & 15, fq = lane >> 4;
    const int K = g.K, nt = K / BK;
    unsigned voffA[2], voffB[2], gcol[2]; int grow[2];
#pragma unroll
    for (int i = 0; i < 2; ++i) { int R, C; stage_rc(tid * 16 + i * 8192, R, C); const int Rb = ((R & ~31) + perm32(R & 31));
        voffA[i] = (unsigned)(R * K + C) * 2u; voffB[i] = (unsigned)(Rb * K + C) * 2u; grow[i] = R; gcol[i] = (unsigned)C * 2u; }
    const size_t kstep = (size_t)(BK * 2);
    const size_t hstep = (size_t)HALF * K * 2;
    const size_t tstep = 2 * hstep;
    const unsigned ldsw = (unsigned)wid * 1024u;
    const int aoff = lds_byte(wr * 64 + fr, fq * 8), boff = lds_byte(wc * 32 + fr, fq * 8);
#define PG8_SA(b, h) (((b) * 2 + (h)) * HTB)
#define PG8_SB(b, h) ((4 + (b) * 2 + (h)) * HTB)
#define PG8_STAGE(bufoff, gbase, voff) do { _Pragma("unroll") for (int _i = 0; _i < 2; ++_i) \
        __builtin_amdgcn_global_load_lds((const unsigned*)((const char*)(gbase) + (voff)[_i]), (LAS unsigned*)(lds + (bufoff) + ldsw + _i * 8192), 16, 0, 0); } while (0)
#define PG8_LDA(dst, b, h) do { _Pragma("unroll") for (int m = 0; m < 4; ++m) _Pragma("unroll") for (int k = 0; k < 2; ++k) dst[m][k] = *(const LAS bf16x8*)(lds + PG8_SA(b, h) + aoff + m * 2048 + k * 1024); } while (0)
#define PG8_LDB(dst, b, h) do { _Pragma("unroll") for (int n = 0; n < 2; ++n) _Pragma("unroll") for (int k = 0; k < 2; ++k) dst[n][k] = *(const LAS bf16x8*)(lds + PG8_SB(b, h) + boff + n * 2048 + k * 1024); } while (0)
#define PG8_MMA(ai, bj, At, Bt) do { __builtin_amdgcn_s_setprio(1); _Pragma("unroll") for (int m = 0; m < 4; ++m) _Pragma("unroll") for (int n = 0; n < 2; ++n) _Pragma("unroll") for (int k = 0; k < 2; ++k) \
        acc[ai][bj][m][n] = __builtin_amdgcn_mfma_f32_16x16x32_bf16(Bt[n][k], At[m][k], acc[ai][bj][m][n], 0, 0, 0); __builtin_amdgcn_s_setprio(0); } while (0)
#define PG8_WAIT_V(n) asm volatile("s_waitcnt vmcnt(" #n ")" ::: "memory")
#define PG8_WAIT_L(n) asm volatile("s_waitcnt lgkmcnt(" #n ")" ::: "memory")
#define PG8_BAR __builtin_amdgcn_s_barrier()
#define PG8_SCHED __builtin_amdgcn_sched_barrier(0)
#define PG8_APTR(u) ((const char*)g.A + (size_t)(u).pa * tstep)
#define PG8_BPTR(u) ((const char*)g.Bt + ((size_t)(u).z * g.bz_stride) * 2 + (size_t)(u).pn * tstep)
    Unit cur, nxt; int ui = 0;
    if (!S.next(0, cur)) return;
    f32x4 acc[2][2][4][2];
#pragma unroll
    for (int a = 0; a < 2; ++a)
#pragma unroll
        for (int b = 0; b < 2; ++b)
#pragma unroll
            for (int m = 0; m < 4; ++m)
#pragma unroll
                for (int n = 0; n < 2; ++n) acc[a][b][m][n] = (f32x4){0.f, 0.f, 0.f, 0.f};
    bf16x8 At[4][2], B0[2][2], B1[2][2];
    const char* cA = GATHER ? (const char*)g.A : PG8_APTR(cur); const char* cB = PG8_BPTR(cur);
    unsigned gcu[2][2] = {{0u, 0u}, {0u, 0u}}, gnx[2][2] = {{0u, 0u}, {0u, 0u}};
#define PG8_GOFF(dst, u) do { _Pragma("unroll") for (int h_ = 0; h_ < 2; ++h_) _Pragma("unroll") for (int i_ = 0; i_ < 2; ++i_) \
        dst[h_][i_] = (unsigned)g.rowidx[(u).pa * 256 + h_ * 128 + grow[i_]] * (unsigned)(K * 2) + gcol[i_]; } while (0)
    if constexpr (GATHER) PG8_GOFF(gcu, cur);
#define PG8_STAGE_A(bufoff, h_, nonGatherPtr, gatherBase, GO) do { if constexpr (GATHER) { PG8_STAGE(bufoff, gatherBase, GO[h_]); } else { PG8_STAGE(bufoff, nonGatherPtr, voffA); } } while (0)
    PG8_STAGE(PG8_SB(0, 0), cB, voffB); PG8_STAGE(PG8_SB(0, 1), cB + hstep, voffB); PG8_STAGE_A(PG8_SA(0, 0), 0, cA, cA, gcu); PG8_STAGE_A(PG8_SA(0, 1), 1, cA + hstep, cA, gcu);
    if (wr == 1) PG8_BAR;
    PG8_WAIT_V(2); PG8_BAR;
    PG8_STAGE(PG8_SB(1, 0), cB + kstep, voffB); PG8_STAGE_A(PG8_SA(1, 0), 0, cA + kstep, cA + kstep, gcu); PG8_STAGE(PG8_SB(1, 1), cB + hstep + kstep, voffB);
    PG8_WAIT_V(6); PG8_BAR;
    for (;;) {
        const bool has_next = S.next(ui + 1, nxt);
        const char* nA = GATHER ? cA : (has_next ? PG8_APTR(nxt) : cA); const char* nB = has_next ? PG8_BPTR(nxt) : cB;
        if constexpr (GATHER) { if (has_next) PG8_GOFF(gnx, nxt); else { _Pragma("unroll") for (int h_ = 0; h_ < 2; ++h_) _Pragma("unroll") for (int i_ = 0; i_ < 2; ++i_) gnx[h_][i_] = gcu[h_][i_]; } }
        for (int t = 0; t < nt; t += 2) {
            const bool last = (t == nt - 2);
            const char* a1 = cA + (size_t)(t + 1) * kstep;
            const char* a2 = last ? nA : cA + (size_t)(t + 2) * kstep; const char* b2 = last ? nB : cB + (size_t)(t + 2) * kstep;
            const char* a3 = a2 + kstep; const char* b3 = b2 + kstep;
            unsigned gse[2][2];
            _Pragma("unroll") for (int h_ = 0; h_ < 2; ++h_) _Pragma("unroll") for (int i_ = 0; i_ < 2; ++i_) gse[h_][i_] = last ? gnx[h_][i_] : gcu[h_][i_];
            PG8_LDB(B0, 0, 0); PG8_LDB(B1, 0, 1); PG8_SCHED; PG8_LDA(At, 0, 0); PG8_STAGE_A(PG8_SA(1, 1), 1, a1 + hstep, a1, gcu);
            PG8_WAIT_V(8); PG8_WAIT_L(0); PG8_BAR; PG8_MMA(0, 0, At, B0); PG8_MMA(0, 1, At, B1); PG8_BAR; PG8_SCHED;
            PG8_LDA(At, 0, 1); PG8_STAGE(PG8_SB(0, 0), b2, voffB); PG8_STAGE(PG8_SB(0, 1), b2 + hstep, voffB); PG8_STAGE_A(PG8_SA(0, 0), 0, a2, a2, gse);
            PG8_WAIT_V(8); PG8_WAIT_L(0); PG8_BAR; PG8_MMA(1, 0, At, B0); PG8_MMA(1, 1, At, B1); PG8_BAR; PG8_SCHED;
            PG8_LDB(B0, 1, 0); PG8_LDB(B1, 1, 1); PG8_SCHED; PG8_LDA(At, 1, 0); PG8_STAGE_A(PG8_SA(0, 1), 1, a2 + hstep, a2, gse);
            PG8_WAIT_V(8); PG8_WAIT_L(0); PG8_BAR; PG8_MMA(0, 0, At, B0); PG8_MMA(0, 1, At, B1); PG8_BAR; PG8_SCHED;
            PG8_LDA(At, 1, 1); PG8_STAGE(PG8_SB(1, 0), b3, voffB); PG8_STAGE(PG8_SB(1, 1), b3 + hstep, voffB); PG8_STAGE_A(PG8_SA(1, 0), 0, a3, a3, gse);
            PG8_WAIT_V(8); PG8_WAIT_L(0); PG8_BAR; PG8_MMA(1, 0, At, B0); PG8_MMA(1, 1, At, B1); PG8_BAR; PG8_SCHED;
        }
        if constexpr (ALIGN_EPI) { if (wr == 0) PG8_BAR; }
        E(acc, cur, wr, wc, fr, fq);
        if (!has_next) break;
#pragma unroll
        for (int a = 0; a < 2; ++a)
#pragma unroll
            for (int b = 0; b < 2; ++b)
#pragma unroll
                for (int m = 0; m < 4; ++m)
#pragma unroll
                    for (int n = 0; n < 2; ++n) acc[a][b][m][n] = (f32x4){0.f, 0.f, 0.f, 0.f};
        cur = nxt; cA = nA; cB = nB; ++ui;
        if constexpr (GATHER) { _Pragma("unroll") for (int h_ = 0; h_ < 2; ++h_) _Pragma("unroll") for (int i_ = 0; i_ < 2; ++i_) gcu[h_][i_] = gnx[h_][i_]; }
        if constexpr (ALIGN_EPI) { if (wr == 1) PG8_BAR; }
    }
    PG8_WAIT_V(0);
    if constexpr (!ALIGN_EPI) { if (wr == 0) PG8_BAR; }
    PG8_BAR;
#undef PG8_SA
#undef PG8_SB
#undef PG8_STAGE
#undef PG8_LDA
#undef PG8_LDB
#undef PG8_MMA
#undef PG8_WAIT_V
#undef PG8_WAIT_L
#undef PG8_BAR
#undef PG8_SCHED
#undef PG8_APTR
#undef PG8_BPTR
#undef PG8_GOFF
#undef PG8_STAGE_A
}

typedef const f32x4 (&AccRef)[2][2][4][2];

__device__ __forceinline__ f32x4 ss_part(const float* ss, size_t row, int fq) { return *(const f32x4*)(ss + row * 16 + 4 * fq); }
__device__ __forceinline__ float ss_tot(f32x4 s) { float p = (s[0] + s[1]) + (s[2] + s[3]); p += __shfl_xor(p, 16); p += __shfl_xor(p, 32); return p; }
#define EPI_FENCE8(v) asm volatile("s_waitcnt vmcnt(0)" : "+v"((v)[0][0]), "+v"((v)[0][1]), "+v"((v)[0][2]), "+v"((v)[0][3]), "+v"((v)[1][0]), "+v"((v)[1][1]), "+v"((v)[1][2]), "+v"((v)[1][3]) :: "memory")
struct EpiScale {
    bf16_t* O; int ldc; const float* ss; int ssmask;
    __device__ __forceinline__ void operator()(AccRef acc, const Unit& u, int wr, int wc, int fr, int fq) const {
        f32x4 sv[2][4]; float rv[2][4];
#pragma unroll
        for (int ai = 0; ai < 2; ++ai)
#pragma unroll
            for (int m = 0; m < 4; ++m) sv[ai][m] = ss_part(ss, (size_t)((u.pm * 256 + ai * 128 + wr * 64 + m * 16 + fr) & ssmask), fq);
        EPI_FENCE8(sv);
#pragma unroll
        for (int ai = 0; ai < 2; ++ai)
#pragma unroll
            for (int m = 0; m < 4; ++m) rv[ai][m] = rsqrtf(ss_tot(sv[ai][m]) * (1.0f / 1024.0f) + 1e-6f);
#pragma unroll
        for (int ai = 0; ai < 2; ++ai)
#pragma unroll
            for (int m = 0; m < 4; ++m) {
                const int row = u.pm * 256 + ai * 128 + wr * 64 + m * 16 + fr;
                const float rinv = rv[ai][m];
#pragma unroll
                for (int bj = 0; bj < 2; ++bj) {
                    const int col = u.pn * 256 + bj * 128 + wc * 32 + 8 * fq;
                    const f32x4 v0 = acc[ai][bj][m][0] * rinv, v1 = acc[ai][bj][m][1] * rinv;
                    u32x4 w; w.x = pk2(v0[0], v0[1]); w.y = pk2(v0[2], v0[3]); w.z = pk2(v1[0], v1[1]); w.w = pk2(v1[2], v1[3]);
                    *(u32x4*)(O + (size_t)row * ldc + col) = w;
                }
            }
    }
};
struct EpiProj {
    bf16_t* O; bf16_t* VT; bf16_t* KF; const float* ss; const float* qg; const float* kg;
    __device__ __forceinline__ void operator()(AccRef acc, const Unit& u, int wr, int wc, int fr, int fq) const {
        f32x4 sv[2][4]; float rv[2][4];
#pragma unroll
        for (int ai = 0; ai < 2; ++ai)
#pragma unroll
            for (int m = 0; m < 4; ++m) sv[ai][m] = ss_part(ss, (size_t)(u.pm * 256 + ai * 128 + wr * 64 + m * 16 + fr), fq);
        if (u.pn >= 7 && u.pn <= 10) {
            const bool isk = u.pn >= 9; const float* gp = isk ? kg : qg;
            const int head = ((u.pn - 7) & 1) * 4 + wc;
            f32x4 g00 = *(const f32x4*)(gp + 8 * fq), g01 = *(const f32x4*)(gp + 8 * fq + 4), g10 = *(const f32x4*)(gp + 32 + 8 * fq), g11 = *(const f32x4*)(gp + 32 + 8 * fq + 4);
            const float qsc = isk ? 1.0f : 0.18033688011112042f;
#pragma unroll
            for (int ai = 0; ai < 2; ++ai)
#pragma unroll
                for (int m = 0; m < 4; ++m) rv[ai][m] = 0.f;
            EPI_FENCE8(sv);
            asm volatile("" : "+v"(g00), "+v"(g01), "+v"(g10), "+v"(g11));
#pragma unroll
            for (int ai = 0; ai < 2; ++ai)
#pragma unroll
                for (int m = 0; m < 4; ++m) rv[ai][m] = ss_tot(sv[ai][m]) * (1.0f / 1024.0f) + 1e-6f;
#pragma unroll
            for (int ai = 0; ai < 2; ++ai)
#pragma unroll
                for (int m = 0; m < 4; ++m) {
                    const int row = u.pm * 256 + ai * 128 + wr * 64 + m * 16 + fr;
                    const f32x4 a0 = acc[ai][0][m][0], a1 = acc[ai][0][m][1], b0 = acc[ai][1][m][0], b1 = acc[ai][1][m][1];
                    float sq = ((a0[0] * a0[0] + a0[1] * a0[1]) + (a0[2] * a0[2] + a0[3] * a0[3])) + ((a1[0] * a1[0] + a1[1] * a1[1]) + (a1[2] * a1[2] + a1[3] * a1[3]))
                             + ((b0[0] * b0[0] + b0[1] * b0[1]) + (b0[2] * b0[2] + b0[3] * b0[3])) + ((b1[0] * b1[0] + b1[1] * b1[1]) + (b1[2] * b1[2] + b1[3] * b1[3]));
                    sq += __shfl_xor(sq, 16); sq += __shfl_xor(sq, 32);
                    const float sc = rsqrtf(sq * (1.0f / 64.0f) + 1e-6f * rv[ai][m]) * qsc;
                    bf16_t* op = isk ? KF + ((((size_t)(row >> 11) * 8 + head) * 128 + ((row & 2047) >> 4)) * 2) * 512 + (fq * 16 + fr) * 8
                                     : O + (size_t)row * INW + 1792 + head * 64 + 8 * fq;
                    const int op2 = isk ? 512 : 32;
                    u32x4 w;
                    w.x = pk2(a0[0] * sc * g00[0], a0[1] * sc * g00[1]); w.y = pk2(a0[2] * sc * g00[2], a0[3] * sc * g00[3]); w.z = pk2(a1[0] * sc * g01[0], a1[1] * sc * g01[1]); w.w = pk2(a1[2] * sc * g01[2], a1[3] * sc * g01[3]);
                    *(u32x4*)op = w;
                    w.x = pk2(b0[0] * sc * g10[0], b0[1] * sc * g10[1]); w.y = pk2(b0[2] * sc * g10[2], b0[3] * sc * g10[3]); w.z = pk2(b1[0] * sc * g11[0], b1[1] * sc * g11[1]); w.w = pk2(b1[2] * sc * g11[2], b1[3] * sc * g11[3]);
                    *(u32x4*)(op + op2) = w;
                }
            return;
        }
#pragma unroll
        for (int ai = 0; ai < 2; ++ai)
#pragma unroll
            for (int m = 0; m < 4; ++m) rv[ai][m] = 0.f;
        EPI_FENCE8(sv);
#pragma unroll
        for (int ai = 0; ai < 2; ++ai)
#pragma unroll
            for (int m = 0; m < 4; ++m) rv[ai][m] = rsqrtf(ss_tot(sv[ai][m]) * (1.0f / 1024.0f) + 1e-6f);
#pragma unroll
        for (int ai = 0; ai < 2; ++ai)
#pragma unroll
            for (int m = 0; m < 4; ++m) {
                const int row = u.pm * 256 + ai * 128 + wr * 64 + m * 16 + fr;
                const float rinv = rv[ai][m];
#pragma unroll
                for (int bj = 0; bj < 2; ++bj) {
                    const int col = u.pn * 256 + bj * 128 + wc * 32 + 8 * fq;
                    const f32x4 v0 = acc[ai][bj][m][0] * rinv, v1 = acc[ai][bj][m][1] * rinv;
                    u32x4 w; w.x = pk2(v0[0], v0[1]); w.y = pk2(v0[2], v0[3]); w.z = pk2(v1[0], v1[1]); w.w = pk2(v1[2], v1[3]);
                    if (u.pn < 11) *(u32x4*)(O + (size_t)row * INW + col) = w;
                    else {
                        const int cv = col - 2816;
                        const int sq_ = row & 2047, kk = sq_ & 31;
                        bf16_t* vp = VT + ((((size_t)((row >> 11) * 8 + (cv >> 6)) * 64 + (sq_ >> 5)) * 4 + ((cv & 63) >> 4)) * 64 + ((kk & 15) >> 2) * 16 + (cv & 15)) * 8 + ((kk >> 4) & 1) * 4 + (kk & 3);
#pragma unroll
                        for (int e = 0; e < 4; ++e) { vp[(2 * e) * 8] = (bf16_t)(w[e] & 0xffffu); vp[(2 * e + 1) * 8] = (bf16_t)(w[e] >> 16); }
                    }
                }
            }
    }
};
struct EpiRes {
    bf16_t* XB; float* SS;
    __device__ __forceinline__ void operator()(AccRef acc, const Unit& u, int wr, int wc, int fr, int fq) const {
        u32x4 xin[2][2][4];
#pragma unroll
        for (int ai = 0; ai < 2; ++ai)
#pragma unroll
            for (int m = 0; m < 4; ++m)
#pragma unroll
                for (int bj = 0; bj < 2; ++bj)
                    xin[bj][ai][m] = *(const u32x4*)(XB + (size_t)(u.pm * 256 + ai * 128 + wr * 64 + m * 16 + fr) * 1024 + u.pn * 256 + bj * 128 + wc * 32 + 8 * fq);
        EPI_FENCE8(xin[0]);
        asm volatile("" : "+v"(xin[1][0][0]), "+v"(xin[1][0][1]), "+v"(xin[1][0][2]), "+v"(xin[1][0][3]), "+v"(xin[1][1][0]), "+v"(xin[1][1][1]), "+v"(xin[1][1][2]), "+v"(xin[1][1][3]));
#pragma unroll
        for (int ai = 0; ai < 2; ++ai)
#pragma unroll
            for (int m = 0; m < 4; ++m) {
                const int row = u.pm * 256 + ai * 128 + wr * 64 + m * 16 + fr;
                float sq = 0.f;
#pragma unroll
                for (int bj = 0; bj < 2; ++bj) {
                    const int col = u.pn * 256 + bj * 128 + wc * 32 + 8 * fq;
                    u32x4* xp = (u32x4*)(XB + (size_t)row * 1024 + col);
                    const u32x4 xw = xin[bj][ai][m];
                    f32x4 x0 = {lo16(xw.x), hi16(xw.x), lo16(xw.y), hi16(xw.y)}, x1 = {lo16(xw.z), hi16(xw.z), lo16(xw.w), hi16(xw.w)};
                    x0 += acc[ai][bj][m][0]; x1 += acc[ai][bj][m][1];
                    u32x4 w; w.x = pk2(x0[0], x0[1]); w.y = pk2(x0[2], x0[3]); w.z = pk2(x1[0], x1[1]); w.w = pk2(x1[2], x1[3]);
                    *xp = w;
                    x0 = (f32x4){lo16(w.x), hi16(w.x), lo16(w.y), hi16(w.y)}; x1 = (f32x4){lo16(w.z), hi16(w.z), lo16(w.w), hi16(w.w)};
                    sq += (x0[0] * x0[0] + x0[1] * x0[1]) + (x0[2] * x0[2] + x0[3] * x0[3]) + (x1[0] * x1[0] + x1[1] * x1[1]) + (x1[2] * x1[2] + x1[3] * x1[3]);
                }
                sq += __shfl_xor(sq, 16); sq += __shfl_xor(sq, 32);
                if (fq == 0) SS[(size_t)row * 16 + u.pn * 4 + wc] = sq;
            }
    }
};
struct EpiGU {
    bf16_t* H; const float* rinv;
    __device__ __forceinline__ void operator()(AccRef acc, const Unit& u, int wr, int wc, int fr, int fq) const {
        float rv[2][4];
#pragma unroll
        for (int ai = 0; ai < 2; ++ai)
#pragma unroll
            for (int m = 0; m < 4; ++m) rv[ai][m] = rinv[u.pm * 256 + ai * 128 + wr * 64 + m * 16 + fr];
        EPI_FENCE8(rv);
#pragma unroll
        for (int ai = 0; ai < 2; ++ai)
#pragma unroll
            for (int m = 0; m < 4; ++m) {
                const int row = u.pm * 256 + ai * 128 + wr * 64 + m * 16 + fr;
                const float rs = rv[ai][m];
                float h[8];
#pragma unroll
                for (int n = 0; n < 2; ++n)
#pragma unroll
                    for (int j = 0; j < 4; ++j) { const float gt = acc[ai][0][m][n][j] * rs, up = acc[ai][1][m][n][j] * rs; h[n * 4 + j] = gt * __builtin_amdgcn_rcpf(1.0f + __expf(-gt)) * up; }
                u32x4 w; w.x = pk2(h[0], h[1]); w.y = pk2(h[2], h[3]); w.z = pk2(h[4], h[5]); w.w = pk2(h[6], h[7]);
                *(u32x4*)(H + (size_t)row * 512 + u.pn * 128 + wc * 32 + 8 * fq) = w;
            }
    }
};
struct EpiDown {
    bf16_t* Y; const int* slot; const float* sw;
    __device__ __forceinline__ void operator()(AccRef acc, const Unit& u, int wr, int wc, int fr, int fq) const {
        int sl[2][4]; float wv[2][4];
#pragma unroll
        for (int ai = 0; ai < 2; ++ai)
#pragma unroll
            for (int m = 0; m < 4; ++m) { const int row = u.pm * 256 + ai * 128 + wr * 64 + m * 16 + fr; sl[ai][m] = slot[row]; wv[ai][m] = sw[row]; }
        EPI_FENCE8(sl);
        asm volatile("" : "+v"(wv[0][0]), "+v"(wv[0][1]), "+v"(wv[0][2]), "+v"(wv[0][3]), "+v"(wv[1][0]), "+v"(wv[1][1]), "+v"(wv[1][2]), "+v"(wv[1][3]));
#pragma unroll
        for (int ai = 0; ai < 2; ++ai)
#pragma unroll
            for (int m = 0; m < 4; ++m) {
                const int s = sl[ai][m]; const float wgt = wv[ai][m];
                if (s >= 0) {
#pragma unroll
                    for (int bj = 0; bj < 2; ++bj) {
                        const int col = u.pn * 256 + bj * 128 + wc * 32 + 8 * fq;
                        const f32x4 v0 = acc[ai][bj][m][0] * wgt, v1 = acc[ai][bj][m][1] * wgt;
                        u32x4 w; w.x = pk2(v0[0], v0[1]); w.y = pk2(v0[2], v0[3]); w.z = pk2(v1[0], v1[1]); w.w = pk2(v1[2], v1[3]);
                        *(u32x4*)(Y + (size_t)s * 1024 + col) = w;
                    }
                }
            }
    }
};
}

#define WSP(type, off) ((type*)(a.ws + (off)))
__device__ __forceinline__ int oblk() { int t = blockIdx.x; asm volatile("" : "+s"(t)); return t; }
__device__ __forceinline__ int ogrid() { int t = gridDim.x; asm volatile("" : "+s"(t)); return t; }
__device__ __forceinline__ int otid() { int t = threadIdx.x; asm volatile("" : "+v"(t)); return t; }
constexpr int LDS_INTAB = LDS_MISC + 14336;
__device__ __forceinline__ const float* ldsin(LAS unsigned char* lds, int i) {
    const unsigned long long p = ((const LAS unsigned long long*)(lds + LDS_INTAB))[i];
    const unsigned lo = __builtin_amdgcn_readfirstlane((unsigned)p), hi = __builtin_amdgcn_readfirstlane((unsigned)(p >> 32));
    return (const float*)(__attribute__((address_space(1))) const float*)(((unsigned long long)hi << 32) | lo);
}
#define INP(i) ldsin(lds, (i))

template <int MAP>
__device__ __forceinline__ void conv_slab(const float* __restrict__ src, int N, int Kper, bf16_t* __restrict__ dst, size_t estride,
                                          const float* __restrict__ gain, int goff, LAS float* tile, int slab) {
    const int tid = otid();
    const int nsn = N >> 8;
    const int kt = slab / nsn, ns = slab - kt * nsn, k0 = kt * 64, n0 = ns * 256;
    const int e = k0 / Kper, kl0 = k0 - e * Kper;
    f32x4 v[8]; float gs[8];
#pragma unroll
    for (int i = 0; i < 8; ++i) { const int idx = tid + i * 512, kk = idx >> 6, n4 = (idx & 63) * 4; v[i] = *(const f32x4*)(src + (size_t)(k0 + kk) * N + n0 + n4);
        const int gi = kl0 + kk - goff; gs[i] = (gain != nullptr) ? gain[gi < 0 ? 0 : gi] : 1.0f; }
    asm volatile("" : "+v"(gs[0]), "+v"(gs[1]), "+v"(gs[2]), "+v"(gs[3]), "+v"(gs[4]), "+v"(gs[5]), "+v"(gs[6]), "+v"(gs[7]));
#pragma unroll
    for (int i = 0; i < 8; ++i) {
        const int idx = tid + i * 512, kk = idx >> 6, n4 = (idx & 63) * 4;
        const float gsc = (kl0 + kk >= goff) ? gs[i] : 1.0f;
        LAS float* tp = tile + kk * 257 + n4;
        tp[0] = v[i][0] * gsc; tp[1] = v[i][1] * gsc; tp[2] = v[i][2] * gsc; tp[3] = v[i][3] * gsc;
    }
    __syncthreads();
#pragma unroll
    for (int i = 0; i < 4; ++i) {
        const int p = tid + i * 512, nn = p >> 3, kg = p & 7;
        float x[8];
#pragma unroll
        for (int j = 0; j < 8; ++j) x[j] = tile[(kg * 8 + j) * 257 + nn];
        const int n = n0 + nn;
        int nr;
        if (MAP == 0) nr = n;
        else if (MAP == 3) { const int pn_ = n >> 8, wi = n & 255;
            nr = (pn_ >= 7 && pn_ <= 10) ? pn_ * 256 + ((wi & 63) >> 5) * 128 + (wi >> 6) * 32 + (wi & 31) : n; }
        else nr = (n >> 7) * 256 + (n & 127) + (MAP == 2 ? 128 : 0);
        u32x4 w; w.x = pk2(x[0], x[1]); w.y = pk2(x[2], x[3]); w.z = pk2(x[4], x[5]); w.w = pk2(x[6], x[7]);
        *(u32x4*)(dst + (size_t)e * estride + (size_t)nr * Kper + kl0 + kg * 8) = w;
    }
    __syncthreads();
}
template <int MAP>
__device__ __forceinline__ void conv_T(const float* __restrict__ src, int Ktot, int N, int Kper, bf16_t* __restrict__ dst, size_t estride,
                                       const float* __restrict__ gain, int goff, LAS float* tile) {
    const int nslab = (Ktot >> 6) * (N >> 8);
    for (int sl = oblk(); sl < nslab; sl += ogrid()) conv_slab<MAP>(src, N, Kper, dst, estride, gain, goff, tile, sl);
}
constexpr int MOE_CONV_ITEMS = 3 * 256;
__device__ __forceinline__ void moe_convert_item(const PA a, int l, LAS unsigned char* lds, int item) {
    LAS float* tile = (LAS float*)lds;
    const int which = item >> 8, s0 = (item & 255) * 4;
    const float* gn = INP(30) + l * 1024;
    for (int sl = s0; sl < s0 + 4; ++sl) {
        if (which == 0)      conv_slab<1>(INP(35) + (size_t)l * 32 * 1024 * 512, 512, 1024, WSP(bf16_t, WS_WGU), (size_t)1024 * 1024, gn, 0, tile, sl);
        else if (which == 1) conv_slab<2>(INP(36) + (size_t)l * 32 * 1024 * 512, 512, 1024, WSP(bf16_t, WS_WGU), (size_t)1024 * 1024, gn, 0, tile, sl);
        else                 conv_slab<0>(INP(37) + (size_t)l * 32 * 512 * 1024, 1024, 512, WSP(bf16_t, WS_WD), (size_t)1024 * 512, nullptr, 0, tile, sl);
    }
}

__device__ __forceinline__ void rows_convert(const float* __restrict__ src, float* __restrict__ dstf, bf16_t* __restrict__ dstb, float* __restrict__ ss, int nrows) {
    const int wave = otid() >> 6, lane = otid() & 63;
    for (int r = oblk() * 8 + wave; r < nrows; r += ogrid() * 8) {
        float sq = 0.f;
        f32x4 vv[4];
#pragma unroll
        for (int i = 0; i < 4; ++i) vv[i] = *(const f32x4*)(src + (size_t)r * 1024 + i * 256 + lane * 4);
        asm volatile("" : "+v"(vv[0]), "+v"(vv[1]), "+v"(vv[2]), "+v"(vv[3]));
#pragma unroll
        for (int i = 0; i < 4; ++i) {
            const int c = i * 256 + lane * 4;
            const f32x4 v = vv[i];
            if (dstf) *(f32x4*)(dstf + (size_t)r * 1024 + c) = v;
            u32x2 w; w.x = pk2(v[0], v[1]); w.y = pk2(v[2], v[3]);
            *(u32x2*)(dstb + (size_t)r * 1024 + c) = w;
            sq += (v[0] * v[0] + v[1] * v[1]) + (v[2] * v[2] + v[3] * v[3]);
        }
        sq = wsum(sq);
        if (lane < 16) ss[(size_t)r * 16 + lane] = (lane == 0) ? sq : 0.f;
    }
}

__device__ __forceinline__ void p0_prologue(const PA a, LAS unsigned char* lds) {
    LAS float* tile = (LAS float*)lds;
    for (int l = 0; l < NL; ++l) {
        conv_T<3>(INP(3) + (size_t)l * 1024 * INW, 1024, INW, 1024, WSP(bf16_t, WS_WIN) + (size_t)l * INW * 1024, 0, INP(2) + l * 1024, 0, tile);
        conv_T<0>(INP(22) + (size_t)l * 1024 * 1024, 1024, 1024, 1024, WSP(bf16_t, WS_WOUT) + (size_t)l * 1024 * 1024, 0, INP(21) + l * 512, 512, tile);
        conv_T<0>(INP(25) + (size_t)l * 1024 * 512, 1024, 512, 1024, WSP(bf16_t, WS_WQ) + (size_t)l * 512 * 1024, 0, INP(23) + l * 1024, 0, tile);
        conv_T<0>(INP(26) + (size_t)l * 1024 * 1024, 1024, 1024, 1024, WSP(bf16_t, WS_WKV) + (size_t)l * 1024 * 1024, 0, INP(24) + l * 1024, 0, tile);
        conv_T<0>(INP(27) + (size_t)l * 512 * 1024, 512, 1024, 512, WSP(bf16_t, WS_WO) + (size_t)l * 1024 * 512, 0, nullptr, 0, tile);
    }
    {
        bf16_t* wrh = WSP(bf16_t, WS_WRH); bf16_t* wrl = WSP(bf16_t, WS_WRL);
        for (int idx = oblk() * 512 + otid(); idx < NL * 48 * 1024; idx += ogrid() * 512) {
            const int k = idx & 1023, r = (idx >> 10) % 48, l = idx / (48 * 1024);
            float w;
            if (r < 16) w = INP(31)[((size_t)l * 1024 + k) * 4 + (r & 3)];
            else { const int ri = ((r >> 2) & 3) * 8 + ((r >> 4) - 1) * 4 + (r & 3); w = INP(33)[((size_t)l * 1024 + k) * 32 + ri]; }
            w *= INP(30)[l * 1024 + k];
            const bf16_t hi = f2bf(w);
            wrh[idx] = hi; wrl[idx] = f2bf(w - bf2f(hi));
        }
    }
    {
        const int gt = oblk() * 512 + otid(), gs = ogrid() * 512;
        for (int e = gt; e < 16 * 8192; e += gs) { const int im = e >> 13, idx = e & 8191, ch = idx & 127, k = idx >> 7, l = im >> 2, chb = (im & 3) * 128;
            bf16_t* ib = (bf16_t*)(a.ws + WS_PBI + (size_t)im * PBI_BYTES);
            ib[ch * 72 + k] = f2bf(INP(6)[(size_t)l * 64 * 512 + k * 512 + chb + ch]); ib[9216 + ch * 72 + k] = f2bf(INP(8)[(size_t)l * 64 * 512 + k * 512 + chb + ch]); }
        for (int e = gt; e < 16 * 16384; e += gs) { const int im = e >> 14, idx = e & 16383, ch = idx & 127, k = idx >> 7, l = im >> 2, chb = (im & 3) * 128;
            bf16_t* ib = (bf16_t*)(a.ws + WS_PBI + (size_t)im * PBI_BYTES);
            ib[18432 + ch * 136 + k] = f2bf(INP(9)[(size_t)l * 128 * 512 + k * 512 + chb + ch]); }
        for (int e = gt; e < 16 * 4096; e += gs) { const int im = e >> 12, idx = e & 4095, ch = idx & 127, k = idx >> 7, l = im >> 2, chb = (im & 3) * 128;
            bf16_t* ib = (bf16_t*)(a.ws + WS_PBI + (size_t)im * PBI_BYTES);
            ib[35840 + ch * 40 + k] = l > 0 ? f2bf(INP(17)[(size_t)(l - 1) * 32 * 512 + k * 512 + chb + ch]) : (bf16_t)0; }
        for (int e = gt; e < 16 * 16384; e += gs) { const int im = e >> 14, idx = e & 16383, n = idx & 31, k = idx >> 5, l = im >> 2;
            bf16_t* ib = (bf16_t*)(a.ws + WS_PBI + (size_t)im * PBI_BYTES);
            ib[40960 + n * 520 + k] = l > 0 ? f2bf(INP(16)[(size_t)(l - 1) * 512 * 32 + k * 32 + n]) : (bf16_t)0; }
        for (int e = gt; e < 16 * 1920; e += gs) { const int im = e / 1920, idx = e - im * 1920, l = im >> 2, chb = (im & 3) * 128;
            float* fb = (float*)(a.ws + WS_PBI + (size_t)im * PBI_BYTES + 115200);
            float v;
            if (idx < 1152) { const int arr = idx >> 7, cc = chb + (idx & 127);
                v = arr == 0 ? INP(4)[l * 1792 + cc] : arr == 1 ? INP(4)[l * 1792 + 512 + cc] : arr == 2 ? INP(4)[l * 1792 + 1024 + cc] : arr == 3 ? INP(5)[l * 512 + cc]
                  : arr == 4 ? INP(7)[l * 512 + cc] : arr == 5 ? INP(10)[l * 512 + cc] : arr == 6 ? INP(11)[l * 512 + cc] : arr == 7 ? (l > 0 ? INP(15)[(l - 1) * 512 + cc] : 0.f) : INP(12)[l * 512 + cc]; }
            else v = INP(4)[l * 1792 + 1024 + (idx - 1152)];
            fb[idx] = v; }
    }
    rows_convert(INP(0), nullptr, WSP(bf16_t, WS_XB), WSP(float, WS_SS), T);
    rows_convert(INP(1), nullptr, WSP(bf16_t, WS_MEMB), WSP(float, WS_MEMSS), MROWS);
}

__device__ __forceinline__ void p2_knorm(const PA a, LAS unsigned char* lds) {
    const int wave = otid() >> 6, lane = otid() & 63;
    bf16_t* kv = WSP(bf16_t, WS_KV);
    for (int it = oblk() * 8 + wave; it < NL * MROWS * 4; it += ogrid() * 8) {
        const int h = it & 3, row = (it >> 2) & (MROWS - 1), l = it >> 14;
        unsigned* p = (unsigned*)(kv + ((size_t)l * MROWS + row) * 1024 + h * 128 + lane * 2);
        const unsigned w = *p; const float x0 = lo16(w), x1 = hi16(w);
        const float ssq = wsum(x0 * x0 + x1 * x1);
        const float rinv = rsqrtf(ssq * (1.0f / 128.0f) + 1e-6f);
        const float* gk = INP(29) + l * 128 + lane * 2;
        *p = pk2(x0 * rinv * gk[0], x1 * rinv * gk[1]);
    }
    bf16_t* vtx = WSP(bf16_t, WS_VTX);
    const int tid = otid();
    for (int it = oblk(); it < NL * 16 * 4; it += ogrid()) {
        const int h = it & 3, b = (it >> 2) & 15, l = it >> 6;
        const bf16_t* src = kv + ((size_t)l * MROWS + b * 256) * 1024 + 512 + h * 128;
        bf16_t* dst = vtx + (size_t)it * 128 * 256;
#pragma unroll 1
        for (int i = 0; i < 8; ++i) {
            const int p = tid + i * 512, d = p & 127, m8 = (p >> 7) * 8;
            unsigned short x[8];
#pragma unroll
            for (int j = 0; j < 8; ++j) x[j] = src[(size_t)(m8 + j) * 1024 + d];
            u32x4 w; w.x = x[0] | ((unsigned)x[1] << 16); w.y = x[2] | ((unsigned)x[3] << 16); w.z = x[4] | ((unsigned)x[5] << 16); w.w = x[6] | ((unsigned)x[7] << 16);
            *(u32x4*)(dst + (size_t)d * 256 + m8) = w;
        }
    }
}

__device__ __forceinline__ float fast_tanh(float x) { return 1.0f - 2.0f * __builtin_amdgcn_rcpf(1.0f + __expf(2.0f * x)); }
__device__ __forceinline__ float fast_sigmoid(float x) { return __builtin_amdgcn_rcpf(1.0f + __expf(-x)); }
template <int MODE>
__device__ __forceinline__ bf16x8 mixfrag(const bf16_t* pu, const bf16_t* pp, float hpf, unsigned mub, int colc, int col) {
    const u32x4 u = *(const u32x4*)(pu + col), p = *(const u32x4*)(pp + col);
    const f32x4 m0 = *(const LAS f32x4*)(unsigned long long)(mub + (unsigned)colc * 4u), m1 = *(const LAS f32x4*)(unsigned long long)(mub + (unsigned)colc * 4u + 16u);
    float x[8];
#pragma unroll
    for (int j = 0; j < 4; ++j) {
        const float u0 = lo16(u[j]), u1 = hi16(u[j]), p0 = lo16(p[j]) * hpf, p1 = hi16(p[j]) * hpf;
        const float ma = (j < 2) ? m0[2 * j] : m1[2 * j - 4], mb = (j < 2) ? m0[2 * j + 1] : m1[2 * j - 3];
        x[2 * j] = u0 + ma * (p0 - u0); x[2 * j + 1] = u1 + mb * (p1 - u1);
    }
#pragma unroll
    for (int j = 0; j < 8; ++j) { if (MODE == 1) x[j] = fast_tanh(x[j]); if (MODE == 2) x[j] = fast_sigmoid(x[j]); }
    u32x4 w; w.x = pk2(x[0], x[1]); w.y = pk2(x[2], x[3]); w.z = pk2(x[4], x[5]); w.w = pk2(x[6], x[7]);
    return __builtin_bit_cast(bf16x8, w);
}
__device__ __forceinline__ void pb_prep(const PA a, int l, LAS unsigned char* lds, XcdBarrier& bar) {
    const int tid = otid(), wave = __builtin_amdgcn_readfirstlane(tid >> 6), lane0 = tid & 63, fr0 = lane0 & 15, fq0 = lane0 >> 4;
    const int G = ogrid(), blk = oblk();
    LAS bf16_t* s_w2 = (LAS bf16_t*)lds;
    LAS bf16_t* s_a2 = (LAS bf16_t*)(lds + 18432);
    LAS bf16_t* s_g2 = (LAS bf16_t*)(lds + 36864);
    LAS bf16_t* s_v2 = (LAS bf16_t*)(lds + 71680);
    LAS bf16_t* s_v1 = (LAS bf16_t*)(lds + 81920);
    LAS float* s_par = (LAS float*)(lds + 115200);
    LAS float* s_mux = s_par + 1152;
    bf16_t* proj = WSP(bf16_t, WS_PROJ);
    const float* mu = INP(4) + l * 1792;
    const float* w0 = INP(5) + l * 512;  const float* w2 = INP(6) + (size_t)l * 64 * 512;
    const float* a0 = INP(7) + l * 512;  const float* a2 = INP(8) + (size_t)l * 64 * 512;
    const float* g2 = INP(9) + (size_t)l * 128 * 512;
    const float* kkw = INP(10) + l * 512; const float* kaw = INP(11) + l * 512;
    const int lv = l > 0 ? l - 1 : 0;
    const float* v0 = INP(15) + lv * 512; const float* v1 = INP(16) + (size_t)lv * 512 * 32; const float* v2 = INP(17) + (size_t)lv * 32 * 512;
    const float* qgn = INP(18) + l * 64; const float* kgn = INP(19) + l * 64;
    bf16_t* SR = WSP(bf16_t, WS_SR); bf16_t* SK = WSP(bf16_t, WS_SK); bf16_t* SV = WSP(bf16_t, WS_SV);
    bf16_t* SA = WSP(bf16_t, WS_SA); bf16_t* SB = WSP(bf16_t, WS_SB); bf16_t* SG = WSP(bf16_t, WS_SG);
    bf16_t* SWD = WSP(bf16_t, WS_SWD); bf16_t* VF = WSP(bf16_t, WS_VF);
    int cur_hp = blk & 3;
    {
        const unsigned char* img = a.ws + WS_PBI + (size_t)(l * 4 + cur_hp) * PBI_BYTES;
        for (int p = tid; p < PBI_BYTES / 16; p += 512) *(LAS u32x4*)(lds + p * 16) = *(const u32x4*)(img + (size_t)p * 16);
        __syncthreads();
    }
    u32x4* LH = WSP(u32x4, WS_LH);
    for (int tt = blk; tt < T / 128; tt += G) {
        const int lane = otid() & 63, fr = lane & 15, fq = lane >> 4;
        const int t = tt * 128 + wave * 16 + fr;
        const bool hpv = (t & (SEQ - 1)) != 0;
        const bf16_t* pu = proj + (size_t)t * INW;
        const bf16_t* pp = hpv ? pu - INW : pu;
        const float hpf = hpv ? 1.0f : 0.0f;
        unsigned mub = (unsigned)(unsigned long long)s_mux - 4096u + (unsigned)(fq * 32); asm volatile("" : "+v"(mub));
        u32x4* dst = LH + ((size_t)(tt * 8 + wave) * 9) * 64 + lane;
#pragma unroll
        for (int s = 0; s < 2; ++s) { dst[s * 64] = __builtin_bit_cast(u32x4, mixfrag<1>(pu, pp, hpf, mub, 1536 + 32 * s, 1536 + 32 * s + 8 * fq)); dst[(2 + s) * 64] = __builtin_bit_cast(u32x4, mixfrag<0>(pu, pp, hpf, mub, 1600 + 32 * s, 1600 + 32 * s + 8 * fq)); }
#pragma unroll
        for (int s = 0; s < 4; ++s) dst[(4 + s) * 64] = __builtin_bit_cast(u32x4, mixfrag<2>(pu, pp, hpf, mub, 1664 + 32 * s, 1664 + 32 * s + 8 * fq));
        if (l > 0) {
            f32x4 c0 = {0.f, 0.f, 0.f, 0.f}, c1 = {0.f, 0.f, 0.f, 0.f};
#pragma unroll 8
            for (int s = 0; s < 16; ++s) {
                const bf16x8 xf = mixfrag<0>(pu, pp, hpf, mub, 1024 + 32 * s, 1024 + 32 * s + 8 * fq);
                const bf16x8 wa = *(const LAS bf16x8*)(s_v1 + fr * 520 + 32 * s + 8 * fq), wb = *(const LAS bf16x8*)(s_v1 + (16 + fr) * 520 + 32 * s + 8 * fq);
                c0 = __builtin_amdgcn_mfma_f32_16x16x32_bf16(wa, xf, c0, 0, 0, 0);
                c1 = __builtin_amdgcn_mfma_f32_16x16x32_bf16(wb, xf, c1, 0, 0, 0);
            }
            u32x4 w; w.x = pk2(c0[0], c0[1]); w.y = pk2(c0[2], c0[3]); w.z = pk2(c1[0], c1[1]); w.w = pk2(c1[2], c1[3]);
            dst[8 * 64] = w;
        }
    }
    if (!MK_PER_PHASE) xcd_barrier(bar);
    for (int item = blk; item < 4 * (T / 128); item += G) {
        const int hp = item & 3, tt = item >> 2;
        if (hp != cur_hp) {
            __syncthreads();
            const unsigned char* img = a.ws + WS_PBI + (size_t)(l * 4 + hp) * PBI_BYTES;
            for (int p = tid; p < PBI_BYTES / 16; p += 512) *(LAS u32x4*)(lds + p * 16) = *(const u32x4*)(img + (size_t)p * 16);
            __syncthreads();
            cur_hp = hp;
        }
        const int lane = otid() & 63, fr = lane & 15, fq = lane >> 4;
        const int t = tt * 128 + wave * 16 + fr;
        const bool hpv = (t & (SEQ - 1)) != 0;
        const bf16_t* pu = proj + (size_t)t * INW;
        const bf16_t* pp = hpv ? pu - INW : pu;
        const float hpf = hpv ? 1.0f : 0.0f;
        bf16x8 fwl[2], fal[2], fgl[4], ft32;
        {
            const u32x4* lh = LH + ((size_t)(tt * 8 + wave) * 9) * 64 + lane;
#pragma unroll
            for (int s = 0; s < 2; ++s) { fwl[s] = __builtin_bit_cast(bf16x8, lh[s * 64]); fal[s] = __builtin_bit_cast(bf16x8, lh[(2 + s) * 64]); }
#pragma unroll
            for (int s = 0; s < 4; ++s) fgl[s] = __builtin_bit_cast(bf16x8, lh[(4 + s) * 64]);
            ft32 = (l > 0) ? __builtin_bit_cast(bf16x8, lh[8 * 64]) : fwl[0];
        }
        {
#pragma unroll
            for (int n8 = 0; n8 < 8; ++n8) {
                f32x4 ag = {0.f, 0.f, 0.f, 0.f};
#pragma unroll
                for (int s = 0; s < 4; ++s) ag = __builtin_amdgcn_mfma_f32_16x16x32_bf16(*(const LAS bf16x8*)(s_g2 + (n8 * 16 + fr) * 136 + 32 * s + 8 * fq), fgl[s], ag, 0, 0, 0);
                u32x2 w; w.x = pk2(ag[0], ag[1]); w.y = pk2(ag[2], ag[3]); *(u32x2*)(SG + (size_t)t * 512 + hp * 128 + n8 * 16 + 4 * fq) = w;
            }
        }
#pragma unroll 1
        for (int hh = 0; hh < 2; ++hh) {
            float atu[4][4], btu[4][4];
            u32x2 hR[4], hK[4], hV[4];
            float kss = 0.f, bsum = 0.f;
            const int t0w = tt * 128 + wave * 16, hd = hp * 2 + hh;
            const int cid = ((t0w >> 11) * 8 + hd) * 128 + ((t0w & (SEQ - 1)) >> 4);
#define DPP1(x, ctrl) __int_as_float(__builtin_amdgcn_update_dpp(0x3f800000, __float_as_int(x), (ctrl), 0xF, 0xF, false))
            u32x2 Lur[4], Lpr[4], Luk[4], Lpk[4], Luv[4], Lpv[4], Lvf[4];
#pragma unroll
            for (int nt = 0; nt < 4; ++nt) {
                if ((nt & 1) == 0) {
#pragma unroll
                    for (int n2 = nt; n2 < nt + 2; ++n2) {
                        const int c4 = hp * 128 + hh * 64 + n2 * 16 + 4 * fq;
                        Lur[n2] = *(const u32x2*)(pu + c4); Lpr[n2] = *(const u32x2*)(pp + c4);
                        Luk[n2] = *(const u32x2*)(pu + 512 + c4); Lpk[n2] = *(const u32x2*)(pp + 512 + c4);
                        Luv[n2] = *(const u32x2*)(pu + 1024 + c4); Lpv[n2] = *(const u32x2*)(pp + 1024 + c4);
                        Lvf[n2] = (l > 0) ? *(const u32x2*)(VF + (size_t)t * 512 + c4) : (u32x2){0u, 0u};
                    }
                    __builtin_amdgcn_sched_barrier(0);
                }
                const int lc = hh * 64 + nt * 16, ch4 = hp * 128 + lc + 4 * fq;
                f32x4 aw = {0.f, 0.f, 0.f, 0.f}, aa = aw, az = aw;
#pragma unroll
                for (int s = 0; s < 2; ++s) {
                    aw = __builtin_amdgcn_mfma_f32_16x16x32_bf16(*(const LAS bf16x8*)(s_w2 + (lc + fr) * 72 + 32 * s + 8 * fq), fwl[s], aw, 0, 0, 0);
                    aa = __builtin_amdgcn_mfma_f32_16x16x32_bf16(*(const LAS bf16x8*)(s_a2 + (lc + fr) * 72 + 32 * s + 8 * fq), fal[s], aa, 0, 0, 0);
                }
                if (l > 0) {
                    const u32x2 q0 = *(const LAS u32x2*)(s_v2 + (lc + fr) * 40 + 4 * fq), q1 = *(const LAS u32x2*)(s_v2 + (lc + fr) * 40 + 16 + 4 * fq);
                    u32x4 w; w.x = q0.x; w.y = q0.y; w.z = q1.x; w.w = q1.y;
                    az = __builtin_amdgcn_mfma_f32_16x16x32_bf16(__builtin_bit_cast(bf16x8, w), ft32, az, 0, 0, 0);
                }
                const u32x2 ur = Lur[nt], pr = Lpr[nt], uk = Luk[nt], pk = Lpk[nt], uv = Luv[nt], pv = Lpv[nt];
                const int pc4 = lc + 4 * fq;
                const f32x4 mr = *(const LAS f32x4*)(s_par + pc4), mk = *(const LAS f32x4*)(s_par + 128 + pc4), mv = *(const LAS f32x4*)(s_par + 256 + pc4);
                const f32x4 w0v = *(const LAS f32x4*)(s_par + 384 + pc4), a0v = *(const LAS f32x4*)(s_par + 512 + pc4), kkwv = *(const LAS f32x4*)(s_par + 640 + pc4), kawv = *(const LAS f32x4*)(s_par + 768 + pc4);
                float xr[4], xk[4], xv[4];
                { const float u0 = lo16(ur.x), u1 = hi16(ur.x), u2 = lo16(ur.y), u3 = hi16(ur.y);
                  xr[0] = u0 + mr[0] * (lo16(pr.x) * hpf - u0); xr[1] = u1 + mr[1] * (hi16(pr.x) * hpf - u1); xr[2] = u2 + mr[2] * (lo16(pr.y) * hpf - u2); xr[3] = u3 + mr[3] * (hi16(pr.y) * hpf - u3); }
                { const float u0 = lo16(uk.x), u1 = hi16(uk.x), u2 = lo16(uk.y), u3 = hi16(uk.y);
                  xk[0] = u0 + mk[0] * (lo16(pk.x) * hpf - u0); xk[1] = u1 + mk[1] * (hi16(pk.x) * hpf - u1); xk[2] = u2 + mk[2] * (lo16(pk.y) * hpf - u2); xk[3] = u3 + mk[3] * (hi16(pk.y) * hpf - u3); }
                { const float u0 = lo16(uv.x), u1 = hi16(uv.x), u2 = lo16(uv.y), u3 = hi16(uv.y);
                  xv[0] = u0 + mv[0] * (lo16(pv.x) * hpf - u0); xv[1] = u1 + mv[1] * (hi16(pv.x) * hpf - u1); xv[2] = u2 + mv[2] * (lo16(pv.y) * hpf - u2); xv[3] = u3 + mv[3] * (hi16(pv.y) * hpf - u3); }
                const size_t o = (size_t)t * 512 + ch4;
                if (l > 0) {
                    const f32x4 v0v = *(const LAS f32x4*)(s_par + 896 + pc4);
                    const u32x2 vfw = Lvf[nt];
                    const float vf0 = lo16(vfw.x), vf1 = hi16(vfw.x), vf2 = lo16(vfw.y), vf3 = hi16(vfw.y);
                    xv[0] += (vf0 - xv[0]) * fast_sigmoid(v0v[0] + az[0]); xv[1] += (vf1 - xv[1]) * fast_sigmoid(v0v[1] + az[1]);
                    xv[2] += (vf2 - xv[2]) * fast_sigmoid(v0v[2] + az[2]); xv[3] += (vf3 - xv[3]) * fast_sigmoid(v0v[3] + az[3]);
                } else {
                    u32x2 w; w.x = pk2(xv[0], xv[1]); w.y = pk2(xv[2], xv[3]); *(u32x2*)(VF + o) = w;
                }
                const f32x4 rkv = *(const LAS f32x4*)(s_par + 1024 + pc4);
                float P[4], rt[4], kt[4];
#pragma unroll
                for (int j = 0; j < 4; ++j) {
                    const float dcl = 0.8750387749f * fast_sigmoid(w0v[j] + aw[j]);
                    const float av = fast_sigmoid(a0v[j] + aa[j]);
                    const float kk = xk[j] * kkwv[j];
                    const float kmod = xk[j] * (1.0f + (av - 1.0f) * kawv[j]);
                    kss += kk * kk; bsum += xr[j] * kmod * rkv[j];
                    float p = __builtin_amdgcn_exp2f(-dcl);
                    p *= DPP1(p, 0x111); p *= DPP1(p, 0x112); p *= DPP1(p, 0x114); p *= DPP1(p, 0x118);
                    const float pm = DPP1(p, 0x111);
                    const float ip = __builtin_amdgcn_rcpf(p);
                    P[j] = p; rt[j] = xr[j] * p; kt[j] = kmod * ip; atu[nt][j] = -kk * pm; btu[nt][j] = kk * av * ip;
                }
                hR[nt].x = pk2(rt[0], rt[1]); hR[nt].y = pk2(rt[2], rt[3]); hK[nt].x = pk2(kt[0], kt[1]); hK[nt].y = pk2(kt[2], kt[3]);
                hV[nt].x = pk2(xv[0], xv[1]); hV[nt].y = pk2(xv[2], xv[3]);
                if (fr == 15) *(f32x4*)(WSP(float, WS_PCK) + (size_t)cid * 64 + nt * 16 + 4 * fq) = (f32x4){P[0], P[1], P[2], P[3]};
            }
            kss += __shfl_xor(kss, 16); kss += __shfl_xor(kss, 32);
            bsum += __shfl_xor(bsum, 16); bsum += __shfl_xor(bsum, 32);
            const float rn = rsqrtf(fmaxf(kss, 1e-24f));
            if (fq == 0) WSP(float, WS_BS)[(size_t)t * 8 + hd] = bsum;
            bf16x8 fA[2], fR[2], fB[2], fK[2], fV[2];
#pragma unroll
            for (int s_ = 0; s_ < 2; ++s_) {
                u32x4 w;
                w.x = pk2(atu[2 * s_][0] * rn, atu[2 * s_][1] * rn); w.y = pk2(atu[2 * s_][2] * rn, atu[2 * s_][3] * rn); w.z = pk2(atu[2 * s_ + 1][0] * rn, atu[2 * s_ + 1][1] * rn); w.w = pk2(atu[2 * s_ + 1][2] * rn, atu[2 * s_ + 1][3] * rn);
                fA[s_] = __builtin_bit_cast(bf16x8, w);
                w.x = pk2(btu[2 * s_][0] * rn, btu[2 * s_][1] * rn); w.y = pk2(btu[2 * s_][2] * rn, btu[2 * s_][3] * rn); w.z = pk2(btu[2 * s_ + 1][0] * rn, btu[2 * s_ + 1][1] * rn); w.w = pk2(btu[2 * s_ + 1][2] * rn, btu[2 * s_ + 1][3] * rn);
                fB[s_] = __builtin_bit_cast(bf16x8, w);
                fR[s_] = __builtin_bit_cast(bf16x8, (u32x4){hR[2 * s_].x, hR[2 * s_].y, hR[2 * s_ + 1].x, hR[2 * s_ + 1].y});
                fK[s_] = __builtin_bit_cast(bf16x8, (u32x4){hK[2 * s_].x, hK[2 * s_].y, hK[2 * s_ + 1].x, hK[2 * s_ + 1].y});
                fV[s_] = __builtin_bit_cast(bf16x8, (u32x4){hV[2 * s_].x, hV[2 * s_].y, hV[2 * s_ + 1].x, hV[2 * s_ + 1].y});
            }
#undef DPP1
            {
                int frv = fr, fqv = fq, lanev = lane; asm volatile("" : "+v"(frv), "+v"(fqv), "+v"(lanev));
                const unsigned rowo = (unsigned)(frv * 1024);
                char* ua = (char*)(SA + ((size_t)t0w * 512 + hd * 64)); char* ur = (char*)(SR + ((size_t)t0w * 512 + hd * 64));
#pragma unroll
                for (int s_ = 0; s_ < 2; ++s_) { const unsigned co = rowo + (unsigned)((((4 * s_ + fqv) ^ (frv & 7))) * 16);
                    *(u32x4*)(ua + co) = __builtin_bit_cast(u32x4, fA[s_]); *(u32x4*)(ur + co) = __builtin_bit_cast(u32x4, fR[s_]); }
                const f32x4 z4 = {0.f, 0.f, 0.f, 0.f};
#define MF(a_, b_, c_) __builtin_amdgcn_mfma_f32_16x16x32_bf16((a_), (b_), (c_), 0, 0, 0)
                const f32x4 nka = MF(fA[1], fK[1], MF(fA[0], fK[0], z4));
                const f32x4 nbr = MF(fR[1], fB[1], MF(fR[0], fB[0], z4));
                const f32x4 nkr = MF(fR[1], fK[1], MF(fR[0], fK[0], z4));
                const f32x4 nba = MF(fB[1], fA[1], MF(fB[0], fA[0], z4));
                unsigned nbu = (unsigned)(unsigned long long)((LAS float*)(lds + PBI_BYTES) + wave * 256); asm volatile("" : "+v"(nbu));
                LAS float* nb = (LAS float*)(unsigned long long)nbu;
                bf16_t* gim = WSP(bf16_t, WS_NKA) + (size_t)cid * 1024;
                const int ncol = (frv >> 2) * 8 + (frv & 3);
#pragma unroll
                for (int j = 0; j < 4; ++j) {
                    const int row = 4 * fqv + j;
                    gim[row * 32 + ncol + 4] = f2bf(frv < row ? nka[j] : 0.f);
                    gim[512 + row * 32 + ncol] = f2bf(frv <= row ? nbr[j] : 0.f);
                    gim[512 + row * 32 + ncol + 4] = f2bf(frv <= row ? nkr[j] : 0.f);
                    nb[row * 16 + frv] = (row < frv) ? nba[j] : 0.f;
                }
                const unsigned idv = (fqv == (frv >> 2)) ? (0x3f80u << (16 * (frv & 1))) : 0u;
                u32x4 idA = {0u, 0u, 0u, 0u}, idB = {0u, 0u, 0u, 0u};
                if ((frv & 3) < 2) { idA.x = idv; idB.z = idv; } else { idA.y = idv; idB.w = idv; }
                char* ubk = (char*)(WSP(bf16_t, WS_BTT) + (size_t)cid * 2048); char* uvs = (char*)(WSP(bf16_t, WS_VST) + (size_t)cid * 1024);
                const unsigned bko = (unsigned)(frv * 64 + fqv * 16), vso = (unsigned)(frv * 32 + fqv * 8);
#pragma unroll
                for (int n_ = 0; n_ < 4; ++n_) {
                    const bf16x8 idf = __builtin_bit_cast(bf16x8, (n_ & 1) ? idB : idA);
                    const f32x4 bT = MF(fB[n_ >> 1], idf, z4), kT = MF(fK[n_ >> 1], idf, z4), vT = MF(fV[n_ >> 1], idf, z4);
                    *(u32x4*)(ubk + n_ * 1024 + bko) = (u32x4){pk2(bT[0], bT[1]), pk2(bT[2], bT[3]), pk2(kT[0], kT[1]), pk2(kT[2], kT[3])};
                    *(u32x2*)(uvs + n_ * 512 + vso) = (u32x2){pk2(vT[0], vT[1]), pk2(vT[2], vT[3])};
                }
#undef MF
                if (lanev < 16) {
                    float X[16];
                    const int tcolp = (lanev >> 2) * 8 + (lanev & 3);
#pragma unroll
                    for (int tcol = 0; tcol < 16; ++tcol) {
                        float acc = (lanev == tcol) ? 1.0f : 0.0f;
#pragma unroll
                        for (int i = 0; i < tcol; ++i) acc += X[i] * nb[i * 16 + tcol];
                        X[tcol] = acc;
                        gim[tcol * 32 + tcolp] = f2bf(acc);
                    }
                }
            }
        }
    }
    __syncthreads();
}

__device__ __forceinline__ void pb2_chunks(const PA a, int l, LAS unsigned char* lds) {
    const int tid = otid(), wave = tid >> 6, lane = tid & 63, fr = lane & 15, fq = lane >> 4;
    LAS bf16_t* sA = (LAS bf16_t*)(lds + wave * 11520);
    LAS bf16_t* sR = sA + 1152; LAS bf16_t* sB = sR + 1152; LAS bf16_t* sK = sB + 1152; LAS bf16_t* sX = sK + 1152;
    LAS float* nb = (LAS float*)(lds + 8 * 11520) + wave * 256;
    bf16_t* SR = WSP(bf16_t, WS_SR); bf16_t* SK = WSP(bf16_t, WS_SK); bf16_t* SV = WSP(bf16_t, WS_SV);
    bf16_t* SA = WSP(bf16_t, WS_SA); bf16_t* SB = WSP(bf16_t, WS_SB); const bf16_t* SWD = WSP(const bf16_t, WS_SWD);
    const float* rkp = INP(12) + l * 512;
    for (int cid = oblk() * 8 + wave; cid < NCHUNK; cid += ogrid() * 8) {
        const int b = cid >> 10, h = (cid >> 7) & 7, c = cid & 127;
        const size_t tok0 = (size_t)b * SEQ + c * 16;
        const size_t e0 = tok0 * 512 + h * 64 + lane;
        const float rkv = rkp[h * 64 + lane];
        const int posl = (lane & 32) | (((lane & 15) >> 2) << 3) | (((lane >> 4) & 1) << 2) | (lane & 3);
        float P = 1.0f;
        unsigned bt2[8], kt2[8], vt2[8];
#pragma unroll
        for (int hf = 0; hf < 2; ++hf) {
            bf16_t r16[8], k16[8], a16[8], b16[8], v16[8]; float w32[8];
#pragma unroll
            for (int t8 = 0; t8 < 8; ++t8) { const size_t e = e0 + (size_t)(hf * 8 + t8) * 512; r16[t8] = SR[e]; k16[t8] = SK[e]; a16[t8] = SA[e]; b16[t8] = SB[e]; v16[t8] = SV[e]; w32[t8] = __builtin_amdgcn_exp2f(-bf2f(SWD[e])); }
#pragma unroll
            for (int t8 = 0; t8 < 8; ++t8) {
                const int t = hf * 8 + t8;
                const float rr = bf2f(r16[t8]), kk = bf2f(k16[t8]), aa = bf2f(a16[t8]), bb = bf2f(b16[t8]);
                const float Pm = P; P *= w32[t8]; const float ip = 1.0f / P;
                const unsigned ar = pk2(aa * Pm, rr * P), bk = pk2(bb * ip, kk * ip);
                const bf16_t at = (bf16_t)(ar & 0xffffu), rt = (bf16_t)(ar >> 16), btv = (bf16_t)(bk & 0xffffu), ktv = (bf16_t)(bk >> 16);
                { const size_t es = tok0 * 512 + (size_t)t * 512 + h * 64 + (posl ^ ((t & 7) << 3)); SA[es] = at; SR[es] = rt; }
                sA[t * 72 + lane] = at; sR[t * 72 + lane] = rt; sB[t * 72 + lane] = btv; sK[t * 72 + lane] = ktv;
                sX[t * 72 + lane] = (bf16_t)(pk2(rr * kk * rkv, 0.f) & 0xffffu);
                if (t & 1) { bt2[t >> 1] |= (unsigned)btv << 16; kt2[t >> 1] |= (unsigned)ktv << 16; vt2[t >> 1] |= (unsigned)v16[t8] << 16; }
                else       { bt2[t >> 1] = btv; kt2[t >> 1] = ktv; vt2[t >> 1] = v16[t8]; }
            }
        }
        WSP(float, WS_PCK)[(size_t)cid * 64 + lane] = P;
        {
            u32x4* pb_ = (u32x4*)(WSP(bf16_t, WS_BTT) + (size_t)cid * 2048 + lane * 32);
            u32x4* pv_ = (u32x4*)(WSP(bf16_t, WS_VST) + (size_t)cid * 1024 + lane * 16);
#pragma unroll
            for (int q = 0; q < 4; ++q) pb_[q] = (u32x4){bt2[2 * q], bt2[2 * q + 1], kt2[2 * q], kt2[2 * q + 1]};
            pv_[0] = (u32x4){vt2[0], vt2[1], vt2[2], vt2[3]}; pv_[1] = (u32x4){vt2[4], vt2[5], vt2[6], vt2[7]};
        }
        bf16x8 fA[2], fR[2], fB[2], fK[2], fX[2];
#pragma unroll
        for (int s_ = 0; s_ < 2; ++s_) {
            fA[s_] = *(const LAS bf16x8*)(sA + fr * 72 + 32 * s_ + 8 * fq); fR[s_] = *(const LAS bf16x8*)(sR + fr * 72 + 32 * s_ + 8 * fq);
            fB[s_] = *(const LAS bf16x8*)(sB + fr * 72 + 32 * s_ + 8 * fq); fK[s_] = *(const LAS bf16x8*)(sK + fr * 72 + 32 * s_ + 8 * fq);
            fX[s_] = *(const LAS bf16x8*)(sX + fr * 72 + 32 * s_ + 8 * fq);
        }
        const f32x4 z4 = {0.f, 0.f, 0.f, 0.f};
        const bf16x8 ones = {0x3f80, 0x3f80, 0x3f80, 0x3f80, 0x3f80, 0x3f80, 0x3f80, 0x3f80};
        const f32x4 nka = __builtin_amdgcn_mfma_f32_16x16x32_bf16(fA[1], fK[1], __builtin_amdgcn_mfma_f32_16x16x32_bf16(fA[0], fK[0], z4, 0, 0, 0), 0, 0, 0);
        const f32x4 nbr = __builtin_amdgcn_mfma_f32_16x16x32_bf16(fR[1], fB[1], __builtin_amdgcn_mfma_f32_16x16x32_bf16(fR[0], fB[0], z4, 0, 0, 0), 0, 0, 0);
        const f32x4 nkr = __builtin_amdgcn_mfma_f32_16x16x32_bf16(fR[1], fK[1], __builtin_amdgcn_mfma_f32_16x16x32_bf16(fR[0], fK[0], z4, 0, 0, 0), 0, 0, 0);
        const f32x4 nba = __builtin_amdgcn_mfma_f32_16x16x32_bf16(fB[1], fA[1], __builtin_amdgcn_mfma_f32_16x16x32_bf16(fB[0], fA[0], z4, 0, 0, 0), 0, 0, 0);
        const f32x4 bsm = __builtin_amdgcn_mfma_f32_16x16x32_bf16(fX[1], ones, __builtin_amdgcn_mfma_f32_16x16x32_bf16(fX[0], ones, z4, 0, 0, 0), 0, 0, 0);
        bf16_t* gim = WSP(bf16_t, WS_NKA) + (size_t)cid * 1024;
        const int ncol = (fr >> 2) * 8 + (fr & 3);
#pragma unroll
        for (int j = 0; j < 4; ++j) {
            const int row = 4 * fq + j;
            gim[row * 32 + ncol + 4] = f2bf(fr < row ? nka[j] : 0.f);
            gim[512 + row * 32 + ncol] = f2bf(fr <= row ? nbr[j] : 0.f);
            gim[512 + row * 32 + ncol + 4] = f2bf(fr <= row ? nkr[j] : 0.f);
            nb[row * 16 + fr] = (row < fr) ? nba[j] : 0.f;
            if (fr == 0) WSP(float, WS_BS)[(tok0 + row) * 8 + h] = bsm[j];
        }
        if (lane < 16) {
            float X[16];
            bf16_t* gtm = WSP(bf16_t, WS_NKA) + (size_t)cid * 1024; const int tcolp = (lane >> 2) * 8 + (lane & 3);
#pragma unroll
            for (int tcol = 0; tcol < 16; ++tcol) {
                float acc = (lane == tcol) ? 1.0f : 0.0f;
#pragma unroll
                for (int i = 0; i < tcol; ++i) acc += X[i] * nb[i * 16 + tcol];
                X[tcol] = acc;
                gtm[tcol * 32 + tcolp] = f2bf(acc);
            }
        }
    }
    __syncthreads();
}

__device__ __forceinline__ void scan_item(const PA a, int l, int bh, LAS unsigned char* lds) {
    const int tid = otid(), wave = __builtin_amdgcn_readfirstlane(tid >> 6), lane = tid & 63, fr = lane & 15, fq = lane >> 4;
    const int b = __builtin_amdgcn_readfirstlane(bh >> 3), h = __builtin_amdgcn_readfirstlane(bh & 7);
    constexpr int SLOT = 15104, NS = 8, DPF = 6;
    constexpr int OA = 0, OR_ = 2048, OBK = 4096, OVT = 8192, ON = 10240, OPC = 12288, OBS = 12544, OSG = 13056;
    constexpr int YBO = NS * SLOT;
    const size_t tokb = (size_t)b * SEQ;
    const int cid0 = (b * 8 + h) * 128;
    const unsigned char* gA = (const unsigned char*)WSP(const bf16_t, WS_SA); const unsigned char* gR = (const unsigned char*)WSP(const bf16_t, WS_SR);
    const unsigned char* gG = (const unsigned char*)WSP(const bf16_t, WS_SG);
    const unsigned char* gBK = (const unsigned char*)WSP(const bf16_t, WS_BTT);
    const unsigned char* gVT = (const unsigned char*)WSP(const bf16_t, WS_VST); const unsigned char* gN = (const unsigned char*)WSP(const bf16_t, WS_NKA);
    const unsigned char* gPC = (const unsigned char*)WSP(const float, WS_PCK); const unsigned char* gBS = (const unsigned char*)WSP(const float, WS_BS);
#define DMA16(gp, ldsoff) __builtin_amdgcn_global_load_lds((const unsigned*)(gp), (LAS unsigned*)(lds + (ldsoff)), 16, 0, 0)
    const unsigned rowoff0 = (unsigned)(((lane >> 3) * 512 + (lane & 7) * 8) * 2), rowoff1 = rowoff0 + 8u * 512u * 2u;
#define DMA_CHUNK(c_) do { const int cid_ = cid0 + (c_); const int so_ = ((c_) % NS) * SLOT; \
        const size_t rb_ = ((tokb + (size_t)(c_) * 16) * 512 + h * 64) * 2; \
        if (wave == 4) { \
            DMA16(gA + rb_ + rowoff0, so_ + OA); DMA16(gA + rb_ + rowoff1, so_ + OA + 1024); DMA16(gR + rb_ + rowoff0, so_ + OR_); DMA16(gR + rb_ + rowoff1, so_ + OR_ + 1024); \
            DMA16(gBK + (size_t)cid_ * 4096 + lane * 16, so_ + OBK); DMA16(gBK + (size_t)cid_ * 4096 + 1024 + lane * 16, so_ + OBK + 1024); \
            DMA16(gBK + (size_t)cid_ * 4096 + 2048 + lane * 16, so_ + OBK + 2048); DMA16(gBK + (size_t)cid_ * 4096 + 3072 + lane * 16, so_ + OBK + 3072); \
            if (lane < 16) DMA16(gPC + (size_t)cid_ * 256 + lane * 16, so_ + OPC); \
        } else { \
            DMA16(gVT + (size_t)cid_ * 2048 + lane * 16, so_ + OVT); DMA16(gVT + (size_t)cid_ * 2048 + 1024 + lane * 16, so_ + OVT + 1024); \
            DMA16(gN + (size_t)cid_ * 2048 + lane * 16, so_ + ON); DMA16(gN + (size_t)cid_ * 2048 + 1024 + lane * 16, so_ + ON + 1024); \
            DMA16(gG + rb_ + rowoff0, so_ + OSG); DMA16(gG + rb_ + rowoff1, so_ + OSG + 1024); \
            if (lane < 32) DMA16(gBS + (tokb + (size_t)(c_) * 16) * 32 + lane * 16, so_ + OBS); \
            if (lane < 1) DMA16(gPC + (size_t)cid_ * 256, so_ + OPC); if (lane < 1) DMA16(gPC + (size_t)cid_ * 256, so_ + OPC); \
        } } while (0)
#define MF(a_, b_, c_) __builtin_amdgcn_mfma_f32_16x16x32_bf16((a_), (b_), (c_), 0, 0, 0)
#define LDF(off_) (*(const LAS bf16x8*)(sl + (off_)))
    const int swz = fr & 7;
    const int aoff0 = fr * 128 + ((fq) ^ swz) * 16, aoff1 = fr * 128 + ((4 + fq) ^ swz) * 16;
    const int noff = fr * 64 + fq * 16, voff = ((wave & 3) * 16 + fr) * 32 + 8 * fq;
    const int hw = wave >= 6 ? wave - 6 : 0;
    const f32x4 lwA = *(const f32x4*)(INP(13) + l * 512 + h * 64 + hw * 32 + 8 * fq), lwB = *(const f32x4*)(INP(13) + l * 512 + h * 64 + hw * 32 + 8 * fq + 4);
    const f32x4 lbA = *(const f32x4*)(INP(14) + l * 512 + h * 64 + hw * 32 + 8 * fq), lbB = *(const f32x4*)(INP(14) + l * 512 + h * 64 + hw * 32 + 8 * fq + 4);
    bf16_t* YC = WSP(bf16_t, WS_YCAT);
#define SCAN_EPI(cp_) do { const int cp = (cp_); \
        const unsigned slb = (unsigned)(unsigned long long)(lds + (cp % NS) * SLOT), ybb = (unsigned)(unsigned long long)(lds + YBO + (cp & 1) * 4352); \
          \
        f32x4 y0, y1, y2, y3; unsigned eB_; u32x4 eG_; unsigned eV[8]; \
        { const unsigned ya = ybb + fr * 272 + fq * 32, ab_ = slb + OBS + fr * 32 + h * 4, ag_ = slb + OSG + fr * 128 + hw * 64 + fq * 16, av_ = slb + OVT + (hw * 32 + 8 * fq) * 32 + fr * 2; \
            asm volatile("ds_read_b128 %0, %4\n\tds_read_b128 %1, %4 offset:16\n\tds_read_b128 %2, %4 offset:128\n\tds_read_b128 %3, %4 offset:144" \
                         : "=&v"(y0), "=&v"(y1), "=&v"(y2), "=&v"(y3) : "v"(ya) : "memory"); \
            asm volatile("ds_read_b32 %0, %2\n\tds_read_b128 %1, %3" : "=&v"(eB_), "=&v"(eG_) : "v"(ab_), "v"(ag_) : "memory"); \
            asm volatile("ds_read_u16 %0, %8\n\tds_read_u16 %1, %8 offset:32\n\tds_read_u16 %2, %8 offset:64\n\tds_read_u16 %3, %8 offset:96\n\tds_read_u16 %4, %8 offset:128\n\tds_read_u16 %5, %8 offset:160\n\tds_read_u16 %6, %8 offset:192\n\tds_read_u16 %7, %8 offset:224\n\ts_waitcnt lgkmcnt(0)" \
                         : "=&v"(eV[0]), "=&v"(eV[1]), "=&v"(eV[2]), "=&v"(eV[3]), "=&v"(eV[4]), "=&v"(eV[5]), "=&v"(eV[6]), "=&v"(eV[7]) : "v"(av_) : "memory"); } \
        asm volatile("" : "+v"(y0), "+v"(y1), "+v"(y2), "+v"(y3), "+v"(eB_), "+v"(eG_)); \
        u32x4 f0, f1, g0, g1; \
        f0.x = pk2(y0[0], y0[1]); f0.y = pk2(y0[2], y0[3]); f0.z = pk2(y1[0], y1[1]); f0.w = pk2(y1[2], y1[3]); f1.x = pk2(y2[0], y2[1]); f1.y = pk2(y2[2], y2[3]); f1.z = pk2(y3[0], y3[1]); f1.w = pk2(y3[2], y3[3]); \
        g0.x = pk2(y0[0] * y0[0], y0[1] * y0[1]); g0.y = pk2(y0[2] * y0[2], y0[3] * y0[3]); g0.z = pk2(y1[0] * y1[0], y1[1] * y1[1]); g0.w = pk2(y1[2] * y1[2], y1[3] * y1[3]); \
        g1.x = pk2(y2[0] * y2[0], y2[1] * y2[1]); g1.y = pk2(y2[2] * y2[2], y2[3] * y2[3]); g1.z = pk2(y3[0] * y3[0], y3[1] * y3[1]); g1.w = pk2(y3[2] * y3[2], y3[3] * y3[3]); \
        const bf16x8 ones = {0x3f80, 0x3f80, 0x3f80, 0x3f80, 0x3f80, 0x3f80, 0x3f80, 0x3f80}; const f32x4 z4 = {0.f, 0.f, 0.f, 0.f}; \
        const f32x4 ssum = MF(ones, __builtin_bit_cast(bf16x8, f1), MF(ones, __builtin_bit_cast(bf16x8, f0), z4));        \
        const f32x4 sqsm = MF(ones, __builtin_bit_cast(bf16x8, g1), MF(ones, __builtin_bit_cast(bf16x8, g0), z4)); \
        const float mean = ssum[0] * (1.0f / 64.0f); const float var = fmaxf(sqsm[0] * (1.0f / 64.0f) - mean * mean, 0.f); \
        const float rstd = rsqrtf(var + 64e-5f), nmr = -mean * rstd, bon = __uint_as_float(eB_); \
        const f32x4 ya_ = hw ? y2 : y0, yb_ = hw ? y3 : y1; \
        float o_[8]; \
        _Pragma("unroll") for (int i = 0; i < 8; ++i) { \
            const float yv = i < 4 ? ya_[i & 3] : yb_[i & 3], lwv = i < 4 ? lwA[i & 3] : lwB[i & 3], lbv = i < 4 ? lbA[i & 3] : lbB[i & 3]; \
            const float vv = __uint_as_float(eV[i] << 16), g = (i & 1) ? hi16(eG_[i >> 1]) : lo16(eG_[i >> 1]); \
            o_[i] = (yv * (rstd * lwv) + (nmr * lwv + lbv) + bon * vv) * g; } \
        u32x4 ow; ow.x = pk2(o_[0], o_[1]); ow.y = pk2(o_[2], o_[3]); ow.z = pk2(o_[4], o_[5]); ow.w = pk2(o_[6], o_[7]); \
        bf16_t* yrow = YC + (tokb + (size_t)cp * 16) * 1024 + h * 64 + hw * 32;       \
        *(u32x4*)((char*)yrow + (unsigned)((fr * 1024 + 8 * fq) * 2)) = ow; } while (0)
    f32x4 S[4];
#pragma unroll
    for (int kt = 0; kt < 4; ++kt) S[kt] = (f32x4){0.f, 0.f, 0.f, 0.f};
    __syncthreads();
    if (wave == 4 || wave == 5) {
#pragma unroll 1
        for (int c = 0; c < DPF; ++c) DMA_CHUNK(c);
        asm volatile("s_waitcnt vmcnt(0)" ::: "memory");
    }
    __syncthreads();
#pragma unroll 1
    for (int c = 0; c < 128; ++c) {
        if (wave < 4) {
            const LAS unsigned char* sl = lds + (c % NS) * SLOT;
            u32x4 s0w, s1w; s0w.x = pk2(S[0][0], S[0][1]); s0w.y = pk2(S[0][2], S[0][3]); s0w.z = pk2(S[1][0], S[1][1]); s0w.w = pk2(S[1][2], S[1][3]);
            s1w.x = pk2(S[2][0], S[2][1]); s1w.y = pk2(S[2][2], S[2][3]); s1w.z = pk2(S[3][0], S[3][1]); s1w.w = pk2(S[3][2], S[3][3]);
            const bf16x8 Sf0 = __builtin_bit_cast(bf16x8, s0w), Sf1 = __builtin_bit_cast(bf16x8, s1w);
            const u32x2 vm = *(const LAS u32x2*)(sl + OVT + voff);
            const bf16x8 TN = LDF(ON + noff), BN = LDF(ON + 1024 + noff);
            const f32x4 z4 = {0.f, 0.f, 0.f, 0.f};
            const bf16x8 ZV = __builtin_bit_cast(bf16x8, (u32x4){0u, 0u, vm.x, vm.y});
            f32x4 Wt = MF(LDF(OA + aoff0), Sf0, z4); Wt = MF(LDF(OA + aoff1), Sf1, Wt); Wt = MF(TN, ZV, Wt);
            const bf16x8 WZ = __builtin_bit_cast(bf16x8, (u32x4){pk2(Wt[0], Wt[1]), pk2(Wt[2], Wt[3]), 0u, 0u});
            const f32x4 Ut = MF(TN, WZ, z4);
            const bf16x8 UV = __builtin_bit_cast(bf16x8, (u32x4){pk2(Ut[0], Ut[1]), pk2(Ut[2], Ut[3]), vm.x, vm.y});
            f32x4 Yt = MF(LDF(OR_ + aoff0), Sf0, z4); Yt = MF(LDF(OR_ + aoff1), Sf1, Yt); Yt = MF(BN, UV, Yt);
#pragma unroll
            for (int kt = 0; kt < 4; ++kt) {
                const f32x4 pc = *(const LAS f32x4*)(sl + OPC + (kt * 16 + 4 * fq) * 4);
                S[kt] = MF(LDF(OBK + kt * 1024 + noff), UV, S[kt]) * pc;
            }
            LAS float* yb = (LAS float*)(lds + YBO + (c & 1) * 4352) + (wave & 3) * 16 + fr;
#pragma unroll
            for (int j = 0; j < 4; ++j) yb[(4 * fq + j) * 68] = Yt[j];
            asm volatile("s_waitcnt lgkmcnt(0)" ::: "memory");
        } else if (wave < 6) {
            if (c + DPF < 128) DMA_CHUNK(c + DPF);
            if (c >= DPF && c + DPF < 128) asm volatile("s_waitcnt vmcnt(45)" ::: "memory"); else asm volatile("s_waitcnt vmcnt(0)" ::: "memory");
        } else if (c > 0) {
            SCAN_EPI(c - 1);
        }
        asm volatile("" ::: "memory"); __builtin_amdgcn_s_barrier(); asm volatile("" ::: "memory");
    }
    if (wave >= 6) { SCAN_EPI(127); }
    asm volatile("s_waitcnt vmcnt(0)" ::: "memory");
    __syncthreads();
#undef SCAN_EPI
#undef DMA16
#undef DMA_CHUNK
#undef MF
#undef LDF
}

__device__ __forceinline__ void attn_item(const PA a, int l, int it, LAS unsigned char* lds) {
    const int tid = otid(), h = __builtin_amdgcn_readfirstlane(tid >> 6), lane = tid & 63, fr = lane & 15, fq = lane >> 4;
    const int b = it >> 5, c = it & 31;
    LAS float* s_bias = (LAS float*)(lds + LDS_MISC + 1024);
    LAS float* s_part = s_bias + 8 * 320;
    LAS float* tb = (LAS float*)lds + h * 1600;
    __syncthreads();
    for (int e = lane; e < 1600; e += 64) { const int r = e / 400, y = e - r * 400; int idx = 383 - (y + r); idx = idx > 319 ? 319 : (idx < 0 ? 0 : idx); tb[e] = s_bias[h * 320 + idx]; }
    const bf16_t* proj = WSP(const bf16_t, WS_PROJ);
    const bf16_t* VT = WSP(const bf16_t, WS_VT) + (size_t)(b * 8 + h) * 64 * 2048;
    const size_t tq0 = (size_t)b * SEQ + c * 64;
    bf16x8 qf[4][2];
#pragma unroll
    for (int nt = 0; nt < 4; ++nt)
#pragma unroll
        for (int ks = 0; ks < 2; ++ks) qf[nt][ks] = *(const bf16x8*)(proj + (tq0 + nt * 16 + fr) * INW + 1792 + h * 64 + 32 * ks + 8 * fq);
    f32x4 o[5][4];
#pragma unroll
    for (int dt = 0; dt < 5; ++dt)
#pragma unroll
        for (int nt = 0; nt < 4; ++nt) o[dt][nt] = (f32x4){0.f, 0.f, 0.f, 0.f};
    const int kc0 = c - 8 > 0 ? c - 8 : 0;
    const int nsteps = (c - kc0 + 1) * 2;
    const bf16x8 ones = {0x3f80, 0x3f80, 0x3f80, 0x3f80, 0x3f80, 0x3f80, 0x3f80, 0x3f80};
    const int rr = (4 - (fr & 3)) & 3;
    const unsigned tbl = (unsigned)(unsigned long long)(tb + rr * 400) + (unsigned)((320 - fr + 4 * fq - rr - 48) * 4);
    const char* kbase = (const char*)(WSP(const bf16_t, WS_KFR) + ((size_t)(b * 8 + h) * 128 + kc0 * 4) * 1024);
    const char* vbase = (const char*)(VT + (size_t)kc0 * 2 * 2048);
    const unsigned loff = (unsigned)(lane * 16);
    bf16x8 kfA[2][2], kfB[2][2]; u32x4 vfA[4], vfB[4];
#define ATT_LOAD(KF, VF, st) do { unsigned lo_ = loff; asm volatile("" : "+v"(lo_)); \
        const char* kp_ = kbase + (size_t)(st) * 4096; const char* vp_ = vbase + (size_t)(st) * 4096; \
        _Pragma("unroll") for (int mt = 0; mt < 2; ++mt) _Pragma("unroll") for (int ks = 0; ks < 2; ++ks) \
            KF[mt][ks] = *(const bf16x8*)(kp_ + (mt * 2 + ks) * 1024 + lo_); \
        _Pragma("unroll") for (int dt = 0; dt < 4; ++dt) VF[dt] = *(const u32x4*)(vp_ + dt * 1024 + lo_); } while (0)
#define MF(a_, b_, c_) __builtin_amdgcn_mfma_f32_16x16x32_bf16((a_), (b_), (c_), 0, 0, 0)
#define ATT_STEP(KF, VF, st) do { \
        f32x4 sacc[2][4]; const f32x4 z4 = {0.f, 0.f, 0.f, 0.f}; \
        _Pragma("unroll") for (int mt = 0; mt < 2; ++mt) _Pragma("unroll") for (int nt = 0; nt < 4; ++nt) sacc[mt][nt] = MF(KF[mt][1], qf[nt][1], MF(KF[mt][0], qf[nt][0], z4)); \
        const int dk = c - (kc0 + ((st) >> 1)), half = (st) & 1; \
        if (dk >= 5) { const float bc = s_bias[h * 320 + 319]; \
            _Pragma("unroll") for (int mt = 0; mt < 2; ++mt) _Pragma("unroll") for (int nt = 0; nt < 4; ++nt) sacc[mt][nt] += bc; \
        } else { \
            const unsigned ta = tbl + (unsigned)((32 * half - 64 * dk + 256) * 4); f32x4 bv[5]; \
            _Pragma("unroll") for (int dd = 0; dd < 5; ++dd) bv[dd] = *(const LAS f32x4*)(unsigned long long)(ta - 1024u + (unsigned)((3 - (dd - 1)) * 64)); \
            _Pragma("unroll") for (int mt = 0; mt < 2; ++mt) _Pragma("unroll") for (int nt = 0; nt < 4; ++nt) sacc[mt][nt] += bv[nt - mt + 1]; } \
        bf16x8 pf[4]; \
        _Pragma("unroll") for (int nt = 0; nt < 4; ++nt) { \
            u32x4 w; w.x = pk2(__builtin_amdgcn_exp2f(sacc[0][nt][0]), __builtin_amdgcn_exp2f(sacc[0][nt][1])); w.y = pk2(__builtin_amdgcn_exp2f(sacc[0][nt][2]), __builtin_amdgcn_exp2f(sacc[0][nt][3])); \
            w.z = pk2(__builtin_amdgcn_exp2f(sacc[1][nt][0]), __builtin_amdgcn_exp2f(sacc[1][nt][1])); w.w = pk2(__builtin_amdgcn_exp2f(sacc[1][nt][2]), __builtin_amdgcn_exp2f(sacc[1][nt][3])); \
            pf[nt] = __builtin_bit_cast(bf16x8, w); } \
        _Pragma("unroll") for (int nt = 0; nt < 4; ++nt) { \
            _Pragma("unroll") for (int dt = 0; dt < 4; ++dt) o[dt][nt] = MF(__builtin_bit_cast(bf16x8, VF[dt]), pf[nt], o[dt][nt]); \
            o[4][nt] = MF(ones, pf[nt], o[4][nt]); } } while (0)
    ATT_LOAD(kfA, vfA, 0);
    __syncthreads();
#pragma unroll 1
    for (int st = 0; st < nsteps; st += 2) {
        ATT_LOAD(kfB, vfB, st + 1);
        ATT_STEP(kfA, vfA, st);
        if (st + 2 < nsteps) ATT_LOAD(kfA, vfA, st + 2);
        ATT_STEP(kfB, vfB, st + 1);
    }
#undef ATT_LOAD
#undef ATT_STEP
#undef MF
#pragma unroll
    for (int nt = 0; nt < 4; ++nt) {
        const float inv = 1.0f / o[4][nt][0];
        float sq = 0.f;
#pragma unroll
        for (int dt = 0; dt < 4; ++dt) { o[dt][nt] *= inv; sq += (o[dt][nt][0] * o[dt][nt][0] + o[dt][nt][1] * o[dt][nt][1]) + (o[dt][nt][2] * o[dt][nt][2] + o[dt][nt][3] * o[dt][nt][3]); }
        sq += __shfl_xor(sq, 16); sq += __shfl_xor(sq, 32);
        if (fq == 0) s_part[h * 64 + nt * 16 + fr] = sq;
    }
    __syncthreads();
#pragma unroll
    for (int nt = 0; nt < 4; ++nt) {
        float tot = 0.f;
#pragma unroll
        for (int hh = 0; hh < 8; ++hh) tot += s_part[hh * 64 + nt * 16 + fr];
        const float rinv = rsqrtf(tot * (1.0f / 512.0f) + 1e-6f);
        bf16_t* yp = WSP(bf16_t, WS_YCAT) + (tq0 + nt * 16 + fr) * 1024 + 512 + h * 64 + 4 * fq;
#pragma unroll
        for (int dt = 0; dt < 4; ++dt) { u32x2 w; w.x = pk2(o[dt][nt][0] * rinv, o[dt][nt][1] * rinv); w.y = pk2(o[dt][nt][2] * rinv, o[dt][nt][3] * rinv); *(u32x2*)(yp + dt * 16) = w; }
    }
    __syncthreads();
}

__device__ __forceinline__ void pc_mixer(const PA a, int l, LAS unsigned char* lds) {
    const int tid = otid();
    LAS float* s_bias = (LAS float*)(lds + LDS_MISC + 1024);
    volatile LAS int* s_item = (volatile LAS int*)(lds + LDS_MISC + 64);
    for (int i = tid; i < 8 * 320; i += 512) s_bias[i] = INP(20)[l * 8 * 320 + i] * 1.4426950408889634f;
    unsigned* qhead = WSP(unsigned, WS_CTL) + CW_QUEUE + l * 64;
    for (;;) {
        __syncthreads();
        if (tid == 0) *s_item = (int)__hip_atomic_fetch_add(qhead, 1u, __ATOMIC_RELAXED, __HIP_MEMORY_SCOPE_AGENT);
        __syncthreads();
        const int item = __builtin_amdgcn_readfirstlane(*s_item);
        if (item >= 128 + 512 + MOE_CONV_ITEMS) break;
        if (item < 128) scan_item(a, l, item, lds);
        else if (item < 128 + 512) attn_item(a, l, item - 128, lds);
        else moe_convert_item(a, l, lds, item - 640);
    }
}

__device__ __forceinline__ void pe2_xattn(const PA a, int l, LAS unsigned char* lds) {
    const int tid = otid(), wave = tid >> 6, lane = tid & 63, fr = lane & 15, fq = lane >> 4;
    LAS bf16_t* sK = (LAS bf16_t*)lds;
    LAS bf16_t* sV = (LAS bf16_t*)(lds + 69632);
    const bf16_t* QX = WSP(const bf16_t, WS_QX); bf16_t* OX = WSP(bf16_t, WS_OX);
    const bf16_t* KV = WSP(const bf16_t, WS_KV) + (size_t)l * MROWS * 1024;
    const bf16_t* VTX = WSP(const bf16_t, WS_VTX) + (size_t)l * MROWS * 512;
    const float* qgn = INP(28) + l * 128;
    for (int it = oblk(); it < 256; it += ogrid()) {
        const int b = it >> 4, h = (it >> 2) & 3, qr = it & 3;
        __syncthreads();
        {
            u32x4 tk[8], tv[8];
#pragma unroll
            for (int i = 0; i < 8; ++i) {
                const int p = tid + i * 512, r = p >> 4, c8 = (p & 15) * 8, d = p >> 5, m8 = (p & 31) * 8;
                tk[i] = *(const u32x4*)(KV + (size_t)(b * 256 + r) * 1024 + h * 128 + c8);
                tv[i] = *(const u32x4*)(VTX + ((size_t)(b * 4 + h) * 128 + d) * 256 + m8);
            }
            asm volatile("" : "+v"(tk[0]), "+v"(tk[1]), "+v"(tk[2]), "+v"(tk[3]), "+v"(tk[4]), "+v"(tk[5]), "+v"(tk[6]), "+v"(tk[7]));
            asm volatile("" : "+v"(tv[0]), "+v"(tv[1]), "+v"(tv[2]), "+v"(tv[3]), "+v"(tv[4]), "+v"(tv[5]), "+v"(tv[6]), "+v"(tv[7]));
#pragma unroll
            for (int i = 0; i < 8; ++i) {
                const int p = tid + i * 512, r = p >> 4, c8 = (p & 15) * 8, d = p >> 5, m8 = (p & 31) * 8;
                *(LAS u32x4*)(sK + r * 136 + c8) = tk[i];
                *(LAS u32x4*)(sV + d * 264 + m8) = tv[i];
            }
        }
        __syncthreads();
#pragma unroll 1
        for (int iter = 0; iter < 2; ++iter) {
            const size_t q0 = (size_t)b * SEQ + qr * 512 + iter * 256 + wave * 32;
            bf16x8 qf[2][4];
#pragma unroll
            for (int nt = 0; nt < 2; ++nt) {
                const bf16_t* qp = QX + (q0 + nt * 16 + fr) * 512 + h * 128 + 8 * fq;
                u32x4 w[4]; float ssq = 0.f;
#pragma unroll
                for (int ks = 0; ks < 4; ++ks) { w[ks] = *(const u32x4*)(qp + 32 * ks);
#pragma unroll
                    for (int j = 0; j < 4; ++j) { const float x0 = lo16(w[ks][j]), x1 = hi16(w[ks][j]); ssq += x0 * x0 + x1 * x1; } }
                ssq += __shfl_xor(ssq, 16); ssq += __shfl_xor(ssq, 32);
                const float sc = rsqrtf(ssq * (1.0f / 128.0f) + 1e-6f) * 0.12751743f;
#pragma unroll
                for (int ks = 0; ks < 4; ++ks) {
                    const f32x4 g0 = *(const f32x4*)(qgn + 32 * ks + 8 * fq), g1 = *(const f32x4*)(qgn + 32 * ks + 8 * fq + 4);
                    u32x4 ow;
                    ow.x = pk2(lo16(w[ks][0]) * sc * g0[0], hi16(w[ks][0]) * sc * g0[1]); ow.y = pk2(lo16(w[ks][1]) * sc * g0[2], hi16(w[ks][1]) * sc * g0[3]);
                    ow.z = pk2(lo16(w[ks][2]) * sc * g1[0], hi16(w[ks][2]) * sc * g1[1]); ow.w = pk2(lo16(w[ks][3]) * sc * g1[2], hi16(w[ks][3]) * sc * g1[3]);
                    qf[nt][ks] = __builtin_bit_cast(bf16x8, ow);
                }
            }
            f32x4 o[8][2];
#pragma unroll
            for (int dt = 0; dt < 8; ++dt) { o[dt][0] = (f32x4){0.f, 0.f, 0.f, 0.f}; o[dt][1] = (f32x4){0.f, 0.f, 0.f, 0.f}; }
            float lsum[2] = {0.f, 0.f};
#pragma unroll 2
            for (int st = 0; st < 8; ++st) {
                const int k0 = st * 32;
                f32x4 sacc[2][2];
#pragma unroll
                for (int mt = 0; mt < 2; ++mt) {
                    sacc[mt][0] = (f32x4){0.f, 0.f, 0.f, 0.f}; sacc[mt][1] = (f32x4){0.f, 0.f, 0.f, 0.f};
#pragma unroll
                    for (int ks = 0; ks < 4; ++ks) {
                        const bf16x8 kfr = *(const LAS bf16x8*)(sK + (k0 + mt * 16 + fr) * 136 + 32 * ks + 8 * fq);
                        sacc[mt][0] = __builtin_amdgcn_mfma_f32_16x16x32_bf16(kfr, qf[0][ks], sacc[mt][0], 0, 0, 0);
                        sacc[mt][1] = __builtin_amdgcn_mfma_f32_16x16x32_bf16(kfr, qf[1][ks], sacc[mt][1], 0, 0, 0);
                    }
                }
                bf16x8 pf[2];
#pragma unroll
                for (int nt = 0; nt < 2; ++nt) {
                    float p[8];
#pragma unroll
                    for (int j = 0; j < 4; ++j) { p[j] = __builtin_amdgcn_exp2f(fminf(sacc[0][nt][j], 80.f)); p[4 + j] = __builtin_amdgcn_exp2f(fminf(sacc[1][nt][j], 80.f)); }
                    lsum[nt] += ((p[0] + p[1]) + (p[2] + p[3])) + ((p[4] + p[5]) + (p[6] + p[7]));
                    u32x4 w; w.x = pk2(p[0], p[1]); w.y = pk2(p[2], p[3]); w.z = pk2(p[4], p[5]); w.w = pk2(p[6], p[7]);
                    pf[nt] = __builtin_bit_cast(bf16x8, w);
                }
#pragma unroll
                for (int dt = 0; dt < 8; ++dt) {
                    const LAS bf16_t* vp = sV + (dt * 16 + fr) * 264 + k0 + 4 * fq;
                    const u32x2 v0 = *(const LAS u32x2*)vp, v1 = *(const LAS u32x2*)(vp + 16);
                    u32x4 w; w.x = v0.x; w.y = v0.y; w.z = v1.x; w.w = v1.y;
                    const bf16x8 vfr = __builtin_bit_cast(bf16x8, w);
                    o[dt][0] = __builtin_amdgcn_mfma_f32_16x16x32_bf16(vfr, pf[0], o[dt][0], 0, 0, 0);
                    o[dt][1] = __builtin_amdgcn_mfma_f32_16x16x32_bf16(vfr, pf[1], o[dt][1], 0, 0, 0);
                }
            }
#pragma unroll
            for (int nt = 0; nt < 2; ++nt) {
                float ls = lsum[nt]; ls += __shfl_xor(ls, 16); ls += __shfl_xor(ls, 32);
                const float inv = 1.0f / ls;
                bf16_t* op = OX + (q0 + nt * 16 + fr) * 512 + h * 128 + 4 * fq;
#pragma unroll
                for (int dt = 0; dt < 8; ++dt) { u32x2 w; w.x = pk2(o[dt][nt][0] * inv, o[dt][nt][1] * inv); w.y = pk2(o[dt][nt][2] * inv, o[dt][nt][3] * inv); *(u32x2*)(op + dt * 16) = w; }
            }
        }
    }
    __syncthreads();
}

__device__ __forceinline__ void pf_router(const PA a, int l, LAS unsigned char* lds) {
    const int tid = otid(), wave = tid >> 6, lane = tid & 63, fr = lane & 15, fq = lane >> 4;
    LAS int* s_cnt = (LAS int*)lds;
    LAS int* s_base = s_cnt + 32;
    LAS int* s_e = s_base + 32;
    LAS int* s_rk = s_e + 256;
    LAS float* s_w = (LAS float*)(s_rk + 256);
    const bf16_t* X = WSP(const bf16_t, WS_XB); const float* SS = WSP(const float, WS_SS);
    const bf16_t* wrh = WSP(const bf16_t, WS_WRH) + (size_t)l * 48 * 1024; const bf16_t* wrl = WSP(const bf16_t, WS_WRL) + (size_t)l * 48 * 1024;
    const float* bg = INP(32) + l * 4; const float* br = INP(34) + l * 32;
    int* EID = WSP(int, WS_EID); float* EW = WSP(float, WS_EW); int* ERK = WSP(int, WS_ERK);
    unsigned* cnt = WSP(unsigned, WS_CTL) + CW_CNT + l * 32;
    for (int tile = oblk(); tile < T / 128; tile += ogrid()) {
        __syncthreads();
        if (tid < 32) s_cnt[tid] = 0;
        __syncthreads();
        const int t = tile * 128 + wave * 16 + fr;
        f32x4 acc[3];
#pragma unroll
        for (int mt = 0; mt < 3; ++mt) acc[mt] = (f32x4){0.f, 0.f, 0.f, 0.f};
        const bf16_t* xr = X + (size_t)t * 1024 + 8 * fq;
        u32x4 wst[6];
#define RT_LOAD(sl_) do { _Pragma("unroll") for (int i = 0; i < 6; ++i) { const int p = tid + i * 512, arr = p / 1536, pr = p - arr * 1536, r = pr >> 5, q = pr & 31; \
            wst[i] = *(const u32x4*)((arr ? wrl : wrh) + (size_t)r * 1024 + (sl_) * 256 + q * 8); } } while (0)
#define RT_STORE(buf_) do { _Pragma("unroll") for (int i = 0; i < 6; ++i) { const int p = tid + i * 512, arr = p / 1536, pr = p - arr * 1536, r = pr >> 5, q = pr & 31; \
            *(LAS u32x4*)(lds + 4096 + (buf_) * 50688 + arr * 25344 + r * 528 + q * 16) = wst[i]; } } while (0)
        RT_LOAD(0); RT_STORE(0);
        __syncthreads();
#pragma unroll 1
        for (int sl = 0; sl < 4; ++sl) {
            if (sl < 3) RT_LOAD(sl + 1);
            const LAS unsigned char* wb_ = lds + 4096 + (sl & 1) * 50688;
#pragma unroll
            for (int s8 = 0; s8 < 8; ++s8) {
                const int s_ = sl * 8 + s8;
                const bf16x8 xh = *(const bf16x8*)(xr + 32 * s_);
#pragma unroll
                for (int mt = 0; mt < 3; ++mt) {
                    const bf16x8 wh = *(const LAS bf16x8*)(wb_ + (mt * 16 + fr) * 528 + (32 * s8 + 8 * fq) * 2);
                    const bf16x8 wl = *(const LAS bf16x8*)(wb_ + 25344 + (mt * 16 + fr) * 528 + (32 * s8 + 8 * fq) * 2);
                    acc[mt] = __builtin_amdgcn_mfma_f32_16x16x32_bf16(wh, xh, acc[mt], 0, 0, 0);
                    acc[mt] = __builtin_amdgcn_mfma_f32_16x16x32_bf16(wl, xh, acc[mt], 0, 0, 0);
                }
            }
            if (sl < 3) { RT_STORE((sl + 1) & 1); __syncthreads(); }
        }
#undef RT_LOAD
#undef RT_STORE
        const f32x4* sp = (const f32x4*)(SS + (size_t)t * 16);
        const f32x4 s0 = sp[0], s1 = sp[1], s2 = sp[2], s3 = sp[3];
        const float tot = ((s0[0] + s0[1]) + (s0[2] + s0[3])) + ((s1[0] + s1[1]) + (s1[2] + s1[3])) + ((s2[0] + s2[1]) + (s2[2] + s2[3])) + ((s3[0] + s3[1]) + (s3[2] + s3[3]));
        const float rinv = rsqrtf(tot * (1.0f / 1024.0f) + 1e-6f);
        float lg[4], lr[8];
#pragma unroll
        for (int j = 0; j < 4; ++j) { lg[j] = acc[0][j] * rinv + bg[j]; lr[j] = acc[1][j] * rinv + br[fq * 8 + j]; lr[4 + j] = acc[2][j] * rinv + br[fq * 8 + 4 + j]; }
        float g0 = lg[0]; int gt = 0;
#pragma unroll
        for (int j = 1; j < 4; ++j) { if (lg[j] > g0) { g0 = lg[j]; gt = j; } }
        if (fq == gt) {
            float gs = 0.f;
#pragma unroll
            for (int j = 0; j < 4; ++j) gs += __expf(lg[j] - g0);
            const float ggate = 1.0f / gs;
            float l1 = -1e30f, l2 = -1e30f; int j1 = 0, j2 = 0;
#pragma unroll
            for (int j = 0; j < 8; ++j) { const float v = lr[j];
                if (v > l1) { l2 = l1; j2 = j1; l1 = v; j1 = j; } else if (v > l2) { l2 = v; j2 = j; } }
            const float e2 = __expf(l2 - l1);
            const float p1 = 1.0f / (1.0f + e2), p2 = e2 / (1.0f + e2);
            const int e1i = gt * 8 + j1, e2i = gt * 8 + j2;
            const int r1 = atomicAdd((int*)(s_cnt + e1i), 1), r2 = atomicAdd((int*)(s_cnt + e2i), 1);
            const int sl = (wave * 16 + fr) * 2;
            s_e[sl] = e1i; s_e[sl + 1] = e2i; s_rk[sl] = r1; s_rk[sl + 1] = r2; s_w[sl] = ggate * p1; s_w[sl + 1] = ggate * p2;
        }
        __syncthreads();
        if (tid < 32) s_base[tid] = (int)__hip_atomic_fetch_add(cnt + tid, (unsigned)s_cnt[tid], __ATOMIC_RELAXED, __HIP_MEMORY_SCOPE_AGENT);
        __syncthreads();
        if (tid < 256) { const int e = s_e[tid]; const size_t o = (size_t)tile * 256 + tid; EID[o] = e; EW[o] = s_w[tid]; ERK[o] = s_base[e] + s_rk[tid]; }
    }
    __syncthreads();
}

__device__ __forceinline__ void pg_gather(const PA a, int l, LAS unsigned char* lds) {
    const int tid = otid(), wave = tid >> 6, lane = tid & 63;
    LAS int* s_ps = (LAS int*)lds;
    const unsigned* cnt = WSP(const unsigned, WS_CTL) + CW_CNT + l * 32;
    int* SSLOT = WSP(int, WS_SSLOT); float* SW = WSP(float, WS_SW); int* MTE = WSP(int, WS_MTE);
    bf16_t* XS = WSP(bf16_t, WS_XS); const bf16_t* XB = WSP(const bf16_t, WS_XB);
    const float* SS = WSP(const float, WS_SS);
    const int* EID = WSP(const int, WS_EID); const float* EW = WSP(const float, WS_EW); const int* ERK = WSP(const int, WS_ERK);
    __syncthreads();
    if (tid == 0) {
        int acc = 0;
        for (int e = 0; e < 32; ++e) { s_ps[e] = acc; const int c = (int)__hip_atomic_load(cnt + e, __ATOMIC_RELAXED, __HIP_MEMORY_SCOPE_AGENT); acc += ((c + 255) >> 8) << 8; }
        s_ps[32] = acc;
    }
    __syncthreads();
    if (oblk() == 0) {
        if (tid < 32) { const int m0 = s_ps[tid] >> 8, m1 = s_ps[tid + 1] >> 8; for (int mt = m0; mt < m1; ++mt) MTE[mt] = tid; }
        if (tid == 0) MTE[511] = s_ps[32] >> 8;
        if (tid < 33) MTE[400 + tid] = s_ps[tid] >> 8;
    }
    int* STOK = WSP(int, WS_STOK); float* SRINV = WSP(float, WS_SRINV);
    for (int e = oblk(); e < 32; e += ogrid()) {
        const int c = (int)__hip_atomic_load(cnt + e, __ATOMIC_RELAXED, __HIP_MEMORY_SCOPE_AGENT);
        const int r0 = s_ps[e] + c, r1 = s_ps[e + 1];
        for (int r = r0 + tid; r < r1; r += 512) { SSLOT[r] = -1; SW[r] = 0.f; STOK[r] = 0; SRINV[r] = 0.f; }
    }
    for (int as = oblk() * 512 + tid; as < 2 * T; as += ogrid() * 512) {
        const int t = as >> 1;
        const int dest = s_ps[EID[as]] + ERK[as];
        const f32x4* sp = (const f32x4*)(SS + (size_t)t * 16);
        const f32x4 s0 = sp[0], s1 = sp[1], s2 = sp[2], s3 = sp[3];
        const float tot = ((s0[0] + s0[1]) + (s0[2] + s0[3])) + ((s1[0] + s1[1]) + (s1[2] + s1[3])) + ((s2[0] + s2[1]) + (s2[2] + s2[3])) + ((s3[0] + s3[1]) + (s3[2] + s3[3]));
        SSLOT[dest] = as; SW[dest] = EW[as]; STOK[dest] = t; SRINV[dest] = rsqrtf(tot * (1.0f / 1024.0f) + 1e-6f);
    }
}

__device__ __forceinline__ void pj_finalize(const PA a, bool last) {
    const int wave = otid() >> 6, lane = otid() & 63;
    float* OUT = a.out; bf16_t* XB = WSP(bf16_t, WS_XB); float* SS = WSP(float, WS_SS);
    const bf16_t* Y = WSP(const bf16_t, WS_Y);
    for (int t = oblk() * 8 + wave; t < T; t += ogrid() * 8) {
        float sq = 0.f;
#pragma unroll
        for (int i = 0; i < 2; ++i) {
            const int c = i * 512 + lane * 8;
            const u32x4 xw = *(const u32x4*)(XB + (size_t)t * 1024 + c);
            const u32x4 y0 = *(const u32x4*)(Y + (size_t)(2 * t) * 1024 + c), y1 = *(const u32x4*)(Y + (size_t)(2 * t + 1) * 1024 + c);
            float v[8];
#pragma unroll
            for (int j = 0; j < 4; ++j) { v[2 * j] = lo16(xw[j]) + (lo16(y0[j]) + lo16(y1[j])); v[2 * j + 1] = hi16(xw[j]) + (hi16(y0[j]) + hi16(y1[j])); }
            if (last) { *(f32x4*)(OUT + (size_t)t * 1024 + c) = (f32x4){v[0], v[1], v[2], v[3]}; *(f32x4*)(OUT + (size_t)t * 1024 + c + 4) = (f32x4){v[4], v[5], v[6], v[7]}; }
            else {
                u32x4 w; w.x = pk2(v[0], v[1]); w.y = pk2(v[2], v[3]); w.z = pk2(v[4], v[5]); w.w = pk2(v[6], v[7]);
                *(u32x4*)(XB + (size_t)t * 1024 + c) = w;
#pragma unroll
                for (int j = 0; j < 4; ++j) { const float a0 = lo16(w[j]), a1 = hi16(w[j]); sq += a0 * a0 + a1 * a1; }
            }
        }
        if (!last) { sq = wsum(sq); if (lane < 16) SS[(size_t)t * 16 + lane] = (lane == 0) ? sq : 0.f; }
    }
}

#define SITE static __device__ __forceinline__ void
#define OPAQUE() do { a.out = (float*)ldsin(lds, 38); a.ws = (unsigned char*)ldsin(lds, 39); } while (0)
__device__ __forceinline__ int opq(int v) { asm volatile("" : "+s"(v)); return v; }
SITE site_p0(PA a, LAS unsigned char* lds) { OPAQUE(); p0_prologue(a, lds); }
SITE site_kv(PA a, LAS unsigned char* lds) { OPAQUE();
    pg8::Gemm g{WSP(const bf16_t, WS_MEMB), WSP(const bf16_t, WS_WKV), 1024, (size_t)1024 * 1024, nullptr};
    pg8::KvOrder S{opq((int)gridDim.x), opq((int)blockIdx.x)};
    pg8::EpiScale E{WSP(bf16_t, WS_KV), 1024, WSP(const float, WS_MEMSS), MROWS - 1};
    pg8::gemm_phase<pg8::EpiScale, pg8::KvOrder>(lds, g, S, E);
}
SITE site_knorm(PA a, LAS unsigned char* lds) { OPAQUE(); p2_knorm(a, lds); }
SITE site_inproj(PA a, int l, LAS unsigned char* lds) { OPAQUE();
    pg8::Gemm g{WSP(const bf16_t, WS_XB), WSP(const bf16_t, WS_WIN) + (size_t)l * INW * 1024, 1024, 0, nullptr};
    pg8::StaticOrder S; S.init(T, INW, opq((int)gridDim.x), opq((int)blockIdx.x));
    pg8::EpiProj E{WSP(bf16_t, WS_PROJ), WSP(bf16_t, WS_VT), WSP(bf16_t, WS_KFR), WSP(const float, WS_SS), INP(18) + l * 64, INP(19) + l * 64};
    pg8::gemm_phase<pg8::EpiProj, pg8::StaticOrder>(lds, g, S, E);
}
SITE site_prep(PA a, int l, LAS unsigned char* lds, XcdBarrier& bar) { OPAQUE();
    pb_prep(a, l, lds, bar);
}
SITE site_chunks(PA a, int l, LAS unsigned char* lds) { OPAQUE(); pb2_chunks(a, l, lds); }
SITE site_mixer(PA a, int l, LAS unsigned char* lds) { OPAQUE(); pc_mixer(a, l, lds); }
SITE site_outproj(PA a, int l, LAS unsigned char* lds) { OPAQUE();
    pg8::Gemm g{WSP(const bf16_t, WS_YCAT), WSP(const bf16_t, WS_WOUT) + (size_t)l * 1024 * 1024, 1024, 0, nullptr};
    pg8::StaticOrder S; S.init(T, 1024, opq((int)gridDim.x), opq((int)blockIdx.x));
    pg8::EpiRes E{WSP(bf16_t, WS_XB), WSP(float, WS_SS)};
    pg8::gemm_phase<pg8::EpiRes, pg8::StaticOrder>(lds, g, S, E);
}
SITE site_xq(PA a, int l, LAS unsigned char* lds) { OPAQUE();
    pg8::Gemm g{WSP(const bf16_t, WS_XB), WSP(const bf16_t, WS_WQ) + (size_t)l * 512 * 1024, 1024, 0, nullptr};
    pg8::StaticOrder S; S.init(T, 512, opq((int)gridDim.x), opq((int)blockIdx.x));
    pg8::EpiScale E{WSP(bf16_t, WS_QX), 512, WSP(const float, WS_SS), T - 1};
    pg8::gemm_phase<pg8::EpiScale, pg8::StaticOrder>(lds, g, S, E);
}
SITE site_xattn(PA a, int l, LAS unsigned char* lds) { OPAQUE(); pe2_xattn(a, l, lds); }
SITE site_xo(PA a, int l, LAS unsigned char* lds) { OPAQUE();
    pg8::Gemm g{WSP(const bf16_t, WS_OX), WSP(const bf16_t, WS_WO) + (size_t)l * 1024 * 512, 512, 0, nullptr};
    pg8::StaticOrder S; S.init(T, 1024, opq((int)gridDim.x), opq((int)blockIdx.x));
    pg8::EpiRes E{WSP(bf16_t, WS_XB), WSP(float, WS_SS)};
    pg8::gemm_phase<pg8::EpiRes, pg8::StaticOrder>(lds, g, S, E);
}
SITE site_router(PA a, int l, LAS unsigned char* lds) { OPAQUE(); pf_router(a, l, lds); }
SITE site_gather(PA a, int l, LAS unsigned char* lds) { OPAQUE(); pg_gather(a, l, lds); }
SITE site_gu(PA a, LAS unsigned char* lds) { OPAQUE();
    pg8::Gemm g{WSP(const bf16_t, WS_XB), WSP(const bf16_t, WS_WGU), 1024, (size_t)1024 * 1024, WSP(const int, WS_STOK)};
    pg8::MoeOrder S; S.mte = WSP(const int, WS_MTE); S.G = opq((int)gridDim.x); S.c = opq((int)blockIdx.x); S.init();
    pg8::EpiGU E{WSP(bf16_t, WS_HB), WSP(const float, WS_SRINV)};
    pg8::gemm_phase<pg8::EpiGU, pg8::MoeOrder, true, true>(lds, g, S, E);
}
SITE site_down(PA a, LAS unsigned char* lds) { OPAQUE();
    pg8::Gemm g{WSP(const bf16_t, WS_HB), WSP(const bf16_t, WS_WD), 512, (size_t)1024 * 512, nullptr};
    pg8::MoeOrder S; S.mte = WSP(const int, WS_MTE); S.G = opq((int)gridDim.x); S.c = opq((int)blockIdx.x); S.init();
    pg8::EpiDown E{WSP(bf16_t, WS_Y), WSP(const int, WS_SSLOT), WSP(const float, WS_SW)};
    pg8::gemm_phase<pg8::EpiDown, pg8::MoeOrder>(lds, g, S, E);
}
SITE site_final(PA a, int l, LAS unsigned char* lds) { OPAQUE(); pj_finalize(a, l == NL - 1); }

__global__ void __launch_bounds__(512, 2) mk_fwd(Args args) {
    extern __shared__ __attribute__((aligned(16))) unsigned char lds_raw[];
    LAS unsigned char* lds = (LAS unsigned char*)lds_raw;
    const int tid = threadIdx.x;
    const int lo = args.ph_lo, hi = args.ph_hi;
    PA a; a.out = args.out; a.ws = args.ws;
    if (tid < 16) ((LAS unsigned*)(lds + LDS_MISC))[tid] = 0u;
    if (tid == 64) {
        LAS unsigned long long* tab = (LAS unsigned long long*)(lds + LDS_INTAB);
#pragma unroll
        for (int i = 0; i < 38; ++i) tab[i] = (unsigned long long)args.in[i];
        tab[38] = (unsigned long long)args.out; tab[39] = (unsigned long long)args.ws;
    }
    __syncthreads();
    XcdBarrier bar; bar.bar = WSP(unsigned, WS_CTL) + CW_BAR; bar.x = 0; bar.st = nullptr;
    if (!MK_PER_PHASE) bar = xcd_barrier_post(WSP(unsigned, WS_CTL) + CW_BAR, (volatile LAS unsigned*)(lds + LDS_MISC));
#define IN(k) (lo <= (k) && (k) < hi)
#define GRID_BAR() do { if (!MK_PER_PHASE) xcd_barrier(bar); } while (0)
#ifdef PROBE_MASK
    unsigned long long pr_acc = 0ull, pr_t0 = 0ull; const unsigned long long pr_start = wall_clock64();
#define PR0() do { pr_t0 = wall_clock64(); } while (0)
#define PR1(p) do { if ((PROBE_MASK >> (p)) & 1) pr_acc += wall_clock64() - pr_t0; } while (0)
#else
#define PR0() do { } while (0)
#define PR1(p) do { } while (0)
#endif
    PR0(); if (IN(0)) { site_p0(a, lds); GRID_BAR(); } PR1(12);
    PR0(); if (IN(1)) { site_kv(a, lds); GRID_BAR(); } PR1(13);
    PR0(); if (IN(2)) { site_knorm(a, lds); GRID_BAR(); } PR1(14);
    for (int l = 0; l < NL; ++l) {
        const int pb = 3 + 12 * l;
        PR0(); if (IN(pb + 0)) { site_inproj(a, l, lds); GRID_BAR(); } PR1(0);
        PR0(); if (IN(pb + 1)) { site_prep(a, l, lds, bar); GRID_BAR(); } PR1(1);
        PR0(); if (IN(pb + 2)) { site_mixer(a, l, lds); GRID_BAR(); } PR1(2);
        PR0(); if (IN(pb + 3)) { site_outproj(a, l, lds); GRID_BAR(); } PR1(3);
        PR0(); if (IN(pb + 4)) { site_xq(a, l, lds); GRID_BAR(); } PR1(4);
        PR0(); if (IN(pb + 5)) { site_xattn(a, l, lds); GRID_BAR(); } PR1(5);
        PR0(); if (IN(pb + 6)) { site_xo(a, l, lds); GRID_BAR(); } PR1(6);
        PR0(); if (IN(pb + 7)) { site_router(a, l, lds); GRID_BAR(); } PR1(7);
        PR0(); if (IN(pb + 8)) { site_gather(a, l, lds); GRID_BAR(); } PR1(8);
        PR0(); if (IN(pb + 9)) { site_gu(a, lds); GRID_BAR(); } PR1(9);
        PR0(); if (IN(pb + 10)) { site_down(a, lds); GRID_BAR(); } PR1(10);
#ifdef PROBE_MASK
        PR0(); if (IN(pb + 11)) { site_final(a, l, lds); GRID_BAR(); } PR1(11);
#else
        if (IN(pb + 11)) { site_final(a, l, lds); if (l + 1 < NL) GRID_BAR(); }
#endif
    }
#ifdef PROBE_MASK
    {
        unsigned long long* pw = (unsigned long long*)(WSP(unsigned, WS_CTL) + 8192);
        if (blockIdx.x == 0 && tid == 0) __hip_atomic_store(pw, pr_acc, __ATOMIC_RELAXED, __HIP_MEMORY_SCOPE_AGENT);
        GRID_BAR();
        const unsigned long long tgt = 1600000ull + __hip_atomic_load(pw, __ATOMIC_RELAXED, __HIP_MEMORY_SCOPE_AGENT) * (unsigned long long)PROBE_MULT;
        while (wall_clock64() - pr_start < tgt) __builtin_amdgcn_s_sleep(16);
    }
#endif
#undef IN
#undef GRID_BAR
}

extern "C" void kernel_launch(void* const* d_in, const int* in_sizes, int n_in, void* d_out, int out_size, void* d_ws, size_t ws_size, hipStream_t stream) {
    static int grid = 0;
    if (grid == 0) {
        if (n_in != 38 || out_size != T * D || ws_size < WS_END) { fprintf(stderr, "kernel_launch: unexpected shapes (n_in %d out %d ws %zu need %zu)\n", n_in, out_size, ws_size, (size_t)WS_END); grid = -1; return; }
        int dev = 0, cus = 0, per_cu = 0;
        if (hipGetDevice(&dev) != hipSuccess || hipDeviceGetAttribute(&cus, hipDeviceAttributeMultiprocessorCount, dev) != hipSuccess) { grid = -1; return; }
        if (hipFuncSetAttribute((const void*)mk_fwd, hipFuncAttributeMaxDynamicSharedMemorySize, LDS_BYTES) != hipSuccess) { fprintf(stderr, "kernel_launch: hipFuncSetAttribute failed\n"); grid = -1; return; }
        if (hipOccupancyMaxActiveBlocksPerMultiprocessor(&per_cu, (const void*)mk_fwd, 512, LDS_BYTES) != hipSuccess || per_cu < 1) { fprintf(stderr, "kernel_launch: occupancy query says %d\n", per_cu); }
        (void)hipGetLastError();
        grid = cus;
    }
    if (grid < 0) return;
    (void)hipMemsetAsync((char*)d_ws + WS_CTL, 0, CTL_BYTES, stream);
    Args a{};
    for (int i = 0; i < 38; ++i) a.in[i] = (const float*)d_in[i];
    a.out = (float*)d_out; a.ws = (unsigned char*)d_ws;
#if MK_PER_PHASE
    for (int p = 0; p < NPH; ++p) { a.ph_lo = p; a.ph_hi = p + 1; hipLaunchKernelGGL(mk_fwd, dim3(grid), dim3(512), LDS_BYTES, stream, a); }
#else
    a.ph_lo = 0; a.ph_hi = NPH;
    hipLaunchKernelGGL(mk_fwd, dim3(grid), dim3(512), LDS_BYTES, stream, a);
#endif
}
```
